# Optimizing an MI355X kernel written in HIP

```python
import jax, jax.numpy as jnp
from jax import lax
import numpy as np

D_MODEL = 1024
BATCH = 16
SEQ = 2048
DEPTH = 4

N_MIXERS = 3
HD = 64
H_MIX = 12
H_MEM = 4
MIX_W = H_MIX * HD
MEM_W = H_MEM * HD
N_MEM = 256
D_FF = 2816
ROPE_THETA = 10000.0
EPS = 1e-6
NEG = -1e30
FORCE = 1e9

RET_H = 6
RET_DK = 64
RET_DV = 128
RET_CHUNK = 128

DSA_H = 12
IDX_H = 8
IDX_D = 64
DSA_TOPK_MAX = 256
Q_BLK = 128

NSA_H = 12
NSA_G = 4
CMP_L = 32
CMP_S = 16
SLC_L = 64
SLC_N_MAX = 16
WIN = 512
SLC_Q_BLK = 16

N_A = (DEPTH + 2) // 3
N_B = (DEPTH + 1) // 3
N_C = DEPTH // 3

RET_SIZES = [RET_H * RET_DK, RET_H * RET_DK, RET_H * RET_DV, RET_H * RET_DV, MEM_W]
DSA_SIZES = [DSA_H * HD, HD, HD, IDX_H * IDX_D, IDX_D, IDX_H, MEM_W]
NSA_SIZES = [NSA_H * HD] + [NSA_G * HD] * 6 + [NSA_H * 3, MEM_W]
RET_COLS = sum(RET_SIZES)
DSA_COLS = sum(DSA_SIZES)
NSA_COLS = sum(NSA_SIZES)

kernel_name = 'hybrid_interleaved_retention_dsa_nsa_macaron'


def split_cols(a, sizes):
    return jnp.split(a, np.cumsum(sizes)[:-1].tolist(), axis=-1)


def rms_norm(x, g):
    xf = x.astype(jnp.float32)
    y = xf * lax.rsqrt(jnp.mean(xf * xf, axis=-1, keepdims=True) + EPS)
    return (y * g.astype(jnp.float32)).astype(x.dtype)


def rope(x, pos):
    half = x.shape[-1] // 2
    inv = ROPE_THETA ** (-jnp.arange(half, dtype=jnp.float32) / half)
    ang = pos.astype(jnp.float32)[:, None] * inv[None, :]
    cos = jnp.cos(ang)[:, None, :].astype(x.dtype)
    sin = jnp.sin(ang)[:, None, :].astype(x.dtype)
    x1, x2 = x[..., :half], x[..., half:]
    return jnp.concatenate([x1 * cos - x2 * sin, x2 * cos + x1 * sin], axis=-1)


def swiglu(x, wg, wu, wd):
    return (jax.nn.silu(x @ wg) * (x @ wu)) @ wd


def masked_softmax(logits, valid):
    return jax.nn.softmax(jnp.where(valid, logits.astype(jnp.float32), NEG), axis=-1)


def chunkwise_retention(q, k, v):
    B, L, H, DK = q.shape
    DV = v.shape[-1]
    C = RET_CHUNK
    nc = L // C
    log_g = jnp.log(1.0 - 2.0 ** (-5.0 - jnp.arange(H, dtype=jnp.float32)))
    qc = q.reshape(B, nc, C, H, DK)
    kc = k.reshape(B, nc, C, H, DK)
    vc = v.reshape(B, nc, C, H, DV)
    idx = jnp.arange(C, dtype=jnp.float32)
    diff = idx[:, None] - idx[None, :]
    dmask = jnp.where(diff >= 0, jnp.exp(log_g[:, None, None] * jnp.maximum(diff, 0.0)), 0.0)
    inner = jnp.einsum('bnihd,bnjhd->bnhij', qc, kc) * dmask
    o_inner = jnp.einsum('bnhij,bnjhe->bnihe', inner, vc)
    zeta = jnp.exp(log_g[:, None] * (C - 1.0 - idx)[None, :])
    kv = jnp.einsum('bnjhd,hj,bnjhe->bnhde', kc, zeta, vc)
    chunk_decay = jnp.exp(log_g * C)[:, None, None]

    def step(state, kv_n):
        return state * chunk_decay + kv_n, state

    state0 = jnp.zeros((B, H, DK, DV), kv.dtype)
    _, prev = lax.scan(step, state0, jnp.moveaxis(kv, 1, 0))
    prev = jnp.moveaxis(prev, 0, 1)
    xi = jnp.exp(log_g[:, None] * (idx + 1.0)[None, :])
    o_cross = jnp.einsum('bnihd,bnhde->bnihe', qc, prev) * xi.T[None, None, :, :, None]
    return (o_inner + o_cross).reshape(B, L, H, DV).astype(jnp.float32)


def retention_mixer(h, w_in):
    B, L, _ = h.shape
    pos = jnp.arange(L)
    q, k, v, g, q_mem = split_cols(h @ w_in, RET_SIZES)
    q = rope(q.reshape(B, L, RET_H, RET_DK), pos)
    k = rope(k.reshape(B, L, RET_H, RET_DK), pos) * (RET_DK ** -0.5)
    v = v.reshape(B, L, RET_H, RET_DV)
    o = chunkwise_retention(q, k, v)
    mu = jnp.mean(o, axis=-1, keepdims=True)
    var = jnp.mean(jnp.square(o - mu), axis=-1, keepdims=True)
    o = ((o - mu) * lax.rsqrt(var + EPS)).astype(h.dtype)
    y = jax.nn.silu(g) * o.reshape(B, L, RET_H * RET_DV)
    return y, q_mem


def dsa_mixer(h, w_in, qn, kn):
    B, L, _ = h.shape
    pos = jnp.arange(L)
    q, k, v, iq, ik, iw, q_mem = split_cols(h @ w_in, DSA_SIZES)
    q = rope(rms_norm(q.reshape(B, L, DSA_H, HD), qn), pos)
    k = rope(rms_norm(k.reshape(B, L, 1, HD), kn), pos)[:, :, 0]
    iq = rope(iq.reshape(B, L, IDX_H, IDX_D), pos)
    ik = rope(ik.reshape(B, L, 1, IDX_D), pos)[:, :, 0]
    topk = min(DSA_TOPK_MAX, L // 4)
    scale = HD ** -0.5
    gather = jax.vmap(lambda t, s: t[s])

    def block(i):
        qs = i * Q_BLK
        qpos = qs + jnp.arange(Q_BLK)
        q_b = lax.dynamic_slice_in_dim(q, qs, Q_BLK, axis=1)
        iq_b = lax.dynamic_slice_in_dim(iq, qs, Q_BLK, axis=1)
        iw_b = lax.dynamic_slice_in_dim(iw, qs, Q_BLK, axis=1)
        rel = jax.nn.relu(jnp.einsum('bqhd,bsd->bqhs', iq_b, ik).astype(jnp.float32))
        score = jnp.einsum('bqh,bqhs->bqs', iw_b.astype(jnp.float32), rel)
        causal = pos[None, :] <= qpos[:, None]
        score = jnp.where(causal[None], score, -jnp.inf)
        _, sel = lax.top_k(score, topk)
        k_sel = gather(k, sel)
        v_sel = gather(v, sel)
        valid = (sel <= qpos[None, :, None])[:, :, None, :]
        lg = jnp.einsum('bqhd,bqkd->bqhk', q_b, k_sel) * scale
        p = masked_softmax(lg, valid)
        return jnp.einsum('bqhk,bqkd->bqhd', p.astype(v_sel.dtype), v_sel)

    o = lax.map(block, jnp.arange(L // Q_BLK))
    o = jnp.moveaxis(o, 0, 1).reshape(B, L, DSA_H * HD)
    return o, q_mem


def nsa_mixer(h, w_in, qn, kn, cmp_pos_k, cmp_pos_v, cmp_wk, cmp_wv):
    B, L, _ = h.shape
    R = NSA_H // NSA_G
    pos = jnp.arange(L)
    scale = HD ** -0.5
    q, kc, vc, ks, vs, kw, vw, gates, q_mem = split_cols(h @ w_in, NSA_SIZES)
    q = rope(rms_norm(q.reshape(B, L, NSA_H, HD), qn), pos).reshape(B, L, NSA_G, R, HD)
    grp = lambda t: t.reshape(B, L, NSA_G, HD)
    kc, vc, vs, vw = grp(kc), grp(vc), grp(vs), grp(vw)
    ks = rope(rms_norm(grp(ks), kn[1]), pos)
    kw = rope(rms_norm(grp(kw), kn[2]), pos)

    n_cmp = (L - CMP_L) // CMP_S + 1
    starts = jnp.arange(n_cmp) * CMP_S
    ends = starts + CMP_L - 1
    blk = starts[:, None] + jnp.arange(CMP_L)[None, :]
    k_blk = kc[:, blk] + cmp_pos_k[None, None, :, None, :]
    v_blk = vc[:, blk] + cmp_pos_v[None, None, :, None, :]
    k_cmp = jnp.einsum('bnlgd,lde->bnge', k_blk, cmp_wk)
    v_cmp = jnp.einsum('bnlgd,lde->bnge', v_blk, cmp_wv)
    k_cmp = rope(rms_norm(k_cmp, kn[0]), ends)
    valid_c = ends[None, :] <= pos[:, None]
    lg = jnp.einsum('bqgrd,bngd->bgrqn', q, k_cmp) * scale
    p_cmp = masked_softmax(lg, valid_c) * jnp.any(valid_c, axis=-1)[:, None]
    o_cmp = jnp.einsum('bgrqn,bngd->bqgrd', p_cmp.astype(v_cmp.dtype), v_cmp)

    n_slc = L // SLC_L
    n_sel = min(SLC_N_MAX, n_slc)
    sstart = jnp.arange(n_slc) * SLC_L
    cover = ((starts[:, None] < sstart[None, :] + SLC_L) &
             (starts[:, None] + CMP_L > sstart[None, :])).astype(jnp.float32)
    imp = jnp.einsum('bgrqn,nj->bgqj', p_cmp, cover)
    jj = jnp.arange(n_slc)[None, :]
    qblk = (pos // SLC_L)[:, None]
    forced = (jj == 0) | (jj == qblk) | (jj == qblk - 1)
    causal_blk = sstart[None, :] <= pos[:, None]
    imp = jnp.where(causal_blk, imp + forced.astype(jnp.float32) * FORCE, NEG)
    _, sel = lax.top_k(imp, n_sel)
    ks_blk = ks.reshape(B, n_slc, SLC_L, NSA_G, HD).transpose(0, 3, 1, 2, 4)
    vs_blk = vs.reshape(B, n_slc, SLC_L, NSA_G, HD).transpose(0, 3, 1, 2, 4)
    gather = jax.vmap(jax.vmap(lambda t, s: t[s]))

    def slc_block(i):
        qs = i * SLC_Q_BLK
        qpos = qs + jnp.arange(SLC_Q_BLK)
        q_c = lax.dynamic_slice_in_dim(q, qs, SLC_Q_BLK, axis=1)
        s_c = lax.dynamic_slice_in_dim(sel, qs, SLC_Q_BLK, axis=2)
        k_g = gather(ks_blk, s_c)
        v_g = gather(vs_blk, s_c)
        kpos = s_c[..., None] * SLC_L + jnp.arange(SLC_L)
        valid = (kpos <= qpos[None, None, :, None, None])[:, :, None]
        lg_s = jnp.einsum('bqgrd,bgqnld->bgrqnl', q_c, k_g) * scale
        lg_s = jnp.where(valid, lg_s.astype(jnp.float32), NEG)
        p = jax.nn.softmax(lg_s.reshape(B, NSA_G, R, SLC_Q_BLK, n_sel * SLC_L), axis=-1).reshape(lg_s.shape)
        return jnp.einsum('bgrqnl,bgqnld->bqgrd', p.astype(v_g.dtype), v_g)

    o_slc = lax.map(slc_block, jnp.arange(L // SLC_Q_BLK))
    o_slc = jnp.moveaxis(o_slc, 0, 1).reshape(B, L, NSA_G, R, HD)

    pad = ((0, 0), (WIN, 0), (0, 0), (0, 0))
    kw_p, vw_p = jnp.pad(kw, pad), jnp.pad(vw, pad)

    def win_block(i):
        qs = i * Q_BLK
        qpos = qs + jnp.arange(Q_BLK)
        kpos = qs - WIN + jnp.arange(WIN + Q_BLK)
        q_b = lax.dynamic_slice_in_dim(q, qs, Q_BLK, axis=1)
        k_b = lax.dynamic_slice_in_dim(kw_p, qs, WIN + Q_BLK, axis=1)
        v_b = lax.dynamic_slice_in_dim(vw_p, qs, WIN + Q_BLK, axis=1)
        d = qpos[:, None] - kpos[None, :]
        valid = (d >= 0) & (d < WIN) & (kpos[None, :] >= 0)
        lg_w = jnp.einsum('bqgrd,bkgd->bgrqk', q_b, k_b) * scale
        p = masked_softmax(lg_w, valid)
        return jnp.einsum('bgrqk,bkgd->bqgrd', p.astype(v_b.dtype), v_b)

    o_win = lax.map(win_block, jnp.arange(L // Q_BLK))
    o_win = jnp.moveaxis(o_win, 0, 1).reshape(B, L, NSA_G, R, HD)

    g = jax.nn.sigmoid(gates.reshape(B, L, NSA_G, R, 3))
    o = g[..., 0:1] * o_cmp + g[..., 1:2] * o_slc + g[..., 2:3] * o_win
    return o.reshape(B, L, NSA_H * HD), q_mem


def memory_attention(q_raw, mem, norm_g, w_kv, qn, kn):
    B, L, _ = q_raw.shape
    M = mem.shape[1]
    k, v = split_cols(rms_norm(mem, norm_g) @ w_kv, [MEM_W, MEM_W])
    k = rms_norm(k.reshape(B, M, H_MEM, HD), kn)
    v = v.reshape(B, M, H_MEM, HD)
    q = rms_norm(q_raw.reshape(B, L, H_MEM, HD), qn)
    lg = jnp.einsum('bqhd,bmhd->bhqm', q, k).astype(jnp.float32) * (HD ** -0.5)
    p = jax.nn.softmax(lg, axis=-1)
    return jnp.einsum('bhqm,bmhd->bqhd', p.astype(v.dtype), v).reshape(B, L, MEM_W)


def setup_inputs(seed: int = 0) -> dict:
    key = jax.random.key(seed)
    ks = jax.random.split(key, 24)
    f32 = jnp.float32

    def nrm(k, shape, fan_in):
        return jax.random.normal(k, shape, f32) * (fan_in ** -0.5)

    def gain(k, shape):
        return 1.0 + 0.05 * jax.random.normal(k, shape, f32)

    return {
        'x': jax.random.normal(ks[0], (BATCH, SEQ, D_MODEL), f32),
        'mem': jax.random.normal(ks[1], (BATCH, N_MEM, D_MODEL), f32),
        'ffn_norm': gain(ks[2], (DEPTH, 2, D_MODEL)),
        'ffn_w_gate': nrm(ks[3], (DEPTH, 2, D_MODEL, D_FF), D_MODEL),
        'ffn_w_up': nrm(ks[4], (DEPTH, 2, D_MODEL, D_FF), D_MODEL),
        'ffn_w_down': nrm(ks[5], (DEPTH, 2, D_FF, D_MODEL), D_FF),
        'mix_norm': gain(ks[6], (DEPTH, D_MODEL)),
        'w_out': nrm(ks[7], (DEPTH, MIX_W + MEM_W, D_MODEL), MIX_W + MEM_W),
        'mem_norm': gain(ks[8], (DEPTH, D_MODEL)),
        'mem_w_kv': nrm(ks[9], (DEPTH, D_MODEL, 2 * MEM_W), D_MODEL),
        'mem_qn': gain(ks[10], (DEPTH, HD)),
        'mem_kn': gain(ks[11], (DEPTH, HD)),
        'ret_w_in': nrm(ks[12], (N_A, D_MODEL, RET_COLS), D_MODEL),
        'dsa_w_in': nrm(ks[13], (N_B, D_MODEL, DSA_COLS), D_MODEL),
        'dsa_qn': gain(ks[14], (N_B, HD)),
        'dsa_kn': gain(ks[15], (N_B, HD)),
        'nsa_w_in': nrm(ks[16], (N_C, D_MODEL, NSA_COLS), D_MODEL),
        'nsa_qn': gain(ks[17], (N_C, HD)),
        'nsa_kn': gain(ks[18], (N_C, 3, HD)),
        'nsa_cmp_pos_k': 0.1 * jax.random.normal(ks[19], (N_C, CMP_L, HD), f32),
        'nsa_cmp_pos_v': 0.1 * jax.random.normal(ks[20], (N_C, CMP_L, HD), f32),
        'nsa_cmp_wk': nrm(ks[21], (N_C, CMP_L, HD, HD), CMP_L * HD),
        'nsa_cmp_wv': nrm(ks[22], (N_C, CMP_L, HD, HD), CMP_L * HD),
    }


def reference(x, mem, ffn_norm, ffn_w_gate, ffn_w_up, ffn_w_down, mix_norm, w_out,
              mem_norm, mem_w_kv, mem_qn, mem_kn, ret_w_in, dsa_w_in, dsa_qn, dsa_kn,
              nsa_w_in, nsa_qn, nsa_kn, nsa_cmp_pos_k, nsa_cmp_pos_v, nsa_cmp_wk, nsa_cmp_wv):
    for i in range(DEPTH):
        h = rms_norm(x, ffn_norm[i, 0])
        x = x + 0.5 * swiglu(h, ffn_w_gate[i, 0], ffn_w_up[i, 0], ffn_w_down[i, 0])
        h = rms_norm(x, mix_norm[i])
        kind, j = i % N_MIXERS, i // N_MIXERS
        if kind == 0:
            y_mix, q_mem = retention_mixer(h, ret_w_in[j])
        elif kind == 1:
            y_mix, q_mem = dsa_mixer(h, dsa_w_in[j], dsa_qn[j], dsa_kn[j])
        else:
            y_mix, q_mem = nsa_mixer(h, nsa_w_in[j], nsa_qn[j], nsa_kn[j], nsa_cmp_pos_k[j],
                                     nsa_cmp_pos_v[j], nsa_cmp_wk[j], nsa_cmp_wv[j])
        y_mem = memory_attention(q_mem, mem, mem_norm[i], mem_w_kv[i], mem_qn[i], mem_kn[i])
        x = x + jnp.concatenate([y_mix, y_mem], axis=-1) @ w_out[i]
        h = rms_norm(x, ffn_norm[i, 1])
        x = x + 0.5 * swiglu(h, ffn_w_gate[i, 1], ffn_w_up[i, 1], ffn_w_down[i, 1])
    return x
```

```cpp
#include <hip/hip_runtime.h>
#include <cstdio>
#include <cstdint>
namespace pg8 {
#define PG8_LAS __attribute__((address_space(3)))
typedef unsigned short bf16_t;
typedef short bf16x8 __attribute__((ext_vector_type(8)));
typedef float f32x4 __attribute__((ext_vector_type(4)));
typedef unsigned u32x4 __attribute__((ext_vector_type(4)));
constexpr int BM = 256, BK = 64, HALF = 128, HTB = HALF * BK * 2  , STAGE_BYTES = 8 * HTB, NXCD = 8, WGM = 8;

__host__ __device__ __forceinline__ int lds_byte(int r, int c) { const int st = (r >> 4) * 2 + (c >> 5), rr = r & 15, cc = c & 31, ob = rr * 64 + cc * 2; return st * 1024 + (ob ^ (((ob >> 9) & 1) << 5)); }
__host__ __device__ __forceinline__ void stage_rc(int b, int& R, int& C) { const int st = b / 1024, sb = b % 1024, swz = sb ^ (((sb >> 9) & 1) << 5); R = (st >> 1) * 16 + swz / 64; C = (st & 1) * 32 + (swz % 64) / 2; }
__host__ __device__ __forceinline__ int perm32(int rho) { const int n = rho >> 4, i = rho & 15; return 8 * (i >> 2) + 4 * n + (i & 3); }

struct Unit { int pm, pn; };
struct Gemm { const bf16_t* A; const bf16_t* Bt; int M, N, K; };

struct StaticOrder {
    int nM, nN, nwg, G, c;
    __host__ __device__ void init(int M, int N, int G_, int c_) { nM = M / BM; nN = N / BM; nwg = nM * nN; G = G_; c = c_; }
    __host__ __device__ bool next(int i, Unit& u) const {
        const long L = (long)i * G + c; if (L >= nwg) return false;
        int wgid = (int)L; { const int q = nwg / NXCD, r = nwg % NXCD, xcd = wgid % NXCD, off = wgid / NXCD; wgid = (xcd < r ? xcd * (q + 1) : r * (q + 1) + (xcd - r) * q) + off; }
        const int nig = WGM * nN, gid = wgid / nig, fm = gid * WGM, gsz = (nM - fm) < WGM ? (nM - fm) : WGM;
        u.pm = fm + ((wgid % nig) % gsz); u.pn = (wgid % nig) / gsz; return true;
    }
    __device__ __forceinline__ void a_ready(const Unit&) const {}
    __device__ __forceinline__ void done(const Unit&) const {}
};

typedef float f32x2_cv __attribute__((ext_vector_type(2))); typedef __bf16 bf16x2_cv __attribute__((ext_vector_type(2)));
__device__ __forceinline__ unsigned cvt_pk_bf16(float lo, float hi) { f32x2_cv v = {lo, hi}; bf16x2_cv b = __builtin_convertvector(v, bf16x2_cv); return __builtin_bit_cast(unsigned, b); }
constexpr float RMS_EPS = 1e-6f;
__device__ __forceinline__ float row_rs(const float* part, int row) {
    const f32x4* p = (const f32x4*)(part + (size_t)row * 16);
    const f32x4 a = p[0], b = p[1], c = p[2], d = p[3];
    const float s = ((a[0] + a[1]) + (a[2] + a[3])) + ((b[0] + b[1]) + (b[2] + b[3])) + ((c[0] + c[1]) + (c[2] + c[3])) + ((d[0] + d[1]) + (d[2] + d[3]));
    return __builtin_amdgcn_rsqf(s * (1.0f / 1024.0f) + RMS_EPS);
}
__device__ __forceinline__ float silu_mul(float g, float u) { return g * u * __builtin_amdgcn_rcpf(1.0f + __builtin_amdgcn_exp2f(-1.4426950408889634f * g)); }
struct EpiSwiglu {
    static constexpr bool PERM = true, AFTER_DRAIN = false;
    bf16_t* H; int ldh; const float* part;
    __device__ __forceinline__ void operator()(const f32x4 (&acc)[2][2][4][2], const Unit& u, int wr, int wc, int fr, int fq) const {
        const int row0 = u.pm * BM + wr * 64 + fr, col0 = u.pn * HALF + wc * 32 + 8 * fq;
#pragma unroll
        for (int ai = 0; ai < 2; ++ai)
#pragma unroll
            for (int m = 0; m < 4; ++m) { const int row = row0 + ai * HALF + m * 16; const float rs = row_rs(part, row);
                const f32x4 g0 = acc[ai][0][m][0] * rs, g1 = acc[ai][0][m][1] * rs, u0 = acc[ai][1][m][0] * rs, u1 = acc[ai][1][m][1] * rs;
                u32x4 w; w.x = cvt_pk_bf16(silu_mul(g0[0], u0[0]), silu_mul(g0[1], u0[1])); w.y = cvt_pk_bf16(silu_mul(g0[2], u0[2]), silu_mul(g0[3], u0[3]));
                w.z = cvt_pk_bf16(silu_mul(g1[0], u1[0]), silu_mul(g1[1], u1[1])); w.w = cvt_pk_bf16(silu_mul(g1[2], u1[2]), silu_mul(g1[3], u1[3]));
                *(u32x4*)(H + (size_t)row * ldh + col0) = w; }
    }
};
struct EpiScale {
    static constexpr bool PERM = true, AFTER_DRAIN = false;
    bf16_t* O; int ldc; const float* part;
    __device__ __forceinline__ void operator()(const f32x4 (&acc)[2][2][4][2], const Unit& u, int wr, int wc, int fr, int fq) const {
        const int row0 = u.pm * BM + wr * 64 + fr, col0 = u.pn * BM + wc * 32 + 8 * fq;
#pragma unroll
        for (int ai = 0; ai < 2; ++ai)
#pragma unroll
            for (int m = 0; m < 4; ++m) { const int row = row0 + ai * HALF + m * 16; const float rs = row_rs(part, row); bf16_t* rowp = O + (size_t)row * ldc + col0;
#pragma unroll
                for (int bj = 0; bj < 2; ++bj) { const f32x4 v0 = acc[ai][bj][m][0] * rs, v1 = acc[ai][bj][m][1] * rs;
                    u32x4 w; w.x = cvt_pk_bf16(v0[0], v0[1]); w.y = cvt_pk_bf16(v0[2], v0[3]); w.z = cvt_pk_bf16(v1[0], v1[1]); w.w = cvt_pk_bf16(v1[2], v1[3]);
                    *(u32x4*)(rowp + bj * HALF) = w; } }
    }
};
struct EpiResid {
    static constexpr bool PERM = true, AFTER_DRAIN = false;
    const float* base; float* out; bf16_t* xb; float* part_out; float coef;
    __device__ __forceinline__ void operator()(const f32x4 (&acc)[2][2][4][2], const Unit& u, int wr, int wc, int fr, int fq) const {
        const int row0 = u.pm * BM + wr * 64 + fr, col0 = u.pn * BM + wc * 32 + 8 * fq;
#pragma unroll
        for (int ai = 0; ai < 2; ++ai)
#pragma unroll
            for (int m = 0; m < 4; ++m) { const int row = row0 + ai * HALF + m * 16; const size_t off = (size_t)row * 1024 + col0; float ss = 0.f;
#pragma unroll
                for (int bj = 0; bj < 2; ++bj) { const f32x4 b0 = *(const f32x4*)(base + off + bj * HALF), b1 = *(const f32x4*)(base + off + bj * HALF + 4);
                    const f32x4 v0 = b0 + acc[ai][bj][m][0] * coef, v1 = b1 + acc[ai][bj][m][1] * coef;
                    *(f32x4*)(out + off + bj * HALF) = v0; *(f32x4*)(out + off + bj * HALF + 4) = v1;
                    u32x4 w; w.x = cvt_pk_bf16(v0[0], v0[1]); w.y = cvt_pk_bf16(v0[2], v0[3]); w.z = cvt_pk_bf16(v1[0], v1[1]); w.w = cvt_pk_bf16(v1[2], v1[3]);
                    *(u32x4*)(xb + off + bj * HALF) = w;
                    ss += (v0[0] * v0[0] + v0[1] * v0[1]) + (v0[2] * v0[2] + v0[3] * v0[3]) + (v1[0] * v1[0] + v1[1] * v1[1]) + (v1[2] * v1[2] + v1[3] * v1[3]); }
                ss += __shfl_xor(ss, 16); ss += __shfl_xor(ss, 32);
                if (fq == 0) part_out[(size_t)row * 16 + u.pn * 4 + wc] = ss; }
    }
};
template <class Epi, class Sched, bool ALIGN_EPI = false, bool SP2 = false>
__device__ __forceinline__ void gemm_phase(PG8_LAS unsigned char* lds, const Gemm g, const Sched& S, const Epi& E, int wave_id) {
    int lane_; asm volatile("v_mbcnt_lo_u32_b32 %0, -1, 0\n\tv_mbcnt_hi_u32_b32 %0, -1, %0" : "=v"(lane_));
    const int wid = wave_id, lane = lane_, tid = wid * 64 + lane, wr = wid >> 2, wc = wid & 3, fr = lane & 15, fq = lane >> 4;
    const int K = g.K, nt = K / BK;
    unsigned voffA[2], voffB[2];
#pragma unroll
    for (int i = 0; i < 2; ++i) { int R, C; stage_rc(tid * 16 + i * 8192, R, C); const int Rb = Epi::PERM ? ((R & ~31) + perm32(R & 31)) : R;
        voffA[i] = (unsigned)(R * K + C) * 2u; voffB[i] = (unsigned)(Rb * K + C) * 2u; }
    const size_t kstep = (size_t)(BK * 2);
    const size_t hstep = (size_t)HALF * K * 2;
    const size_t tstep = 2 * hstep;
    const unsigned ldsw = (unsigned)wid * 1024u;
    const int aoff = lds_byte(wr * 64 + fr, fq * 8), boff = lds_byte(wc * 32 + fr, fq * 8);
#define PG8_SA(b, h) (((b) * 2 + (h)) * HTB)
#define PG8_SB(b, h) ((4 + (b) * 2 + (h)) * HTB)
#define PG8_STAGE(bufoff, gbase, voff) do { _Pragma("unroll") for (int _i = 0; _i < 2; ++_i) \
        __builtin_amdgcn_global_load_lds((const unsigned*)((const char*)(gbase) + (voff)[_i]), (PG8_LAS unsigned*)(lds + (bufoff) + ldsw + _i * 8192), 16, 0, 0); } while (0)
#define PG8_LDA(dst, b, h) do { _Pragma("unroll") for (int m = 0; m < 4; ++m) _Pragma("unroll") for (int k = 0; k < 2; ++k) dst[m][k] = *(const PG8_LAS bf16x8*)(lds + PG8_SA(b, h) + aoff + m * 2048 + k * 1024); } while (0)
#define PG8_LDB(dst, b, h) do { _Pragma("unroll") for (int n = 0; n < 2; ++n) _Pragma("unroll") for (int k = 0; k < 2; ++k) dst[n][k] = *(const PG8_LAS bf16x8*)(lds + PG8_SB(b, h) + boff + n * 2048 + k * 1024); } while (0)
#define PG8_MMA(ai, bj, At, Bt) do { __builtin_amdgcn_s_setprio(1); _Pragma("unroll") for (int m = 0; m < 4; ++m) _Pragma("unroll") for (int n = 0; n < 2; ++n) _Pragma("unroll") for (int k = 0; k < 2; ++k) \
        acc[ai][bj][m][n] = __builtin_amdgcn_mfma_f32_16x16x32_bf16(Bt[n][k], At[m][k], acc[ai][bj][m][n], 0, 0, 0); __builtin_amdgcn_s_setprio(0); } while (0)
#define PG8_WAIT_V(n) asm volatile("s_waitcnt vmcnt(" #n ")" ::: "memory")
#define PG8_WAIT_L(n) asm volatile("s_waitcnt lgkmcnt(" #n ")" ::: "memory")
#define PG8_BAR __builtin_amdgcn_s_barrier()
#define PG8_SCHED __builtin_amdgcn_sched_barrier(0)
    Unit cur, nxt; int ui = 0;
    if (!S.next(0, cur)) return;
    f32x4 acc[2][2][4][2];
#pragma unroll
    for (int a = 0; a < 2; ++a)
#pragma unroll
        for (int b = 0; b < 2; ++b)
#pragma unroll
            for (int m = 0; m < 4; ++m)
#pragma unroll
                for (int n = 0; n < 2; ++n) acc[a][b][m][n] = (f32x4){0.f, 0.f, 0.f, 0.f};
    bf16x8 At[4][2], B0[2][2], B1[2][2];
    const char* cA = (const char*)g.A + (size_t)cur.pm * tstep; const char* cB = (const char*)g.Bt + (size_t)cur.pn * tstep;
    S.a_ready(cur);
    if constexpr (SP2) {
        PG8_STAGE(PG8_SB(0, 0), cB, voffB); PG8_STAGE(PG8_SB(0, 1), cB + hstep, voffB); PG8_STAGE(PG8_SA(0, 0), cA, voffA); PG8_STAGE(PG8_SA(0, 1), cA + hstep, voffA);
        if (wr == 1) PG8_BAR;
        PG8_WAIT_V(2); PG8_BAR;
        PG8_STAGE(PG8_SB(1, 0), cB + kstep, voffB); PG8_STAGE(PG8_SA(1, 0), cA + kstep, voffA); PG8_STAGE(PG8_SB(1, 1), cB + hstep + kstep, voffB);
        PG8_WAIT_V(6); PG8_BAR;
    } else {
        PG8_STAGE(PG8_SB(0, 0), cB, voffB); PG8_STAGE(PG8_SA(0, 0), cA, voffA); PG8_STAGE(PG8_SB(0, 1), cB + hstep, voffB); PG8_STAGE(PG8_SA(0, 1), cA + hstep, voffA);
        if (wr == 1) PG8_BAR;
        PG8_WAIT_V(4); PG8_BAR;
        PG8_STAGE(PG8_SB(1, 0), cB + kstep, voffB); PG8_STAGE(PG8_SA(1, 0), cA + kstep, voffA); PG8_STAGE(PG8_SB(1, 1), cB + hstep + kstep, voffB);
        PG8_WAIT_V(6); PG8_BAR;
    }
    for (;;) {
        const bool has_next = S.next(ui + 1, nxt);
        const char* nA = has_next ? (const char*)g.A + (size_t)nxt.pm * tstep : cA; const char* nB = has_next ? (const char*)g.Bt + (size_t)nxt.pn * tstep : cB;
        for (int t = 0; t < nt; t += 2) {
            const bool last = (t == nt - 2);
            const char* a1 = cA + (size_t)(t + 1) * kstep;
            const char* a2 = last ? nA : cA + (size_t)(t + 2) * kstep; const char* b2 = last ? nB : cB + (size_t)(t + 2) * kstep;
            const char* a3 = a2 + kstep; const char* b3 = b2 + kstep;
            if (last && has_next) S.a_ready(nxt);
            if constexpr (SP2) {
            PG8_LDB(B0, 0, 0); PG8_LDB(B1, 0, 1); PG8_SCHED; PG8_LDA(At, 0, 0); PG8_STAGE(PG8_SA(1, 1), a1 + hstep, voffA);
            PG8_WAIT_V(8); PG8_WAIT_L(0); PG8_BAR; PG8_MMA(0, 0, At, B0); PG8_MMA(0, 1, At, B1); PG8_BAR; PG8_SCHED;
            PG8_LDA(At, 0, 1); PG8_STAGE(PG8_SB(0, 0), b2, voffB); PG8_STAGE(PG8_SB(0, 1), b2 + hstep, voffB); PG8_STAGE(PG8_SA(0, 0), a2, voffA);
            PG8_WAIT_V(8); PG8_WAIT_L(0); PG8_BAR; PG8_MMA(1, 0, At, B0); PG8_MMA(1, 1, At, B1); PG8_BAR; PG8_SCHED;
            PG8_LDB(B0, 1, 0); PG8_LDB(B1, 1, 1); PG8_SCHED; PG8_LDA(At, 1, 0); PG8_STAGE(PG8_SA(0, 1), a2 + hstep, voffA);
            PG8_WAIT_V(8); PG8_WAIT_L(0); PG8_BAR; PG8_MMA(0, 0, At, B0); PG8_MMA(0, 1, At, B1); PG8_BAR; PG8_SCHED;
            PG8_LDA(At, 1, 1); PG8_STAGE(PG8_SB(1, 0), b3, voffB); PG8_STAGE(PG8_SB(1, 1), b3 + hstep, voffB); PG8_STAGE(PG8_SA(1, 0), a3, voffA);
            PG8_WAIT_V(8); PG8_WAIT_L(0); PG8_BAR; PG8_MMA(1, 0, At, B0); PG8_MMA(1, 1, At, B1); PG8_BAR; PG8_SCHED;
            } else {
            PG8_LDB(B0, 0, 0); PG8_SCHED; PG8_LDA(At, 0, 0); PG8_STAGE(PG8_SA(1, 1), a1 + hstep, voffA);
            PG8_WAIT_L(8); PG8_BAR; PG8_WAIT_L(0); PG8_MMA(0, 0, At, B0); PG8_BAR; PG8_SCHED;
            PG8_LDB(B1, 0, 1); PG8_STAGE(PG8_SB(0, 0), b2, voffB);
            PG8_BAR; PG8_WAIT_L(0); PG8_MMA(0, 1, At, B1); PG8_BAR;
            PG8_LDA(At, 0, 1); PG8_STAGE(PG8_SA(0, 0), a2, voffA);
            PG8_BAR; PG8_WAIT_L(0); PG8_MMA(1, 0, At, B0); PG8_BAR; PG8_SCHED;
            PG8_STAGE(PG8_SB(0, 1), b2 + hstep, voffB);
            PG8_WAIT_V(6); PG8_BAR; PG8_MMA(1, 1, At, B1); PG8_BAR;
            PG8_LDB(B0, 1, 0); PG8_SCHED; PG8_LDA(At, 1, 0); PG8_STAGE(PG8_SA(0, 1), a2 + hstep, voffA);
            PG8_WAIT_L(8); PG8_BAR; PG8_WAIT_L(0); PG8_MMA(0, 0, At, B0); PG8_BAR; PG8_SCHED;
            PG8_LDB(B1, 1, 1); PG8_STAGE(PG8_SB(1, 0), b3, voffB);
            PG8_BAR; PG8_WAIT_L(0); PG8_MMA(0, 1, At, B1); PG8_BAR;
            PG8_LDA(At, 1, 1); PG8_STAGE(PG8_SA(1, 0), a3, voffA);
            PG8_BAR; PG8_WAIT_L(0); PG8_MMA(1, 0, At, B0); PG8_BAR; PG8_SCHED;
            PG8_STAGE(PG8_SB(1, 1), b3 + hstep, voffB);
            PG8_WAIT_V(6); PG8_BAR; PG8_MMA(1, 1, At, B1); PG8_BAR;
            }
        }
        if constexpr (ALIGN_EPI) { if (wr == 0) PG8_BAR; }
        if constexpr (!Epi::AFTER_DRAIN) { E(acc, cur, wr, wc, fr, fq); S.done(cur); }
        if (!has_next) break;
#pragma unroll
        for (int a = 0; a < 2; ++a)
#pragma unroll
            for (int b = 0; b < 2; ++b)
#pragma unroll
                for (int m = 0; m < 4; ++m)
#pragma unroll
                    for (int n = 0; n < 2; ++n) acc[a][b][m][n] = (f32x4){0.f, 0.f, 0.f, 0.f};
        cur = nxt; cA = nA; cB = nB; ++ui;
        if constexpr (ALIGN_EPI) { if (wr == 1) PG8_BAR; }
    }
    PG8_WAIT_V(0);
    if constexpr (!ALIGN_EPI) { if (wr == 0) PG8_BAR; }
    PG8_BAR;
    if constexpr (Epi::AFTER_DRAIN) { E.fused(acc, cur, wr, wc, fr, fq, lds, wid, lane); S.done(cur); }
#undef PG8_SA
#undef PG8_SB
#undef PG8_STAGE
#undef PG8_LDA
#undef PG8_LDB
#undef PG8_MMA
#undef PG8_WAIT_V
#undef PG8_WAIT_L
#undef PG8_BAR
#undef PG8_SCHED
}
}
#define LAS __attribute__((address_space(3)))
#define XB_TMO      128
#define XB_XCNT(j)  (256  + 64 * (j))
#define XB_XSUB(j)  (1280 + 64 * (j))
#define XB_XGEN(j)  (2304 + 64 * (j))
#define XB_TOP      3328
#define XB_TOPGEN   3392
#define XCD_BAR_WORDS 3456
#define XB_SPIN_CAP (1u << 18)

__device__ __forceinline__ unsigned xb_ld(unsigned* p)              { return __hip_atomic_load(p, __ATOMIC_RELAXED, __HIP_MEMORY_SCOPE_AGENT); }
__device__ __forceinline__ unsigned xb_add(unsigned* p, unsigned v) { return __hip_atomic_fetch_add(p, v, __ATOMIC_RELAXED, __HIP_MEMORY_SCOPE_AGENT); }
__device__ __forceinline__ unsigned xb_xcc_id() { return (unsigned)__builtin_amdgcn_s_getreg((3 << 11) | 20) & 0xFu; }
#define XB_SPIN(cond, bar) do { unsigned _sp = 0; while (cond) { __builtin_amdgcn_s_sleep(1); \
    if ((++_sp & 255u) == 0u) { if (xb_ld(&(bar)[XB_TMO])) break; if (_sp > XB_SPIN_CAP) { atomicAdd(&(bar)[XB_TMO], 1u); break; } } } } while (0)

struct XcdBarrier {
    unsigned* bar; unsigned x;
    volatile LAS unsigned* st;
};

__device__ __forceinline__ XcdBarrier xcd_barrier_post(unsigned* bar, volatile LAS unsigned* st) {
    XcdBarrier b; b.bar = bar; b.x = xb_xcc_id(); b.st = st;
    if (threadIdx.x == 0) (void)xb_add(&bar[XB_XCNT(b.x)], 1u);
    return b;
}
__device__ __forceinline__ void xcd_barrier_complete(unsigned* bar, unsigned x, unsigned& nloc, unsigned& nx) {
    const unsigned G = gridDim.x * gridDim.y * gridDim.z;
    unsigned sum, cnt, mine, sp = 0u;
    for (;;) {
        sum = 0u; cnt = 0u; mine = 0u;
#pragma unroll
        for (unsigned j = 0; j < 16; ++j) { const unsigned c = xb_ld(&bar[XB_XCNT(j)]); sum += c; cnt += (c > 0u) ? 1u : 0u; mine = (j == x) ? c : mine; }
        if (sum == G) break;
        __builtin_amdgcn_s_sleep(1);
        if ((++sp & 255u) == 0u) { if (xb_ld(&bar[XB_TMO])) break; if (sp > XB_SPIN_CAP) { atomicAdd(&bar[XB_TMO], 1u); break; } }
    }
    nloc = mine > 0u ? mine : 1u; nx = cnt > 0u ? cnt : 1u;
}

__device__ __forceinline__ void xcd_barrier(const XcdBarrier& b) {
    asm volatile("s_waitcnt vmcnt(0)" ::: "memory");
    __syncthreads();
    if (threadIdx.x == 0) {
        unsigned* bar = b.bar;
        __builtin_amdgcn_s_waitcnt(0);
        unsigned nloc = b.st[0], nx = b.st[1];
        if (nloc == 0u) { xcd_barrier_complete(bar, b.x, nloc, nx); b.st[0] = nloc; b.st[1] = nx; }
        const unsigned old = xb_add(&bar[XB_XSUB(b.x)], 1u);
        const unsigned gen = old / nloc;
        if (old + 1u == (gen + 1u) * nloc) {
            __builtin_amdgcn_fence(__ATOMIC_RELEASE, "agent");
            asm volatile("s_waitcnt vmcnt(0)" ::: "memory");
            const unsigned og = xb_add(&bar[XB_TOP], 1u);
            const unsigned tg = og / nx;
            if (og + 1u == (tg + 1u) * nx) xb_add(&bar[XB_TOPGEN], 1u);
            else XB_SPIN(xb_ld(&bar[XB_TOPGEN]) == tg, bar);
            __builtin_amdgcn_fence(__ATOMIC_ACQUIRE, "agent");
            xb_add(&bar[XB_XGEN(b.x)], 1u);
            asm volatile("s_waitcnt vmcnt(0)" ::: "memory");
        } else {
            XB_SPIN(xb_ld(&bar[XB_XGEN(b.x)]) == gen, bar);
            __builtin_amdgcn_fence(__ATOMIC_ACQUIRE, "agent");
            asm volatile("s_waitcnt vmcnt(0)" ::: "memory");
        }
    }
    __syncthreads();
}
#undef LAS
#ifndef RET_MODE
#define RET_MODE 1
#endif
#ifndef NSA_INLINE
#define NSA_INLINE __forceinline__
#endif
#ifndef PROBE_DUP
#define PROBE_DUP 0
#endif
#ifndef DBG_BRUTE
#define DBG_BRUTE 0
#endif
#ifndef DBG_ZERO
#define DBG_ZERO 0
#endif
constexpr int NWAVES = 8;
constexpr int NB = 16, SEQ = 2048, DM = 1024, MTOK = NB * SEQ, FF = 2816, NMEMT = 256, MMEM = NB * NMEMT, DEPTH = 4;
constexpr float EPS = 1e-6f;
constexpr float QSCALE = 0.125f * 1.4426950408889634f;
constexpr int RET_LD = 2560, RET_Q = 0, RET_K = 384, RET_V = 768, RET_G = 1536, RET_QM = 2304;
constexpr int DSA_LD = 1792, DSA_Q = 0, DSA_K = 768, DSA_V = 832, DSA_IQ = 896, DSA_IK = 1408, DSA_IW = 1472, DSA_QM = 1480, DSA_COLS = 1736;
constexpr int NSA_LD = 2816, NSA_Q = 0, NSA_KC = 768, NSA_VC = 1024, NSA_KS = 1280, NSA_VS = 1536, NSA_KW = 1792, NSA_VW = 2048, NSA_QM = 2304, NSA_GT = 2560;
constexpr int NSA_SRC_GT = 2304, NSA_SRC_QM = 2340, NSA_COLS = 2596;

constexpr size_t MiB = 1u << 20;
constexpr size_t WS_CTL = 0, CTL_ZERO_BYTES = 1 * MiB;
constexpr size_t WS_PART = 1 * MiB;
constexpr size_t WS_PARTM = 3 * MiB;
constexpr size_t WS_ROPE = 3 * MiB + 512 * 1024;
constexpr size_t WS_MISC = 4 * MiB;
constexpr size_t WS_CMPW = 4 * MiB + 64 * 1024;
constexpr size_t WS_KCMP = 5 * MiB;
constexpr size_t WS_VCMPT = 6 * MiB;
constexpr size_t WS_MK = 7 * MiB;
constexpr size_t WS_MVT = 15 * MiB;
constexpr size_t WS_MEMB = 23 * MiB;
constexpr size_t WS_MKV = 31 * MiB;
constexpr size_t WS_WKV = 47 * MiB;
constexpr size_t WS_WBUF0 = 51 * MiB, WBUF_BYTES = 41 * MiB;
constexpr size_t WS_XB = 133 * MiB;
constexpr size_t WS_Y = 197 * MiB;
constexpr size_t WS_HID = 261 * MiB;
constexpr size_t WS_SC = 373 * MiB;
constexpr size_t WS_MB = 501 * MiB;
constexpr size_t WS_END = 509 * MiB;
static_assert(WS_HID + (size_t)MTOK * FF * 2 <= WS_MB && WS_SC + (size_t)MTOK * SEQ * 2 <= WS_MB && WS_WBUF0 + 2 * WBUF_BYTES <= WS_XB, "d_ws map");
constexpr size_t WB_W1A = 0, WB_W2A = WB_W1A + (size_t)2 * FF * DM, WB_W1B = WB_W2A + (size_t)DM * FF, WB_W2B = WB_W1B + (size_t)2 * FF * DM,
                 WB_WIN = WB_W2B + (size_t)DM * FF, WB_WO = WB_WIN + (size_t)NSA_LD * DM, WB_END = WB_WO + (size_t)DM * DM;
static_assert(WB_END * 2 <= WBUF_BYTES, "weight buffer");
constexpr int CW_BAR = 4096;
constexpr int CW_CK = 32768;
constexpr int CW_Q = 16384;

#define GAS __attribute__((address_space(1)))
#define LAS __attribute__((address_space(3)))
typedef unsigned short bf16;
typedef unsigned v4u __attribute__((ext_vector_type(4)));
typedef unsigned v2u __attribute__((ext_vector_type(2)));
typedef float f32x4 __attribute__((ext_vector_type(4)));
typedef float f32x16 __attribute__((ext_vector_type(16)));
typedef short bf16x8 __attribute__((ext_vector_type(8)));
typedef GAS unsigned gu32;
#define RLX_AGENT __ATOMIC_RELAXED, __HIP_MEMORY_SCOPE_AGENT
#define LDS_WAIT() asm volatile("s_waitcnt lgkmcnt(0)" ::: "memory")
#define VM_WAIT() asm volatile("s_waitcnt vmcnt(0)" ::: "memory")
__device__ __forceinline__ unsigned f2bf(float f) { unsigned u = __builtin_bit_cast(unsigned, f); return (u + 0x7fffu + ((u >> 16) & 1u)) >> 16; }
__device__ __forceinline__ unsigned pk2(float lo, float hi) { return pg8::cvt_pk_bf16(lo, hi); }
__device__ __forceinline__ float bf2f(unsigned h) { return __builtin_bit_cast(float, h << 16); }
__device__ __forceinline__ float bflo(unsigned w) { return __builtin_bit_cast(float, w << 16); }
__device__ __forceinline__ float bfhi(unsigned w) { return __builtin_bit_cast(float, w & 0xffff0000u); }
struct Args { const float* in[23]; float* out; unsigned char* ws; int ph_lo, ph_hi; };
typedef const __attribute__((address_space(4))) Args* KArgs;
struct Frame {
    LAS unsigned char* lds;
    volatile LAS unsigned* MISC;
    gu32* ctl;
    int tid, lane, wave, G, gw, NGW;
    unsigned char* ws;
    KArgs ka;
    float* out;
};
__device__ __forceinline__ float wave_sum(float v) {
#pragma unroll
    for (int o = 1; o < 64; o <<= 1) v += __shfl_xor(v, o);
    return v;
}
__device__ __forceinline__ float wave_max(float v) {
#pragma unroll
    for (int o = 1; o < 64; o <<= 1) v = fmaxf(v, __shfl_xor(v, o));
    return v;
}
__device__ __forceinline__ int grab(gu32* ctr, int lane) { unsigned v = 0; if (lane == 0) v = __hip_atomic_fetch_add(ctr, 1u, RLX_AGENT); return __builtin_amdgcn_readfirstlane((int)v); }

__device__ __forceinline__ void cvt_item(const float* W, int ldw, const float* gain, bf16* WT, int K, LAS float* scr, int k0, int src_col0, int nvalid, int dst_row0, int lane) {
    const int c = lane & 31;
#pragma unroll 8
    for (int i = 0; i < 32; ++i) { const int kk = 2 * i + (lane >> 5); float v = 0.f;
        if (c < nvalid) { v = W[(size_t)(k0 + kk) * ldw + src_col0 + c]; if (gain) v *= gain[k0 + kk]; }
        scr[kk * 33 + c] = v; }
    LDS_WAIT(); asm volatile("" ::: "memory");
    const int c8 = lane & 7;
#pragma unroll
    for (int j = 0; j < 4; ++j) { const int n = (lane >> 3) + 8 * j; const LAS float* s = scr + (8 * c8) * 33 + n;
        v4u o; o.x = pk2(s[0 * 33], s[1 * 33]); o.y = pk2(s[2 * 33], s[3 * 33]); o.z = pk2(s[4 * 33], s[5 * 33]); o.w = pk2(s[6 * 33], s[7 * 33]);
        *(GAS v4u*)(WT + (size_t)(dst_row0 + n) * K + k0 + 8 * c8) = o; }
    LDS_WAIT(); asm volatile("" ::: "memory");
}
__device__ __forceinline__ void cvt_matrix(Frame& F, int& it_base, const float* W, const float* W2, int ldw, int ncols, const float* gain, bf16* WT, int K, int nrows_dst, int kind) {
    LAS float* scr = (LAS float*)(F.lds + F.wave * 16384);
    const int nkb = K / 64, njb = nrows_dst / 32, nitems = nkb * njb;
    int first = (F.gw - it_base % F.NGW + F.NGW) % F.NGW;
    for (int i = first; i < nitems; i += F.NGW) {
        const int kb = i / njb, jb = i % njb; const float* src = W; int sc0 = jb * 32, nv = 32;
        if (kind == 0) { nv = ncols - sc0; nv = nv < 0 ? 0 : (nv > 32 ? 32 : nv); }
        else if (kind == 1) { const int c = jb * 32, pn = c >> 8, bj = (c >> 7) & 1, j = c & 127; src = bj ? W2 : W; sc0 = pn * 128 + j; }
        else { const int c = jb * 32;
            if (c < NSA_QM) { sc0 = c; }
            else if (c < NSA_GT) { sc0 = NSA_SRC_QM + (c - NSA_QM); }
            else { sc0 = NSA_SRC_GT + (c - NSA_GT); nv = NSA_SRC_QM - sc0; nv = nv < 0 ? 0 : (nv > 32 ? 32 : nv); } }
        cvt_item(src, ldw, gain, WT, K, scr, kb * 64, sc0, nv, jb * 32, F.lane);
    }
    it_base += nitems;
}
__device__ __forceinline__ void convert_layer(Frame& F, int Ly) {
    bf16* WB = (bf16*)(F.ws + WS_WBUF0 + (size_t)(Ly & 1) * WBUF_BYTES);
    const float* fnorm = F.ka->in[2]; const float* wg = F.ka->in[3]; const float* wu = F.ka->in[4]; const float* wd = F.ka->in[5];
    int itb = 0;
#pragma unroll 1
    for (int hf = 0; hf < 2; ++hf) {
        const size_t o1 = (size_t)(Ly * 2 + hf) * DM * FF;
        cvt_matrix(F, itb, wg + o1, wu + o1, FF, FF, fnorm + (size_t)(Ly * 2 + hf) * DM, WB + (hf ? WB_W1B : WB_W1A), DM, 2 * FF, 1);
        cvt_matrix(F, itb, wd + o1, nullptr, DM, DM, nullptr, WB + (hf ? WB_W2B : WB_W2A), FF, DM, 0);
    }
    const float* mnorm = F.ka->in[6] + (size_t)Ly * DM;
    const int kind = Ly % 3, j = Ly / 3;
    if (kind == 0) cvt_matrix(F, itb, F.ka->in[12] + (size_t)j * DM * RET_LD, nullptr, RET_LD, RET_LD, mnorm, WB + WB_WIN, DM, RET_LD, 0);
    else if (kind == 1) cvt_matrix(F, itb, F.ka->in[13] + (size_t)j * DM * DSA_COLS, nullptr, DSA_COLS, DSA_COLS, mnorm, WB + WB_WIN, DM, DSA_LD, 0);
    else cvt_matrix(F, itb, F.ka->in[16] + (size_t)j * DM * NSA_COLS, nullptr, NSA_COLS, NSA_COLS, mnorm, WB + WB_WIN, DM, NSA_LD, 2);
    cvt_matrix(F, itb, F.ka->in[7] + (size_t)Ly * DM * DM, nullptr, DM, DM, nullptr, WB + WB_WO, DM, DM, 0);
}

__device__ __forceinline__ void xform(Frame& F, const bf16* src, int spitch, int scol0, int nheads, int rows, int Lr, bf16* dst, int dmode, int dpitch, int dcol0,
                                      const float* gain, bool rope, float cscale, int decay  ) {
    const float* tab = (const float*)(F.ws + WS_ROPE);
    const int i8 = F.lane & 7, sub = F.lane >> 3; const int items = rows * nheads;
    float gn[8];
#pragma unroll
    for (int j = 0; j < 8; ++j) gn[j] = gain ? gain[8 * i8 + j] : 1.f;
    constexpr int U = 4;
    for (int it0 = F.gw * (8 * U); it0 < items; it0 += F.NGW * (8 * U)) {
        v4u raw[U]; f32x4 c0[U], c1[U], s0[U], s1[U];
#pragma unroll
        for (int u = 0; u < U; ++u) { const int it = it0 + 8 * u + sub; const int row = it / nheads, h = it % nheads, t = row % Lr;
            raw[u] = *(const GAS v4u*)(src + (size_t)row * spitch + scol0 + h * 64 + 8 * i8);
            if (rope) { const float* tr = tab + (size_t)t * 64 + 8 * (i8 & 3);
                c0[u] = *(const GAS f32x4*)(tr); c1[u] = *(const GAS f32x4*)(tr + 4); s0[u] = *(const GAS f32x4*)(tr + 32); s1[u] = *(const GAS f32x4*)(tr + 36); } }
#pragma unroll
        for (int u = 0; u < U; ++u) { const int it = it0 + 8 * u + sub; const int row = it / nheads, h = it % nheads, t = row % Lr;
            float v[8] = {bflo(raw[u].x), bfhi(raw[u].x), bflo(raw[u].y), bfhi(raw[u].y), bflo(raw[u].z), bfhi(raw[u].z), bflo(raw[u].w), bfhi(raw[u].w)};
            if (gain) { float ss = 0.f;
#pragma unroll
                for (int j = 0; j < 8; ++j) ss += v[j] * v[j];
                ss += __shfl_xor(ss, 1); ss += __shfl_xor(ss, 2); ss += __shfl_xor(ss, 4);
                const float r = __builtin_amdgcn_rsqf(ss * (1.f / 64.f) + EPS);
#pragma unroll
                for (int j = 0; j < 8; ++j) v[j] = v[j] * r * gn[j]; }
            if (rope) {
                const float cs[8] = {c0[u][0], c0[u][1], c0[u][2], c0[u][3], c1[u][0], c1[u][1], c1[u][2], c1[u][3]}, sn[8] = {s0[u][0], s0[u][1], s0[u][2], s0[u][3], s1[u][0], s1[u][1], s1[u][2], s1[u][3]};
#pragma unroll
                for (int j = 0; j < 8; ++j) { const float p = __shfl_xor(v[j], 4); v[j] = (i8 < 4) ? (v[j] * cs[j] - p * sn[j]) : (v[j] * cs[j] + p * sn[j]); } }
            float f = cscale;
            if (decay) { const float lg = __builtin_amdgcn_logf(1.0f - __builtin_amdgcn_exp2f(-5.0f - (float)h)); f *= __builtin_amdgcn_exp2f((float)(decay * t) * lg); }
            v4u o; o.x = pk2(v[0] * f, v[1] * f); o.y = pk2(v[2] * f, v[3] * f); o.z = pk2(v[4] * f, v[5] * f); o.w = pk2(v[6] * f, v[7] * f);
            bf16* dp = dmode == 0 ? dst + (size_t)row * dpitch + dcol0 + h * 64 + 8 * i8 : dst + ((size_t)((row / Lr) * nheads + h) * Lr + t) * 64 + 8 * i8;
            *(GAS v4u*)dp = o; }
    }
}
__device__ __forceinline__ void transpose_cols(Frame& F, const bf16* src, int spitch, int scol0, int ncols, int nb, int Lr, bf16* dst) {
    LAS bf16* scr = (LAS bf16*)(F.lds + F.wave * 16384);
    const int ntt = Lr / 64, nct = ncols / 64, ntiles = nb * ntt * nct; const int i8 = F.lane & 7, sub = F.lane >> 3;
    for (int tl = F.gw; tl < ntiles; tl += F.NGW) {
        const int ct = tl % nct, tt = (tl / nct) % ntt, b = tl / (nct * ntt); const int t0 = tt * 64, c0 = ct * 64;
#pragma unroll
        for (int k = 0; k < 8; ++k) { const int r = sub + 8 * k;
            const v4u raw = *(const GAS v4u*)(src + (size_t)(b * Lr + t0 + r) * spitch + scol0 + c0 + 8 * i8);
            *(LAS v4u*)(scr + r * 72 + 8 * i8) = raw; }
        LDS_WAIT(); asm volatile("" ::: "memory");
        bf16* drow = dst + ((size_t)b * ncols + c0 + F.lane) * Lr + t0;
#pragma unroll
        for (int k = 0; k < 8; ++k) { unsigned w[4];
#pragma unroll
            for (int q = 0; q < 4; ++q) { const unsigned lo = scr[(8 * k + 2 * q) * 72 + F.lane], hi = scr[(8 * k + 2 * q + 1) * 72 + F.lane]; w[q] = lo | (hi << 16); }
            v4u o; o.x = w[0]; o.y = w[1]; o.z = w[2]; o.w = w[3]; *(GAS v4u*)(drow + 8 * k) = o; }
        LDS_WAIT(); asm volatile("" ::: "memory");
    }
}
__device__ __forceinline__ void row_to_bf16(Frame& F, const float* xrow, bf16* orow, float* part) {
    const GAS f32x4* xr = (const GAS f32x4*)xrow + F.lane;
    f32x4 v[4]; float s = 0.f;
#pragma unroll
    for (int j = 0; j < 4; ++j) { v[j] = xr[64 * j]; s += (v[j].x * v[j].x + v[j].y * v[j].y) + (v[j].z * v[j].z + v[j].w * v[j].w); }
    s = wave_sum(s);
    GAS v2u* o8 = (GAS v2u*)orow + F.lane;
#pragma unroll
    for (int j = 0; j < 4; ++j) { v2u o; o.x = pk2(v[j].x, v[j].y); o.y = pk2(v[j].z, v[j].w); o8[64 * j] = o; }
    if (F.lane < 16) part[F.lane] = F.lane == 0 ? s : 0.f;
}
enum { MK_NONE = 0, MK_CAUSAL = 1, MK_WIN = 2, MK_BITS = 3, MK_SLC = 4, MK_CMP = 5 };
struct KVp { const bf16* K; int kpitch; const bf16* VT; int vpitch; };
struct MaskArg { int q0[3]; const unsigned* mb; unsigned sel; int nmax; float lg; };
__device__ __forceinline__ bf16x8 ld8(const bf16* p) { return *(const GAS bf16x8*)p; }
__device__ __forceinline__ float fast_exp2(float x) { return __builtin_amdgcn_exp2f(x); }

template <int NS, int NT, int MODE, int MT, int PF = 2>
__device__ __forceinline__ void attn_core(const LAS bf16x8* ql, const KVp kv, int kt0, int kt1, float negb, const MaskArg& ma, const unsigned* const (&mbrow)[NS],
                                          f32x16 (&O)[NS][NT], float (&lsum)[NS], int lane) {
    const int r32 = lane & 31, hi = lane >> 5;
    const int kperm = (r32 & 0x13) | ((r32 & 4) << 1) | ((r32 & 8) >> 1);
    const bf16* kp = kv.K + (size_t)kperm * kv.kpitch + 8 * hi;
    const bf16* vp = kv.VT + (size_t)r32 * kv.vpitch + 8 * hi;
    bf16x8 kf[4], vf[2][NT], kfn[4], vfn[2][NT];
#define AC_LOADK(dst, kt_) do { const bf16* kq_ = kp + (size_t)(32 * (kt_)) * kv.kpitch; _Pragma("unroll") for (int ks = 0; ks < 4; ++ks) dst[ks] = ld8(kq_ + 16 * ks); } while (0)
#define AC_LOADV(dst, kt_) do { _Pragma("unroll") for (int nt = 0; nt < NT; ++nt) { const bf16* vq_ = vp + (size_t)(32 * nt) * kv.vpitch + 32 * (kt_); dst[0][nt] = ld8(vq_); dst[1][nt] = ld8(vq_ + 16); } } while (0)
    if (kt0 < kt1) { if (PF >= 1) AC_LOADK(kf, kt0); if (PF >= 2) AC_LOADV(vf, kt0); }
#pragma unroll 1
    for (int kt = kt0; kt < kt1; ++kt) {
        unsigned selbit = 1u; bool active = true;
        if (MT == MK_SLC) { selbit = (ma.sel >> (kt >> 1)) & 1u; active = __any(selbit != 0u); }
        const int ktn = (kt + 1 < kt1) ? kt + 1 : kt;
        if (PF == 0) { if (active) { AC_LOADK(kf, kt); AC_LOADV(vf, kt); } }
        else { AC_LOADK(kfn, ktn); if (PF >= 2) AC_LOADV(vfn, ktn); else if (active) AC_LOADV(vf, kt); }
        if (active) {
        const LAS bf16x8* qlp = ql; asm volatile("" : "+v"(qlp));
#pragma unroll
        for (int s = 0; s < NS; ++s) {
            f32x16 acc;
#pragma unroll
            for (int r = 0; r < 16; ++r) acc[r] = 0.f;
#pragma unroll
            for (int ks = 0; ks < 4; ++ks) acc = __builtin_amdgcn_mfma_f32_32x32x16_bf16(kf[ks], qlp[(s * 4 + ks) * 64], acc, 0, 0, 0);
            const int tq = ma.q0[s] + r32, kb = 32 * kt + 8 * hi;
            bool full = true;
            if (MT == MK_CAUSAL) full = (32 * kt + 31 <= ma.q0[s]);
            if (MT == MK_WIN) full = (32 * kt + 31 <= ma.q0[s]) && (32 * kt >= ma.q0[s] + 31 - 511);
            if (MT == MK_SLC) full = (32 * kt + 31 <= ma.q0[s]) && __all(selbit != 0u);
            if (MT == MK_BITS || MT == MK_CMP) full = false;
            float p[16];
            if (full) {
#pragma unroll
                for (int r = 0; r < 16; ++r) { const int key = kb + 16 * (r >> 3) + (r & 7); p[r] = MODE == 0 ? fast_exp2(acc[r]) : (MODE == 1 ? acc[r] : acc[r] * fast_exp2((float)(tq - key) * ma.lg)); }
            } else {
                unsigned w = 0;
                if (MT == MK_BITS) w = mbrow[s][kt];
#pragma unroll
                for (int r = 0; r < 16; ++r) { const int key = kb + 16 * (r >> 3) + (r & 7); bool v = true;
                    if (MT == MK_CAUSAL) v = key <= tq;
                    if (MT == MK_WIN) v = (key <= tq) && (key >= tq - 511);
                    if (MT == MK_SLC) v = (key <= tq) && (selbit != 0u);
                    if (MT == MK_BITS) v = (w >> (8 * hi + 16 * (r >> 3) + (r & 7))) & 1u;
                    if (MT == MK_CMP) v = key <= ma.nmax;
                    const float e = MODE == 0 ? fast_exp2(acc[r]) : (MODE == 1 ? acc[r] : acc[r] * fast_exp2((float)((tq - key) < 0 ? 0 : (tq - key)) * ma.lg));
                    p[r] = v ? e : 0.f; }
            }
            if (MODE == 0) { float a = 0.f;
#pragma unroll
                for (int r = 0; r < 16; ++r) a += p[r];
                lsum[s] += a; }
            bf16x8 pk0, pk1;
            { v4u t0, t1; t0.x = pk2(p[0], p[1]); t0.y = pk2(p[2], p[3]); t0.z = pk2(p[4], p[5]); t0.w = pk2(p[6], p[7]);
              t1.x = pk2(p[8], p[9]); t1.y = pk2(p[10], p[11]); t1.z = pk2(p[12], p[13]); t1.w = pk2(p[14], p[15]);
              pk0 = __builtin_bit_cast(bf16x8, t0); pk1 = __builtin_bit_cast(bf16x8, t1); }
#pragma unroll
            for (int nt = 0; nt < NT; ++nt) { O[s][nt] = __builtin_amdgcn_mfma_f32_32x32x16_bf16(pk0, vf[0][nt], O[s][nt], 0, 0, 0);
                                              O[s][nt] = __builtin_amdgcn_mfma_f32_32x32x16_bf16(pk1, vf[1][nt], O[s][nt], 0, 0, 0); }
            if (NS >= 3) __builtin_amdgcn_sched_barrier(0);
        }
        }
        if (PF >= 1) {
#pragma unroll
            for (int ks = 0; ks < 4; ++ks) kf[ks] = kfn[ks];
            if (PF >= 2) {
#pragma unroll
                for (int nt = 0; nt < NT; ++nt) { vf[0][nt] = vfn[0][nt]; vf[1][nt] = vfn[1][nt]; } }
        }
    }
#undef AC_LOADK
#undef AC_LOADV
}
__device__ __forceinline__ int crow(int r, int hi) { return (r & 3) + 8 * (r >> 2) + 4 * hi; }
template <int NT, bool ADD>
__device__ __forceinline__ void store_o(const f32x16 (&O)[NT], float f, bf16* Y, int row0, int col0, int lane) {
    const int r32 = lane & 31, hi = lane >> 5;
    unsigned ybase = (unsigned)((row0 + 4 * hi) * 1024 + col0 + r32); asm volatile("" : "+v"(ybase));
#pragma unroll
    for (int rh = 0; rh < 2; ++rh) {
        unsigned short old[NT][8];
        if (ADD) {
#pragma unroll
            for (int ri = 0; ri < 8; ++ri)
#pragma unroll
                for (int nt = 0; nt < NT; ++nt) { const int r = 8 * rh + ri; old[nt][ri] = Y[ybase + (unsigned)(((r & 3) + 8 * (r >> 2)) * 1024) + 32 * nt]; }
        }
#pragma unroll
        for (int ri = 0; ri < 8; ++ri) { const int r = 8 * rh + ri; const int q = crow(r, hi); const float fr = __shfl(f, q);
            const unsigned yo = ybase + (unsigned)(((r & 3) + 8 * (r >> 2)) * 1024);
#pragma unroll
            for (int nt = 0; nt < NT; ++nt) { float v = O[nt][r] * fr; if (ADD) v += bf2f(old[nt][ri]); Y[yo + 32 * nt] = (bf16)f2bf(v); } }
    }
}
template <int NS> __device__ __forceinline__ void stage_q(LAS bf16x8* ql, const bf16* const (&qrow)[NS], int lane) {
    const int hi = lane >> 5;
#pragma unroll
    for (int s = 0; s < NS; ++s)
#pragma unroll
        for (int ks = 0; ks < 4; ++ks) ql[(s * 4 + ks) * 64] = ld8(qrow[s] + 16 * ks + 8 * hi);
    LDS_WAIT(); asm volatile("" ::: "memory");
}
__device__ __forceinline__ LAS bf16x8* wave_q(Frame& F) { return (LAS bf16x8*)(F.lds + F.wave * 16384) + F.lane; }
template <int NS, int NT> __device__ __forceinline__ void zero_o(f32x16 (&O)[NS][NT], float (&l)[NS]) {
#pragma unroll
    for (int s = 0; s < NS; ++s) { l[s] = 0.f;
#pragma unroll
        for (int nt = 0; nt < NT; ++nt)
#pragma unroll
            for (int r = 0; r < 16; ++r) O[s][nt][r] = 0.f; }
}

__device__ __forceinline__ void mem_task(Frame& F, int task, int Ly, const bf16* PROJ, int ldp, int qmcol) {
    const int qb = task & 31, h = (task >> 5) & 3, b = task >> 7; const int r32 = F.lane & 31;
    const int row0 = b * SEQ + 64 * qb;
    const bf16* qrow[2] = {PROJ + (size_t)(row0 + r32) * ldp + qmcol + h * 64, PROJ + (size_t)(row0 + 32 + r32) * ldp + qmcol + h * 64};
    LAS bf16x8* ql = wave_q(F); stage_q<2>(ql, qrow, F.lane);
    KVp kv{(const bf16*)(F.ws + WS_MK) + ((size_t)((Ly * NB + b) * 4 + h) * NMEMT) * 64, 64, (const bf16*)(F.ws + WS_MVT) + ((size_t)(Ly * NB + b) * 256 + h * 64) * NMEMT, NMEMT};
    f32x16 O[2][2]; float l[2]; zero_o<2, 2>(O, l);
    MaskArg ma{}; const unsigned* mbr[2] = {nullptr, nullptr};
    const float negb = 0.f;
    attn_core<2, 2, 0, MK_NONE>(ql, kv, 0, NMEMT / 32, negb, ma, mbr, O, l, F.lane);
    bf16* Y = (bf16*)(F.ws + WS_Y);
#pragma unroll
    for (int s = 0; s < 2; ++s) { const float lt = l[s] + __shfl_xor(l[s], 32); store_o<2, false>(O[s], (DBG_ZERO & 8) ? 0.f : 1.f / lt, Y, row0 + 32 * s, 768 + h * 64, F.lane); }
}
__device__ __forceinline__ void ret_task(Frame& F, int task, const bf16* PROJ) {
    const int qb = 31 - (task & 31), h = (task >> 5) % 6, b = (task >> 5) / 6; const int r32 = F.lane & 31, hi = F.lane >> 5;
    const int row0 = b * SEQ + 64 * qb;
    const bf16* qrow[2] = {PROJ + (size_t)(row0 + r32) * RET_LD + RET_Q + h * 64, PROJ + (size_t)(row0 + 32 + r32) * RET_LD + RET_Q + h * 64};
    LAS bf16x8* ql = wave_q(F); stage_q<2>(ql, qrow, F.lane);
    KVp kv{PROJ + (size_t)(b * SEQ) * RET_LD + RET_K + h * 64, RET_LD, (const bf16*)(F.ws + WS_XB) + ((size_t)b * 768 + h * 128) * SEQ, SEQ};
    f32x16 O[2][4]; float l[2]; zero_o<2, 4>(O, l);
    MaskArg ma{}; ma.q0[0] = 64 * qb; ma.q0[1] = 64 * qb + 32; const unsigned* mbr[2] = {nullptr, nullptr};
    ma.lg = __builtin_amdgcn_logf(1.0f - __builtin_amdgcn_exp2f(-5.0f - (float)h));
    attn_core<2, 4, RET_MODE, MK_CAUSAL, 1>(ql, kv, 0, 2 * qb + 2, 0.f, ma, mbr, O, l, F.lane);
    bf16* Y = (bf16*)(F.ws + WS_Y);
#pragma unroll
    for (int s = 0; s < 2; ++s)
#pragma unroll
        for (int rh = 0; rh < 2; ++rh) {
            unsigned short gv[8][4];
#pragma unroll
            for (int ri = 0; ri < 8; ++ri) { const int r = 8 * rh + ri; const bf16* gp = PROJ + (size_t)(row0 + 32 * s + crow(r, hi)) * RET_LD + RET_G + h * 128 + r32;
#pragma unroll
                for (int nt = 0; nt < 4; ++nt) gv[ri][nt] = gp[32 * nt]; }
#pragma unroll
            for (int ri = 0; ri < 8; ++ri) { const int r = 8 * rh + ri;
                float a = (O[s][0][r] + O[s][1][r]) + (O[s][2][r] + O[s][3][r]);
#pragma unroll
                for (int o = 1; o < 32; o <<= 1) a += __shfl_xor(a, o);
                const float mu = a * (1.f / 128.f);
                float d0 = O[s][0][r] - mu, d1 = O[s][1][r] - mu, d2 = O[s][2][r] - mu, d3 = O[s][3][r] - mu;
                float q = (d0 * d0 + d1 * d1) + (d2 * d2 + d3 * d3);
#pragma unroll
                for (int o = 1; o < 32; o <<= 1) q += __shfl_xor(q, o);
                const float rstd = __builtin_amdgcn_rsqf(q * (1.f / 128.f) + EPS);
                const int row = row0 + 32 * s + crow(r, hi);
                bf16* yp = Y + (size_t)row * 1024 + h * 128 + r32;
                const float dd[4] = {d0, d1, d2, d3};
#pragma unroll
                for (int nt = 0; nt < 4; ++nt) { const float g = bf2f(gv[ri][nt]); const float sg = g * __builtin_amdgcn_rcpf(1.f + fast_exp2(-1.4426950408889634f * g));
                    yp[32 * nt] = (DBG_ZERO & 1) ? (bf16)0 : (bf16)f2bf(sg * dd[nt] * rstd); }
            }
        }
}
#if DBG_BRUTE
__device__ __forceinline__ void ret_brute(Frame& F, int idx, const bf16* PROJ) {
    const int t = idx % SEQ, h = (idx / SEQ) % 6, b = idx / (SEQ * 6), lane = F.lane;
    float q[64];
    { const bf16* qp = PROJ + (size_t)(b * SEQ + t) * RET_LD + RET_Q + h * 64;
#pragma unroll
      for (int i = 0; i < 8; ++i) { const v4u w = *(const GAS v4u*)(qp + 8 * i); q[8 * i] = bflo(w.x); q[8 * i + 1] = bfhi(w.x); q[8 * i + 2] = bflo(w.y); q[8 * i + 3] = bfhi(w.y); q[8 * i + 4] = bflo(w.z); q[8 * i + 5] = bfhi(w.z); q[8 * i + 6] = bflo(w.w); q[8 * i + 7] = bfhi(w.w); } }
    LAS float* lres = (LAS float*)(F.lds + F.wave * 16384);
#pragma unroll 1
    for (int half = 0; half < 2; ++half) {
        float oacc[64];
#pragma unroll
        for (int e = 0; e < 64; ++e) oacc[e] = 0.f;
#pragma unroll 1
        for (int s0 = 0; s0 <= t; s0 += 64) { const int s = s0 + lane; const bool valid = s <= t; float S = 0.f;
            if (valid) { const bf16* kp = PROJ + (size_t)(b * SEQ + s) * RET_LD + RET_K + h * 64;
#pragma unroll
                for (int i = 0; i < 8; ++i) { const v4u w = *(const GAS v4u*)(kp + 8 * i);
                    S += q[8 * i] * bflo(w.x) + q[8 * i + 1] * bfhi(w.x) + q[8 * i + 2] * bflo(w.y) + q[8 * i + 3] * bfhi(w.y) + q[8 * i + 4] * bflo(w.z) + q[8 * i + 5] * bfhi(w.z) + q[8 * i + 6] * bflo(w.w) + q[8 * i + 7] * bfhi(w.w); } }
            const bf16* vt = (const bf16*)(F.ws + WS_XB) + ((size_t)b * 768 + h * 128 + half * 64) * SEQ + (valid ? s : 0);
#pragma unroll
            for (int e = 0; e < 64; ++e) oacc[e] += valid ? S * bf2f(vt[(size_t)e * SEQ]) : 0.f; }
#pragma unroll
        for (int e = 0; e < 64; ++e) { const float r = wave_sum(oacc[e]); if (e == lane) lres[half * 64 + e] = r; }
    }
    LDS_WAIT(); asm volatile("" ::: "memory");
    float mu = 0.f;
#pragma unroll 8
    for (int e = 0; e < 128; ++e) mu += lres[e];
    mu *= (1.f / 128.f); float var = 0.f;
#pragma unroll 8
    for (int e = 0; e < 128; ++e) { const float d0 = lres[e] - mu; var += d0 * d0; }
    const float rstd = __builtin_amdgcn_rsqf(var * (1.f / 128.f) + EPS);
    const size_t row = (size_t)(b * SEQ + t);
    const bf16* gp = PROJ + row * RET_LD + RET_G + h * 128; bf16* yp = (bf16*)(F.ws + WS_Y) + row * 1024 + h * 128;
#pragma unroll
    for (int half = 0; half < 2; ++half) { const int e = half * 64 + lane; const float g = bf2f(gp[e]); const float sg = g * __builtin_amdgcn_rcpf(1.f + fast_exp2(-1.4426950408889634f * g)); yp[e] = (bf16)f2bf(sg * (lres[e] - mu) * rstd); }
    LDS_WAIT(); asm volatile("" ::: "memory");
}
#endif
typedef _Float16 h2_t __attribute__((ext_vector_type(2)));
__device__ __forceinline__ unsigned pkh(float a, float b) { h2_t v = {(_Float16)a, (_Float16)b}; return __builtin_bit_cast(unsigned, v); }
__device__ __forceinline__ void dsa_d1_task(Frame& F, int task, const bf16* PROJ) {
    const int b = task / 288; int rem = task % 288; int qb = 63, kc = 0;
    { int grp = 7; while (rem >= 8 * (grp + 1)) { rem -= 8 * (grp + 1); --grp; }
      qb = 8 * grp + 7 - rem / (grp + 1); kc = rem % (grp + 1); }
    const int r32 = F.lane & 31, hi = F.lane >> 5; const int row = b * SEQ + 32 * qb + r32;
    const bf16* qp = PROJ + (size_t)row * DSA_LD + DSA_IQ + 8 * hi;
    bf16x8 qf[4][4]; LAS bf16x8* ql = wave_q(F);
#pragma unroll
    for (int h = 0; h < 4; ++h)
#pragma unroll
        for (int ks = 0; ks < 4; ++ks) { qf[h][ks] = ld8(qp + h * 64 + 16 * ks); ql[(h * 4 + ks) * 64] = ld8(qp + (4 + h) * 64 + 16 * ks); }
    LDS_WAIT(); asm volatile("" ::: "memory");
    float iw[8];
    { const v4u w = *(const GAS v4u*)(PROJ + (size_t)row * DSA_LD + DSA_IW); iw[0] = bflo(w.x); iw[1] = bfhi(w.x); iw[2] = bflo(w.y); iw[3] = bfhi(w.y); iw[4] = bflo(w.z); iw[5] = bfhi(w.z); iw[6] = bflo(w.w); iw[7] = bfhi(w.w); }
    const int kperm = (r32 & 0x13) | ((r32 & 4) << 1) | ((r32 & 8) >> 1);
    const bf16* kp = PROJ + (size_t)(b * SEQ + kperm) * DSA_LD + DSA_IK + 8 * hi;
    _Float16* sc = (_Float16*)(F.ws + WS_SC) + (size_t)row * SEQ + 8 * hi;
    const int kt1 = (8 * kc + 8 < qb + 1) ? 8 * kc + 8 : qb + 1;
#pragma unroll 1
    for (int kt = 8 * kc; kt < kt1; ++kt) {
        bf16x8 kf[4];
#pragma unroll
        for (int ks = 0; ks < 4; ++ks) kf[ks] = ld8(kp + (size_t)(32 * kt) * DSA_LD + 16 * ks);
        float s[16];
#pragma unroll
        for (int r = 0; r < 16; ++r) s[r] = 0.f;
#pragma unroll
        for (int h = 0; h < 8; ++h) { f32x16 acc;
#pragma unroll
            for (int r = 0; r < 16; ++r) acc[r] = 0.f;
#pragma unroll
            for (int ks = 0; ks < 4; ++ks) acc = __builtin_amdgcn_mfma_f32_32x32x16_bf16(kf[ks], h < 4 ? qf[h & 3][ks] : ql[((h & 3) * 4 + ks) * 64], acc, 0, 0, 0);
#pragma unroll
            for (int r = 0; r < 16; ++r) s[r] += iw[h] * fmaxf(acc[r], 0.f);
            __builtin_amdgcn_sched_barrier(0); }
        v4u o0, o1; o0.x = pkh(s[0], s[1]); o0.y = pkh(s[2], s[3]); o0.z = pkh(s[4], s[5]); o0.w = pkh(s[6], s[7]);
        o1.x = pkh(s[8], s[9]); o1.y = pkh(s[10], s[11]); o1.z = pkh(s[12], s[13]); o1.w = pkh(s[14], s[15]);
        *(GAS v4u*)(sc + 32 * kt) = o0; *(GAS v4u*)(sc + 32 * kt + 16) = o1;
    }
}
__device__ __forceinline__ void dsa_d2_row(Frame& F, int row) {
    const int t = row % SEQ, lane = F.lane;
    unsigned* mbp = (unsigned*)(F.ws + WS_MB) + (size_t)row * 64;
    int nvalid = t + 1 - 32 * lane; nvalid = nvalid < 0 ? 0 : (nvalid > 32 ? 32 : nvalid);
    const unsigned cb = nvalid == 32 ? 0xffffffffu : ((1u << nvalid) - 1u);
    if (t < 256) { mbp[lane] = cb; return; }
    unsigned key[32];
    { const unsigned short* sp = (const unsigned short*)(F.ws + WS_SC) + (size_t)row * SEQ + 32 * lane;
      v4u raw[4];
#pragma unroll
      for (int i = 0; i < 4; ++i) raw[i] = nvalid > 0 ? *(const GAS v4u*)(sp + 8 * i) : (v4u){0u, 0u, 0u, 0u};
#pragma unroll
      for (int i = 0; i < 4; ++i) { const unsigned w[4] = {raw[i].x, raw[i].y, raw[i].z, raw[i].w};
#pragma unroll
          for (int j = 0; j < 4; ++j) {
#pragma unroll
              for (int k = 0; k < 2; ++k) { const int e = 8 * i + 2 * j + k; const unsigned u = (w[j] >> (16 * k)) & 0xffffu;
                  const unsigned sk = (u & 0x8000u) ? (~u & 0xffffu) : (u | 0x8000u);
                  key[e] = (e < nvalid) ? sk : 0u; } } } }
    unsigned T = 0;
#pragma unroll 1
    for (int bit = 15; bit >= 0; --bit) { const unsigned Tc = T | (1u << bit); int cnt = 0;
#pragma unroll
        for (int e = 0; e < 32; ++e) cnt += __popcll(__ballot(key[e] >= Tc));
        if (cnt >= 256) T = Tc; }
    unsigned g = 0, eq = 0; int cgt = 0;
#pragma unroll
    for (int e = 0; e < 32; ++e) { const bool gt = key[e] > T; cgt += __popcll(__ballot(gt)); g |= (gt ? 1u : 0u) << e; eq |= (key[e] == T ? 1u : 0u) << e; }
    const int need = 256 - cgt; const int myeq = __popc(eq);
    int incl = myeq;
#pragma unroll
    for (int o = 1; o < 64; o <<= 1) { const int v = __shfl_up(incl, o); if (lane >= o) incl += v; }
    const int pre = incl - myeq; int take = need - pre; take = take < 0 ? 0 : (take > myeq ? myeq : take);
    unsigned te = eq; int cnt = myeq;
    while (cnt > take) { te &= ~(1u << (31 - __clz(te))); --cnt; }
    mbp[lane] = (g | te) & cb;
}
__device__ __forceinline__ void dsa_d3_task(Frame& F, int task, const bf16* PROJ) {
    const int hg = task & 3, qb = 63 - ((task >> 2) & 63), b = task >> 8; const int r32 = F.lane & 31;
    const int row0 = b * SEQ + 32 * qb;
    const bf16* qrow[3]; const unsigned* mbr[3];
#pragma unroll
    for (int s = 0; s < 3; ++s) { qrow[s] = PROJ + (size_t)(row0 + r32) * DSA_LD + DSA_Q + (3 * hg + s) * 64; mbr[s] = (const unsigned*)(F.ws + WS_MB) + (size_t)(row0 + r32) * 64; }
    LAS bf16x8* ql = wave_q(F); stage_q<3>(ql, qrow, F.lane);
    KVp kv{PROJ + (size_t)(b * SEQ) * DSA_LD + DSA_K, DSA_LD, (const bf16*)(F.ws + WS_XB) + (size_t)b * 64 * SEQ, SEQ};
    f32x16 O[3][2]; float l[3]; zero_o<3, 2>(O, l);
    MaskArg ma{}; ma.q0[0] = ma.q0[1] = ma.q0[2] = 32 * qb;
    const float negb = 0.f;
    attn_core<3, 2, 0, MK_BITS, 1>(ql, kv, 0, qb + 1, negb, ma, mbr, O, l, F.lane);
    bf16* Y = (bf16*)(F.ws + WS_Y);
#pragma unroll
    for (int s = 0; s < 3; ++s) { const float lt = l[s] + __shfl_xor(l[s], 32); store_o<2, false>(O[s], (DBG_ZERO & 2) ? 0.f : 1.f / lt, Y, row0, (3 * hg + s) * 64, F.lane); }
}

__device__ __forceinline__ void nsa_cmp_task(Frame& F, int task, const bf16* PROJ, const float* kn0) {
    const int nb = task & 3, g = (task >> 2) & 3, b = task >> 4; const int r32 = F.lane & 31, hi = F.lane >> 5;
    const int n = 32 * nb + r32, nc = n > 126 ? 126 : n;
    const bf16* arow = PROJ + (size_t)(b * SEQ + 16 * nc) * NSA_LD + 64 * g + 8 * hi;
    const bf16* WkT = (const bf16*)(F.ws + WS_CMPW); const bf16* WvT = WkT + 64 * 2048;
    const bf16* wkp = WkT + (size_t)r32 * 2048 + 8 * hi; const bf16* wvp = WvT + (size_t)r32 * 2048 + 8 * hi;
    f32x16 Dk[2], Dv[2];
#pragma unroll
    for (int et = 0; et < 2; ++et)
#pragma unroll
        for (int r = 0; r < 16; ++r) { Dk[et][r] = 0.f; Dv[et][r] = 0.f; }
#pragma unroll 4
    for (int kk = 0; kk < 128; ++kk) {
        const bf16* ap = arow + (size_t)(kk >> 2) * NSA_LD + 16 * (kk & 3);
        const bf16x8 kcf = ld8(ap + NSA_KC), vcf = ld8(ap + NSA_VC);
#pragma unroll
        for (int et = 0; et < 2; ++et) { const bf16x8 wk = ld8(wkp + (size_t)(32 * et) * 2048 + 16 * kk), wv = ld8(wvp + (size_t)(32 * et) * 2048 + 16 * kk);
            Dk[et] = __builtin_amdgcn_mfma_f32_32x32x16_bf16(wk, kcf, Dk[et], 0, 0, 0);
            Dv[et] = __builtin_amdgcn_mfma_f32_32x32x16_bf16(vcf, wv, Dv[et], 0, 0, 0); }
    }
    const float* ck = (const float*)(F.ws + WS_CTL) + CW_CK; const float* cv = ck + 64;
    const float* tab = (const float*)(F.ws + WS_ROPE) + (size_t)(16 * nc + 31) * 64;
    float ss = 0.f;
#pragma unroll
    for (int et = 0; et < 2; ++et)
#pragma unroll
        for (int r = 0; r < 16; ++r) { Dk[et][r] += ck[32 * et + crow(r, hi)]; ss += Dk[et][r] * Dk[et][r]; }
    ss += __shfl_xor(ss, 32);
    const float rs = __builtin_amdgcn_rsqf(ss * (1.f / 64.f) + EPS);
    bf16* kout = (bf16*)(F.ws + WS_KCMP) + ((size_t)((b * 4 + g) * 128 + n)) * 64;
#pragma unroll
    for (int rq = 0; rq < 4; ++rq) { float o0[4], o1[4];
#pragma unroll
        for (int i = 0; i < 4; ++i) { const int r = 4 * rq + i, idx = crow(r, hi); const float v0 = Dk[0][r] * rs * kn0[idx], v1 = Dk[1][r] * rs * kn0[32 + idx];
            const float c = tab[idx], s = tab[32 + idx]; o0[i] = v0 * c - v1 * s; o1[i] = v1 * c + v0 * s; if (n > 126) { o0[i] = 0.f; o1[i] = 0.f; } }
        v2u w0, w1; w0.x = pk2(o0[0], o0[1]); w0.y = pk2(o0[2], o0[3]); w1.x = pk2(o1[0], o1[1]); w1.y = pk2(o1[2], o1[3]);
        *(GAS v2u*)(kout + 8 * rq + 4 * hi) = w0; *(GAS v2u*)(kout + 32 + 8 * rq + 4 * hi) = w1; }
    bf16* vout = (bf16*)(F.ws + WS_VCMPT) + ((size_t)((b * 4 + g) * 64)) * 128 + 32 * nb;
#pragma unroll
    for (int et = 0; et < 2; ++et) { const float cve = cv[32 * et + r32];
#pragma unroll
        for (int rq = 0; rq < 4; ++rq) { float o[4];
#pragma unroll
            for (int i = 0; i < 4; ++i) { const int nl = 8 * rq + 4 * hi + i; o[i] = (32 * nb + nl > 126) ? 0.f : Dv[et][4 * rq + i] + cve; }
            v2u w; w.x = pk2(o[0], o[1]); w.y = pk2(o[2], o[3]);
            *(GAS v2u*)(vout + (size_t)(32 * et + r32) * 128 + 8 * rq + 4 * hi) = w; } }
}
__device__ NSA_INLINE void nsa_task(unsigned char* ws_, LAS unsigned char* lds_, int wave_, int task, const bf16* PROJ) {
    Frame F; F.ws = ws_; F.lds = lds_; F.wave = wave_;
    asm volatile("v_mbcnt_lo_u32_b32 %0, -1, 0\n\tv_mbcnt_hi_u32_b32 %0, -1, %0" : "=v"(F.lane));
    const int g = task & 3, qb = 63 - ((task >> 2) & 63), b = task >> 8; const int r32 = F.lane & 31, hi = F.lane >> 5;
    const int row0 = b * SEQ + 32 * qb, tq = 32 * qb + r32;
    const bf16* qrow[3];
#pragma unroll
    for (int s = 0; s < 3; ++s) qrow[s] = PROJ + (size_t)(row0 + r32) * NSA_LD + NSA_Q + (3 * g + s) * 64;
    LAS bf16x8* ql = wave_q(F); stage_q<3>(ql, qrow, F.lane);
#define NSA_GATE(s_, c_) (__builtin_amdgcn_rcpf(1.f + fast_exp2(-1.4426950408889634f * bf2f(PROJ[(size_t)(row0 + r32) * NSA_LD + NSA_GT + 9 * g + 3 * (s_) + (c_)]))))
    bf16* Y = (bf16*)(F.ws + WS_Y);
    MaskArg ma{}; ma.q0[0] = ma.q0[1] = ma.q0[2] = 32 * qb; ma.nmax = tq >= 31 ? (tq - 31) >> 4 : -1;
    const KVp kvc{(const bf16*)(F.ws + WS_KCMP) + (size_t)((b * 4 + g) * 128) * 64, 64, (const bf16*)(F.ws + WS_VCMPT) + (size_t)((b * 4 + g) * 64) * 128, 128};
    float imp[16];
#pragma unroll
    for (int r = 0; r < 16; ++r) imp[r] = 0.f;
#ifndef NSA_NO_A
    {   const int kperm = (r32 & 0x13) | ((r32 & 4) << 1) | ((r32 & 8) >> 1);
        const bf16* kp = kvc.K + (size_t)kperm * 64 + 8 * hi;
#pragma unroll 1
        for (int s = 0; s < 3; ++s) { f32x16 ia; float ls = 0.f;
#pragma unroll
            for (int r = 0; r < 16; ++r) ia[r] = 0.f;
#pragma unroll 1
            for (int kt = 0; kt < 4; ++kt) { f32x16 acc;
#pragma unroll
                for (int r = 0; r < 16; ++r) acc[r] = 0.f;
#pragma unroll
                for (int ks = 0; ks < 4; ++ks) acc = __builtin_amdgcn_mfma_f32_32x32x16_bf16(ld8(kp + (size_t)(32 * kt) * 64 + 16 * ks), ql[(s * 4 + ks) * 64], acc, 0, 0, 0);
                float p[16];
#pragma unroll
                for (int r = 0; r < 16; ++r) { const int key = 32 * kt + 8 * hi + 16 * (r >> 3) + (r & 7); p[r] = key <= ma.nmax ? fast_exp2(acc[r]) : 0.f; ls += p[r]; }
#pragma unroll
                for (int ks2 = 0; ks2 < 2; ++ks2) { v4u pw, cw; unsigned short cvv[8];
                    pw.x = pk2(p[8 * ks2], p[8 * ks2 + 1]); pw.y = pk2(p[8 * ks2 + 2], p[8 * ks2 + 3]); pw.z = pk2(p[8 * ks2 + 4], p[8 * ks2 + 5]); pw.w = pk2(p[8 * ks2 + 6], p[8 * ks2 + 7]);
#pragma unroll
                    for (int jj = 0; jj < 8; ++jj) { const int nn = 32 * kt + 16 * ks2 + 8 * hi + jj; cvv[jj] = (nn >= 4 * r32 - 1 && nn <= 4 * r32 + 3) ? 0x3f80 : 0; }
                    cw.x = cvv[0] | (cvv[1] << 16); cw.y = cvv[2] | (cvv[3] << 16); cw.z = cvv[4] | (cvv[5] << 16); cw.w = cvv[6] | (cvv[7] << 16);
                    ia = __builtin_amdgcn_mfma_f32_32x32x16_bf16(__builtin_bit_cast(bf16x8, cw), __builtin_bit_cast(bf16x8, pw), ia, 0, 0, 0); }
            }
            const float lt = ls + __shfl_xor(ls, 32); const float inv = lt > 0.f ? 1.f / lt : 0.f;
#pragma unroll
            for (int r = 0; r < 16; ++r) imp[r] += ia[r] * inv;
        }
    }
#endif
    unsigned sel;
    { const int qblk = tq >> 6;
      if (32 * qb + 31 < 1024) sel = (2u << qblk) - 1u;
      else { float val[16], oth[16];
#pragma unroll
        for (int r = 0; r < 16; ++r) { const int j = crow(r, hi); val[r] = j > qblk ? -1e30f : ((j == 0 || j == qblk || j == qblk - 1) ? 1e9f : imp[r]); oth[r] = __shfl_xor(val[r], 32); }
        unsigned mine = 0;
#pragma unroll
        for (int r = 0; r < 16; ++r) { const int j = crow(r, hi); int rank = 0;
#pragma unroll
            for (int r2 = 0; r2 < 16; ++r2) { const int j2 = crow(r2, hi), j3 = crow(r2, hi ^ 1);
                rank += (val[r2] > val[r] || (val[r2] == val[r] && j2 < j)) ? 1 : 0;
                rank += (oth[r2] > val[r] || (oth[r2] == val[r] && j3 < j)) ? 1 : 0; }
            if (rank < 16 && j <= qblk) mine |= 1u << j; }
        sel = mine | __shfl_xor(mine, 32); } }
    const unsigned* mbr2[2] = {nullptr, nullptr}; const unsigned* mbr1[1] = {nullptr};
    const KVp kvs{PROJ + (size_t)(b * SEQ) * NSA_LD + NSA_KS + 64 * g, NSA_LD, (const bf16*)(F.ws + WS_XB) + ((size_t)b * 256 + 64 * g) * SEQ, SEQ};
    const KVp kvw{PROJ + (size_t)(b * SEQ) * NSA_LD + NSA_KW + 64 * g, NSA_LD, (const bf16*)(F.ws + WS_XB) + (size_t)NB * 256 * SEQ + ((size_t)b * 256 + 64 * g) * SEQ, SEQ};
    ma.sel = sel;
#define NSA_BRANCH(MT_, KV_, KT0_, KT1_, C_, ADD_, ZBIT_) do { \
      { f32x16 O2[2][2]; float l2[2]; zero_o<2, 2>(O2, l2); attn_core<2, 2, 0, MT_>(ql, KV_, KT0_, KT1_, 0.f, ma, mbr2, O2, l2, F.lane); VM_WAIT(); \
        _Pragma("unroll") for (int s = 0; s < 2; ++s) { const float lt = l2[s] + __shfl_xor(l2[s], 32); \
          store_o<2, ADD_>(O2[s], (lt > 0.f && !(DBG_ZERO & ZBIT_)) ? NSA_GATE(s, C_) / lt : 0.f, Y, row0, (3 * g + s) * 64, F.lane); } } \
      { f32x16 O1[1][2]; float l1[1]; zero_o<1, 2>(O1, l1); attn_core<1, 2, 0, MT_>(ql + 2 * 4 * 64, KV_, KT0_, KT1_, 0.f, ma, mbr1, O1, l1, F.lane); VM_WAIT(); \
        const float lt = l1[0] + __shfl_xor(l1[0], 32); \
        store_o<2, ADD_>(O1[0], (lt > 0.f && !(DBG_ZERO & ZBIT_)) ? NSA_GATE(2, C_) / lt : 0.f, Y, row0, (3 * g + 2) * 64, F.lane); } } while (0)
    NSA_BRANCH(MK_CMP, kvc, 0, 4, 0, false, 4);
    NSA_BRANCH(MK_SLC, kvs, 0, qb + 1, 1, true, 16);
    NSA_BRANCH(MK_WIN, kvw, (qb > 16 ? qb - 16 : 0), qb + 1, 2, true, 32);
#undef NSA_BRANCH
}
__device__ __forceinline__ void prologue_misc(Frame& F) {
    float* tab = (float*)(F.ws + WS_ROPE);
    for (int idx = blockIdx.x * (NWAVES * 64) + F.tid; idx < SEQ * 32; idx += F.G * NWAVES * 64) {
        const int t = idx >> 5, i = idx & 31;
        const float inv = exp2f(-(float)i * (13.287712379549449f / 32.0f));
        const float ang = (float)t * inv; float s, c; sincosf(ang, &s, &c);
        tab[t * 64 + i] = c; tab[t * 64 + 32 + i] = s; }
    if (blockIdx.x < 4) {
        const int kv = F.wave & 1, part = blockIdx.x * 4 + (F.wave >> 1);
        const float* pos = kv ? F.ka->in[20] : F.ka->in[19]; const float* w = kv ? F.ka->in[22] : F.ka->in[21]; float a = 0.f;
#pragma unroll 8
        for (int i = part * 128; i < part * 128 + 128; ++i) a += pos[i] * w[(size_t)i * 64 + F.lane];
        atomicAdd((float*)(F.ws + WS_CTL) + CW_CK + 64 * kv + F.lane, a);
    }
}
__device__ __forceinline__ void prologue_phase(Frame& F) {
    prologue_misc(F);
    bf16* XB = (bf16*)(F.ws + WS_XB); float* PART = (float*)(F.ws + WS_PART);
    for (int m = F.gw; m < MTOK; m += F.NGW) row_to_bf16(F, F.ka->in[0] + (size_t)m * DM, XB + (size_t)m * DM, PART + (size_t)m * 16);
    bf16* MEMB = (bf16*)(F.ws + WS_MEMB); float* PARTM = (float*)(F.ws + WS_PARTM);
    for (int m = F.gw; m < MMEM; m += F.NGW) row_to_bf16(F, F.ka->in[1] + (size_t)m * DM, MEMB + (size_t)m * DM, PARTM + (size_t)m * 16);
    int itb = 0;
#pragma unroll 1
    for (int ly = 0; ly < DEPTH; ++ly) cvt_matrix(F, itb, F.ka->in[9] + (size_t)ly * DM * 512, nullptr, 512, 512, F.ka->in[8] + (size_t)ly * DM, (bf16*)(F.ws + WS_WKV) + (size_t)ly * 512 * DM, DM, 512, 0);
    cvt_matrix(F, itb, F.ka->in[21], nullptr, 64, 64, nullptr, (bf16*)(F.ws + WS_CMPW), 2048, 64, 0);
    cvt_matrix(F, itb, F.ka->in[22], nullptr, 64, 64, nullptr, (bf16*)(F.ws + WS_CMPW) + 64 * 2048, 2048, 64, 0);
    convert_layer(F, 0);
}

template <unsigned PHASE_MASK> __global__ void __launch_bounds__(NWAVES * 64, 2) mk_fwd(Args args) {
    extern __shared__ __attribute__((aligned(16))) unsigned char lds[];
    Frame F;
    F.lds = (LAS unsigned char*)lds;
    F.MISC = (volatile LAS unsigned*)(F.lds + 131072 + 320);
    F.tid = threadIdx.x; F.lane = F.tid & 63; F.wave = __builtin_amdgcn_readfirstlane(F.tid >> 6);
    F.G = gridDim.x; F.gw = blockIdx.x * NWAVES + F.wave; F.NGW = F.G * NWAVES;
    F.ws = args.ws; F.ctl = (gu32*)(args.ws + WS_CTL); F.out = args.out;
    F.ka = (KArgs)__builtin_amdgcn_kernarg_segment_ptr();
    for (int u = F.tid; u < (147456 - 131072) / 4; u += NWAVES * 64) ((LAS unsigned*)(F.lds + 131072))[u] = 0u;
    __syncthreads();
    XcdBarrier bar = xcd_barrier_post((unsigned*)(F.ctl + CW_BAR), F.MISC + 8);
    constexpr bool ALLPH = PHASE_MASK == 0xffffffffu;
    const int lo = ALLPH ? 0 : args.ph_lo, hi = ALLPH ? 0 : args.ph_hi; int pc = 0;
#define PH_BEGIN(id) if (ALLPH || ((((PHASE_MASK) >> (id)) & 1u) && lo <= pc && pc < hi)) { asm volatile("" : "+s"(F.ka), "+s"(F.ws), "+s"(F.out), "+s"(F.gw), "+s"(F.NGW), "+s"(F.G), "+s"(F.wave)); asm volatile("v_mbcnt_lo_u32_b32 %0, -1, 0\n\tv_mbcnt_hi_u32_b32 %0, -1, %0" : "=v"(F.lane)); F.tid = F.wave * 64 + F.lane;
#define PH_END_(islast)   if (ALLPH ? !(islast) : (pc + 1 < hi)) { XcdBarrier b2_ = bar; asm volatile("" : "+s"(b2_.bar), "+s"(b2_.x)); xcd_barrier(b2_); } } if (!ALLPH) ++pc;
#define PH_END PH_END_(false)
#define QCTR(i) (F.ctl + CW_Q + 64 * (i))

#define XB ((bf16*)(F.ws + WS_XB))
#define Yb ((bf16*)(F.ws + WS_Y))
#define HID ((bf16*)(F.ws + WS_HID))
#define PART ((float*)(F.ws + WS_PART))
    LAS unsigned char* ring = F.lds;

    PH_BEGIN(0) prologue_phase(F); PH_END
    PH_BEGIN(1) { pg8::Gemm g{(const bf16*)(F.ws + WS_MEMB), (const bf16*)(F.ws + WS_WKV), MMEM, 2048, DM}; pg8::StaticOrder S; S.init(MMEM, 2048, F.G, (int)blockIdx.x);
        pg8::EpiScale E{(bf16*)(F.ws + WS_MKV), 2048, (const float*)(F.ws + WS_PARTM)};
        pg8::gemm_phase<pg8::EpiScale, pg8::StaticOrder, true, true>(ring, g, S, E, F.wave); } PH_END
    PH_BEGIN(2)
#pragma unroll 1
        for (int ly = 0; ly < DEPTH; ++ly) {
            xform(F, (const bf16*)(F.ws + WS_MKV), 2048, ly * 512, 4, MMEM, NMEMT, (bf16*)(F.ws + WS_MK) + (size_t)ly * NB * 4 * NMEMT * 64, 1, 0, 0, F.ka->in[11] + ly * 64, false, 1.f, 0);
            transpose_cols(F, (const bf16*)(F.ws + WS_MKV), 2048, ly * 512 + 256, 256, NB, NMEMT, (bf16*)(F.ws + WS_MVT) + (size_t)ly * NB * 256 * NMEMT);
        }
    PH_END

#pragma unroll 1
    for (int Ly = 0; Ly < DEPTH; ++Ly) {
#define WB ((const bf16*)(F.ws + WS_WBUF0 + (size_t)(Ly & 1) * WBUF_BYTES))
        const int kind = Ly % 3;
        const int ldp = kind == 0 ? RET_LD : (kind == 1 ? DSA_LD : NSA_LD);
        PH_BEGIN(3) { pg8::Gemm g{XB, WB + WB_W1A, MTOK, 2 * FF, DM}; pg8::StaticOrder S; S.init(MTOK, 2 * FF, F.G, (int)blockIdx.x);
            pg8::EpiSwiglu E{HID, FF, PART};
            pg8::gemm_phase<pg8::EpiSwiglu, pg8::StaticOrder, true, true>(ring, g, S, E, F.wave); } PH_END
        PH_BEGIN(4) { pg8::Gemm g{HID, WB + WB_W2A, MTOK, DM, FF}; pg8::StaticOrder S; S.init(MTOK, DM, F.G, (int)blockIdx.x);
            pg8::EpiResid E{Ly == 0 ? F.ka->in[0] : F.out, F.out, XB, PART, 0.5f};
            pg8::gemm_phase<pg8::EpiResid, pg8::StaticOrder, true, true>(ring, g, S, E, F.wave); } PH_END
        PH_BEGIN(5) { pg8::Gemm g{XB, WB + WB_WIN, MTOK, ldp, DM}; pg8::StaticOrder S; S.init(MTOK, ldp, F.G, (int)blockIdx.x);
            pg8::EpiScale E{HID, ldp, PART};
            pg8::gemm_phase<pg8::EpiScale, pg8::StaticOrder, true, true>(ring, g, S, E, F.wave); } PH_END
        PH_BEGIN(6)
            if (kind == 0) {
                xform(F, HID, ldp, RET_Q, 6, MTOK, SEQ, HID, 0, ldp, RET_Q, nullptr, true, 1.f, RET_MODE == 1 ? +1 : 0);
                xform(F, HID, ldp, RET_K, 6, MTOK, SEQ, HID, 0, ldp, RET_K, nullptr, true, 0.125f, RET_MODE == 1 ? -1 : 0);
                xform(F, HID, ldp, RET_QM, 4, MTOK, SEQ, HID, 0, ldp, RET_QM, F.ka->in[10] + Ly * 64, false, QSCALE, 0);
                transpose_cols(F, HID, ldp, RET_V, 768, NB, SEQ, XB);
            } else if (kind == 1) {
                xform(F, HID, ldp, DSA_Q, 12, MTOK, SEQ, HID, 0, ldp, DSA_Q, F.ka->in[14], true, QSCALE, 0);
                xform(F, HID, ldp, DSA_K, 1, MTOK, SEQ, HID, 0, ldp, DSA_K, F.ka->in[15], true, 1.f, 0);
                xform(F, HID, ldp, DSA_IQ, 8, MTOK, SEQ, HID, 0, ldp, DSA_IQ, nullptr, true, 1.f, 0);
                xform(F, HID, ldp, DSA_IK, 1, MTOK, SEQ, HID, 0, ldp, DSA_IK, nullptr, true, 1.f, 0);
                xform(F, HID, ldp, DSA_QM, 4, MTOK, SEQ, HID, 0, ldp, DSA_QM, F.ka->in[10] + Ly * 64, false, QSCALE, 0);
                transpose_cols(F, HID, ldp, DSA_V, 64, NB, SEQ, XB);
            } else {
                xform(F, HID, ldp, NSA_Q, 12, MTOK, SEQ, HID, 0, ldp, NSA_Q, F.ka->in[17], true, QSCALE, 0);
                xform(F, HID, ldp, NSA_KS, 4, MTOK, SEQ, HID, 0, ldp, NSA_KS, F.ka->in[18] + 64, true, 1.f, 0);
                xform(F, HID, ldp, NSA_KW, 4, MTOK, SEQ, HID, 0, ldp, NSA_KW, F.ka->in[18] + 128, true, 1.f, 0);
                xform(F, HID, ldp, NSA_QM, 4, MTOK, SEQ, HID, 0, ldp, NSA_QM, F.ka->in[10] + Ly * 64, false, QSCALE, 0);
                transpose_cols(F, HID, ldp, NSA_VS, 256, NB, SEQ, XB);
                transpose_cols(F, HID, ldp, NSA_VW, 256, NB, SEQ, XB + (size_t)NB * 256 * SEQ);
                for (int t = F.gw; t < 256; t += F.NGW) nsa_cmp_task(F, t, HID, F.ka->in[18]);
            }
            if (Ly + 1 < DEPTH) convert_layer(F, Ly + 1);
        PH_END
        if (kind == 0) {
            PH_BEGIN(7)
                for (;;) { asm volatile("v_mbcnt_lo_u32_b32 %0, -1, 0\n\tv_mbcnt_hi_u32_b32 %0, -1, %0" : "=v"(F.lane)); const int t = grab(QCTR(Ly * 8 + 0), F.lane); if (t >= 3072 + 2048) break; if (t < 3072) ret_task(F, t, HID); else mem_task(F, t - 3072, Ly, HID, ldp, RET_QM); }
            PH_END
        } else if (kind == 1) {
            PH_BEGIN(8)
                for (;;) { asm volatile("v_mbcnt_lo_u32_b32 %0, -1, 0\n\tv_mbcnt_hi_u32_b32 %0, -1, %0" : "=v"(F.lane)); const int t = grab(QCTR(Ly * 8 + 0), F.lane); if (t >= 4608 + 2048) break; if (t < 4608) dsa_d1_task(F, t, HID); else mem_task(F, t - 4608, Ly, HID, ldp, DSA_QM); }
            PH_END
            PH_BEGIN(9)
                for (;;) { asm volatile("v_mbcnt_lo_u32_b32 %0, -1, 0\n\tv_mbcnt_hi_u32_b32 %0, -1, %0" : "=v"(F.lane)); const int t = grab(QCTR(Ly * 8 + 1), F.lane); if (t >= MTOK / 8) break;
#pragma unroll 1
                    for (int i = 0; i < 8; ++i) dsa_d2_row(F, MTOK - 1 - (8 * t + i)); }
            PH_END
            PH_BEGIN(10)
                for (;;) { asm volatile("v_mbcnt_lo_u32_b32 %0, -1, 0\n\tv_mbcnt_hi_u32_b32 %0, -1, %0" : "=v"(F.lane)); const int t = grab(QCTR(Ly * 8 + 2), F.lane); if (t >= 4096) break; dsa_d3_task(F, t, HID); }
            PH_END
        } else {
            PH_BEGIN(11)
                for (;;) { asm volatile("v_mbcnt_lo_u32_b32 %0, -1, 0\n\tv_mbcnt_hi_u32_b32 %0, -1, %0" : "=v"(F.lane)); const int t = grab(QCTR(Ly * 8 + 0), F.lane); if (t >= 4096 + 2048) break; if (t < 4096) nsa_task(F.ws, F.lds, F.wave, t, HID); else mem_task(F, t - 4096, Ly, HID, ldp, NSA_QM); }
            PH_END
        }
        PH_BEGIN(12) { pg8::Gemm g{Yb, WB + WB_WO, MTOK, DM, DM}; pg8::StaticOrder S; S.init(MTOK, DM, F.G, (int)blockIdx.x);
            pg8::EpiResid E{F.out, F.out, XB, PART, 1.0f};
            pg8::gemm_phase<pg8::EpiResid, pg8::StaticOrder, true, true>(ring, g, S, E, F.wave); } PH_END
        PH_BEGIN(13) { pg8::Gemm g{XB, WB + WB_W1B, MTOK, 2 * FF, DM}; pg8::StaticOrder S; S.init(MTOK, 2 * FF, F.G, (int)blockIdx.x);
            pg8::EpiSwiglu E{HID, FF, PART};
            pg8::gemm_phase<pg8::EpiSwiglu, pg8::StaticOrder, true, true>(ring, g, S, E, F.wave); } PH_END
        PH_BEGIN(14) { pg8::Gemm g{HID, WB + WB_W2B, MTOK, DM, FF}; pg8::StaticOrder S; S.init(MTOK, DM, F.G, (int)blockIdx.x);
            pg8::EpiResid E{F.out, F.out, XB, PART, 0.5f};
            pg8::gemm_phase<pg8::EpiResid, pg8::StaticOrder, true, true>(ring, g, S, E, F.wave); } PH_END_(Ly == DEPTH - 1)
    }
#undef XB
#undef Yb
#undef HID
#undef PART
#undef WB
#undef PH_BEGIN
#undef PH_END
#undef PH_END_
}

constexpr int LDS_BYTES = 147456;
#ifndef MK_PER_PHASE
#define MK_PER_PHASE 0
#endif
typedef void (*kern_t)(Args);
template <unsigned M> static kern_t kern_of() { return mk_fwd<M>; }
#if MK_PER_PHASE
static kern_t phase_kernel(int id) {
    switch (id) {
        case 0: return kern_of<1u << 0>(); case 1: return kern_of<1u << 1>(); case 2: return kern_of<1u << 2>(); case 3: return kern_of<1u << 3>(); case 4: return kern_of<1u << 4>();
        case 5: return kern_of<1u << 5>(); case 6: return kern_of<1u << 6>(); case 7: return kern_of<1u << 7>(); case 8: return kern_of<1u << 8>(); case 9: return kern_of<1u << 9>();
        case 10: return kern_of<1u << 10>(); case 11: return kern_of<1u << 11>(); case 12: return kern_of<1u << 12>(); case 13: return kern_of<1u << 13>(); default: return kern_of<1u << 14>();
    }
}
#endif
extern "C" void kernel_launch(void* const* d_in, const int* in_sizes, int n_in, void* d_out, int out_size, void* d_ws, size_t ws_size, hipStream_t stream) {
    static int grid = 0;
    if (grid == 0) {
        if (n_in != 23 || out_size != MTOK * DM || ws_size < WS_END) { fprintf(stderr, "kernel_launch: unexpected shapes (n_in %d, out %d, ws %zu)\n", n_in, out_size, ws_size); grid = -1; return; }
        int dev = 0, cus = 0;
        if (hipGetDevice(&dev) != hipSuccess || hipDeviceGetAttribute(&cus, hipDeviceAttributeMultiprocessorCount, dev) != hipSuccess) { grid = -1; return; }
#if MK_PER_PHASE
        for (int id = 0; id < 15; ++id) if (hipFuncSetAttribute((const void*)phase_kernel(id), hipFuncAttributeMaxDynamicSharedMemorySize, LDS_BYTES) != hipSuccess) { fprintf(stderr, "kernel_launch: hipFuncSetAttribute failed\n"); grid = -1; return; }
#else
        if (hipFuncSetAttribute((const void*)kern_of<0xffffffffu>(), hipFuncAttributeMaxDynamicSharedMemorySize, LDS_BYTES) != hipSuccess) { fprintf(stderr, "kernel_launch: hipFuncSetAttribute failed\n"); grid = -1; return; }
#endif
        (void)hipGetLastError();
        grid = cus;
    }
    if (grid < 0) return;
    if (hipMemsetAsync((char*)d_ws + WS_CTL, 0, CTL_ZERO_BYTES, stream) != hipSuccess) return;
    Args a{};
    for (int i = 0; i < 23; ++i) a.in[i] = (const float*)d_in[i];
    a.out = (float*)d_out; a.ws = (unsigned char*)d_ws;
    constexpr int NPH = 3 + 8 * DEPTH + 2;
#if MK_PER_PHASE
    int ids[NPH]; int n = 0; ids[n++] = 0; ids[n++] = 1; ids[n++] = 2;
    for (int ly = 0; ly < DEPTH; ++ly) { ids[n++] = 3; ids[n++] = 4; ids[n++] = 5; ids[n++] = 6;
        if (ly % 3 == 0) ids[n++] = 7; else if (ly % 3 == 1) { ids[n++] = 8; ids[n++] = 9; ids[n++] = 10; } else ids[n++] = 11;
        ids[n++] = 12; ids[n++] = 13; ids[n++] = 14; }
    for (int p = 0; p < NPH; ++p) { a.ph_lo = p; a.ph_hi = p + 1; hipLaunchKernelGGL(phase_kernel(ids[p]), dim3(grid), dim3(NWAVES * 64), LDS_BYTES, stream, a);
#if PROBE_DUP
        if ((PROBE_DUP >> ids[p]) & 1) {
            hipMemsetAsync((char*)d_ws + WS_CTL + CW_Q * 4, 0, 64 * 4 * 64, stream);
            hipLaunchKernelGGL(phase_kernel(ids[p]), dim3(grid), dim3(NWAVES * 64), LDS_BYTES, stream, a); }
#endif
    }
#else
    a.ph_lo = 0; a.ph_hi = NPH; hipLaunchKernelGGL(kern_of<0xffffffffu>(), dim3(grid), dim3(NWAVES * 64), LDS_BYTES, stream, a);
#endif
}
```

```cpp
#include <hip/hip_runtime.h>
#include <cstdio>
#include <cstdint>
namespace pg8 {
#define PG8_LAS __attribute__((address_space(3)))
typedef unsigned short bf16_t;
typedef short bf16x8 __attribute__((ext_vector_type(8)));
typedef float f32x4 __attribute__((ext_vector_type(4)));
typedef unsigned u32x4 __attribute__((ext_vector_type(4)));
constexpr int BM = 256, BK = 64, HALF = 128, HTB = HALF * BK * 2  , STAGE_BYTES = 8 * HTB, NXCD = 8, WGM = 8;

__host__ __device__ __forceinline__ int lds_byte(int r, int c) { const int st = (r >> 4) * 2 + (c >> 5), rr = r & 15, cc = c & 31, ob = rr * 64 + cc * 2; return st * 1024 + (ob ^ (((ob >> 9) & 1) << 5)); }
__host__ __device__ __forceinline__ void stage_rc(int b, int& R, int& C) { const int st = b / 1024, sb = b % 1024, swz = sb ^ (((sb >> 9) & 1) << 5); R = (st >> 1) * 16 + swz / 64; C = (st & 1) * 32 + (swz % 64) / 2; }
__host__ __device__ __forceinline__ int perm32(int rho) { const int n = rho >> 4, i = rho & 15; return 8 * (i >> 2) + 4 * n + (i & 3); }

struct Unit { int pm, pn; };
struct Gemm { const bf16_t* A; const bf16_t* Bt; int M, N, K; };

struct StaticOrder {
    int nM, nN, nwg, G, c;
    __host__ __device__ void init(int M, int N, int G_, int c_) { nM = M / BM; nN = N / BM; nwg = nM * nN; G = G_; c = c_; }
    __host__ __device__ bool next(int i, Unit& u) const {
        const long L = (long)i * G + c; if (L >= nwg) return false;
        int wgid = (int)L; { const int q = nwg / NXCD, r = nwg % NXCD, xcd = wgid % NXCD, off = wgid / NXCD; wgid = (xcd < r ? xcd * (q + 1) : r * (q + 1) + (xcd - r) * q) + off; }
        const int nig = WGM * nN, gid = wgid / nig, fm = gid * WGM, gsz = (nM - fm) < WGM ? (nM - fm) : WGM;
        u.pm = fm + ((wgid % nig) % gsz); u.pn = (wgid % nig) / gsz; return true;
    }
    __device__ __forceinline__ void a_ready(const Unit&) const {}
    __device__ __forceinline__ void done(const Unit&) const {}
};

typedef float f32x2_cv __attribute__((ext_vector_type(2))); typedef __bf16 bf16x2_cv __attribute__((ext_vector_type(2)));
__device__ __forceinline__ unsigned cvt_pk_bf16(float lo, float hi) { f32x2_cv v = {lo, hi}; bf16x2_cv b = __builtin_convertvector(v, bf16x2_cv); return __builtin_bit_cast(unsigned, b); }
constexpr float RMS_EPS = 1e-6f;
__device__ __forceinline__ void rows_rs(const float* part, int row0, int fq, float (&rs)[2][4]) {
    f32x4 pr[2][4];
#pragma unroll
    for (int ai = 0; ai < 2; ++ai)
#pragma unroll
        for (int m = 0; m < 4; ++m) pr[ai][m] = *(const f32x4*)(part + (size_t)(row0 + ai * HALF + m * 16) * 16 + 4 * fq);
#pragma unroll
    for (int ai = 0; ai < 2; ++ai)
#pragma unroll
        for (int m = 0; m < 4; ++m) { float s = (pr[ai][m][0] + pr[ai][m][1]) + (pr[ai][m][2] + pr[ai][m][3]); s += __shfl_xor(s, 16); s += __shfl_xor(s, 32);
            rs[ai][m] = __builtin_amdgcn_rsqf(s * (1.0f / 1024.0f) + RMS_EPS); }
}
__device__ __forceinline__ float silu_mul(float g, float u) { return g * u * __builtin_amdgcn_rcpf(1.0f + __builtin_amdgcn_exp2f(-1.4426950408889634f * g)); }
struct EpiSwiglu {
    static constexpr bool PERM = true, AFTER_DRAIN = false;
    bf16_t* H; int ldh; const float* part;
    __device__ __forceinline__ void operator()(const f32x4 (&acc)[2][2][4][2], const Unit& u, int wr, int wc, int fr_, int fq_) const {
        int le_; asm volatile("v_mbcnt_lo_u32_b32 %0, -1, 0\n\tv_mbcnt_hi_u32_b32 %0, -1, %0" : "=v"(le_)); const int fr = le_ & 15, fq = le_ >> 4;
        const int row0 = u.pm * BM + wr * 64 + fr, col0 = u.pn * HALF + wc * 32 + 8 * fq;
        float rsv[2][4]; rows_rs(part, row0, fq, rsv);
#pragma unroll
        for (int ai = 0; ai < 2; ++ai)
#pragma unroll
            for (int m = 0; m < 4; ++m) { const int row = row0 + ai * HALF + m * 16; const float rs = rsv[ai][m];
                const f32x4 g0 = acc[ai][0][m][0] * rs, g1 = acc[ai][0][m][1] * rs, u0 = acc[ai][1][m][0] * rs, u1 = acc[ai][1][m][1] * rs;
                u32x4 w; w.x = cvt_pk_bf16(silu_mul(g0[0], u0[0]), silu_mul(g0[1], u0[1])); w.y = cvt_pk_bf16(silu_mul(g0[2], u0[2]), silu_mul(g0[3], u0[3]));
                w.z = cvt_pk_bf16(silu_mul(g1[0], u1[0]), silu_mul(g1[1], u1[1])); w.w = cvt_pk_bf16(silu_mul(g1[2], u1[2]), silu_mul(g1[3], u1[3]));
                *(u32x4*)(H + (size_t)row * ldh + col0) = w; }
    }
};
struct EpiScale {
    static constexpr bool PERM = true, AFTER_DRAIN = false;
    bf16_t* O; int ldc; const float* part;
    __device__ __forceinline__ void operator()(const f32x4 (&acc)[2][2][4][2], const Unit& u, int wr, int wc, int fr_, int fq_) const {
        int le_; asm volatile("v_mbcnt_lo_u32_b32 %0, -1, 0\n\tv_mbcnt_hi_u32_b32 %0, -1, %0" : "=v"(le_)); const int fr = le_ & 15, fq = le_ >> 4;
        const int row0 = u.pm * BM + wr * 64 + fr, col0 = u.pn * BM + wc * 32 + 8 * fq;
        float rsv[2][4]; rows_rs(part, row0, fq, rsv);
#pragma unroll
        for (int ai = 0; ai < 2; ++ai)
#pragma unroll
            for (int m = 0; m < 4; ++m) { const int row = row0 + ai * HALF + m * 16; const float rs = rsv[ai][m]; bf16_t* rowp = O + (size_t)row * ldc + col0;
#pragma unroll
                for (int bj = 0; bj < 2; ++bj) { const f32x4 v0 = acc[ai][bj][m][0] * rs, v1 = acc[ai][bj][m][1] * rs;
                    u32x4 w; w.x = cvt_pk_bf16(v0[0], v0[1]); w.y = cvt_pk_bf16(v0[2], v0[3]); w.z = cvt_pk_bf16(v1[0], v1[1]); w.w = cvt_pk_bf16(v1[2], v1[3]);
                    *(u32x4*)(rowp + bj * HALF) = w; } }
    }
};
struct EpiResid {
    static constexpr bool PERM = true, AFTER_DRAIN = false;
    const bf16_t* base; bf16_t* xb; float* out; float* part_out; float coef;
    __device__ __forceinline__ void operator()(const f32x4 (&acc)[2][2][4][2], const Unit& u, int wr, int wc, int fr_, int fq_) const {
        int le_; asm volatile("v_mbcnt_lo_u32_b32 %0, -1, 0\n\tv_mbcnt_hi_u32_b32 %0, -1, %0" : "=v"(le_)); const int fr = le_ & 15, fq = le_ >> 4;
        const int row0 = u.pm * BM + wr * 64 + fr, col0 = u.pn * BM + wc * 32 + 8 * fq;
        u32x4 bs[2][4][2];
#pragma unroll
        for (int ai = 0; ai < 2; ++ai)
#pragma unroll
            for (int m = 0; m < 4; ++m)
#pragma unroll
                for (int bj = 0; bj < 2; ++bj) bs[ai][m][bj] = *(const u32x4*)(base + (size_t)(row0 + ai * HALF + m * 16) * 1024 + col0 + bj * HALF);
#pragma unroll
        for (int ai = 0; ai < 2; ++ai)
#pragma unroll
            for (int m = 0; m < 4; ++m) { const int row = row0 + ai * HALF + m * 16; const size_t off = (size_t)row * 1024 + col0; float ss = 0.f;
#pragma unroll
                for (int bj = 0; bj < 2; ++bj) { const u32x4 b = bs[ai][m][bj];
                    const f32x4 b0 = {__builtin_bit_cast(float, b.x << 16), __builtin_bit_cast(float, b.x & 0xffff0000u), __builtin_bit_cast(float, b.y << 16), __builtin_bit_cast(float, b.y & 0xffff0000u)};
                    const f32x4 b1 = {__builtin_bit_cast(float, b.z << 16), __builtin_bit_cast(float, b.z & 0xffff0000u), __builtin_bit_cast(float, b.w << 16), __builtin_bit_cast(float, b.w & 0xffff0000u)};
                    const f32x4 v0 = b0 + acc[ai][bj][m][0] * coef, v1 = b1 + acc[ai][bj][m][1] * coef;
                    if (out) { *(f32x4*)(out + off + bj * HALF) = v0; *(f32x4*)(out + off + bj * HALF + 4) = v1; }
                    u32x4 w; w.x = cvt_pk_bf16(v0[0], v0[1]); w.y = cvt_pk_bf16(v0[2], v0[3]); w.z = cvt_pk_bf16(v1[0], v1[1]); w.w = cvt_pk_bf16(v1[2], v1[3]);
                    *(u32x4*)(xb + off + bj * HALF) = w;
                    ss += (v0[0] * v0[0] + v0[1] * v0[1]) + (v0[2] * v0[2] + v0[3] * v0[3]) + (v1[0] * v1[0] + v1[1] * v1[1]) + (v1[2] * v1[2] + v1[3] * v1[3]); }
                ss += __shfl_xor(ss, 16); ss += __shfl_xor(ss, 32);
                if (fq == 0) part_out[(size_t)row * 16 + u.pn * 4 + wc] = ss; }
    }
};
template <class Epi, class Sched, bool ALIGN_EPI = false, bool SP2 = false>
__device__ __forceinline__ void gemm_phase(PG8_LAS unsigned char* lds, const Gemm g, const Sched& S, const Epi& E, int wave_id) {
    int lane_; asm volatile("v_mbcnt_lo_u32_b32 %0, -1, 0\n\tv_mbcnt_hi_u32_b32 %0, -1, %0" : "=v"(lane_));
    const int wid = wave_id, lane = lane_, tid = wid * 64 + lane, wr = wid >> 2, wc = wid & 3, fr = lane & 15, fq = lane >> 4;
    const int K = g.K, nt = K / BK;
    unsigned voffA[2], voffB[2];
#pragma unroll
    for (int i = 0; i < 2; ++i) { int R, C; stage_rc(tid * 16 + i * 8192, R, C); const int Rb = Epi::PERM ? ((R & ~31) + perm32(R & 31)) : R;
        voffA[i] = (unsigned)(R * K + C) * 2u; voffB[i] = (unsigned)(Rb * K + C) * 2u; }
    const size_t kstep = (size_t)(BK * 2);
    const size_t hstep = (size_t)HALF * K * 2;
    const size_t tstep = 2 * hstep;
    const unsigned ldsw = (unsigned)wid * 1024u;
    const int aoff = lds_byte(wr * 64 + fr, fq * 8), boff = lds_byte(wc * 32 + fr, fq * 8);
#define PG8_SA(b, h) (((b) * 2 + (h)) * HTB)
#define PG8_SB(b, h) ((4 + (b) * 2 + (h)) * HTB)
#define PG8_STAGE(bufoff, gbase, voff) do { _Pragma("unroll") for (int _i = 0; _i < 2; ++_i) \
        __builtin_amdgcn_global_load_lds((const unsigned*)((const char*)(gbase) + (voff)[_i]), (PG8_LAS unsigned*)(lds + (bufoff) + ldsw + _i * 8192), 16, 0, 0); } while (0)
#define PG8_LDA(dst, b, h) do { _Pragma("unroll") for (int m = 0; m < 4; ++m) _Pragma("unroll") for (int k = 0; k < 2; ++k) dst[m][k] = *(const PG8_LAS bf16x8*)(lds + PG8_SA(b, h) + aoff + m * 2048 + k * 1024); } while (0)
#define PG8_LDB(dst, b, h) do { _Pragma("unroll") for (int n = 0; n < 2; ++n) _Pragma("unroll") for (int k = 0; k < 2; ++k) dst[n][k] = *(const PG8_LAS bf16x8*)(lds + PG8_SB(b, h) + boff + n * 2048 + k * 1024); } while (0)
#define PG8_MMA(ai, bj, At, Bt) do { __builtin_amdgcn_s_setprio(1); _Pragma("unroll") for (int m = 0; m < 4; ++m) _Pragma("unroll") for (int n = 0; n < 2; ++n) _Pragma("unroll") for (int k = 0; k < 2; ++k) \
        acc[ai][bj][m][n] = __builtin_amdgcn_mfma_f32_16x16x32_bf16(Bt[n][k], At[m][k], acc[ai][bj][m][n], 0, 0, 0); __builtin_amdgcn_s_setprio(0); } while (0)
#define PG8_WAIT_V(n) asm volatile("s_waitcnt vmcnt(" #n ")" ::: "memory")
#define PG8_WAIT_L(n) asm volatile("s_waitcnt lgkmcnt(" #n ")" ::: "memory")
#define PG8_BAR __builtin_amdgcn_s_barrier()
#define PG8_SCHED __builtin_amdgcn_sched_barrier(0)
    Unit cur, nxt; int ui = 0;
    if (!S.next(0, cur)) return;
    f32x4 acc[2][2][4][2];
#pragma unroll
    for (int a = 0; a < 2; ++a)
#pragma unroll
        for (int b = 0; b < 2; ++b)
#pragma unroll
            for (int m = 0; m < 4; ++m)
#pragma unroll
                for (int n = 0; n < 2; ++n) acc[a][b][m][n] = (f32x4){0.f, 0.f, 0.f, 0.f};
    bf16x8 At[4][2], B0[2][2], B1[2][2];
    const char* cA = (const char*)g.A + (size_t)cur.pm * tstep; const char* cB = (const char*)g.Bt + (size_t)cur.pn * tstep;
    S.a_ready(cur);
    if constexpr (SP2) {
        PG8_STAGE(PG8_SB(0, 0), cB, voffB); PG8_STAGE(PG8_SB(0, 1), cB + hstep, voffB); PG8_STAGE(PG8_SA(0, 0), cA, voffA); PG8_STAGE(PG8_SA(0, 1), cA + hstep, voffA);
        if (wr == 1) PG8_BAR;
        PG8_WAIT_V(2); PG8_BAR;
        PG8_STAGE(PG8_SB(1, 0), cB + kstep, voffB); PG8_STAGE(PG8_SA(1, 0), cA + kstep, voffA); PG8_STAGE(PG8_SB(1, 1), cB + hstep + kstep, voffB);
        PG8_WAIT_V(6); PG8_BAR;
    } else {
        PG8_STAGE(PG8_SB(0, 0), cB, voffB); PG8_STAGE(PG8_SA(0, 0), cA, voffA); PG8_STAGE(PG8_SB(0, 1), cB + hstep, voffB); PG8_STAGE(PG8_SA(0, 1), cA + hstep, voffA);
        if (wr == 1) PG8_BAR;
        PG8_WAIT_V(4); PG8_BAR;
        PG8_STAGE(PG8_SB(1, 0), cB + kstep, voffB); PG8_STAGE(PG8_SA(1, 0), cA + kstep, voffA); PG8_STAGE(PG8_SB(1, 1), cB + hstep + kstep, voffB);
        PG8_WAIT_V(6); PG8_BAR;
    }
    for (;;) {
        const bool has_next = S.next(ui + 1, nxt);
        const char* nA = has_next ? (const char*)g.A + (size_t)nxt.pm * tstep : cA; const char* nB = has_next ? (const char*)g.Bt + (size_t)nxt.pn * tstep : cB;
        for (int t = 0; t < nt; t += 2) {
            const bool last = (t == nt - 2);
            const char* a1 = cA + (size_t)(t + 1) * kstep;
            const char* a2 = last ? nA : cA + (size_t)(t + 2) * kstep; const char* b2 = last ? nB : cB + (size_t)(t + 2) * kstep;
            const char* a3 = a2 + kstep; const char* b3 = b2 + kstep;
            if (last && has_next) S.a_ready(nxt);
            if constexpr (SP2) {
            PG8_LDB(B0, 0, 0); PG8_LDB(B1, 0, 1); PG8_SCHED; PG8_LDA(At, 0, 0); PG8_STAGE(PG8_SA(1, 1), a1 + hstep, voffA);
            PG8_WAIT_V(8); PG8_WAIT_L(0); PG8_BAR; PG8_MMA(0, 0, At, B0); PG8_MMA(0, 1, At, B1); PG8_BAR; PG8_SCHED;
            PG8_LDA(At, 0, 1); PG8_STAGE(PG8_SB(0, 0), b2, voffB); PG8_STAGE(PG8_SB(0, 1), b2 + hstep, voffB); PG8_STAGE(PG8_SA(0, 0), a2, voffA);
            PG8_WAIT_V(8); PG8_WAIT_L(0); PG8_BAR; PG8_MMA(1, 0, At, B0); PG8_MMA(1, 1, At, B1); PG8_BAR; PG8_SCHED;
            PG8_LDB(B0, 1, 0); PG8_LDB(B1, 1, 1); PG8_SCHED; PG8_LDA(At, 1, 0); PG8_STAGE(PG8_SA(0, 1), a2 + hstep, voffA);
            PG8_WAIT_V(8); PG8_WAIT_L(0); PG8_BAR; PG8_MMA(0, 0, At, B0); PG8_MMA(0, 1, At, B1); PG8_BAR; PG8_SCHED;
            PG8_LDA(At, 1, 1); PG8_STAGE(PG8_SB(1, 0), b3, voffB); PG8_STAGE(PG8_SB(1, 1), b3 + hstep, voffB); PG8_STAGE(PG8_SA(1, 0), a3, voffA);
            PG8_WAIT_V(8); PG8_WAIT_L(0); PG8_BAR; PG8_MMA(1, 0, At, B0); PG8_MMA(1, 1, At, B1); PG8_BAR; PG8_SCHED;
            } else {
            PG8_LDB(B0, 0, 0); PG8_SCHED; PG8_LDA(At, 0, 0); PG8_STAGE(PG8_SA(1, 1), a1 + hstep, voffA);
            PG8_WAIT_L(8); PG8_BAR; PG8_WAIT_L(0); PG8_MMA(0, 0, At, B0); PG8_BAR; PG8_SCHED;
            PG8_LDB(B1, 0, 1); PG8_STAGE(PG8_SB(0, 0), b2, voffB);
            PG8_BAR; PG8_WAIT_L(0); PG8_MMA(0, 1, At, B1); PG8_BAR;
            PG8_LDA(At, 0, 1); PG8_STAGE(PG8_SA(0, 0), a2, voffA);
            PG8_BAR; PG8_WAIT_L(0); PG8_MMA(1, 0, At, B0); PG8_BAR; PG8_SCHED;
            PG8_STAGE(PG8_SB(0, 1), b2 + hstep, voffB);
            PG8_WAIT_V(6); PG8_BAR; PG8_MMA(1, 1, At, B1); PG8_BAR;
            PG8_LDB(B0, 1, 0); PG8_SCHED; PG8_LDA(At, 1, 0); PG8_STAGE(PG8_SA(0, 1), a2 + hstep, voffA);
            PG8_WAIT_L(8); PG8_BAR; PG8_WAIT_L(0); PG8_MMA(0, 0, At, B0); PG8_BAR; PG8_SCHED;
            PG8_LDB(B1, 1, 1); PG8_STAGE(PG8_SB(1, 0), b3, voffB);
            PG8_BAR; PG8_WAIT_L(0); PG8_MMA(0, 1, At, B1); PG8_BAR;
            PG8_LDA(At, 1, 1); PG8_STAGE(PG8_SA(1, 0), a3, voffA);
            PG8_BAR; PG8_WAIT_L(0); PG8_MMA(1, 0, At, B0); PG8_BAR; PG8_SCHED;
            PG8_STAGE(PG8_SB(1, 1), b3 + hstep, voffB);
            PG8_WAIT_V(6); PG8_BAR; PG8_MMA(1, 1, At, B1); PG8_BAR;
            }
        }
        if constexpr (ALIGN_EPI) { if (wr == 0) PG8_BAR; }
        if constexpr (!Epi::AFTER_DRAIN) { E(acc, cur, wr, wc, fr, fq); S.done(cur); }
        if (!has_next) break;
#pragma unroll
        for (int a = 0; a < 2; ++a)
#pragma unroll
            for (int b = 0; b < 2; ++b)
#pragma unroll
                for (int m = 0; m < 4; ++m)
#pragma unroll
                    for (int n = 0; n < 2; ++n) acc[a][b][m][n] = (f32x4){0.f, 0.f, 0.f, 0.f};
        cur = nxt; cA = nA; cB = nB; ++ui;
        if constexpr (ALIGN_EPI) { if (wr == 1) PG8_BAR; }
    }
    PG8_WAIT_V(0);
    if constexpr (!ALIGN_EPI) { if (wr == 0) PG8_BAR; }
    PG8_BAR;
    if constexpr (Epi::AFTER_DRAIN) { E.fused(acc, cur, wr, wc, fr, fq, lds, wid, lane); S.done(cur); }
#undef PG8_SA
#undef PG8_SB
#undef PG8_STAGE
#undef PG8_LDA
#undef PG8_LDB
#undef PG8_MMA
#undef PG8_WAIT_V
#undef PG8_WAIT_L
#undef PG8_BAR
#undef PG8_SCHED
}
}
#define LAS __attribute__((address_space(3)))
#define XB_TMO      128
#define XB_XCNT(j)  (256  + 64 * (j))
#define XB_XSUB(j)  (1280 + 64 * (j))
#define XB_XGEN(j)  (2304 + 64 * (j))
#define XB_TOP      3328
#define XB_TOPGEN   3392
#define XCD_BAR_WORDS 3456
#define XB_SPIN_CAP (1u << 18)

__device__ __forceinline__ unsigned xb_ld(unsigned* p)              { return __hip_atomic_load(p, __ATOMIC_RELAXED, __HIP_MEMORY_SCOPE_AGENT); }
__device__ __forceinline__ unsigned xb_add(unsigned* p, unsigned v) { return __hip_atomic_fetch_add(p, v, __ATOMIC_RELAXED, __HIP_MEMORY_SCOPE_AGENT); }
__device__ __forceinline__ unsigned xb_xcc_id() { return (unsigned)__builtin_amdgcn_s_getreg((3 << 11) | 20) & 0xFu; }
#define XB_SPIN(cond, bar) do { unsigned _sp = 0; while (cond) { __builtin_amdgcn_s_sleep(1); \
    if ((++_sp & 255u) == 0u) { if (xb_ld(&(bar)[XB_TMO])) break; if (_sp > XB_SPIN_CAP) { atomicAdd(&(bar)[XB_TMO], 1u); break; } } } } while (0)

struct XcdBarrier {
    unsigned* bar; unsigned x;
    volatile LAS unsigned* st;
};

__device__ __forceinline__ XcdBarrier xcd_barrier_post(unsigned* bar, volatile LAS unsigned* st) {
    XcdBarrier b; b.bar = bar; b.x = xb_xcc_id(); b.st = st;
    if (threadIdx.x == 0) (void)xb_add(&bar[XB_XCNT(b.x)], 1u);
    return b;
}
__device__ __forceinline__ void xcd_barrier_complete(unsigned* bar, unsigned x, unsigned& nloc, unsigned& nx) {
    const unsigned G = gridDim.x * gridDim.y * gridDim.z;
    unsigned sum, cnt, mine, sp = 0u;
    for (;;) {
        sum = 0u; cnt = 0u; mine = 0u;
#pragma unroll
        for (unsigned j = 0; j < 16; ++j) { const unsigned c = xb_ld(&bar[XB_XCNT(j)]); sum += c; cnt += (c > 0u) ? 1u : 0u; mine = (j == x) ? c : mine; }
        if (sum == G) break;
        __builtin_amdgcn_s_sleep(1);
        if ((++sp & 255u) == 0u) { if (xb_ld(&bar[XB_TMO])) break; if (sp > XB_SPIN_CAP) { atomicAdd(&bar[XB_TMO], 1u); break; } }
    }
    nloc = mine > 0u ? mine : 1u; nx = cnt > 0u ? cnt : 1u;
}

__device__ __forceinline__ void xcd_barrier(const XcdBarrier& b) {
    asm volatile("s_waitcnt vmcnt(0)" ::: "memory");
    __syncthreads();
    if (threadIdx.x == 0) {
        unsigned* bar = b.bar;
        __builtin_amdgcn_s_waitcnt(0);
        unsigned nloc = b.st[0], nx = b.st[1];
        if (nloc == 0u) { xcd_barrier_complete(bar, b.x, nloc, nx); b.st[0] = nloc; b.st[1] = nx; }
        const unsigned old = xb_add(&bar[XB_XSUB(b.x)], 1u);
        const unsigned gen = old / nloc;
        if (old + 1u == (gen + 1u) * nloc) {
            __builtin_amdgcn_fence(__ATOMIC_RELEASE, "agent");
            asm volatile("s_waitcnt vmcnt(0)" ::: "memory");
            const unsigned og = xb_add(&bar[XB_TOP], 1u);
            const unsigned tg = og / nx;
            if (og + 1u == (tg + 1u) * nx) xb_add(&bar[XB_TOPGEN], 1u);
            else XB_SPIN(xb_ld(&bar[XB_TOPGEN]) == tg, bar);
            __builtin_amdgcn_fence(__ATOMIC_ACQUIRE, "agent");
            xb_add(&bar[XB_XGEN(b.x)], 1u);
            asm volatile("s_waitcnt vmcnt(0)" ::: "memory");
        } else {
            XB_SPIN(xb_ld(&bar[XB_XGEN(b.x)]) == gen, bar);
            __builtin_amdgcn_fence(__ATOMIC_ACQUIRE, "agent");
            asm volatile("s_waitcnt vmcnt(0)" ::: "memory");
        }
    }
    __syncthreads();
}
#undef LAS
#ifndef RET_MODE
#define RET_MODE 1
#endif
#ifndef NSA_INLINE
#define NSA_INLINE __forceinline__
#endif
#ifndef PROBE_DUP
#define PROBE_DUP 0
#endif
#ifndef DBG_BRUTE
#define DBG_BRUTE 0
#endif
#ifndef DBG_ZERO
#define DBG_ZERO 0
#endif
constexpr int NWAVES = 8;
constexpr int NB = 16, SEQ = 2048, DM = 1024, MTOK = NB * SEQ, FF = 2816, NMEMT = 256, MMEM = NB * NMEMT, DEPTH = 4;
constexpr float EPS = 1e-6f;
constexpr float QSCALE = 0.125f * 1.4426950408889634f;
constexpr int RET_LD = 2560, RET_Q = 0, RET_K = 384, RET_V = 768, RET_G = 1536, RET_QM = 2304;
constexpr int DSA_LD = 1792, DSA_Q = 0, DSA_K = 768, DSA_V = 832, DSA_IQ = 896, DSA_IK = 1408, DSA_IW = 1472, DSA_QM = 1480, DSA_COLS = 1736;
constexpr int NSA_LD = 2816, NSA_Q = 0, NSA_KC = 768, NSA_VC = 1024, NSA_KS = 1280, NSA_VS = 1536, NSA_KW = 1792, NSA_VW = 2048, NSA_QM = 2304, NSA_GT = 2560;
constexpr int NSA_SRC_GT = 2304, NSA_SRC_QM = 2340, NSA_COLS = 2596;

constexpr size_t MiB = 1u << 20;
constexpr size_t WS_CTL = 0, CTL_ZERO_BYTES = 1 * MiB;
constexpr size_t WS_PART = 1 * MiB;
constexpr size_t WS_PARTM = 3 * MiB;
constexpr size_t WS_ROPE = 3 * MiB + 512 * 1024;
constexpr size_t WS_MISC = 4 * MiB;
constexpr size_t WS_CMPW = 4 * MiB + 64 * 1024;
constexpr size_t WS_KCMP = 5 * MiB;
constexpr size_t WS_VCMPT = 6 * MiB;
constexpr size_t WS_MK = 7 * MiB;
constexpr size_t WS_MVT = 15 * MiB;
constexpr size_t WS_MEMB = 23 * MiB;
constexpr size_t WS_MKV = 31 * MiB;
constexpr size_t WS_WKV = 47 * MiB;
constexpr size_t WS_WBUF0 = 51 * MiB, WBUF_BYTES = 41 * MiB;
constexpr size_t WS_XB = 133 * MiB;
constexpr size_t WS_Y = 197 * MiB;
constexpr size_t WS_HID = 261 * MiB;
constexpr size_t WS_SC = 373 * MiB;
constexpr size_t WS_MB = 501 * MiB;
constexpr size_t WS_END = 509 * MiB;
static_assert(WS_HID + (size_t)MTOK * FF * 2 <= WS_MB && WS_SC + (size_t)MTOK * SEQ * 2 <= WS_MB && WS_WBUF0 + 2 * WBUF_BYTES <= WS_XB, "d_ws map");
constexpr size_t WB_W1A = 0, WB_W2A = WB_W1A + (size_t)2 * FF * DM, WB_W1B = WB_W2A + (size_t)DM * FF, WB_W2B = WB_W1B + (size_t)2 * FF * DM,
                 WB_WIN = WB_W2B + (size_t)DM * FF, WB_WO = WB_WIN + (size_t)NSA_LD * DM, WB_END = WB_WO + (size_t)DM * DM;
static_assert(WB_END * 2 <= WBUF_BYTES, "weight buffer");
constexpr int CW_BAR = 4096;
constexpr int CW_CK = 32768;
constexpr int CW_Q = 16384;

#define GAS __attribute__((address_space(1)))
#define LAS __attribute__((address_space(3)))
typedef unsigned short bf16;
typedef unsigned v4u __attribute__((ext_vector_type(4)));
typedef unsigned v2u __attribute__((ext_vector_type(2)));
typedef float f32x4 __attribute__((ext_vector_type(4)));
typedef float f32x16 __attribute__((ext_vector_type(16)));
typedef short bf16x8 __attribute__((ext_vector_type(8)));
typedef GAS unsigned gu32;
#define RLX_AGENT __ATOMIC_RELAXED, __HIP_MEMORY_SCOPE_AGENT
#define LDS_WAIT() asm volatile("s_waitcnt lgkmcnt(0)" ::: "memory")
#define VM_WAIT() asm volatile("s_waitcnt vmcnt(0)" ::: "memory")
__device__ __forceinline__ unsigned f2bf(float f) { unsigned u = __builtin_bit_cast(unsigned, f); return (u + 0x7fffu + ((u >> 16) & 1u)) >> 16; }
__device__ __forceinline__ unsigned pk2(float lo, float hi) { return pg8::cvt_pk_bf16(lo, hi); }
__device__ __forceinline__ float bf2f(unsigned h) { return __builtin_bit_cast(float, h << 16); }
__device__ __forceinline__ float bflo(unsigned w) { return __builtin_bit_cast(float, w << 16); }
__device__ __forceinline__ float bfhi(unsigned w) { return __builtin_bit_cast(float, w & 0xffff0000u); }
struct Args { const float* in[23]; float* out; unsigned char* ws; int ph_lo, ph_hi, dry, pad; };
typedef const __attribute__((address_space(4))) Args* KArgs;
struct Frame {
    LAS unsigned char* lds;
    volatile LAS unsigned* MISC;
    gu32* ctl;
    int tid, lane, wave, G, gw, NGW;
    unsigned char* ws;
    KArgs ka;
    float* out;
};
__device__ __forceinline__ float wave_sum(float v) {
#pragma unroll
    for (int o = 1; o < 64; o <<= 1) v += __shfl_xor(v, o);
    return v;
}
__device__ __forceinline__ float wave_max(float v) {
#pragma unroll
    for (int o = 1; o < 64; o <<= 1) v = fmaxf(v, __shfl_xor(v, o));
    return v;
}
__device__ __forceinline__ int grab(gu32* ctr, int lane) { unsigned v = 0; if (lane == 0) v = __hip_atomic_fetch_add(ctr, 1u, RLX_AGENT); return __builtin_amdgcn_readfirstlane((int)v); }

__device__ __forceinline__ void cvt_item(const float* W, int ldw, const float* gain, bf16* WT, int K, LAS float* scr, int k0, int src_col0, int nvalid, int dst_row0, int lane) {
    const int c = lane & 31;
#pragma unroll 8
    for (int i = 0; i < 32; ++i) { const int kk = 2 * i + (lane >> 5); float v = 0.f;
        if (c < nvalid) { v = W[(size_t)(k0 + kk) * ldw + src_col0 + c]; if (gain) v *= gain[k0 + kk]; }
        scr[kk * 33 + c] = v; }
    LDS_WAIT(); asm volatile("" ::: "memory");
    const int c8 = lane & 7;
#pragma unroll
    for (int j = 0; j < 4; ++j) { const int n = (lane >> 3) + 8 * j; const LAS float* s = scr + (8 * c8) * 33 + n;
        v4u o; o.x = pk2(s[0 * 33], s[1 * 33]); o.y = pk2(s[2 * 33], s[3 * 33]); o.z = pk2(s[4 * 33], s[5 * 33]); o.w = pk2(s[6 * 33], s[7 * 33]);
        *(GAS v4u*)(WT + (size_t)(dst_row0 + n) * K + k0 + 8 * c8) = o; }
    LDS_WAIT(); asm volatile("" ::: "memory");
}
__device__ __forceinline__ void cvt_matrix(Frame& F, int& it_base, const float* W, const float* W2, int ldw, int ncols, const float* gain, bf16* WT, int K, int nrows_dst, int kind) {
    LAS float* scr = (LAS float*)(F.lds + F.wave * 16384);
    const int nkb = K / 64, njb = nrows_dst / 32, nitems = nkb * njb;
    int first = (F.gw - it_base % F.NGW + F.NGW) % F.NGW;
    for (int i = first; i < nitems; i += F.NGW) {
        const int kb = i / njb, jb = i % njb; const float* src = W; int sc0 = jb * 32, nv = 32;
        if (kind == 0) { nv = ncols - sc0; nv = nv < 0 ? 0 : (nv > 32 ? 32 : nv); }
        else if (kind == 1) { const int c = jb * 32, pn = c >> 8, bj = (c >> 7) & 1, j = c & 127; src = bj ? W2 : W; sc0 = pn * 128 + j; }
        else { const int c = jb * 32;
            if (c < NSA_QM) { sc0 = c; }
            else if (c < NSA_GT) { sc0 = NSA_SRC_QM + (c - NSA_QM); }
            else { sc0 = NSA_SRC_GT + (c - NSA_GT); nv = NSA_SRC_QM - sc0; nv = nv < 0 ? 0 : (nv > 32 ? 32 : nv); } }
        cvt_item(src, ldw, gain, WT, K, scr, kb * 64, sc0, nv, jb * 32, F.lane);
    }
    it_base += nitems;
}
__device__ __forceinline__ void convert_layer(Frame& F, int Ly) {
    bf16* WB = (bf16*)(F.ws + WS_WBUF0 + (size_t)(Ly & 1) * WBUF_BYTES);
    const float* fnorm = F.ka->in[2]; const float* wg = F.ka->in[3]; const float* wu = F.ka->in[4]; const float* wd = F.ka->in[5];
    int itb = 0;
#pragma unroll 1
    for (int hf = 0; hf < 2; ++hf) {
        const size_t o1 = (size_t)(Ly * 2 + hf) * DM * FF;
        cvt_matrix(F, itb, wg + o1, wu + o1, FF, FF, fnorm + (size_t)(Ly * 2 + hf) * DM, WB + (hf ? WB_W1B : WB_W1A), DM, 2 * FF, 1);
        cvt_matrix(F, itb, wd + o1, nullptr, DM, DM, nullptr, WB + (hf ? WB_W2B : WB_W2A), FF, DM, 0);
    }
    const float* mnorm = F.ka->in[6] + (size_t)Ly * DM;
    const int kind = Ly % 3, j = Ly / 3;
    if (kind == 0) cvt_matrix(F, itb, F.ka->in[12] + (size_t)j * DM * RET_LD, nullptr, RET_LD, RET_LD, mnorm, WB + WB_WIN, DM, RET_LD, 0);
    else if (kind == 1) cvt_matrix(F, itb, F.ka->in[13] + (size_t)j * DM * DSA_COLS, nullptr, DSA_COLS, DSA_COLS, mnorm, WB + WB_WIN, DM, DSA_LD, 0);
    else cvt_matrix(F, itb, F.ka->in[16] + (size_t)j * DM * NSA_COLS, nullptr, NSA_COLS, NSA_COLS, mnorm, WB + WB_WIN, DM, NSA_LD, 2);
    cvt_matrix(F, itb, F.ka->in[7] + (size_t)Ly * DM * DM, nullptr, DM, DM, nullptr, WB + WB_WO, DM, DM, 0);
}

__device__ __forceinline__ void xform(Frame& F, const bf16* src, int spitch, int scol0, int nheads, int rows, int Lr, bf16* dst, int dmode, int dpitch, int dcol0,
                                      const float* gain, bool rope, float cscale, int decay  ) {
    const float* tab = (const float*)(F.ws + WS_ROPE);
    const int i8 = F.lane & 7, sub = F.lane >> 3; const int items = rows * nheads;
    float gn[8];
#pragma unroll
    for (int j = 0; j < 8; ++j) gn[j] = gain ? gain[8 * i8 + j] : 1.f;
    constexpr int U = 4;
    for (int it0 = F.gw * (8 * U); it0 < items; it0 += F.NGW * (8 * U)) {
        v4u raw[U]; f32x4 c0[U], c1[U], s0[U], s1[U];
#pragma unroll
        for (int u = 0; u < U; ++u) { const int it = it0 + 8 * u + sub; const int row = it / nheads, h = it % nheads, t = row % Lr;
            raw[u] = *(const GAS v4u*)(src + (size_t)row * spitch + scol0 + h * 64 + 8 * i8);
            if (rope) { const float* tr = tab + (size_t)t * 64 + 8 * (i8 & 3);
                c0[u] = *(const GAS f32x4*)(tr); c1[u] = *(const GAS f32x4*)(tr + 4); s0[u] = *(const GAS f32x4*)(tr + 32); s1[u] = *(const GAS f32x4*)(tr + 36); } }
#pragma unroll
        for (int u = 0; u < U; ++u) { const int it = it0 + 8 * u + sub; const int row = it / nheads, h = it % nheads, t = row % Lr;
            float v[8] = {bflo(raw[u].x), bfhi(raw[u].x), bflo(raw[u].y), bfhi(raw[u].y), bflo(raw[u].z), bfhi(raw[u].z), bflo(raw[u].w), bfhi(raw[u].w)};
            if (gain) { float ss = 0.f;
#pragma unroll
                for (int j = 0; j < 8; ++j) ss += v[j] * v[j];
                ss += __shfl_xor(ss, 1); ss += __shfl_xor(ss, 2); ss += __shfl_xor(ss, 4);
                const float r = __builtin_amdgcn_rsqf(ss * (1.f / 64.f) + EPS);
#pragma unroll
                for (int j = 0; j < 8; ++j) v[j] = v[j] * r * gn[j]; }
            if (rope) {
                const float cs[8] = {c0[u][0], c0[u][1], c0[u][2], c0[u][3], c1[u][0], c1[u][1], c1[u][2], c1[u][3]}, sn[8] = {s0[u][0], s0[u][1], s0[u][2], s0[u][3], s1[u][0], s1[u][1], s1[u][2], s1[u][3]};
#pragma unroll
                for (int j = 0; j < 8; ++j) { const float p = __shfl_xor(v[j], 4); v[j] = (i8 < 4) ? (v[j] * cs[j] - p * sn[j]) : (v[j] * cs[j] + p * sn[j]); } }
            float f = cscale;
            if (decay) { const float lg = __builtin_amdgcn_logf(1.0f - __builtin_amdgcn_exp2f(-5.0f - (float)h)); f *= __builtin_amdgcn_exp2f((float)(decay * t) * lg); }
            v4u o; o.x = pk2(v[0] * f, v[1] * f); o.y = pk2(v[2] * f, v[3] * f); o.z = pk2(v[4] * f, v[5] * f); o.w = pk2(v[6] * f, v[7] * f);
            bf16* dp = dmode == 0 ? dst + (size_t)row * dpitch + dcol0 + h * 64 + 8 * i8 : dst + ((size_t)((row / Lr) * nheads + h) * Lr + t) * 64 + 8 * i8;
            *(GAS v4u*)dp = o; }
    }
}
__device__ __forceinline__ void transpose_cols(Frame& F, const bf16* src, int spitch, int scol0, int ncols, int nb, int Lr, bf16* dst) {
    LAS bf16* scr = (LAS bf16*)(F.lds + F.wave * 16384);
    const int ntt = Lr / 64, nct = ncols / 64, ntiles = nb * ntt * nct; const int i8 = F.lane & 7, sub = F.lane >> 3;
    for (int tl = F.gw; tl < ntiles; tl += F.NGW) {
        const int ct = tl % nct, tt = (tl / nct) % ntt, b = tl / (nct * ntt); const int t0 = tt * 64, c0 = ct * 64;
#pragma unroll
        for (int k = 0; k < 8; ++k) { const int r = sub + 8 * k;
            const v4u raw = *(const GAS v4u*)(src + (size_t)(b * Lr + t0 + r) * spitch + scol0 + c0 + 8 * i8);
            *(LAS v4u*)(scr + r * 72 + 8 * i8) = raw; }
        LDS_WAIT(); asm volatile("" ::: "memory");
        bf16* drow = dst + ((size_t)b * ncols + c0 + F.lane) * Lr + t0;
#pragma unroll
        for (int k = 0; k < 8; ++k) { unsigned w[4];
#pragma unroll
            for (int q = 0; q < 4; ++q) { const unsigned lo = scr[(8 * k + 2 * q) * 72 + F.lane], hi = scr[(8 * k + 2 * q + 1) * 72 + F.lane]; w[q] = lo | (hi << 16); }
            v4u o; o.x = w[0]; o.y = w[1]; o.z = w[2]; o.w = w[3]; *(GAS v4u*)(drow + 8 * k) = o; }
        LDS_WAIT(); asm volatile("" ::: "memory");
    }
}
__device__ __forceinline__ void row_to_bf16(Frame& F, const float* xrow, bf16* orow, float* part) {
    const GAS f32x4* xr = (const GAS f32x4*)xrow + F.lane;
    f32x4 v[4]; float s = 0.f;
#pragma unroll
    for (int j = 0; j < 4; ++j) { v[j] = xr[64 * j]; s += (v[j].x * v[j].x + v[j].y * v[j].y) + (v[j].z * v[j].z + v[j].w * v[j].w); }
    s = wave_sum(s);
    GAS v2u* o8 = (GAS v2u*)orow + F.lane;
#pragma unroll
    for (int j = 0; j < 4; ++j) { v2u o; o.x = pk2(v[j].x, v[j].y); o.y = pk2(v[j].z, v[j].w); o8[64 * j] = o; }
    if (F.lane < 16) part[F.lane] = F.lane == 0 ? s : 0.f;
}
enum { MK_NONE = 0, MK_CAUSAL = 1, MK_WIN = 2, MK_BITS = 3, MK_SLC = 4, MK_CMP = 5 };
struct KVp { const bf16* K; int kpitch; const bf16* VT; int vpitch; };
struct MaskArg { int q0[3]; const unsigned* mb; unsigned sel; int nmax; float lg; };
__device__ __forceinline__ bf16x8 ld8(const bf16* p) { return *(const GAS bf16x8*)p; }
__device__ __forceinline__ float fast_exp2(float x) { return __builtin_amdgcn_exp2f(x); }

template <int NS, int NT, int MODE, int MT, int PF = 2>
__device__ __forceinline__ void attn_core(const LAS bf16x8* ql, const KVp kv, int kt0, int kt1, float negb, const MaskArg& ma, const unsigned* const (&mbrow)[NS],
                                          f32x16 (&O)[NS][NT], float (&lsum)[NS], int lane) {
    const int r32 = lane & 31, hi = lane >> 5;
    const int kperm = (r32 & 0x13) | ((r32 & 4) << 1) | ((r32 & 8) >> 1);
    const bf16* kp = kv.K + (size_t)kperm * kv.kpitch + 8 * hi;
    const bf16* vp = kv.VT + (size_t)r32 * kv.vpitch + 8 * hi;
    bf16x8 kf[4], vf[2][NT], kfn[4], vfn[2][NT];
#define AC_LOADK(dst, kt_) do { const bf16* kq_ = kp + (size_t)(32 * (kt_)) * kv.kpitch; _Pragma("unroll") for (int ks = 0; ks < 4; ++ks) dst[ks] = ld8(kq_ + 16 * ks); } while (0)
#define AC_LOADV(dst, kt_) do { _Pragma("unroll") for (int nt = 0; nt < NT; ++nt) { const bf16* vq_ = vp + (size_t)(32 * nt) * kv.vpitch + 32 * (kt_); dst[0][nt] = ld8(vq_); dst[1][nt] = ld8(vq_ + 16); } } while (0)
    if (kt0 < kt1) { if (PF >= 1) AC_LOADK(kf, kt0); if (PF >= 2) AC_LOADV(vf, kt0); }
#pragma unroll 1
    for (int kt = kt0; kt < kt1; ++kt) {
        unsigned selbit = 1u; bool active = true;
        if (MT == MK_SLC) { selbit = (ma.sel >> (kt >> 1)) & 1u; active = __any(selbit != 0u); }
        const int ktn = (kt + 1 < kt1) ? kt + 1 : kt;
        if (PF == 0) { if (active) { AC_LOADK(kf, kt); AC_LOADV(vf, kt); } }
        else { AC_LOADK(kfn, ktn); if (PF >= 2) AC_LOADV(vfn, ktn); else if (active) AC_LOADV(vf, kt); }
        if (active) {
        const LAS bf16x8* qlp = ql; asm volatile("" : "+v"(qlp));
#pragma unroll
        for (int s = 0; s < NS; ++s) {
            f32x16 acc;
#pragma unroll
            for (int r = 0; r < 16; ++r) acc[r] = 0.f;
#pragma unroll
            for (int ks = 0; ks < 4; ++ks) acc = __builtin_amdgcn_mfma_f32_32x32x16_bf16(kf[ks], qlp[(s * 4 + ks) * 64], acc, 0, 0, 0);
            const int tq = ma.q0[s] + r32, kb = 32 * kt + 8 * hi;
            bool full = true;
            if (MT == MK_CAUSAL) full = (32 * kt + 31 <= ma.q0[s]);
            if (MT == MK_WIN) full = (32 * kt + 31 <= ma.q0[s]) && (32 * kt >= ma.q0[s] + 31 - 511);
            if (MT == MK_SLC) full = (32 * kt + 31 <= ma.q0[s]) && __all(selbit != 0u);
            if (MT == MK_BITS || MT == MK_CMP) full = false;
            float p[16];
            if (full) {
#pragma unroll
                for (int r = 0; r < 16; ++r) { const int key = kb + 16 * (r >> 3) + (r & 7); p[r] = MODE == 0 ? fast_exp2(acc[r]) : (MODE == 1 ? acc[r] : acc[r] * fast_exp2((float)(tq - key) * ma.lg)); }
            } else {
                unsigned w = 0;
                if (MT == MK_BITS) w = mbrow[s][kt];
#pragma unroll
                for (int r = 0; r < 16; ++r) { const int key = kb + 16 * (r >> 3) + (r & 7); bool v = true;
                    if (MT == MK_CAUSAL) v = key <= tq;
                    if (MT == MK_WIN) v = (key <= tq) && (key >= tq - 511);
                    if (MT == MK_SLC) v = (key <= tq) && (selbit != 0u);
                    if (MT == MK_BITS) v = (w >> (8 * hi + 16 * (r >> 3) + (r & 7))) & 1u;
                    if (MT == MK_CMP) v = key <= ma.nmax;
                    const float e = MODE == 0 ? fast_exp2(acc[r]) : (MODE == 1 ? acc[r] : acc[r] * fast_exp2((float)((tq - key) < 0 ? 0 : (tq - key)) * ma.lg));
                    p[r] = v ? e : 0.f; }
            }
            if (MODE == 0) { float a = 0.f;
#pragma unroll
                for (int r = 0; r < 16; ++r) a += p[r];
                lsum[s] += a; }
            bf16x8 pk0, pk1;
            { v4u t0, t1; t0.x = pk2(p[0], p[1]); t0.y = pk2(p[2], p[3]); t0.z = pk2(p[4], p[5]); t0.w = pk2(p[6], p[7]);
              t1.x = pk2(p[8], p[9]); t1.y = pk2(p[10], p[11]); t1.z = pk2(p[12], p[13]); t1.w = pk2(p[14], p[15]);
              pk0 = __builtin_bit_cast(bf16x8, t0); pk1 = __builtin_bit_cast(bf16x8, t1); }
#pragma unroll
            for (int nt = 0; nt < NT; ++nt) { O[s][nt] = __builtin_amdgcn_mfma_f32_32x32x16_bf16(pk0, vf[0][nt], O[s][nt], 0, 0, 0);
                                              O[s][nt] = __builtin_amdgcn_mfma_f32_32x32x16_bf16(pk1, vf[1][nt], O[s][nt], 0, 0, 0); }
            if (NS >= 3) __builtin_amdgcn_sched_barrier(0);
        }
        }
        if (PF >= 1) {
#pragma unroll
            for (int ks = 0; ks < 4; ++ks) kf[ks] = kfn[ks];
            if (PF >= 2) {
#pragma unroll
                for (int nt = 0; nt < NT; ++nt) { vf[0][nt] = vfn[0][nt]; vf[1][nt] = vfn[1][nt]; } }
        }
    }
#undef AC_LOADK
#undef AC_LOADV
}
__device__ __forceinline__ int crow(int r, int hi) { return (r & 3) + 8 * (r >> 2) + 4 * hi; }
template <int NT, bool ADD>
__device__ __forceinline__ void store_o(const f32x16 (&O)[NT], float f, bf16* Y, int row0, int col0, int lane) {
    const int r32 = lane & 31, hi = lane >> 5;
    unsigned ybase = (unsigned)((row0 + 4 * hi) * 1024 + col0 + r32); asm volatile("" : "+v"(ybase));
#pragma unroll
    for (int rh = 0; rh < 2; ++rh) {
        unsigned short old[NT][8];
        if (ADD) {
#pragma unroll
            for (int ri = 0; ri < 8; ++ri)
#pragma unroll
                for (int nt = 0; nt < NT; ++nt) { const int r = 8 * rh + ri; old[nt][ri] = Y[ybase + (unsigned)(((r & 3) + 8 * (r >> 2)) * 1024) + 32 * nt]; }
        }
#pragma unroll
        for (int ri = 0; ri < 8; ++ri) { const int r = 8 * rh + ri; const int q = crow(r, hi); const float fr = __shfl(f, q);
            const unsigned yo = ybase + (unsigned)(((r & 3) + 8 * (r >> 2)) * 1024);
#pragma unroll
            for (int nt = 0; nt < NT; ++nt) { float v = O[nt][r] * fr; if (ADD) v += bf2f(old[nt][ri]); Y[yo + 32 * nt] = (bf16)f2bf(v); } }
    }
}
template <int NS> __device__ __forceinline__ void stage_q(LAS bf16x8* ql, const bf16* const (&qrow)[NS], int lane) {
    const int hi = lane >> 5;
#pragma unroll
    for (int s = 0; s < NS; ++s)
#pragma unroll
        for (int ks = 0; ks < 4; ++ks) ql[(s * 4 + ks) * 64] = ld8(qrow[s] + 16 * ks + 8 * hi);
    LDS_WAIT(); asm volatile("" ::: "memory");
}
__device__ __forceinline__ LAS bf16x8* wave_q(Frame& F) { return (LAS bf16x8*)(F.lds + F.wave * 16384) + F.lane; }
template <int NS, int NT> __device__ __forceinline__ void zero_o(f32x16 (&O)[NS][NT], float (&l)[NS]) {
#pragma unroll
    for (int s = 0; s < NS; ++s) { l[s] = 0.f;
#pragma unroll
        for (int nt = 0; nt < NT; ++nt)
#pragma unroll
            for (int r = 0; r < 16; ++r) O[s][nt][r] = 0.f; }
}

__device__ __forceinline__ void mem_task(Frame& F, int task, int Ly, const bf16* PROJ, int ldp, int qmcol) {
    const int qb = task & 31, h = (task >> 5) & 3, b = task >> 7; const int r32 = F.lane & 31;
    const int row0 = b * SEQ + 64 * qb;
    const bf16* qrow[2] = {PROJ + (size_t)(row0 + r32) * ldp + qmcol + h * 64, PROJ + (size_t)(row0 + 32 + r32) * ldp + qmcol + h * 64};
    LAS bf16x8* ql = wave_q(F); stage_q<2>(ql, qrow, F.lane);
    KVp kv{(const bf16*)(F.ws + WS_MK) + ((size_t)((Ly * NB + b) * 4 + h) * NMEMT) * 64, 64, (const bf16*)(F.ws + WS_MVT) + ((size_t)(Ly * NB + b) * 256 + h * 64) * NMEMT, NMEMT};
    f32x16 O[2][2]; float l[2]; zero_o<2, 2>(O, l);
    MaskArg ma{}; const unsigned* mbr[2] = {nullptr, nullptr};
    const float negb = 0.f;
    attn_core<2, 2, 0, MK_NONE>(ql, kv, 0, NMEMT / 32, negb, ma, mbr, O, l, F.lane);
    bf16* Y = (bf16*)(F.ws + WS_Y);
#pragma unroll
    for (int s = 0; s < 2; ++s) { const float lt = l[s] + __shfl_xor(l[s], 32); store_o<2, false>(O[s], (DBG_ZERO & 8) ? 0.f : 1.f / lt, Y, row0 + 32 * s, 768 + h * 64, F.lane); }
}
__device__ __forceinline__ void ret_task(Frame& F, int task, const bf16* PROJ) {
    const int qb = 31 - (task & 31), h = (task >> 5) % 6, b = (task >> 5) / 6; const int r32 = F.lane & 31, hi = F.lane >> 5;
    const int row0 = b * SEQ + 64 * qb;
    const bf16* qrow[2] = {PROJ + (size_t)(row0 + r32) * RET_LD + RET_Q + h * 64, PROJ + (size_t)(row0 + 32 + r32) * RET_LD + RET_Q + h * 64};
    LAS bf16x8* ql = wave_q(F); stage_q<2>(ql, qrow, F.lane);
    KVp kv{PROJ + (size_t)(b * SEQ) * RET_LD + RET_K + h * 64, RET_LD, (const bf16*)F.out + ((size_t)b * 768 + h * 128) * SEQ, SEQ};
    f32x16 O[2][4]; float l[2]; zero_o<2, 4>(O, l);
    MaskArg ma{}; ma.q0[0] = 64 * qb; ma.q0[1] = 64 * qb + 32; const unsigned* mbr[2] = {nullptr, nullptr};
    ma.lg = __builtin_amdgcn_logf(1.0f - __builtin_amdgcn_exp2f(-5.0f - (float)h));
    attn_core<2, 4, RET_MODE, MK_CAUSAL, 1>(ql, kv, 0, 2 * qb + 2, 0.f, ma, mbr, O, l, F.lane);
    bf16* Y = (bf16*)(F.ws + WS_Y);
#pragma unroll
    for (int s = 0; s < 2; ++s)
#pragma unroll
        for (int rh = 0; rh < 2; ++rh) {
            unsigned short gv[8][4];
#pragma unroll
            for (int ri = 0; ri < 8; ++ri) { const int r = 8 * rh + ri; const bf16* gp = PROJ + (size_t)(row0 + 32 * s + crow(r, hi)) * RET_LD + RET_G + h * 128 + r32;
#pragma unroll
                for (int nt = 0; nt < 4; ++nt) gv[ri][nt] = gp[32 * nt]; }
#pragma unroll
            for (int ri = 0; ri < 8; ++ri) { const int r = 8 * rh + ri;
                float a = (O[s][0][r] + O[s][1][r]) + (O[s][2][r] + O[s][3][r]);
#pragma unroll
                for (int o = 1; o < 32; o <<= 1) a += __shfl_xor(a, o);
                const float mu = a * (1.f / 128.f);
                float d0 = O[s][0][r] - mu, d1 = O[s][1][r] - mu, d2 = O[s][2][r] - mu, d3 = O[s][3][r] - mu;
                float q = (d0 * d0 + d1 * d1) + (d2 * d2 + d3 * d3);
#pragma unroll
                for (int o = 1; o < 32; o <<= 1) q += __shfl_xor(q, o);
                const float rstd = __builtin_amdgcn_rsqf(q * (1.f / 128.f) + EPS);
                const int row = row0 + 32 * s + crow(r, hi);
                bf16* yp = Y + (size_t)row * 1024 + h * 128 + r32;
                const float dd[4] = {d0, d1, d2, d3};
#pragma unroll
                for (int nt = 0; nt < 4; ++nt) { const float g = bf2f(gv[ri][nt]); const float sg = g * __builtin_amdgcn_rcpf(1.f + fast_exp2(-1.4426950408889634f * g));
                    yp[32 * nt] = (DBG_ZERO & 1) ? (bf16)0 : (bf16)f2bf(sg * dd[nt] * rstd); }
            }
        }
}

typedef _Float16 h2_t __attribute__((ext_vector_type(2)));
__device__ __forceinline__ unsigned pkh(float a, float b) { h2_t v = {(_Float16)a, (_Float16)b}; return __builtin_bit_cast(unsigned, v); }
__device__ __forceinline__ void dsa_d1_task(Frame& F, int task, const bf16* PROJ) {
    const int b = task / 288; int rem = task % 288; int qb = 63, kc = 0;
    { int grp = 7; while (rem >= 8 * (grp + 1)) { rem -= 8 * (grp + 1); --grp; }
      qb = 8 * grp + 7 - rem / (grp + 1); kc = rem % (grp + 1); }
    const int r32 = F.lane & 31, hi = F.lane >> 5; const int row = b * SEQ + 32 * qb + r32;
    const bf16* qp = PROJ + (size_t)row * DSA_LD + DSA_IQ + 8 * hi;
    bf16x8 qf[4][4]; LAS bf16x8* ql = wave_q(F);
#pragma unroll
    for (int h = 0; h < 4; ++h)
#pragma unroll
        for (int ks = 0; ks < 4; ++ks) { qf[h][ks] = ld8(qp + h * 64 + 16 * ks); ql[(h * 4 + ks) * 64] = ld8(qp + (4 + h) * 64 + 16 * ks); }
    LDS_WAIT(); asm volatile("" ::: "memory");
    float iw[8];
    { const v4u w = *(const GAS v4u*)(PROJ + (size_t)row * DSA_LD + DSA_IW); iw[0] = bflo(w.x); iw[1] = bfhi(w.x); iw[2] = bflo(w.y); iw[3] = bfhi(w.y); iw[4] = bflo(w.z); iw[5] = bfhi(w.z); iw[6] = bflo(w.w); iw[7] = bfhi(w.w); }
    const int kperm = (r32 & 0x13) | ((r32 & 4) << 1) | ((r32 & 8) >> 1);
    const bf16* kp = PROJ + (size_t)(b * SEQ + kperm) * DSA_LD + DSA_IK + 8 * hi;
    _Float16* sc = (_Float16*)(F.ws + WS_SC) + (size_t)row * SEQ + 8 * hi;
    const int kt1 = (8 * kc + 8 < qb + 1) ? 8 * kc + 8 : qb + 1;
#pragma unroll 1
    for (int kt = 8 * kc; kt < kt1; ++kt) {
        bf16x8 kf[4];
#pragma unroll
        for (int ks = 0; ks < 4; ++ks) kf[ks] = ld8(kp + (size_t)(32 * kt) * DSA_LD + 16 * ks);
        float s[16];
#pragma unroll
        for (int r = 0; r < 16; ++r) s[r] = 0.f;
#pragma unroll
        for (int h = 0; h < 8; ++h) { f32x16 acc;
#pragma unroll
            for (int r = 0; r < 16; ++r) acc[r] = 0.f;
#pragma unroll
            for (int ks = 0; ks < 4; ++ks) acc = __builtin_amdgcn_mfma_f32_32x32x16_bf16(kf[ks], h < 4 ? qf[h & 3][ks] : ql[((h & 3) * 4 + ks) * 64], acc, 0, 0, 0);
#pragma unroll
            for (int r = 0; r < 16; ++r) s[r] += iw[h] * fmaxf(acc[r], 0.f);
            __builtin_amdgcn_sched_barrier(0); }
        v4u o0, o1; o0.x = pkh(s[0], s[1]); o0.y = pkh(s[2], s[3]); o0.z = pkh(s[4], s[5]); o0.w = pkh(s[6], s[7]);
        o1.x = pkh(s[8], s[9]); o1.y = pkh(s[10], s[11]); o1.z = pkh(s[12], s[13]); o1.w = pkh(s[14], s[15]);
        *(GAS v4u*)(sc + 32 * kt) = o0; *(GAS v4u*)(sc + 32 * kt + 16) = o1;
    }
}
__device__ __forceinline__ void dsa_d2_row(Frame& F, int row) {
    const int t = row % SEQ, lane = F.lane;
    unsigned* mbp = (unsigned*)(F.ws + WS_MB) + (size_t)row * 64;
    int nvalid = t + 1 - 32 * lane; nvalid = nvalid < 0 ? 0 : (nvalid > 32 ? 32 : nvalid);
    const unsigned cb = nvalid == 32 ? 0xffffffffu : ((1u << nvalid) - 1u);
    if (t < 256) { mbp[lane] = cb; return; }
    unsigned key[32];
    { const unsigned short* sp = (const unsigned short*)(F.ws + WS_SC) + (size_t)row * SEQ + 32 * lane;
      v4u raw[4];
#pragma unroll
      for (int i = 0; i < 4; ++i) raw[i] = nvalid > 0 ? *(const GAS v4u*)(sp + 8 * i) : (v4u){0u, 0u, 0u, 0u};
#pragma unroll
      for (int i = 0; i < 4; ++i) { const unsigned w[4] = {raw[i].x, raw[i].y, raw[i].z, raw[i].w};
#pragma unroll
          for (int j = 0; j < 4; ++j) {
#pragma unroll
              for (int k = 0; k < 2; ++k) { const int e = 8 * i + 2 * j + k; const unsigned u = (w[j] >> (16 * k)) & 0xffffu;
                  const unsigned sk = (u & 0x8000u) ? (~u & 0xffffu) : (u | 0x8000u);
                  key[e] = (e < nvalid) ? sk : 0u; } } } }
    unsigned T = 0;
#pragma unroll 1
    for (int bit = 15; bit >= 0; --bit) { const unsigned Tc = T | (1u << bit); int cnt = 0;
#pragma unroll
        for (int e = 0; e < 32; ++e) cnt += __popcll(__ballot(key[e] >= Tc));
        if (cnt >= 256) T = Tc; }
    unsigned g = 0, eq = 0; int cgt = 0;
#pragma unroll
    for (int e = 0; e < 32; ++e) { const bool gt = key[e] > T; cgt += __popcll(__ballot(gt)); unsigned bg = gt ? 1u : 0u, be = key[e] == T ? 1u : 0u; asm volatile("" : "+v"(bg), "+v"(be));
        g |= bg << e; eq |= be << e; }
    const int need = 256 - cgt; const int myeq = __popc(eq);
    int incl = myeq;
#pragma unroll
    for (int o = 1; o < 64; o <<= 1) { const int v = __shfl_up(incl, o); if (lane >= o) incl += v; }
    const int pre = incl - myeq; int take = need - pre; take = take < 0 ? 0 : (take > myeq ? myeq : take);
    unsigned te = eq; int cnt = myeq;
    while (cnt > take) { te &= ~(1u << (31 - __clz(te))); --cnt; }
    mbp[lane] = (g | te) & cb;
}
__device__ __forceinline__ void dsa_d3_task(Frame& F, int task, const bf16* PROJ) {
    const int hg = task & 3, qb = 63 - ((task >> 2) & 63), b = task >> 8; const int r32 = F.lane & 31;
    const int row0 = b * SEQ + 32 * qb;
    const bf16* qrow[3]; const unsigned* mbr[3];
#pragma unroll
    for (int s = 0; s < 3; ++s) { qrow[s] = PROJ + (size_t)(row0 + r32) * DSA_LD + DSA_Q + (3 * hg + s) * 64; mbr[s] = (const unsigned*)(F.ws + WS_MB) + (size_t)(row0 + r32) * 64; }
    LAS bf16x8* ql = wave_q(F); stage_q<3>(ql, qrow, F.lane);
    KVp kv{PROJ + (size_t)(b * SEQ) * DSA_LD + DSA_K, DSA_LD, (const bf16*)F.out + (size_t)b * 64 * SEQ, SEQ};
    f32x16 O[3][2]; float l[3]; zero_o<3, 2>(O, l);
    MaskArg ma{}; ma.q0[0] = ma.q0[1] = ma.q0[2] = 32 * qb;
    const float negb = 0.f;
    attn_core<3, 2, 0, MK_BITS, 1>(ql, kv, 0, qb + 1, negb, ma, mbr, O, l, F.lane);
    bf16* Y = (bf16*)(F.ws + WS_Y);
#pragma unroll
    for (int s = 0; s < 3; ++s) { const float lt = l[s] + __shfl_xor(l[s], 32); store_o<2, false>(O[s], (DBG_ZERO & 2) ? 0.f : 1.f / lt, Y, row0, (3 * hg + s) * 64, F.lane); }
}

__device__ __forceinline__ void nsa_cmp_task(Frame& F, int task, const bf16* PROJ, const float* kn0) {
    const int nb = task & 3, g = (task >> 2) & 3, b = task >> 4; const int r32 = F.lane & 31, hi = F.lane >> 5;
    const int n = 32 * nb + r32, nc = n > 126 ? 126 : n;
    const bf16* arow = PROJ + (size_t)(b * SEQ + 16 * nc) * NSA_LD + 64 * g + 8 * hi;
    const bf16* WkT = (const bf16*)(F.ws + WS_CMPW); const bf16* WvT = WkT + 64 * 2048;
    const bf16* wkp = WkT + (size_t)r32 * 2048 + 8 * hi; const bf16* wvp = WvT + (size_t)r32 * 2048 + 8 * hi;
    f32x16 Dk[2], Dv[2];
#pragma unroll
    for (int et = 0; et < 2; ++et)
#pragma unroll
        for (int r = 0; r < 16; ++r) { Dk[et][r] = 0.f; Dv[et][r] = 0.f; }
#pragma unroll 4
    for (int kk = 0; kk < 128; ++kk) {
        const bf16* ap = arow + (size_t)(kk >> 2) * NSA_LD + 16 * (kk & 3);
        const bf16x8 kcf = ld8(ap + NSA_KC), vcf = ld8(ap + NSA_VC);
#pragma unroll
        for (int et = 0; et < 2; ++et) { const bf16x8 wk = ld8(wkp + (size_t)(32 * et) * 2048 + 16 * kk), wv = ld8(wvp + (size_t)(32 * et) * 2048 + 16 * kk);
            Dk[et] = __builtin_amdgcn_mfma_f32_32x32x16_bf16(wk, kcf, Dk[et], 0, 0, 0);
            Dv[et] = __builtin_amdgcn_mfma_f32_32x32x16_bf16(vcf, wv, Dv[et], 0, 0, 0); }
    }
    const float* ck = (const float*)(F.ws + WS_CTL) + CW_CK; const float* cv = ck + 64;
    const float* tab = (const float*)(F.ws + WS_ROPE) + (size_t)(16 * nc + 31) * 64;
    float ss = 0.f;
#pragma unroll
    for (int et = 0; et < 2; ++et)
#pragma unroll
        for (int r = 0; r < 16; ++r) { Dk[et][r] += ck[32 * et + crow(r, hi)]; ss += Dk[et][r] * Dk[et][r]; }
    ss += __shfl_xor(ss, 32);
    const float rs = __builtin_amdgcn_rsqf(ss * (1.f / 64.f) + EPS);
    bf16* kout = (bf16*)(F.ws + WS_KCMP) + ((size_t)((b * 4 + g) * 128 + n)) * 64;
#pragma unroll
    for (int rq = 0; rq < 4; ++rq) { float o0[4], o1[4];
#pragma unroll
        for (int i = 0; i < 4; ++i) { const int r = 4 * rq + i, idx = crow(r, hi); const float v0 = Dk[0][r] * rs * kn0[idx], v1 = Dk[1][r] * rs * kn0[32 + idx];
            const float c = tab[idx], s = tab[32 + idx]; o0[i] = v0 * c - v1 * s; o1[i] = v1 * c + v0 * s; if (n > 126) { o0[i] = 0.f; o1[i] = 0.f; } }
        v2u w0, w1; w0.x = pk2(o0[0], o0[1]); w0.y = pk2(o0[2], o0[3]); w1.x = pk2(o1[0], o1[1]); w1.y = pk2(o1[2], o1[3]);
        *(GAS v2u*)(kout + 8 * rq + 4 * hi) = w0; *(GAS v2u*)(kout + 32 + 8 * rq + 4 * hi) = w1; }
    bf16* vout = (bf16*)(F.ws + WS_VCMPT) + ((size_t)((b * 4 + g) * 64)) * 128 + 32 * nb;
#pragma unroll
    for (int et = 0; et < 2; ++et) { const float cve = cv[32 * et + r32];
#pragma unroll
        for (int rq = 0; rq < 4; ++rq) { float o[4];
#pragma unroll
            for (int i = 0; i < 4; ++i) { const int nl = 8 * rq + 4 * hi + i; o[i] = (32 * nb + nl > 126) ? 0.f : Dv[et][4 * rq + i] + cve; }
            v2u w; w.x = pk2(o[0], o[1]); w.y = pk2(o[2], o[3]);
            *(GAS v2u*)(vout + (size_t)(32 * et + r32) * 128 + 8 * rq + 4 * hi) = w; } }
}
__device__ NSA_INLINE void nsa_task(unsigned char* ws_, float* out_, LAS unsigned char* lds_, int wave_, int task, const bf16* PROJ) {
    Frame F; F.ws = ws_; F.out = out_; F.lds = lds_; F.wave = wave_;
    asm volatile("v_mbcnt_lo_u32_b32 %0, -1, 0\n\tv_mbcnt_hi_u32_b32 %0, -1, %0" : "=v"(F.lane));
    const int g = task & 3, qb = 63 - ((task >> 2) & 63), b = task >> 8; const int r32 = F.lane & 31, hi = F.lane >> 5;
    const int row0 = b * SEQ + 32 * qb, tq = 32 * qb + r32;
    const bf16* qrow[3];
#pragma unroll
    for (int s = 0; s < 3; ++s) qrow[s] = PROJ + (size_t)(row0 + r32) * NSA_LD + NSA_Q + (3 * g + s) * 64;
    LAS bf16x8* ql = wave_q(F); stage_q<3>(ql, qrow, F.lane);
#define NSA_GATE(s_, c_) (__builtin_amdgcn_rcpf(1.f + fast_exp2(-1.4426950408889634f * bf2f(PROJ[(size_t)(row0 + r32) * NSA_LD + NSA_GT + 9 * g + 3 * (s_) + (c_)]))))
    bf16* Y = (bf16*)(F.ws + WS_Y);
    MaskArg ma{}; ma.q0[0] = ma.q0[1] = ma.q0[2] = 32 * qb; ma.nmax = tq >= 31 ? (tq - 31) >> 4 : -1;
    const KVp kvc{(const bf16*)(F.ws + WS_KCMP) + (size_t)((b * 4 + g) * 128) * 64, 64, (const bf16*)(F.ws + WS_VCMPT) + (size_t)((b * 4 + g) * 64) * 128, 128};
    float imp[16];
#pragma unroll
    for (int r = 0; r < 16; ++r) imp[r] = 0.f;
#ifndef NSA_NO_A
    {   const int kperm = (r32 & 0x13) | ((r32 & 4) << 1) | ((r32 & 8) >> 1);
        const bf16* kp = kvc.K + (size_t)kperm * 64 + 8 * hi;
#pragma unroll 1
        for (int s = 0; s < 3; ++s) { f32x16 ia; float ls = 0.f;
#pragma unroll
            for (int r = 0; r < 16; ++r) ia[r] = 0.f;
#pragma unroll 1
            for (int kt = 0; kt < 4; ++kt) { f32x16 acc;
#pragma unroll
                for (int r = 0; r < 16; ++r) acc[r] = 0.f;
#pragma unroll
                for (int ks = 0; ks < 4; ++ks) acc = __builtin_amdgcn_mfma_f32_32x32x16_bf16(ld8(kp + (size_t)(32 * kt) * 64 + 16 * ks), ql[(s * 4 + ks) * 64], acc, 0, 0, 0);
                float p[16];
#pragma unroll
                for (int r = 0; r < 16; ++r) { const int key = 32 * kt + 8 * hi + 16 * (r >> 3) + (r & 7); p[r] = key <= ma.nmax ? fast_exp2(acc[r]) : 0.f; ls += p[r]; }
#pragma unroll
                for (int ks2 = 0; ks2 < 2; ++ks2) { v4u pw, cw; unsigned short cvv[8];
                    pw.x = pk2(p[8 * ks2], p[8 * ks2 + 1]); pw.y = pk2(p[8 * ks2 + 2], p[8 * ks2 + 3]); pw.z = pk2(p[8 * ks2 + 4], p[8 * ks2 + 5]); pw.w = pk2(p[8 * ks2 + 6], p[8 * ks2 + 7]);
#pragma unroll
                    for (int jj = 0; jj < 8; ++jj) { const int nn = 32 * kt + 16 * ks2 + 8 * hi + jj; cvv[jj] = (nn >= 4 * r32 - 1 && nn <= 4 * r32 + 3) ? 0x3f80 : 0; }
                    cw.x = cvv[0] | (cvv[1] << 16); cw.y = cvv[2] | (cvv[3] << 16); cw.z = cvv[4] | (cvv[5] << 16); cw.w = cvv[6] | (cvv[7] << 16);
                    ia = __builtin_amdgcn_mfma_f32_32x32x16_bf16(__builtin_bit_cast(bf16x8, cw), __builtin_bit_cast(bf16x8, pw), ia, 0, 0, 0); }
            }
            const float lt = ls + __shfl_xor(ls, 32); const float inv = lt > 0.f ? 1.f / lt : 0.f;
#pragma unroll
            for (int r = 0; r < 16; ++r) imp[r] += ia[r] * inv;
        }
    }
#endif
    unsigned sel;
    { const int qblk = tq >> 6;
      if (32 * qb + 31 < 1024) sel = (2u << qblk) - 1u;
      else { float val[16], oth[16];
#pragma unroll
        for (int r = 0; r < 16; ++r) { const int j = crow(r, hi); val[r] = j > qblk ? -1e30f : ((j == 0 || j == qblk || j == qblk - 1) ? 1e9f : imp[r]); oth[r] = __shfl_xor(val[r], 32); }
        unsigned mine = 0;
#pragma unroll
        for (int r = 0; r < 16; ++r) { const int j = crow(r, hi); int rank = 0;
#pragma unroll
            for (int r2 = 0; r2 < 16; ++r2) { const int j2 = crow(r2, hi), j3 = crow(r2, hi ^ 1);
                rank += (val[r2] > val[r] || (val[r2] == val[r] && j2 < j)) ? 1 : 0;
                rank += (oth[r2] > val[r] || (oth[r2] == val[r] && j3 < j)) ? 1 : 0; }
            mine |= ((rank < 16 && j <= qblk) ? 1u : 0u) << ((r & 3) + 8 * (r >> 2)); }
        mine <<= 4 * hi;
        sel = mine | __shfl_xor(mine, 32); } }
    const unsigned* mbr2[2] = {nullptr, nullptr}; const unsigned* mbr1[1] = {nullptr};
    const KVp kvs{PROJ + (size_t)(b * SEQ) * NSA_LD + NSA_KS + 64 * g, NSA_LD, (const bf16*)F.out + ((size_t)b * 256 + 64 * g) * SEQ, SEQ};
    const KVp kvw{PROJ + (size_t)(b * SEQ) * NSA_LD + NSA_KW + 64 * g, NSA_LD, (const bf16*)F.out + (size_t)NB * 256 * SEQ + ((size_t)b * 256 + 64 * g) * SEQ, SEQ};
    ma.sel = sel;
#define NSA_BRANCH(MT_, KV_, KT0_, KT1_, C_, ADD_, ZBIT_) do { \
      { f32x16 O2[2][2]; float l2[2]; zero_o<2, 2>(O2, l2); attn_core<2, 2, 0, MT_>(ql, KV_, KT0_, KT1_, 0.f, ma, mbr2, O2, l2, F.lane); VM_WAIT(); \
        _Pragma("unroll") for (int s = 0; s < 2; ++s) { const float lt = l2[s] + __shfl_xor(l2[s], 32); \
          store_o<2, ADD_>(O2[s], (lt > 0.f && !(DBG_ZERO & ZBIT_)) ? NSA_GATE(s, C_) / lt : 0.f, Y, row0, (3 * g + s) * 64, F.lane); } } \
      { f32x16 O1[1][2]; float l1[1]; zero_o<1, 2>(O1, l1); attn_core<1, 2, 0, MT_>(ql + 2 * 4 * 64, KV_, KT0_, KT1_, 0.f, ma, mbr1, O1, l1, F.lane); VM_WAIT(); \
        const float lt = l1[0] + __shfl_xor(l1[0], 32); \
        store_o<2, ADD_>(O1[0], (lt > 0.f && !(DBG_ZERO & ZBIT_)) ? NSA_GATE(2, C_) / lt : 0.f, Y, row0, (3 * g + 2) * 64, F.lane); } } while (0)
    NSA_BRANCH(MK_CMP, kvc, 0, 4, 0, false, 4);
    NSA_BRANCH(MK_SLC, kvs, 0, qb + 1, 1, true, 16);
    NSA_BRANCH(MK_WIN, kvw, (qb > 16 ? qb - 16 : 0), qb + 1, 2, true, 32);
#undef NSA_BRANCH
}
__device__ __forceinline__ void prologue_misc(Frame& F) {
    float* tab = (float*)(F.ws + WS_ROPE);
    for (int idx = blockIdx.x * (NWAVES * 64) + F.tid; idx < SEQ * 32; idx += F.G * NWAVES * 64) {
        const int t = idx >> 5, i = idx & 31;
        const float inv = exp2f(-(float)i * (13.287712379549449f / 32.0f));
        const float ang = (float)t * inv; float s, c; sincosf(ang, &s, &c);
        tab[t * 64 + i] = c; tab[t * 64 + 32 + i] = s; }
    if (blockIdx.x < 4) {
        const int kv = F.wave & 1, part = blockIdx.x * 4 + (F.wave >> 1);
        const float* pos = kv ? F.ka->in[20] : F.ka->in[19]; const float* w = kv ? F.ka->in[22] : F.ka->in[21]; float a = 0.f;
#pragma unroll 8
        for (int i = part * 128; i < part * 128 + 128; ++i) a += pos[i] * w[(size_t)i * 64 + F.lane];
        atomicAdd((float*)(F.ws + WS_CTL) + CW_CK + 64 * kv + F.lane, a);
    }
}
__device__ __forceinline__ void prologue_phase(Frame& F) {
    prologue_misc(F);
    bf16* XB = (bf16*)(F.ws + WS_XB); float* PART = (float*)(F.ws + WS_PART);
    for (int m = F.gw; m < MTOK; m += F.NGW) row_to_bf16(F, F.ka->in[0] + (size_t)m * DM, XB + (size_t)m * DM, PART + (size_t)m * 16);
    bf16* MEMB = (bf16*)(F.ws + WS_MEMB); float* PARTM = (float*)(F.ws + WS_PARTM);
    for (int m = F.gw; m < MMEM; m += F.NGW) row_to_bf16(F, F.ka->in[1] + (size_t)m * DM, MEMB + (size_t)m * DM, PARTM + (size_t)m * 16);
    int itb = 0;
#pragma unroll 1
    for (int ly = 0; ly < DEPTH; ++ly) cvt_matrix(F, itb, F.ka->in[9] + (size_t)ly * DM * 512, nullptr, 512, 512, F.ka->in[8] + (size_t)ly * DM, (bf16*)(F.ws + WS_WKV) + (size_t)ly * 512 * DM, DM, 512, 0);
    cvt_matrix(F, itb, F.ka->in[21], nullptr, 64, 64, nullptr, (bf16*)(F.ws + WS_CMPW), 2048, 64, 0);
    cvt_matrix(F, itb, F.ka->in[22], nullptr, 64, 64, nullptr, (bf16*)(F.ws + WS_CMPW) + 64 * 2048, 2048, 64, 0);
    convert_layer(F, 0);
}

template <unsigned PHASE_MASK> __global__ void __launch_bounds__(NWAVES * 64, 2) mk_fwd(Args args) {
    extern __shared__ __attribute__((aligned(16))) unsigned char lds[];
    Frame F;
    F.lds = (LAS unsigned char*)lds;
    F.MISC = (volatile LAS unsigned*)(F.lds + 131072 + 320);
    F.tid = threadIdx.x; F.lane = F.tid & 63; F.wave = __builtin_amdgcn_readfirstlane(F.tid >> 6);
    F.G = gridDim.x; F.gw = blockIdx.x * NWAVES + F.wave; F.NGW = F.G * NWAVES;
    F.ws = args.ws; F.ctl = (gu32*)(args.ws + WS_CTL); F.out = args.out;
    F.ka = (KArgs)__builtin_amdgcn_kernarg_segment_ptr();
    for (int u = F.tid; u < (147456 - 131072) / 4; u += NWAVES * 64) ((LAS unsigned*)(F.lds + 131072))[u] = 0u;
    __syncthreads();
    XcdBarrier bar = xcd_barrier_post((unsigned*)(F.ctl + CW_BAR), F.MISC + 8);
    constexpr bool ALLPH = PHASE_MASK == 0xffffffffu;
    const int lo = ALLPH ? 0 : args.ph_lo, hi = ALLPH ? 0 : args.ph_hi; int pc = 0;
    const bool dry = ALLPH ? false : (args.dry != 0);
#define PH_BEGIN(id) if (ALLPH || ((((PHASE_MASK) >> (id)) & 1u) && lo <= pc && pc < hi)) { asm volatile("" : "+s"(F.ka), "+s"(F.ws), "+s"(F.out), "+s"(F.gw), "+s"(F.NGW), "+s"(F.G), "+s"(F.wave)); asm volatile("v_mbcnt_lo_u32_b32 %0, -1, 0\n\tv_mbcnt_hi_u32_b32 %0, -1, %0" : "=v"(F.lane)); F.tid = F.wave * 64 + F.lane;
#define PH_END_(islast)   if (ALLPH ? !(islast) : (pc + 1 < hi)) { XcdBarrier b2_ = bar; asm volatile("" : "+s"(b2_.bar), "+s"(b2_.x)); xcd_barrier(b2_); } } if (!ALLPH) ++pc;
#define PH_END PH_END_(false)
#define QCTR(i) (F.ctl + CW_Q + 64 * (i))

#define XB ((bf16*)(F.ws + WS_XB))
#define VTB ((bf16*)F.out)
#define Yb ((bf16*)(F.ws + WS_Y))
#define HID ((bf16*)(F.ws + WS_HID))
#define PART ((float*)(F.ws + WS_PART))
    LAS unsigned char* ring = F.lds;

    PH_BEGIN(0) prologue_phase(F); PH_END
    PH_BEGIN(1) { pg8::Gemm g{(const bf16*)(F.ws + WS_MEMB), (const bf16*)(F.ws + WS_WKV), MMEM, 2048, DM}; pg8::StaticOrder S; S.init(MMEM, 2048, F.G, (int)blockIdx.x);
        pg8::EpiScale E{(bf16*)(F.ws + WS_MKV), 2048, (const float*)(F.ws + WS_PARTM)};
        pg8::gemm_phase<pg8::EpiScale, pg8::StaticOrder, true, true>(ring, g, S, E, F.wave); } PH_END
    PH_BEGIN(2)
#pragma unroll 1
        for (int ly = 0; ly < DEPTH; ++ly) {
            xform(F, (const bf16*)(F.ws + WS_MKV), 2048, ly * 512, 4, MMEM, NMEMT, (bf16*)(F.ws + WS_MK) + (size_t)ly * NB * 4 * NMEMT * 64, 1, 0, 0, F.ka->in[11] + ly * 64, false, 1.f, 0);
            transpose_cols(F, (const bf16*)(F.ws + WS_MKV), 2048, ly * 512 + 256, 256, NB, NMEMT, (bf16*)(F.ws + WS_MVT) + (size_t)ly * NB * 256 * NMEMT);
        }
    PH_END

#pragma unroll 1
    for (int Ly = 0; Ly < DEPTH; ++Ly) {
#define WB ((const bf16*)(F.ws + WS_WBUF0 + (size_t)(Ly & 1) * WBUF_BYTES))
        const int kind = Ly % 3;
        const int ldp = kind == 0 ? RET_LD : (kind == 1 ? DSA_LD : NSA_LD);
        PH_BEGIN(3) { pg8::Gemm g{XB, WB + WB_W1A, MTOK, 2 * FF, DM}; pg8::StaticOrder S; S.init(MTOK, 2 * FF, F.G, (int)blockIdx.x);
            pg8::EpiSwiglu E{HID, FF, PART};
            pg8::gemm_phase<pg8::EpiSwiglu, pg8::StaticOrder, true, true>(ring, g, S, E, F.wave); } PH_END
        PH_BEGIN(4) { pg8::Gemm g{HID, WB + WB_W2A, MTOK, DM, FF}; pg8::StaticOrder S; S.init(MTOK, DM, F.G, (int)blockIdx.x);
            pg8::EpiResid E{XB, XB, nullptr, PART, dry ? 0.f : 0.5f};
            pg8::gemm_phase<pg8::EpiResid, pg8::StaticOrder, true, true>(ring, g, S, E, F.wave); } PH_END
        PH_BEGIN(5) { pg8::Gemm g{XB, WB + WB_WIN, MTOK, ldp, DM}; pg8::StaticOrder S; S.init(MTOK, ldp, F.G, (int)blockIdx.x);
            pg8::EpiScale E{HID, ldp, PART};
            pg8::gemm_phase<pg8::EpiScale, pg8::StaticOrder, true, true>(ring, g, S, E, F.wave); } PH_END
        PH_BEGIN(6)
            if (kind == 0) {
                xform(F, HID, ldp, RET_Q, 6, MTOK, SEQ, (dry ? Yb : HID), 0, (dry ? 1024 : ldp), (dry ? 0 : RET_Q), nullptr, true, 1.f, RET_MODE == 1 ? +1 : 0);
                xform(F, HID, ldp, RET_K, 6, MTOK, SEQ, (dry ? Yb : HID), 0, (dry ? 1024 : ldp), (dry ? 0 : RET_K), nullptr, true, 0.125f, RET_MODE == 1 ? -1 : 0);
                xform(F, HID, ldp, RET_QM, 4, MTOK, SEQ, (dry ? Yb : HID), 0, (dry ? 1024 : ldp), (dry ? 0 : RET_QM), F.ka->in[10] + Ly * 64, false, QSCALE, 0);
                transpose_cols(F, HID, ldp, RET_V, 768, NB, SEQ, VTB);
            } else if (kind == 1) {
                xform(F, HID, ldp, DSA_Q, 12, MTOK, SEQ, (dry ? Yb : HID), 0, (dry ? 1024 : ldp), (dry ? 0 : DSA_Q), F.ka->in[14], true, QSCALE, 0);
                xform(F, HID, ldp, DSA_K, 1, MTOK, SEQ, (dry ? Yb : HID), 0, (dry ? 1024 : ldp), (dry ? 0 : DSA_K), F.ka->in[15], true, 1.f, 0);
                xform(F, HID, ldp, DSA_IQ, 8, MTOK, SEQ, (dry ? Yb : HID), 0, (dry ? 1024 : ldp), (dry ? 0 : DSA_IQ), nullptr, true, 1.f, 0);
                xform(F, HID, ldp, DSA_IK, 1, MTOK, SEQ, (dry ? Yb : HID), 0, (dry ? 1024 : ldp), (dry ? 0 : DSA_IK), nullptr, true, 1.f, 0);
                xform(F, HID, ldp, DSA_QM, 4, MTOK, SEQ, (dry ? Yb : HID), 0, (dry ? 1024 : ldp), (dry ? 0 : DSA_QM), F.ka->in[10] + Ly * 64, false, QSCALE, 0);
                transpose_cols(F, HID, ldp, DSA_V, 64, NB, SEQ, VTB);
            } else {
                xform(F, HID, ldp, NSA_Q, 12, MTOK, SEQ, (dry ? Yb : HID), 0, (dry ? 1024 : ldp), (dry ? 0 : NSA_Q), F.ka->in[17], true, QSCALE, 0);
                xform(F, HID, ldp, NSA_KS, 4, MTOK, SEQ, (dry ? Yb : HID), 0, (dry ? 1024 : ldp), (dry ? 0 : NSA_KS), F.ka->in[18] + 64, true, 1.f, 0);
                xform(F, HID, ldp, NSA_KW, 4, MTOK, SEQ, (dry ? Yb : HID), 0, (dry ? 1024 : ldp), (dry ? 0 : NSA_KW), F.ka->in[18] + 128, true, 1.f, 0);
                xform(F, HID, ldp, NSA_QM, 4, MTOK, SEQ, (dry ? Yb : HID), 0, (dry ? 1024 : ldp), (dry ? 0 : NSA_QM), F.ka->in[10] + Ly * 64, false, QSCALE, 0);
                transpose_cols(F, HID, ldp, NSA_VS, 256, NB, SEQ, VTB);
                transpose_cols(F, HID, ldp, NSA_VW, 256, NB, SEQ, VTB + (size_t)NB * 256 * SEQ);
                for (int t = F.gw; t < 256; t += F.NGW) nsa_cmp_task(F, t, HID, F.ka->in[18]);
            }
            if (Ly + 1 < DEPTH) convert_layer(F, Ly + 1);
        PH_END
        if (kind == 0) {
            PH_BEGIN(7)
                for (;;) { asm volatile("v_mbcnt_lo_u32_b32 %0, -1, 0\n\tv_mbcnt_hi_u32_b32 %0, -1, %0" : "=v"(F.lane)); const int t = grab(QCTR(Ly * 8 + 0), F.lane); if (t >= 3072 + 2048) break; if (t < 3072) ret_task(F, t, HID); else mem_task(F, t - 3072, Ly, HID, ldp, RET_QM); }
            PH_END
        } else if (kind == 1) {
            PH_BEGIN(8)
                for (;;) { asm volatile("v_mbcnt_lo_u32_b32 %0, -1, 0\n\tv_mbcnt_hi_u32_b32 %0, -1, %0" : "=v"(F.lane)); const int t = grab(QCTR(Ly * 8 + 0), F.lane); if (t >= 4608 + 2048) break; if (t < 4608) dsa_d1_task(F, t, HID); else mem_task(F, t - 4608, Ly, HID, ldp, DSA_QM); }
            PH_END
            PH_BEGIN(9)
                for (;;) { asm volatile("v_mbcnt_lo_u32_b32 %0, -1, 0\n\tv_mbcnt_hi_u32_b32 %0, -1, %0" : "=v"(F.lane)); const int t = grab(QCTR(Ly * 8 + 1), F.lane); if (t >= MTOK / 8) break;
#pragma unroll 1
                    for (int i = 0; i < 8; ++i) dsa_d2_row(F, MTOK - 1 - (8 * t + i)); }
            PH_END
            PH_BEGIN(10)
                for (;;) { asm volatile("v_mbcnt_lo_u32_b32 %0, -1, 0\n\tv_mbcnt_hi_u32_b32 %0, -1, %0" : "=v"(F.lane)); const int t = grab(QCTR(Ly * 8 + 2), F.lane); if (t >= 4096) break; dsa_d3_task(F, t, HID); }
            PH_END
        } else {
            PH_BEGIN(11)
                for (;;) { asm volatile("v_mbcnt_lo_u32_b32 %0, -1, 0\n\tv_mbcnt_hi_u32_b32 %0, -1, %0" : "=v"(F.lane)); const int t = grab(QCTR(Ly * 8 + 0), F.lane); if (t >= 4096 + 2048) break; if (t < 4096) nsa_task(F.ws, F.out, F.lds, F.wave, t, HID); else mem_task(F, t - 4096, Ly, HID, ldp, NSA_QM); }
            PH_END
        }
        PH_BEGIN(12) { pg8::Gemm g{Yb, WB + WB_WO, MTOK, DM, DM}; pg8::StaticOrder S; S.init(MTOK, DM, F.G, (int)blockIdx.x);
            pg8::EpiResid E{XB, XB, nullptr, PART, dry ? 0.f : 1.0f};
            pg8::gemm_phase<pg8::EpiResid, pg8::StaticOrder, true, true>(ring, g, S, E, F.wave); } PH_END
        PH_BEGIN(13) { pg8::Gemm g{XB, WB + WB_W1B, MTOK, 2 * FF, DM}; pg8::StaticOrder S; S.init(MTOK, 2 * FF, F.G, (int)blockIdx.x);
            pg8::EpiSwiglu E{HID, FF, PART};
            pg8::gemm_phase<pg8::EpiSwiglu, pg8::StaticOrder, true, true>(ring, g, S, E, F.wave); } PH_END
        PH_BEGIN(14) { pg8::Gemm g{HID, WB + WB_W2B, MTOK, DM, FF}; pg8::StaticOrder S; S.init(MTOK, DM, F.G, (int)blockIdx.x);
            pg8::EpiResid E{XB, XB, Ly == DEPTH - 1 ? F.out : nullptr, PART, dry ? 0.f : 0.5f};
            pg8::gemm_phase<pg8::EpiResid, pg8::StaticOrder, true, true>(ring, g, S, E, F.wave); } PH_END_(Ly == DEPTH - 1)
    }
#undef XB
#undef VTB
#undef Yb
#undef HID
#undef PART
#undef WB
#undef PH_BEGIN
#undef PH_END
#undef PH_END_
}

constexpr int LDS_BYTES = 147456;
#ifndef MK_PER_PHASE
#define MK_PER_PHASE 0
#endif
typedef void (*kern_t)(Args);
template <unsigned M> static kern_t kern_of() { return mk_fwd<M>; }
#if MK_PER_PHASE
static kern_t phase_kernel(int id) {
    switch (id) {
        case 0: return kern_of<1u << 0>(); case 1: return kern_of<1u << 1>(); case 2: return kern_of<1u << 2>(); case 3: return kern_of<1u << 3>(); case 4: return kern_of<1u << 4>();
        case 5: return kern_of<1u << 5>(); case 6: return kern_of<1u << 6>(); case 7: return kern_of<1u << 7>(); case 8: return kern_of<1u << 8>(); case 9: return kern_of<1u << 9>();
        case 10: return kern_of<1u << 10>(); case 11: return kern_of<1u << 11>(); case 12: return kern_of<1u << 12>(); case 13: return kern_of<1u << 13>(); default: return kern_of<1u << 14>();
    }
}
#endif
extern "C" void kernel_launch(void* const* d_in, const int* in_sizes, int n_in, void* d_out, int out_size, void* d_ws, size_t ws_size, hipStream_t stream) {
    static int grid = 0;
    if (grid == 0) {
        if (n_in != 23 || out_size != MTOK * DM || ws_size < WS_END) { fprintf(stderr, "kernel_launch: unexpected shapes (n_in %d, out %d, ws %zu)\n", n_in, out_size, ws_size); grid = -1; return; }
        int dev = 0, cus = 0;
        if (hipGetDevice(&dev) != hipSuccess || hipDeviceGetAttribute(&cus, hipDeviceAttributeMultiprocessorCount, dev) != hipSuccess) { grid = -1; return; }
#if MK_PER_PHASE
        for (int id = 0; id < 15; ++id) if (hipFuncSetAttribute((const void*)phase_kernel(id), hipFuncAttributeMaxDynamicSharedMemorySize, LDS_BYTES) != hipSuccess) { fprintf(stderr, "kernel_launch: hipFuncSetAttribute failed\n"); grid = -1; return; }
#else
        if (hipFuncSetAttribute((const void*)kern_of<0xffffffffu>(), hipFuncAttributeMaxDynamicSharedMemorySize, LDS_BYTES) != hipSuccess) { fprintf(stderr, "kernel_launch: hipFuncSetAttribute failed\n"); grid = -1; return; }
#endif
        (void)hipGetLastError();
        grid = cus;
    }
    if (grid < 0) return;
    if (hipMemsetAsync((char*)d_ws + WS_CTL, 0, CTL_ZERO_BYTES, stream) != hipSuccess) return;
    Args a{};
    for (int i = 0; i < 23; ++i) a.in[i] = (const float*)d_in[i];
    a.out = (float*)d_out; a.ws = (unsigned char*)d_ws;
    constexpr int NPH = 3 + 8 * DEPTH + 2;
#if MK_PER_PHASE
    int ids[NPH]; int n = 0; ids[n++] = 0; ids[n++] = 1; ids[n++] = 2;
    for (int ly = 0; ly < DEPTH; ++ly) { ids[n++] = 3; ids[n++] = 4; ids[n++] = 5; ids[n++] = 6;
        if (ly % 3 == 0) ids[n++] = 7; else if (ly % 3 == 1) { ids[n++] = 8; ids[n++] = 9; ids[n++] = 10; } else ids[n++] = 11;
        ids[n++] = 12; ids[n++] = 13; ids[n++] = 14; }
    for (int p = 0; p < NPH; ++p) { a.ph_lo = p; a.ph_hi = p + 1;
#if PROBE_DUP
        if ((PROBE_DUP >> ids[p]) & 1) {
            a.dry = 1; hipLaunchKernelGGL(phase_kernel(ids[p]), dim3(grid), dim3(NWAVES * 64), LDS_BYTES, stream, a); a.dry = 0;
            hipMemsetAsync((char*)d_ws + WS_CTL + CW_Q * 4, 0, 64 * 4 * 64, stream); }
#endif
        hipLaunchKernelGGL(phase_kernel(ids[p]), dim3(grid), dim3(NWAVES * 64), LDS_BYTES, stream, a);
    }
#else
    a.ph_lo = 0; a.ph_hi = NPH; hipLaunchKernelGGL(kern_of<0xffffffffu>(), dim3(grid), dim3(NWAVES * 64), LDS_BYTES, stream, a);
#endif
}
```

```cpp
#include <hip/hip_runtime.h>
#include <cstdio>
#include <cstdint>
namespace pg8 {
#define PG8_LAS __attribute__((address_space(3)))
typedef unsigned short bf16_t;
typedef short bf16x8 __attribute__((ext_vector_type(8)));
typedef float f32x4 __attribute__((ext_vector_type(4)));
typedef unsigned u32x4 __attribute__((ext_vector_type(4)));
constexpr int BM = 256, BK = 64, HALF = 128, HTB = HALF * BK * 2  , STAGE_BYTES = 8 * HTB, NXCD = 8, WGM = 8;

__host__ __device__ __forceinline__ int lds_byte(int r, int c) { const int st = (r >> 4) * 2 + (c >> 5), rr = r & 15, cc = c & 31, ob = rr * 64 + cc * 2; return st * 1024 + (ob ^ (((ob >> 9) & 1) << 5)); }
__host__ __device__ __forceinline__ void stage_rc(int b, int& R, int& C) { const int st = b / 1024, sb = b % 1024, swz = sb ^ (((sb >> 9) & 1) << 5); R = (st >> 1) * 16 + swz / 64; C = (st & 1) * 32 + (swz % 64) / 2; }
__host__ __device__ __forceinline__ int perm32(int rho) { const int n = rho >> 4, i = rho & 15; return 8 * (i >> 2) + 4 * n + (i & 3); }

struct Unit { int pm, pn; };
struct Gemm { const bf16_t* A; const bf16_t* Bt; int M, N, K; };

struct StaticOrder {
    int nM, nN, nwg, G, c;
    __host__ __device__ void init(int M, int N, int G_, int c_) { nM = M / BM; nN = N / BM; nwg = nM * nN; G = G_; c = c_; }
    __host__ __device__ bool next(int i, Unit& u) const {
        const long L = (long)i * G + c; if (L >= nwg) return false;
        int wgid = (int)L; { const int q = nwg / NXCD, r = nwg % NXCD, xcd = wgid % NXCD, off = wgid / NXCD; wgid = (xcd < r ? xcd * (q + 1) : r * (q + 1) + (xcd - r) * q) + off; }
        const int nig = WGM * nN, gid = wgid / nig, fm = gid * WGM, gsz = (nM - fm) < WGM ? (nM - fm) : WGM;
        u.pm = fm + ((wgid % nig) % gsz); u.pn = (wgid % nig) / gsz; return true;
    }
    __device__ __forceinline__ void a_ready(const Unit&) const {}
    __device__ __forceinline__ void done(const Unit&) const {}
};

__device__ __forceinline__ int lane_now() { int l; asm volatile("v_mbcnt_lo_u32_b32 %0, -1, 0\n\tv_mbcnt_hi_u32_b32 %0, -1, %0" : "=v"(l)); return l; }
__device__ __forceinline__ float shfl_idx_(float v, int src) { return __builtin_bit_cast(float, __builtin_amdgcn_ds_bpermute(src << 2, __builtin_bit_cast(int, v))); }
__device__ __forceinline__ int shfl_idx_(int v, int src) { return __builtin_amdgcn_ds_bpermute(src << 2, v); }
__device__ __forceinline__ unsigned shfl_idx_(unsigned v, int src) { return (unsigned)__builtin_amdgcn_ds_bpermute(src << 2, (int)v); }
#define __shfl_xor(v, o) pg8::shfl_idx_((v), pg8::lane_now() ^ (o))
#define __shfl(v, src) pg8::shfl_idx_((v), (src))
#define __shfl_down(v, o) pg8::shfl_idx_((v), pg8::lane_now() + (o))
#define __shfl_up(v, o) pg8::shfl_idx_((v), pg8::lane_now() - (o))
typedef float f32x2_cv __attribute__((ext_vector_type(2))); typedef __bf16 bf16x2_cv __attribute__((ext_vector_type(2)));
__device__ __forceinline__ unsigned cvt_pk_bf16(float lo, float hi) { f32x2_cv v = {lo, hi}; bf16x2_cv b = __builtin_convertvector(v, bf16x2_cv); return __builtin_bit_cast(unsigned, b); }
constexpr float RMS_EPS = 1e-6f;
__device__ __forceinline__ void rows_rs(const float* part, int row0, int fq, float (&rs)[2][4]) {
    f32x4 pr[2][4];
#pragma unroll
    for (int ai = 0; ai < 2; ++ai)
#pragma unroll
        for (int m = 0; m < 4; ++m) pr[ai][m] = *(const f32x4*)(part + (size_t)(row0 + ai * HALF + m * 16) * 16 + 4 * fq);
#pragma unroll
    for (int ai = 0; ai < 2; ++ai)
#pragma unroll
        for (int m = 0; m < 4; ++m) { float s = (pr[ai][m][0] + pr[ai][m][1]) + (pr[ai][m][2] + pr[ai][m][3]); s += __shfl_xor(s, 16); s += __shfl_xor(s, 32);
            rs[ai][m] = __builtin_amdgcn_rsqf(s * (1.0f / 1024.0f) + RMS_EPS); }
}
__device__ __forceinline__ float silu_mul(float g, float u) { return g * u * __builtin_amdgcn_rcpf(1.0f + __builtin_amdgcn_exp2f(-1.4426950408889634f * g)); }
struct EpiSwiglu {
    static constexpr bool PERM = true, AFTER_DRAIN = false;
    bf16_t* H; int ldh; const float* part; int dmode;
    __device__ __forceinline__ void operator()(const f32x4 (&acc)[2][2][4][2], const Unit& u, int wr, int wc, int fr_, int fq_) const {
        int le_; asm volatile("v_mbcnt_lo_u32_b32 %0, -1, 0\n\tv_mbcnt_hi_u32_b32 %0, -1, %0" : "=v"(le_)); const int fr = le_ & 15, fq = le_ >> 4;
        const int row0 = u.pm * BM + wr * 64 + fr, col0 = u.pn * HALF + wc * 32 + 8 * fq;
        if (dmode == 2) return;
        float rsv[2][4]; rows_rs(part, row0, fq, rsv);
#pragma unroll
        for (int ai = 0; ai < 2; ++ai)
#pragma unroll
            for (int m = 0; m < 4; ++m) { const int row = row0 + ai * HALF + m * 16; const float rs = rsv[ai][m];
                const f32x4 g0 = acc[ai][0][m][0] * rs, g1 = acc[ai][0][m][1] * rs, u0 = acc[ai][1][m][0] * rs, u1 = acc[ai][1][m][1] * rs;
                u32x4 w; w.x = cvt_pk_bf16(silu_mul(g0[0], u0[0]), silu_mul(g0[1], u0[1])); w.y = cvt_pk_bf16(silu_mul(g0[2], u0[2]), silu_mul(g0[3], u0[3]));
                w.z = cvt_pk_bf16(silu_mul(g1[0], u1[0]), silu_mul(g1[1], u1[1])); w.w = cvt_pk_bf16(silu_mul(g1[2], u1[2]), silu_mul(g1[3], u1[3]));
                if (dmode == 0 || w.x == 0x12345678u) *(u32x4*)(H + (size_t)row * ldh + col0) = w; }
    }
};
struct EpiScale {
    static constexpr bool PERM = true, AFTER_DRAIN = false;
    bf16_t* O; int ldc; const float* part;
    __device__ __forceinline__ void operator()(const f32x4 (&acc)[2][2][4][2], const Unit& u, int wr, int wc, int fr_, int fq_) const {
        int le_; asm volatile("v_mbcnt_lo_u32_b32 %0, -1, 0\n\tv_mbcnt_hi_u32_b32 %0, -1, %0" : "=v"(le_)); const int fr = le_ & 15, fq = le_ >> 4;
        const int row0 = u.pm * BM + wr * 64 + fr, col0 = u.pn * BM + wc * 32 + 8 * fq;
        float rsv[2][4]; rows_rs(part, row0, fq, rsv);
#pragma unroll
        for (int ai = 0; ai < 2; ++ai)
#pragma unroll
            for (int m = 0; m < 4; ++m) { const int row = row0 + ai * HALF + m * 16; const float rs = rsv[ai][m]; bf16_t* rowp = O + (size_t)row * ldc + col0;
#pragma unroll
                for (int bj = 0; bj < 2; ++bj) { const f32x4 v0 = acc[ai][bj][m][0] * rs, v1 = acc[ai][bj][m][1] * rs;
                    u32x4 w; w.x = cvt_pk_bf16(v0[0], v0[1]); w.y = cvt_pk_bf16(v0[2], v0[3]); w.z = cvt_pk_bf16(v1[0], v1[1]); w.w = cvt_pk_bf16(v1[2], v1[3]);
                    *(u32x4*)(rowp + bj * HALF) = w; } }
    }
};
struct EpiResid {
    static constexpr bool PERM = true, AFTER_DRAIN = false;
    const bf16_t* base; bf16_t* xb; float* out; float* part_out; float coef;
    __device__ __forceinline__ void operator()(const f32x4 (&acc)[2][2][4][2], const Unit& u, int wr, int wc, int fr_, int fq_) const {
        int le_; asm volatile("v_mbcnt_lo_u32_b32 %0, -1, 0\n\tv_mbcnt_hi_u32_b32 %0, -1, %0" : "=v"(le_)); const int fr = le_ & 15, fq = le_ >> 4;
        const int row0 = u.pm * BM + wr * 64 + fr, col0 = u.pn * BM + wc * 32 + 8 * fq;
        u32x4 bs[2][4][2];
#pragma unroll
        for (int ai = 0; ai < 2; ++ai)
#pragma unroll
            for (int m = 0; m < 4; ++m)
#pragma unroll
                for (int bj = 0; bj < 2; ++bj) bs[ai][m][bj] = *(const u32x4*)(base + (size_t)(row0 + ai * HALF + m * 16) * 1024 + col0 + bj * HALF);
#pragma unroll
        for (int ai = 0; ai < 2; ++ai)
#pragma unroll
            for (int m = 0; m < 4; ++m) { const int row = row0 + ai * HALF + m * 16; const size_t off = (size_t)row * 1024 + col0; float ss = 0.f;
#pragma unroll
                for (int bj = 0; bj < 2; ++bj) { const u32x4 b = bs[ai][m][bj];
                    const f32x4 b0 = {__builtin_bit_cast(float, b.x << 16), __builtin_bit_cast(float, b.x & 0xffff0000u), __builtin_bit_cast(float, b.y << 16), __builtin_bit_cast(float, b.y & 0xffff0000u)};
                    const f32x4 b1 = {__builtin_bit_cast(float, b.z << 16), __builtin_bit_cast(float, b.z & 0xffff0000u), __builtin_bit_cast(float, b.w << 16), __builtin_bit_cast(float, b.w & 0xffff0000u)};
                    const f32x4 v0 = b0 + acc[ai][bj][m][0] * coef, v1 = b1 + acc[ai][bj][m][1] * coef;
                    if (out) { *(f32x4*)(out + off + bj * HALF) = v0; *(f32x4*)(out + off + bj * HALF + 4) = v1; }
                    u32x4 w; w.x = cvt_pk_bf16(v0[0], v0[1]); w.y = cvt_pk_bf16(v0[2], v0[3]); w.z = cvt_pk_bf16(v1[0], v1[1]); w.w = cvt_pk_bf16(v1[2], v1[3]);
                    *(u32x4*)(xb + off + bj * HALF) = w;
                    ss += (v0[0] * v0[0] + v0[1] * v0[1]) + (v0[2] * v0[2] + v0[3] * v0[3]) + (v1[0] * v1[0] + v1[1] * v1[1]) + (v1[2] * v1[2] + v1[3] * v1[3]); }
                ss += __shfl_xor(ss, 16); ss += __shfl_xor(ss, 32);
                if (fq == 0) part_out[(size_t)row * 16 + u.pn * 4 + wc] = ss; }
    }
};
template <class Epi, class Sched, bool ALIGN_EPI = false, bool SP2 = false>
__device__ __forceinline__ void gemm_phase(PG8_LAS unsigned char* lds, const Gemm g, const Sched& S, const Epi& E, int wave_id) {
    int lane_; asm volatile("v_mbcnt_lo_u32_b32 %0, -1, 0\n\tv_mbcnt_hi_u32_b32 %0, -1, %0" : "=v"(lane_));
    const int wid = wave_id, lane = lane_, tid = wid * 64 + lane, wr = wid >> 2, wc = wid & 3, fr = lane & 15, fq = lane >> 4;
    const int K = g.K, nt = K / BK;
    unsigned voffA[2], voffB[2];
#pragma unroll
    for (int i = 0; i < 2; ++i) { int R, C; stage_rc(tid * 16 + i * 8192, R, C); const int Rb = Epi::PERM ? ((R & ~31) + perm32(R & 31)) : R;
        voffA[i] = (unsigned)(R * K + C) * 2u; voffB[i] = (unsigned)(Rb * K + C) * 2u; }
    const size_t kstep = (size_t)(BK * 2);
    const size_t hstep = (size_t)HALF * K * 2;
    const size_t tstep = 2 * hstep;
    const unsigned ldsw = (unsigned)wid * 1024u;
    const int aoff = lds_byte(wr * 64 + fr, fq * 8), boff = lds_byte(wc * 32 + fr, fq * 8);
#define PG8_SA(b, h) (((b) * 2 + (h)) * HTB)
#define PG8_SB(b, h) ((4 + (b) * 2 + (h)) * HTB)
#define PG8_STAGE(bufoff, gbase, voff) do { _Pragma("unroll") for (int _i = 0; _i < 2; ++_i) \
        __builtin_amdgcn_global_load_lds((const unsigned*)((const char*)(gbase) + (voff)[_i]), (PG8_LAS unsigned*)(lds + (bufoff) + ldsw + _i * 8192), 16, 0, 0); } while (0)
#define PG8_LDA(dst, b, h) do { _Pragma("unroll") for (int m = 0; m < 4; ++m) _Pragma("unroll") for (int k = 0; k < 2; ++k) dst[m][k] = *(const PG8_LAS bf16x8*)(lds + PG8_SA(b, h) + aoff + m * 2048 + k * 1024); } while (0)
#define PG8_LDB(dst, b, h) do { _Pragma("unroll") for (int n = 0; n < 2; ++n) _Pragma("unroll") for (int k = 0; k < 2; ++k) dst[n][k] = *(const PG8_LAS bf16x8*)(lds + PG8_SB(b, h) + boff + n * 2048 + k * 1024); } while (0)
#define PG8_MMA(ai, bj, At, Bt) do { __builtin_amdgcn_s_setprio(1); _Pragma("unroll") for (int m = 0; m < 4; ++m) _Pragma("unroll") for (int n = 0; n < 2; ++n) _Pragma("unroll") for (int k = 0; k < 2; ++k) \
        acc[ai][bj][m][n] = __builtin_amdgcn_mfma_f32_16x16x32_bf16(Bt[n][k], At[m][k], acc[ai][bj][m][n], 0, 0, 0); __builtin_amdgcn_s_setprio(0); } while (0)
#define PG8_WAIT_V(n) asm volatile("s_waitcnt vmcnt(" #n ")" ::: "memory")
#define PG8_WAIT_L(n) asm volatile("s_waitcnt lgkmcnt(" #n ")" ::: "memory")
#define PG8_BAR __builtin_amdgcn_s_barrier()
#define PG8_SCHED __builtin_amdgcn_sched_barrier(0)
    Unit cur, nxt; int ui = 0;
    if (!S.next(0, cur)) return;
    f32x4 acc[2][2][4][2];
#pragma unroll
    for (int a = 0; a < 2; ++a)
#pragma unroll
        for (int b = 0; b < 2; ++b)
#pragma unroll
            for (int m = 0; m < 4; ++m)
#pragma unroll
                for (int n = 0; n < 2; ++n) acc[a][b][m][n] = (f32x4){0.f, 0.f, 0.f, 0.f};
    bf16x8 At[4][2], B0[2][2], B1[2][2];
    const char* cA = (const char*)g.A + (size_t)cur.pm * tstep; const char* cB = (const char*)g.Bt + (size_t)cur.pn * tstep;
    S.a_ready(cur);
    if constexpr (SP2) {
        PG8_STAGE(PG8_SB(0, 0), cB, voffB); PG8_STAGE(PG8_SB(0, 1), cB + hstep, voffB); PG8_STAGE(PG8_SA(0, 0), cA, voffA); PG8_STAGE(PG8_SA(0, 1), cA + hstep, voffA);
        if (wr == 1) PG8_BAR;
        PG8_WAIT_V(2); PG8_BAR;
        PG8_STAGE(PG8_SB(1, 0), cB + kstep, voffB); PG8_STAGE(PG8_SA(1, 0), cA + kstep, voffA); PG8_STAGE(PG8_SB(1, 1), cB + hstep + kstep, voffB);
        PG8_WAIT_V(6); PG8_BAR;
    } else {
        PG8_STAGE(PG8_SB(0, 0), cB, voffB); PG8_STAGE(PG8_SA(0, 0), cA, voffA); PG8_STAGE(PG8_SB(0, 1), cB + hstep, voffB); PG8_STAGE(PG8_SA(0, 1), cA + hstep, voffA);
        if (wr == 1) PG8_BAR;
        PG8_WAIT_V(4); PG8_BAR;
        PG8_STAGE(PG8_SB(1, 0), cB + kstep, voffB); PG8_STAGE(PG8_SA(1, 0), cA + kstep, voffA); PG8_STAGE(PG8_SB(1, 1), cB + hstep + kstep, voffB);
        PG8_WAIT_V(6); PG8_BAR;
    }
    for (;;) {
        const bool has_next = S.next(ui + 1, nxt);
        const char* nA = has_next ? (const char*)g.A + (size_t)nxt.pm * tstep : cA; const char* nB = has_next ? (const char*)g.Bt + (size_t)nxt.pn * tstep : cB;
        for (int t = 0; t < nt; t += 2) {
            const bool last = (t == nt - 2);
            const char* a1 = cA + (size_t)(t + 1) * kstep;
            const char* a2 = last ? nA : cA + (size_t)(t + 2) * kstep; const char* b2 = last ? nB : cB + (size_t)(t + 2) * kstep;
            const char* a3 = a2 + kstep; const char* b3 = b2 + kstep;
            if (last && has_next) S.a_ready(nxt);
            if constexpr (SP2) {
            PG8_LDB(B0, 0, 0); PG8_LDB(B1, 0, 1); PG8_SCHED; PG8_LDA(At, 0, 0); PG8_STAGE(PG8_SA(1, 1), a1 + hstep, voffA);
            PG8_WAIT_V(8); PG8_WAIT_L(0); PG8_BAR; PG8_MMA(0, 0, At, B0); PG8_MMA(0, 1, At, B1); PG8_BAR; PG8_SCHED;
            PG8_LDA(At, 0, 1); PG8_STAGE(PG8_SB(0, 0), b2, voffB); PG8_STAGE(PG8_SB(0, 1), b2 + hstep, voffB); PG8_STAGE(PG8_SA(0, 0), a2, voffA);
            PG8_WAIT_V(8); PG8_WAIT_L(0); PG8_BAR; PG8_MMA(1, 0, At, B0); PG8_MMA(1, 1, At, B1); PG8_BAR; PG8_SCHED;
            PG8_LDB(B0, 1, 0); PG8_LDB(B1, 1, 1); PG8_SCHED; PG8_LDA(At, 1, 0); PG8_STAGE(PG8_SA(0, 1), a2 + hstep, voffA);
            PG8_WAIT_V(8); PG8_WAIT_L(0); PG8_BAR; PG8_MMA(0, 0, At, B0); PG8_MMA(0, 1, At, B1); PG8_BAR; PG8_SCHED;
            PG8_LDA(At, 1, 1); PG8_STAGE(PG8_SB(1, 0), b3, voffB); PG8_STAGE(PG8_SB(1, 1), b3 + hstep, voffB); PG8_STAGE(PG8_SA(1, 0), a3, voffA);
            PG8_WAIT_V(8); PG8_WAIT_L(0); PG8_BAR; PG8_MMA(1, 0, At, B0); PG8_MMA(1, 1, At, B1); PG8_BAR; PG8_SCHED;
            } else {
            PG8_LDB(B0, 0, 0); PG8_SCHED; PG8_LDA(At, 0, 0); PG8_STAGE(PG8_SA(1, 1), a1 + hstep, voffA);
            PG8_WAIT_L(8); PG8_BAR; PG8_WAIT_L(0); PG8_MMA(0, 0, At, B0); PG8_BAR; PG8_SCHED;
            PG8_LDB(B1, 0, 1); PG8_STAGE(PG8_SB(0, 0), b2, voffB);
            PG8_BAR; PG8_WAIT_L(0); PG8_MMA(0, 1, At, B1); PG8_BAR;
            PG8_LDA(At, 0, 1); PG8_STAGE(PG8_SA(0, 0), a2, voffA);
            PG8_BAR; PG8_WAIT_L(0); PG8_MMA(1, 0, At, B0); PG8_BAR; PG8_SCHED;
            PG8_STAGE(PG8_SB(0, 1), b2 + hstep, voffB);
            PG8_WAIT_V(6); PG8_BAR; PG8_MMA(1, 1, At, B1); PG8_BAR;
            PG8_LDB(B0, 1, 0); PG8_SCHED; PG8_LDA(At, 1, 0); PG8_STAGE(PG8_SA(0, 1), a2 + hstep, voffA);
            PG8_WAIT_L(8); PG8_BAR; PG8_WAIT_L(0); PG8_MMA(0, 0, At, B0); PG8_BAR; PG8_SCHED;
            PG8_LDB(B1, 1, 1); PG8_STAGE(PG8_SB(1, 0), b3, voffB);
            PG8_BAR; PG8_WAIT_L(0); PG8_MMA(0, 1, At, B1); PG8_BAR;
            PG8_LDA(At, 1, 1); PG8_STAGE(PG8_SA(1, 0), a3, voffA);
            PG8_BAR; PG8_WAIT_L(0); PG8_MMA(1, 0, At, B0); PG8_BAR; PG8_SCHED;
            PG8_STAGE(PG8_SB(1, 1), b3 + hstep, voffB);
            PG8_WAIT_V(6); PG8_BAR; PG8_MMA(1, 1, At, B1); PG8_BAR;
            }
        }
        if constexpr (ALIGN_EPI) { if (wr == 0) PG8_BAR; }
        if constexpr (!Epi::AFTER_DRAIN) { E(acc, cur, wr, wc, fr, fq); S.done(cur); }
        if (!has_next) break;
#pragma unroll
        for (int a = 0; a < 2; ++a)
#pragma unroll
            for (int b = 0; b < 2; ++b)
#pragma unroll
                for (int m = 0; m < 4; ++m)
#pragma unroll
                    for (int n = 0; n < 2; ++n) acc[a][b][m][n] = (f32x4){0.f, 0.f, 0.f, 0.f};
        cur = nxt; cA = nA; cB = nB; ++ui;
        if constexpr (ALIGN_EPI) { if (wr == 1) PG8_BAR; }
    }
    PG8_WAIT_V(0);
    if constexpr (!ALIGN_EPI) { if (wr == 0) PG8_BAR; }
    PG8_BAR;
    if constexpr (Epi::AFTER_DRAIN) { E.fused(acc, cur, wr, wc, fr, fq, lds, wid, lane); S.done(cur); }
#undef PG8_SA
#undef PG8_SB
#undef PG8_STAGE
#undef PG8_LDA
#undef PG8_LDB
#undef PG8_MMA
#undef PG8_WAIT_V
#undef PG8_WAIT_L
#undef PG8_BAR
#undef PG8_SCHED
}
}
#define LAS __attribute__((address_space(3)))
#define XB_TMO      128
#define XB_XCNT(j)  (256  + 64 * (j))
#define XB_XSUB(j)  (1280 + 64 * (j))
#define XB_XGEN(j)  (2304 + 64 * (j))
#define XB_TOP      3328
#define XB_TOPGEN   3392
#define XCD_BAR_WORDS 3456
#define XB_SPIN_CAP (1u << 18)

__device__ __forceinline__ unsigned xb_ld(unsigned* p)              { return __hip_atomic_load(p, __ATOMIC_RELAXED, __HIP_MEMORY_SCOPE_AGENT); }
__device__ __forceinline__ unsigned xb_add(unsigned* p, unsigned v) { return __hip_atomic_fetch_add(p, v, __ATOMIC_RELAXED, __HIP_MEMORY_SCOPE_AGENT); }
__device__ __forceinline__ unsigned xb_xcc_id() { return (unsigned)__builtin_amdgcn_s_getreg((3 << 11) | 20) & 0xFu; }
#define XB_SPIN(cond, bar) do { unsigned _sp = 0; while (cond) { __builtin_amdgcn_s_sleep(1); \
    if ((++_sp & 255u) == 0u) { if (xb_ld(&(bar)[XB_TMO])) break; if (_sp > XB_SPIN_CAP) { atomicAdd(&(bar)[XB_TMO], 1u); break; } } } } while (0)

struct XcdBarrier {
    unsigned* bar; unsigned x;
    volatile LAS unsigned* st;
};

__device__ __forceinline__ XcdBarrier xcd_barrier_post(unsigned* bar, volatile LAS unsigned* st) {
    XcdBarrier b; b.bar = bar; b.x = xb_xcc_id(); b.st = st;
    if (threadIdx.x == 0) (void)xb_add(&bar[XB_XCNT(b.x)], 1u);
    return b;
}
__device__ __forceinline__ void xcd_barrier_complete(unsigned* bar, unsigned x, unsigned& nloc, unsigned& nx) {
    const unsigned G = gridDim.x * gridDim.y * gridDim.z;
    unsigned sum, cnt, mine, sp = 0u;
    for (;;) {
        sum = 0u; cnt = 0u; mine = 0u;
#pragma unroll
        for (unsigned j = 0; j < 16; ++j) { const unsigned c = xb_ld(&bar[XB_XCNT(j)]); sum += c; cnt += (c > 0u) ? 1u : 0u; mine = (j == x) ? c : mine; }
        if (sum == G) break;
        __builtin_amdgcn_s_sleep(1);
        if ((++sp & 255u) == 0u) { if (xb_ld(&bar[XB_TMO])) break; if (sp > XB_SPIN_CAP) { atomicAdd(&bar[XB_TMO], 1u); break; } }
    }
    nloc = mine > 0u ? mine : 1u; nx = cnt > 0u ? cnt : 1u;
}

__device__ __forceinline__ void xcd_barrier(const XcdBarrier& b) {
    asm volatile("s_waitcnt vmcnt(0)" ::: "memory");
    __syncthreads();
    if (threadIdx.x == 0) {
        unsigned* bar = b.bar;
        __builtin_amdgcn_s_waitcnt(0);
        unsigned nloc = b.st[0], nx = b.st[1];
        if (nloc == 0u) { xcd_barrier_complete(bar, b.x, nloc, nx); b.st[0] = nloc; b.st[1] = nx; }
        const unsigned old = xb_add(&bar[XB_XSUB(b.x)], 1u);
        const unsigned gen = old / nloc;
        if (old + 1u == (gen + 1u) * nloc) {
            __builtin_amdgcn_fence(__ATOMIC_RELEASE, "agent");
            asm volatile("s_waitcnt vmcnt(0)" ::: "memory");
            const unsigned og = xb_add(&bar[XB_TOP], 1u);
            const unsigned tg = og / nx;
            if (og + 1u == (tg + 1u) * nx) xb_add(&bar[XB_TOPGEN], 1u);
            else XB_SPIN(xb_ld(&bar[XB_TOPGEN]) == tg, bar);
            __builtin_amdgcn_fence(__ATOMIC_ACQUIRE, "agent");
            xb_add(&bar[XB_XGEN(b.x)], 1u);
            asm volatile("s_waitcnt vmcnt(0)" ::: "memory");
        } else {
            XB_SPIN(xb_ld(&bar[XB_XGEN(b.x)]) == gen, bar);
            __builtin_amdgcn_fence(__ATOMIC_ACQUIRE, "agent");
            asm volatile("s_waitcnt vmcnt(0)" ::: "memory");
        }
    }
    __syncthreads();
}
#undef LAS
#ifndef RET_MODE
#define RET_MODE 1
#endif
#ifndef NSA_INLINE
#define NSA_INLINE __forceinline__
#endif
#ifndef DRY_MODE
#define DRY_MODE 0
#endif
#ifndef RET_WG
#define RET_WG 1
#endif
#ifndef PROBE_DUP
#define PROBE_DUP 0
#endif
#ifndef DBG_BRUTE
#define DBG_BRUTE 0
#endif
#ifndef DBG_ZERO
#define DBG_ZERO 0
#endif
constexpr int NWAVES = 8;
constexpr int NB = 16, SEQ = 2048, DM = 1024, MTOK = NB * SEQ, FF = 2816, NMEMT = 256, MMEM = NB * NMEMT, DEPTH = 4;
constexpr float EPS = 1e-6f;
constexpr float QSCALE = 0.125f * 1.4426950408889634f;
constexpr int RET_LD = 2560, RET_Q = 0, RET_K = 384, RET_V = 768, RET_G = 1536, RET_QM = 2304;
constexpr int DSA_LD = 1792, DSA_Q = 0, DSA_K = 768, DSA_V = 832, DSA_IQ = 896, DSA_IK = 1408, DSA_IW = 1472, DSA_QM = 1480, DSA_COLS = 1736;
constexpr int NSA_LD = 2816, NSA_Q = 0, NSA_KC = 768, NSA_VC = 1024, NSA_KS = 1280, NSA_VS = 1536, NSA_KW = 1792, NSA_VW = 2048, NSA_QM = 2304, NSA_GT = 2560;
constexpr int NSA_SRC_GT = 2304, NSA_SRC_QM = 2340, NSA_COLS = 2596;

constexpr size_t MiB = 1u << 20;
constexpr size_t WS_CTL = 0, CTL_ZERO_BYTES = 1 * MiB;
constexpr size_t WS_PART = 1 * MiB;
constexpr size_t WS_PARTM = 3 * MiB;
constexpr size_t WS_ROPE = 3 * MiB + 512 * 1024;
constexpr size_t WS_MISC = 4 * MiB;
constexpr size_t WS_CMPW = 4 * MiB + 64 * 1024;
constexpr size_t WS_KCMP = 5 * MiB;
constexpr size_t WS_VCMPT = 6 * MiB;
constexpr size_t WS_MK = 7 * MiB;
constexpr size_t WS_MVT = 15 * MiB;
constexpr size_t WS_MEMB = 23 * MiB;
constexpr size_t WS_MKV = 31 * MiB;
constexpr size_t WS_WKV = 47 * MiB;
constexpr size_t WS_WBUF0 = 51 * MiB, WBUF_BYTES = 41 * MiB;
constexpr size_t WS_XB = 133 * MiB;
constexpr size_t WS_Y = 197 * MiB;
constexpr size_t WS_HID = 261 * MiB;
constexpr size_t WS_SC = 373 * MiB;
constexpr size_t WS_MB = 501 * MiB;
constexpr size_t WS_END = 509 * MiB;
static_assert(WS_HID + (size_t)MTOK * FF * 2 <= WS_MB && WS_SC + (size_t)MTOK * SEQ * 2 <= WS_MB && WS_WBUF0 + 2 * WBUF_BYTES <= WS_XB, "d_ws map");
constexpr size_t WB_W1A = 0, WB_W2A = WB_W1A + (size_t)2 * FF * DM, WB_W1B = WB_W2A + (size_t)DM * FF, WB_W2B = WB_W1B + (size_t)2 * FF * DM,
                 WB_WIN = WB_W2B + (size_t)DM * FF, WB_WO = WB_WIN + (size_t)NSA_LD * DM, WB_END = WB_WO + (size_t)DM * DM;
static_assert(WB_END * 2 <= WBUF_BYTES, "weight buffer");
constexpr int CW_BAR = 4096;
constexpr int CW_CK = 32768;
constexpr int CW_Q = 16384;

#define GAS __attribute__((address_space(1)))
#define LAS __attribute__((address_space(3)))
typedef unsigned short bf16;
typedef unsigned v4u __attribute__((ext_vector_type(4)));
typedef unsigned v2u __attribute__((ext_vector_type(2)));
typedef float f32x4 __attribute__((ext_vector_type(4)));
typedef float f32x16 __attribute__((ext_vector_type(16)));
typedef short bf16x8 __attribute__((ext_vector_type(8)));
typedef GAS unsigned gu32;
#define RLX_AGENT __ATOMIC_RELAXED, __HIP_MEMORY_SCOPE_AGENT
#define LDS_WAIT() asm volatile("s_waitcnt lgkmcnt(0)" ::: "memory")
#define VM_WAIT() asm volatile("s_waitcnt vmcnt(0)" ::: "memory")
__device__ __forceinline__ unsigned f2bf(float f) { unsigned u = __builtin_bit_cast(unsigned, f); return (u + 0x7fffu + ((u >> 16) & 1u)) >> 16; }
__device__ __forceinline__ unsigned pk2(float lo, float hi) { return pg8::cvt_pk_bf16(lo, hi); }
__device__ __forceinline__ float bf2f(unsigned h) { return __builtin_bit_cast(float, h << 16); }
__device__ __forceinline__ float bflo(unsigned w) { return __builtin_bit_cast(float, w << 16); }
__device__ __forceinline__ float bfhi(unsigned w) { return __builtin_bit_cast(float, w & 0xffff0000u); }
struct Args { const float* in[23]; float* out; unsigned char* ws; int ph_lo, ph_hi, dry, pad; };
typedef const __attribute__((address_space(4))) Args* KArgs;
struct Frame {
    LAS unsigned char* lds;
    volatile LAS unsigned* MISC;
    gu32* ctl;
    int tid, lane, wave, G, gw, NGW;
    unsigned char* ws;
    KArgs ka;
    float* out;
};
__device__ __forceinline__ float wave_sum(float v) {
#pragma unroll
    for (int o = 1; o < 64; o <<= 1) v += __shfl_xor(v, o);
    return v;
}
__device__ __forceinline__ float wave_max(float v) {
#pragma unroll
    for (int o = 1; o < 64; o <<= 1) v = fmaxf(v, __shfl_xor(v, o));
    return v;
}
__device__ __forceinline__ int grab(gu32* ctr, int lane) { unsigned v = 0; if (lane == 0) v = __hip_atomic_fetch_add(ctr, 1u, RLX_AGENT); return __builtin_amdgcn_readfirstlane((int)v); }

__device__ __forceinline__ void cvt_item(const float* W, int ldw, const float* gain, bf16* WT, int K, LAS float* scr, int k0, int src_col0, int nvalid, int dst_row0, int lane) {
    const int c = lane & 31;
#pragma unroll 8
    for (int i = 0; i < 32; ++i) { const int kk = 2 * i + (lane >> 5); float v = 0.f;
        if (c < nvalid) { v = W[(size_t)(k0 + kk) * ldw + src_col0 + c]; if (gain) v *= gain[k0 + kk]; }
        scr[kk * 33 + c] = v; }
    LDS_WAIT(); asm volatile("" ::: "memory");
    const int c8 = lane & 7;
#pragma unroll
    for (int j = 0; j < 4; ++j) { const int n = (lane >> 3) + 8 * j; const LAS float* s = scr + (8 * c8) * 33 + n;
        v4u o; o.x = pk2(s[0 * 33], s[1 * 33]); o.y = pk2(s[2 * 33], s[3 * 33]); o.z = pk2(s[4 * 33], s[5 * 33]); o.w = pk2(s[6 * 33], s[7 * 33]);
        *(GAS v4u*)(WT + (size_t)(dst_row0 + n) * K + k0 + 8 * c8) = o; }
    LDS_WAIT(); asm volatile("" ::: "memory");
}
__device__ __forceinline__ void cvt_matrix(Frame& F, int& it_base, const float* W, const float* W2, int ldw, int ncols, const float* gain, bf16* WT, int K, int nrows_dst, int kind) {
    LAS float* scr = (LAS float*)(F.lds + F.wave * 16384);
    const int nkb = K / 64, njb = nrows_dst / 32, nitems = nkb * njb;
    int first = (F.gw - it_base % F.NGW + F.NGW) % F.NGW;
    for (int i = first; i < nitems; i += F.NGW) {
        const int kb = i / njb, jb = i % njb; const float* src = W; int sc0 = jb * 32, nv = 32;
        if (kind == 0) { nv = ncols - sc0; nv = nv < 0 ? 0 : (nv > 32 ? 32 : nv); }
        else if (kind == 1) { const int c = jb * 32, pn = c >> 8, bj = (c >> 7) & 1, j = c & 127; src = bj ? W2 : W; sc0 = pn * 128 + j; }
        else { const int c = jb * 32;
            if (c < NSA_QM) { sc0 = c; }
            else if (c < NSA_GT) { sc0 = NSA_SRC_QM + (c - NSA_QM); }
            else { sc0 = NSA_SRC_GT + (c - NSA_GT); nv = NSA_SRC_QM - sc0; nv = nv < 0 ? 0 : (nv > 32 ? 32 : nv); } }
        cvt_item(src, ldw, gain, WT, K, scr, kb * 64, sc0, nv, jb * 32, F.lane);
    }
    it_base += nitems;
}
__device__ __forceinline__ void convert_layer(Frame& F, int Ly) {
    bf16* WB = (bf16*)(F.ws + WS_WBUF0 + (size_t)(Ly & 1) * WBUF_BYTES);
    const float* fnorm = F.ka->in[2]; const float* wg = F.ka->in[3]; const float* wu = F.ka->in[4]; const float* wd = F.ka->in[5];
    int itb = 0;
#pragma unroll 1
    for (int hf = 0; hf < 2; ++hf) {
        const size_t o1 = (size_t)(Ly * 2 + hf) * DM * FF;
        cvt_matrix(F, itb, wg + o1, wu + o1, FF, FF, fnorm + (size_t)(Ly * 2 + hf) * DM, WB + (hf ? WB_W1B : WB_W1A), DM, 2 * FF, 1);
        cvt_matrix(F, itb, wd + o1, nullptr, DM, DM, nullptr, WB + (hf ? WB_W2B : WB_W2A), FF, DM, 0);
    }
    const float* mnorm = F.ka->in[6] + (size_t)Ly * DM;
    const int kind = Ly % 3, j = Ly / 3;
    if (kind == 0) cvt_matrix(F, itb, F.ka->in[12] + (size_t)j * DM * RET_LD, nullptr, RET_LD, RET_LD, mnorm, WB + WB_WIN, DM, RET_LD, 0);
    else if (kind == 1) cvt_matrix(F, itb, F.ka->in[13] + (size_t)j * DM * DSA_COLS, nullptr, DSA_COLS, DSA_COLS, mnorm, WB + WB_WIN, DM, DSA_LD, 0);
    else cvt_matrix(F, itb, F.ka->in[16] + (size_t)j * DM * NSA_COLS, nullptr, NSA_COLS, NSA_COLS, mnorm, WB + WB_WIN, DM, NSA_LD, 2);
    cvt_matrix(F, itb, F.ka->in[7] + (size_t)Ly * DM * DM, nullptr, DM, DM, nullptr, WB + WB_WO, DM, DM, 0);
}

__device__ __forceinline__ void xform(Frame& F, const bf16* src, int spitch, int scol0, int nheads, int rows, int Lr, bf16* dst, int dmode, int dpitch, int dcol0,
                                      const float* gain, bool rope, float cscale, int decay  ) {
    const float* tab = (const float*)(F.ws + WS_ROPE);
    const int i8 = F.lane & 7, sub = F.lane >> 3; const int items = rows * nheads;
    float gn[8];
#pragma unroll
    for (int j = 0; j < 8; ++j) gn[j] = gain ? gain[8 * i8 + j] : 1.f;
    constexpr int U = 4;
    for (int it0 = F.gw * (8 * U); it0 < items; it0 += F.NGW * (8 * U)) {
        v4u raw[U]; f32x4 c0[U], c1[U], s0[U], s1[U];
#pragma unroll
        for (int u = 0; u < U; ++u) { const int it = it0 + 8 * u + sub; const int row = it / nheads, h = it % nheads, t = row % Lr;
            raw[u] = *(const GAS v4u*)(src + (size_t)row * spitch + scol0 + h * 64 + 8 * i8);
            if (rope) { const float* tr = tab + (size_t)t * 64 + 8 * (i8 & 3);
                c0[u] = *(const GAS f32x4*)(tr); c1[u] = *(const GAS f32x4*)(tr + 4); s0[u] = *(const GAS f32x4*)(tr + 32); s1[u] = *(const GAS f32x4*)(tr + 36); } }
#pragma unroll
        for (int u = 0; u < U; ++u) { const int it = it0 + 8 * u + sub; const int row = it / nheads, h = it % nheads, t = row % Lr;
            float v[8] = {bflo(raw[u].x), bfhi(raw[u].x), bflo(raw[u].y), bfhi(raw[u].y), bflo(raw[u].z), bfhi(raw[u].z), bflo(raw[u].w), bfhi(raw[u].w)};
            if (gain) { float ss = 0.f;
#pragma unroll
                for (int j = 0; j < 8; ++j) ss += v[j] * v[j];
                ss += __shfl_xor(ss, 1); ss += __shfl_xor(ss, 2); ss += __shfl_xor(ss, 4);
                const float r = __builtin_amdgcn_rsqf(ss * (1.f / 64.f) + EPS);
#pragma unroll
                for (int j = 0; j < 8; ++j) v[j] = v[j] * r * gn[j]; }
            if (rope) {
                const float cs[8] = {c0[u][0], c0[u][1], c0[u][2], c0[u][3], c1[u][0], c1[u][1], c1[u][2], c1[u][3]}, sn[8] = {s0[u][0], s0[u][1], s0[u][2], s0[u][3], s1[u][0], s1[u][1], s1[u][2], s1[u][3]};
#pragma unroll
                for (int j = 0; j < 8; ++j) { const float p = __shfl_xor(v[j], 4); v[j] = (i8 < 4) ? (v[j] * cs[j] - p * sn[j]) : (v[j] * cs[j] + p * sn[j]); } }
            float f = cscale;
            if (decay) { const float lg = __builtin_amdgcn_logf(1.0f - __builtin_amdgcn_exp2f(-5.0f - (float)h)); f *= __builtin_amdgcn_exp2f((float)(decay * t) * lg); }
            v4u o; o.x = pk2(v[0] * f, v[1] * f); o.y = pk2(v[2] * f, v[3] * f); o.z = pk2(v[4] * f, v[5] * f); o.w = pk2(v[6] * f, v[7] * f);
            bf16* dp = dmode == 0 ? dst + (size_t)row * dpitch + dcol0 + h * 64 + 8 * i8 : dst + ((size_t)((row / Lr) * nheads + h) * Lr + t) * 64 + 8 * i8;
            *(GAS v4u*)dp = o; }
    }
}
__device__ __forceinline__ void transpose_cols(Frame& F, const bf16* src, int spitch, int scol0, int ncols, int nb, int Lr, bf16* dst) {
    LAS bf16* scr = (LAS bf16*)(F.lds + F.wave * 16384);
    const int ntt = Lr / 64, nct = ncols / 64, ntiles = nb * ntt * nct; const int i8 = F.lane & 7, sub = F.lane >> 3;
    for (int tl = F.gw; tl < ntiles; tl += F.NGW) {
        const int ct = tl % nct, tt = (tl / nct) % ntt, b = tl / (nct * ntt); const int t0 = tt * 64, c0 = ct * 64;
#pragma unroll
        for (int k = 0; k < 8; ++k) { const int r = sub + 8 * k;
            const v4u raw = *(const GAS v4u*)(src + (size_t)(b * Lr + t0 + r) * spitch + scol0 + c0 + 8 * i8);
            *(LAS v4u*)(scr + r * 72 + 8 * i8) = raw; }
        LDS_WAIT(); asm volatile("" ::: "memory");
        bf16* drow = dst + ((size_t)b * ncols + c0 + F.lane) * Lr + t0;
#pragma unroll
        for (int k = 0; k < 8; ++k) { unsigned w[4];
#pragma unroll
            for (int q = 0; q < 4; ++q) { const unsigned lo = scr[(8 * k + 2 * q) * 72 + F.lane], hi = scr[(8 * k + 2 * q + 1) * 72 + F.lane]; w[q] = lo | (hi << 16); }
            v4u o; o.x = w[0]; o.y = w[1]; o.z = w[2]; o.w = w[3]; *(GAS v4u*)(drow + 8 * k) = o; }
        LDS_WAIT(); asm volatile("" ::: "memory");
    }
}
__device__ __forceinline__ void row_to_bf16(Frame& F, const float* xrow, bf16* orow, float* part) {
    const GAS f32x4* xr = (const GAS f32x4*)xrow + F.lane;
    f32x4 v[4]; float s = 0.f;
#pragma unroll
    for (int j = 0; j < 4; ++j) { v[j] = xr[64 * j]; s += (v[j].x * v[j].x + v[j].y * v[j].y) + (v[j].z * v[j].z + v[j].w * v[j].w); }
    s = wave_sum(s);
    GAS v2u* o8 = (GAS v2u*)orow + F.lane;
#pragma unroll
    for (int j = 0; j < 4; ++j) { v2u o; o.x = pk2(v[j].x, v[j].y); o.y = pk2(v[j].z, v[j].w); o8[64 * j] = o; }
    if (F.lane < 16) part[F.lane] = F.lane == 0 ? s : 0.f;
}
enum { MK_NONE = 0, MK_CAUSAL = 1, MK_WIN = 2, MK_BITS = 3, MK_SLC = 4, MK_CMP = 5 };
struct KVp { const bf16* K; int kpitch; const bf16* VT; int vpitch; };
struct MaskArg { int q0[3]; const unsigned* mb; unsigned sel; int nmax; float lg; };
__device__ __forceinline__ bf16x8 ld8(const bf16* p) { return *(const GAS bf16x8*)p; }
__device__ __forceinline__ float fast_exp2(float x) { return __builtin_amdgcn_exp2f(x); }

template <int NS, int NT, int MODE, int MT, int PF = 2>
__device__ __forceinline__ void attn_core(const LAS bf16x8* ql, const KVp kv, int kt0, int kt1, float negb, const MaskArg& ma, const unsigned* const (&mbrow)[NS],
                                          f32x16 (&O)[NS][NT], float (&lsum)[NS], int lane) {
    const int r32 = lane & 31, hi = lane >> 5;
    const int kperm = (r32 & 0x13) | ((r32 & 4) << 1) | ((r32 & 8) >> 1);
    const bf16* kp = kv.K + (size_t)kperm * kv.kpitch + 8 * hi;
    const bf16* vp = kv.VT + (size_t)r32 * kv.vpitch + 8 * hi;
    bf16x8 kf[4], vf[2][NT], kfn[4], vfn[2][NT];
#define AC_LOADK(dst, kt_) do { const bf16* kq_ = kp + (size_t)(32 * (kt_)) * kv.kpitch; _Pragma("unroll") for (int ks = 0; ks < 4; ++ks) dst[ks] = ld8(kq_ + 16 * ks); } while (0)
#define AC_LOADV(dst, kt_) do { _Pragma("unroll") for (int nt = 0; nt < NT; ++nt) { const bf16* vq_ = vp + (size_t)(32 * nt) * kv.vpitch + 32 * (kt_); dst[0][nt] = ld8(vq_); dst[1][nt] = ld8(vq_ + 16); } } while (0)
    unsigned mw[NS], mwn[NS];
    if (kt0 < kt1) { if (PF >= 1) AC_LOADK(kf, kt0); if (PF >= 2) AC_LOADV(vf, kt0);
        if (MT == MK_BITS) { _Pragma("unroll") for (int s = 0; s < NS; ++s) mw[s] = mbrow[s][kt0]; } }
#pragma unroll 1
    for (int kt = kt0; kt < kt1; ++kt) {
        unsigned selbit = 1u; bool active = true;
        if (MT == MK_SLC) { selbit = (ma.sel >> (kt >> 1)) & 1u; active = __any(selbit != 0u); }
        const int ktn = (kt + 1 < kt1) ? kt + 1 : kt;
        if (PF == 0) { if (active) { AC_LOADK(kf, kt); AC_LOADV(vf, kt); } }
        else { AC_LOADK(kfn, ktn); if (PF >= 2) AC_LOADV(vfn, ktn); else if (active) AC_LOADV(vf, kt); }
        if (MT == MK_BITS) { _Pragma("unroll") for (int s = 0; s < NS; ++s) mwn[s] = mbrow[s][ktn]; }
        if (active) {
        const LAS bf16x8* qlp = ql; asm volatile("" : "+v"(qlp));
#pragma unroll
        for (int s = 0; s < NS; ++s) {
            f32x16 acc;
#pragma unroll
            for (int r = 0; r < 16; ++r) acc[r] = 0.f;
#pragma unroll
            for (int ks = 0; ks < 4; ++ks) acc = __builtin_amdgcn_mfma_f32_32x32x16_bf16(kf[ks], qlp[(s * 4 + ks) * 64], acc, 0, 0, 0);
            const int tq = ma.q0[s] + r32, kb = 32 * kt + 8 * hi;
            bool full = true;
            if (MT == MK_CAUSAL) full = (32 * kt + 31 <= ma.q0[s]);
            if (MT == MK_WIN) full = (32 * kt + 31 <= ma.q0[s]) && (32 * kt >= ma.q0[s] + 31 - 511);
            if (MT == MK_SLC) full = (32 * kt + 31 <= ma.q0[s]) && __all(selbit != 0u);
            if (MT == MK_BITS || MT == MK_CMP) full = false;
            float p[16];
            if (full) {
#pragma unroll
                for (int r = 0; r < 16; ++r) { const int key = kb + 16 * (r >> 3) + (r & 7); p[r] = MODE == 0 ? fast_exp2(acc[r]) : (MODE == 1 ? acc[r] : acc[r] * fast_exp2((float)(tq - key) * ma.lg)); }
            } else {
                unsigned w = 0;
                if (MT == MK_BITS) w = mw[s];
#pragma unroll
                for (int r = 0; r < 16; ++r) { const int key = kb + 16 * (r >> 3) + (r & 7); bool v = true;
                    if (MT == MK_CAUSAL) v = key <= tq;
                    if (MT == MK_WIN) v = (key <= tq) && (key >= tq - 511);
                    if (MT == MK_SLC) v = (key <= tq) && (selbit != 0u);
                    if (MT == MK_BITS) v = (w >> (8 * hi + 16 * (r >> 3) + (r & 7))) & 1u;
                    if (MT == MK_CMP) v = key <= ma.nmax;
                    const float e = MODE == 0 ? fast_exp2(acc[r]) : (MODE == 1 ? acc[r] : acc[r] * fast_exp2((float)((tq - key) < 0 ? 0 : (tq - key)) * ma.lg));
                    p[r] = v ? e : 0.f; }
            }
            if (MODE == 0) { float a = 0.f;
#pragma unroll
                for (int r = 0; r < 16; ++r) a += p[r];
                lsum[s] += a; }
            bf16x8 pk0, pk1;
            { v4u t0, t1; t0.x = pk2(p[0], p[1]); t0.y = pk2(p[2], p[3]); t0.z = pk2(p[4], p[5]); t0.w = pk2(p[6], p[7]);
              t1.x = pk2(p[8], p[9]); t1.y = pk2(p[10], p[11]); t1.z = pk2(p[12], p[13]); t1.w = pk2(p[14], p[15]);
              pk0 = __builtin_bit_cast(bf16x8, t0); pk1 = __builtin_bit_cast(bf16x8, t1); }
#pragma unroll
            for (int nt = 0; nt < NT; ++nt) { O[s][nt] = __builtin_amdgcn_mfma_f32_32x32x16_bf16(pk0, vf[0][nt], O[s][nt], 0, 0, 0);
                                              O[s][nt] = __builtin_amdgcn_mfma_f32_32x32x16_bf16(pk1, vf[1][nt], O[s][nt], 0, 0, 0); }
            if (NS >= 3) __builtin_amdgcn_sched_barrier(0);
        }
        }
        if (MT == MK_BITS) { _Pragma("unroll") for (int s = 0; s < NS; ++s) mw[s] = mwn[s]; }
        if (PF >= 1) {
#pragma unroll
            for (int ks = 0; ks < 4; ++ks) kf[ks] = kfn[ks];
            if (PF >= 2) {
#pragma unroll
                for (int nt = 0; nt < NT; ++nt) { vf[0][nt] = vfn[0][nt]; vf[1][nt] = vfn[1][nt]; } }
        }
    }
#undef AC_LOADK
#undef AC_LOADV
}
__device__ __forceinline__ int crow(int r, int hi) { return (r & 3) + 8 * (r >> 2) + 4 * hi; }
template <int NT, bool ADD>
__device__ __forceinline__ void store_o(const f32x16 (&O)[NT], float f, bf16* Y, int row0, int col0, int lane) {
    const int r32 = lane & 31, hi = lane >> 5;
    unsigned ybase = (unsigned)((row0 + 4 * hi) * 1024 + col0 + r32); asm volatile("" : "+v"(ybase));
#pragma unroll
    for (int rh = 0; rh < 2; ++rh) {
        unsigned short old[NT][8];
        if (ADD) {
#pragma unroll
            for (int ri = 0; ri < 8; ++ri)
#pragma unroll
                for (int nt = 0; nt < NT; ++nt) { const int r = 8 * rh + ri; old[nt][ri] = Y[ybase + (unsigned)(((r & 3) + 8 * (r >> 2)) * 1024) + 32 * nt]; }
        }
#pragma unroll
        for (int ri = 0; ri < 8; ++ri) { const int r = 8 * rh + ri; const int q = crow(r, hi); const float fr = __shfl(f, q);
            const unsigned yo = ybase + (unsigned)(((r & 3) + 8 * (r >> 2)) * 1024);
#pragma unroll
            for (int nt = 0; nt < NT; ++nt) { float v = O[nt][r] * fr; if (ADD) v += bf2f(old[nt][ri]); Y[yo + 32 * nt] = (bf16)f2bf(v); } }
    }
}
template <int NS> __device__ __forceinline__ void stage_q(LAS bf16x8* ql, const bf16* const (&qrow)[NS], int lane) {
    const int hi = lane >> 5;
#pragma unroll
    for (int s = 0; s < NS; ++s)
#pragma unroll
        for (int ks = 0; ks < 4; ++ks) ql[(s * 4 + ks) * 64] = ld8(qrow[s] + 16 * ks + 8 * hi);
    LDS_WAIT(); asm volatile("" ::: "memory");
}
__device__ __forceinline__ LAS bf16x8* wave_q(Frame& F) { return (LAS bf16x8*)(F.lds + F.wave * 16384) + F.lane; }
template <int NS, int NT> __device__ __forceinline__ void zero_o(f32x16 (&O)[NS][NT], float (&l)[NS]) {
#pragma unroll
    for (int s = 0; s < NS; ++s) { l[s] = 0.f;
#pragma unroll
        for (int nt = 0; nt < NT; ++nt)
#pragma unroll
            for (int r = 0; r < 16; ++r) O[s][nt][r] = 0.f; }
}

__device__ __forceinline__ void mem_task(Frame& F, int task, int Ly, const bf16* PROJ, int ldp, int qmcol) {
    const int qb = task & 31, h = (task >> 5) & 3, b = task >> 7; const int r32 = F.lane & 31;
    const int row0 = b * SEQ + 64 * qb;
    const bf16* qrow[2] = {PROJ + (size_t)(row0 + r32) * ldp + qmcol + h * 64, PROJ + (size_t)(row0 + 32 + r32) * ldp + qmcol + h * 64};
    LAS bf16x8* ql = wave_q(F); stage_q<2>(ql, qrow, F.lane);
    KVp kv{(const bf16*)(F.ws + WS_MK) + ((size_t)((Ly * NB + b) * 4 + h) * NMEMT) * 64, 64, (const bf16*)(F.ws + WS_MVT) + ((size_t)(Ly * NB + b) * 256 + h * 64) * NMEMT, NMEMT};
    f32x16 O[2][2]; float l[2]; zero_o<2, 2>(O, l);
    MaskArg ma{}; const unsigned* mbr[2] = {nullptr, nullptr};
    const float negb = 0.f;
    attn_core<2, 2, 0, MK_NONE>(ql, kv, 0, NMEMT / 32, negb, ma, mbr, O, l, F.lane);
    bf16* Y = (bf16*)(F.ws + WS_Y);
#pragma unroll
    for (int s = 0; s < 2; ++s) { const float lt = l[s] + __shfl_xor(l[s], 32); store_o<2, false>(O[s], (DBG_ZERO & 8) ? 0.f : 1.f / lt, Y, row0 + 32 * s, 768 + h * 64, F.lane); }
}
__device__ __forceinline__ void ret_epilogue(Frame& F, const f32x16 (&O)[4], int rowb, int h, const bf16* PROJ) {
    const int r32 = F.lane & 31, hi = F.lane >> 5;
    bf16* Y = (bf16*)(F.ws + WS_Y);
#pragma unroll
    for (int rh = 0; rh < 2; ++rh) {
        unsigned short gv[8][4];
#pragma unroll
        for (int ri = 0; ri < 8; ++ri) { const int r = 8 * rh + ri; const bf16* gp = PROJ + (size_t)(rowb + crow(r, hi)) * RET_LD + RET_G + h * 128 + r32;
#pragma unroll
            for (int nt = 0; nt < 4; ++nt) gv[ri][nt] = gp[32 * nt]; }
#pragma unroll
        for (int ri = 0; ri < 8; ++ri) { const int r = 8 * rh + ri;
            float a = (O[0][r] + O[1][r]) + (O[2][r] + O[3][r]);
#pragma unroll
            for (int o = 1; o < 32; o <<= 1) a += __shfl_xor(a, o);
            const float mu = a * (1.f / 128.f);
            float d0 = O[0][r] - mu, d1 = O[1][r] - mu, d2 = O[2][r] - mu, d3 = O[3][r] - mu;
            float q = (d0 * d0 + d1 * d1) + (d2 * d2 + d3 * d3);
#pragma unroll
            for (int o = 1; o < 32; o <<= 1) q += __shfl_xor(q, o);
            const float rstd = __builtin_amdgcn_rsqf(q * (1.f / 128.f) + EPS);
            const int row = rowb + crow(r, hi);
            bf16* yp = Y + (size_t)row * 1024 + h * 128 + r32;
            const float dd[4] = {d0, d1, d2, d3};
#pragma unroll
            for (int nt = 0; nt < 4; ++nt) { const float g = bf2f(gv[ri][nt]); const float sg = g * __builtin_amdgcn_rcpf(1.f + fast_exp2(-1.4426950408889634f * g));
                yp[32 * nt] = (DBG_ZERO & 1) ? (bf16)0 : (bf16)f2bf(sg * dd[nt] * rstd); }
        }
    }
}
__device__ __forceinline__ void glds16(const void* gsrc, unsigned lds_dst) { unsigned keep;
    asm volatile("s_mov_b32 %0, m0\n\ts_mov_b32 m0, %2\n\ts_nop 0\n\tglobal_load_lds_dwordx4 %1, off\n\ts_mov_b32 m0, %0" : "=&s"(keep) : "v"(gsrc), "s"(lds_dst) : "memory"); }
constexpr int RWG_SLOT = 12288, RWG_R = 9;
__device__ __forceinline__ void ret_wg_task(Frame& F, int task, const bf16* PROJ) {
    const int qb = 7 - (task & 7), h = (task >> 3) % 6, b = (task >> 3) / 6, w = F.wave; const int r32 = F.lane & 31, hi = F.lane >> 5;
    const int rowb = b * SEQ + 256 * qb + 32 * w;
    bf16x8 qf[4];
    { const bf16* qp = PROJ + (size_t)(rowb + r32) * RET_LD + RET_Q + h * 64 + 8 * hi;
#pragma unroll
      for (int ks = 0; ks < 4; ++ks) qf[ks] = ld8(qp + 16 * ks); }
    asm volatile("s_waitcnt vmcnt(0)" : "+v"(qf[0]), "+v"(qf[1]), "+v"(qf[2]), "+v"(qf[3]) :: "memory");
    const int kperm = (r32 & 0x13) | ((r32 & 4) << 1) | ((r32 & 8) >> 1);
    const bf16* ksrc = PROJ + (size_t)(b * SEQ + kperm) * RET_LD + RET_K + h * 64 + 16 * (w & 3) + 8 * hi;
    const bf16* vsrc = (const bf16*)F.out + ((size_t)b * 768 + h * 128 + 32 * (w >> 1) + r32) * SEQ + 16 * (w & 1) + 8 * hi;
    const unsigned lds0 = (unsigned)(uintptr_t)F.lds;
    const unsigned kdst = lds0 + (unsigned)(w & 3) * 1024u, vdst = lds0 + 4096u + (unsigned)w * 1024u;
    const int kt1 = 8 * qb + 8, my1 = 8 * qb + w + 1;
#define RWG_DMA(t_, slot_) do { const int tt_ = (t_) < kt1 ? (t_) : kt1 - 1; const unsigned so_ = (unsigned)(((t_) < kt1) ? (slot_) : RWG_R) * RWG_SLOT; \
        if (w < 4) glds16(ksrc + (size_t)(32 * tt_) * RET_LD, (unsigned)__builtin_amdgcn_readfirstlane(kdst + so_)); \
        glds16(vsrc + 32 * tt_, (unsigned)__builtin_amdgcn_readfirstlane(vdst + so_)); } while (0)
    f32x16 O[4];
#pragma unroll
    for (int nt = 0; nt < 4; ++nt)
#pragma unroll
        for (int r = 0; r < 16; ++r) O[nt][r] = 0.f;
#pragma unroll 1
    for (int j = 0; j < RWG_R - 1; ++j) RWG_DMA(j, j);
    int slot = 0, fslot = RWG_R - 1;
#pragma unroll 1
    for (int kt = 0; kt < kt1; ++kt) {
        if (w < 4) asm volatile("s_waitcnt vmcnt(%0)\n\ts_barrier" :: "n"(2 * (RWG_R - 2)) : "memory");
        else       asm volatile("s_waitcnt vmcnt(%0)\n\ts_barrier" :: "n"(RWG_R - 2) : "memory");
        RWG_DMA(kt + RWG_R - 1, fslot);
        if (kt < my1) {
            const LAS bf16x8* sp = (const LAS bf16x8*)(F.lds + slot * RWG_SLOT) + F.lane;
            bf16x8 kf[4], vf[2][4];
#pragma unroll
            for (int ks = 0; ks < 4; ++ks) kf[ks] = sp[ks * 64];
#pragma unroll
            for (int nt = 0; nt < 4; ++nt) { vf[0][nt] = sp[(4 + 2 * nt) * 64]; vf[1][nt] = sp[(5 + 2 * nt) * 64]; }
            f32x16 acc;
#pragma unroll
            for (int r = 0; r < 16; ++r) acc[r] = 0.f;
#pragma unroll
            for (int ks = 0; ks < 4; ++ks) acc = __builtin_amdgcn_mfma_f32_32x32x16_bf16(kf[ks], qf[ks], acc, 0, 0, 0);
            float p[16];
            if (kt + 1 < my1) {
#pragma unroll
                for (int r = 0; r < 16; ++r) p[r] = acc[r];
            } else {
#pragma unroll
                for (int r = 0; r < 16; ++r) p[r] = (8 * hi + 16 * (r >> 3) + (r & 7) <= r32) ? acc[r] : 0.f;
            }
            bf16x8 pk0, pk1;
            { v4u t0, t1; t0.x = pk2(p[0], p[1]); t0.y = pk2(p[2], p[3]); t0.z = pk2(p[4], p[5]); t0.w = pk2(p[6], p[7]);
              t1.x = pk2(p[8], p[9]); t1.y = pk2(p[10], p[11]); t1.z = pk2(p[12], p[13]); t1.w = pk2(p[14], p[15]);
              pk0 = __builtin_bit_cast(bf16x8, t0); pk1 = __builtin_bit_cast(bf16x8, t1); }
#pragma unroll
            for (int nt = 0; nt < 4; ++nt) { O[nt] = __builtin_amdgcn_mfma_f32_32x32x16_bf16(pk0, vf[0][nt], O[nt], 0, 0, 0);
                                             O[nt] = __builtin_amdgcn_mfma_f32_32x32x16_bf16(pk1, vf[1][nt], O[nt], 0, 0, 0); }
        }
        fslot = slot; slot = slot + 1 == RWG_R ? 0 : slot + 1;
    }
    asm volatile("s_waitcnt vmcnt(0)\n\ts_barrier" ::: "memory");
#undef RWG_DMA
    ret_epilogue(F, O, rowb, h, PROJ);
}
__device__ __forceinline__ void ret_task(Frame& F, int task, const bf16* PROJ) {
    const int qb = 31 - (task & 31), h = (task >> 5) % 6, b = (task >> 5) / 6; const int r32 = F.lane & 31, hi = F.lane >> 5;
    const int row0 = b * SEQ + 64 * qb;
    const bf16* qrow[2] = {PROJ + (size_t)(row0 + r32) * RET_LD + RET_Q + h * 64, PROJ + (size_t)(row0 + 32 + r32) * RET_LD + RET_Q + h * 64};
    LAS bf16x8* ql = wave_q(F); stage_q<2>(ql, qrow, F.lane);
    KVp kv{PROJ + (size_t)(b * SEQ) * RET_LD + RET_K + h * 64, RET_LD, (const bf16*)F.out + ((size_t)b * 768 + h * 128) * SEQ, SEQ};
    f32x16 O[2][4]; float l[2]; zero_o<2, 4>(O, l);
    MaskArg ma{}; ma.q0[0] = 64 * qb; ma.q0[1] = 64 * qb + 32; const unsigned* mbr[2] = {nullptr, nullptr};
    ma.lg = __builtin_amdgcn_logf(1.0f - __builtin_amdgcn_exp2f(-5.0f - (float)h));
    attn_core<2, 4, RET_MODE, MK_CAUSAL, 1>(ql, kv, 0, 2 * qb + 2, 0.f, ma, mbr, O, l, F.lane);
#pragma unroll
    for (int s = 0; s < 2; ++s) ret_epilogue(F, O[s], row0 + 32 * s, h, PROJ);
}

typedef _Float16 h2_t __attribute__((ext_vector_type(2)));
__device__ __forceinline__ unsigned pkh(float a, float b) { h2_t v = {(_Float16)a, (_Float16)b}; return __builtin_bit_cast(unsigned, v); }
__device__ __forceinline__ void dsa_d1_task(Frame& F, int task, const bf16* PROJ) {
    const int b = task / 288; int rem = task % 288; int qb = 63, kc = 0;
    { int grp = 7; while (rem >= 8 * (grp + 1)) { rem -= 8 * (grp + 1); --grp; }
      qb = 8 * grp + 7 - rem / (grp + 1); kc = rem % (grp + 1); }
    const int r32 = F.lane & 31, hi = F.lane >> 5; const int row = b * SEQ + 32 * qb + r32;
    const bf16* qp = PROJ + (size_t)row * DSA_LD + DSA_IQ + 8 * hi;
    bf16x8 qf[4][4]; LAS bf16x8* ql = wave_q(F);
#pragma unroll
    for (int h = 0; h < 4; ++h)
#pragma unroll
        for (int ks = 0; ks < 4; ++ks) { qf[h][ks] = ld8(qp + h * 64 + 16 * ks); ql[(h * 4 + ks) * 64] = ld8(qp + (4 + h) * 64 + 16 * ks); }
    LDS_WAIT(); asm volatile("" ::: "memory");
    float iw[8];
    { const v4u w = *(const GAS v4u*)(PROJ + (size_t)row * DSA_LD + DSA_IW); iw[0] = bflo(w.x); iw[1] = bfhi(w.x); iw[2] = bflo(w.y); iw[3] = bfhi(w.y); iw[4] = bflo(w.z); iw[5] = bfhi(w.z); iw[6] = bflo(w.w); iw[7] = bfhi(w.w); }
    const int kperm = (r32 & 0x13) | ((r32 & 4) << 1) | ((r32 & 8) >> 1);
    const bf16* kp = PROJ + (size_t)(b * SEQ + kperm) * DSA_LD + DSA_IK + 8 * hi;
    _Float16* sc = (_Float16*)(F.ws + WS_SC) + (size_t)row * SEQ + 8 * hi;
    const int kt1 = (8 * kc + 8 < qb + 1) ? 8 * kc + 8 : qb + 1;
    bf16x8 kf[4], kfn[4];
#pragma unroll
    for (int ks = 0; ks < 4; ++ks) kf[ks] = ld8(kp + (size_t)(32 * (8 * kc)) * DSA_LD + 16 * ks);
#pragma unroll 1
    for (int kt = 8 * kc; kt < kt1; ++kt) {
        { const int ktn = kt + 1 < kt1 ? kt + 1 : kt;
#pragma unroll
          for (int ks = 0; ks < 4; ++ks) kfn[ks] = ld8(kp + (size_t)(32 * ktn) * DSA_LD + 16 * ks); }
        float s[16];
#pragma unroll
        for (int r = 0; r < 16; ++r) s[r] = 0.f;
#pragma unroll
        for (int h = 0; h < 8; ++h) { f32x16 acc;
#pragma unroll
            for (int r = 0; r < 16; ++r) acc[r] = 0.f;
#pragma unroll
            for (int ks = 0; ks < 4; ++ks) acc = __builtin_amdgcn_mfma_f32_32x32x16_bf16(kf[ks], h < 4 ? qf[h & 3][ks] : ql[((h & 3) * 4 + ks) * 64], acc, 0, 0, 0);
#pragma unroll
            for (int r = 0; r < 16; ++r) s[r] += iw[h] * fmaxf(acc[r], 0.f);
            __builtin_amdgcn_sched_barrier(0); }
        v4u o0, o1; o0.x = pkh(s[0], s[1]); o0.y = pkh(s[2], s[3]); o0.z = pkh(s[4], s[5]); o0.w = pkh(s[6], s[7]);
        o1.x = pkh(s[8], s[9]); o1.y = pkh(s[10], s[11]); o1.z = pkh(s[12], s[13]); o1.w = pkh(s[14], s[15]);
        *(GAS v4u*)(sc + 32 * kt) = o0; *(GAS v4u*)(sc + 32 * kt + 16) = o1;
#pragma unroll
        for (int ks = 0; ks < 4; ++ks) kf[ks] = kfn[ks];
    }
}
__device__ __forceinline__ int hist_select(LAS unsigned* hist, const unsigned (&key)[32], bool lvl2, unsigned B, int target, int lane) {
    { unsigned z = 0u; asm volatile("" : "+v"(z)); *(LAS v4u*)(hist + 4 * lane) = (v4u){z, z, z, z}; }
    LDS_WAIT(); asm volatile("" ::: "memory");
#pragma unroll
    for (int e = 0; e < 32; ++e) { const unsigned d = lvl2 ? (key[e] & 255u) : (key[e] >> 8); const bool m = lvl2 ? ((key[e] >> 8) == B) : true;
        if (m) __hip_atomic_fetch_add(hist + d, 1u, __ATOMIC_RELAXED, __HIP_MEMORY_SCOPE_WAVEFRONT); }
    LDS_WAIT(); asm volatile("" ::: "memory");
    const v4u c = *(LAS v4u*)(hist + 4 * lane);
    const int s = (int)(c.x + c.y + c.z + c.w);
    int S = s;
#pragma unroll
    for (int o = 1; o < 64; o <<= 1) { const int v = __shfl_down(S, o); if (lane + o < 64) S += v; }
    const unsigned long long bm = __ballot(S >= target);
    const int Ls = 63 - __clzll(bm);
    int a = S - s, dig, abv;
    if (a + (int)c.w >= target) { dig = 3; abv = a; } else { a += (int)c.w;
        if (a + (int)c.z >= target) { dig = 2; abv = a; } else { a += (int)c.z;
            if (a + (int)c.y >= target) { dig = 1; abv = a; } else { a += (int)c.y; dig = 0; abv = a; } } }
    const int packed = ((4 * lane + dig) << 12) | abv;
    const int r = __shfl(packed, Ls);
    LDS_WAIT(); asm volatile("" ::: "memory");
    return r;
}
__device__ __forceinline__ void d2_load(Frame& F, int row, v4u (&raw)[4]) {
    const int t = row % SEQ, lane = F.lane;
    const unsigned short* sp = (const unsigned short*)(F.ws + WS_SC) + (size_t)row * SEQ + (32 * lane <= t ? 32 * lane : 0);
#pragma unroll
    for (int i = 0; i < 4; ++i) raw[i] = *(const GAS v4u*)(sp + 8 * i);
}
__device__ __forceinline__ void dsa_d2_row(Frame& F, int row, const v4u (&raw)[4]) {
    const int t = row % SEQ, lane = F.lane;
    unsigned* mbp = (unsigned*)(F.ws + WS_MB) + (size_t)row * 64;
    int nvalid = t + 1 - 32 * lane; nvalid = nvalid < 0 ? 0 : (nvalid > 32 ? 32 : nvalid);
    const unsigned cb = nvalid == 32 ? 0xffffffffu : ((1u << nvalid) - 1u);
    if (t < 256) { mbp[lane] = cb; return; }
    unsigned key[32];
#pragma unroll
    for (int i = 0; i < 4; ++i) { const unsigned w[4] = {raw[i].x, raw[i].y, raw[i].z, raw[i].w};
#pragma unroll
        for (int j = 0; j < 4; ++j) {
#pragma unroll
            for (int k = 0; k < 2; ++k) { const int e = 8 * i + 2 * j + k; const unsigned u = (w[j] >> (16 * k)) & 0xffffu;
                const unsigned sk = (u & 0x8000u) ? (~u & 0xffffu) : (u | 0x8000u);
                key[e] = (e < nvalid) ? sk : 0u; } } }
    LAS unsigned* hist = (LAS unsigned*)(F.lds + F.wave * 16384);
    const int d1 = hist_select(hist, key, false, 0u, 256, lane);
    const unsigned Bh = (unsigned)d1 >> 12; const int above1 = d1 & 0xfff;
    const int d2 = hist_select(hist, key, true, Bh, 256 - above1, lane);
    const unsigned T = (Bh << 8) | ((unsigned)d2 >> 12);
    const int cgt = above1 + (d2 & 0xfff);
    unsigned g = 0, eq = 0;
#pragma unroll
    for (int e = 0; e < 32; ++e) { unsigned bg = key[e] > T ? 1u : 0u, be = key[e] == T ? 1u : 0u; asm volatile("" : "+v"(bg), "+v"(be));
        g |= bg << e; eq |= be << e; }
    const int need = 256 - cgt; const int myeq = __popc(eq);
    int incl = myeq;
#pragma unroll
    for (int o = 1; o < 64; o <<= 1) { const int v = __shfl_up(incl, o); if (lane >= o) incl += v; }
    const int pre = incl - myeq; int take = need - pre; take = take < 0 ? 0 : (take > myeq ? myeq : take);
    unsigned te = eq; int cnt = myeq;
    while (cnt > take) { te &= ~(1u << (31 - __clz(te))); --cnt; }
    mbp[lane] = (g | te) & cb;
}
__device__ __forceinline__ void dsa_d3_task(Frame& F, int task, const bf16* PROJ) {
    const int hg = task & 3, qb = 63 - ((task >> 2) & 63), b = task >> 8; const int r32 = F.lane & 31;
    const int row0 = b * SEQ + 32 * qb;
    const bf16* qrow[3]; const unsigned* mbr[3];
#pragma unroll
    for (int s = 0; s < 3; ++s) { qrow[s] = PROJ + (size_t)(row0 + r32) * DSA_LD + DSA_Q + (3 * hg + s) * 64; mbr[s] = (const unsigned*)(F.ws + WS_MB) + (size_t)(row0 + r32) * 64; }
    LAS bf16x8* ql = wave_q(F); stage_q<3>(ql, qrow, F.lane);
    KVp kv{PROJ + (size_t)(b * SEQ) * DSA_LD + DSA_K, DSA_LD, (const bf16*)F.out + (size_t)b * 64 * SEQ, SEQ};
    f32x16 O[3][2]; float l[3]; zero_o<3, 2>(O, l);
    MaskArg ma{}; ma.q0[0] = ma.q0[1] = ma.q0[2] = 32 * qb;
    const float negb = 0.f;
    attn_core<3, 2, 0, MK_BITS, 2>(ql, kv, 0, qb + 1, negb, ma, mbr, O, l, F.lane);
    bf16* Y = (bf16*)(F.ws + WS_Y);
#pragma unroll
    for (int s = 0; s < 3; ++s) { const float lt = l[s] + __shfl_xor(l[s], 32); store_o<2, false>(O[s], (DBG_ZERO & 2) ? 0.f : 1.f / lt, Y, row0, (3 * hg + s) * 64, F.lane); }
}

__device__ __forceinline__ void nsa_cmp_task(Frame& F, int task, const bf16* PROJ, const float* kn0) {
    const int nb = task & 3, g = (task >> 2) & 3, b = task >> 4; const int r32 = F.lane & 31, hi = F.lane >> 5;
    const int n = 32 * nb + r32, nc = n > 126 ? 126 : n;
    const bf16* arow = PROJ + (size_t)(b * SEQ + 16 * nc) * NSA_LD + 64 * g + 8 * hi;
    const bf16* WkT = (const bf16*)(F.ws + WS_CMPW); const bf16* WvT = WkT + 64 * 2048;
    const bf16* wkp = WkT + (size_t)r32 * 2048 + 8 * hi; const bf16* wvp = WvT + (size_t)r32 * 2048 + 8 * hi;
    f32x16 Dk[2], Dv[2];
#pragma unroll
    for (int et = 0; et < 2; ++et)
#pragma unroll
        for (int r = 0; r < 16; ++r) { Dk[et][r] = 0.f; Dv[et][r] = 0.f; }
#pragma unroll 4
    for (int kk = 0; kk < 128; ++kk) {
        const bf16* ap = arow + (size_t)(kk >> 2) * NSA_LD + 16 * (kk & 3);
        const bf16x8 kcf = ld8(ap + NSA_KC), vcf = ld8(ap + NSA_VC);
#pragma unroll
        for (int et = 0; et < 2; ++et) { const bf16x8 wk = ld8(wkp + (size_t)(32 * et) * 2048 + 16 * kk), wv = ld8(wvp + (size_t)(32 * et) * 2048 + 16 * kk);
            Dk[et] = __builtin_amdgcn_mfma_f32_32x32x16_bf16(wk, kcf, Dk[et], 0, 0, 0);
            Dv[et] = __builtin_amdgcn_mfma_f32_32x32x16_bf16(vcf, wv, Dv[et], 0, 0, 0); }
    }
    const float* ck = (const float*)(F.ws + WS_CTL) + CW_CK; const float* cv = ck + 64;
    const float* tab = (const float*)(F.ws + WS_ROPE) + (size_t)(16 * nc + 31) * 64;
    float ss = 0.f;
#pragma unroll
    for (int et = 0; et < 2; ++et)
#pragma unroll
        for (int r = 0; r < 16; ++r) { Dk[et][r] += ck[32 * et + crow(r, hi)]; ss += Dk[et][r] * Dk[et][r]; }
    ss += __shfl_xor(ss, 32);
    const float rs = __builtin_amdgcn_rsqf(ss * (1.f / 64.f) + EPS);
    bf16* kout = (bf16*)(F.ws + WS_KCMP) + ((size_t)((b * 4 + g) * 128 + n)) * 64;
#pragma unroll
    for (int rq = 0; rq < 4; ++rq) { float o0[4], o1[4];
#pragma unroll
        for (int i = 0; i < 4; ++i) { const int r = 4 * rq + i, idx = crow(r, hi); const float v0 = Dk[0][r] * rs * kn0[idx], v1 = Dk[1][r] * rs * kn0[32 + idx];
            const float c = tab[idx], s = tab[32 + idx]; o0[i] = v0 * c - v1 * s; o1[i] = v1 * c + v0 * s; if (n > 126) { o0[i] = 0.f; o1[i] = 0.f; } }
        v2u w0, w1; w0.x = pk2(o0[0], o0[1]); w0.y = pk2(o0[2], o0[3]); w1.x = pk2(o1[0], o1[1]); w1.y = pk2(o1[2], o1[3]);
        *(GAS v2u*)(kout + 8 * rq + 4 * hi) = w0; *(GAS v2u*)(kout + 32 + 8 * rq + 4 * hi) = w1; }
    bf16* vout = (bf16*)(F.ws + WS_VCMPT) + ((size_t)((b * 4 + g) * 64)) * 128 + 32 * nb;
#pragma unroll
    for (int et = 0; et < 2; ++et) { const float cve = cv[32 * et + r32];
#pragma unroll
        for (int rq = 0; rq < 4; ++rq) { float o[4];
#pragma unroll
            for (int i = 0; i < 4; ++i) { const int nl = 8 * rq + 4 * hi + i; o[i] = (32 * nb + nl > 126) ? 0.f : Dv[et][4 * rq + i] + cve; }
            v2u w; w.x = pk2(o[0], o[1]); w.y = pk2(o[2], o[3]);
            *(GAS v2u*)(vout + (size_t)(32 * et + r32) * 128 + 8 * rq + 4 * hi) = w; } }
}
__device__ NSA_INLINE void nsa_task(unsigned char* ws_, float* out_, LAS unsigned char* lds_, int wave_, int task, const bf16* PROJ) {
    Frame F; F.ws = ws_; F.out = out_; F.lds = lds_; F.wave = wave_;
    asm volatile("v_mbcnt_lo_u32_b32 %0, -1, 0\n\tv_mbcnt_hi_u32_b32 %0, -1, %0" : "=v"(F.lane));
    const int g = task & 3, qb = 63 - ((task >> 2) & 63), b = task >> 8; const int r32 = F.lane & 31, hi = F.lane >> 5;
    const int row0 = b * SEQ + 32 * qb, tq = 32 * qb + r32;
    const bf16* qrow[3];
#pragma unroll
    for (int s = 0; s < 3; ++s) qrow[s] = PROJ + (size_t)(row0 + r32) * NSA_LD + NSA_Q + (3 * g + s) * 64;
    LAS bf16x8* ql = wave_q(F); stage_q<3>(ql, qrow, F.lane);
#define NSA_GATE(s_, c_) (__builtin_amdgcn_rcpf(1.f + fast_exp2(-1.4426950408889634f * bf2f(PROJ[(size_t)(row0 + r32) * NSA_LD + NSA_GT + 9 * g + 3 * (s_) + (c_)]))))
    bf16* Y = (bf16*)(F.ws + WS_Y);
    MaskArg ma{}; ma.q0[0] = ma.q0[1] = ma.q0[2] = 32 * qb; ma.nmax = tq >= 31 ? (tq - 31) >> 4 : -1;
    const KVp kvc{(const bf16*)(F.ws + WS_KCMP) + (size_t)((b * 4 + g) * 128) * 64, 64, (const bf16*)(F.ws + WS_VCMPT) + (size_t)((b * 4 + g) * 64) * 128, 128};
    float imp[16];
#pragma unroll
    for (int r = 0; r < 16; ++r) imp[r] = 0.f;
#ifndef NSA_NO_A
    {   const int kperm = (r32 & 0x13) | ((r32 & 4) << 1) | ((r32 & 8) >> 1);
        const bf16* kp = kvc.K + (size_t)kperm * 64 + 8 * hi;
#pragma unroll 1
        for (int s = 0; s < 3; ++s) { f32x16 ia; float ls = 0.f;
#pragma unroll
            for (int r = 0; r < 16; ++r) ia[r] = 0.f;
#pragma unroll 1
            for (int kt = 0; kt < 4; ++kt) { f32x16 acc;
#pragma unroll
                for (int r = 0; r < 16; ++r) acc[r] = 0.f;
#pragma unroll
                for (int ks = 0; ks < 4; ++ks) acc = __builtin_amdgcn_mfma_f32_32x32x16_bf16(ld8(kp + (size_t)(32 * kt) * 64 + 16 * ks), ql[(s * 4 + ks) * 64], acc, 0, 0, 0);
                float p[16];
#pragma unroll
                for (int r = 0; r < 16; ++r) { const int key = 32 * kt + 8 * hi + 16 * (r >> 3) + (r & 7); p[r] = key <= ma.nmax ? fast_exp2(acc[r]) : 0.f; ls += p[r]; }
#pragma unroll
                for (int ks2 = 0; ks2 < 2; ++ks2) { v4u pw, cw; unsigned short cvv[8];
                    pw.x = pk2(p[8 * ks2], p[8 * ks2 + 1]); pw.y = pk2(p[8 * ks2 + 2], p[8 * ks2 + 3]); pw.z = pk2(p[8 * ks2 + 4], p[8 * ks2 + 5]); pw.w = pk2(p[8 * ks2 + 6], p[8 * ks2 + 7]);
#pragma unroll
                    for (int jj = 0; jj < 8; ++jj) { const int nn = 32 * kt + 16 * ks2 + 8 * hi + jj; cvv[jj] = (nn >= 4 * r32 - 1 && nn <= 4 * r32 + 3) ? 0x3f80 : 0; }
                    cw.x = cvv[0] | (cvv[1] << 16); cw.y = cvv[2] | (cvv[3] << 16); cw.z = cvv[4] | (cvv[5] << 16); cw.w = cvv[6] | (cvv[7] << 16);
                    ia = __builtin_amdgcn_mfma_f32_32x32x16_bf16(__builtin_bit_cast(bf16x8, cw), __builtin_bit_cast(bf16x8, pw), ia, 0, 0, 0); }
            }
            const float lt = ls + __shfl_xor(ls, 32); const float inv = lt > 0.f ? 1.f / lt : 0.f;
#pragma unroll
            for (int r = 0; r < 16; ++r) imp[r] += ia[r] * inv;
        }
    }
#endif
    unsigned sel;
    { const int qblk = tq >> 6;
      if (32 * qb + 31 < 1024) sel = (2u << qblk) - 1u;
      else { float val[16], oth[16];
#pragma unroll
        for (int r = 0; r < 16; ++r) { const int j = crow(r, hi); val[r] = j > qblk ? -1e30f : ((j == 0 || j == qblk || j == qblk - 1) ? 1e9f : imp[r]); oth[r] = __shfl_xor(val[r], 32); }
        unsigned mine = 0;
#pragma unroll
        for (int r = 0; r < 16; ++r) { const int j = crow(r, hi); int rank = 0;
#pragma unroll
            for (int r2 = 0; r2 < 16; ++r2) { const int j2 = crow(r2, hi), j3 = crow(r2, hi ^ 1);
                rank += (val[r2] > val[r] || (val[r2] == val[r] && j2 < j)) ? 1 : 0;
                rank += (oth[r2] > val[r] || (oth[r2] == val[r] && j3 < j)) ? 1 : 0; }
            mine |= ((rank < 16 && j <= qblk) ? 1u : 0u) << ((r & 3) + 8 * (r >> 2)); }
        mine <<= 4 * hi;
        sel = mine | __shfl_xor(mine, 32); } }
    const unsigned* mbr2[2] = {nullptr, nullptr}; const unsigned* mbr1[1] = {nullptr};
    const KVp kvs{PROJ + (size_t)(b * SEQ) * NSA_LD + NSA_KS + 64 * g, NSA_LD, (const bf16*)F.out + ((size_t)b * 256 + 64 * g) * SEQ, SEQ};
    const KVp kvw{PROJ + (size_t)(b * SEQ) * NSA_LD + NSA_KW + 64 * g, NSA_LD, (const bf16*)F.out + (size_t)NB * 256 * SEQ + ((size_t)b * 256 + 64 * g) * SEQ, SEQ};
    ma.sel = sel;
#define NSA_BRANCH(MT_, KV_, KT0_, KT1_, C_, ADD_, ZBIT_) do { \
      { f32x16 O2[2][2]; float l2[2]; zero_o<2, 2>(O2, l2); attn_core<2, 2, 0, MT_>(ql, KV_, KT0_, KT1_, 0.f, ma, mbr2, O2, l2, F.lane); VM_WAIT(); \
        _Pragma("unroll") for (int s = 0; s < 2; ++s) { const float lt = l2[s] + __shfl_xor(l2[s], 32); \
          store_o<2, ADD_>(O2[s], (lt > 0.f && !(DBG_ZERO & ZBIT_)) ? NSA_GATE(s, C_) / lt : 0.f, Y, row0, (3 * g + s) * 64, F.lane); } } \
      { f32x16 O1[1][2]; float l1[1]; zero_o<1, 2>(O1, l1); attn_core<1, 2, 0, MT_>(ql + 2 * 4 * 64, KV_, KT0_, KT1_, 0.f, ma, mbr1, O1, l1, F.lane); VM_WAIT(); \
        const float lt = l1[0] + __shfl_xor(l1[0], 32); \
        store_o<2, ADD_>(O1[0], (lt > 0.f && !(DBG_ZERO & ZBIT_)) ? NSA_GATE(2, C_) / lt : 0.f, Y, row0, (3 * g + 2) * 64, F.lane); } } while (0)
    NSA_BRANCH(MK_CMP, kvc, 0, 4, 0, false, 4);
    NSA_BRANCH(MK_SLC, kvs, 0, qb + 1, 1, true, 16);
    NSA_BRANCH(MK_WIN, kvw, (qb > 16 ? qb - 16 : 0), qb + 1, 2, true, 32);
#undef NSA_BRANCH
}
__device__ __forceinline__ void prologue_misc(Frame& F) {
    float* tab = (float*)(F.ws + WS_ROPE);
    for (int idx = blockIdx.x * (NWAVES * 64) + F.tid; idx < SEQ * 32; idx += F.G * NWAVES * 64) {
        const int t = idx >> 5, i = idx & 31;
        const float inv = exp2f(-(float)i * (13.287712379549449f / 32.0f));
        const float ang = (float)t * inv; float s, c; sincosf(ang, &s, &c);
        tab[t * 64 + i] = c; tab[t * 64 + 32 + i] = s; }
    if (blockIdx.x < 4) {
        const int kv = F.wave & 1, part = blockIdx.x * 4 + (F.wave >> 1);
        const float* pos = kv ? F.ka->in[20] : F.ka->in[19]; const float* w = kv ? F.ka->in[22] : F.ka->in[21]; float a = 0.f;
#pragma unroll 8
        for (int i = part * 128; i < part * 128 + 128; ++i) a += pos[i] * w[(size_t)i * 64 + F.lane];
        atomicAdd((float*)(F.ws + WS_CTL) + CW_CK + 64 * kv + F.lane, a);
    }
}
__device__ __forceinline__ void prologue_phase(Frame& F) {
    prologue_misc(F);
    bf16* XB = (bf16*)(F.ws + WS_XB); float* PART = (float*)(F.ws + WS_PART);
    for (int m = F.gw; m < MTOK; m += F.NGW) row_to_bf16(F, F.ka->in[0] + (size_t)m * DM, XB + (size_t)m * DM, PART + (size_t)m * 16);
    bf16* MEMB = (bf16*)(F.ws + WS_MEMB); float* PARTM = (float*)(F.ws + WS_PARTM);
    for (int m = F.gw; m < MMEM; m += F.NGW) row_to_bf16(F, F.ka->in[1] + (size_t)m * DM, MEMB + (size_t)m * DM, PARTM + (size_t)m * 16);
    int itb = 0;
#pragma unroll 1
    for (int ly = 0; ly < DEPTH; ++ly) cvt_matrix(F, itb, F.ka->in[9] + (size_t)ly * DM * 512, nullptr, 512, 512, F.ka->in[8] + (size_t)ly * DM, (bf16*)(F.ws + WS_WKV) + (size_t)ly * 512 * DM, DM, 512, 0);
    cvt_matrix(F, itb, F.ka->in[21], nullptr, 64, 64, nullptr, (bf16*)(F.ws + WS_CMPW), 2048, 64, 0);
    cvt_matrix(F, itb, F.ka->in[22], nullptr, 64, 64, nullptr, (bf16*)(F.ws + WS_CMPW) + 64 * 2048, 2048, 64, 0);
    convert_layer(F, 0);
}

template <unsigned PHASE_MASK> __global__ void __launch_bounds__(NWAVES * 64, 2) mk_fwd(Args args) {
    extern __shared__ __attribute__((aligned(16))) unsigned char lds[];
    Frame F;
    F.lds = (LAS unsigned char*)lds;
    F.MISC = (volatile LAS unsigned*)(F.lds + 131072 + 320);
    F.tid = threadIdx.x; F.lane = F.tid & 63; F.wave = __builtin_amdgcn_readfirstlane(F.tid >> 6);
    F.G = gridDim.x; F.gw = blockIdx.x * NWAVES + F.wave; F.NGW = F.G * NWAVES;
    F.ws = args.ws; F.ctl = (gu32*)(args.ws + WS_CTL); F.out = args.out;
    F.ka = (KArgs)__builtin_amdgcn_kernarg_segment_ptr();
    for (int u = F.tid; u < (147456 - 131072) / 4; u += NWAVES * 64) ((LAS unsigned*)(F.lds + 131072))[u] = 0u;
    __syncthreads();
    XcdBarrier bar = xcd_barrier_post((unsigned*)(F.ctl + CW_BAR), F.MISC + 8);
    constexpr bool ALLPH = PHASE_MASK == 0xffffffffu;
    const int lo = ALLPH ? 0 : args.ph_lo, hi = ALLPH ? 0 : args.ph_hi; int pc = 0;
    const bool dry = ALLPH ? false : (args.dry != 0);
#define PH_BEGIN(id) if (ALLPH || ((((PHASE_MASK) >> (id)) & 1u) && lo <= pc && pc < hi)) { asm volatile("" : "+s"(F.ka), "+s"(F.ws), "+s"(F.out), "+s"(F.gw), "+s"(F.NGW), "+s"(F.G), "+s"(F.wave)); asm volatile("v_mbcnt_lo_u32_b32 %0, -1, 0\n\tv_mbcnt_hi_u32_b32 %0, -1, %0" : "=v"(F.lane)); F.tid = F.wave * 64 + F.lane;
#define PH_END_(islast)   if (ALLPH ? !(islast) : (pc + 1 < hi)) { XcdBarrier b2_ = bar; asm volatile("" : "+s"(b2_.bar), "+s"(b2_.x)); xcd_barrier(b2_); } } if (!ALLPH) ++pc;
#define PH_END PH_END_(false)
#define QCTR(i) (F.ctl + CW_Q + 64 * (i))

#define XB ((bf16*)(F.ws + WS_XB))
#define VTB ((bf16*)F.out)
#define Yb ((bf16*)(F.ws + WS_Y))
#define HID ((bf16*)(F.ws + WS_HID))
#define PART ((float*)(F.ws + WS_PART))
    LAS unsigned char* ring = F.lds;

    PH_BEGIN(0) prologue_phase(F); PH_END
    PH_BEGIN(1) { pg8::Gemm g{(const bf16*)(F.ws + WS_MEMB), (const bf16*)(F.ws + WS_WKV), MMEM, 2048, DM}; pg8::StaticOrder S; S.init(MMEM, 2048, F.G, (int)blockIdx.x);
        pg8::EpiScale E{(bf16*)(F.ws + WS_MKV), 2048, (const float*)(F.ws + WS_PARTM)};
        pg8::gemm_phase<pg8::EpiScale, pg8::StaticOrder, true, true>(ring, g, S, E, F.wave); } PH_END
    PH_BEGIN(2)
#pragma unroll 1
        for (int ly = 0; ly < DEPTH; ++ly) {
            xform(F, (const bf16*)(F.ws + WS_MKV), 2048, ly * 512, 4, MMEM, NMEMT, (bf16*)(F.ws + WS_MK) + (size_t)ly * NB * 4 * NMEMT * 64, 1, 0, 0, F.ka->in[11] + ly * 64, false, 1.f, 0);
            transpose_cols(F, (const bf16*)(F.ws + WS_MKV), 2048, ly * 512 + 256, 256, NB, NMEMT, (bf16*)(F.ws + WS_MVT) + (size_t)ly * NB * 256 * NMEMT);
        }
    PH_END

#pragma unroll 1
    for (int Ly = 0; Ly < DEPTH; ++Ly) {
#define WB ((const bf16*)(F.ws + WS_WBUF0 + (size_t)(Ly & 1) * WBUF_BYTES))
        const int kind = Ly % 3;
        const int ldp = kind == 0 ? RET_LD : (kind == 1 ? DSA_LD : NSA_LD);
        PH_BEGIN(3) { pg8::Gemm g{XB, WB + WB_W1A, MTOK, 2 * FF, DM}; pg8::StaticOrder S; S.init(MTOK, 2 * FF, F.G, (int)blockIdx.x);
            pg8::EpiSwiglu E{HID, FF, PART, dry ? DRY_MODE : 0};
            pg8::gemm_phase<pg8::EpiSwiglu, pg8::StaticOrder, true, true>(ring, g, S, E, F.wave); } PH_END
        PH_BEGIN(4) { pg8::Gemm g{HID, WB + WB_W2A, MTOK, DM, FF}; pg8::StaticOrder S; S.init(MTOK, DM, F.G, (int)blockIdx.x);
            pg8::EpiResid E{XB, XB, nullptr, PART, dry ? 0.f : 0.5f};
            pg8::gemm_phase<pg8::EpiResid, pg8::StaticOrder, true, true>(ring, g, S, E, F.wave); } PH_END
        PH_BEGIN(5) { pg8::Gemm g{XB, WB + WB_WIN, MTOK, ldp, DM}; pg8::StaticOrder S; S.init(MTOK, ldp, F.G, (int)blockIdx.x);
            pg8::EpiScale E{HID, ldp, PART};
            pg8::gemm_phase<pg8::EpiScale, pg8::StaticOrder, true, true>(ring, g, S, E, F.wave); } PH_END
        PH_BEGIN(6)
            if (kind == 0) {
                xform(F, HID, ldp, RET_Q, 6, MTOK, SEQ, (dry ? Yb : HID), 0, (dry ? 1024 : ldp), (dry ? 0 : RET_Q), nullptr, true, 1.f, RET_MODE == 1 ? +1 : 0);
                xform(F, HID, ldp, RET_K, 6, MTOK, SEQ, (dry ? Yb : HID), 0, (dry ? 1024 : ldp), (dry ? 0 : RET_K), nullptr, true, 0.125f, RET_MODE == 1 ? -1 : 0);
                xform(F, HID, ldp, RET_QM, 4, MTOK, SEQ, (dry ? Yb : HID), 0, (dry ? 1024 : ldp), (dry ? 0 : RET_QM), F.ka->in[10] + Ly * 64, false, QSCALE, 0);
                transpose_cols(F, HID, ldp, RET_V, 768, NB, SEQ, VTB);
            } else if (kind == 1) {
                xform(F, HID, ldp, DSA_Q, 12, MTOK, SEQ, (dry ? Yb : HID), 0, (dry ? 1024 : ldp), (dry ? 0 : DSA_Q), F.ka->in[14], true, QSCALE, 0);
                xform(F, HID, ldp, DSA_K, 1, MTOK, SEQ, (dry ? Yb : HID), 0, (dry ? 1024 : ldp), (dry ? 0 : DSA_K), F.ka->in[15], true, 1.f, 0);
                xform(F, HID, ldp, DSA_IQ, 8, MTOK, SEQ, (dry ? Yb : HID), 0, (dry ? 1024 : ldp), (dry ? 0 : DSA_IQ), nullptr, true, 1.f, 0);
                xform(F, HID, ldp, DSA_IK, 1, MTOK, SEQ, (dry ? Yb : HID), 0, (dry ? 1024 : ldp), (dry ? 0 : DSA_IK), nullptr, true, 1.f, 0);
                xform(F, HID, ldp, DSA_QM, 4, MTOK, SEQ, (dry ? Yb : HID), 0, (dry ? 1024 : ldp), (dry ? 0 : DSA_QM), F.ka->in[10] + Ly * 64, false, QSCALE, 0);
                transpose_cols(F, HID, ldp, DSA_V, 64, NB, SEQ, VTB);
            } else {
                xform(F, HID, ldp, NSA_Q, 12, MTOK, SEQ, (dry ? Yb : HID), 0, (dry ? 1024 : ldp), (dry ? 0 : NSA_Q), F.ka->in[17], true, QSCALE, 0);
                xform(F, HID, ldp, NSA_KS, 4, MTOK, SEQ, (dry ? Yb : HID), 0, (dry ? 1024 : ldp), (dry ? 0 : NSA_KS), F.ka->in[18] + 64, true, 1.f, 0);
                xform(F, HID, ldp, NSA_KW, 4, MTOK, SEQ, (dry ? Yb : HID), 0, (dry ? 1024 : ldp), (dry ? 0 : NSA_KW), F.ka->in[18] + 128, true, 1.f, 0);
                xform(F, HID, ldp, NSA_QM, 4, MTOK, SEQ, (dry ? Yb : HID), 0, (dry ? 1024 : ldp), (dry ? 0 : NSA_QM), F.ka->in[10] + Ly * 64, false, QSCALE, 0);
                transpose_cols(F, HID, ldp, NSA_VS, 256, NB, SEQ, VTB);
                transpose_cols(F, HID, ldp, NSA_VW, 256, NB, SEQ, VTB + (size_t)NB * 256 * SEQ);
                for (int t = F.gw; t < 256; t += F.NGW) nsa_cmp_task(F, t, HID, F.ka->in[18]);
            }
            if (Ly + 1 < DEPTH) convert_layer(F, Ly + 1);
        PH_END
        if (kind == 0) {
            PH_BEGIN(7)
#if RET_WG
                for (;;) {
                    asm volatile("s_waitcnt vmcnt(0) lgkmcnt(0)\n\ts_barrier" ::: "memory");
                    if (F.tid == 0) F.MISC[16] = __hip_atomic_fetch_add(QCTR(Ly * 8 + 3), 1u, RLX_AGENT);
                    asm volatile("s_waitcnt vmcnt(0) lgkmcnt(0)\n\ts_barrier" ::: "memory");
                    const int t = __builtin_amdgcn_readfirstlane((int)F.MISC[16]);
                    if (t >= NB * 6 * 8) break;
                    asm volatile("v_mbcnt_lo_u32_b32 %0, -1, 0\n\tv_mbcnt_hi_u32_b32 %0, -1, %0" : "=v"(F.lane));
                    ret_wg_task(F, t, HID);
                }
#endif
                for (;;) { asm volatile("v_mbcnt_lo_u32_b32 %0, -1, 0\n\tv_mbcnt_hi_u32_b32 %0, -1, %0" : "=v"(F.lane)); const int t = grab(QCTR(Ly * 8 + 0), F.lane) + (RET_WG ? 3072 : 0); if (t >= 3072 + 2048) break; if (t < 3072) ret_task(F, t, HID); else mem_task(F, t - 3072, Ly, HID, ldp, RET_QM); }
            PH_END
        } else if (kind == 1) {
            PH_BEGIN(8)
                for (;;) { asm volatile("v_mbcnt_lo_u32_b32 %0, -1, 0\n\tv_mbcnt_hi_u32_b32 %0, -1, %0" : "=v"(F.lane)); const int t = grab(QCTR(Ly * 8 + 0), F.lane); if (t >= 4608 + 2048) break; if (t < 4608) dsa_d1_task(F, t, HID); else mem_task(F, t - 4608, Ly, HID, ldp, DSA_QM); }
            PH_END
            PH_BEGIN(9)
                for (;;) { asm volatile("v_mbcnt_lo_u32_b32 %0, -1, 0\n\tv_mbcnt_hi_u32_b32 %0, -1, %0" : "=v"(F.lane)); const int t = grab(QCTR(Ly * 8 + 1), F.lane); if (t >= MTOK / 8) break;
{ v4u ra[4], rb[4]; d2_load(F, MTOK - 1 - 8 * t, ra);
#pragma unroll 1
                      for (int i = 0; i < 8; i += 2) { d2_load(F, MTOK - 1 - (8 * t + i + 1), rb); dsa_d2_row(F, MTOK - 1 - (8 * t + i), ra);
                          if (i + 2 < 8) d2_load(F, MTOK - 1 - (8 * t + i + 2), ra); dsa_d2_row(F, MTOK - 1 - (8 * t + i + 1), rb); } } }
            PH_END
            PH_BEGIN(10)
                for (;;) { asm volatile("v_mbcnt_lo_u32_b32 %0, -1, 0\n\tv_mbcnt_hi_u32_b32 %0, -1, %0" : "=v"(F.lane)); const int t = grab(QCTR(Ly * 8 + 2), F.lane); if (t >= 4096) break; dsa_d3_task(F, t, HID); }
            PH_END
        } else {
            PH_BEGIN(11)
                for (;;) { asm volatile("v_mbcnt_lo_u32_b32 %0, -1, 0\n\tv_mbcnt_hi_u32_b32 %0, -1, %0" : "=v"(F.lane)); const int t = grab(QCTR(Ly * 8 + 0), F.lane); if (t >= 4096 + 2048) break; if (t < 4096) nsa_task(F.ws, F.out, F.lds, F.wave, t, HID); else mem_task(F, t - 4096, Ly, HID, ldp, NSA_QM); }
            PH_END
        }
        PH_BEGIN(12) { pg8::Gemm g{Yb, WB + WB_WO, MTOK, DM, DM}; pg8::StaticOrder S; S.init(MTOK, DM, F.G, (int)blockIdx.x);
            pg8::EpiResid E{XB, XB, nullptr, PART, dry ? 0.f : 1.0f};
            pg8::gemm_phase<pg8::EpiResid, pg8::StaticOrder, true, true>(ring, g, S, E, F.wave); } PH_END
        PH_BEGIN(13) { pg8::Gemm g{XB, WB + WB_W1B, MTOK, 2 * FF, DM}; pg8::StaticOrder S; S.init(MTOK, 2 * FF, F.G, (int)blockIdx.x);
            pg8::EpiSwiglu E{HID, FF, PART, dry ? DRY_MODE : 0};
            pg8::gemm_phase<pg8::EpiSwiglu, pg8::StaticOrder, true, true>(ring, g, S, E, F.wave); } PH_END
        PH_BEGIN(14) { pg8::Gemm g{HID, WB + WB_W2B, MTOK, DM, FF}; pg8::StaticOrder S; S.init(MTOK, DM, F.G, (int)blockIdx.x);
            pg8::EpiResid E{XB, XB, Ly == DEPTH - 1 ? F.out : nullptr, PART, dry ? 0.f : 0.5f};
            pg8::gemm_phase<pg8::EpiResid, pg8::StaticOrder, true, true>(ring, g, S, E, F.wave); } PH_END_(Ly == DEPTH - 1)
    }
#undef XB
#undef VTB
#undef Yb
#undef HID
#undef PART
#undef WB
#undef PH_BEGIN
#undef PH_END
#undef PH_END_
}

constexpr int LDS_BYTES = 147456;
#ifndef MK_PER_PHASE
#define MK_PER_PHASE 0
#endif
typedef void (*kern_t)(Args);
template <unsigned M> static kern_t kern_of() { return mk_fwd<M>; }
#if MK_PER_PHASE
static kern_t phase_kernel(int id) {
    switch (id) {
        case 0: return kern_of<1u << 0>(); case 1: return kern_of<1u << 1>(); case 2: return kern_of<1u << 2>(); case 3: return kern_of<1u << 3>(); case 4: return kern_of<1u << 4>();
        case 5: return kern_of<1u << 5>(); case 6: return kern_of<1u << 6>(); case 7: return kern_of<1u << 7>(); case 8: return kern_of<1u << 8>(); case 9: return kern_of<1u << 9>();
        case 10: return kern_of<1u << 10>(); case 11: return kern_of<1u << 11>(); case 12: return kern_of<1u << 12>(); case 13: return kern_of<1u << 13>(); default: return kern_of<1u << 14>();
    }
}
#endif
extern "C" void kernel_launch(void* const* d_in, const int* in_sizes, int n_in, void* d_out, int out_size, void* d_ws, size_t ws_size, hipStream_t stream) {
    static int grid = 0;
    if (grid == 0) {
        if (n_in != 23 || out_size != MTOK * DM || ws_size < WS_END) { fprintf(stderr, "kernel_launch: unexpected shapes (n_in %d, out %d, ws %zu)\n", n_in, out_size, ws_size); grid = -1; return; }
        int dev = 0, cus = 0;
        if (hipGetDevice(&dev) != hipSuccess || hipDeviceGetAttribute(&cus, hipDeviceAttributeMultiprocessorCount, dev) != hipSuccess) { grid = -1; return; }
#if MK_PER_PHASE
        for (int id = 0; id < 15; ++id) if (hipFuncSetAttribute((const void*)phase_kernel(id), hipFuncAttributeMaxDynamicSharedMemorySize, LDS_BYTES) != hipSuccess) { fprintf(stderr, "kernel_launch: hipFuncSetAttribute failed\n"); grid = -1; return; }
#else
        if (hipFuncSetAttribute((const void*)kern_of<0xffffffffu>(), hipFuncAttributeMaxDynamicSharedMemorySize, LDS_BYTES) != hipSuccess) { fprintf(stderr, "kernel_launch: hipFuncSetAttribute failed\n"); grid = -1; return; }
#endif
        (void)hipGetLastError();
        grid = cus;
    }
    if (grid < 0) return;
    if (hipMemsetAsync((char*)d_ws + WS_CTL, 0, CTL_ZERO_BYTES, stream) != hipSuccess) return;
    Args a{};
    for (int i = 0; i < 23; ++i) a.in[i] = (const float*)d_in[i];
    a.out = (float*)d_out; a.ws = (unsigned char*)d_ws;
    constexpr int NPH = 3 + 8 * DEPTH + 2;
#if MK_PER_PHASE
    int ids[NPH]; int n = 0; ids[n++] = 0; ids[n++] = 1; ids[n++] = 2;
    for (int ly = 0; ly < DEPTH; ++ly) { ids[n++] = 3; ids[n++] = 4; ids[n++] = 5; ids[n++] = 6;
        if (ly % 3 == 0) ids[n++] = 7; else if (ly % 3 == 1) { ids[n++] = 8; ids[n++] = 9; ids[n++] = 10; } else ids[n++] = 11;
        ids[n++] = 12; ids[n++] = 13; ids[n++] = 14; }
    for (int p = 0; p < NPH; ++p) { a.ph_lo = p; a.ph_hi = p + 1;
#if PROBE_DUP
        if ((PROBE_DUP >> ids[p]) & 1) {
            a.dry = 1; hipLaunchKernelGGL(phase_kernel(ids[p]), dim3(grid), dim3(NWAVES * 64), LDS_BYTES, stream, a); a.dry = 0;
            hipMemsetAsync((char*)d_ws + WS_CTL + CW_Q * 4, 0, 64 * 4 * 64, stream); }
#endif
        hipLaunchKernelGGL(phase_kernel(ids[p]), dim3(grid), dim3(NWAVES * 64), LDS_BYTES, stream, a);
    }
#else
    a.ph_lo = 0; a.ph_hi = NPH; hipLaunchKernelGGL(kern_of<0xffffffffu>(), dim3(grid), dim3(NWAVES * 64), LDS_BYTES, stream, a);
#endif
}
```

```cpp
#include <hip/hip_runtime.h>
#include <cstdio>
#include <cstdint>
namespace pg8 {
#define PG8_LAS __attribute__((address_space(3)))
typedef unsigned short bf16_t;
typedef short bf16x8 __attribute__((ext_vector_type(8)));
typedef float f32x4 __attribute__((ext_vector_type(4)));
typedef unsigned u32x4 __attribute__((ext_vector_type(4)));
constexpr int BM = 256, BK = 64, HALF = 128, HTB = HALF * BK * 2  , STAGE_BYTES = 8 * HTB, NXCD = 8, WGM = 8;

__host__ __device__ __forceinline__ int lds_byte(int r, int c) { const int st = (r >> 4) * 2 + (c >> 5), rr = r & 15, cc = c & 31, ob = rr * 64 + cc * 2; return st * 1024 + (ob ^ (((ob >> 9) & 1) << 5)); }
__host__ __device__ __forceinline__ void stage_rc(int b, int& R, int& C) { const int st = b / 1024, sb = b % 1024, swz = sb ^ (((sb >> 9) & 1) << 5); R = (st >> 1) * 16 + swz / 64; C = (st & 1) * 32 + (swz % 64) / 2; }
__host__ __device__ __forceinline__ int perm32(int rho) { const int n = rho >> 4, i = rho & 15; return 8 * (i >> 2) + 4 * n + (i & 3); }

struct Unit { int pm, pn; };
struct Gemm { const bf16_t* A; const bf16_t* Bt; int M, N, K; };

struct StaticOrder {
    int nM, nN, nwg, G, c;
    __host__ __device__ void init(int M, int N, int G_, int c_) { nM = M / BM; nN = N / BM; nwg = nM * nN; G = G_; c = c_; }
    __host__ __device__ bool next(int i, Unit& u) const {
        const long L = (long)i * G + c; if (L >= nwg) return false;
        int wgid = (int)L; { const int q = nwg / NXCD, r = nwg % NXCD, xcd = wgid % NXCD, off = wgid / NXCD; wgid = (xcd < r ? xcd * (q + 1) : r * (q + 1) + (xcd - r) * q) + off; }
        const int nig = WGM * nN, gid = wgid / nig, fm = gid * WGM, gsz = (nM - fm) < WGM ? (nM - fm) : WGM;
        u.pm = fm + ((wgid % nig) % gsz); u.pn = (wgid % nig) / gsz; return true;
    }
    __device__ __forceinline__ void a_ready(const Unit&) const {}
    __device__ __forceinline__ void done(const Unit&) const {}
};

__device__ __forceinline__ int lane_now() { int l; asm volatile("v_mbcnt_lo_u32_b32 %0, -1, 0\n\tv_mbcnt_hi_u32_b32 %0, -1, %0" : "=v"(l)); return l; }
__device__ __forceinline__ float shfl_idx_(float v, int src) { return __builtin_bit_cast(float, __builtin_amdgcn_ds_bpermute(src << 2, __builtin_bit_cast(int, v))); }
__device__ __forceinline__ int shfl_idx_(int v, int src) { return __builtin_amdgcn_ds_bpermute(src << 2, v); }
__device__ __forceinline__ unsigned shfl_idx_(unsigned v, int src) { return (unsigned)__builtin_amdgcn_ds_bpermute(src << 2, (int)v); }
#define __shfl_xor(v, o) pg8::shfl_idx_((v), pg8::lane_now() ^ (o))
#define __shfl(v, src) pg8::shfl_idx_((v), (src))
#define __shfl_down(v, o) pg8::shfl_idx_((v), pg8::lane_now() + (o))
#define __shfl_up(v, o) pg8::shfl_idx_((v), pg8::lane_now() - (o))
typedef float f32x2_cv __attribute__((ext_vector_type(2))); typedef __bf16 bf16x2_cv __attribute__((ext_vector_type(2)));
__device__ __forceinline__ unsigned cvt_pk_bf16(float lo, float hi) { f32x2_cv v = {lo, hi}; bf16x2_cv b = __builtin_convertvector(v, bf16x2_cv); return __builtin_bit_cast(unsigned, b); }
constexpr float RMS_EPS = 1e-6f;
__device__ __forceinline__ void rows_rs(const float* part, int row0, int fq, float (&rs)[2][4]) {
    f32x4 pr[2][4];
#pragma unroll
    for (int ai = 0; ai < 2; ++ai)
#pragma unroll
        for (int m = 0; m < 4; ++m) pr[ai][m] = *(const f32x4*)(part + (size_t)(row0 + ai * HALF + m * 16) * 16 + 4 * fq);
#pragma unroll
    for (int ai = 0; ai < 2; ++ai)
#pragma unroll
        for (int m = 0; m < 4; ++m) { float s = (pr[ai][m][0] + pr[ai][m][1]) + (pr[ai][m][2] + pr[ai][m][3]); s += __shfl_xor(s, 16); s += __shfl_xor(s, 32);
            rs[ai][m] = __builtin_amdgcn_rsqf(s * (1.0f / 1024.0f) + RMS_EPS); }
}
__device__ __forceinline__ float silu_mul(float g, float u) { return g * u * __builtin_amdgcn_rcpf(1.0f + __builtin_amdgcn_exp2f(-1.4426950408889634f * g)); }
struct EpiSwiglu {
    static constexpr bool PERM = true, AFTER_DRAIN = false;
    bf16_t* H; int ldh; const float* part; int dmode;
    __device__ __forceinline__ void operator()(const f32x4 (&acc)[2][2][4][2], const Unit& u, int wr, int wc, int fr_, int fq_) const {
        int le_; asm volatile("v_mbcnt_lo_u32_b32 %0, -1, 0\n\tv_mbcnt_hi_u32_b32 %0, -1, %0" : "=v"(le_)); const int fr = le_ & 15, fq = le_ >> 4;
        const int row0 = u.pm * BM + wr * 64 + fr, col0 = u.pn * HALF + wc * 32 + 8 * fq;
        if (dmode == 2) return;
        float rsv[2][4]; rows_rs(part, row0, fq, rsv);
#pragma unroll
        for (int ai = 0; ai < 2; ++ai)
#pragma unroll
            for (int m = 0; m < 4; ++m) { const int row = row0 + ai * HALF + m * 16; const float rs = rsv[ai][m];
                const f32x4 g0 = acc[ai][0][m][0] * rs, g1 = acc[ai][0][m][1] * rs, u0 = acc[ai][1][m][0] * rs, u1 = acc[ai][1][m][1] * rs;
                u32x4 w; w.x = cvt_pk_bf16(silu_mul(g0[0], u0[0]), silu_mul(g0[1], u0[1])); w.y = cvt_pk_bf16(silu_mul(g0[2], u0[2]), silu_mul(g0[3], u0[3]));
                w.z = cvt_pk_bf16(silu_mul(g1[0], u1[0]), silu_mul(g1[1], u1[1])); w.w = cvt_pk_bf16(silu_mul(g1[2], u1[2]), silu_mul(g1[3], u1[3]));
                if (dmode == 0 || w.x == 0x12345678u) *(u32x4*)(H + (size_t)row * ldh + col0) = w; }
    }
};
struct EpiScale {
    static constexpr bool PERM = true, AFTER_DRAIN = false;
    bf16_t* O; int ldc; const float* part;
    __device__ __forceinline__ void operator()(const f32x4 (&acc)[2][2][4][2], const Unit& u, int wr, int wc, int fr_, int fq_) const {
        int le_; asm volatile("v_mbcnt_lo_u32_b32 %0, -1, 0\n\tv_mbcnt_hi_u32_b32 %0, -1, %0" : "=v"(le_)); const int fr = le_ & 15, fq = le_ >> 4;
        const int row0 = u.pm * BM + wr * 64 + fr, col0 = u.pn * BM + wc * 32 + 8 * fq;
        float rsv[2][4]; rows_rs(part, row0, fq, rsv);
#pragma unroll
        for (int ai = 0; ai < 2; ++ai)
#pragma unroll
            for (int m = 0; m < 4; ++m) { const int row = row0 + ai * HALF + m * 16; const float rs = rsv[ai][m]; bf16_t* rowp = O + (size_t)row * ldc + col0;
#pragma unroll
                for (int bj = 0; bj < 2; ++bj) { const f32x4 v0 = acc[ai][bj][m][0] * rs, v1 = acc[ai][bj][m][1] * rs;
                    u32x4 w; w.x = cvt_pk_bf16(v0[0], v0[1]); w.y = cvt_pk_bf16(v0[2], v0[3]); w.z = cvt_pk_bf16(v1[0], v1[1]); w.w = cvt_pk_bf16(v1[2], v1[3]);
                    *(u32x4*)(rowp + bj * HALF) = w; } }
    }
};
struct EpiResid {
    static constexpr bool PERM = true, AFTER_DRAIN = false;
    const bf16_t* base; bf16_t* xb; float* out; float* part_out; float coef;
    __device__ __forceinline__ void operator()(const f32x4 (&acc)[2][2][4][2], const Unit& u, int wr, int wc, int fr_, int fq_) const {
        int le_; asm volatile("v_mbcnt_lo_u32_b32 %0, -1, 0\n\tv_mbcnt_hi_u32_b32 %0, -1, %0" : "=v"(le_)); const int fr = le_ & 15, fq = le_ >> 4;
        const int row0 = u.pm * BM + wr * 64 + fr, col0 = u.pn * BM + wc * 32 + 8 * fq;
        u32x4 bs[2][4][2];
#pragma unroll
        for (int ai = 0; ai < 2; ++ai)
#pragma unroll
            for (int m = 0; m < 4; ++m)
#pragma unroll
                for (int bj = 0; bj < 2; ++bj) bs[ai][m][bj] = *(const u32x4*)(base + (size_t)(row0 + ai * HALF + m * 16) * 1024 + col0 + bj * HALF);
#pragma unroll
        for (int ai = 0; ai < 2; ++ai)
#pragma unroll
            for (int m = 0; m < 4; ++m) { const int row = row0 + ai * HALF + m * 16; const size_t off = (size_t)row * 1024 + col0; float ss = 0.f;
#pragma unroll
                for (int bj = 0; bj < 2; ++bj) { const u32x4 b = bs[ai][m][bj];
                    const f32x4 b0 = {__builtin_bit_cast(float, b.x << 16), __builtin_bit_cast(float, b.x & 0xffff0000u), __builtin_bit_cast(float, b.y << 16), __builtin_bit_cast(float, b.y & 0xffff0000u)};
                    const f32x4 b1 = {__builtin_bit_cast(float, b.z << 16), __builtin_bit_cast(float, b.z & 0xffff0000u), __builtin_bit_cast(float, b.w << 16), __builtin_bit_cast(float, b.w & 0xffff0000u)};
                    const f32x4 v0 = b0 + acc[ai][bj][m][0] * coef, v1 = b1 + acc[ai][bj][m][1] * coef;
                    if (out) { *(f32x4*)(out + off + bj * HALF) = v0; *(f32x4*)(out + off + bj * HALF + 4) = v1; }
                    u32x4 w; w.x = cvt_pk_bf16(v0[0], v0[1]); w.y = cvt_pk_bf16(v0[2], v0[3]); w.z = cvt_pk_bf16(v1[0], v1[1]); w.w = cvt_pk_bf16(v1[2], v1[3]);
                    *(u32x4*)(xb + off + bj * HALF) = w;
                    ss += (v0[0] * v0[0] + v0[1] * v0[1]) + (v0[2] * v0[2] + v0[3] * v0[3]) + (v1[0] * v1[0] + v1[1] * v1[1]) + (v1[2] * v1[2] + v1[3] * v1[3]); }
                ss += __shfl_xor(ss, 16); ss += __shfl_xor(ss, 32);
                if (fq == 0) part_out[(size_t)row * 16 + u.pn * 4 + wc] = ss; }
    }
};
template <class Epi, class Sched, bool ALIGN_EPI = false, bool SP2 = false>
__device__ __forceinline__ void gemm_phase(PG8_LAS unsigned char* lds, const Gemm g, const Sched& S, const Epi& E, int wave_id) {
    int lane_; asm volatile("v_mbcnt_lo_u32_b32 %0, -1, 0\n\tv_mbcnt_hi_u32_b32 %0, -1, %0" : "=v"(lane_));
    const int wid = wave_id, lane = lane_, tid = wid * 64 + lane, wr = wid >> 2, wc = wid & 3, fr = lane & 15, fq = lane >> 4;
    const int K = g.K, nt = K / BK;
    unsigned voffA[2], voffB[2];
#pragma unroll
    for (int i = 0; i < 2; ++i) { int R, C; stage_rc(tid * 16 + i * 8192, R, C); const int Rb = Epi::PERM ? ((R & ~31) + perm32(R & 31)) : R;
        voffA[i] = (unsigned)(R * K + C) * 2u; voffB[i] = (unsigned)(Rb * K + C) * 2u; }
    const size_t kstep = (size_t)(BK * 2);
    const size_t hstep = (size_t)HALF * K * 2;
    const size_t tstep = 2 * hstep;
    const unsigned ldsw = (unsigned)wid * 1024u;
    const int aoff = lds_byte(wr * 64 + fr, fq * 8), boff = lds_byte(wc * 32 + fr, fq * 8);
#define PG8_SA(b, h) (((b) * 2 + (h)) * HTB)
#define PG8_SB(b, h) ((4 + (b) * 2 + (h)) * HTB)
#define PG8_STAGE(bufoff, gbase, voff) do { _Pragma("unroll") for (int _i = 0; _i < 2; ++_i) \
        __builtin_amdgcn_global_load_lds((const unsigned*)((const char*)(gbase) + (voff)[_i]), (PG8_LAS unsigned*)(lds + (bufoff) + ldsw + _i * 8192), 16, 0, 0); } while (0)
#define PG8_LDA(dst, b, h) do { _Pragma("unroll") for (int m = 0; m < 4; ++m) _Pragma("unroll") for (int k = 0; k < 2; ++k) dst[m][k] = *(const PG8_LAS bf16x8*)(lds + PG8_SA(b, h) + aoff + m * 2048 + k * 1024); } while (0)
#define PG8_LDB(dst, b, h) do { _Pragma("unroll") for (int n = 0; n < 2; ++n) _Pragma("unroll") for (int k = 0; k < 2; ++k) dst[n][k] = *(const PG8_LAS bf16x8*)(lds + PG8_SB(b, h) + boff + n * 2048 + k * 1024); } while (0)
#define PG8_MMA(ai, bj, At, Bt) do { __builtin_amdgcn_s_setprio(1); _Pragma("unroll") for (int m = 0; m < 4; ++m) _Pragma("unroll") for (int n = 0; n < 2; ++n) _Pragma("unroll") for (int k = 0; k < 2; ++k) \
        acc[ai][bj][m][n] = __builtin_amdgcn_mfma_f32_16x16x32_bf16(Bt[n][k], At[m][k], acc[ai][bj][m][n], 0, 0, 0); __builtin_amdgcn_s_setprio(0); } while (0)
#define PG8_WAIT_V(n) asm volatile("s_waitcnt vmcnt(" #n ")" ::: "memory")
#define PG8_WAIT_L(n) asm volatile("s_waitcnt lgkmcnt(" #n ")" ::: "memory")
#define PG8_BAR __builtin_amdgcn_s_barrier()
#define PG8_SCHED __builtin_amdgcn_sched_barrier(0)
    Unit cur, nxt; int ui = 0;
    if (!S.next(0, cur)) return;
    f32x4 acc[2][2][4][2];
#pragma unroll
    for (int a = 0; a < 2; ++a)
#pragma unroll
        for (int b = 0; b < 2; ++b)
#pragma unroll
            for (int m = 0; m < 4; ++m)
#pragma unroll
                for (int n = 0; n < 2; ++n) acc[a][b][m][n] = (f32x4){0.f, 0.f, 0.f, 0.f};
    bf16x8 At[4][2], B0[2][2], B1[2][2];
    const char* cA = (const char*)g.A + (size_t)cur.pm * tstep; const char* cB = (const char*)g.Bt + (size_t)cur.pn * tstep;
    S.a_ready(cur);
    if constexpr (SP2) {
        PG8_STAGE(PG8_SB(0, 0), cB, voffB); PG8_STAGE(PG8_SB(0, 1), cB + hstep, voffB); PG8_STAGE(PG8_SA(0, 0), cA, voffA); PG8_STAGE(PG8_SA(0, 1), cA + hstep, voffA);
        if (wr == 1) PG8_BAR;
        PG8_WAIT_V(2); PG8_BAR;
        PG8_STAGE(PG8_SB(1, 0), cB + kstep, voffB); PG8_STAGE(PG8_SA(1, 0), cA + kstep, voffA); PG8_STAGE(PG8_SB(1, 1), cB + hstep + kstep, voffB);
        PG8_WAIT_V(6); PG8_BAR;
    } else {
        PG8_STAGE(PG8_SB(0, 0), cB, voffB); PG8_STAGE(PG8_SA(0, 0), cA, voffA); PG8_STAGE(PG8_SB(0, 1), cB + hstep, voffB); PG8_STAGE(PG8_SA(0, 1), cA + hstep, voffA);
        if (wr == 1) PG8_BAR;
        PG8_WAIT_V(4); PG8_BAR;
        PG8_STAGE(PG8_SB(1, 0), cB + kstep, voffB); PG8_STAGE(PG8_SA(1, 0), cA + kstep, voffA); PG8_STAGE(PG8_SB(1, 1), cB + hstep + kstep, voffB);
        PG8_WAIT_V(6); PG8_BAR;
    }
    for (;;) {
        const bool has_next = S.next(ui + 1, nxt);
        const char* nA = has_next ? (const char*)g.A + (size_t)nxt.pm * tstep : cA; const char* nB = has_next ? (const char*)g.Bt + (size_t)nxt.pn * tstep : cB;
        for (int t = 0; t < nt; t += 2) {
            const bool last = (t == nt - 2);
            const char* a1 = cA + (size_t)(t + 1) * kstep;
            const char* a2 = last ? nA : cA + (size_t)(t + 2) * kstep; const char* b2 = last ? nB : cB + (size_t)(t + 2) * kstep;
            const char* a3 = a2 + kstep; const char* b3 = b2 + kstep;
            if (last && has_next) S.a_ready(nxt);
            if constexpr (SP2) {
            PG8_LDB(B0, 0, 0); PG8_LDB(B1, 0, 1); PG8_SCHED; PG8_LDA(At, 0, 0); PG8_STAGE(PG8_SA(1, 1), a1 + hstep, voffA);
            PG8_WAIT_V(8); PG8_WAIT_L(0); PG8_BAR; PG8_MMA(0, 0, At, B0); PG8_MMA(0, 1, At, B1); PG8_BAR; PG8_SCHED;
            PG8_LDA(At, 0, 1); PG8_STAGE(PG8_SB(0, 0), b2, voffB); PG8_STAGE(PG8_SB(0, 1), b2 + hstep, voffB); PG8_STAGE(PG8_SA(0, 0), a2, voffA);
            PG8_WAIT_V(8); PG8_WAIT_L(0); PG8_BAR; PG8_MMA(1, 0, At, B0); PG8_MMA(1, 1, At, B1); PG8_BAR; PG8_SCHED;
            PG8_LDB(B0, 1, 0); PG8_LDB(B1, 1, 1); PG8_SCHED; PG8_LDA(At, 1, 0); PG8_STAGE(PG8_SA(0, 1), a2 + hstep, voffA);
            PG8_WAIT_V(8); PG8_WAIT_L(0); PG8_BAR; PG8_MMA(0, 0, At, B0); PG8_MMA(0, 1, At, B1); PG8_BAR; PG8_SCHED;
            PG8_LDA(At, 1, 1); PG8_STAGE(PG8_SB(1, 0), b3, voffB); PG8_STAGE(PG8_SB(1, 1), b3 + hstep, voffB); PG8_STAGE(PG8_SA(1, 0), a3, voffA);
            PG8_WAIT_V(8); PG8_WAIT_L(0); PG8_BAR; PG8_MMA(1, 0, At, B0); PG8_MMA(1, 1, At, B1); PG8_BAR; PG8_SCHED;
            } else {
            PG8_LDB(B0, 0, 0); PG8_SCHED; PG8_LDA(At, 0, 0); PG8_STAGE(PG8_SA(1, 1), a1 + hstep, voffA);
            PG8_WAIT_L(8); PG8_BAR; PG8_WAIT_L(0); PG8_MMA(0, 0, At, B0); PG8_BAR; PG8_SCHED;
            PG8_LDB(B1, 0, 1); PG8_STAGE(PG8_SB(0, 0), b2, voffB);
            PG8_BAR; PG8_WAIT_L(0); PG8_MMA(0, 1, At, B1); PG8_BAR;
            PG8_LDA(At, 0, 1); PG8_STAGE(PG8_SA(0, 0), a2, voffA);
            PG8_BAR; PG8_WAIT_L(0); PG8_MMA(1, 0, At, B0); PG8_BAR; PG8_SCHED;
            PG8_STAGE(PG8_SB(0, 1), b2 + hstep, voffB);
            PG8_WAIT_V(6); PG8_BAR; PG8_MMA(1, 1, At, B1); PG8_BAR;
            PG8_LDB(B0, 1, 0); PG8_SCHED; PG8_LDA(At, 1, 0); PG8_STAGE(PG8_SA(0, 1), a2 + hstep, voffA);
            PG8_WAIT_L(8); PG8_BAR; PG8_WAIT_L(0); PG8_MMA(0, 0, At, B0); PG8_BAR; PG8_SCHED;
            PG8_LDB(B1, 1, 1); PG8_STAGE(PG8_SB(1, 0), b3, voffB);
            PG8_BAR; PG8_WAIT_L(0); PG8_MMA(0, 1, At, B1); PG8_BAR;
            PG8_LDA(At, 1, 1); PG8_STAGE(PG8_SA(1, 0), a3, voffA);
            PG8_BAR; PG8_WAIT_L(0); PG8_MMA(1, 0, At, B0); PG8_BAR; PG8_SCHED;
            PG8_STAGE(PG8_SB(1, 1), b3 + hstep, voffB);
            PG8_WAIT_V(6); PG8_BAR; PG8_MMA(1, 1, At, B1); PG8_BAR;
            }
        }
        if constexpr (ALIGN_EPI) { if (wr == 0) PG8_BAR; }
        if constexpr (!Epi::AFTER_DRAIN) { E(acc, cur, wr, wc, fr, fq); S.done(cur); }
        if (!has_next) break;
#pragma unroll
        for (int a = 0; a < 2; ++a)
#pragma unroll
            for (int b = 0; b < 2; ++b)
#pragma unroll
                for (int m = 0; m < 4; ++m)
#pragma unroll
                    for (int n = 0; n < 2; ++n) acc[a][b][m][n] = (f32x4){0.f, 0.f, 0.f, 0.f};
        cur = nxt; cA = nA; cB = nB; ++ui;
        if constexpr (ALIGN_EPI) { if (wr == 1) PG8_BAR; }
    }
    PG8_WAIT_V(0);
    if constexpr (!ALIGN_EPI) { if (wr == 0) PG8_BAR; }
    PG8_BAR;
    if constexpr (Epi::AFTER_DRAIN) { E.fused(acc, cur, wr, wc, fr, fq, lds, wid, lane); S.done(cur); }
#undef PG8_SA
#undef PG8_SB
#undef PG8_STAGE
#undef PG8_LDA
#undef PG8_LDB
#undef PG8_MMA
#undef PG8_WAIT_V
#undef PG8_WAIT_L
#undef PG8_BAR
#undef PG8_SCHED
}
}
#define LAS __attribute__((address_space(3)))
#define XB_TMO      128
#define XB_XCNT(j)  (256  + 64 * (j))
#define XB_XSUB(j)  (1280 + 64 * (j))
#define XB_XGEN(j)  (2304 + 64 * (j))
#define XB_TOP      3328
#define XB_TOPGEN   3392
#define XCD_BAR_WORDS 3456
#define XB_SPIN_CAP (1u << 18)

__device__ __forceinline__ unsigned xb_ld(unsigned* p)              { return __hip_atomic_load(p, __ATOMIC_RELAXED, __HIP_MEMORY_SCOPE_AGENT); }
__device__ __forceinline__ unsigned xb_add(unsigned* p, unsigned v) { return __hip_atomic_fetch_add(p, v, __ATOMIC_RELAXED, __HIP_MEMORY_SCOPE_AGENT); }
__device__ __forceinline__ unsigned xb_xcc_id() { return (unsigned)__builtin_amdgcn_s_getreg((3 << 11) | 20) & 0xFu; }
#define XB_SPIN(cond, bar) do { unsigned _sp = 0; while (cond) { __builtin_amdgcn_s_sleep(1); \
    if ((++_sp & 255u) == 0u) { if (xb_ld(&(bar)[XB_TMO])) break; if (_sp > XB_SPIN_CAP) { atomicAdd(&(bar)[XB_TMO], 1u); break; } } } } while (0)

struct XcdBarrier {
    unsigned* bar; unsigned x;
    volatile LAS unsigned* st;
};

__device__ __forceinline__ XcdBarrier xcd_barrier_post(unsigned* bar, volatile LAS unsigned* st) {
    XcdBarrier b; b.bar = bar; b.x = xb_xcc_id(); b.st = st;
    if (threadIdx.x == 0) (void)xb_add(&bar[XB_XCNT(b.x)], 1u);
    return b;
}
__device__ __forceinline__ void xcd_barrier_complete(unsigned* bar, unsigned x, unsigned& nloc, unsigned& nx) {
    const unsigned G = gridDim.x * gridDim.y * gridDim.z;
    unsigned sum, cnt, mine, sp = 0u;
    for (;;) {
        sum = 0u; cnt = 0u; mine = 0u;
#pragma unroll
        for (unsigned j = 0; j < 16; ++j) { const unsigned c = xb_ld(&bar[XB_XCNT(j)]); sum += c; cnt += (c > 0u) ? 1u : 0u; mine = (j == x) ? c : mine; }
        if (sum == G) break;
        __builtin_amdgcn_s_sleep(1);
        if ((++sp & 255u) == 0u) { if (xb_ld(&bar[XB_TMO])) break; if (sp > XB_SPIN_CAP) { atomicAdd(&bar[XB_TMO], 1u); break; } }
    }
    nloc = mine > 0u ? mine : 1u; nx = cnt > 0u ? cnt : 1u;
}

__device__ __forceinline__ void xcd_barrier(const XcdBarrier& b) {
    asm volatile("s_waitcnt vmcnt(0)" ::: "memory");
    __syncthreads();
    if (threadIdx.x == 0) {
        unsigned* bar = b.bar;
        __builtin_amdgcn_s_waitcnt(0);
        unsigned nloc = b.st[0], nx = b.st[1];
        if (nloc == 0u) { xcd_barrier_complete(bar, b.x, nloc, nx); b.st[0] = nloc; b.st[1] = nx; }
        const unsigned old = xb_add(&bar[XB_XSUB(b.x)], 1u);
        const unsigned gen = old / nloc;
        if (old + 1u == (gen + 1u) * nloc) {
            __builtin_amdgcn_fence(__ATOMIC_RELEASE, "agent");
            asm volatile("s_waitcnt vmcnt(0)" ::: "memory");
            const unsigned og = xb_add(&bar[XB_TOP], 1u);
            const unsigned tg = og / nx;
            if (og + 1u == (tg + 1u) * nx) xb_add(&bar[XB_TOPGEN], 1u);
            else XB_SPIN(xb_ld(&bar[XB_TOPGEN]) == tg, bar);
            __builtin_amdgcn_fence(__ATOMIC_ACQUIRE, "agent");
            xb_add(&bar[XB_XGEN(b.x)], 1u);
            asm volatile("s_waitcnt vmcnt(0)" ::: "memory");
        } else {
            XB_SPIN(xb_ld(&bar[XB_XGEN(b.x)]) == gen, bar);
            __builtin_amdgcn_fence(__ATOMIC_ACQUIRE, "agent");
            asm volatile("s_waitcnt vmcnt(0)" ::: "memory");
        }
    }
    __syncthreads();
}
#undef LAS
#ifndef RET_MODE
#define RET_MODE 1
#endif
#ifndef NSA_INLINE
#define NSA_INLINE __forceinline__
#endif
#ifndef DRY_MODE
#define DRY_MODE 0
#endif
#ifndef NSA_WG
#define NSA_WG 1
#endif
#ifndef D3_WG
#define D3_WG 1
#endif
#ifndef RET_WG
#define RET_WG 1
#endif
#ifndef PROBE_DUP
#define PROBE_DUP 0
#endif
#ifndef DBG_BRUTE
#define DBG_BRUTE 0
#endif
#ifndef DBG_ZERO
#define DBG_ZERO 0
#endif
constexpr int NWAVES = 8;
constexpr int NB = 16, SEQ = 2048, DM = 1024, MTOK = NB * SEQ, FF = 2816, NMEMT = 256, MMEM = NB * NMEMT, DEPTH = 4;
constexpr float EPS = 1e-6f;
constexpr float QSCALE = 0.125f * 1.4426950408889634f;
constexpr int RET_LD = 2560, RET_Q = 0, RET_K = 384, RET_V = 768, RET_G = 1536, RET_QM = 2304;
constexpr int DSA_LD = 1792, DSA_Q = 0, DSA_K = 768, DSA_V = 832, DSA_IQ = 896, DSA_IK = 1408, DSA_IW = 1472, DSA_QM = 1480, DSA_COLS = 1736;
constexpr int NSA_LD = 2816, NSA_Q = 0, NSA_KC = 768, NSA_VC = 1024, NSA_KS = 1280, NSA_VS = 1536, NSA_KW = 1792, NSA_VW = 2048, NSA_QM = 2304, NSA_GT = 2560;
constexpr int NSA_SRC_GT = 2304, NSA_SRC_QM = 2340, NSA_COLS = 2596;

constexpr size_t MiB = 1u << 20;
constexpr size_t WS_CTL = 0, CTL_ZERO_BYTES = 1 * MiB;
constexpr size_t WS_PART = 1 * MiB;
constexpr size_t WS_PARTM = 3 * MiB;
constexpr size_t WS_ROPE = 3 * MiB + 512 * 1024;
constexpr size_t WS_MISC = 4 * MiB;
constexpr size_t WS_CMPW = 4 * MiB + 64 * 1024;
constexpr size_t WS_KCMP = 5 * MiB;
constexpr size_t WS_VCMPT = 6 * MiB;
constexpr size_t WS_MK = 7 * MiB;
constexpr size_t WS_MVT = 15 * MiB;
constexpr size_t WS_MEMB = 23 * MiB;
constexpr size_t WS_MKV = 31 * MiB;
constexpr size_t WS_WKV = 47 * MiB;
constexpr size_t WS_WBUF0 = 51 * MiB, WBUF_BYTES = 41 * MiB;
constexpr size_t WS_XB = 133 * MiB;
constexpr size_t WS_Y = 197 * MiB;
constexpr size_t WS_HID = 261 * MiB;
constexpr size_t WS_SC = 373 * MiB;
constexpr size_t WS_MB = 501 * MiB;
constexpr size_t WS_END = 509 * MiB;
static_assert(WS_HID + (size_t)MTOK * FF * 2 <= WS_MB && WS_SC + (size_t)MTOK * SEQ * 2 <= WS_MB && WS_WBUF0 + 2 * WBUF_BYTES <= WS_XB, "d_ws map");
constexpr size_t WB_W1A = 0, WB_W2A = WB_W1A + (size_t)2 * FF * DM, WB_W1B = WB_W2A + (size_t)DM * FF, WB_W2B = WB_W1B + (size_t)2 * FF * DM,
                 WB_WIN = WB_W2B + (size_t)DM * FF, WB_WO = WB_WIN + (size_t)NSA_LD * DM, WB_END = WB_WO + (size_t)DM * DM;
static_assert(WB_END * 2 <= WBUF_BYTES, "weight buffer");
constexpr int LDS_CTRL = 147456 - 1024;
constexpr int CW_BAR = 4096;
constexpr int CW_CK = 32768;
constexpr int CW_Q = 16384;

#define GAS __attribute__((address_space(1)))
#define LAS __attribute__((address_space(3)))
typedef unsigned short bf16;
typedef unsigned v4u __attribute__((ext_vector_type(4)));
typedef unsigned v2u __attribute__((ext_vector_type(2)));
typedef float f32x4 __attribute__((ext_vector_type(4)));
typedef float f32x16 __attribute__((ext_vector_type(16)));
typedef short bf16x8 __attribute__((ext_vector_type(8)));
typedef GAS unsigned gu32;
#define RLX_AGENT __ATOMIC_RELAXED, __HIP_MEMORY_SCOPE_AGENT
#define LDS_WAIT() asm volatile("s_waitcnt lgkmcnt(0)" ::: "memory")
#define VM_WAIT() asm volatile("s_waitcnt vmcnt(0)" ::: "memory")
__device__ __forceinline__ unsigned f2bf(float f) { unsigned u = __builtin_bit_cast(unsigned, f); return (u + 0x7fffu + ((u >> 16) & 1u)) >> 16; }
__device__ __forceinline__ unsigned pk2(float lo, float hi) { return pg8::cvt_pk_bf16(lo, hi); }
__device__ __forceinline__ float bf2f(unsigned h) { return __builtin_bit_cast(float, h << 16); }
__device__ __forceinline__ float bflo(unsigned w) { return __builtin_bit_cast(float, w << 16); }
__device__ __forceinline__ float bfhi(unsigned w) { return __builtin_bit_cast(float, w & 0xffff0000u); }
struct Args { const float* in[23]; float* out; unsigned char* ws; int ph_lo, ph_hi, dry, pad; };
typedef const __attribute__((address_space(4))) Args* KArgs;
struct Frame {
    LAS unsigned char* lds;
    volatile LAS unsigned* MISC;
    gu32* ctl;
    int tid, lane, wave, G, gw, NGW;
    unsigned char* ws;
    KArgs ka;
    float* out;
};
__device__ __forceinline__ float wave_sum(float v) {
#pragma unroll
    for (int o = 1; o < 64; o <<= 1) v += __shfl_xor(v, o);
    return v;
}
__device__ __forceinline__ float wave_max(float v) {
#pragma unroll
    for (int o = 1; o < 64; o <<= 1) v = fmaxf(v, __shfl_xor(v, o));
    return v;
}
__device__ __forceinline__ int grab(gu32* ctr, int lane) { unsigned v = 0; if (lane == 0) v = __hip_atomic_fetch_add(ctr, 1u, RLX_AGENT); return __builtin_amdgcn_readfirstlane((int)v); }

__device__ __forceinline__ void cvt_item(const float* W, int ldw, const float* gain, bf16* WT, int K, LAS float* scr, int k0, int src_col0, int nvalid, int dst_row0, int lane) {
    const int c = lane & 31;
#pragma unroll 8
    for (int i = 0; i < 32; ++i) { const int kk = 2 * i + (lane >> 5); float v = 0.f;
        if (c < nvalid) { v = W[(size_t)(k0 + kk) * ldw + src_col0 + c]; if (gain) v *= gain[k0 + kk]; }
        scr[kk * 33 + c] = v; }
    LDS_WAIT(); asm volatile("" ::: "memory");
    const int c8 = lane & 7;
#pragma unroll
    for (int j = 0; j < 4; ++j) { const int n = (lane >> 3) + 8 * j; const LAS float* s = scr + (8 * c8) * 33 + n;
        v4u o; o.x = pk2(s[0 * 33], s[1 * 33]); o.y = pk2(s[2 * 33], s[3 * 33]); o.z = pk2(s[4 * 33], s[5 * 33]); o.w = pk2(s[6 * 33], s[7 * 33]);
        *(GAS v4u*)(WT + (size_t)(dst_row0 + n) * K + k0 + 8 * c8) = o; }
    LDS_WAIT(); asm volatile("" ::: "memory");
}
__device__ __forceinline__ void cvt_matrix(Frame& F, int& it_base, const float* W, const float* W2, int ldw, int ncols, const float* gain, bf16* WT, int K, int nrows_dst, int kind) {
    LAS float* scr = (LAS float*)(F.lds + F.wave * 16384);
    const int nkb = K / 64, njb = nrows_dst / 32, nitems = nkb * njb;
    int first = (F.gw - it_base % F.NGW + F.NGW) % F.NGW;
    for (int i = first; i < nitems; i += F.NGW) {
        const int kb = i / njb, jb = i % njb; const float* src = W; int sc0 = jb * 32, nv = 32;
        if (kind == 0) { nv = ncols - sc0; nv = nv < 0 ? 0 : (nv > 32 ? 32 : nv); }
        else if (kind == 1) { const int c = jb * 32, pn = c >> 8, bj = (c >> 7) & 1, j = c & 127; src = bj ? W2 : W; sc0 = pn * 128 + j; }
        else { const int c = jb * 32;
            if (c < NSA_QM) { sc0 = c; }
            else if (c < NSA_GT) { sc0 = NSA_SRC_QM + (c - NSA_QM); }
            else { sc0 = NSA_SRC_GT + (c - NSA_GT); nv = NSA_SRC_QM - sc0; nv = nv < 0 ? 0 : (nv > 32 ? 32 : nv); } }
        cvt_item(src, ldw, gain, WT, K, scr, kb * 64, sc0, nv, jb * 32, F.lane);
    }
    it_base += nitems;
}
__device__ __forceinline__ void convert_layer(Frame& F, int Ly) {
    bf16* WB = (bf16*)(F.ws + WS_WBUF0 + (size_t)(Ly & 1) * WBUF_BYTES);
    const float* fnorm = F.ka->in[2]; const float* wg = F.ka->in[3]; const float* wu = F.ka->in[4]; const float* wd = F.ka->in[5];
    int itb = 0;
#pragma unroll 1
    for (int hf = 0; hf < 2; ++hf) {
        const size_t o1 = (size_t)(Ly * 2 + hf) * DM * FF;
        cvt_matrix(F, itb, wg + o1, wu + o1, FF, FF, fnorm + (size_t)(Ly * 2 + hf) * DM, WB + (hf ? WB_W1B : WB_W1A), DM, 2 * FF, 1);
        cvt_matrix(F, itb, wd + o1, nullptr, DM, DM, nullptr, WB + (hf ? WB_W2B : WB_W2A), FF, DM, 0);
    }
    const float* mnorm = F.ka->in[6] + (size_t)Ly * DM;
    const int kind = Ly % 3, j = Ly / 3;
    if (kind == 0) cvt_matrix(F, itb, F.ka->in[12] + (size_t)j * DM * RET_LD, nullptr, RET_LD, RET_LD, mnorm, WB + WB_WIN, DM, RET_LD, 0);
    else if (kind == 1) cvt_matrix(F, itb, F.ka->in[13] + (size_t)j * DM * DSA_COLS, nullptr, DSA_COLS, DSA_COLS, mnorm, WB + WB_WIN, DM, DSA_LD, 0);
    else cvt_matrix(F, itb, F.ka->in[16] + (size_t)j * DM * NSA_COLS, nullptr, NSA_COLS, NSA_COLS, mnorm, WB + WB_WIN, DM, NSA_LD, 2);
    cvt_matrix(F, itb, F.ka->in[7] + (size_t)Ly * DM * DM, nullptr, DM, DM, nullptr, WB + WB_WO, DM, DM, 0);
}

__device__ __forceinline__ void xform(Frame& F, const bf16* src, int spitch, int scol0, int nheads, int rows, int Lr, bf16* dst, int dmode, int dpitch, int dcol0,
                                      const float* gain, bool rope, float cscale, int decay  ) {
    const float* tab = (const float*)(F.ws + WS_ROPE);
    const int i8 = F.lane & 7, sub = F.lane >> 3; const int items = rows * nheads;
    float gn[8];
#pragma unroll
    for (int j = 0; j < 8; ++j) gn[j] = gain ? gain[8 * i8 + j] : 1.f;
    constexpr int U = 4;
    for (int it0 = F.gw * (8 * U); it0 < items; it0 += F.NGW * (8 * U)) {
        v4u raw[U]; f32x4 c0[U], c1[U], s0[U], s1[U];
#pragma unroll
        for (int u = 0; u < U; ++u) { const int it = it0 + 8 * u + sub; const int row = it / nheads, h = it % nheads, t = row % Lr;
            raw[u] = *(const GAS v4u*)(src + (size_t)row * spitch + scol0 + h * 64 + 8 * i8);
            if (rope) { const float* tr = tab + (size_t)t * 64 + 8 * (i8 & 3);
                c0[u] = *(const GAS f32x4*)(tr); c1[u] = *(const GAS f32x4*)(tr + 4); s0[u] = *(const GAS f32x4*)(tr + 32); s1[u] = *(const GAS f32x4*)(tr + 36); } }
#pragma unroll
        for (int u = 0; u < U; ++u) { const int it = it0 + 8 * u + sub; const int row = it / nheads, h = it % nheads, t = row % Lr;
            float v[8] = {bflo(raw[u].x), bfhi(raw[u].x), bflo(raw[u].y), bfhi(raw[u].y), bflo(raw[u].z), bfhi(raw[u].z), bflo(raw[u].w), bfhi(raw[u].w)};
            if (gain) { float ss = 0.f;
#pragma unroll
                for (int j = 0; j < 8; ++j) ss += v[j] * v[j];
                ss += __shfl_xor(ss, 1); ss += __shfl_xor(ss, 2); ss += __shfl_xor(ss, 4);
                const float r = __builtin_amdgcn_rsqf(ss * (1.f / 64.f) + EPS);
#pragma unroll
                for (int j = 0; j < 8; ++j) v[j] = v[j] * r * gn[j]; }
            if (rope) {
                const float cs[8] = {c0[u][0], c0[u][1], c0[u][2], c0[u][3], c1[u][0], c1[u][1], c1[u][2], c1[u][3]}, sn[8] = {s0[u][0], s0[u][1], s0[u][2], s0[u][3], s1[u][0], s1[u][1], s1[u][2], s1[u][3]};
#pragma unroll
                for (int j = 0; j < 8; ++j) { const float p = __shfl_xor(v[j], 4); v[j] = (i8 < 4) ? (v[j] * cs[j] - p * sn[j]) : (v[j] * cs[j] + p * sn[j]); } }
            float f = cscale;
            if (decay) { const float lg = __builtin_amdgcn_logf(1.0f - __builtin_amdgcn_exp2f(-5.0f - (float)h)); f *= __builtin_amdgcn_exp2f((float)(decay * t) * lg); }
            v4u o; o.x = pk2(v[0] * f, v[1] * f); o.y = pk2(v[2] * f, v[3] * f); o.z = pk2(v[4] * f, v[5] * f); o.w = pk2(v[6] * f, v[7] * f);
            bf16* dp = dmode == 0 ? dst + (size_t)row * dpitch + dcol0 + h * 64 + 8 * i8 : dst + ((size_t)((row / Lr) * nheads + h) * Lr + t) * 64 + 8 * i8;
            *(GAS v4u*)dp = o; }
    }
}
__device__ __forceinline__ void transpose_cols(Frame& F, const bf16* src, int spitch, int scol0, int ncols, int nb, int Lr, bf16* dst) {
    LAS bf16* scr = (LAS bf16*)(F.lds + F.wave * 16384);
    const int ntt = Lr / 64, nct = ncols / 64, ntiles = nb * ntt * nct; const int i8 = F.lane & 7, sub = F.lane >> 3;
    for (int tl = F.gw; tl < ntiles; tl += F.NGW) {
        const int ct = tl % nct, tt = (tl / nct) % ntt, b = tl / (nct * ntt); const int t0 = tt * 64, c0 = ct * 64;
#pragma unroll
        for (int k = 0; k < 8; ++k) { const int r = sub + 8 * k;
            const v4u raw = *(const GAS v4u*)(src + (size_t)(b * Lr + t0 + r) * spitch + scol0 + c0 + 8 * i8);
            *(LAS v4u*)(scr + r * 72 + 8 * i8) = raw; }
        LDS_WAIT(); asm volatile("" ::: "memory");
        bf16* drow = dst + ((size_t)b * ncols + c0 + F.lane) * Lr + t0;
#pragma unroll
        for (int k = 0; k < 8; ++k) { unsigned w[4];
#pragma unroll
            for (int q = 0; q < 4; ++q) { const unsigned lo = scr[(8 * k + 2 * q) * 72 + F.lane], hi = scr[(8 * k + 2 * q + 1) * 72 + F.lane]; w[q] = lo | (hi << 16); }
            v4u o; o.x = w[0]; o.y = w[1]; o.z = w[2]; o.w = w[3]; *(GAS v4u*)(drow + 8 * k) = o; }
        LDS_WAIT(); asm volatile("" ::: "memory");
    }
}
__device__ __forceinline__ void row_to_bf16(Frame& F, const float* xrow, bf16* orow, float* part) {
    const GAS f32x4* xr = (const GAS f32x4*)xrow + F.lane;
    f32x4 v[4]; float s = 0.f;
#pragma unroll
    for (int j = 0; j < 4; ++j) { v[j] = xr[64 * j]; s += (v[j].x * v[j].x + v[j].y * v[j].y) + (v[j].z * v[j].z + v[j].w * v[j].w); }
    s = wave_sum(s);
    GAS v2u* o8 = (GAS v2u*)orow + F.lane;
#pragma unroll
    for (int j = 0; j < 4; ++j) { v2u o; o.x = pk2(v[j].x, v[j].y); o.y = pk2(v[j].z, v[j].w); o8[64 * j] = o; }
    if (F.lane < 16) part[F.lane] = F.lane == 0 ? s : 0.f;
}
enum { MK_NONE = 0, MK_CAUSAL = 1, MK_WIN = 2, MK_BITS = 3, MK_SLC = 4, MK_CMP = 5 };
struct KVp { const bf16* K; int kpitch; const bf16* VT; int vpitch; };
struct MaskArg { int q0[3]; const unsigned* mb; unsigned sel; int nmax; float lg; };
__device__ __forceinline__ bf16x8 ld8(const bf16* p) { return *(const GAS bf16x8*)p; }
__device__ __forceinline__ float fast_exp2(float x) { return __builtin_amdgcn_exp2f(x); }

template <int NS, int NT, int MODE, int MT, int PF = 2>
__device__ __forceinline__ void attn_core(const LAS bf16x8* ql, const KVp kv, int kt0, int kt1, float negb, const MaskArg& ma, const unsigned* const (&mbrow)[NS],
                                          f32x16 (&O)[NS][NT], float (&lsum)[NS], int lane) {
    const int r32 = lane & 31, hi = lane >> 5;
    const int kperm = (r32 & 0x13) | ((r32 & 4) << 1) | ((r32 & 8) >> 1);
    const bf16* kp = kv.K + (size_t)kperm * kv.kpitch + 8 * hi;
    const bf16* vp = kv.VT + (size_t)r32 * kv.vpitch + 8 * hi;
    bf16x8 kf[4], vf[2][NT], kfn[4], vfn[2][NT];
#define AC_LOADK(dst, kt_) do { const bf16* kq_ = kp + (size_t)(32 * (kt_)) * kv.kpitch; _Pragma("unroll") for (int ks = 0; ks < 4; ++ks) dst[ks] = ld8(kq_ + 16 * ks); } while (0)
#define AC_LOADV(dst, kt_) do { _Pragma("unroll") for (int nt = 0; nt < NT; ++nt) { const bf16* vq_ = vp + (size_t)(32 * nt) * kv.vpitch + 32 * (kt_); dst[0][nt] = ld8(vq_); dst[1][nt] = ld8(vq_ + 16); } } while (0)
    unsigned mw[NS], mwn[NS];
    if (kt0 < kt1) { if (PF >= 1) AC_LOADK(kf, kt0); if (PF >= 2) AC_LOADV(vf, kt0);
        if (MT == MK_BITS) { _Pragma("unroll") for (int s = 0; s < NS; ++s) mw[s] = mbrow[s][kt0]; } }
#pragma unroll 1
    for (int kt = kt0; kt < kt1; ++kt) {
        unsigned selbit = 1u; bool active = true;
        if (MT == MK_SLC) { selbit = (ma.sel >> (kt >> 1)) & 1u; active = __any(selbit != 0u); }
        const int ktn = (kt + 1 < kt1) ? kt + 1 : kt;
        if (PF == 0) { if (active) { AC_LOADK(kf, kt); AC_LOADV(vf, kt); } }
        else { AC_LOADK(kfn, ktn); if (PF >= 2) AC_LOADV(vfn, ktn); else if (active) AC_LOADV(vf, kt); }
        if (MT == MK_BITS) { _Pragma("unroll") for (int s = 0; s < NS; ++s) mwn[s] = mbrow[s][ktn]; }
        if (active) {
        const LAS bf16x8* qlp = ql; asm volatile("" : "+v"(qlp));
#pragma unroll
        for (int s = 0; s < NS; ++s) {
            f32x16 acc;
#pragma unroll
            for (int r = 0; r < 16; ++r) acc[r] = 0.f;
#pragma unroll
            for (int ks = 0; ks < 4; ++ks) acc = __builtin_amdgcn_mfma_f32_32x32x16_bf16(kf[ks], qlp[(s * 4 + ks) * 64], acc, 0, 0, 0);
            const int tq = ma.q0[s] + r32, kb = 32 * kt + 8 * hi;
            bool full = true;
            if (MT == MK_CAUSAL) full = (32 * kt + 31 <= ma.q0[s]);
            if (MT == MK_WIN) full = (32 * kt + 31 <= ma.q0[s]) && (32 * kt >= ma.q0[s] + 31 - 511);
            if (MT == MK_SLC) full = (32 * kt + 31 <= ma.q0[s]) && __all(selbit != 0u);
            if (MT == MK_BITS || MT == MK_CMP) full = false;
            float p[16];
            if (full) {
#pragma unroll
                for (int r = 0; r < 16; ++r) { const int key = kb + 16 * (r >> 3) + (r & 7); p[r] = MODE == 0 ? fast_exp2(acc[r]) : (MODE == 1 ? acc[r] : acc[r] * fast_exp2((float)(tq - key) * ma.lg)); }
            } else {
                unsigned w = 0;
                if (MT == MK_BITS) w = mw[s];
#pragma unroll
                for (int r = 0; r < 16; ++r) { const int key = kb + 16 * (r >> 3) + (r & 7); bool v = true;
                    if (MT == MK_CAUSAL) v = key <= tq;
                    if (MT == MK_WIN) v = (key <= tq) && (key >= tq - 511);
                    if (MT == MK_SLC) v = (key <= tq) && (selbit != 0u);
                    if (MT == MK_BITS) v = (w >> (8 * hi + 16 * (r >> 3) + (r & 7))) & 1u;
                    if (MT == MK_CMP) v = key <= ma.nmax;
                    const float e = MODE == 0 ? fast_exp2(acc[r]) : (MODE == 1 ? acc[r] : acc[r] * fast_exp2((float)((tq - key) < 0 ? 0 : (tq - key)) * ma.lg));
                    p[r] = v ? e : 0.f; }
            }
            if (MODE == 0) { float a = 0.f;
#pragma unroll
                for (int r = 0; r < 16; ++r) a += p[r];
                lsum[s] += a; }
            bf16x8 pk0, pk1;
            { v4u t0, t1; t0.x = pk2(p[0], p[1]); t0.y = pk2(p[2], p[3]); t0.z = pk2(p[4], p[5]); t0.w = pk2(p[6], p[7]);
              t1.x = pk2(p[8], p[9]); t1.y = pk2(p[10], p[11]); t1.z = pk2(p[12], p[13]); t1.w = pk2(p[14], p[15]);
              pk0 = __builtin_bit_cast(bf16x8, t0); pk1 = __builtin_bit_cast(bf16x8, t1); }
#pragma unroll
            for (int nt = 0; nt < NT; ++nt) { O[s][nt] = __builtin_amdgcn_mfma_f32_32x32x16_bf16(pk0, vf[0][nt], O[s][nt], 0, 0, 0);
                                              O[s][nt] = __builtin_amdgcn_mfma_f32_32x32x16_bf16(pk1, vf[1][nt], O[s][nt], 0, 0, 0); }
            if (NS >= 3) __builtin_amdgcn_sched_barrier(0);
        }
        }
        if (MT == MK_BITS) { _Pragma("unroll") for (int s = 0; s < NS; ++s) mw[s] = mwn[s]; }
        if (PF >= 1) {
#pragma unroll
            for (int ks = 0; ks < 4; ++ks) kf[ks] = kfn[ks];
            if (PF >= 2) {
#pragma unroll
                for (int nt = 0; nt < NT; ++nt) { vf[0][nt] = vfn[0][nt]; vf[1][nt] = vfn[1][nt]; } }
        }
    }
#undef AC_LOADK
#undef AC_LOADV
}
template <int NS, int NT, int MODE, int MT>
__device__ __forceinline__ void tile_math(const bf16x8 (&kf)[4], const bf16x8 (&vf)[2][NT], const LAS bf16x8* ql, int kt, const MaskArg& ma, const unsigned (&mw)[NS], unsigned selbit,
                                          f32x16 (&O)[NS][NT], float (&lsum)[NS], int lane) {
    const int r32 = lane & 31, hi = lane >> 5;
    const LAS bf16x8* qlp = ql; asm volatile("" : "+v"(qlp));
#pragma unroll
    for (int s = 0; s < NS; ++s) {
        f32x16 acc;
#pragma unroll
        for (int r = 0; r < 16; ++r) acc[r] = 0.f;
#pragma unroll
        for (int ks = 0; ks < 4; ++ks) acc = __builtin_amdgcn_mfma_f32_32x32x16_bf16(kf[ks], qlp[(s * 4 + ks) * 64], acc, 0, 0, 0);
        const int tq = ma.q0[s] + r32, kb = 32 * kt + 8 * hi;
        bool full = true;
        if (MT == MK_CAUSAL) full = (32 * kt + 31 <= ma.q0[s]);
        if (MT == MK_WIN) full = (32 * kt + 31 <= ma.q0[s]) && (32 * kt >= ma.q0[s] + 31 - 511);
        if (MT == MK_SLC) full = (32 * kt + 31 <= ma.q0[s]) && __all(selbit != 0u);
        if (MT == MK_BITS || MT == MK_CMP) full = false;
        float p[16];
        if (full) {
#pragma unroll
            for (int r = 0; r < 16; ++r) p[r] = MODE == 0 ? fast_exp2(acc[r]) : acc[r];
        } else if (MT == MK_BITS) {
            const unsigned wsh = mw[s] >> (8 * hi);
#pragma unroll
            for (int r = 0; r < 16; ++r) { const int m = ((int)(wsh << (31 - (16 * (r >> 3) + (r & 7))))) >> 31;
                p[r] = __builtin_bit_cast(float, __builtin_bit_cast(unsigned, fast_exp2(acc[r])) & (unsigned)m); }
        } else {
            const unsigned w = mw[s];
#pragma unroll
            for (int r = 0; r < 16; ++r) { const int key = kb + 16 * (r >> 3) + (r & 7); bool v = true;
                if (MT == MK_CAUSAL) v = key <= tq;
                if (MT == MK_WIN) v = (key <= tq) && (key >= tq - 511);
                if (MT == MK_SLC) v = (key <= tq) && (selbit != 0u);
                if (MT == MK_BITS) v = (w >> (8 * hi + 16 * (r >> 3) + (r & 7))) & 1u;
                if (MT == MK_CMP) v = key <= ma.nmax;
                const float e = MODE == 0 ? fast_exp2(acc[r]) : acc[r];
                p[r] = v ? e : 0.f; }
        }
        if (MODE == 0) { float a = 0.f;
#pragma unroll
            for (int r = 0; r < 16; ++r) a += p[r];
            lsum[s] += a; }
        bf16x8 pk0, pk1;
        { v4u t0, t1; t0.x = pk2(p[0], p[1]); t0.y = pk2(p[2], p[3]); t0.z = pk2(p[4], p[5]); t0.w = pk2(p[6], p[7]);
          t1.x = pk2(p[8], p[9]); t1.y = pk2(p[10], p[11]); t1.z = pk2(p[12], p[13]); t1.w = pk2(p[14], p[15]);
          pk0 = __builtin_bit_cast(bf16x8, t0); pk1 = __builtin_bit_cast(bf16x8, t1); }
#pragma unroll
        for (int nt = 0; nt < NT; ++nt) { O[s][nt] = __builtin_amdgcn_mfma_f32_32x32x16_bf16(pk0, vf[0][nt], O[s][nt], 0, 0, 0);
                                          O[s][nt] = __builtin_amdgcn_mfma_f32_32x32x16_bf16(pk1, vf[1][nt], O[s][nt], 0, 0, 0); }
        if (NS >= 3) __builtin_amdgcn_sched_barrier(0);
    }
}
__device__ __forceinline__ int crow(int r, int hi) { return (r & 3) + 8 * (r >> 2) + 4 * hi; }
template <int NT, bool ADD>
__device__ __forceinline__ void store_o(const f32x16 (&O)[NT], float f, bf16* Y, int row0, int col0, int lane) {
    const int r32 = lane & 31, hi = lane >> 5;
    unsigned ybase = (unsigned)((row0 + 4 * hi) * 1024 + col0 + r32); asm volatile("" : "+v"(ybase));
#pragma unroll
    for (int rh = 0; rh < 2; ++rh) {
        unsigned short old[NT][8];
        if (ADD) {
#pragma unroll
            for (int ri = 0; ri < 8; ++ri)
#pragma unroll
                for (int nt = 0; nt < NT; ++nt) { const int r = 8 * rh + ri; old[nt][ri] = Y[ybase + (unsigned)(((r & 3) + 8 * (r >> 2)) * 1024) + 32 * nt]; }
        }
#pragma unroll
        for (int ri = 0; ri < 8; ++ri) { const int r = 8 * rh + ri; const int q = crow(r, hi); const float fr = __shfl(f, q);
            const unsigned yo = ybase + (unsigned)(((r & 3) + 8 * (r >> 2)) * 1024);
#pragma unroll
            for (int nt = 0; nt < NT; ++nt) { float v = O[nt][r] * fr; if (ADD) v += bf2f(old[nt][ri]); Y[yo + 32 * nt] = (bf16)f2bf(v); } }
    }
}
template <int NS> __device__ __forceinline__ void stage_q(LAS bf16x8* ql, const bf16* const (&qrow)[NS], int lane) {
    const int hi = lane >> 5;
#pragma unroll
    for (int s = 0; s < NS; ++s)
#pragma unroll
        for (int ks = 0; ks < 4; ++ks) ql[(s * 4 + ks) * 64] = ld8(qrow[s] + 16 * ks + 8 * hi);
    LDS_WAIT(); asm volatile("" ::: "memory");
}
__device__ __forceinline__ LAS bf16x8* wave_q(Frame& F) { return (LAS bf16x8*)(F.lds + F.wave * 16384) + F.lane; }
template <int NS, int NT> __device__ __forceinline__ void zero_o(f32x16 (&O)[NS][NT], float (&l)[NS]) {
#pragma unroll
    for (int s = 0; s < NS; ++s) { l[s] = 0.f;
#pragma unroll
        for (int nt = 0; nt < NT; ++nt)
#pragma unroll
            for (int r = 0; r < 16; ++r) O[s][nt][r] = 0.f; }
}

__device__ __forceinline__ void mem_task(Frame& F, int task, int Ly, const bf16* PROJ, int ldp, int qmcol) {
    const int qb = task & 31, h = (task >> 5) & 3, b = task >> 7; const int r32 = F.lane & 31;
    const int row0 = b * SEQ + 64 * qb;
    const bf16* qrow[2] = {PROJ + (size_t)(row0 + r32) * ldp + qmcol + h * 64, PROJ + (size_t)(row0 + 32 + r32) * ldp + qmcol + h * 64};
    LAS bf16x8* ql = wave_q(F); stage_q<2>(ql, qrow, F.lane);
    KVp kv{(const bf16*)(F.ws + WS_MK) + ((size_t)((Ly * NB + b) * 4 + h) * NMEMT) * 64, 64, (const bf16*)(F.ws + WS_MVT) + ((size_t)(Ly * NB + b) * 256 + h * 64) * NMEMT, NMEMT};
    f32x16 O[2][2]; float l[2]; zero_o<2, 2>(O, l);
    MaskArg ma{}; const unsigned* mbr[2] = {nullptr, nullptr};
    const float negb = 0.f;
    attn_core<2, 2, 0, MK_NONE>(ql, kv, 0, NMEMT / 32, negb, ma, mbr, O, l, F.lane);
    bf16* Y = (bf16*)(F.ws + WS_Y);
#pragma unroll
    for (int s = 0; s < 2; ++s) { const float lt = l[s] + __shfl_xor(l[s], 32); store_o<2, false>(O[s], (DBG_ZERO & 8) ? 0.f : 1.f / lt, Y, row0 + 32 * s, 768 + h * 64, F.lane); }
}
__device__ __forceinline__ void ret_epilogue(Frame& F, const f32x16 (&O)[4], int rowb, int h, const bf16* PROJ) {
    const int r32 = F.lane & 31, hi = F.lane >> 5;
    bf16* Y = (bf16*)(F.ws + WS_Y);
#pragma unroll
    for (int rh = 0; rh < 2; ++rh) {
        unsigned short gv[8][4];
#pragma unroll
        for (int ri = 0; ri < 8; ++ri) { const int r = 8 * rh + ri; const bf16* gp = PROJ + (size_t)(rowb + crow(r, hi)) * RET_LD + RET_G + h * 128 + r32;
#pragma unroll
            for (int nt = 0; nt < 4; ++nt) gv[ri][nt] = gp[32 * nt]; }
#pragma unroll
        for (int ri = 0; ri < 8; ++ri) { const int r = 8 * rh + ri;
            float a = (O[0][r] + O[1][r]) + (O[2][r] + O[3][r]);
#pragma unroll
            for (int o = 1; o < 32; o <<= 1) a += __shfl_xor(a, o);
            const float mu = a * (1.f / 128.f);
            float d0 = O[0][r] - mu, d1 = O[1][r] - mu, d2 = O[2][r] - mu, d3 = O[3][r] - mu;
            float q = (d0 * d0 + d1 * d1) + (d2 * d2 + d3 * d3);
#pragma unroll
            for (int o = 1; o < 32; o <<= 1) q += __shfl_xor(q, o);
            const float rstd = __builtin_amdgcn_rsqf(q * (1.f / 128.f) + EPS);
            const int row = rowb + crow(r, hi);
            bf16* yp = Y + (size_t)row * 1024 + h * 128 + r32;
            const float dd[4] = {d0, d1, d2, d3};
#pragma unroll
            for (int nt = 0; nt < 4; ++nt) { const float g = bf2f(gv[ri][nt]); const float sg = g * __builtin_amdgcn_rcpf(1.f + fast_exp2(-1.4426950408889634f * g));
                yp[32 * nt] = (DBG_ZERO & 1) ? (bf16)0 : (bf16)f2bf(sg * dd[nt] * rstd); }
        }
    }
}
__device__ __forceinline__ void glds16(const void* gsrc, unsigned lds_dst) { unsigned keep;
    asm volatile("s_mov_b32 %0, m0\n\ts_mov_b32 m0, %2\n\ts_nop 0\n\tglobal_load_lds_dwordx4 %1, off\n\ts_mov_b32 m0, %0" : "=&s"(keep) : "v"(gsrc), "s"(lds_dst) : "memory"); }
template <int NS, int MT, int R>
__device__ __forceinline__ void wg_attn(Frame& F, const LAS bf16x8* ql, const bf16* psrc, int pstep, unsigned ring_off, int kt0, int kt1, unsigned blk, int my0, int my1,
                                        const MaskArg& ma, const LAS unsigned* mlds, f32x16 (&O)[NS][2], float (&lsum)[NS]) {
    const unsigned pdst = (unsigned)(uintptr_t)F.lds + ring_off + (unsigned)F.wave * 1024u;
#define WG_NEED(k_) ((MT != MK_SLC) || (((blk) >> ((k_) >> 1)) & 1u))
#define WG_ADV(k_) do { ++(k_); } while ((k_) < kt1 && !WG_NEED(k_))
    int kd = kt0; if (kd < kt1 && !WG_NEED(kd)) WG_ADV(kd);
    int kc = kd;
    int sd = 0, sc = 0, nd = 0;
#pragma unroll 1
    for (int j = 0; j < R - 1; ++j) if (kd < kt1) { glds16(psrc + (size_t)kd * pstep, (unsigned)__builtin_amdgcn_readfirstlane(pdst + (unsigned)sd * 8192u)); WG_ADV(kd); sd = sd + 1 == R ? 0 : sd + 1; ++nd; }
#pragma unroll 1
    while (kc < kt1) {
        const int yo = nd - 1;
        if (yo >= 3) asm volatile("s_waitcnt vmcnt(3)\n\ts_barrier" ::: "memory");
        else if (yo == 2) asm volatile("s_waitcnt vmcnt(2)\n\ts_barrier" ::: "memory");
        else if (yo == 1) asm volatile("s_waitcnt vmcnt(1)\n\ts_barrier" ::: "memory");
        else asm volatile("s_waitcnt vmcnt(0)\n\ts_barrier" ::: "memory");
        if (kd < kt1) { glds16(psrc + (size_t)kd * pstep, (unsigned)__builtin_amdgcn_readfirstlane(pdst + (unsigned)sd * 8192u)); WG_ADV(kd); sd = sd + 1 == R ? 0 : sd + 1; ++nd; }
        if (kc >= my0 && kc < my1) {
            unsigned selbit = 1u; bool active = true;
            if (MT == MK_SLC) { selbit = (ma.sel >> (kc >> 1)) & 1u; active = __any(selbit != 0u); }
            if (active) {
                const LAS bf16x8* sp = (const LAS bf16x8*)(F.lds + ring_off + sc * 8192) + F.lane;
                bf16x8 kf[4], vf[2][2];
#pragma unroll
                for (int ks = 0; ks < 4; ++ks) kf[ks] = sp[ks * 64];
#pragma unroll
                for (int nt = 0; nt < 2; ++nt) { vf[0][nt] = sp[(4 + 2 * nt) * 64]; vf[1][nt] = sp[(5 + 2 * nt) * 64]; }
                unsigned mw[NS];
#pragma unroll
                for (int s = 0; s < NS; ++s) mw[s] = (MT == MK_BITS) ? mlds[kc] : 0u;
                tile_math<NS, 2, 0, MT>(kf, vf, ql, kc, ma, mw, selbit, O, lsum, F.lane);
            }
        }
        WG_ADV(kc); sc = sc + 1 == R ? 0 : sc + 1; --nd;
    }
    asm volatile("s_waitcnt vmcnt(0)\n\ts_barrier" ::: "memory");
#undef WG_NEED
#undef WG_ADV
}
constexpr int RWG_SLOT = 12288, RWG_R = 9;
__device__ __forceinline__ void ret_wg_task(Frame& F, int task, const bf16* PROJ) {
    const int qb = 7 - (task & 7), h = (task >> 3) % 6, b = (task >> 3) / 6, w = F.wave; const int r32 = F.lane & 31, hi = F.lane >> 5;
    const int rowb = b * SEQ + 256 * qb + 32 * w;
    bf16x8 qf[4];
    { const bf16* qp = PROJ + (size_t)(rowb + r32) * RET_LD + RET_Q + h * 64 + 8 * hi;
#pragma unroll
      for (int ks = 0; ks < 4; ++ks) qf[ks] = ld8(qp + 16 * ks); }
    asm volatile("s_waitcnt vmcnt(0)" : "+v"(qf[0]), "+v"(qf[1]), "+v"(qf[2]), "+v"(qf[3]) :: "memory");
    const int kperm = (r32 & 0x13) | ((r32 & 4) << 1) | ((r32 & 8) >> 1);
    const bf16* ksrc = PROJ + (size_t)(b * SEQ + kperm) * RET_LD + RET_K + h * 64 + 16 * (w & 3) + 8 * hi;
    const bf16* vsrc = (const bf16*)F.out + ((size_t)b * 768 + h * 128 + 32 * (w >> 1) + r32) * SEQ + 16 * (w & 1) + 8 * hi;
    const unsigned lds0 = (unsigned)(uintptr_t)F.lds;
    const unsigned kdst = lds0 + (unsigned)(w & 3) * 1024u, vdst = lds0 + 4096u + (unsigned)w * 1024u;
    const int kt1 = 8 * qb + 8, my1 = 8 * qb + w + 1;
#define RWG_DMA(t_, slot_) do { const int tt_ = (t_) < kt1 ? (t_) : kt1 - 1; const unsigned so_ = (unsigned)(((t_) < kt1) ? (slot_) : RWG_R) * RWG_SLOT; \
        if (w < 4) glds16(ksrc + (size_t)(32 * tt_) * RET_LD, (unsigned)__builtin_amdgcn_readfirstlane(kdst + so_)); \
        glds16(vsrc + 32 * tt_, (unsigned)__builtin_amdgcn_readfirstlane(vdst + so_)); } while (0)
    f32x16 O[4];
#pragma unroll
    for (int nt = 0; nt < 4; ++nt)
#pragma unroll
        for (int r = 0; r < 16; ++r) O[nt][r] = 0.f;
#pragma unroll 1
    for (int j = 0; j < RWG_R - 1; ++j) RWG_DMA(j, j);
    int slot = 0, fslot = RWG_R - 1;
#pragma unroll 1
    for (int kt = 0; kt < kt1; ++kt) {
        if (w < 4) asm volatile("s_waitcnt vmcnt(%0)\n\ts_barrier" :: "n"(2 * (RWG_R - 2)) : "memory");
        else       asm volatile("s_waitcnt vmcnt(%0)\n\ts_barrier" :: "n"(RWG_R - 2) : "memory");
        RWG_DMA(kt + RWG_R - 1, fslot);
        if (kt < my1) {
            const LAS bf16x8* sp = (const LAS bf16x8*)(F.lds + slot * RWG_SLOT) + F.lane;
            bf16x8 kf[4], vf[2][4];
#pragma unroll
            for (int ks = 0; ks < 4; ++ks) kf[ks] = sp[ks * 64];
#pragma unroll
            for (int nt = 0; nt < 4; ++nt) { vf[0][nt] = sp[(4 + 2 * nt) * 64]; vf[1][nt] = sp[(5 + 2 * nt) * 64]; }
            f32x16 acc;
#pragma unroll
            for (int r = 0; r < 16; ++r) acc[r] = 0.f;
#pragma unroll
            for (int ks = 0; ks < 4; ++ks) acc = __builtin_amdgcn_mfma_f32_32x32x16_bf16(kf[ks], qf[ks], acc, 0, 0, 0);
            float p[16];
            if (kt + 1 < my1) {
#pragma unroll
                for (int r = 0; r < 16; ++r) p[r] = acc[r];
            } else {
#pragma unroll
                for (int r = 0; r < 16; ++r) p[r] = (8 * hi + 16 * (r >> 3) + (r & 7) <= r32) ? acc[r] : 0.f;
            }
            bf16x8 pk0, pk1;
            { v4u t0, t1; t0.x = pk2(p[0], p[1]); t0.y = pk2(p[2], p[3]); t0.z = pk2(p[4], p[5]); t0.w = pk2(p[6], p[7]);
              t1.x = pk2(p[8], p[9]); t1.y = pk2(p[10], p[11]); t1.z = pk2(p[12], p[13]); t1.w = pk2(p[14], p[15]);
              pk0 = __builtin_bit_cast(bf16x8, t0); pk1 = __builtin_bit_cast(bf16x8, t1); }
#pragma unroll
            for (int nt = 0; nt < 4; ++nt) { O[nt] = __builtin_amdgcn_mfma_f32_32x32x16_bf16(pk0, vf[0][nt], O[nt], 0, 0, 0);
                                             O[nt] = __builtin_amdgcn_mfma_f32_32x32x16_bf16(pk1, vf[1][nt], O[nt], 0, 0, 0); }
        }
        fslot = slot; slot = slot + 1 == RWG_R ? 0 : slot + 1;
    }
    asm volatile("s_waitcnt vmcnt(0)\n\ts_barrier" ::: "memory");
#undef RWG_DMA
    ret_epilogue(F, O, rowb, h, PROJ);
}
__device__ __forceinline__ void ret_task(Frame& F, int task, const bf16* PROJ) {
    const int qb = 31 - (task & 31), h = (task >> 5) % 6, b = (task >> 5) / 6; const int r32 = F.lane & 31, hi = F.lane >> 5;
    const int row0 = b * SEQ + 64 * qb;
    const bf16* qrow[2] = {PROJ + (size_t)(row0 + r32) * RET_LD + RET_Q + h * 64, PROJ + (size_t)(row0 + 32 + r32) * RET_LD + RET_Q + h * 64};
    LAS bf16x8* ql = wave_q(F); stage_q<2>(ql, qrow, F.lane);
    KVp kv{PROJ + (size_t)(b * SEQ) * RET_LD + RET_K + h * 64, RET_LD, (const bf16*)F.out + ((size_t)b * 768 + h * 128) * SEQ, SEQ};
    f32x16 O[2][4]; float l[2]; zero_o<2, 4>(O, l);
    MaskArg ma{}; ma.q0[0] = 64 * qb; ma.q0[1] = 64 * qb + 32; const unsigned* mbr[2] = {nullptr, nullptr};
    ma.lg = __builtin_amdgcn_logf(1.0f - __builtin_amdgcn_exp2f(-5.0f - (float)h));
    attn_core<2, 4, RET_MODE, MK_CAUSAL, 1>(ql, kv, 0, 2 * qb + 2, 0.f, ma, mbr, O, l, F.lane);
#pragma unroll
    for (int s = 0; s < 2; ++s) ret_epilogue(F, O[s], row0 + 32 * s, h, PROJ);
}

typedef _Float16 h2_t __attribute__((ext_vector_type(2)));
__device__ __forceinline__ unsigned pkh(float a, float b) { h2_t v = {(_Float16)a, (_Float16)b}; return __builtin_bit_cast(unsigned, v); }
__device__ __forceinline__ void dsa_d1_task(Frame& F, int task, const bf16* PROJ) {
    const int b = task / 288; int rem = task % 288; int qb = 63, kc = 0;
    { int grp = 7; while (rem >= 8 * (grp + 1)) { rem -= 8 * (grp + 1); --grp; }
      qb = 8 * grp + 7 - rem / (grp + 1); kc = rem % (grp + 1); }
    const int r32 = F.lane & 31, hi = F.lane >> 5; const int row = b * SEQ + 32 * qb + r32;
    const bf16* qp = PROJ + (size_t)row * DSA_LD + DSA_IQ + 8 * hi;
    bf16x8 qf[4][4]; LAS bf16x8* ql = wave_q(F);
#pragma unroll
    for (int h = 0; h < 4; ++h)
#pragma unroll
        for (int ks = 0; ks < 4; ++ks) { qf[h][ks] = ld8(qp + h * 64 + 16 * ks); ql[(h * 4 + ks) * 64] = ld8(qp + (4 + h) * 64 + 16 * ks); }
    LDS_WAIT(); asm volatile("" ::: "memory");
    float iw[8];
    { const v4u w = *(const GAS v4u*)(PROJ + (size_t)row * DSA_LD + DSA_IW); iw[0] = bflo(w.x); iw[1] = bfhi(w.x); iw[2] = bflo(w.y); iw[3] = bfhi(w.y); iw[4] = bflo(w.z); iw[5] = bfhi(w.z); iw[6] = bflo(w.w); iw[7] = bfhi(w.w); }
    const int kperm = (r32 & 0x13) | ((r32 & 4) << 1) | ((r32 & 8) >> 1);
    const bf16* kp = PROJ + (size_t)(b * SEQ + kperm) * DSA_LD + DSA_IK + 8 * hi;
    _Float16* sc = (_Float16*)(F.ws + WS_SC) + (size_t)row * SEQ + 8 * hi;
    const int kt1 = (8 * kc + 8 < qb + 1) ? 8 * kc + 8 : qb + 1;
    bf16x8 kf[4], kfn[4];
#pragma unroll
    for (int ks = 0; ks < 4; ++ks) kf[ks] = ld8(kp + (size_t)(32 * (8 * kc)) * DSA_LD + 16 * ks);
#pragma unroll 1
    for (int kt = 8 * kc; kt < kt1; ++kt) {
        { const int ktn = kt + 1 < kt1 ? kt + 1 : kt;
#pragma unroll
          for (int ks = 0; ks < 4; ++ks) kfn[ks] = ld8(kp + (size_t)(32 * ktn) * DSA_LD + 16 * ks); }
        float s[16];
#pragma unroll
        for (int r = 0; r < 16; ++r) s[r] = 0.f;
#pragma unroll
        for (int h = 0; h < 8; ++h) { f32x16 acc;
#pragma unroll
            for (int r = 0; r < 16; ++r) acc[r] = 0.f;
#pragma unroll
            for (int ks = 0; ks < 4; ++ks) acc = __builtin_amdgcn_mfma_f32_32x32x16_bf16(kf[ks], h < 4 ? qf[h & 3][ks] : ql[((h & 3) * 4 + ks) * 64], acc, 0, 0, 0);
#pragma unroll
            for (int r = 0; r < 16; ++r) s[r] += iw[h] * fmaxf(acc[r], 0.f);
            __builtin_amdgcn_sched_barrier(0); }
        v4u o0, o1; o0.x = pkh(s[0], s[1]); o0.y = pkh(s[2], s[3]); o0.z = pkh(s[4], s[5]); o0.w = pkh(s[6], s[7]);
        o1.x = pkh(s[8], s[9]); o1.y = pkh(s[10], s[11]); o1.z = pkh(s[12], s[13]); o1.w = pkh(s[14], s[15]);
        *(GAS v4u*)(sc + 32 * kt) = o0; *(GAS v4u*)(sc + 32 * kt + 16) = o1;
#pragma unroll
        for (int ks = 0; ks < 4; ++ks) kf[ks] = kfn[ks];
    }
}
__device__ __forceinline__ int hist_select(LAS unsigned* hist, const unsigned (&key)[32], bool lvl2, unsigned B, int target, int lane) {
    { unsigned z = 0u; asm volatile("" : "+v"(z)); *(LAS v4u*)(hist + 4 * lane) = (v4u){z, z, z, z}; }
    LDS_WAIT(); asm volatile("" ::: "memory");
#pragma unroll
    for (int e = 0; e < 32; ++e) { const unsigned d = lvl2 ? (key[e] & 255u) : (key[e] >> 8); const bool m = lvl2 ? ((key[e] >> 8) == B) : true;
        if (m) __hip_atomic_fetch_add(hist + d, 1u, __ATOMIC_RELAXED, __HIP_MEMORY_SCOPE_WAVEFRONT); }
    LDS_WAIT(); asm volatile("" ::: "memory");
    const v4u c = *(LAS v4u*)(hist + 4 * lane);
    const int s = (int)(c.x + c.y + c.z + c.w);
    int S = s;
#pragma unroll
    for (int o = 1; o < 64; o <<= 1) { const int v = __shfl_down(S, o); if (lane + o < 64) S += v; }
    const unsigned long long bm = __ballot(S >= target);
    const int Ls = 63 - __clzll(bm);
    int a = S - s, dig, abv;
    if (a + (int)c.w >= target) { dig = 3; abv = a; } else { a += (int)c.w;
        if (a + (int)c.z >= target) { dig = 2; abv = a; } else { a += (int)c.z;
            if (a + (int)c.y >= target) { dig = 1; abv = a; } else { a += (int)c.y; dig = 0; abv = a; } } }
    const int packed = ((4 * lane + dig) << 12) | abv;
    const int r = __shfl(packed, Ls);
    LDS_WAIT(); asm volatile("" ::: "memory");
    return r;
}
__device__ __forceinline__ void d2_load(Frame& F, int row, v4u (&raw)[4]) {
    const int t = row % SEQ, lane = F.lane;
    const unsigned short* sp = (const unsigned short*)(F.ws + WS_SC) + (size_t)row * SEQ + (32 * lane <= t ? 32 * lane : 0);
#pragma unroll
    for (int i = 0; i < 4; ++i) raw[i] = *(const GAS v4u*)(sp + 8 * i);
}
__device__ __forceinline__ void dsa_d2_row(Frame& F, int row, const v4u (&raw)[4]) {
    const int t = row % SEQ, lane = F.lane;
    unsigned* mbp = (unsigned*)(F.ws + WS_MB) + (size_t)row * 64;
    int nvalid = t + 1 - 32 * lane; nvalid = nvalid < 0 ? 0 : (nvalid > 32 ? 32 : nvalid);
    const unsigned cb = nvalid == 32 ? 0xffffffffu : ((1u << nvalid) - 1u);
    if (t < 256) { mbp[lane] = cb; return; }
    unsigned key[32];
#pragma unroll
    for (int i = 0; i < 4; ++i) { const unsigned w[4] = {raw[i].x, raw[i].y, raw[i].z, raw[i].w};
#pragma unroll
        for (int j = 0; j < 4; ++j) {
#pragma unroll
            for (int k = 0; k < 2; ++k) { const int e = 8 * i + 2 * j + k; const unsigned u = (w[j] >> (16 * k)) & 0xffffu;
                const unsigned sk = (u & 0x8000u) ? (~u & 0xffffu) : (u | 0x8000u);
                key[e] = (e < nvalid) ? sk : 0u; } } }
    LAS unsigned* hist = (LAS unsigned*)(F.lds + F.wave * 16384);
    const int d1 = hist_select(hist, key, false, 0u, 256, lane);
    const unsigned Bh = (unsigned)d1 >> 12; const int above1 = d1 & 0xfff;
    const int d2 = hist_select(hist, key, true, Bh, 256 - above1, lane);
    const unsigned T = (Bh << 8) | ((unsigned)d2 >> 12);
    const int cgt = above1 + (d2 & 0xfff);
    unsigned g = 0, eq = 0;
#pragma unroll
    for (int e = 0; e < 32; ++e) { unsigned bg = key[e] > T ? 1u : 0u, be = key[e] == T ? 1u : 0u; asm volatile("" : "+v"(bg), "+v"(be));
        g |= bg << e; eq |= be << e; }
    const int need = 256 - cgt; const int myeq = __popc(eq);
    int incl = myeq;
#pragma unroll
    for (int o = 1; o < 64; o <<= 1) { const int v = __shfl_up(incl, o); if (lane >= o) incl += v; }
    const int pre = incl - myeq; int take = need - pre; take = take < 0 ? 0 : (take > myeq ? myeq : take);
    unsigned te = eq; int cnt = myeq;
    while (cnt > take) { te &= ~(1u << (31 - __clz(te))); --cnt; }
    mbp[lane] = (g | te) & cb;
}
__device__ __forceinline__ void dsa_d3_task(Frame& F, int task, const bf16* PROJ) {
    const int hg = task & 3, qb = 63 - ((task >> 2) & 63), b = task >> 8; const int r32 = F.lane & 31;
    const int row0 = b * SEQ + 32 * qb;
    const bf16* qrow[3]; const unsigned* mbr[3];
#pragma unroll
    for (int s = 0; s < 3; ++s) { qrow[s] = PROJ + (size_t)(row0 + r32) * DSA_LD + DSA_Q + (3 * hg + s) * 64; mbr[s] = (const unsigned*)(F.ws + WS_MB) + (size_t)(row0 + r32) * 64; }
    LAS bf16x8* ql = wave_q(F); stage_q<3>(ql, qrow, F.lane);
    KVp kv{PROJ + (size_t)(b * SEQ) * DSA_LD + DSA_K, DSA_LD, (const bf16*)F.out + (size_t)b * 64 * SEQ, SEQ};
    f32x16 O[3][2]; float l[3]; zero_o<3, 2>(O, l);
    MaskArg ma{}; ma.q0[0] = ma.q0[1] = ma.q0[2] = 32 * qb;
    const float negb = 0.f;
    attn_core<3, 2, 0, MK_BITS, 2>(ql, kv, 0, qb + 1, negb, ma, mbr, O, l, F.lane);
    bf16* Y = (bf16*)(F.ws + WS_Y);
#pragma unroll
    for (int s = 0; s < 3; ++s) { const float lt = l[s] + __shfl_xor(l[s], 32); store_o<2, false>(O[s], (DBG_ZERO & 2) ? 0.f : 1.f / lt, Y, row0, (3 * hg + s) * 64, F.lane); }
}

constexpr unsigned D3_MOFF = 98304u, D3_ROFF = 98304u + 64u * 65u * 4u;
__device__ __forceinline__ void dsa_d3_wg_task(Frame& F, int task, const bf16* PROJ) {
    const int qb = 31 - (task & 31), b = task >> 5, w = F.wave, qs = w >> 2, hg = w & 3; const int r32 = F.lane & 31, hi = F.lane >> 5;
    const int row0 = b * SEQ + 64 * qb + 32 * qs;
    const bf16* qrow[3];
#pragma unroll
    for (int s = 0; s < 3; ++s) qrow[s] = PROJ + (size_t)(row0 + r32) * DSA_LD + DSA_Q + (3 * hg + s) * 64;
    LAS bf16x8* ql = (LAS bf16x8*)(F.lds + w * 12288) + F.lane; stage_q<3>(ql, qrow, F.lane);
    { const unsigned* mb = (const unsigned*)(F.ws + WS_MB) + (size_t)(b * SEQ + 64 * qb) * 64; LAS unsigned* ml = (LAS unsigned*)(F.lds + D3_MOFF);
#pragma unroll
      for (int j = 0; j < 2; ++j) { const int e = (F.tid + 512 * j) * 4, row = e >> 6, col = e & 63; const v4u m = *(const GAS v4u*)(mb + e);
          ml[row * 65 + col] = m.x; ml[row * 65 + col + 1] = m.y; ml[row * 65 + col + 2] = m.z; ml[row * 65 + col + 3] = m.w; } }
    asm volatile("s_waitcnt vmcnt(0) lgkmcnt(0)\n\ts_barrier" ::: "memory");
    const int kperm = (r32 & 0x13) | ((r32 & 4) << 1) | ((r32 & 8) >> 1);
    const bf16* psrc; int pstep;
    if (w < 4) { psrc = PROJ + (size_t)(b * SEQ + kperm) * DSA_LD + DSA_K + 16 * w + 8 * hi; pstep = 32 * DSA_LD; }
    else { const int j = w - 4; psrc = (const bf16*)F.out + ((size_t)b * 64 + 32 * (j >> 1) + r32) * SEQ + 16 * (j & 1) + 8 * hi; pstep = 32; }
    f32x16 O[3][2]; float l[3]; zero_o<3, 2>(O, l);
    MaskArg ma{}; ma.q0[0] = ma.q0[1] = ma.q0[2] = 64 * qb + 32 * qs;
    const LAS unsigned* mlds = (const LAS unsigned*)(F.lds + D3_MOFF) + (qs * 32 + r32) * 65;
    wg_attn<3, MK_BITS, 3>(F, ql, psrc, pstep, D3_ROFF, 0, 2 * qb + 2, 0xffffffffu, 0, 2 * qb + qs + 1, ma, mlds, O, l);
    bf16* Y = (bf16*)(F.ws + WS_Y);
#pragma unroll
    for (int s = 0; s < 3; ++s) { const float lt = l[s] + __shfl_xor(l[s], 32); store_o<2, false>(O[s], (DBG_ZERO & 2) ? 0.f : 1.f / lt, Y, row0, (3 * hg + s) * 64, F.lane); }
}

__device__ __forceinline__ void nsa_cmp_task(Frame& F, int task, const bf16* PROJ, const float* kn0) {
    const int nb = task & 3, g = (task >> 2) & 3, b = task >> 4; const int r32 = F.lane & 31, hi = F.lane >> 5;
    const int n = 32 * nb + r32, nc = n > 126 ? 126 : n;
    const bf16* arow = PROJ + (size_t)(b * SEQ + 16 * nc) * NSA_LD + 64 * g + 8 * hi;
    const bf16* WkT = (const bf16*)(F.ws + WS_CMPW); const bf16* WvT = WkT + 64 * 2048;
    const bf16* wkp = WkT + (size_t)r32 * 2048 + 8 * hi; const bf16* wvp = WvT + (size_t)r32 * 2048 + 8 * hi;
    f32x16 Dk[2], Dv[2];
#pragma unroll
    for (int et = 0; et < 2; ++et)
#pragma unroll
        for (int r = 0; r < 16; ++r) { Dk[et][r] = 0.f; Dv[et][r] = 0.f; }
#pragma unroll 4
    for (int kk = 0; kk < 128; ++kk) {
        const bf16* ap = arow + (size_t)(kk >> 2) * NSA_LD + 16 * (kk & 3);
        const bf16x8 kcf = ld8(ap + NSA_KC), vcf = ld8(ap + NSA_VC);
#pragma unroll
        for (int et = 0; et < 2; ++et) { const bf16x8 wk = ld8(wkp + (size_t)(32 * et) * 2048 + 16 * kk), wv = ld8(wvp + (size_t)(32 * et) * 2048 + 16 * kk);
            Dk[et] = __builtin_amdgcn_mfma_f32_32x32x16_bf16(wk, kcf, Dk[et], 0, 0, 0);
            Dv[et] = __builtin_amdgcn_mfma_f32_32x32x16_bf16(vcf, wv, Dv[et], 0, 0, 0); }
    }
    const float* ck = (const float*)(F.ws + WS_CTL) + CW_CK; const float* cv = ck + 64;
    const float* tab = (const float*)(F.ws + WS_ROPE) + (size_t)(16 * nc + 31) * 64;
    float ss = 0.f;
#pragma unroll
    for (int et = 0; et < 2; ++et)
#pragma unroll
        for (int r = 0; r < 16; ++r) { Dk[et][r] += ck[32 * et + crow(r, hi)]; ss += Dk[et][r] * Dk[et][r]; }
    ss += __shfl_xor(ss, 32);
    const float rs = __builtin_amdgcn_rsqf(ss * (1.f / 64.f) + EPS);
    bf16* kout = (bf16*)(F.ws + WS_KCMP) + ((size_t)((b * 4 + g) * 128 + n)) * 64;
#pragma unroll
    for (int rq = 0; rq < 4; ++rq) { float o0[4], o1[4];
#pragma unroll
        for (int i = 0; i < 4; ++i) { const int r = 4 * rq + i, idx = crow(r, hi); const float v0 = Dk[0][r] * rs * kn0[idx], v1 = Dk[1][r] * rs * kn0[32 + idx];
            const float c = tab[idx], s = tab[32 + idx]; o0[i] = v0 * c - v1 * s; o1[i] = v1 * c + v0 * s; if (n > 126) { o0[i] = 0.f; o1[i] = 0.f; } }
        v2u w0, w1; w0.x = pk2(o0[0], o0[1]); w0.y = pk2(o0[2], o0[3]); w1.x = pk2(o1[0], o1[1]); w1.y = pk2(o1[2], o1[3]);
        *(GAS v2u*)(kout + 8 * rq + 4 * hi) = w0; *(GAS v2u*)(kout + 32 + 8 * rq + 4 * hi) = w1; }
    bf16* vout = (bf16*)(F.ws + WS_VCMPT) + ((size_t)((b * 4 + g) * 64)) * 128 + 32 * nb;
#pragma unroll
    for (int et = 0; et < 2; ++et) { const float cve = cv[32 * et + r32];
#pragma unroll
        for (int rq = 0; rq < 4; ++rq) { float o[4];
#pragma unroll
            for (int i = 0; i < 4; ++i) { const int nl = 8 * rq + 4 * hi + i; o[i] = (32 * nb + nl > 126) ? 0.f : Dv[et][4 * rq + i] + cve; }
            v2u w; w.x = pk2(o[0], o[1]); w.y = pk2(o[2], o[3]);
            *(GAS v2u*)(vout + (size_t)(32 * et + r32) * 128 + 8 * rq + 4 * hi) = w; } }
}
constexpr unsigned NSA_ROFF = 98304u;
template <bool WG>
__device__ NSA_INLINE void nsa_task(unsigned char* ws_, float* out_, LAS unsigned char* lds_, int wave_, int task, const bf16* PROJ) {
    Frame F; F.ws = ws_; F.out = out_; F.lds = lds_; F.wave = wave_; F.MISC = (volatile LAS unsigned*)(lds_ + LDS_CTRL + 64);
    asm volatile("v_mbcnt_lo_u32_b32 %0, -1, 0\n\tv_mbcnt_hi_u32_b32 %0, -1, %0" : "=v"(F.lane));
    const int qb8 = 7 - (task & 7);
    const int g = WG ? (task >> 3) & 3 : task & 3, qb = WG ? 8 * qb8 + wave_ : 63 - ((task >> 2) & 63), b = WG ? task >> 5 : task >> 8; const int r32 = F.lane & 31, hi = F.lane >> 5;
    const int row0 = b * SEQ + 32 * qb, tq = 32 * qb + r32;
    const bf16* qrow[3];
#pragma unroll
    for (int s = 0; s < 3; ++s) qrow[s] = PROJ + (size_t)(row0 + r32) * NSA_LD + NSA_Q + (3 * g + s) * 64;
    LAS bf16x8* ql = WG ? (LAS bf16x8*)(F.lds + F.wave * 12288) + F.lane : wave_q(F); stage_q<3>(ql, qrow, F.lane);
#define NSA_GATE(s_, c_) (__builtin_amdgcn_rcpf(1.f + fast_exp2(-1.4426950408889634f * bf2f(PROJ[(size_t)(row0 + r32) * NSA_LD + NSA_GT + 9 * g + 3 * (s_) + (c_)]))))
    bf16* Y = (bf16*)(F.ws + WS_Y);
    MaskArg ma{}; ma.q0[0] = ma.q0[1] = ma.q0[2] = 32 * qb; ma.nmax = tq >= 31 ? (tq - 31) >> 4 : -1;
    const KVp kvc{(const bf16*)(F.ws + WS_KCMP) + (size_t)((b * 4 + g) * 128) * 64, 64, (const bf16*)(F.ws + WS_VCMPT) + (size_t)((b * 4 + g) * 64) * 128, 128};
    float imp[16];
#pragma unroll
    for (int r = 0; r < 16; ++r) imp[r] = 0.f;
#ifndef NSA_NO_A
    {   const int kperm = (r32 & 0x13) | ((r32 & 4) << 1) | ((r32 & 8) >> 1);
        const bf16* kp = kvc.K + (size_t)kperm * 64 + 8 * hi;
#pragma unroll 1
        for (int s = 0; s < 3; ++s) { f32x16 ia; float ls = 0.f;
#pragma unroll
            for (int r = 0; r < 16; ++r) ia[r] = 0.f;
#pragma unroll 1
            for (int kt = 0; kt < 4; ++kt) { f32x16 acc;
#pragma unroll
                for (int r = 0; r < 16; ++r) acc[r] = 0.f;
#pragma unroll
                for (int ks = 0; ks < 4; ++ks) acc = __builtin_amdgcn_mfma_f32_32x32x16_bf16(ld8(kp + (size_t)(32 * kt) * 64 + 16 * ks), ql[(s * 4 + ks) * 64], acc, 0, 0, 0);
                float p[16];
#pragma unroll
                for (int r = 0; r < 16; ++r) { const int key = 32 * kt + 8 * hi + 16 * (r >> 3) + (r & 7); p[r] = key <= ma.nmax ? fast_exp2(acc[r]) : 0.f; ls += p[r]; }
#pragma unroll
                for (int ks2 = 0; ks2 < 2; ++ks2) { v4u pw, cw; unsigned short cvv[8];
                    pw.x = pk2(p[8 * ks2], p[8 * ks2 + 1]); pw.y = pk2(p[8 * ks2 + 2], p[8 * ks2 + 3]); pw.z = pk2(p[8 * ks2 + 4], p[8 * ks2 + 5]); pw.w = pk2(p[8 * ks2 + 6], p[8 * ks2 + 7]);
#pragma unroll
                    for (int jj = 0; jj < 8; ++jj) { const int nn = 32 * kt + 16 * ks2 + 8 * hi + jj; cvv[jj] = (nn >= 4 * r32 - 1 && nn <= 4 * r32 + 3) ? 0x3f80 : 0; }
                    cw.x = cvv[0] | (cvv[1] << 16); cw.y = cvv[2] | (cvv[3] << 16); cw.z = cvv[4] | (cvv[5] << 16); cw.w = cvv[6] | (cvv[7] << 16);
                    ia = __builtin_amdgcn_mfma_f32_32x32x16_bf16(__builtin_bit_cast(bf16x8, cw), __builtin_bit_cast(bf16x8, pw), ia, 0, 0, 0); }
            }
            const float lt = ls + __shfl_xor(ls, 32); const float inv = lt > 0.f ? 1.f / lt : 0.f;
#pragma unroll
            for (int r = 0; r < 16; ++r) imp[r] += ia[r] * inv;
        }
    }
#endif
    unsigned sel;
    { const int qblk = tq >> 6;
      if (32 * qb + 31 < 1024) sel = (2u << qblk) - 1u;
      else { float val[16], oth[16];
#pragma unroll
        for (int r = 0; r < 16; ++r) { const int j = crow(r, hi); val[r] = j > qblk ? -1e30f : ((j == 0 || j == qblk || j == qblk - 1) ? 1e9f : imp[r]); oth[r] = __shfl_xor(val[r], 32); }
        unsigned mine = 0;
#pragma unroll
        for (int r = 0; r < 16; ++r) { const int j = crow(r, hi); int rank = 0;
#pragma unroll
            for (int r2 = 0; r2 < 16; ++r2) { const int j2 = crow(r2, hi), j3 = crow(r2, hi ^ 1);
                rank += (val[r2] > val[r] || (val[r2] == val[r] && j2 < j)) ? 1 : 0;
                rank += (oth[r2] > val[r] || (oth[r2] == val[r] && j3 < j)) ? 1 : 0; }
            mine |= ((rank < 16 && j <= qblk) ? 1u : 0u) << ((r & 3) + 8 * (r >> 2)); }
        mine <<= 4 * hi;
        sel = mine | __shfl_xor(mine, 32); } }
    const unsigned* mbr2[2] = {nullptr, nullptr}; const unsigned* mbr1[1] = {nullptr};
    const KVp kvs{PROJ + (size_t)(b * SEQ) * NSA_LD + NSA_KS + 64 * g, NSA_LD, (const bf16*)F.out + ((size_t)b * 256 + 64 * g) * SEQ, SEQ};
    const KVp kvw{PROJ + (size_t)(b * SEQ) * NSA_LD + NSA_KW + 64 * g, NSA_LD, (const bf16*)F.out + (size_t)NB * 256 * SEQ + ((size_t)b * 256 + 64 * g) * SEQ, SEQ};
    ma.sel = sel;
#define NSA_BRANCH(MT_, KV_, KT0_, KT1_, C_, ADD_, ZBIT_) do { \
      { f32x16 O2[2][2]; float l2[2]; zero_o<2, 2>(O2, l2); attn_core<2, 2, 0, MT_>(ql, KV_, KT0_, KT1_, 0.f, ma, mbr2, O2, l2, F.lane); VM_WAIT(); \
        _Pragma("unroll") for (int s = 0; s < 2; ++s) { const float lt = l2[s] + __shfl_xor(l2[s], 32); \
          store_o<2, ADD_>(O2[s], (lt > 0.f && !(DBG_ZERO & ZBIT_)) ? NSA_GATE(s, C_) / lt : 0.f, Y, row0, (3 * g + s) * 64, F.lane); } } \
      { f32x16 O1[1][2]; float l1[1]; zero_o<1, 2>(O1, l1); attn_core<1, 2, 0, MT_>(ql + 2 * 4 * 64, KV_, KT0_, KT1_, 0.f, ma, mbr1, O1, l1, F.lane); VM_WAIT(); \
        const float lt = l1[0] + __shfl_xor(l1[0], 32); \
        store_o<2, ADD_>(O1[0], (lt > 0.f && !(DBG_ZERO & ZBIT_)) ? NSA_GATE(2, C_) / lt : 0.f, Y, row0, (3 * g + 2) * 64, F.lane); } } while (0)
    NSA_BRANCH(MK_CMP, kvc, 0, 4, 0, false, 4);
    if (!WG) {
    NSA_BRANCH(MK_SLC, kvs, 0, qb + 1, 1, true, 16);
    NSA_BRANCH(MK_WIN, kvw, (qb > 16 ? qb - 16 : 0), qb + 1, 2, true, 32);
    } else {
        unsigned wsel = sel;
#pragma unroll
        for (int o = 1; o < 32; o <<= 1) wsel |= __shfl_xor(wsel, o);
        if (F.lane == 0) __hip_atomic_fetch_or((LAS unsigned*)(F.lds + LDS_CTRL + 64) + 17, wsel, __ATOMIC_RELAXED, __HIP_MEMORY_SCOPE_WORKGROUP);
        asm volatile("s_waitcnt vmcnt(0) lgkmcnt(0)\n\ts_barrier" ::: "memory");
        const unsigned blk = (unsigned)__builtin_amdgcn_readfirstlane((int)F.MISC[17]);
        const int kperm = (r32 & 0x13) | ((r32 & 4) << 1) | ((r32 & 8) >> 1), w = F.wave;
#define NSA_WGBRANCH(MT_, KCOL_, VTOFF_, KT0_, KT1_, MY0_, MY1_, BLK_, C_, ZBIT_) do { \
        const bf16* psrc; int pstep; \
        if (w < 4) { psrc = PROJ + (size_t)(b * SEQ + kperm) * NSA_LD + (KCOL_) + 64 * g + 16 * w + 8 * hi; pstep = 32 * NSA_LD; } \
        else { const int j_ = w - 4; psrc = (const bf16*)F.out + (VTOFF_) + ((size_t)b * 256 + 64 * g + 32 * (j_ >> 1) + r32) * SEQ + 16 * (j_ & 1) + 8 * hi; pstep = 32; } \
        f32x16 O3[3][2]; float l3[3]; zero_o<3, 2>(O3, l3); \
        wg_attn<3, MT_, 5>(F, ql, psrc, pstep, NSA_ROFF, KT0_, KT1_, BLK_, MY0_, MY1_, ma, (const LAS unsigned*)nullptr, O3, l3); \
        _Pragma("unroll") for (int s = 0; s < 3; ++s) { const float lt = l3[s] + __shfl_xor(l3[s], 32); \
          store_o<2, true>(O3[s], (lt > 0.f && !(DBG_ZERO & ZBIT_)) ? NSA_GATE(s, C_) / lt : 0.f, Y, row0, (3 * g + s) * 64, F.lane); } } while (0)
        NSA_WGBRANCH(MK_SLC, NSA_KS, (size_t)0, 0, 8 * qb8 + 8, 0, qb + 1, blk, 1, 16);
        NSA_WGBRANCH(MK_WIN, NSA_KW, (size_t)NB * 256 * SEQ, (8 * qb8 > 16 ? 8 * qb8 - 16 : 0), 8 * qb8 + 8, (qb > 16 ? qb - 16 : 0), qb + 1, 0xffffffffu, 2, 32);
#undef NSA_WGBRANCH
    }
#undef NSA_BRANCH
}
__device__ __forceinline__ void prologue_misc(Frame& F) {
    float* tab = (float*)(F.ws + WS_ROPE);
    for (int idx = blockIdx.x * (NWAVES * 64) + F.tid; idx < SEQ * 32; idx += F.G * NWAVES * 64) {
        const int t = idx >> 5, i = idx & 31;
        const float inv = exp2f(-(float)i * (13.287712379549449f / 32.0f));
        const float ang = (float)t * inv; float s, c; sincosf(ang, &s, &c);
        tab[t * 64 + i] = c; tab[t * 64 + 32 + i] = s; }
    if (blockIdx.x < 4) {
        const int kv = F.wave & 1, part = blockIdx.x * 4 + (F.wave >> 1);
        const float* pos = kv ? F.ka->in[20] : F.ka->in[19]; const float* w = kv ? F.ka->in[22] : F.ka->in[21]; float a = 0.f;
#pragma unroll 8
        for (int i = part * 128; i < part * 128 + 128; ++i) a += pos[i] * w[(size_t)i * 64 + F.lane];
        atomicAdd((float*)(F.ws + WS_CTL) + CW_CK + 64 * kv + F.lane, a);
    }
}
__device__ __forceinline__ void prologue_phase(Frame& F) {
    prologue_misc(F);
    bf16* XB = (bf16*)(F.ws + WS_XB); float* PART = (float*)(F.ws + WS_PART);
    for (int m = F.gw; m < MTOK; m += F.NGW) row_to_bf16(F, F.ka->in[0] + (size_t)m * DM, XB + (size_t)m * DM, PART + (size_t)m * 16);
    bf16* MEMB = (bf16*)(F.ws + WS_MEMB); float* PARTM = (float*)(F.ws + WS_PARTM);
    for (int m = F.gw; m < MMEM; m += F.NGW) row_to_bf16(F, F.ka->in[1] + (size_t)m * DM, MEMB + (size_t)m * DM, PARTM + (size_t)m * 16);
    int itb = 0;
#pragma unroll 1
    for (int ly = 0; ly < DEPTH; ++ly) cvt_matrix(F, itb, F.ka->in[9] + (size_t)ly * DM * 512, nullptr, 512, 512, F.ka->in[8] + (size_t)ly * DM, (bf16*)(F.ws + WS_WKV) + (size_t)ly * 512 * DM, DM, 512, 0);
    cvt_matrix(F, itb, F.ka->in[21], nullptr, 64, 64, nullptr, (bf16*)(F.ws + WS_CMPW), 2048, 64, 0);
    cvt_matrix(F, itb, F.ka->in[22], nullptr, 64, 64, nullptr, (bf16*)(F.ws + WS_CMPW) + 64 * 2048, 2048, 64, 0);
    convert_layer(F, 0);
}

template <unsigned PHASE_MASK> __global__ void __launch_bounds__(NWAVES * 64, 2) mk_fwd(Args args) {
    extern __shared__ __attribute__((aligned(16))) unsigned char lds[];
    Frame F;
    F.lds = (LAS unsigned char*)lds;
    F.MISC = (volatile LAS unsigned*)(F.lds + LDS_CTRL + 64);
    F.tid = threadIdx.x; F.lane = F.tid & 63; F.wave = __builtin_amdgcn_readfirstlane(F.tid >> 6);
    F.G = gridDim.x; F.gw = blockIdx.x * NWAVES + F.wave; F.NGW = F.G * NWAVES;
    F.ws = args.ws; F.ctl = (gu32*)(args.ws + WS_CTL); F.out = args.out;
    F.ka = (KArgs)__builtin_amdgcn_kernarg_segment_ptr();
    for (int u = F.tid; u < 1024 / 4; u += NWAVES * 64) ((LAS unsigned*)(F.lds + LDS_CTRL))[u] = 0u;
    __syncthreads();
    XcdBarrier bar = xcd_barrier_post((unsigned*)(F.ctl + CW_BAR), F.MISC + 8);
    constexpr bool ALLPH = PHASE_MASK == 0xffffffffu;
    const int lo = ALLPH ? 0 : args.ph_lo, hi = ALLPH ? 0 : args.ph_hi; int pc = 0;
    const bool dry = ALLPH ? false : (args.dry != 0);
#define PH_BEGIN(id) if (ALLPH || ((((PHASE_MASK) >> (id)) & 1u) && lo <= pc && pc < hi)) { asm volatile("" : "+s"(F.ka), "+s"(F.ws), "+s"(F.out), "+s"(F.gw), "+s"(F.NGW), "+s"(F.G), "+s"(F.wave)); asm volatile("v_mbcnt_lo_u32_b32 %0, -1, 0\n\tv_mbcnt_hi_u32_b32 %0, -1, %0" : "=v"(F.lane)); F.tid = F.wave * 64 + F.lane;
#define PH_END_(islast)   if (ALLPH ? !(islast) : (pc + 1 < hi)) { XcdBarrier b2_ = bar; asm volatile("" : "+s"(b2_.bar), "+s"(b2_.x)); xcd_barrier(b2_); } } if (!ALLPH) ++pc;
#define PH_END PH_END_(false)
#define QCTR(i) (F.ctl + CW_Q + 64 * (i))

#define XB ((bf16*)(F.ws + WS_XB))
#define VTB ((bf16*)F.out)
#define Yb ((bf16*)(F.ws + WS_Y))
#define HID ((bf16*)(F.ws + WS_HID))
#define PART ((float*)(F.ws + WS_PART))
    LAS unsigned char* ring = F.lds;

    PH_BEGIN(0) prologue_phase(F); PH_END
    PH_BEGIN(1) { pg8::Gemm g{(const bf16*)(F.ws + WS_MEMB), (const bf16*)(F.ws + WS_WKV), MMEM, 2048, DM}; pg8::StaticOrder S; S.init(MMEM, 2048, F.G, (int)blockIdx.x);
        pg8::EpiScale E{(bf16*)(F.ws + WS_MKV), 2048, (const float*)(F.ws + WS_PARTM)};
        pg8::gemm_phase<pg8::EpiScale, pg8::StaticOrder, true, true>(ring, g, S, E, F.wave); } PH_END
    PH_BEGIN(2)
#pragma unroll 1
        for (int ly = 0; ly < DEPTH; ++ly) {
            xform(F, (const bf16*)(F.ws + WS_MKV), 2048, ly * 512, 4, MMEM, NMEMT, (bf16*)(F.ws + WS_MK) + (size_t)ly * NB * 4 * NMEMT * 64, 1, 0, 0, F.ka->in[11] + ly * 64, false, 1.f, 0);
            transpose_cols(F, (const bf16*)(F.ws + WS_MKV), 2048, ly * 512 + 256, 256, NB, NMEMT, (bf16*)(F.ws + WS_MVT) + (size_t)ly * NB * 256 * NMEMT);
        }
    PH_END

#pragma unroll 1
    for (int Ly = 0; Ly < DEPTH; ++Ly) {
#define WB ((const bf16*)(F.ws + WS_WBUF0 + (size_t)(Ly & 1) * WBUF_BYTES))
        const int kind = Ly % 3;
        const int ldp = kind == 0 ? RET_LD : (kind == 1 ? DSA_LD : NSA_LD);
        PH_BEGIN(3) { pg8::Gemm g{XB, WB + WB_W1A, MTOK, 2 * FF, DM}; pg8::StaticOrder S; S.init(MTOK, 2 * FF, F.G, (int)blockIdx.x);
            pg8::EpiSwiglu E{HID, FF, PART, dry ? DRY_MODE : 0};
            pg8::gemm_phase<pg8::EpiSwiglu, pg8::StaticOrder, true, true>(ring, g, S, E, F.wave); } PH_END
        PH_BEGIN(4) { pg8::Gemm g{HID, WB + WB_W2A, MTOK, DM, FF}; pg8::StaticOrder S; S.init(MTOK, DM, F.G, (int)blockIdx.x);
            pg8::EpiResid E{XB, XB, nullptr, PART, dry ? 0.f : 0.5f};
            pg8::gemm_phase<pg8::EpiResid, pg8::StaticOrder, true, true>(ring, g, S, E, F.wave); } PH_END
        PH_BEGIN(5) { pg8::Gemm g{XB, WB + WB_WIN, MTOK, ldp, DM}; pg8::StaticOrder S; S.init(MTOK, ldp, F.G, (int)blockIdx.x);
            pg8::EpiScale E{HID, ldp, PART};
            pg8::gemm_phase<pg8::EpiScale, pg8::StaticOrder, true, true>(ring, g, S, E, F.wave); } PH_END
        PH_BEGIN(6)
            if (kind == 0) {
                xform(F, HID, ldp, RET_Q, 6, MTOK, SEQ, (dry ? Yb : HID), 0, (dry ? 1024 : ldp), (dry ? 0 : RET_Q), nullptr, true, 1.f, RET_MODE == 1 ? +1 : 0);
                xform(F, HID, ldp, RET_K, 6, MTOK, SEQ, (dry ? Yb : HID), 0, (dry ? 1024 : ldp), (dry ? 0 : RET_K), nullptr, true, 0.125f, RET_MODE == 1 ? -1 : 0);
                xform(F, HID, ldp, RET_QM, 4, MTOK, SEQ, (dry ? Yb : HID), 0, (dry ? 1024 : ldp), (dry ? 0 : RET_QM), F.ka->in[10] + Ly * 64, false, QSCALE, 0);
                transpose_cols(F, HID, ldp, RET_V, 768, NB, SEQ, VTB);
            } else if (kind == 1) {
                xform(F, HID, ldp, DSA_Q, 12, MTOK, SEQ, (dry ? Yb : HID), 0, (dry ? 1024 : ldp), (dry ? 0 : DSA_Q), F.ka->in[14], true, QSCALE, 0);
                xform(F, HID, ldp, DSA_K, 1, MTOK, SEQ, (dry ? Yb : HID), 0, (dry ? 1024 : ldp), (dry ? 0 : DSA_K), F.ka->in[15], true, 1.f, 0);
                xform(F, HID, ldp, DSA_IQ, 8, MTOK, SEQ, (dry ? Yb : HID), 0, (dry ? 1024 : ldp), (dry ? 0 : DSA_IQ), nullptr, true, 1.f, 0);
                xform(F, HID, ldp, DSA_IK, 1, MTOK, SEQ, (dry ? Yb : HID), 0, (dry ? 1024 : ldp), (dry ? 0 : DSA_IK), nullptr, true, 1.f, 0);
                xform(F, HID, ldp, DSA_QM, 4, MTOK, SEQ, (dry ? Yb : HID), 0, (dry ? 1024 : ldp), (dry ? 0 : DSA_QM), F.ka->in[10] + Ly * 64, false, QSCALE, 0);
                transpose_cols(F, HID, ldp, DSA_V, 64, NB, SEQ, VTB);
            } else {
                xform(F, HID, ldp, NSA_Q, 12, MTOK, SEQ, (dry ? Yb : HID), 0, (dry ? 1024 : ldp), (dry ? 0 : NSA_Q), F.ka->in[17], true, QSCALE, 0);
                xform(F, HID, ldp, NSA_KS, 4, MTOK, SEQ, (dry ? Yb : HID), 0, (dry ? 1024 : ldp), (dry ? 0 : NSA_KS), F.ka->in[18] + 64, true, 1.f, 0);
                xform(F, HID, ldp, NSA_KW, 4, MTOK, SEQ, (dry ? Yb : HID), 0, (dry ? 1024 : ldp), (dry ? 0 : NSA_KW), F.ka->in[18] + 128, true, 1.f, 0);
                xform(F, HID, ldp, NSA_QM, 4, MTOK, SEQ, (dry ? Yb : HID), 0, (dry ? 1024 : ldp), (dry ? 0 : NSA_QM), F.ka->in[10] + Ly * 64, false, QSCALE, 0);
                transpose_cols(F, HID, ldp, NSA_VS, 256, NB, SEQ, VTB);
                transpose_cols(F, HID, ldp, NSA_VW, 256, NB, SEQ, VTB + (size_t)NB * 256 * SEQ);
                for (int t = F.gw; t < 256; t += F.NGW) nsa_cmp_task(F, t, HID, F.ka->in[18]);
            }
            if (Ly + 1 < DEPTH) convert_layer(F, Ly + 1);
        PH_END
        if (kind == 0) {
            PH_BEGIN(7)
#if RET_WG
                for (;;) {
                    asm volatile("s_waitcnt vmcnt(0) lgkmcnt(0)\n\ts_barrier" ::: "memory");
                    if (F.tid == 0) F.MISC[16] = __hip_atomic_fetch_add(QCTR(Ly * 8 + 3), 1u, RLX_AGENT);
                    asm volatile("s_waitcnt vmcnt(0) lgkmcnt(0)\n\ts_barrier" ::: "memory");
                    const int t = __builtin_amdgcn_readfirstlane((int)F.MISC[16]);
                    if (t >= NB * 6 * 8) break;
                    asm volatile("v_mbcnt_lo_u32_b32 %0, -1, 0\n\tv_mbcnt_hi_u32_b32 %0, -1, %0" : "=v"(F.lane));
                    ret_wg_task(F, t, HID);
                }
#endif
                for (;;) { asm volatile("v_mbcnt_lo_u32_b32 %0, -1, 0\n\tv_mbcnt_hi_u32_b32 %0, -1, %0" : "=v"(F.lane)); const int t = grab(QCTR(Ly * 8 + 0), F.lane) + (RET_WG ? 3072 : 0); if (t >= 3072 + 2048) break; if (t < 3072) ret_task(F, t, HID); else mem_task(F, t - 3072, Ly, HID, ldp, RET_QM); }
            PH_END
        } else if (kind == 1) {
            PH_BEGIN(8)
                for (;;) { asm volatile("v_mbcnt_lo_u32_b32 %0, -1, 0\n\tv_mbcnt_hi_u32_b32 %0, -1, %0" : "=v"(F.lane)); const int t = grab(QCTR(Ly * 8 + 0), F.lane); if (t >= 4608 + 2048) break; if (t < 4608) dsa_d1_task(F, t, HID); else mem_task(F, t - 4608, Ly, HID, ldp, DSA_QM); }
            PH_END
            PH_BEGIN(9)
                for (;;) { asm volatile("v_mbcnt_lo_u32_b32 %0, -1, 0\n\tv_mbcnt_hi_u32_b32 %0, -1, %0" : "=v"(F.lane)); const int t = grab(QCTR(Ly * 8 + 1), F.lane); if (t >= MTOK / 8) break;
{ v4u ra[4], rb[4]; d2_load(F, MTOK - 1 - 8 * t, ra);
#pragma unroll 1
                      for (int i = 0; i < 8; i += 2) { d2_load(F, MTOK - 1 - (8 * t + i + 1), rb); dsa_d2_row(F, MTOK - 1 - (8 * t + i), ra);
                          if (i + 2 < 8) d2_load(F, MTOK - 1 - (8 * t + i + 2), ra); dsa_d2_row(F, MTOK - 1 - (8 * t + i + 1), rb); } } }
            PH_END
            PH_BEGIN(10)
                #if D3_WG
                for (;;) {
                    asm volatile("s_waitcnt vmcnt(0) lgkmcnt(0)\n\ts_barrier" ::: "memory");
                    if (F.tid == 0) F.MISC[16] = __hip_atomic_fetch_add(QCTR(Ly * 8 + 3), 1u, RLX_AGENT);
                    asm volatile("s_waitcnt vmcnt(0) lgkmcnt(0)\n\ts_barrier" ::: "memory");
                    const int t = __builtin_amdgcn_readfirstlane((int)F.MISC[16]);
                    if (t >= NB * 32) break;
                    asm volatile("v_mbcnt_lo_u32_b32 %0, -1, 0\n\tv_mbcnt_hi_u32_b32 %0, -1, %0" : "=v"(F.lane)); F.tid = F.wave * 64 + F.lane;
                    dsa_d3_wg_task(F, t, HID);
                }
#else
                for (;;) { asm volatile("v_mbcnt_lo_u32_b32 %0, -1, 0\n\tv_mbcnt_hi_u32_b32 %0, -1, %0" : "=v"(F.lane)); const int t = grab(QCTR(Ly * 8 + 2), F.lane); if (t >= 4096) break; dsa_d3_task(F, t, HID); }
#endif
            PH_END
        } else {
            PH_BEGIN(11)
#if NSA_WG
                for (;;) {
                    asm volatile("s_waitcnt vmcnt(0) lgkmcnt(0)\n\ts_barrier" ::: "memory");
                    if (F.tid == 0) { F.MISC[16] = __hip_atomic_fetch_add(QCTR(Ly * 8 + 3), 1u, RLX_AGENT); F.MISC[17] = 0u; }
                    asm volatile("s_waitcnt vmcnt(0) lgkmcnt(0)\n\ts_barrier" ::: "memory");
                    const int t = __builtin_amdgcn_readfirstlane((int)F.MISC[16]);
                    if (t >= NB * 4 * 8) break;
                    nsa_task<true>(F.ws, F.out, F.lds, F.wave, t, HID);
                }
#endif
                for (;;) { asm volatile("v_mbcnt_lo_u32_b32 %0, -1, 0\n\tv_mbcnt_hi_u32_b32 %0, -1, %0" : "=v"(F.lane)); const int t = grab(QCTR(Ly * 8 + 0), F.lane) + (NSA_WG ? 4096 : 0); if (t >= 4096 + 2048) break; if (t < 4096) nsa_task<false>(F.ws, F.out, F.lds, F.wave, t, HID); else mem_task(F, t - 4096, Ly, HID, ldp, NSA_QM); }
            PH_END
        }
        PH_BEGIN(12) { pg8::Gemm g{Yb, WB + WB_WO, MTOK, DM, DM}; pg8::StaticOrder S; S.init(MTOK, DM, F.G, (int)blockIdx.x);
            pg8::EpiResid E{XB, XB, nullptr, PART, dry ? 0.f : 1.0f};
            pg8::gemm_phase<pg8::EpiResid, pg8::StaticOrder, true, true>(ring, g, S, E, F.wave); } PH_END
        PH_BEGIN(13) { pg8::Gemm g{XB, WB + WB_W1B, MTOK, 2 * FF, DM}; pg8::StaticOrder S; S.init(MTOK, 2 * FF, F.G, (int)blockIdx.x);
            pg8::EpiSwiglu E{HID, FF, PART, dry ? DRY_MODE : 0};
            pg8::gemm_phase<pg8::EpiSwiglu, pg8::StaticOrder, true, true>(ring, g, S, E, F.wave); } PH_END
        PH_BEGIN(14) { pg8::Gemm g{HID, WB + WB_W2B, MTOK, DM, FF}; pg8::StaticOrder S; S.init(MTOK, DM, F.G, (int)blockIdx.x);
            pg8::EpiResid E{XB, XB, Ly == DEPTH - 1 ? F.out : nullptr, PART, dry ? 0.f : 0.5f};
            pg8::gemm_phase<pg8::EpiResid, pg8::StaticOrder, true, true>(ring, g, S, E, F.wave); } PH_END_(Ly == DEPTH - 1)
    }
#undef XB
#undef VTB
#undef Yb
#undef HID
#undef PART
#undef WB
#undef PH_BEGIN
#undef PH_END
#undef PH_END_
}

constexpr int LDS_BYTES = 147456;
#ifndef MK_PER_PHASE
#define MK_PER_PHASE 0
#endif
typedef void (*kern_t)(Args);
template <unsigned M> static kern_t kern_of() { return mk_fwd<M>; }
#if MK_PER_PHASE
static kern_t phase_kernel(int id) {
    switch (id) {
        case 0: return kern_of<1u << 0>(); case 1: return kern_of<1u << 1>(); case 2: return kern_of<1u << 2>(); case 3: return kern_of<1u << 3>(); case 4: return kern_of<1u << 4>();
        case 5: return kern_of<1u << 5>(); case 6: return kern_of<1u << 6>(); case 7: return kern_of<1u << 7>(); case 8: return kern_of<1u << 8>(); case 9: return kern_of<1u << 9>();
        case 10: return kern_of<1u << 10>(); case 11: return kern_of<1u << 11>(); case 12: return kern_of<1u << 12>(); case 13: return kern_of<1u << 13>(); default: return kern_of<1u << 14>();
    }
}
#endif
extern "C" void kernel_launch(void* const* d_in, const int* in_sizes, int n_in, void* d_out, int out_size, void* d_ws, size_t ws_size, hipStream_t stream) {
    static int grid = 0;
    if (grid == 0) {
        if (n_in != 23 || out_size != MTOK * DM || ws_size < WS_END) { fprintf(stderr, "kernel_launch: unexpected shapes (n_in %d, out %d, ws %zu)\n", n_in, out_size, ws_size); grid = -1; return; }
        int dev = 0, cus = 0;
        if (hipGetDevice(&dev) != hipSuccess || hipDeviceGetAttribute(&cus, hipDeviceAttributeMultiprocessorCount, dev) != hipSuccess) { grid = -1; return; }
#if MK_PER_PHASE
        for (int id = 0; id < 15; ++id) if (hipFuncSetAttribute((const void*)phase_kernel(id), hipFuncAttributeMaxDynamicSharedMemorySize, LDS_BYTES) != hipSuccess) { fprintf(stderr, "kernel_launch: hipFuncSetAttribute failed\n"); grid = -1; return; }
#else
        if (hipFuncSetAttribute((const void*)kern_of<0xffffffffu>(), hipFuncAttributeMaxDynamicSharedMemorySize, LDS_BYTES) != hipSuccess) { fprintf(stderr, "kernel_launch: hipFuncSetAttribute failed\n"); grid = -1; return; }
#endif
        (void)hipGetLastError();
        grid = cus;
    }
    if (grid < 0) return;
    if (hipMemsetAsync((char*)d_ws + WS_CTL, 0, CTL_ZERO_BYTES, stream) != hipSuccess) return;
    Args a{};
    for (int i = 0; i < 23; ++i) a.in[i] = (const float*)d_in[i];
    a.out = (float*)d_out; a.ws = (unsigned char*)d_ws;
    constexpr int NPH = 3 + 8 * DEPTH + 2;
#if MK_PER_PHASE
    int ids[NPH]; int n = 0; ids[n++] = 0; ids[n++] = 1; ids[n++] = 2;
    for (int ly = 0; ly < DEPTH; ++ly) { ids[n++] = 3; ids[n++] = 4; ids[n++] = 5; ids[n++] = 6;
        if (ly % 3 == 0) ids[n++] = 7; else if (ly % 3 == 1) { ids[n++] = 8; ids[n++] = 9; ids[n++] = 10; } else ids[n++] = 11;
        ids[n++] = 12; ids[n++] = 13; ids[n++] = 14; }
    for (int p = 0; p < NPH; ++p) { a.ph_lo = p; a.ph_hi = p + 1;
#if PROBE_DUP
        if ((PROBE_DUP >> ids[p]) & 1) {
            a.dry = 1; hipLaunchKernelGGL(phase_kernel(ids[p]), dim3(grid), dim3(NWAVES * 64), LDS_BYTES, stream, a); a.dry = 0;
            hipMemsetAsync((char*)d_ws + WS_CTL + CW_Q * 4, 0, 64 * 4 * 64, stream); }
#endif
        hipLaunchKernelGGL(phase_kernel(ids[p]), dim3(grid), dim3(NWAVES * 64), LDS_BYTES, stream, a);
    }
#else
    a.ph_lo = 0; a.ph_hi = NPH; hipLaunchKernelGGL(kern_of<0xffffffffu>(), dim3(grid), dim3(NWAVES * 64), LDS_BYTES, stream, a);
#endif
}
```

```cpp
#include <hip/hip_runtime.h>
#include <cstdio>
#include <cstdint>
namespace pg8 {
#define PG8_LAS __attribute__((address_space(3)))
typedef unsigned short bf16_t;
typedef short bf16x8 __attribute__((ext_vector_type(8)));
typedef float f32x4 __attribute__((ext_vector_type(4)));
typedef unsigned u32x4 __attribute__((ext_vector_type(4)));
constexpr int BM = 256, BK = 64, HALF = 128, HTB = HALF * BK * 2  , STAGE_BYTES = 8 * HTB, NXCD = 8, WGM = 8;

__host__ __device__ __forceinline__ int lds_byte(int r, int c) { const int st = (r >> 4) * 2 + (c >> 5), rr = r & 15, cc = c & 31, ob = rr * 64 + cc * 2; return st * 1024 + (ob ^ (((ob >> 9) & 1) << 5)); }
__host__ __device__ __forceinline__ void stage_rc(int b, int& R, int& C) { const int st = b / 1024, sb = b % 1024, swz = sb ^ (((sb >> 9) & 1) << 5); R = (st >> 1) * 16 + swz / 64; C = (st & 1) * 32 + (swz % 64) / 2; }
__host__ __device__ __forceinline__ int perm32(int rho) { const int n = rho >> 4, i = rho & 15; return 8 * (i >> 2) + 4 * n + (i & 3); }

struct Unit { int pm, pn; };
struct Gemm { const bf16_t* A; const bf16_t* Bt; int M, N, K; };

struct StaticOrder {
    int nM, nN, nwg, G, c;
    __host__ __device__ void init(int M, int N, int G_, int c_) { nM = M / BM; nN = N / BM; nwg = nM * nN; G = G_; c = c_; }
    __host__ __device__ bool next(int i, Unit& u) const {
        const long L = (long)i * G + c; if (L >= nwg) return false;
        int wgid = (int)L; { const int q = nwg / NXCD, r = nwg % NXCD, xcd = wgid % NXCD, off = wgid / NXCD; wgid = (xcd < r ? xcd * (q + 1) : r * (q + 1) + (xcd - r) * q) + off; }
        const int nig = WGM * nN, gid = wgid / nig, fm = gid * WGM, gsz = (nM - fm) < WGM ? (nM - fm) : WGM;
        u.pm = fm + ((wgid % nig) % gsz); u.pn = (wgid % nig) / gsz; return true;
    }
    __device__ __forceinline__ void a_ready(const Unit&) const {}
    __device__ __forceinline__ void done(const Unit&) const {}
};

__device__ __forceinline__ int lane_now() { int l; asm volatile("v_mbcnt_lo_u32_b32 %0, -1, 0\n\tv_mbcnt_hi_u32_b32 %0, -1, %0" : "=v"(l)); return l; }
__device__ __forceinline__ float shfl_idx_(float v, int src) { return __builtin_bit_cast(float, __builtin_amdgcn_ds_bpermute(src << 2, __builtin_bit_cast(int, v))); }
__device__ __forceinline__ int shfl_idx_(int v, int src) { return __builtin_amdgcn_ds_bpermute(src << 2, v); }
__device__ __forceinline__ unsigned shfl_idx_(unsigned v, int src) { return (unsigned)__builtin_amdgcn_ds_bpermute(src << 2, (int)v); }
#define __shfl_xor(v, o) pg8::shfl_idx_((v), pg8::lane_now() ^ (o))
#define __shfl(v, src) pg8::shfl_idx_((v), (src))
#define __shfl_down(v, o) pg8::shfl_idx_((v), pg8::lane_now() + (o))
#define __shfl_up(v, o) pg8::shfl_idx_((v), pg8::lane_now() - (o))
typedef float f32x2_cv __attribute__((ext_vector_type(2))); typedef __bf16 bf16x2_cv __attribute__((ext_vector_type(2)));
__device__ __forceinline__ unsigned cvt_pk_bf16(float lo, float hi) { f32x2_cv v = {lo, hi}; bf16x2_cv b = __builtin_convertvector(v, bf16x2_cv); return __builtin_bit_cast(unsigned, b); }
constexpr float RMS_EPS = 1e-6f;
__device__ __forceinline__ void rows_rs(const float* part, int row0, int fq, float (&rs)[2][4]) {
    f32x4 pr[2][4];
#pragma unroll
    for (int ai = 0; ai < 2; ++ai)
#pragma unroll
        for (int m = 0; m < 4; ++m) pr[ai][m] = *(const f32x4*)(part + (size_t)(row0 + ai * HALF + m * 16) * 16 + 4 * fq);
#pragma unroll
    for (int ai = 0; ai < 2; ++ai)
#pragma unroll
        for (int m = 0; m < 4; ++m) { float s = (pr[ai][m][0] + pr[ai][m][1]) + (pr[ai][m][2] + pr[ai][m][3]); s += __shfl_xor(s, 16); s += __shfl_xor(s, 32);
            rs[ai][m] = __builtin_amdgcn_rsqf(s * (1.0f / 1024.0f) + RMS_EPS); }
}
__device__ __forceinline__ float silu_mul(float g, float u) { return g * u * __builtin_amdgcn_rcpf(1.0f + __builtin_amdgcn_exp2f(-1.4426950408889634f * g)); }
struct EpiSwiglu {
    static constexpr bool PERM = true, AFTER_DRAIN = false;
    bf16_t* H; int ldh; const float* part; int dmode;
    __device__ __forceinline__ void operator()(const f32x4 (&acc)[2][2][4][2], const Unit& u, int wr, int wc, int fr_, int fq_) const {
        int le_; asm volatile("v_mbcnt_lo_u32_b32 %0, -1, 0\n\tv_mbcnt_hi_u32_b32 %0, -1, %0" : "=v"(le_)); const int fr = le_ & 15, fq = le_ >> 4;
        const int row0 = u.pm * BM + wr * 64 + fr, col0 = u.pn * HALF + wc * 32 + 8 * fq;
        if (dmode == 2) return;
        float rsv[2][4]; rows_rs(part, row0, fq, rsv);
#pragma unroll
        for (int ai = 0; ai < 2; ++ai)
#pragma unroll
            for (int m = 0; m < 4; ++m) { const int row = row0 + ai * HALF + m * 16; const float rs = rsv[ai][m];
                const f32x4 g0 = acc[ai][0][m][0] * rs, g1 = acc[ai][0][m][1] * rs, u0 = acc[ai][1][m][0] * rs, u1 = acc[ai][1][m][1] * rs;
                u32x4 w; w.x = cvt_pk_bf16(silu_mul(g0[0], u0[0]), silu_mul(g0[1], u0[1])); w.y = cvt_pk_bf16(silu_mul(g0[2], u0[2]), silu_mul(g0[3], u0[3]));
                w.z = cvt_pk_bf16(silu_mul(g1[0], u1[0]), silu_mul(g1[1], u1[1])); w.w = cvt_pk_bf16(silu_mul(g1[2], u1[2]), silu_mul(g1[3], u1[3]));
                if (dmode == 0 || w.x == 0x12345678u) *(u32x4*)(H + (size_t)row * ldh + col0) = w; }
    }
};
struct EpiScale {
    static constexpr bool PERM = true, AFTER_DRAIN = false;
    bf16_t* O; int ldc; const float* part;
    __device__ __forceinline__ void operator()(const f32x4 (&acc)[2][2][4][2], const Unit& u, int wr, int wc, int fr_, int fq_) const {
        int le_; asm volatile("v_mbcnt_lo_u32_b32 %0, -1, 0\n\tv_mbcnt_hi_u32_b32 %0, -1, %0" : "=v"(le_)); const int fr = le_ & 15, fq = le_ >> 4;
        const int row0 = u.pm * BM + wr * 64 + fr, col0 = u.pn * BM + wc * 32 + 8 * fq;
        float rsv[2][4]; rows_rs(part, row0, fq, rsv);
#pragma unroll
        for (int ai = 0; ai < 2; ++ai)
#pragma unroll
            for (int m = 0; m < 4; ++m) { const int row = row0 + ai * HALF + m * 16; const float rs = rsv[ai][m]; bf16_t* rowp = O + (size_t)row * ldc + col0;
#pragma unroll
                for (int bj = 0; bj < 2; ++bj) { const f32x4 v0 = acc[ai][bj][m][0] * rs, v1 = acc[ai][bj][m][1] * rs;
                    u32x4 w; w.x = cvt_pk_bf16(v0[0], v0[1]); w.y = cvt_pk_bf16(v0[2], v0[3]); w.z = cvt_pk_bf16(v1[0], v1[1]); w.w = cvt_pk_bf16(v1[2], v1[3]);
                    *(u32x4*)(rowp + bj * HALF) = w; } }
    }
};
struct EpiResid {
    static constexpr bool PERM = true, AFTER_DRAIN = false;
    const bf16_t* base; bf16_t* xb; float* out; float* part_out; float coef;
    __device__ __forceinline__ void operator()(const f32x4 (&acc)[2][2][4][2], const Unit& u, int wr, int wc, int fr_, int fq_) const {
        int le_; asm volatile("v_mbcnt_lo_u32_b32 %0, -1, 0\n\tv_mbcnt_hi_u32_b32 %0, -1, %0" : "=v"(le_)); const int fr = le_ & 15, fq = le_ >> 4;
        const int row0 = u.pm * BM + wr * 64 + fr, col0 = u.pn * BM + wc * 32 + 8 * fq;
        u32x4 bs[2][4][2];
#pragma unroll
        for (int ai = 0; ai < 2; ++ai)
#pragma unroll
            for (int m = 0; m < 4; ++m)
#pragma unroll
                for (int bj = 0; bj < 2; ++bj) bs[ai][m][bj] = *(const u32x4*)(base + (size_t)(row0 + ai * HALF + m * 16) * 1024 + col0 + bj * HALF);
#pragma unroll
        for (int ai = 0; ai < 2; ++ai)
#pragma unroll
            for (int m = 0; m < 4; ++m) { const int row = row0 + ai * HALF + m * 16; const size_t off = (size_t)row * 1024 + col0; float ss = 0.f;
#pragma unroll
                for (int bj = 0; bj < 2; ++bj) { const u32x4 b = bs[ai][m][bj];
                    const f32x4 b0 = {__builtin_bit_cast(float, b.x << 16), __builtin_bit_cast(float, b.x & 0xffff0000u), __builtin_bit_cast(float, b.y << 16), __builtin_bit_cast(float, b.y & 0xffff0000u)};
                    const f32x4 b1 = {__builtin_bit_cast(float, b.z << 16), __builtin_bit_cast(float, b.z & 0xffff0000u), __builtin_bit_cast(float, b.w << 16), __builtin_bit_cast(float, b.w & 0xffff0000u)};
                    const f32x4 v0 = b0 + acc[ai][bj][m][0] * coef, v1 = b1 + acc[ai][bj][m][1] * coef;
                    if (out) { *(f32x4*)(out + off + bj * HALF) = v0; *(f32x4*)(out + off + bj * HALF + 4) = v1; }
                    u32x4 w; w.x = cvt_pk_bf16(v0[0], v0[1]); w.y = cvt_pk_bf16(v0[2], v0[3]); w.z = cvt_pk_bf16(v1[0], v1[1]); w.w = cvt_pk_bf16(v1[2], v1[3]);
                    *(u32x4*)(xb + off + bj * HALF) = w;
                    ss += (v0[0] * v0[0] + v0[1] * v0[1]) + (v0[2] * v0[2] + v0[3] * v0[3]) + (v1[0] * v1[0] + v1[1] * v1[1]) + (v1[2] * v1[2] + v1[3] * v1[3]); }
                ss += __shfl_xor(ss, 16); ss += __shfl_xor(ss, 32);
                if (fq == 0) part_out[(size_t)row * 16 + u.pn * 4 + wc] = ss; }
    }
};
template <class Epi, class Sched, bool ALIGN_EPI = false, bool SP2 = false>
__device__ __forceinline__ void gemm_phase(PG8_LAS unsigned char* lds, const Gemm g, const Sched& S, const Epi& E, int wave_id) {
    int lane_; asm volatile("v_mbcnt_lo_u32_b32 %0, -1, 0\n\tv_mbcnt_hi_u32_b32 %0, -1, %0" : "=v"(lane_));
    const int wid = wave_id, lane = lane_, tid = wid * 64 + lane, wr = wid >> 2, wc = wid & 3, fr = lane & 15, fq = lane >> 4;
    const int K = g.K, nt = K / BK;
    unsigned voffA[2], voffB[2];
#pragma unroll
    for (int i = 0; i < 2; ++i) { int R, C; stage_rc(tid * 16 + i * 8192, R, C); const int Rb = Epi::PERM ? ((R & ~31) + perm32(R & 31)) : R;
        voffA[i] = (unsigned)(R * K + C) * 2u; voffB[i] = (unsigned)(Rb * K + C) * 2u; }
    const size_t kstep = (size_t)(BK * 2);
    const size_t hstep = (size_t)HALF * K * 2;
    const size_t tstep = 2 * hstep;
    const unsigned ldsw = (unsigned)wid * 1024u;
    const int aoff = lds_byte(wr * 64 + fr, fq * 8), boff = lds_byte(wc * 32 + fr, fq * 8);
#define PG8_SA(b, h) (((b) * 2 + (h)) * HTB)
#define PG8_SB(b, h) ((4 + (b) * 2 + (h)) * HTB)
#define PG8_STAGE(bufoff, gbase, voff) do { _Pragma("unroll") for (int _i = 0; _i < 2; ++_i) \
        __builtin_amdgcn_global_load_lds((const unsigned*)((const char*)(gbase) + (voff)[_i]), (PG8_LAS unsigned*)(lds + (bufoff) + ldsw + _i * 8192), 16, 0, 0); } while (0)
#define PG8_LDA(dst, b, h) do { _Pragma("unroll") for (int m = 0; m < 4; ++m) _Pragma("unroll") for (int k = 0; k < 2; ++k) dst[m][k] = *(const PG8_LAS bf16x8*)(lds + PG8_SA(b, h) + aoff + m * 2048 + k * 1024); } while (0)
#define PG8_LDB(dst, b, h) do { _Pragma("unroll") for (int n = 0; n < 2; ++n) _Pragma("unroll") for (int k = 0; k < 2; ++k) dst[n][k] = *(const PG8_LAS bf16x8*)(lds + PG8_SB(b, h) + boff + n * 2048 + k * 1024); } while (0)
#define PG8_MMA(ai, bj, At, Bt) do { __builtin_amdgcn_s_setprio(1); _Pragma("unroll") for (int m = 0; m < 4; ++m) _Pragma("unroll") for (int n = 0; n < 2; ++n) _Pragma("unroll") for (int k = 0; k < 2; ++k) \
        acc[ai][bj][m][n] = __builtin_amdgcn_mfma_f32_16x16x32_bf16(Bt[n][k], At[m][k], acc[ai][bj][m][n], 0, 0, 0); __builtin_amdgcn_s_setprio(0); } while (0)
#define PG8_WAIT_V(n) asm volatile("s_waitcnt vmcnt(" #n ")" ::: "memory")
#define PG8_WAIT_L(n) asm volatile("s_waitcnt lgkmcnt(" #n ")" ::: "memory")
#define PG8_BAR __builtin_amdgcn_s_barrier()
#define PG8_SCHED __builtin_amdgcn_sched_barrier(0)
    Unit cur, nxt; int ui = 0;
    if (!S.next(0, cur)) return;
    f32x4 acc[2][2][4][2];
#pragma unroll
    for (int a = 0; a < 2; ++a)
#pragma unroll
        for (int b = 0; b < 2; ++b)
#pragma unroll
            for (int m = 0; m < 4; ++m)
#pragma unroll
                for (int n = 0; n < 2; ++n) acc[a][b][m][n] = (f32x4){0.f, 0.f, 0.f, 0.f};
    bf16x8 At[4][2], B0[2][2], B1[2][2];
    const char* cA = (const char*)g.A + (size_t)cur.pm * tstep; const char* cB = (const char*)g.Bt + (size_t)cur.pn * tstep;
    S.a_ready(cur);
    if constexpr (SP2) {
        PG8_STAGE(PG8_SB(0, 0), cB, voffB); PG8_STAGE(PG8_SB(0, 1), cB + hstep, voffB); PG8_STAGE(PG8_SA(0, 0), cA, voffA); PG8_STAGE(PG8_SA(0, 1), cA + hstep, voffA);
        if (wr == 1) PG8_BAR;
        PG8_WAIT_V(2); PG8_BAR;
        PG8_STAGE(PG8_SB(1, 0), cB + kstep, voffB); PG8_STAGE(PG8_SA(1, 0), cA + kstep, voffA); PG8_STAGE(PG8_SB(1, 1), cB + hstep + kstep, voffB);
        PG8_WAIT_V(6); PG8_BAR;
    } else {
        PG8_STAGE(PG8_SB(0, 0), cB, voffB); PG8_STAGE(PG8_SA(0, 0), cA, voffA); PG8_STAGE(PG8_SB(0, 1), cB + hstep, voffB); PG8_STAGE(PG8_SA(0, 1), cA + hstep, voffA);
        if (wr == 1) PG8_BAR;
        PG8_WAIT_V(4); PG8_BAR;
        PG8_STAGE(PG8_SB(1, 0), cB + kstep, voffB); PG8_STAGE(PG8_SA(1, 0), cA + kstep, voffA); PG8_STAGE(PG8_SB(1, 1), cB + hstep + kstep, voffB);
        PG8_WAIT_V(6); PG8_BAR;
    }
    for (;;) {
        const bool has_next = S.next(ui + 1, nxt);
        const char* nA = has_next ? (const char*)g.A + (size_t)nxt.pm * tstep : cA; const char* nB = has_next ? (const char*)g.Bt + (size_t)nxt.pn * tstep : cB;
        for (int t = 0; t < nt; t += 2) {
            const bool last = (t == nt - 2);
            const char* a1 = cA + (size_t)(t + 1) * kstep;
            const char* a2 = last ? nA : cA + (size_t)(t + 2) * kstep; const char* b2 = last ? nB : cB + (size_t)(t + 2) * kstep;
            const char* a3 = a2 + kstep; const char* b3 = b2 + kstep;
            if (last && has_next) S.a_ready(nxt);
            if constexpr (SP2) {
            PG8_LDB(B0, 0, 0); PG8_LDB(B1, 0, 1); PG8_SCHED; PG8_LDA(At, 0, 0); PG8_STAGE(PG8_SA(1, 1), a1 + hstep, voffA);
            PG8_WAIT_V(8); PG8_WAIT_L(0); PG8_BAR; PG8_MMA(0, 0, At, B0); PG8_MMA(0, 1, At, B1); PG8_BAR; PG8_SCHED;
            PG8_LDA(At, 0, 1); PG8_STAGE(PG8_SB(0, 0), b2, voffB); PG8_STAGE(PG8_SB(0, 1), b2 + hstep, voffB); PG8_STAGE(PG8_SA(0, 0), a2, voffA);
            PG8_WAIT_V(8); PG8_WAIT_L(0); PG8_BAR; PG8_MMA(1, 0, At, B0); PG8_MMA(1, 1, At, B1); PG8_BAR; PG8_SCHED;
            PG8_LDB(B0, 1, 0); PG8_LDB(B1, 1, 1); PG8_SCHED; PG8_LDA(At, 1, 0); PG8_STAGE(PG8_SA(0, 1), a2 + hstep, voffA);
            PG8_WAIT_V(8); PG8_WAIT_L(0); PG8_BAR; PG8_MMA(0, 0, At, B0); PG8_MMA(0, 1, At, B1); PG8_BAR; PG8_SCHED;
            PG8_LDA(At, 1, 1); PG8_STAGE(PG8_SB(1, 0), b3, voffB); PG8_STAGE(PG8_SB(1, 1), b3 + hstep, voffB); PG8_STAGE(PG8_SA(1, 0), a3, voffA);
            PG8_WAIT_V(8); PG8_WAIT_L(0); PG8_BAR; PG8_MMA(1, 0, At, B0); PG8_MMA(1, 1, At, B1); PG8_BAR; PG8_SCHED;
            } else {
            PG8_LDB(B0, 0, 0); PG8_SCHED; PG8_LDA(At, 0, 0); PG8_STAGE(PG8_SA(1, 1), a1 + hstep, voffA);
            PG8_WAIT_L(8); PG8_BAR; PG8_WAIT_L(0); PG8_MMA(0, 0, At, B0); PG8_BAR; PG8_SCHED;
            PG8_LDB(B1, 0, 1); PG8_STAGE(PG8_SB(0, 0), b2, voffB);
            PG8_BAR; PG8_WAIT_L(0); PG8_MMA(0, 1, At, B1); PG8_BAR;
            PG8_LDA(At, 0, 1); PG8_STAGE(PG8_SA(0, 0), a2, voffA);
            PG8_BAR; PG8_WAIT_L(0); PG8_MMA(1, 0, At, B0); PG8_BAR; PG8_SCHED;
            PG8_STAGE(PG8_SB(0, 1), b2 + hstep, voffB);
            PG8_WAIT_V(6); PG8_BAR; PG8_MMA(1, 1, At, B1); PG8_BAR;
            PG8_LDB(B0, 1, 0); PG8_SCHED; PG8_LDA(At, 1, 0); PG8_STAGE(PG8_SA(0, 1), a2 + hstep, voffA);
            PG8_WAIT_L(8); PG8_BAR; PG8_WAIT_L(0); PG8_MMA(0, 0, At, B0); PG8_BAR; PG8_SCHED;
            PG8_LDB(B1, 1, 1); PG8_STAGE(PG8_SB(1, 0), b3, voffB);
            PG8_BAR; PG8_WAIT_L(0); PG8_MMA(0, 1, At, B1); PG8_BAR;
            PG8_LDA(At, 1, 1); PG8_STAGE(PG8_SA(1, 0), a3, voffA);
            PG8_BAR; PG8_WAIT_L(0); PG8_MMA(1, 0, At, B0); PG8_BAR; PG8_SCHED;
            PG8_STAGE(PG8_SB(1, 1), b3 + hstep, voffB);
            PG8_WAIT_V(6); PG8_BAR; PG8_MMA(1, 1, At, B1); PG8_BAR;
            }
        }
        if constexpr (ALIGN_EPI) { if (wr == 0) PG8_BAR; }
        if constexpr (!Epi::AFTER_DRAIN) { E(acc, cur, wr, wc, fr, fq); S.done(cur); }
        if (!has_next) break;
#pragma unroll
        for (int a = 0; a < 2; ++a)
#pragma unroll
            for (int b = 0; b < 2; ++b)
#pragma unroll
                for (int m = 0; m < 4; ++m)
#pragma unroll
                    for (int n = 0; n < 2; ++n) acc[a][b][m][n] = (f32x4){0.f, 0.f, 0.f, 0.f};
        cur = nxt; cA = nA; cB = nB; ++ui;
        if constexpr (ALIGN_EPI) { if (wr == 1) PG8_BAR; }
    }
    PG8_WAIT_V(0);
    if constexpr (!ALIGN_EPI) { if (wr == 0) PG8_BAR; }
    PG8_BAR;
    if constexpr (Epi::AFTER_DRAIN) { E.fused(acc, cur, wr, wc, fr, fq, lds, wid, lane); S.done(cur); }
#undef PG8_SA
#undef PG8_SB
#undef PG8_STAGE
#undef PG8_LDA
#undef PG8_LDB
#undef PG8_MMA
#undef PG8_WAIT_V
#undef PG8_WAIT_L
#undef PG8_BAR
#undef PG8_SCHED
}
}
#define LAS __attribute__((address_space(3)))
#define XB_TMO      128
#define XB_XCNT(j)  (256  + 64 * (j))
#define XB_XSUB(j)  (1280 + 64 * (j))
#define XB_XGEN(j)  (2304 + 64 * (j))
#define XB_TOP      3328
#define XB_TOPGEN   3392
#define XCD_BAR_WORDS 3456
#define XB_SPIN_CAP (1u << 18)

__device__ __forceinline__ unsigned xb_ld(unsigned* p)              { return __hip_atomic_load(p, __ATOMIC_RELAXED, __HIP_MEMORY_SCOPE_AGENT); }
__device__ __forceinline__ unsigned xb_add(unsigned* p, unsigned v) { return __hip_atomic_fetch_add(p, v, __ATOMIC_RELAXED, __HIP_MEMORY_SCOPE_AGENT); }
__device__ __forceinline__ unsigned xb_xcc_id() { return (unsigned)__builtin_amdgcn_s_getreg((3 << 11) | 20) & 0xFu; }
#define XB_SPIN(cond, bar) do { unsigned _sp = 0; while (cond) { __builtin_amdgcn_s_sleep(1); \
    if ((++_sp & 255u) == 0u) { if (xb_ld(&(bar)[XB_TMO])) break; if (_sp > XB_SPIN_CAP) { atomicAdd(&(bar)[XB_TMO], 1u); break; } } } } while (0)

struct XcdBarrier {
    unsigned* bar; unsigned x;
    volatile LAS unsigned* st;
};

__device__ __forceinline__ XcdBarrier xcd_barrier_post(unsigned* bar, volatile LAS unsigned* st) {
    XcdBarrier b; b.bar = bar; b.x = xb_xcc_id(); b.st = st;
    if (threadIdx.x == 0) (void)xb_add(&bar[XB_XCNT(b.x)], 1u);
    return b;
}
__device__ __forceinline__ void xcd_barrier_complete(unsigned* bar, unsigned x, unsigned& nloc, unsigned& nx) {
    const unsigned G = gridDim.x * gridDim.y * gridDim.z;
    unsigned sum, cnt, mine, sp = 0u;
    for (;;) {
        sum = 0u; cnt = 0u; mine = 0u;
#pragma unroll
        for (unsigned j = 0; j < 16; ++j) { const unsigned c = xb_ld(&bar[XB_XCNT(j)]); sum += c; cnt += (c > 0u) ? 1u : 0u; mine = (j == x) ? c : mine; }
        if (sum == G) break;
        __builtin_amdgcn_s_sleep(1);
        if ((++sp & 255u) == 0u) { if (xb_ld(&bar[XB_TMO])) break; if (sp > XB_SPIN_CAP) { atomicAdd(&bar[XB_TMO], 1u); break; } }
    }
    nloc = mine > 0u ? mine : 1u; nx = cnt > 0u ? cnt : 1u;
}

__device__ __forceinline__ void xcd_barrier(const XcdBarrier& b) {
    asm volatile("s_waitcnt vmcnt(0)" ::: "memory");
    __syncthreads();
    if (threadIdx.x == 0) {
        unsigned* bar = b.bar;
        __builtin_amdgcn_s_waitcnt(0);
        unsigned nloc = b.st[0], nx = b.st[1];
        if (nloc == 0u) { xcd_barrier_complete(bar, b.x, nloc, nx); b.st[0] = nloc; b.st[1] = nx; }
        const unsigned old = xb_add(&bar[XB_XSUB(b.x)], 1u);
        const unsigned gen = old / nloc;
        if (old + 1u == (gen + 1u) * nloc) {
            __builtin_amdgcn_fence(__ATOMIC_RELEASE, "agent");
            asm volatile("s_waitcnt vmcnt(0)" ::: "memory");
            const unsigned og = xb_add(&bar[XB_TOP], 1u);
            const unsigned tg = og / nx;
            if (og + 1u == (tg + 1u) * nx) xb_add(&bar[XB_TOPGEN], 1u);
            else XB_SPIN(xb_ld(&bar[XB_TOPGEN]) == tg, bar);
            __builtin_amdgcn_fence(__ATOMIC_ACQUIRE, "agent");
            xb_add(&bar[XB_XGEN(b.x)], 1u);
            asm volatile("s_waitcnt vmcnt(0)" ::: "memory");
        } else {
            XB_SPIN(xb_ld(&bar[XB_XGEN(b.x)]) == gen, bar);
            __builtin_amdgcn_fence(__ATOMIC_ACQUIRE, "agent");
            asm volatile("s_waitcnt vmcnt(0)" ::: "memory");
        }
    }
    __syncthreads();
}
#undef LAS
#ifndef RET_MODE
#define RET_MODE 1
#endif
#ifndef NSA_INLINE
#define NSA_INLINE __forceinline__
#endif
#ifndef DRY_MODE
#define DRY_MODE 0
#endif
#ifndef NSA_WG
#define NSA_WG 1
#endif
#ifndef D3_WG
#define D3_WG 1
#endif
#ifndef RET_WG
#define RET_WG 1
#endif
#ifndef PROBE_DUP
#define PROBE_DUP 0
#endif
#ifndef DBG_BRUTE
#define DBG_BRUTE 0
#endif
#ifndef DBG_ZERO
#define DBG_ZERO 0
#endif
constexpr int NWAVES = 8;
constexpr int NB = 16, SEQ = 2048, DM = 1024, MTOK = NB * SEQ, FF = 2816, NMEMT = 256, MMEM = NB * NMEMT, DEPTH = 4;
constexpr float EPS = 1e-6f;
constexpr float QSCALE = 0.125f * 1.4426950408889634f;
constexpr int RET_LD = 2560, RET_Q = 0, RET_K = 384, RET_V = 768, RET_G = 1536, RET_QM = 2304;
constexpr int DSA_LD = 1792, DSA_Q = 0, DSA_K = 768, DSA_V = 832, DSA_IQ = 896, DSA_IK = 1408, DSA_IW = 1472, DSA_QM = 1480, DSA_COLS = 1736;
constexpr int NSA_LD = 2816, NSA_Q = 0, NSA_KC = 768, NSA_VC = 1024, NSA_KS = 1280, NSA_VS = 1536, NSA_KW = 1792, NSA_VW = 2048, NSA_QM = 2304, NSA_GT = 2560;
constexpr int NSA_SRC_GT = 2304, NSA_SRC_QM = 2340, NSA_COLS = 2596;

constexpr size_t MiB = 1u << 20;
constexpr size_t WS_CTL = 0, CTL_ZERO_BYTES = 1 * MiB;
constexpr size_t WS_PART = 1 * MiB;
constexpr size_t WS_PARTM = 3 * MiB;
constexpr size_t WS_ROPE = 3 * MiB + 512 * 1024;
constexpr size_t WS_MISC = 4 * MiB;
constexpr size_t WS_CMPW = 4 * MiB + 64 * 1024;
constexpr size_t WS_KCMP = 5 * MiB;
constexpr size_t WS_VCMPT = 6 * MiB;
constexpr size_t WS_MK = 7 * MiB;
constexpr size_t WS_MVT = 15 * MiB;
constexpr size_t WS_MEMB = 23 * MiB;
constexpr size_t WS_MKV = 31 * MiB;
constexpr size_t WS_WKV = 47 * MiB;
constexpr size_t WS_WBUF0 = 51 * MiB, WBUF_BYTES = 41 * MiB;
constexpr size_t WS_XB = 133 * MiB;
constexpr size_t WS_Y = 197 * MiB;
constexpr size_t WS_HID = 261 * MiB;
constexpr size_t WS_SC = 373 * MiB;
constexpr size_t WS_MB = 501 * MiB;
constexpr size_t WS_END = 509 * MiB;
static_assert(WS_HID + (size_t)MTOK * FF * 2 <= WS_MB && WS_SC + (size_t)MTOK * SEQ * 2 <= WS_MB && WS_WBUF0 + 2 * WBUF_BYTES <= WS_XB, "d_ws map");
constexpr size_t WB_W1A = 0, WB_W2A = WB_W1A + (size_t)2 * FF * DM, WB_W1B = WB_W2A + (size_t)DM * FF, WB_W2B = WB_W1B + (size_t)2 * FF * DM,
                 WB_WIN = WB_W2B + (size_t)DM * FF, WB_WO = WB_WIN + (size_t)NSA_LD * DM, WB_END = WB_WO + (size_t)DM * DM;
static_assert(WB_END * 2 <= WBUF_BYTES, "weight buffer");
constexpr int LDS_CTRL = 147456 - 1024;
constexpr int CW_BAR = 4096;
constexpr int CW_CK = 32768;
constexpr int CW_Q = 16384;

#define GAS __attribute__((address_space(1)))
#define LAS __attribute__((address_space(3)))
typedef unsigned short bf16;
typedef unsigned v4u __attribute__((ext_vector_type(4)));
typedef unsigned v2u __attribute__((ext_vector_type(2)));
typedef float f32x4 __attribute__((ext_vector_type(4)));
typedef float f32x16 __attribute__((ext_vector_type(16)));
typedef short bf16x8 __attribute__((ext_vector_type(8)));
typedef GAS unsigned gu32;
#define RLX_AGENT __ATOMIC_RELAXED, __HIP_MEMORY_SCOPE_AGENT
#define LDS_WAIT() asm volatile("s_waitcnt lgkmcnt(0)" ::: "memory")
#define VM_WAIT() asm volatile("s_waitcnt vmcnt(0)" ::: "memory")
__device__ __forceinline__ unsigned f2bf(float f) { unsigned u = __builtin_bit_cast(unsigned, f); return (u + 0x7fffu + ((u >> 16) & 1u)) >> 16; }
__device__ __forceinline__ unsigned pk2(float lo, float hi) { return pg8::cvt_pk_bf16(lo, hi); }
__device__ __forceinline__ float bf2f(unsigned h) { return __builtin_bit_cast(float, h << 16); }
__device__ __forceinline__ float bflo(unsigned w) { return __builtin_bit_cast(float, w << 16); }
__device__ __forceinline__ float bfhi(unsigned w) { return __builtin_bit_cast(float, w & 0xffff0000u); }
struct Args { const float* in[23]; float* out; unsigned char* ws; int ph_lo, ph_hi, dry, pad; };
typedef const __attribute__((address_space(4))) Args* KArgs;
struct Frame {
    LAS unsigned char* lds;
    volatile LAS unsigned* MISC;
    gu32* ctl;
    int tid, lane, wave, G, gw, NGW;
    unsigned char* ws;
    KArgs ka;
    float* out;
};
__device__ __forceinline__ float wave_sum(float v) {
#pragma unroll
    for (int o = 1; o < 64; o <<= 1) v += __shfl_xor(v, o);
    return v;
}
__device__ __forceinline__ float wave_max(float v) {
#pragma unroll
    for (int o = 1; o < 64; o <<= 1) v = fmaxf(v, __shfl_xor(v, o));
    return v;
}
__device__ __forceinline__ int grab(gu32* ctr, int lane) { unsigned v = 0; if (lane == 0) v = __hip_atomic_fetch_add(ctr, 1u, RLX_AGENT); return __builtin_amdgcn_readfirstlane((int)v); }

__device__ __forceinline__ void cvt_item(const float* W, int ldw, const float* gain, bf16* WT, int K, LAS float* scr, int k0, int src_col0, int nvalid, int dst_row0, int lane) {
    const int c = lane & 31;
    float wv[32], gv2[32];
#pragma unroll
    for (int i = 0; i < 32; ++i) { const int kk = 2 * i + (lane >> 5); wv[i] = (c < nvalid) ? W[(size_t)(k0 + kk) * ldw + src_col0 + c] : 0.f; gv2[i] = gain ? gain[k0 + kk] : 1.f; }
#pragma unroll
    for (int i = 0; i < 32; ++i) { const int kk = 2 * i + (lane >> 5); scr[kk * 33 + c] = wv[i] * gv2[i]; }
    LDS_WAIT(); asm volatile("" ::: "memory");
    const int c8 = lane & 7;
#pragma unroll
    for (int j = 0; j < 4; ++j) { const int n = (lane >> 3) + 8 * j; const LAS float* s = scr + (8 * c8) * 33 + n;
        v4u o; o.x = pk2(s[0 * 33], s[1 * 33]); o.y = pk2(s[2 * 33], s[3 * 33]); o.z = pk2(s[4 * 33], s[5 * 33]); o.w = pk2(s[6 * 33], s[7 * 33]);
        *(GAS v4u*)(WT + (size_t)(dst_row0 + n) * K + k0 + 8 * c8) = o; }
    LDS_WAIT(); asm volatile("" ::: "memory");
}
__device__ __forceinline__ void cvt_matrix(Frame& F, int& it_base, const float* W, const float* W2, int ldw, int ncols, const float* gain, bf16* WT, int K, int nrows_dst, int kind) {
    LAS float* scr = (LAS float*)(F.lds + F.wave * 16384);
    const int nkb = K / 64, njb = nrows_dst / 32, nitems = nkb * njb;
    int first = (F.gw - it_base % F.NGW + F.NGW) % F.NGW;
    for (int i = first; i < nitems; i += F.NGW) {
        const int kb = i / njb, jb = i % njb; const float* src = W; int sc0 = jb * 32, nv = 32;
        if (kind == 0) { nv = ncols - sc0; nv = nv < 0 ? 0 : (nv > 32 ? 32 : nv); }
        else if (kind == 1) { const int c = jb * 32, pn = c >> 8, bj = (c >> 7) & 1, j = c & 127; src = bj ? W2 : W; sc0 = pn * 128 + j; }
        else { const int c = jb * 32;
            if (c < NSA_QM) { sc0 = c; }
            else if (c < NSA_GT) { sc0 = NSA_SRC_QM + (c - NSA_QM); }
            else { sc0 = NSA_SRC_GT + (c - NSA_GT); nv = NSA_SRC_QM - sc0; nv = nv < 0 ? 0 : (nv > 32 ? 32 : nv); } }
        cvt_item(src, ldw, gain, WT, K, scr, kb * 64, sc0, nv, jb * 32, F.lane);
    }
    it_base += nitems;
}
__device__ __forceinline__ void convert_layer(Frame& F, int Ly) {
    bf16* WB = (bf16*)(F.ws + WS_WBUF0 + (size_t)(Ly & 1) * WBUF_BYTES);
    const float* fnorm = F.ka->in[2]; const float* wg = F.ka->in[3]; const float* wu = F.ka->in[4]; const float* wd = F.ka->in[5];
    int itb = 0;
#pragma unroll 1
    for (int hf = 0; hf < 2; ++hf) {
        const size_t o1 = (size_t)(Ly * 2 + hf) * DM * FF;
        cvt_matrix(F, itb, wg + o1, wu + o1, FF, FF, fnorm + (size_t)(Ly * 2 + hf) * DM, WB + (hf ? WB_W1B : WB_W1A), DM, 2 * FF, 1);
        cvt_matrix(F, itb, wd + o1, nullptr, DM, DM, nullptr, WB + (hf ? WB_W2B : WB_W2A), FF, DM, 0);
    }
    const float* mnorm = F.ka->in[6] + (size_t)Ly * DM;
    const int kind = Ly % 3, j = Ly / 3;
    if (kind == 0) cvt_matrix(F, itb, F.ka->in[12] + (size_t)j * DM * RET_LD, nullptr, RET_LD, RET_LD, mnorm, WB + WB_WIN, DM, RET_LD, 0);
    else if (kind == 1) cvt_matrix(F, itb, F.ka->in[13] + (size_t)j * DM * DSA_COLS, nullptr, DSA_COLS, DSA_COLS, mnorm, WB + WB_WIN, DM, DSA_LD, 0);
    else cvt_matrix(F, itb, F.ka->in[16] + (size_t)j * DM * NSA_COLS, nullptr, NSA_COLS, NSA_COLS, mnorm, WB + WB_WIN, DM, NSA_LD, 2);
    cvt_matrix(F, itb, F.ka->in[7] + (size_t)Ly * DM * DM, nullptr, DM, DM, nullptr, WB + WB_WO, DM, DM, 0);
}

__device__ __forceinline__ void xform(Frame& F, const bf16* src, int spitch, int scol0, int nheads, int rows, int Lr, bf16* dst, int dmode, int dpitch, int dcol0,
                                      const float* gain, bool rope, float cscale, int decay  ) {
    const float* tab = (const float*)(F.ws + WS_ROPE);
    const int i8 = F.lane & 7, sub = F.lane >> 3; const int items = rows * nheads;
    float gn[8];
#pragma unroll
    for (int j = 0; j < 8; ++j) gn[j] = gain ? gain[8 * i8 + j] : 1.f;
    constexpr int U = 4;
    for (int it0 = F.gw * (8 * U); it0 < items; it0 += F.NGW * (8 * U)) {
        v4u raw[U]; f32x4 c0[U], c1[U], s0[U], s1[U];
#pragma unroll
        for (int u = 0; u < U; ++u) { const int it = it0 + 8 * u + sub; const int row = it / nheads, h = it % nheads, t = row % Lr;
            raw[u] = *(const GAS v4u*)(src + (size_t)row * spitch + scol0 + h * 64 + 8 * i8);
            if (rope) { const float* tr = tab + (size_t)t * 64 + 8 * (i8 & 3);
                c0[u] = *(const GAS f32x4*)(tr); c1[u] = *(const GAS f32x4*)(tr + 4); s0[u] = *(const GAS f32x4*)(tr + 32); s1[u] = *(const GAS f32x4*)(tr + 36); } }
#pragma unroll
        for (int u = 0; u < U; ++u) { const int it = it0 + 8 * u + sub; const int row = it / nheads, h = it % nheads, t = row % Lr;
            float v[8] = {bflo(raw[u].x), bfhi(raw[u].x), bflo(raw[u].y), bfhi(raw[u].y), bflo(raw[u].z), bfhi(raw[u].z), bflo(raw[u].w), bfhi(raw[u].w)};
            if (gain) { float ss = 0.f;
#pragma unroll
                for (int j = 0; j < 8; ++j) ss += v[j] * v[j];
                ss += __shfl_xor(ss, 1); ss += __shfl_xor(ss, 2); ss += __shfl_xor(ss, 4);
                const float r = __builtin_amdgcn_rsqf(ss * (1.f / 64.f) + EPS);
#pragma unroll
                for (int j = 0; j < 8; ++j) v[j] = v[j] * r * gn[j]; }
            if (rope) {
                const float cs[8] = {c0[u][0], c0[u][1], c0[u][2], c0[u][3], c1[u][0], c1[u][1], c1[u][2], c1[u][3]}, sn[8] = {s0[u][0], s0[u][1], s0[u][2], s0[u][3], s1[u][0], s1[u][1], s1[u][2], s1[u][3]};
#pragma unroll
                for (int j = 0; j < 8; ++j) { const float p = __shfl_xor(v[j], 4); v[j] = (i8 < 4) ? (v[j] * cs[j] - p * sn[j]) : (v[j] * cs[j] + p * sn[j]); } }
            float f = cscale;
            if (decay) { const float lg = __builtin_amdgcn_logf(1.0f - __builtin_amdgcn_exp2f(-5.0f - (float)h)); f *= __builtin_amdgcn_exp2f((float)(decay * t) * lg); }
            v4u o; o.x = pk2(v[0] * f, v[1] * f); o.y = pk2(v[2] * f, v[3] * f); o.z = pk2(v[4] * f, v[5] * f); o.w = pk2(v[6] * f, v[7] * f);
            bf16* dp = dmode == 0 ? dst + (size_t)row * dpitch + dcol0 + h * 64 + 8 * i8 : dst + ((size_t)((row / Lr) * nheads + h) * Lr + t) * 64 + 8 * i8;
            *(GAS v4u*)dp = o; }
    }
}
__device__ __forceinline__ void transpose_cols(Frame& F, const bf16* src, int spitch, int scol0, int ncols, int nb, int Lr, bf16* dst) {
    LAS bf16* scr = (LAS bf16*)(F.lds + F.wave * 16384);
    const int ntt = Lr / 64, nct = ncols / 64, ntiles = nb * ntt * nct; const int i8 = F.lane & 7, sub = F.lane >> 3;
    for (int tl = F.gw; tl < ntiles; tl += F.NGW) {
        const int ct = tl % nct, tt = (tl / nct) % ntt, b = tl / (nct * ntt); const int t0 = tt * 64, c0 = ct * 64;
#pragma unroll
        for (int k = 0; k < 8; ++k) { const int r = sub + 8 * k;
            const v4u raw = *(const GAS v4u*)(src + (size_t)(b * Lr + t0 + r) * spitch + scol0 + c0 + 8 * i8);
            *(LAS v4u*)(scr + r * 72 + 8 * i8) = raw; }
        LDS_WAIT(); asm volatile("" ::: "memory");
        bf16* drow = dst + ((size_t)b * ncols + c0 + F.lane) * Lr + t0;
#pragma unroll
        for (int k = 0; k < 8; ++k) { unsigned w[4];
#pragma unroll
            for (int q = 0; q < 4; ++q) { const unsigned lo = scr[(8 * k + 2 * q) * 72 + F.lane], hi = scr[(8 * k + 2 * q + 1) * 72 + F.lane]; w[q] = lo | (hi << 16); }
            v4u o; o.x = w[0]; o.y = w[1]; o.z = w[2]; o.w = w[3]; *(GAS v4u*)(drow + 8 * k) = o; }
        LDS_WAIT(); asm volatile("" ::: "memory");
    }
}
__device__ __forceinline__ void row_to_bf16(Frame& F, const float* xrow, bf16* orow, float* part) {
    const GAS f32x4* xr = (const GAS f32x4*)xrow + F.lane;
    f32x4 v[4]; float s = 0.f;
#pragma unroll
    for (int j = 0; j < 4; ++j) { v[j] = xr[64 * j]; s += (v[j].x * v[j].x + v[j].y * v[j].y) + (v[j].z * v[j].z + v[j].w * v[j].w); }
    s = wave_sum(s);
    GAS v2u* o8 = (GAS v2u*)orow + F.lane;
#pragma unroll
    for (int j = 0; j < 4; ++j) { v2u o; o.x = pk2(v[j].x, v[j].y); o.y = pk2(v[j].z, v[j].w); o8[64 * j] = o; }
    if (F.lane < 16) part[F.lane] = F.lane == 0 ? s : 0.f;
}
enum { MK_NONE = 0, MK_CAUSAL = 1, MK_WIN = 2, MK_BITS = 3, MK_SLC = 4, MK_CMP = 5 };
struct KVp { const bf16* K; int kpitch; const bf16* VT; int vpitch; };
struct MaskArg { int q0[3]; const unsigned* mb; unsigned sel; int nmax; float lg; };
__device__ __forceinline__ bf16x8 ld8(const bf16* p) { return *(const GAS bf16x8*)p; }
__device__ __forceinline__ float fast_exp2(float x) { return __builtin_amdgcn_exp2f(x); }

template <int NS, int NT, int MODE, int MT, int PF = 2>
__device__ __forceinline__ void attn_core(const LAS bf16x8* ql, const KVp kv, int kt0, int kt1, float negb, const MaskArg& ma, const unsigned* const (&mbrow)[NS],
                                          f32x16 (&O)[NS][NT], float (&lsum)[NS], int lane) {
    const int r32 = lane & 31, hi = lane >> 5;
    const int kperm = (r32 & 0x13) | ((r32 & 4) << 1) | ((r32 & 8) >> 1);
    const bf16* kp = kv.K + (size_t)kperm * kv.kpitch + 8 * hi;
    const bf16* vp = kv.VT + (size_t)r32 * kv.vpitch + 8 * hi;
    bf16x8 kf[4], vf[2][NT], kfn[4], vfn[2][NT];
#define AC_LOADK(dst, kt_) do { const bf16* kq_ = kp + (size_t)(32 * (kt_)) * kv.kpitch; _Pragma("unroll") for (int ks = 0; ks < 4; ++ks) dst[ks] = ld8(kq_ + 16 * ks); } while (0)
#define AC_LOADV(dst, kt_) do { _Pragma("unroll") for (int nt = 0; nt < NT; ++nt) { const bf16* vq_ = vp + (size_t)(32 * nt) * kv.vpitch + 32 * (kt_); dst[0][nt] = ld8(vq_); dst[1][nt] = ld8(vq_ + 16); } } while (0)
    unsigned mw[NS], mwn[NS];
    if (kt0 < kt1) { if (PF >= 1) AC_LOADK(kf, kt0); if (PF >= 2) AC_LOADV(vf, kt0);
        if (MT == MK_BITS) { _Pragma("unroll") for (int s = 0; s < NS; ++s) mw[s] = mbrow[s][kt0]; } }
#pragma unroll 1
    for (int kt = kt0; kt < kt1; ++kt) {
        unsigned selbit = 1u; bool active = true;
        if (MT == MK_SLC) { selbit = (ma.sel >> (kt >> 1)) & 1u; active = __any(selbit != 0u); }
        const int ktn = (kt + 1 < kt1) ? kt + 1 : kt;
        if (PF == 0) { if (active) { AC_LOADK(kf, kt); AC_LOADV(vf, kt); } }
        else { AC_LOADK(kfn, ktn); if (PF >= 2) AC_LOADV(vfn, ktn); else if (active) AC_LOADV(vf, kt); }
        if (MT == MK_BITS) { _Pragma("unroll") for (int s = 0; s < NS; ++s) mwn[s] = mbrow[s][ktn]; }
        if (active) {
        const LAS bf16x8* qlp = ql; asm volatile("" : "+v"(qlp));
#pragma unroll
        for (int s = 0; s < NS; ++s) {
            f32x16 acc;
#pragma unroll
            for (int r = 0; r < 16; ++r) acc[r] = 0.f;
#pragma unroll
            for (int ks = 0; ks < 4; ++ks) acc = __builtin_amdgcn_mfma_f32_32x32x16_bf16(kf[ks], qlp[(s * 4 + ks) * 64], acc, 0, 0, 0);
            const int tq = ma.q0[s] + r32, kb = 32 * kt + 8 * hi;
            bool full = true;
            if (MT == MK_CAUSAL) full = (32 * kt + 31 <= ma.q0[s]);
            if (MT == MK_WIN) full = (32 * kt + 31 <= ma.q0[s]) && (32 * kt >= ma.q0[s] + 31 - 511);
            if (MT == MK_SLC) full = (32 * kt + 31 <= ma.q0[s]) && __all(selbit != 0u);
            if (MT == MK_BITS || MT == MK_CMP) full = false;
            float p[16];
            if (full) {
#pragma unroll
                for (int r = 0; r < 16; ++r) { const int key = kb + 16 * (r >> 3) + (r & 7); p[r] = MODE == 0 ? fast_exp2(acc[r]) : (MODE == 1 ? acc[r] : acc[r] * fast_exp2((float)(tq - key) * ma.lg)); }
            } else {
                unsigned w = 0;
                if (MT == MK_BITS) w = mw[s];
#pragma unroll
                for (int r = 0; r < 16; ++r) { const int key = kb + 16 * (r >> 3) + (r & 7); bool v = true;
                    if (MT == MK_CAUSAL) v = key <= tq;
                    if (MT == MK_WIN) v = (key <= tq) && (key >= tq - 511);
                    if (MT == MK_SLC) v = (key <= tq) && (selbit != 0u);
                    if (MT == MK_BITS) v = (w >> (8 * hi + 16 * (r >> 3) + (r & 7))) & 1u;
                    if (MT == MK_CMP) v = key <= ma.nmax;
                    const float e = MODE == 0 ? fast_exp2(acc[r]) : (MODE == 1 ? acc[r] : acc[r] * fast_exp2((float)((tq - key) < 0 ? 0 : (tq - key)) * ma.lg));
                    p[r] = v ? e : 0.f; }
            }
            if (MODE == 0) { float a = 0.f;
#pragma unroll
                for (int r = 0; r < 16; ++r) a += p[r];
                lsum[s] += a; }
            bf16x8 pk0, pk1;
            { v4u t0, t1; t0.x = pk2(p[0], p[1]); t0.y = pk2(p[2], p[3]); t0.z = pk2(p[4], p[5]); t0.w = pk2(p[6], p[7]);
              t1.x = pk2(p[8], p[9]); t1.y = pk2(p[10], p[11]); t1.z = pk2(p[12], p[13]); t1.w = pk2(p[14], p[15]);
              pk0 = __builtin_bit_cast(bf16x8, t0); pk1 = __builtin_bit_cast(bf16x8, t1); }
#pragma unroll
            for (int nt = 0; nt < NT; ++nt) { O[s][nt] = __builtin_amdgcn_mfma_f32_32x32x16_bf16(pk0, vf[0][nt], O[s][nt], 0, 0, 0);
                                              O[s][nt] = __builtin_amdgcn_mfma_f32_32x32x16_bf16(pk1, vf[1][nt], O[s][nt], 0, 0, 0); }
            if (NS >= 3) __builtin_amdgcn_sched_barrier(0);
        }
        }
        if (MT == MK_BITS) { _Pragma("unroll") for (int s = 0; s < NS; ++s) mw[s] = mwn[s]; }
        if (PF >= 1) {
#pragma unroll
            for (int ks = 0; ks < 4; ++ks) kf[ks] = kfn[ks];
            if (PF >= 2) {
#pragma unroll
                for (int nt = 0; nt < NT; ++nt) { vf[0][nt] = vfn[0][nt]; vf[1][nt] = vfn[1][nt]; } }
        }
    }
#undef AC_LOADK
#undef AC_LOADV
}
template <int NS, int NT, int MODE, int MT>
__device__ __forceinline__ void tile_math(const bf16x8 (&kf)[4], const bf16x8 (&vf)[2][NT], const LAS bf16x8* ql, int kt, const MaskArg& ma, const unsigned (&mw)[NS], unsigned selbit,
                                          f32x16 (&O)[NS][NT], float (&lsum)[NS], int lane) {
    const int r32 = lane & 31, hi = lane >> 5;
    const LAS bf16x8* qlp = ql; asm volatile("" : "+v"(qlp));
#pragma unroll
    for (int s = 0; s < NS; ++s) {
        f32x16 acc;
#pragma unroll
        for (int r = 0; r < 16; ++r) acc[r] = 0.f;
#pragma unroll
        for (int ks = 0; ks < 4; ++ks) acc = __builtin_amdgcn_mfma_f32_32x32x16_bf16(kf[ks], qlp[(s * 4 + ks) * 64], acc, 0, 0, 0);
        const int tq = ma.q0[s] + r32, kb = 32 * kt + 8 * hi;
        bool full = true;
        if (MT == MK_CAUSAL) full = (32 * kt + 31 <= ma.q0[s]);
        if (MT == MK_WIN) full = (32 * kt + 31 <= ma.q0[s]) && (32 * kt >= ma.q0[s] + 31 - 511);
        if (MT == MK_SLC) full = (32 * kt + 31 <= ma.q0[s]) && __all(selbit != 0u);
        if (MT == MK_BITS || MT == MK_CMP) full = false;
        float p[16];
        if (full) {
#pragma unroll
            for (int r = 0; r < 16; ++r) p[r] = MODE == 0 ? fast_exp2(acc[r]) : acc[r];
        } else if (MT == MK_BITS) {
            const unsigned wsh = mw[s] >> (8 * hi);
#pragma unroll
            for (int r = 0; r < 16; ++r) { const int m = ((int)(wsh << (31 - (16 * (r >> 3) + (r & 7))))) >> 31;
                p[r] = __builtin_bit_cast(float, __builtin_bit_cast(unsigned, fast_exp2(acc[r])) & (unsigned)m); }
        } else {
            const unsigned w = mw[s];
#pragma unroll
            for (int r = 0; r < 16; ++r) { const int key = kb + 16 * (r >> 3) + (r & 7); bool v = true;
                if (MT == MK_CAUSAL) v = key <= tq;
                if (MT == MK_WIN) v = (key <= tq) && (key >= tq - 511);
                if (MT == MK_SLC) v = (key <= tq) && (selbit != 0u);
                if (MT == MK_BITS) v = (w >> (8 * hi + 16 * (r >> 3) + (r & 7))) & 1u;
                if (MT == MK_CMP) v = key <= ma.nmax;
                const float e = MODE == 0 ? fast_exp2(acc[r]) : acc[r];
                p[r] = v ? e : 0.f; }
        }
        if (MODE == 0) { float a = 0.f;
#pragma unroll
            for (int r = 0; r < 16; ++r) a += p[r];
            lsum[s] += a; }
        bf16x8 pk0, pk1;
        { v4u t0, t1; t0.x = pk2(p[0], p[1]); t0.y = pk2(p[2], p[3]); t0.z = pk2(p[4], p[5]); t0.w = pk2(p[6], p[7]);
          t1.x = pk2(p[8], p[9]); t1.y = pk2(p[10], p[11]); t1.z = pk2(p[12], p[13]); t1.w = pk2(p[14], p[15]);
          pk0 = __builtin_bit_cast(bf16x8, t0); pk1 = __builtin_bit_cast(bf16x8, t1); }
#pragma unroll
        for (int nt = 0; nt < NT; ++nt) { O[s][nt] = __builtin_amdgcn_mfma_f32_32x32x16_bf16(pk0, vf[0][nt], O[s][nt], 0, 0, 0);
                                          O[s][nt] = __builtin_amdgcn_mfma_f32_32x32x16_bf16(pk1, vf[1][nt], O[s][nt], 0, 0, 0); }
        if (NS >= 3) __builtin_amdgcn_sched_barrier(0);
    }
}
__device__ __forceinline__ int crow(int r, int hi) { return (r & 3) + 8 * (r >> 2) + 4 * hi; }
template <int NT, bool ADD>
__device__ __forceinline__ void store_o(const f32x16 (&O)[NT], float f, bf16* Y, int row0, int col0, int lane) {
    const int r32 = lane & 31, hi = lane >> 5;
    unsigned ybase = (unsigned)((row0 + 4 * hi) * 1024 + col0 + r32); asm volatile("" : "+v"(ybase));
#pragma unroll
    for (int rh = 0; rh < 2; ++rh) {
        unsigned short old[NT][8];
        if (ADD) {
#pragma unroll
            for (int ri = 0; ri < 8; ++ri)
#pragma unroll
                for (int nt = 0; nt < NT; ++nt) { const int r = 8 * rh + ri; old[nt][ri] = Y[ybase + (unsigned)(((r & 3) + 8 * (r >> 2)) * 1024) + 32 * nt]; }
        }
#pragma unroll
        for (int ri = 0; ri < 8; ++ri) { const int r = 8 * rh + ri; const int q = crow(r, hi); const float fr = __shfl(f, q);
            const unsigned yo = ybase + (unsigned)(((r & 3) + 8 * (r >> 2)) * 1024);
#pragma unroll
            for (int nt = 0; nt < NT; ++nt) { float v = O[nt][r] * fr; if (ADD) v += bf2f(old[nt][ri]); Y[yo + 32 * nt] = (bf16)f2bf(v); } }
    }
}
template <int NS> __device__ __forceinline__ void stage_q(LAS bf16x8* ql, const bf16* const (&qrow)[NS], int lane) {
    const int hi = lane >> 5;
#pragma unroll
    for (int s = 0; s < NS; ++s)
#pragma unroll
        for (int ks = 0; ks < 4; ++ks) ql[(s * 4 + ks) * 64] = ld8(qrow[s] + 16 * ks + 8 * hi);
    LDS_WAIT(); asm volatile("" ::: "memory");
}
__device__ __forceinline__ void q32_load(const bf16* p  , float (&v)[4][8]) {
    v4u raw[4];
#pragma unroll
    for (int ks = 0; ks < 4; ++ks) raw[ks] = *(const GAS v4u*)(p + 16 * ks);
#pragma unroll
    for (int ks = 0; ks < 4; ++ks) { v[ks][0] = bflo(raw[ks].x); v[ks][1] = bfhi(raw[ks].x); v[ks][2] = bflo(raw[ks].y); v[ks][3] = bfhi(raw[ks].y);
        v[ks][4] = bflo(raw[ks].z); v[ks][5] = bfhi(raw[ks].z); v[ks][6] = bflo(raw[ks].w); v[ks][7] = bfhi(raw[ks].w); }
}
__device__ __forceinline__ void q32_xf(float (&v)[4][8], const float* gain, bool rope, int t, float scale, int hi, const float* tab) {
    if (gain) { float ss = 0.f;
#pragma unroll
        for (int ks = 0; ks < 4; ++ks)
#pragma unroll
            for (int j = 0; j < 8; ++j) ss += v[ks][j] * v[ks][j];
        ss += __shfl_xor(ss, 32);
        const float r = __builtin_amdgcn_rsqf(ss * (1.f / 64.f) + EPS);
#pragma unroll
        for (int ks = 0; ks < 4; ++ks) { const f32x4 g0 = *(const GAS f32x4*)(gain + 16 * ks + 8 * hi), g1 = *(const GAS f32x4*)(gain + 16 * ks + 8 * hi + 4);
#pragma unroll
            for (int j = 0; j < 4; ++j) { v[ks][j] *= r * g0[j]; v[ks][4 + j] *= r * g1[j]; } } }
    if (rope) { const float* tr = tab + (size_t)t * 64 + 8 * hi;
#pragma unroll
        for (int ks = 0; ks < 2; ++ks) { const f32x4 c0 = *(const GAS f32x4*)(tr + 16 * ks), c1 = *(const GAS f32x4*)(tr + 16 * ks + 4), s0 = *(const GAS f32x4*)(tr + 32 + 16 * ks), s1 = *(const GAS f32x4*)(tr + 36 + 16 * ks);
#pragma unroll
            for (int j = 0; j < 8; ++j) { const float c = j < 4 ? c0[j & 3] : c1[j & 3], sn = j < 4 ? s0[j & 3] : s1[j & 3]; const float a = v[ks][j], b = v[ks + 2][j];
                v[ks][j] = a * c - b * sn; v[ks + 2][j] = b * c + a * sn; } } }
#pragma unroll
    for (int ks = 0; ks < 4; ++ks)
#pragma unroll
        for (int j = 0; j < 8; ++j) v[ks][j] *= scale;
}
__device__ __forceinline__ bf16x8 q32_pack(const float (&v)[8]) { v4u o; o.x = pk2(v[0], v[1]); o.y = pk2(v[2], v[3]); o.z = pk2(v[4], v[5]); o.w = pk2(v[6], v[7]); return __builtin_bit_cast(bf16x8, o); }
template <int NS> __device__ __forceinline__ void stage_q_xf(Frame& F, LAS bf16x8* ql, const bf16* const (&qrow)[NS], const int (&tpos)[NS], const float* gain, bool rope, float scale) {
    const int hi = F.lane >> 5; const float* tab = (const float*)(F.ws + WS_ROPE);
#pragma unroll
    for (int s = 0; s < NS; ++s) { float v[4][8]; q32_load(qrow[s] + 8 * hi, v); q32_xf(v, gain, rope, tpos[s], scale, hi, tab);
#pragma unroll
        for (int ks = 0; ks < 4; ++ks) ql[(s * 4 + ks) * 64] = q32_pack(v[ks]); }
    LDS_WAIT(); asm volatile("" ::: "memory");
}
__device__ __forceinline__ LAS bf16x8* wave_q(Frame& F) { return (LAS bf16x8*)(F.lds + F.wave * 16384) + F.lane; }
template <int NS, int NT> __device__ __forceinline__ void zero_o(f32x16 (&O)[NS][NT], float (&l)[NS]) {
#pragma unroll
    for (int s = 0; s < NS; ++s) { l[s] = 0.f;
#pragma unroll
        for (int nt = 0; nt < NT; ++nt)
#pragma unroll
            for (int r = 0; r < 16; ++r) O[s][nt][r] = 0.f; }
}

__device__ __forceinline__ void mem_task(Frame& F, int task, int Ly, const bf16* PROJ, int ldp, int qmcol) {
    const int qb = task & 31, h = (task >> 5) & 3, b = task >> 7; const int r32 = F.lane & 31;
    const int row0 = b * SEQ + 64 * qb;
    const bf16* qrow[2] = {PROJ + (size_t)(row0 + r32) * ldp + qmcol + h * 64, PROJ + (size_t)(row0 + 32 + r32) * ldp + qmcol + h * 64};
    LAS bf16x8* ql = wave_q(F); { const int tp[2] = {0, 0}; stage_q_xf<2>(F, ql, qrow, tp, F.ka->in[10] + Ly * 64, false, QSCALE); }
    KVp kv{(const bf16*)(F.ws + WS_MK) + ((size_t)((Ly * NB + b) * 4 + h) * NMEMT) * 64, 64, (const bf16*)(F.ws + WS_MVT) + ((size_t)(Ly * NB + b) * 256 + h * 64) * NMEMT, NMEMT};
    f32x16 O[2][2]; float l[2]; zero_o<2, 2>(O, l);
    MaskArg ma{}; const unsigned* mbr[2] = {nullptr, nullptr};
    const float negb = 0.f;
    attn_core<2, 2, 0, MK_NONE>(ql, kv, 0, NMEMT / 32, negb, ma, mbr, O, l, F.lane);
    bf16* Y = (bf16*)(F.ws + WS_Y);
#pragma unroll
    for (int s = 0; s < 2; ++s) { const float lt = l[s] + __shfl_xor(l[s], 32); store_o<2, false>(O[s], (DBG_ZERO & 8) ? 0.f : 1.f / lt, Y, row0 + 32 * s, 768 + h * 64, F.lane); }
}
__device__ __forceinline__ void ret_epilogue(Frame& F, const f32x16 (&O)[4], int rowb, int h, const bf16* PROJ) {
    const int r32 = F.lane & 31, hi = F.lane >> 5;
    bf16* Y = (bf16*)(F.ws + WS_Y);
#pragma unroll
    for (int rh = 0; rh < 2; ++rh) {
        unsigned short gv[8][4];
#pragma unroll
        for (int ri = 0; ri < 8; ++ri) { const int r = 8 * rh + ri; const bf16* gp = PROJ + (size_t)(rowb + crow(r, hi)) * RET_LD + RET_G + h * 128 + r32;
#pragma unroll
            for (int nt = 0; nt < 4; ++nt) gv[ri][nt] = gp[32 * nt]; }
#pragma unroll
        for (int ri = 0; ri < 8; ++ri) { const int r = 8 * rh + ri;
            float a = (O[0][r] + O[1][r]) + (O[2][r] + O[3][r]);
#pragma unroll
            for (int o = 1; o < 32; o <<= 1) a += __shfl_xor(a, o);
            const float mu = a * (1.f / 128.f);
            float d0 = O[0][r] - mu, d1 = O[1][r] - mu, d2 = O[2][r] - mu, d3 = O[3][r] - mu;
            float q = (d0 * d0 + d1 * d1) + (d2 * d2 + d3 * d3);
#pragma unroll
            for (int o = 1; o < 32; o <<= 1) q += __shfl_xor(q, o);
            const float rstd = __builtin_amdgcn_rsqf(q * (1.f / 128.f) + EPS);
            const int row = rowb + crow(r, hi);
            bf16* yp = Y + (size_t)row * 1024 + h * 128 + r32;
            const float dd[4] = {d0, d1, d2, d3};
#pragma unroll
            for (int nt = 0; nt < 4; ++nt) { const float g = bf2f(gv[ri][nt]); const float sg = g * __builtin_amdgcn_rcpf(1.f + fast_exp2(-1.4426950408889634f * g));
                yp[32 * nt] = (DBG_ZERO & 1) ? (bf16)0 : (bf16)f2bf(sg * dd[nt] * rstd); }
        }
    }
}
__device__ __forceinline__ void glds16(const void* gsrc, unsigned lds_dst) { unsigned keep;
    asm volatile("s_mov_b32 %0, m0\n\ts_mov_b32 m0, %2\n\ts_nop 0\n\tglobal_load_lds_dwordx4 %1, off\n\ts_mov_b32 m0, %0" : "=&s"(keep) : "v"(gsrc), "s"(lds_dst) : "memory"); }
template <int NS, int MT, int R>
__device__ __forceinline__ void wg_attn(Frame& F, const LAS bf16x8* ql, const bf16* psrc, int pstep, unsigned ring_off, int kt0, int kt1, unsigned blk, int my0, int my1,
                                        const MaskArg& ma, const LAS unsigned* mlds, f32x16 (&O)[NS][2], float (&lsum)[NS]) {
    const unsigned pdst = (unsigned)(uintptr_t)F.lds + ring_off + (unsigned)F.wave * 1024u;
#define WG_NEED(k_) ((MT != MK_SLC) || (((blk) >> ((k_) >> 1)) & 1u))
#define WG_ADV(k_) do { ++(k_); } while ((k_) < kt1 && !WG_NEED(k_))
    int kd = kt0; if (kd < kt1 && !WG_NEED(kd)) WG_ADV(kd);
    int kc = kd;
    int sd = 0, sc = 0, nd = 0;
#pragma unroll 1
    for (int j = 0; j < R - 1; ++j) if (kd < kt1) { glds16(psrc + (size_t)kd * pstep, (unsigned)__builtin_amdgcn_readfirstlane(pdst + (unsigned)sd * 8192u)); WG_ADV(kd); sd = sd + 1 == R ? 0 : sd + 1; ++nd; }
#pragma unroll 1
    while (kc < kt1) {
        const int yo = nd - 1;
        if (yo >= 3) asm volatile("s_waitcnt vmcnt(3)\n\ts_barrier" ::: "memory");
        else if (yo == 2) asm volatile("s_waitcnt vmcnt(2)\n\ts_barrier" ::: "memory");
        else if (yo == 1) asm volatile("s_waitcnt vmcnt(1)\n\ts_barrier" ::: "memory");
        else asm volatile("s_waitcnt vmcnt(0)\n\ts_barrier" ::: "memory");
        if (kd < kt1) { glds16(psrc + (size_t)kd * pstep, (unsigned)__builtin_amdgcn_readfirstlane(pdst + (unsigned)sd * 8192u)); WG_ADV(kd); sd = sd + 1 == R ? 0 : sd + 1; ++nd; }
        if (kc >= my0 && kc < my1) {
            unsigned selbit = 1u; bool active = true;
            if (MT == MK_SLC) { selbit = (ma.sel >> (kc >> 1)) & 1u; active = __any(selbit != 0u); }
            if (active) {
                const LAS bf16x8* sp = (const LAS bf16x8*)(F.lds + ring_off + sc * 8192) + F.lane;
                bf16x8 kf[4], vf[2][2];
#pragma unroll
                for (int ks = 0; ks < 4; ++ks) kf[ks] = sp[ks * 64];
#pragma unroll
                for (int nt = 0; nt < 2; ++nt) { vf[0][nt] = sp[(4 + 2 * nt) * 64]; vf[1][nt] = sp[(5 + 2 * nt) * 64]; }
                unsigned mw[NS];
#pragma unroll
                for (int s = 0; s < NS; ++s) mw[s] = (MT == MK_BITS) ? mlds[kc] : 0u;
                tile_math<NS, 2, 0, MT>(kf, vf, ql, kc, ma, mw, selbit, O, lsum, F.lane);
            }
        }
        WG_ADV(kc); sc = sc + 1 == R ? 0 : sc + 1; --nd;
    }
    asm volatile("s_waitcnt vmcnt(0)\n\ts_barrier" ::: "memory");
#undef WG_NEED
#undef WG_ADV
}
constexpr int RWG_SLOT = 12288, RWG_R = 9;
__device__ __forceinline__ void ret_wg_task(Frame& F, int task, const bf16* PROJ) {
    const int qb = 7 - (task & 7), h = (task >> 3) % 6, b = (task >> 3) / 6, w = F.wave; const int r32 = F.lane & 31, hi = F.lane >> 5;
    const int rowb = b * SEQ + 256 * qb + 32 * w;
    bf16x8 qf[4];
    { float v[4][8]; q32_load(PROJ + (size_t)(rowb + r32) * RET_LD + RET_Q + h * 64 + 8 * hi, v);
      const int t = 256 * qb + 32 * w + r32; const float lg = __builtin_amdgcn_logf(1.0f - __builtin_amdgcn_exp2f(-5.0f - (float)h));
      q32_xf(v, nullptr, true, t, __builtin_amdgcn_exp2f((float)t * lg), hi, (const float*)(F.ws + WS_ROPE));
#pragma unroll
      for (int ks = 0; ks < 4; ++ks) qf[ks] = q32_pack(v[ks]); }
    asm volatile("s_waitcnt vmcnt(0)" : "+v"(qf[0]), "+v"(qf[1]), "+v"(qf[2]), "+v"(qf[3]) :: "memory");
    const int kperm = (r32 & 0x13) | ((r32 & 4) << 1) | ((r32 & 8) >> 1);
    const bf16* ksrc = PROJ + (size_t)(b * SEQ + kperm) * RET_LD + RET_K + h * 64 + 16 * (w & 3) + 8 * hi;
    const bf16* vsrc = (const bf16*)F.out + ((size_t)b * 768 + h * 128 + 32 * (w >> 1) + r32) * SEQ + 16 * (w & 1) + 8 * hi;
    const unsigned lds0 = (unsigned)(uintptr_t)F.lds;
    const unsigned kdst = lds0 + (unsigned)(w & 3) * 1024u, vdst = lds0 + 4096u + (unsigned)w * 1024u;
    const int kt1 = 8 * qb + 8, my1 = 8 * qb + w + 1;
#define RWG_DMA(t_, slot_) do { const int tt_ = (t_) < kt1 ? (t_) : kt1 - 1; const unsigned so_ = (unsigned)(((t_) < kt1) ? (slot_) : RWG_R) * RWG_SLOT; \
        if (w < 4) glds16(ksrc + (size_t)(32 * tt_) * RET_LD, (unsigned)__builtin_amdgcn_readfirstlane(kdst + so_)); \
        glds16(vsrc + 32 * tt_, (unsigned)__builtin_amdgcn_readfirstlane(vdst + so_)); } while (0)
    f32x16 O[4];
#pragma unroll
    for (int nt = 0; nt < 4; ++nt)
#pragma unroll
        for (int r = 0; r < 16; ++r) O[nt][r] = 0.f;
#pragma unroll 1
    for (int j = 0; j < RWG_R - 1; ++j) RWG_DMA(j, j);
    int slot = 0, fslot = RWG_R - 1;
#pragma unroll 1
    for (int kt = 0; kt < kt1; ++kt) {
        if (w < 4) asm volatile("s_waitcnt vmcnt(%0)\n\ts_barrier" :: "n"(2 * (RWG_R - 2)) : "memory");
        else       asm volatile("s_waitcnt vmcnt(%0)\n\ts_barrier" :: "n"(RWG_R - 2) : "memory");
        RWG_DMA(kt + RWG_R - 1, fslot);
        if (kt < my1) {
            const LAS bf16x8* sp = (const LAS bf16x8*)(F.lds + slot * RWG_SLOT) + F.lane;
            bf16x8 kf[4], vf[2][4];
#pragma unroll
            for (int ks = 0; ks < 4; ++ks) kf[ks] = sp[ks * 64];
#pragma unroll
            for (int nt = 0; nt < 4; ++nt) { vf[0][nt] = sp[(4 + 2 * nt) * 64]; vf[1][nt] = sp[(5 + 2 * nt) * 64]; }
            f32x16 acc;
#pragma unroll
            for (int r = 0; r < 16; ++r) acc[r] = 0.f;
#pragma unroll
            for (int ks = 0; ks < 4; ++ks) acc = __builtin_amdgcn_mfma_f32_32x32x16_bf16(kf[ks], qf[ks], acc, 0, 0, 0);
            float p[16];
            if (kt + 1 < my1) {
#pragma unroll
                for (int r = 0; r < 16; ++r) p[r] = acc[r];
            } else {
#pragma unroll
                for (int r = 0; r < 16; ++r) p[r] = (8 * hi + 16 * (r >> 3) + (r & 7) <= r32) ? acc[r] : 0.f;
            }
            bf16x8 pk0, pk1;
            { v4u t0, t1; t0.x = pk2(p[0], p[1]); t0.y = pk2(p[2], p[3]); t0.z = pk2(p[4], p[5]); t0.w = pk2(p[6], p[7]);
              t1.x = pk2(p[8], p[9]); t1.y = pk2(p[10], p[11]); t1.z = pk2(p[12], p[13]); t1.w = pk2(p[14], p[15]);
              pk0 = __builtin_bit_cast(bf16x8, t0); pk1 = __builtin_bit_cast(bf16x8, t1); }
#pragma unroll
            for (int nt = 0; nt < 4; ++nt) { O[nt] = __builtin_amdgcn_mfma_f32_32x32x16_bf16(pk0, vf[0][nt], O[nt], 0, 0, 0);
                                             O[nt] = __builtin_amdgcn_mfma_f32_32x32x16_bf16(pk1, vf[1][nt], O[nt], 0, 0, 0); }
        }
        fslot = slot; slot = slot + 1 == RWG_R ? 0 : slot + 1;
    }
    asm volatile("s_waitcnt vmcnt(0)\n\ts_barrier" ::: "memory");
#undef RWG_DMA
    ret_epilogue(F, O, rowb, h, PROJ);
}
__device__ __forceinline__ void ret_task(Frame& F, int task, const bf16* PROJ) {
    const int qb = 31 - (task & 31), h = (task >> 5) % 6, b = (task >> 5) / 6; const int r32 = F.lane & 31, hi = F.lane >> 5;
    const int row0 = b * SEQ + 64 * qb;
    const bf16* qrow[2] = {PROJ + (size_t)(row0 + r32) * RET_LD + RET_Q + h * 64, PROJ + (size_t)(row0 + 32 + r32) * RET_LD + RET_Q + h * 64};
    LAS bf16x8* ql = wave_q(F); stage_q<2>(ql, qrow, F.lane);
    KVp kv{PROJ + (size_t)(b * SEQ) * RET_LD + RET_K + h * 64, RET_LD, (const bf16*)F.out + ((size_t)b * 768 + h * 128) * SEQ, SEQ};
    f32x16 O[2][4]; float l[2]; zero_o<2, 4>(O, l);
    MaskArg ma{}; ma.q0[0] = 64 * qb; ma.q0[1] = 64 * qb + 32; const unsigned* mbr[2] = {nullptr, nullptr};
    ma.lg = __builtin_amdgcn_logf(1.0f - __builtin_amdgcn_exp2f(-5.0f - (float)h));
    attn_core<2, 4, RET_MODE, MK_CAUSAL, 1>(ql, kv, 0, 2 * qb + 2, 0.f, ma, mbr, O, l, F.lane);
#pragma unroll
    for (int s = 0; s < 2; ++s) ret_epilogue(F, O[s], row0 + 32 * s, h, PROJ);
}

typedef _Float16 h2_t __attribute__((ext_vector_type(2)));
__device__ __forceinline__ unsigned pkh(float a, float b) { h2_t v = {(_Float16)a, (_Float16)b}; return __builtin_bit_cast(unsigned, v); }
__device__ __forceinline__ void dsa_d1_task(Frame& F, int task, const bf16* PROJ) {
    const int b = task / 288; int rem = task % 288; int qb = 63, kc = 0;
    { int grp = 7; while (rem >= 8 * (grp + 1)) { rem -= 8 * (grp + 1); --grp; }
      qb = 8 * grp + 7 - rem / (grp + 1); kc = rem % (grp + 1); }
    const int r32 = F.lane & 31, hi = F.lane >> 5; const int row = b * SEQ + 32 * qb + r32;
    const bf16* qp = PROJ + (size_t)row * DSA_LD + DSA_IQ + 8 * hi;
    bf16x8 qf[4][4]; LAS bf16x8* ql = wave_q(F);
    { const int tpos = 32 * qb + r32; const float* tab = (const float*)(F.ws + WS_ROPE);
#pragma unroll
      for (int h = 0; h < 8; ++h) { float v[4][8]; q32_load(qp + h * 64, v); q32_xf(v, nullptr, true, tpos, 1.f, hi, tab);
#pragma unroll
          for (int ks = 0; ks < 4; ++ks) { const bf16x8 f = q32_pack(v[ks]); if (h < 4) qf[h & 3][ks] = f; else ql[((h & 3) * 4 + ks) * 64] = f; } } }
    LDS_WAIT(); asm volatile("" ::: "memory");
    float iw[8];
    { const v4u w = *(const GAS v4u*)(PROJ + (size_t)row * DSA_LD + DSA_IW); iw[0] = bflo(w.x); iw[1] = bfhi(w.x); iw[2] = bflo(w.y); iw[3] = bfhi(w.y); iw[4] = bflo(w.z); iw[5] = bfhi(w.z); iw[6] = bflo(w.w); iw[7] = bfhi(w.w); }
    const int kperm = (r32 & 0x13) | ((r32 & 4) << 1) | ((r32 & 8) >> 1);
    const bf16* kp = PROJ + (size_t)(b * SEQ + kperm) * DSA_LD + DSA_IK + 8 * hi;
    _Float16* sc = (_Float16*)(F.ws + WS_SC) + (size_t)row * SEQ + 8 * hi;
    const int kt1 = (8 * kc + 8 < qb + 1) ? 8 * kc + 8 : qb + 1;
    bf16x8 kf[4], kfn[4];
#pragma unroll
    for (int ks = 0; ks < 4; ++ks) kf[ks] = ld8(kp + (size_t)(32 * (8 * kc)) * DSA_LD + 16 * ks);
#pragma unroll 1
    for (int kt = 8 * kc; kt < kt1; ++kt) {
        { const int ktn = kt + 1 < kt1 ? kt + 1 : kt;
#pragma unroll
          for (int ks = 0; ks < 4; ++ks) kfn[ks] = ld8(kp + (size_t)(32 * ktn) * DSA_LD + 16 * ks); }
        float s[16];
#pragma unroll
        for (int r = 0; r < 16; ++r) s[r] = 0.f;
#pragma unroll
        for (int h = 0; h < 8; ++h) { f32x16 acc;
#pragma unroll
            for (int r = 0; r < 16; ++r) acc[r] = 0.f;
#pragma unroll
            for (int ks = 0; ks < 4; ++ks) acc = __builtin_amdgcn_mfma_f32_32x32x16_bf16(kf[ks], h < 4 ? qf[h & 3][ks] : ql[((h & 3) * 4 + ks) * 64], acc, 0, 0, 0);
#pragma unroll
            for (int r = 0; r < 16; ++r) s[r] += iw[h] * fmaxf(acc[r], 0.f);
            __builtin_amdgcn_sched_barrier(0); }
        v4u o0, o1; o0.x = pkh(s[0], s[1]); o0.y = pkh(s[2], s[3]); o0.z = pkh(s[4], s[5]); o0.w = pkh(s[6], s[7]);
        o1.x = pkh(s[8], s[9]); o1.y = pkh(s[10], s[11]); o1.z = pkh(s[12], s[13]); o1.w = pkh(s[14], s[15]);
        *(GAS v4u*)(sc + 32 * kt) = o0; *(GAS v4u*)(sc + 32 * kt + 16) = o1;
#pragma unroll
        for (int ks = 0; ks < 4; ++ks) kf[ks] = kfn[ks];
    }
}
__device__ __forceinline__ int hist_select(LAS unsigned* hist, const unsigned (&key)[32], bool lvl2, unsigned B, int target, int lane) {
    { unsigned z = 0u; asm volatile("" : "+v"(z)); *(LAS v4u*)(hist + 4 * lane) = (v4u){z, z, z, z}; }
    LDS_WAIT(); asm volatile("" ::: "memory");
#pragma unroll
    for (int e = 0; e < 32; ++e) { const unsigned d = lvl2 ? (key[e] & 255u) : (key[e] >> 8); const bool m = lvl2 ? ((key[e] >> 8) == B) : true;
        if (m) __hip_atomic_fetch_add(hist + d, 1u, __ATOMIC_RELAXED, __HIP_MEMORY_SCOPE_WAVEFRONT); }
    LDS_WAIT(); asm volatile("" ::: "memory");
    const v4u c = *(LAS v4u*)(hist + 4 * lane);
    const int s = (int)(c.x + c.y + c.z + c.w);
    int S = s;
#pragma unroll
    for (int o = 1; o < 64; o <<= 1) { const int v = __shfl_down(S, o); if (lane + o < 64) S += v; }
    const unsigned long long bm = __ballot(S >= target);
    const int Ls = 63 - __clzll(bm);
    int a = S - s, dig, abv;
    if (a + (int)c.w >= target) { dig = 3; abv = a; } else { a += (int)c.w;
        if (a + (int)c.z >= target) { dig = 2; abv = a; } else { a += (int)c.z;
            if (a + (int)c.y >= target) { dig = 1; abv = a; } else { a += (int)c.y; dig = 0; abv = a; } } }
    const int packed = ((4 * lane + dig) << 12) | abv;
    const int r = __shfl(packed, Ls);
    LDS_WAIT(); asm volatile("" ::: "memory");
    return r;
}
__device__ __forceinline__ void d2_load(Frame& F, int row, v4u (&raw)[4]) {
    const int t = row % SEQ, lane = F.lane;
    const unsigned short* sp = (const unsigned short*)(F.ws + WS_SC) + (size_t)row * SEQ + (32 * lane <= t ? 32 * lane : 0);
#pragma unroll
    for (int i = 0; i < 4; ++i) raw[i] = *(const GAS v4u*)(sp + 8 * i);
}
__device__ __forceinline__ void dsa_d2_row(Frame& F, int row, const v4u (&raw)[4]) {
    const int t = row % SEQ, lane = F.lane;
    unsigned* mbp = (unsigned*)(F.ws + WS_MB) + (size_t)row * 64;
    int nvalid = t + 1 - 32 * lane; nvalid = nvalid < 0 ? 0 : (nvalid > 32 ? 32 : nvalid);
    const unsigned cb = nvalid == 32 ? 0xffffffffu : ((1u << nvalid) - 1u);
    if (t < 256) { mbp[lane] = cb; return; }
    unsigned key[32];
#pragma unroll
    for (int i = 0; i < 4; ++i) { const unsigned w[4] = {raw[i].x, raw[i].y, raw[i].z, raw[i].w};
#pragma unroll
        for (int j = 0; j < 4; ++j) {
#pragma unroll
            for (int k = 0; k < 2; ++k) { const int e = 8 * i + 2 * j + k; const unsigned u = (w[j] >> (16 * k)) & 0xffffu;
                const unsigned sk = (u & 0x8000u) ? (~u & 0xffffu) : (u | 0x8000u);
                key[e] = (e < nvalid) ? sk : 0u; } } }
    LAS unsigned* hist = (LAS unsigned*)(F.lds + F.wave * 16384);
    const int d1 = hist_select(hist, key, false, 0u, 256, lane);
    const unsigned Bh = (unsigned)d1 >> 12; const int above1 = d1 & 0xfff;
    const int d2 = hist_select(hist, key, true, Bh, 256 - above1, lane);
    const unsigned T = (Bh << 8) | ((unsigned)d2 >> 12);
    const int cgt = above1 + (d2 & 0xfff);
    unsigned g = 0, eq = 0;
#pragma unroll
    for (int e = 0; e < 32; ++e) { unsigned bg = key[e] > T ? 1u : 0u, be = key[e] == T ? 1u : 0u; asm volatile("" : "+v"(bg), "+v"(be));
        g |= bg << e; eq |= be << e; }
    const int need = 256 - cgt; const int myeq = __popc(eq);
    int incl = myeq;
#pragma unroll
    for (int o = 1; o < 64; o <<= 1) { const int v = __shfl_up(incl, o); if (lane >= o) incl += v; }
    const int pre = incl - myeq; int take = need - pre; take = take < 0 ? 0 : (take > myeq ? myeq : take);
    unsigned te = eq; int cnt = myeq;
    while (cnt > take) { te &= ~(1u << (31 - __clz(te))); --cnt; }
    mbp[lane] = (g | te) & cb;
}
__device__ __forceinline__ void dsa_d3_task(Frame& F, int task, const bf16* PROJ) {
    const int hg = task & 3, qb = 63 - ((task >> 2) & 63), b = task >> 8; const int r32 = F.lane & 31;
    const int row0 = b * SEQ + 32 * qb;
    const bf16* qrow[3]; const unsigned* mbr[3];
#pragma unroll
    for (int s = 0; s < 3; ++s) { qrow[s] = PROJ + (size_t)(row0 + r32) * DSA_LD + DSA_Q + (3 * hg + s) * 64; mbr[s] = (const unsigned*)(F.ws + WS_MB) + (size_t)(row0 + r32) * 64; }
    LAS bf16x8* ql = wave_q(F); stage_q<3>(ql, qrow, F.lane);
    KVp kv{PROJ + (size_t)(b * SEQ) * DSA_LD + DSA_K, DSA_LD, (const bf16*)F.out + (size_t)b * 64 * SEQ, SEQ};
    f32x16 O[3][2]; float l[3]; zero_o<3, 2>(O, l);
    MaskArg ma{}; ma.q0[0] = ma.q0[1] = ma.q0[2] = 32 * qb;
    const float negb = 0.f;
    attn_core<3, 2, 0, MK_BITS, 2>(ql, kv, 0, qb + 1, negb, ma, mbr, O, l, F.lane);
    bf16* Y = (bf16*)(F.ws + WS_Y);
#pragma unroll
    for (int s = 0; s < 3; ++s) { const float lt = l[s] + __shfl_xor(l[s], 32); store_o<2, false>(O[s], (DBG_ZERO & 2) ? 0.f : 1.f / lt, Y, row0, (3 * hg + s) * 64, F.lane); }
}

constexpr unsigned D3_MOFF = 98304u, D3_ROFF = 98304u + 64u * 65u * 4u;
__device__ __forceinline__ void dsa_d3_wg_task(Frame& F, int task, const bf16* PROJ) {
    const int qb = 31 - (task & 31), b = task >> 5, w = F.wave, qs = w >> 2, hg = w & 3; const int r32 = F.lane & 31, hi = F.lane >> 5;
    const int row0 = b * SEQ + 64 * qb + 32 * qs;
    const bf16* qrow[3];
#pragma unroll
    for (int s = 0; s < 3; ++s) qrow[s] = PROJ + (size_t)(row0 + r32) * DSA_LD + DSA_Q + (3 * hg + s) * 64;
    LAS bf16x8* ql = (LAS bf16x8*)(F.lds + w * 12288) + F.lane; { const int tq_ = 64 * qb + 32 * qs + r32; const int tp[3] = {tq_, tq_, tq_}; stage_q_xf<3>(F, ql, qrow, tp, F.ka->in[14], true, QSCALE); }
    { const unsigned* mb = (const unsigned*)(F.ws + WS_MB) + (size_t)(b * SEQ + 64 * qb) * 64; LAS unsigned* ml = (LAS unsigned*)(F.lds + D3_MOFF);
#pragma unroll
      for (int j = 0; j < 2; ++j) { const int e = (F.tid + 512 * j) * 4, row = e >> 6, col = e & 63; const v4u m = *(const GAS v4u*)(mb + e);
          ml[row * 65 + col] = m.x; ml[row * 65 + col + 1] = m.y; ml[row * 65 + col + 2] = m.z; ml[row * 65 + col + 3] = m.w; } }
    asm volatile("s_waitcnt vmcnt(0) lgkmcnt(0)\n\ts_barrier" ::: "memory");
    const int kperm = (r32 & 0x13) | ((r32 & 4) << 1) | ((r32 & 8) >> 1);
    const bf16* psrc; int pstep;
    if (w < 4) { psrc = PROJ + (size_t)(b * SEQ + kperm) * DSA_LD + DSA_K + 16 * w + 8 * hi; pstep = 32 * DSA_LD; }
    else { const int j = w - 4; psrc = (const bf16*)F.out + ((size_t)b * 64 + 32 * (j >> 1) + r32) * SEQ + 16 * (j & 1) + 8 * hi; pstep = 32; }
    f32x16 O[3][2]; float l[3]; zero_o<3, 2>(O, l);
    MaskArg ma{}; ma.q0[0] = ma.q0[1] = ma.q0[2] = 64 * qb + 32 * qs;
    const LAS unsigned* mlds = (const LAS unsigned*)(F.lds + D3_MOFF) + (qs * 32 + r32) * 65;
    wg_attn<3, MK_BITS, 3>(F, ql, psrc, pstep, D3_ROFF, 0, 2 * qb + 2, 0xffffffffu, 0, 2 * qb + qs + 1, ma, mlds, O, l);
    bf16* Y = (bf16*)(F.ws + WS_Y);
#pragma unroll
    for (int s = 0; s < 3; ++s) { const float lt = l[s] + __shfl_xor(l[s], 32); store_o<2, false>(O[s], (DBG_ZERO & 2) ? 0.f : 1.f / lt, Y, row0, (3 * hg + s) * 64, F.lane); }
}

__device__ __forceinline__ void nsa_cmp_task(Frame& F, int task, const bf16* PROJ, const float* kn0) {
    const int nb = task & 3, g = (task >> 2) & 3, b = task >> 4; const int r32 = F.lane & 31, hi = F.lane >> 5;
    const int n = 32 * nb + r32, nc = n > 126 ? 126 : n;
    const bf16* arow = PROJ + (size_t)(b * SEQ + 16 * nc) * NSA_LD + 64 * g + 8 * hi;
    const bf16* WkT = (const bf16*)(F.ws + WS_CMPW); const bf16* WvT = WkT + 64 * 2048;
    const bf16* wkp = WkT + (size_t)r32 * 2048 + 8 * hi; const bf16* wvp = WvT + (size_t)r32 * 2048 + 8 * hi;
    f32x16 Dk[2], Dv[2];
#pragma unroll
    for (int et = 0; et < 2; ++et)
#pragma unroll
        for (int r = 0; r < 16; ++r) { Dk[et][r] = 0.f; Dv[et][r] = 0.f; }
#pragma unroll 4
    for (int kk = 0; kk < 128; ++kk) {
        const bf16* ap = arow + (size_t)(kk >> 2) * NSA_LD + 16 * (kk & 3);
        const bf16x8 kcf = ld8(ap + NSA_KC), vcf = ld8(ap + NSA_VC);
#pragma unroll
        for (int et = 0; et < 2; ++et) { const bf16x8 wk = ld8(wkp + (size_t)(32 * et) * 2048 + 16 * kk), wv = ld8(wvp + (size_t)(32 * et) * 2048 + 16 * kk);
            Dk[et] = __builtin_amdgcn_mfma_f32_32x32x16_bf16(wk, kcf, Dk[et], 0, 0, 0);
            Dv[et] = __builtin_amdgcn_mfma_f32_32x32x16_bf16(vcf, wv, Dv[et], 0, 0, 0); }
    }
    const float* ck = (const float*)(F.ws + WS_CTL) + CW_CK; const float* cv = ck + 64;
    const float* tab = (const float*)(F.ws + WS_ROPE) + (size_t)(16 * nc + 31) * 64;
    float ss = 0.f;
#pragma unroll
    for (int et = 0; et < 2; ++et)
#pragma unroll
        for (int r = 0; r < 16; ++r) { Dk[et][r] += ck[32 * et + crow(r, hi)]; ss += Dk[et][r] * Dk[et][r]; }
    ss += __shfl_xor(ss, 32);
    const float rs = __builtin_amdgcn_rsqf(ss * (1.f / 64.f) + EPS);
    bf16* kout = (bf16*)(F.ws + WS_KCMP) + ((size_t)((b * 4 + g) * 128 + n)) * 64;
#pragma unroll
    for (int rq = 0; rq < 4; ++rq) { float o0[4], o1[4];
#pragma unroll
        for (int i = 0; i < 4; ++i) { const int r = 4 * rq + i, idx = crow(r, hi); const float v0 = Dk[0][r] * rs * kn0[idx], v1 = Dk[1][r] * rs * kn0[32 + idx];
            const float c = tab[idx], s = tab[32 + idx]; o0[i] = v0 * c - v1 * s; o1[i] = v1 * c + v0 * s; if (n > 126) { o0[i] = 0.f; o1[i] = 0.f; } }
        v2u w0, w1; w0.x = pk2(o0[0], o0[1]); w0.y = pk2(o0[2], o0[3]); w1.x = pk2(o1[0], o1[1]); w1.y = pk2(o1[2], o1[3]);
        *(GAS v2u*)(kout + 8 * rq + 4 * hi) = w0; *(GAS v2u*)(kout + 32 + 8 * rq + 4 * hi) = w1; }
    bf16* vout = (bf16*)(F.ws + WS_VCMPT) + ((size_t)((b * 4 + g) * 64)) * 128 + 32 * nb;
#pragma unroll
    for (int et = 0; et < 2; ++et) { const float cve = cv[32 * et + r32];
#pragma unroll
        for (int rq = 0; rq < 4; ++rq) { float o[4];
#pragma unroll
            for (int i = 0; i < 4; ++i) { const int nl = 8 * rq + 4 * hi + i; o[i] = (32 * nb + nl > 126) ? 0.f : Dv[et][4 * rq + i] + cve; }
            v2u w; w.x = pk2(o[0], o[1]); w.y = pk2(o[2], o[3]);
            *(GAS v2u*)(vout + (size_t)(32 * et + r32) * 128 + 8 * rq + 4 * hi) = w; } }
}
constexpr unsigned NSA_ROFF = 98304u;
template <bool WG>
__device__ NSA_INLINE void nsa_task(KArgs ka_, unsigned char* ws_, float* out_, LAS unsigned char* lds_, int wave_, int task, const bf16* PROJ) {
    Frame F; F.ka = ka_; F.ws = ws_; F.out = out_; F.lds = lds_; F.wave = wave_; F.MISC = (volatile LAS unsigned*)(lds_ + LDS_CTRL + 64);
    asm volatile("v_mbcnt_lo_u32_b32 %0, -1, 0\n\tv_mbcnt_hi_u32_b32 %0, -1, %0" : "=v"(F.lane));
    const int qb8 = 7 - (task & 7);
    const int g = WG ? (task >> 3) & 3 : task & 3, qb = WG ? 8 * qb8 + wave_ : 63 - ((task >> 2) & 63), b = WG ? task >> 5 : task >> 8; const int r32 = F.lane & 31, hi = F.lane >> 5;
    const int row0 = b * SEQ + 32 * qb, tq = 32 * qb + r32;
    const bf16* qrow[3];
#pragma unroll
    for (int s = 0; s < 3; ++s) qrow[s] = PROJ + (size_t)(row0 + r32) * NSA_LD + NSA_Q + (3 * g + s) * 64;
    LAS bf16x8* ql = WG ? (LAS bf16x8*)(F.lds + F.wave * 12288) + F.lane : wave_q(F); { const int tp[3] = {tq, tq, tq}; stage_q_xf<3>(F, ql, qrow, tp, F.ka->in[17], true, QSCALE); }
#define NSA_GATE(s_, c_) (__builtin_amdgcn_rcpf(1.f + fast_exp2(-1.4426950408889634f * bf2f(PROJ[(size_t)(row0 + r32) * NSA_LD + NSA_GT + 9 * g + 3 * (s_) + (c_)]))))
    bf16* Y = (bf16*)(F.ws + WS_Y);
    MaskArg ma{}; ma.q0[0] = ma.q0[1] = ma.q0[2] = 32 * qb; ma.nmax = tq >= 31 ? (tq - 31) >> 4 : -1;
    const KVp kvc{(const bf16*)(F.ws + WS_KCMP) + (size_t)((b * 4 + g) * 128) * 64, 64, (const bf16*)(F.ws + WS_VCMPT) + (size_t)((b * 4 + g) * 64) * 128, 128};
    float imp[16];
#pragma unroll
    for (int r = 0; r < 16; ++r) imp[r] = 0.f;
#ifndef NSA_NO_A
    {   const int kperm = (r32 & 0x13) | ((r32 & 4) << 1) | ((r32 & 8) >> 1);
        const bf16* kp = kvc.K + (size_t)kperm * 64 + 8 * hi;
#pragma unroll 1
        for (int s = 0; s < 3; ++s) { f32x16 ia; float ls = 0.f;
#pragma unroll
            for (int r = 0; r < 16; ++r) ia[r] = 0.f;
#pragma unroll 1
            for (int kt = 0; kt < 4; ++kt) { f32x16 acc;
#pragma unroll
                for (int r = 0; r < 16; ++r) acc[r] = 0.f;
#pragma unroll
                for (int ks = 0; ks < 4; ++ks) acc = __builtin_amdgcn_mfma_f32_32x32x16_bf16(ld8(kp + (size_t)(32 * kt) * 64 + 16 * ks), ql[(s * 4 + ks) * 64], acc, 0, 0, 0);
                float p[16];
#pragma unroll
                for (int r = 0; r < 16; ++r) { const int key = 32 * kt + 8 * hi + 16 * (r >> 3) + (r & 7); p[r] = key <= ma.nmax ? fast_exp2(acc[r]) : 0.f; ls += p[r]; }
#pragma unroll
                for (int ks2 = 0; ks2 < 2; ++ks2) { v4u pw, cw; unsigned short cvv[8];
                    pw.x = pk2(p[8 * ks2], p[8 * ks2 + 1]); pw.y = pk2(p[8 * ks2 + 2], p[8 * ks2 + 3]); pw.z = pk2(p[8 * ks2 + 4], p[8 * ks2 + 5]); pw.w = pk2(p[8 * ks2 + 6], p[8 * ks2 + 7]);
#pragma unroll
                    for (int jj = 0; jj < 8; ++jj) { const int nn = 32 * kt + 16 * ks2 + 8 * hi + jj; cvv[jj] = (nn >= 4 * r32 - 1 && nn <= 4 * r32 + 3) ? 0x3f80 : 0; }
                    cw.x = cvv[0] | (cvv[1] << 16); cw.y = cvv[2] | (cvv[3] << 16); cw.z = cvv[4] | (cvv[5] << 16); cw.w = cvv[6] | (cvv[7] << 16);
                    ia = __builtin_amdgcn_mfma_f32_32x32x16_bf16(__builtin_bit_cast(bf16x8, cw), __builtin_bit_cast(bf16x8, pw), ia, 0, 0, 0); }
            }
            const float lt = ls + __shfl_xor(ls, 32); const float inv = lt > 0.f ? 1.f / lt : 0.f;
#pragma unroll
            for (int r = 0; r < 16; ++r) imp[r] += ia[r] * inv;
        }
    }
#endif
    unsigned sel;
    { const int qblk = tq >> 6;
      if (32 * qb + 31 < 1024) sel = (2u << qblk) - 1u;
      else { float val[16], oth[16];
#pragma unroll
        for (int r = 0; r < 16; ++r) { const int j = crow(r, hi); val[r] = j > qblk ? -1e30f : ((j == 0 || j == qblk || j == qblk - 1) ? 1e9f : imp[r]); oth[r] = __shfl_xor(val[r], 32); }
        unsigned mine = 0;
#pragma unroll
        for (int r = 0; r < 16; ++r) { const int j = crow(r, hi); int rank = 0;
#pragma unroll
            for (int r2 = 0; r2 < 16; ++r2) { const int j2 = crow(r2, hi), j3 = crow(r2, hi ^ 1);
                rank += (val[r2] > val[r] || (val[r2] == val[r] && j2 < j)) ? 1 : 0;
                rank += (oth[r2] > val[r] || (oth[r2] == val[r] && j3 < j)) ? 1 : 0; }
            mine |= ((rank < 16 && j <= qblk) ? 1u : 0u) << ((r & 3) + 8 * (r >> 2)); }
        mine <<= 4 * hi;
        sel = mine | __shfl_xor(mine, 32); } }
    const unsigned* mbr2[2] = {nullptr, nullptr}; const unsigned* mbr1[1] = {nullptr};
    const KVp kvs{PROJ + (size_t)(b * SEQ) * NSA_LD + NSA_KS + 64 * g, NSA_LD, (const bf16*)F.out + ((size_t)b * 256 + 64 * g) * SEQ, SEQ};
    const KVp kvw{PROJ + (size_t)(b * SEQ) * NSA_LD + NSA_KW + 64 * g, NSA_LD, (const bf16*)F.out + (size_t)NB * 256 * SEQ + ((size_t)b * 256 + 64 * g) * SEQ, SEQ};
    ma.sel = sel;
#define NSA_BRANCH(MT_, KV_, KT0_, KT1_, C_, ADD_, ZBIT_) do { \
      { f32x16 O2[2][2]; float l2[2]; zero_o<2, 2>(O2, l2); attn_core<2, 2, 0, MT_>(ql, KV_, KT0_, KT1_, 0.f, ma, mbr2, O2, l2, F.lane); VM_WAIT(); \
        _Pragma("unroll") for (int s = 0; s < 2; ++s) { const float lt = l2[s] + __shfl_xor(l2[s], 32); \
          store_o<2, ADD_>(O2[s], (lt > 0.f && !(DBG_ZERO & ZBIT_)) ? NSA_GATE(s, C_) / lt : 0.f, Y, row0, (3 * g + s) * 64, F.lane); } } \
      { f32x16 O1[1][2]; float l1[1]; zero_o<1, 2>(O1, l1); attn_core<1, 2, 0, MT_>(ql + 2 * 4 * 64, KV_, KT0_, KT1_, 0.f, ma, mbr1, O1, l1, F.lane); VM_WAIT(); \
        const float lt = l1[0] + __shfl_xor(l1[0], 32); \
        store_o<2, ADD_>(O1[0], (lt > 0.f && !(DBG_ZERO & ZBIT_)) ? NSA_GATE(2, C_) / lt : 0.f, Y, row0, (3 * g + 2) * 64, F.lane); } } while (0)
    NSA_BRANCH(MK_CMP, kvc, 0, 4, 0, false, 4);
    if (!WG) {
    NSA_BRANCH(MK_SLC, kvs, 0, qb + 1, 1, true, 16);
    NSA_BRANCH(MK_WIN, kvw, (qb > 16 ? qb - 16 : 0), qb + 1, 2, true, 32);
    } else {
        unsigned wsel = sel;
#pragma unroll
        for (int o = 1; o < 32; o <<= 1) wsel |= __shfl_xor(wsel, o);
        if (F.lane == 0) __hip_atomic_fetch_or((LAS unsigned*)(F.lds + LDS_CTRL + 64) + 17, wsel, __ATOMIC_RELAXED, __HIP_MEMORY_SCOPE_WORKGROUP);
        asm volatile("s_waitcnt vmcnt(0) lgkmcnt(0)\n\ts_barrier" ::: "memory");
        const unsigned blk = (unsigned)__builtin_amdgcn_readfirstlane((int)F.MISC[17]);
        const int kperm = (r32 & 0x13) | ((r32 & 4) << 1) | ((r32 & 8) >> 1), w = F.wave;
#define NSA_WGBRANCH(MT_, KCOL_, VTOFF_, KT0_, KT1_, MY0_, MY1_, BLK_, C_, ZBIT_) do { \
        const bf16* psrc; int pstep; \
        if (w < 4) { psrc = PROJ + (size_t)(b * SEQ + kperm) * NSA_LD + (KCOL_) + 64 * g + 16 * w + 8 * hi; pstep = 32 * NSA_LD; } \
        else { const int j_ = w - 4; psrc = (const bf16*)F.out + (VTOFF_) + ((size_t)b * 256 + 64 * g + 32 * (j_ >> 1) + r32) * SEQ + 16 * (j_ & 1) + 8 * hi; pstep = 32; } \
        f32x16 O3[3][2]; float l3[3]; zero_o<3, 2>(O3, l3); \
        wg_attn<3, MT_, 5>(F, ql, psrc, pstep, NSA_ROFF, KT0_, KT1_, BLK_, MY0_, MY1_, ma, (const LAS unsigned*)nullptr, O3, l3); \
        _Pragma("unroll") for (int s = 0; s < 3; ++s) { const float lt = l3[s] + __shfl_xor(l3[s], 32); \
          store_o<2, true>(O3[s], (lt > 0.f && !(DBG_ZERO & ZBIT_)) ? NSA_GATE(s, C_) / lt : 0.f, Y, row0, (3 * g + s) * 64, F.lane); } } while (0)
        NSA_WGBRANCH(MK_SLC, NSA_KS, (size_t)0, 0, 8 * qb8 + 8, 0, qb + 1, blk, 1, 16);
        NSA_WGBRANCH(MK_WIN, NSA_KW, (size_t)NB * 256 * SEQ, (8 * qb8 > 16 ? 8 * qb8 - 16 : 0), 8 * qb8 + 8, (qb > 16 ? qb - 16 : 0), qb + 1, 0xffffffffu, 2, 32);
#undef NSA_WGBRANCH
    }
#undef NSA_BRANCH
}
__device__ __forceinline__ void prologue_misc(Frame& F) {
    float* tab = (float*)(F.ws + WS_ROPE);
    for (int idx = blockIdx.x * (NWAVES * 64) + F.tid; idx < SEQ * 32; idx += F.G * NWAVES * 64) {
        const int t = idx >> 5, i = idx & 31;
        const float inv = exp2f(-(float)i * (13.287712379549449f / 32.0f));
        const float ang = (float)t * inv; float s, c; sincosf(ang, &s, &c);
        tab[t * 64 + i] = c; tab[t * 64 + 32 + i] = s; }
    if (blockIdx.x < 4) {
        const int kv = F.wave & 1, part = blockIdx.x * 4 + (F.wave >> 1);
        const float* pos = kv ? F.ka->in[20] : F.ka->in[19]; const float* w = kv ? F.ka->in[22] : F.ka->in[21]; float a = 0.f;
#pragma unroll 8
        for (int i = part * 128; i < part * 128 + 128; ++i) a += pos[i] * w[(size_t)i * 64 + F.lane];
        atomicAdd((float*)(F.ws + WS_CTL) + CW_CK + 64 * kv + F.lane, a);
    }
}
__device__ __forceinline__ void prologue_phase(Frame& F) {
    prologue_misc(F);
    bf16* XB = (bf16*)(F.ws + WS_XB); float* PART = (float*)(F.ws + WS_PART);
    for (int m = F.gw; m < MTOK; m += F.NGW) row_to_bf16(F, F.ka->in[0] + (size_t)m * DM, XB + (size_t)m * DM, PART + (size_t)m * 16);
    bf16* MEMB = (bf16*)(F.ws + WS_MEMB); float* PARTM = (float*)(F.ws + WS_PARTM);
    for (int m = F.gw; m < MMEM; m += F.NGW) row_to_bf16(F, F.ka->in[1] + (size_t)m * DM, MEMB + (size_t)m * DM, PARTM + (size_t)m * 16);
    int itb = 0;
#pragma unroll 1
    for (int ly = 0; ly < DEPTH; ++ly) cvt_matrix(F, itb, F.ka->in[9] + (size_t)ly * DM * 512, nullptr, 512, 512, F.ka->in[8] + (size_t)ly * DM, (bf16*)(F.ws + WS_WKV) + (size_t)ly * 512 * DM, DM, 512, 0);
    cvt_matrix(F, itb, F.ka->in[21], nullptr, 64, 64, nullptr, (bf16*)(F.ws + WS_CMPW), 2048, 64, 0);
    cvt_matrix(F, itb, F.ka->in[22], nullptr, 64, 64, nullptr, (bf16*)(F.ws + WS_CMPW) + 64 * 2048, 2048, 64, 0);
    convert_layer(F, 0);
}

template <unsigned PHASE_MASK> __global__ void __launch_bounds__(NWAVES * 64, 2) mk_fwd(Args args) {
    extern __shared__ __attribute__((aligned(16))) unsigned char lds[];
    Frame F;
    F.lds = (LAS unsigned char*)lds;
    F.MISC = (volatile LAS unsigned*)(F.lds + LDS_CTRL + 64);
    F.tid = threadIdx.x; F.lane = F.tid & 63; F.wave = __builtin_amdgcn_readfirstlane(F.tid >> 6);
    F.G = gridDim.x; F.gw = blockIdx.x * NWAVES + F.wave; F.NGW = F.G * NWAVES;
    F.ws = args.ws; F.ctl = (gu32*)(args.ws + WS_CTL); F.out = args.out;
    F.ka = (KArgs)__builtin_amdgcn_kernarg_segment_ptr();
    for (int u = F.tid; u < 1024 / 4; u += NWAVES * 64) ((LAS unsigned*)(F.lds + LDS_CTRL))[u] = 0u;
    __syncthreads();
    XcdBarrier bar = xcd_barrier_post((unsigned*)(F.ctl + CW_BAR), F.MISC + 8);
    constexpr bool ALLPH = PHASE_MASK == 0xffffffffu;
    const int lo = ALLPH ? 0 : args.ph_lo, hi = ALLPH ? 0 : args.ph_hi; int pc = 0;
    const bool dry = ALLPH ? false : (args.dry != 0);
#define PH_BEGIN(id) if (ALLPH || ((((PHASE_MASK) >> (id)) & 1u) && lo <= pc && pc < hi)) { asm volatile("" : "+s"(F.ka), "+s"(F.ws), "+s"(F.out), "+s"(F.gw), "+s"(F.NGW), "+s"(F.G), "+s"(F.wave)); asm volatile("v_mbcnt_lo_u32_b32 %0, -1, 0\n\tv_mbcnt_hi_u32_b32 %0, -1, %0" : "=v"(F.lane)); F.tid = F.wave * 64 + F.lane;
#define PH_END_(islast)   if (ALLPH ? !(islast) : (pc + 1 < hi)) { XcdBarrier b2_ = bar; asm volatile("" : "+s"(b2_.bar), "+s"(b2_.x)); xcd_barrier(b2_); } } if (!ALLPH) ++pc;
#define PH_END PH_END_(false)
#define QCTR(i) (F.ctl + CW_Q + 64 * (i))

#define XB ((bf16*)(F.ws + WS_XB))
#define VTB ((bf16*)F.out)
#define Yb ((bf16*)(F.ws + WS_Y))
#define HID ((bf16*)(F.ws + WS_HID))
#define PART ((float*)(F.ws + WS_PART))
    LAS unsigned char* ring = F.lds;

    PH_BEGIN(0) prologue_phase(F); PH_END
    PH_BEGIN(1) { pg8::Gemm g{(const bf16*)(F.ws + WS_MEMB), (const bf16*)(F.ws + WS_WKV), MMEM, 2048, DM}; pg8::StaticOrder S; S.init(MMEM, 2048, F.G, (int)blockIdx.x);
        pg8::EpiScale E{(bf16*)(F.ws + WS_MKV), 2048, (const float*)(F.ws + WS_PARTM)};
        pg8::gemm_phase<pg8::EpiScale, pg8::StaticOrder, true, true>(ring, g, S, E, F.wave); } PH_END
    PH_BEGIN(2)
#pragma unroll 1
        for (int ly = 0; ly < DEPTH; ++ly) {
            xform(F, (const bf16*)(F.ws + WS_MKV), 2048, ly * 512, 4, MMEM, NMEMT, (bf16*)(F.ws + WS_MK) + (size_t)ly * NB * 4 * NMEMT * 64, 1, 0, 0, F.ka->in[11] + ly * 64, false, 1.f, 0);
            transpose_cols(F, (const bf16*)(F.ws + WS_MKV), 2048, ly * 512 + 256, 256, NB, NMEMT, (bf16*)(F.ws + WS_MVT) + (size_t)ly * NB * 256 * NMEMT);
        }
    PH_END

#pragma unroll 1
    for (int Ly = 0; Ly < DEPTH; ++Ly) {
#define WB ((const bf16*)(F.ws + WS_WBUF0 + (size_t)(Ly & 1) * WBUF_BYTES))
        const int kind = Ly % 3;
        const int ldp = kind == 0 ? RET_LD : (kind == 1 ? DSA_LD : NSA_LD);
        PH_BEGIN(3) { pg8::Gemm g{XB, WB + WB_W1A, MTOK, 2 * FF, DM}; pg8::StaticOrder S; S.init(MTOK, 2 * FF, F.G, (int)blockIdx.x);
            pg8::EpiSwiglu E{HID, FF, PART, dry ? DRY_MODE : 0};
            pg8::gemm_phase<pg8::EpiSwiglu, pg8::StaticOrder, true, true>(ring, g, S, E, F.wave); } PH_END
        PH_BEGIN(4) { pg8::Gemm g{HID, WB + WB_W2A, MTOK, DM, FF}; pg8::StaticOrder S; S.init(MTOK, DM, F.G, (int)blockIdx.x);
            pg8::EpiResid E{XB, XB, nullptr, PART, dry ? 0.f : 0.5f};
            pg8::gemm_phase<pg8::EpiResid, pg8::StaticOrder, true, true>(ring, g, S, E, F.wave); } PH_END
        PH_BEGIN(5) { pg8::Gemm g{XB, WB + WB_WIN, MTOK, ldp, DM}; pg8::StaticOrder S; S.init(MTOK, ldp, F.G, (int)blockIdx.x);
            pg8::EpiScale E{HID, ldp, PART};
            pg8::gemm_phase<pg8::EpiScale, pg8::StaticOrder, true, true>(ring, g, S, E, F.wave); } PH_END
        PH_BEGIN(6)
#define DO_X (!dry || DRY_MODE == 0 || DRY_MODE == 11)
#define DO_T (!dry || DRY_MODE == 0 || DRY_MODE == 12)
#define DO_C (!dry || DRY_MODE == 0 || DRY_MODE == 13)
            if (kind == 0) {
                if (DO_X) xform(F, HID, ldp, RET_K, 6, MTOK, SEQ, (dry ? Yb : HID), 0, (dry ? 1024 : ldp), (dry ? 0 : RET_K), nullptr, true, 0.125f, RET_MODE == 1 ? -1 : 0);
                if (DO_T) transpose_cols(F, HID, ldp, RET_V, 768, NB, SEQ, VTB);
            } else if (kind == 1) {
                if (DO_X) xform(F, HID, ldp, DSA_K, 1, MTOK, SEQ, (dry ? Yb : HID), 0, (dry ? 1024 : ldp), (dry ? 0 : DSA_K), F.ka->in[15], true, 1.f, 0);
                if (DO_X) xform(F, HID, ldp, DSA_IK, 1, MTOK, SEQ, (dry ? Yb : HID), 0, (dry ? 1024 : ldp), (dry ? 0 : DSA_IK), nullptr, true, 1.f, 0);
                if (DO_T) transpose_cols(F, HID, ldp, DSA_V, 64, NB, SEQ, VTB);
            } else {
                if (DO_X) xform(F, HID, ldp, NSA_KS, 4, MTOK, SEQ, (dry ? Yb : HID), 0, (dry ? 1024 : ldp), (dry ? 0 : NSA_KS), F.ka->in[18] + 64, true, 1.f, 0);
                if (DO_X) xform(F, HID, ldp, NSA_KW, 4, MTOK, SEQ, (dry ? Yb : HID), 0, (dry ? 1024 : ldp), (dry ? 0 : NSA_KW), F.ka->in[18] + 128, true, 1.f, 0);
                if (DO_T) transpose_cols(F, HID, ldp, NSA_VS, 256, NB, SEQ, VTB);
                if (DO_T) transpose_cols(F, HID, ldp, NSA_VW, 256, NB, SEQ, VTB + (size_t)NB * 256 * SEQ);
                if (DO_T) for (int t = F.gw; t < 256; t += F.NGW) nsa_cmp_task(F, t, HID, F.ka->in[18]);
            }
            if (DO_C && Ly + 1 < DEPTH) convert_layer(F, Ly + 1);
#undef DO_X
#undef DO_T
#undef DO_C
        PH_END
        if (kind == 0) {
            PH_BEGIN(7)
                for (;;) {
                    asm volatile("s_waitcnt vmcnt(0) lgkmcnt(0)\n\ts_barrier" ::: "memory");
                    if (F.tid == 0) F.MISC[16] = __hip_atomic_fetch_add(QCTR(Ly * 8 + 3), 1u, RLX_AGENT);
                    asm volatile("s_waitcnt vmcnt(0) lgkmcnt(0)\n\ts_barrier" ::: "memory");
                    const int t = __builtin_amdgcn_readfirstlane((int)F.MISC[16]);
                    if (t >= NB * 6 * 8) break;
                    asm volatile("v_mbcnt_lo_u32_b32 %0, -1, 0\n\tv_mbcnt_hi_u32_b32 %0, -1, %0" : "=v"(F.lane));
                    ret_wg_task(F, t, HID);
                }
                for (;;) { asm volatile("v_mbcnt_lo_u32_b32 %0, -1, 0\n\tv_mbcnt_hi_u32_b32 %0, -1, %0" : "=v"(F.lane)); const int t = grab(QCTR(Ly * 8 + 0), F.lane) + (RET_WG ? 3072 : 0); if (t >= 3072 + 2048) break; mem_task(F, t - 3072, Ly, HID, ldp, RET_QM); }
            PH_END
        } else if (kind == 1) {
            PH_BEGIN(8)
                for (;;) { asm volatile("v_mbcnt_lo_u32_b32 %0, -1, 0\n\tv_mbcnt_hi_u32_b32 %0, -1, %0" : "=v"(F.lane)); const int t = grab(QCTR(Ly * 8 + 0), F.lane); if (t >= 4608 + 2048) break; if (t < 4608) dsa_d1_task(F, t, HID); else mem_task(F, t - 4608, Ly, HID, ldp, DSA_QM); }
            PH_END
            PH_BEGIN(9)
                for (;;) { asm volatile("v_mbcnt_lo_u32_b32 %0, -1, 0\n\tv_mbcnt_hi_u32_b32 %0, -1, %0" : "=v"(F.lane)); const int t = grab(QCTR(Ly * 8 + 1), F.lane); if (t >= MTOK / 8) break;
{ v4u ra[4], rb[4]; d2_load(F, MTOK - 1 - 8 * t, ra);
#pragma unroll 1
                      for (int i = 0; i < 8; i += 2) { d2_load(F, MTOK - 1 - (8 * t + i + 1), rb); dsa_d2_row(F, MTOK - 1 - (8 * t + i), ra);
                          if (i + 2 < 8) d2_load(F, MTOK - 1 - (8 * t + i + 2), ra); dsa_d2_row(F, MTOK - 1 - (8 * t + i + 1), rb); } } }
            PH_END
            PH_BEGIN(10)
                                for (;;) {
                    asm volatile("s_waitcnt vmcnt(0) lgkmcnt(0)\n\ts_barrier" ::: "memory");
                    if (F.tid == 0) F.MISC[16] = __hip_atomic_fetch_add(QCTR(Ly * 8 + 3), 1u, RLX_AGENT);
                    asm volatile("s_waitcnt vmcnt(0) lgkmcnt(0)\n\ts_barrier" ::: "memory");
                    const int t = __builtin_amdgcn_readfirstlane((int)F.MISC[16]);
                    if (t >= NB * 32) break;
                    asm volatile("v_mbcnt_lo_u32_b32 %0, -1, 0\n\tv_mbcnt_hi_u32_b32 %0, -1, %0" : "=v"(F.lane)); F.tid = F.wave * 64 + F.lane;
                    dsa_d3_wg_task(F, t, HID);
                }

            PH_END
        } else {
            PH_BEGIN(11)
                for (;;) {
                    asm volatile("s_waitcnt vmcnt(0) lgkmcnt(0)\n\ts_barrier" ::: "memory");
                    if (F.tid == 0) { F.MISC[16] = __hip_atomic_fetch_add(QCTR(Ly * 8 + 3), 1u, RLX_AGENT); F.MISC[17] = 0u; }
                    asm volatile("s_waitcnt vmcnt(0) lgkmcnt(0)\n\ts_barrier" ::: "memory");
                    const int t = __builtin_amdgcn_readfirstlane((int)F.MISC[16]);
                    if (t >= NB * 4 * 8) break;
                    nsa_task<true>(F.ka, F.ws, F.out, F.lds, F.wave, t, HID);
                }
                for (;;) { asm volatile("v_mbcnt_lo_u32_b32 %0, -1, 0\n\tv_mbcnt_hi_u32_b32 %0, -1, %0" : "=v"(F.lane)); const int t = grab(QCTR(Ly * 8 + 0), F.lane) + (NSA_WG ? 4096 : 0); if (t >= 4096 + 2048) break; mem_task(F, t - 4096, Ly, HID, ldp, NSA_QM); }
            PH_END
        }
        PH_BEGIN(12) { pg8::Gemm g{Yb, WB + WB_WO, MTOK, DM, DM}; pg8::StaticOrder S; S.init(MTOK, DM, F.G, (int)blockIdx.x);
            pg8::EpiResid E{XB, XB, nullptr, PART, dry ? 0.f : 1.0f};
            pg8::gemm_phase<pg8::EpiResid, pg8::StaticOrder, true, true>(ring, g, S, E, F.wave); } PH_END
        PH_BEGIN(13) { pg8::Gemm g{XB, WB + WB_W1B, MTOK, 2 * FF, DM}; pg8::StaticOrder S; S.init(MTOK, 2 * FF, F.G, (int)blockIdx.x);
            pg8::EpiSwiglu E{HID, FF, PART, dry ? DRY_MODE : 0};
            pg8::gemm_phase<pg8::EpiSwiglu, pg8::StaticOrder, true, true>(ring, g, S, E, F.wave); } PH_END
        PH_BEGIN(14) { pg8::Gemm g{HID, WB + WB_W2B, MTOK, DM, FF}; pg8::StaticOrder S; S.init(MTOK, DM, F.G, (int)blockIdx.x);
            pg8::EpiResid E{XB, XB, Ly == DEPTH - 1 ? F.out : nullptr, PART, dry ? 0.f : 0.5f};
            pg8::gemm_phase<pg8::EpiResid, pg8::StaticOrder, true, true>(ring, g, S, E, F.wave); } PH_END_(Ly == DEPTH - 1)
    }
#undef XB
#undef VTB
#undef Yb
#undef HID
#undef PART
#undef WB
#undef PH_BEGIN
#undef PH_END
#undef PH_END_
}

constexpr int LDS_BYTES = 147456;
#ifndef MK_PER_PHASE
#define MK_PER_PHASE 0
#endif
typedef void (*kern_t)(Args);
template <unsigned M> static kern_t kern_of() { return mk_fwd<M>; }
#if MK_PER_PHASE
static kern_t phase_kernel(int id) {
    switch (id) {
        case 0: return kern_of<1u << 0>(); case 1: return kern_of<1u << 1>(); case 2: return kern_of<1u << 2>(); case 3: return kern_of<1u << 3>(); case 4: return kern_of<1u << 4>();
        case 5: return kern_of<1u << 5>(); case 6: return kern_of<1u << 6>(); case 7: return kern_of<1u << 7>(); case 8: return kern_of<1u << 8>(); case 9: return kern_of<1u << 9>();
        case 10: return kern_of<1u << 10>(); case 11: return kern_of<1u << 11>(); case 12: return kern_of<1u << 12>(); case 13: return kern_of<1u << 13>(); default: return kern_of<1u << 14>();
    }
}
#endif
extern "C" void kernel_launch(void* const* d_in, const int* in_sizes, int n_in, void* d_out, int out_size, void* d_ws, size_t ws_size, hipStream_t stream) {
    static int grid = 0;
    if (grid == 0) {
        if (n_in != 23 || out_size != MTOK * DM || ws_size < WS_END) { fprintf(stderr, "kernel_launch: unexpected shapes (n_in %d, out %d, ws %zu)\n", n_in, out_size, ws_size); grid = -1; return; }
        int dev = 0, cus = 0;
        if (hipGetDevice(&dev) != hipSuccess || hipDeviceGetAttribute(&cus, hipDeviceAttributeMultiprocessorCount, dev) != hipSuccess) { grid = -1; return; }
#if MK_PER_PHASE
        for (int id = 0; id < 15; ++id) if (hipFuncSetAttribute((const void*)phase_kernel(id), hipFuncAttributeMaxDynamicSharedMemorySize, LDS_BYTES) != hipSuccess) { fprintf(stderr, "kernel_launch: hipFuncSetAttribute failed\n"); grid = -1; return; }
#else
        if (hipFuncSetAttribute((const void*)kern_of<0xffffffffu>(), hipFuncAttributeMaxDynamicSharedMemorySize, LDS_BYTES) != hipSuccess) { fprintf(stderr, "kernel_launch: hipFuncSetAttribute failed\n"); grid = -1; return; }
#endif
        (void)hipGetLastError();
        grid = cus;
    }
    if (grid < 0) return;
    if (hipMemsetAsync((char*)d_ws + WS_CTL, 0, CTL_ZERO_BYTES, stream) != hipSuccess) return;
    Args a{};
    for (int i = 0; i < 23; ++i) a.in[i] = (const float*)d_in[i];
    a.out = (float*)d_out; a.ws = (unsigned char*)d_ws;
    constexpr int NPH = 3 + 8 * DEPTH + 2;
#if MK_PER_PHASE
    int ids[NPH]; int n = 0; ids[n++] = 0; ids[n++] = 1; ids[n++] = 2;
    for (int ly = 0; ly < DEPTH; ++ly) { ids[n++] = 3; ids[n++] = 4; ids[n++] = 5; ids[n++] = 6;
        if (ly % 3 == 0) ids[n++] = 7; else if (ly % 3 == 1) { ids[n++] = 8; ids[n++] = 9; ids[n++] = 10; } else ids[n++] = 11;
        ids[n++] = 12; ids[n++] = 13; ids[n++] = 14; }
    for (int p = 0; p < NPH; ++p) { a.ph_lo = p; a.ph_hi = p + 1;
#if PROBE_DUP
        if ((PROBE_DUP >> ids[p]) & 1) {
            a.dry = 1; hipLaunchKernelGGL(phase_kernel(ids[p]), dim3(grid), dim3(NWAVES * 64), LDS_BYTES, stream, a); a.dry = 0;
            hipMemsetAsync((char*)d_ws + WS_CTL + CW_Q * 4, 0, 64 * 4 * 64, stream); }
#endif
        hipLaunchKernelGGL(phase_kernel(ids[p]), dim3(grid), dim3(NWAVES * 64), LDS_BYTES, stream, a);
    }
#else
    a.ph_lo = 0; a.ph_hi = NPH; hipLaunchKernelGGL(kern_of<0xffffffffu>(), dim3(grid), dim3(NWAVES * 64), LDS_BYTES, stream, a);
#endif
}
```

```cpp
#include <hip/hip_runtime.h>
#include <cstdio>
#include <cstdint>
namespace pg8 {
#define PG8_LAS __attribute__((address_space(3)))
typedef unsigned short bf16_t;
typedef short bf16x8 __attribute__((ext_vector_type(8)));
typedef float f32x4 __attribute__((ext_vector_type(4)));
typedef unsigned u32x4 __attribute__((ext_vector_type(4)));
constexpr int BM = 256, BK = 64, HALF = 128, HTB = HALF * BK * 2  , STAGE_BYTES = 8 * HTB, NXCD = 8, WGM = 8;

__host__ __device__ __forceinline__ int lds_byte(int r, int c) { const int st = (r >> 4) * 2 + (c >> 5), rr = r & 15, cc = c & 31, ob = rr * 64 + cc * 2; return st * 1024 + (ob ^ (((ob >> 9) & 1) << 5)); }
__host__ __device__ __forceinline__ void stage_rc(int b, int& R, int& C) { const int st = b / 1024, sb = b % 1024, swz = sb ^ (((sb >> 9) & 1) << 5); R = (st >> 1) * 16 + swz / 64; C = (st & 1) * 32 + (swz % 64) / 2; }
__host__ __device__ __forceinline__ int perm32(int rho) { const int n = rho >> 4, i = rho & 15; return 8 * (i >> 2) + 4 * n + (i & 3); }

struct Unit { int pm, pn; };
struct Gemm { const bf16_t* A; const bf16_t* Bt; int M, N, K; };

struct StaticOrder {
    int nM, nN, nwg, G, c;
    __host__ __device__ void init(int M, int N, int G_, int c_) { nM = M / BM; nN = N / BM; nwg = nM * nN; G = G_; c = c_; }
    __host__ __device__ bool next(int i, Unit& u) const {
        const long L = (long)i * G + c; if (L >= nwg) return false;
        int wgid = (int)L; { const int q = nwg / NXCD, r = nwg % NXCD, xcd = wgid % NXCD, off = wgid / NXCD; wgid = (xcd < r ? xcd * (q + 1) : r * (q + 1) + (xcd - r) * q) + off; }
        const int nig = WGM * nN, gid = wgid / nig, fm = gid * WGM, gsz = (nM - fm) < WGM ? (nM - fm) : WGM;
        u.pm = fm + ((wgid % nig) % gsz); u.pn = (wgid % nig) / gsz; return true;
    }
    __device__ __forceinline__ void a_ready(const Unit&) const {}
    __device__ __forceinline__ void done(const Unit&) const {}
};

__device__ __forceinline__ int lane_now() { int l; asm volatile("v_mbcnt_lo_u32_b32 %0, -1, 0\n\tv_mbcnt_hi_u32_b32 %0, -1, %0" : "=v"(l)); return l; }
__device__ __forceinline__ float shfl_idx_(float v, int src) { return __builtin_bit_cast(float, __builtin_amdgcn_ds_bpermute(src << 2, __builtin_bit_cast(int, v))); }
__device__ __forceinline__ int shfl_idx_(int v, int src) { return __builtin_amdgcn_ds_bpermute(src << 2, v); }
__device__ __forceinline__ unsigned shfl_idx_(unsigned v, int src) { return (unsigned)__builtin_amdgcn_ds_bpermute(src << 2, (int)v); }
#define __shfl_xor(v, o) pg8::shfl_idx_((v), pg8::lane_now() ^ (o))
#define __shfl(v, src) pg8::shfl_idx_((v), (src))
#define __shfl_down(v, o) pg8::shfl_idx_((v), pg8::lane_now() + (o))
#define __shfl_up(v, o) pg8::shfl_idx_((v), pg8::lane_now() - (o))
typedef float f32x2_cv __attribute__((ext_vector_type(2))); typedef __bf16 bf16x2_cv __attribute__((ext_vector_type(2)));
__device__ __forceinline__ unsigned cvt_pk_bf16(float lo, float hi) { f32x2_cv v = {lo, hi}; bf16x2_cv b = __builtin_convertvector(v, bf16x2_cv); return __builtin_bit_cast(unsigned, b); }
constexpr float RMS_EPS = 1e-6f;
__device__ __forceinline__ void rows_rs(const float* part, int row0, int fq, float (&rs)[2][4]) {
    f32x4 pr[2][4];
#pragma unroll
    for (int ai = 0; ai < 2; ++ai)
#pragma unroll
        for (int m = 0; m < 4; ++m) pr[ai][m] = *(const f32x4*)(part + (size_t)(row0 + ai * HALF + m * 16) * 16 + 4 * fq);
#pragma unroll
    for (int ai = 0; ai < 2; ++ai)
#pragma unroll
        for (int m = 0; m < 4; ++m) { float s = (pr[ai][m][0] + pr[ai][m][1]) + (pr[ai][m][2] + pr[ai][m][3]); s += __shfl_xor(s, 16); s += __shfl_xor(s, 32);
            rs[ai][m] = __builtin_amdgcn_rsqf(s * (1.0f / 1024.0f) + RMS_EPS); }
}
__device__ __forceinline__ float silu_mul(float g, float u) { return g * u * __builtin_amdgcn_rcpf(1.0f + __builtin_amdgcn_exp2f(-1.4426950408889634f * g)); }
struct EpiSwiglu {
    static constexpr bool PERM = true, AFTER_DRAIN = false;
    bf16_t* H; int ldh; const float* part; int dmode;
    __device__ __forceinline__ void operator()(const f32x4 (&acc)[2][2][4][2], const Unit& u, int wr, int wc, int fr_, int fq_) const {
        int le_; asm volatile("v_mbcnt_lo_u32_b32 %0, -1, 0\n\tv_mbcnt_hi_u32_b32 %0, -1, %0" : "=v"(le_)); const int fr = le_ & 15, fq = le_ >> 4;
        const int row0 = u.pm * BM + wr * 64 + fr, col0 = u.pn * HALF + wc * 32 + 8 * fq;
        if (dmode == 2) return;
        float rsv[2][4]; rows_rs(part, row0, fq, rsv);
#pragma unroll
        for (int ai = 0; ai < 2; ++ai)
#pragma unroll
            for (int m = 0; m < 4; ++m) { const int row = row0 + ai * HALF + m * 16; const float rs = rsv[ai][m];
                const f32x4 g0 = acc[ai][0][m][0] * rs, g1 = acc[ai][0][m][1] * rs, u0 = acc[ai][1][m][0] * rs, u1 = acc[ai][1][m][1] * rs;
                u32x4 w; w.x = cvt_pk_bf16(silu_mul(g0[0], u0[0]), silu_mul(g0[1], u0[1])); w.y = cvt_pk_bf16(silu_mul(g0[2], u0[2]), silu_mul(g0[3], u0[3]));
                w.z = cvt_pk_bf16(silu_mul(g1[0], u1[0]), silu_mul(g1[1], u1[1])); w.w = cvt_pk_bf16(silu_mul(g1[2], u1[2]), silu_mul(g1[3], u1[3]));
                if (dmode == 0 || w.x == 0x12345678u) *(u32x4*)(H + (size_t)row * ldh + col0) = w; }
    }
};
struct EpiScale {
    static constexpr bool PERM = true, AFTER_DRAIN = false;
    bf16_t* O; int ldc; const float* part;
    __device__ __forceinline__ void operator()(const f32x4 (&acc)[2][2][4][2], const Unit& u, int wr, int wc, int fr_, int fq_) const {
        int le_; asm volatile("v_mbcnt_lo_u32_b32 %0, -1, 0\n\tv_mbcnt_hi_u32_b32 %0, -1, %0" : "=v"(le_)); const int fr = le_ & 15, fq = le_ >> 4;
        const int row0 = u.pm * BM + wr * 64 + fr, col0 = u.pn * BM + wc * 32 + 8 * fq;
        float rsv[2][4]; rows_rs(part, row0, fq, rsv);
#pragma unroll
        for (int ai = 0; ai < 2; ++ai)
#pragma unroll
            for (int m = 0; m < 4; ++m) { const int row = row0 + ai * HALF + m * 16; const float rs = rsv[ai][m]; bf16_t* rowp = O + (size_t)row * ldc + col0;
#pragma unroll
                for (int bj = 0; bj < 2; ++bj) { const f32x4 v0 = acc[ai][bj][m][0] * rs, v1 = acc[ai][bj][m][1] * rs;
                    u32x4 w; w.x = cvt_pk_bf16(v0[0], v0[1]); w.y = cvt_pk_bf16(v0[2], v0[3]); w.z = cvt_pk_bf16(v1[0], v1[1]); w.w = cvt_pk_bf16(v1[2], v1[3]);
                    *(u32x4*)(rowp + bj * HALF) = w; } }
    }
};
struct EpiResid {
    static constexpr bool PERM = true, AFTER_DRAIN = false;
    const bf16_t* base; bf16_t* xb; float* out; float* part_out; float coef;
    __device__ __forceinline__ void operator()(const f32x4 (&acc)[2][2][4][2], const Unit& u, int wr, int wc, int fr_, int fq_) const {
        int le_; asm volatile("v_mbcnt_lo_u32_b32 %0, -1, 0\n\tv_mbcnt_hi_u32_b32 %0, -1, %0" : "=v"(le_)); const int fr = le_ & 15, fq = le_ >> 4;
        const int row0 = u.pm * BM + wr * 64 + fr, col0 = u.pn * BM + wc * 32 + 8 * fq;
        u32x4 bs[2][4][2];
#pragma unroll
        for (int ai = 0; ai < 2; ++ai)
#pragma unroll
            for (int m = 0; m < 4; ++m)
#pragma unroll
                for (int bj = 0; bj < 2; ++bj) bs[ai][m][bj] = *(const u32x4*)(base + (size_t)(row0 + ai * HALF + m * 16) * 1024 + col0 + bj * HALF);
#pragma unroll
        for (int ai = 0; ai < 2; ++ai)
#pragma unroll
            for (int m = 0; m < 4; ++m) { const int row = row0 + ai * HALF + m * 16; const size_t off = (size_t)row * 1024 + col0; float ss = 0.f;
#pragma unroll
                for (int bj = 0; bj < 2; ++bj) { const u32x4 b = bs[ai][m][bj];
                    const f32x4 b0 = {__builtin_bit_cast(float, b.x << 16), __builtin_bit_cast(float, b.x & 0xffff0000u), __builtin_bit_cast(float, b.y << 16), __builtin_bit_cast(float, b.y & 0xffff0000u)};
                    const f32x4 b1 = {__builtin_bit_cast(float, b.z << 16), __builtin_bit_cast(float, b.z & 0xffff0000u), __builtin_bit_cast(float, b.w << 16), __builtin_bit_cast(float, b.w & 0xffff0000u)};
                    const f32x4 v0 = b0 + acc[ai][bj][m][0] * coef, v1 = b1 + acc[ai][bj][m][1] * coef;
                    if (out) { *(f32x4*)(out + off + bj * HALF) = v0; *(f32x4*)(out + off + bj * HALF + 4) = v1; }
                    u32x4 w; w.x = cvt_pk_bf16(v0[0], v0[1]); w.y = cvt_pk_bf16(v0[2], v0[3]); w.z = cvt_pk_bf16(v1[0], v1[1]); w.w = cvt_pk_bf16(v1[2], v1[3]);
                    *(u32x4*)(xb + off + bj * HALF) = w;
                    ss += (v0[0] * v0[0] + v0[1] * v0[1]) + (v0[2] * v0[2] + v0[3] * v0[3]) + (v1[0] * v1[0] + v1[1] * v1[1]) + (v1[2] * v1[2] + v1[3] * v1[3]); }
                ss += __shfl_xor(ss, 16); ss += __shfl_xor(ss, 32);
                if (fq == 0) part_out[(size_t)row * 16 + u.pn * 4 + wc] = ss; }
    }
};
template <class Epi, class Sched, bool ALIGN_EPI = false, bool SP2 = false>
__device__ __forceinline__ void gemm_phase(PG8_LAS unsigned char* lds, const Gemm g, const Sched& S, const Epi& E, int wave_id) {
    int lane_; asm volatile("v_mbcnt_lo_u32_b32 %0, -1, 0\n\tv_mbcnt_hi_u32_b32 %0, -1, %0" : "=v"(lane_));
    const int wid = wave_id, lane = lane_, tid = wid * 64 + lane, wr = wid >> 2, wc = wid & 3, fr = lane & 15, fq = lane >> 4;
    const int K = g.K, nt = K / BK;
    unsigned voffA[2], voffB[2];
#pragma unroll
    for (int i = 0; i < 2; ++i) { int R, C; stage_rc(tid * 16 + i * 8192, R, C); const int Rb = Epi::PERM ? ((R & ~31) + perm32(R & 31)) : R;
        voffA[i] = (unsigned)(R * K + C) * 2u; voffB[i] = (unsigned)(Rb * K + C) * 2u; }
    const size_t kstep = (size_t)(BK * 2);
    const size_t hstep = (size_t)HALF * K * 2;
    const size_t tstep = 2 * hstep;
    const unsigned ldsw = (unsigned)wid * 1024u;
    const int aoff = lds_byte(wr * 64 + fr, fq * 8), boff = lds_byte(wc * 32 + fr, fq * 8);
#define PG8_SA(b, h) (((b) * 2 + (h)) * HTB)
#define PG8_SB(b, h) ((4 + (b) * 2 + (h)) * HTB)
#define PG8_STAGE(bufoff, gbase, voff) do { _Pragma("unroll") for (int _i = 0; _i < 2; ++_i) \
        __builtin_amdgcn_global_load_lds((const unsigned*)((const char*)(gbase) + (voff)[_i]), (PG8_LAS unsigned*)(lds + (bufoff) + ldsw + _i * 8192), 16, 0, 0); } while (0)
#define PG8_LDA(dst, b, h) do { _Pragma("unroll") for (int m = 0; m < 4; ++m) _Pragma("unroll") for (int k = 0; k < 2; ++k) dst[m][k] = *(const PG8_LAS bf16x8*)(lds + PG8_SA(b, h) + aoff + m * 2048 + k * 1024); } while (0)
#define PG8_LDB(dst, b, h) do { _Pragma("unroll") for (int n = 0; n < 2; ++n) _Pragma("unroll") for (int k = 0; k < 2; ++k) dst[n][k] = *(const PG8_LAS bf16x8*)(lds + PG8_SB(b, h) + boff + n * 2048 + k * 1024); } while (0)
#define PG8_MMA(ai, bj, At, Bt) do { __builtin_amdgcn_s_setprio(1); _Pragma("unroll") for (int m = 0; m < 4; ++m) _Pragma("unroll") for (int n = 0; n < 2; ++n) _Pragma("unroll") for (int k = 0; k < 2; ++k) \
        acc[ai][bj][m][n] = __builtin_amdgcn_mfma_f32_16x16x32_bf16(Bt[n][k], At[m][k], acc[ai][bj][m][n], 0, 0, 0); __builtin_amdgcn_s_setprio(0); } while (0)
#define PG8_WAIT_V(n) asm volatile("s_waitcnt vmcnt(" #n ")" ::: "memory")
#define PG8_WAIT_L(n) asm volatile("s_waitcnt lgkmcnt(" #n ")" ::: "memory")
#define PG8_BAR __builtin_amdgcn_s_barrier()
#define PG8_SCHED __builtin_amdgcn_sched_barrier(0)
    Unit cur, nxt; int ui = 0;
    if (!S.next(0, cur)) return;
    f32x4 acc[2][2][4][2];
#pragma unroll
    for (int a = 0; a < 2; ++a)
#pragma unroll
        for (int b = 0; b < 2; ++b)
#pragma unroll
            for (int m = 0; m < 4; ++m)
#pragma unroll
                for (int n = 0; n < 2; ++n) acc[a][b][m][n] = (f32x4){0.f, 0.f, 0.f, 0.f};
    bf16x8 At[4][2], B0[2][2], B1[2][2];
    const char* cA = (const char*)g.A + (size_t)cur.pm * tstep; const char* cB = (const char*)g.Bt + (size_t)cur.pn * tstep;
    S.a_ready(cur);
    if constexpr (SP2) {
        PG8_STAGE(PG8_SB(0, 0), cB, voffB); PG8_STAGE(PG8_SB(0, 1), cB + hstep, voffB); PG8_STAGE(PG8_SA(0, 0), cA, voffA); PG8_STAGE(PG8_SA(0, 1), cA + hstep, voffA);
        if (wr == 1) PG8_BAR;
        PG8_WAIT_V(2); PG8_BAR;
        PG8_STAGE(PG8_SB(1, 0), cB + kstep, voffB); PG8_STAGE(PG8_SA(1, 0), cA + kstep, voffA); PG8_STAGE(PG8_SB(1, 1), cB + hstep + kstep, voffB);
        PG8_WAIT_V(6); PG8_BAR;
    } else {
        PG8_STAGE(PG8_SB(0, 0), cB, voffB); PG8_STAGE(PG8_SA(0, 0), cA, voffA); PG8_STAGE(PG8_SB(0, 1), cB + hstep, voffB); PG8_STAGE(PG8_SA(0, 1), cA + hstep, voffA);
        if (wr == 1) PG8_BAR;
        PG8_WAIT_V(4); PG8_BAR;
        PG8_STAGE(PG8_SB(1, 0), cB + kstep, voffB); PG8_STAGE(PG8_SA(1, 0), cA + kstep, voffA); PG8_STAGE(PG8_SB(1, 1), cB + hstep + kstep, voffB);
        PG8_WAIT_V(6); PG8_BAR;
    }
    for (;;) {
        const bool has_next = S.next(ui + 1, nxt);
        const char* nA = has_next ? (const char*)g.A + (size_t)nxt.pm * tstep : cA; const char* nB = has_next ? (const char*)g.Bt + (size_t)nxt.pn * tstep : cB;
        for (int t = 0; t < nt; t += 2) {
            const bool last = (t == nt - 2);
            const char* a1 = cA + (size_t)(t + 1) * kstep;
            const char* a2 = last ? nA : cA + (size_t)(t + 2) * kstep; const char* b2 = last ? nB : cB + (size_t)(t + 2) * kstep;
            const char* a3 = a2 + kstep; const char* b3 = b2 + kstep;
            if (last && has_next) S.a_ready(nxt);
            if constexpr (SP2) {
            PG8_LDB(B0, 0, 0); PG8_LDB(B1, 0, 1); PG8_SCHED; PG8_LDA(At, 0, 0); PG8_STAGE(PG8_SA(1, 1), a1 + hstep, voffA);
            PG8_WAIT_V(8); PG8_WAIT_L(0); PG8_BAR; PG8_MMA(0, 0, At, B0); PG8_MMA(0, 1, At, B1); PG8_BAR; PG8_SCHED;
            PG8_LDA(At, 0, 1); PG8_STAGE(PG8_SB(0, 0), b2, voffB); PG8_STAGE(PG8_SB(0, 1), b2 + hstep, voffB); PG8_STAGE(PG8_SA(0, 0), a2, voffA);
            PG8_WAIT_V(8); PG8_WAIT_L(0); PG8_BAR; PG8_MMA(1, 0, At, B0); PG8_MMA(1, 1, At, B1); PG8_BAR; PG8_SCHED;
            PG8_LDB(B0, 1, 0); PG8_LDB(B1, 1, 1); PG8_SCHED; PG8_LDA(At, 1, 0); PG8_STAGE(PG8_SA(0, 1), a2 + hstep, voffA);
            PG8_WAIT_V(8); PG8_WAIT_L(0); PG8_BAR; PG8_MMA(0, 0, At, B0); PG8_MMA(0, 1, At, B1); PG8_BAR; PG8_SCHED;
            PG8_LDA(At, 1, 1); PG8_STAGE(PG8_SB(1, 0), b3, voffB); PG8_STAGE(PG8_SB(1, 1), b3 + hstep, voffB); PG8_STAGE(PG8_SA(1, 0), a3, voffA);
            PG8_WAIT_V(8); PG8_WAIT_L(0); PG8_BAR; PG8_MMA(1, 0, At, B0); PG8_MMA(1, 1, At, B1); PG8_BAR; PG8_SCHED;
            } else {
            PG8_LDB(B0, 0, 0); PG8_SCHED; PG8_LDA(At, 0, 0); PG8_STAGE(PG8_SA(1, 1), a1 + hstep, voffA);
            PG8_WAIT_L(8); PG8_BAR; PG8_WAIT_L(0); PG8_MMA(0, 0, At, B0); PG8_BAR; PG8_SCHED;
            PG8_LDB(B1, 0, 1); PG8_STAGE(PG8_SB(0, 0), b2, voffB);
            PG8_BAR; PG8_WAIT_L(0); PG8_MMA(0, 1, At, B1); PG8_BAR;
            PG8_LDA(At, 0, 1); PG8_STAGE(PG8_SA(0, 0), a2, voffA);
            PG8_BAR; PG8_WAIT_L(0); PG8_MMA(1, 0, At, B0); PG8_BAR; PG8_SCHED;
            PG8_STAGE(PG8_SB(0, 1), b2 + hstep, voffB);
            PG8_WAIT_V(6); PG8_BAR; PG8_MMA(1, 1, At, B1); PG8_BAR;
            PG8_LDB(B0, 1, 0); PG8_SCHED; PG8_LDA(At, 1, 0); PG8_STAGE(PG8_SA(0, 1), a2 + hstep, voffA);
            PG8_WAIT_L(8); PG8_BAR; PG8_WAIT_L(0); PG8_MMA(0, 0, At, B0); PG8_BAR; PG8_SCHED;
            PG8_LDB(B1, 1, 1); PG8_STAGE(PG8_SB(1, 0), b3, voffB);
            PG8_BAR; PG8_WAIT_L(0); PG8_MMA(0, 1, At, B1); PG8_BAR;
            PG8_LDA(At, 1, 1); PG8_STAGE(PG8_SA(1, 0), a3, voffA);
            PG8_BAR; PG8_WAIT_L(0); PG8_MMA(1, 0, At, B0); PG8_BAR; PG8_SCHED;
            PG8_STAGE(PG8_SB(1, 1), b3 + hstep, voffB);
            PG8_WAIT_V(6); PG8_BAR; PG8_MMA(1, 1, At, B1); PG8_BAR;
            }
        }
        if constexpr (ALIGN_EPI) { if (wr == 0) PG8_BAR; }
        if constexpr (!Epi::AFTER_DRAIN) { E(acc, cur, wr, wc, fr, fq); S.done(cur); }
        if (!has_next) break;
#pragma unroll
        for (int a = 0; a < 2; ++a)
#pragma unroll
            for (int b = 0; b < 2; ++b)
#pragma unroll
                for (int m = 0; m < 4; ++m)
#pragma unroll
                    for (int n = 0; n < 2; ++n) acc[a][b][m][n] = (f32x4){0.f, 0.f, 0.f, 0.f};
        cur = nxt; cA = nA; cB = nB; ++ui;
        if constexpr (ALIGN_EPI) { if (wr == 1) PG8_BAR; }
    }
    PG8_WAIT_V(0);
    if constexpr (!ALIGN_EPI) { if (wr == 0) PG8_BAR; }
    PG8_BAR;
    if constexpr (Epi::AFTER_DRAIN) { E.fused(acc, cur, wr, wc, fr, fq, lds, wid, lane); S.done(cur); }
#undef PG8_SA
#undef PG8_SB
#undef PG8_STAGE
#undef PG8_LDA
#undef PG8_LDB
#undef PG8_MMA
#undef PG8_WAIT_V
#undef PG8_WAIT_L
#undef PG8_BAR
#undef PG8_SCHED
}
}
#define LAS __attribute__((address_space(3)))
#define XB_TMO      128
#define XB_XCNT(j)  (256  + 64 * (j))
#define XB_XSUB(j)  (1280 + 64 * (j))
#define XB_XGEN(j)  (2304 + 64 * (j))
#define XB_TOP      3328
#define XB_TOPGEN   3392
#define XCD_BAR_WORDS 3456
#define XB_SPIN_CAP (1u << 18)

__device__ __forceinline__ unsigned xb_ld(unsigned* p)              { return __hip_atomic_load(p, __ATOMIC_RELAXED, __HIP_MEMORY_SCOPE_AGENT); }
__device__ __forceinline__ unsigned xb_add(unsigned* p, unsigned v) { return __hip_atomic_fetch_add(p, v, __ATOMIC_RELAXED, __HIP_MEMORY_SCOPE_AGENT); }
__device__ __forceinline__ unsigned xb_xcc_id() { return (unsigned)__builtin_amdgcn_s_getreg((3 << 11) | 20) & 0xFu; }
#define XB_SPIN(cond, bar) do { unsigned _sp = 0; while (cond) { __builtin_amdgcn_s_sleep(1); \
    if ((++_sp & 255u) == 0u) { if (xb_ld(&(bar)[XB_TMO])) break; if (_sp > XB_SPIN_CAP) { atomicAdd(&(bar)[XB_TMO], 1u); break; } } } } while (0)

struct XcdBarrier {
    unsigned* bar; unsigned x;
    volatile LAS unsigned* st;
};

__device__ __forceinline__ XcdBarrier xcd_barrier_post(unsigned* bar, volatile LAS unsigned* st) {
    XcdBarrier b; b.bar = bar; b.x = xb_xcc_id(); b.st = st;
    if (threadIdx.x == 0) (void)xb_add(&bar[XB_XCNT(b.x)], 1u);
    return b;
}
__device__ __forceinline__ void xcd_barrier_complete(unsigned* bar, unsigned x, unsigned& nloc, unsigned& nx) {
    const unsigned G = gridDim.x * gridDim.y * gridDim.z;
    unsigned sum, cnt, mine, sp = 0u;
    for (;;) {
        sum = 0u; cnt = 0u; mine = 0u;
#pragma unroll
        for (unsigned j = 0; j < 16; ++j) { const unsigned c = xb_ld(&bar[XB_XCNT(j)]); sum += c; cnt += (c > 0u) ? 1u : 0u; mine = (j == x) ? c : mine; }
        if (sum == G) break;
        __builtin_amdgcn_s_sleep(1);
        if ((++sp & 255u) == 0u) { if (xb_ld(&bar[XB_TMO])) break; if (sp > XB_SPIN_CAP) { atomicAdd(&bar[XB_TMO], 1u); break; } }
    }
    nloc = mine > 0u ? mine : 1u; nx = cnt > 0u ? cnt : 1u;
}

__device__ __forceinline__ void xcd_barrier(const XcdBarrier& b) {
    asm volatile("s_waitcnt vmcnt(0)" ::: "memory");
    __syncthreads();
    if (threadIdx.x == 0) {
        unsigned* bar = b.bar;
        __builtin_amdgcn_s_waitcnt(0);
        unsigned nloc = b.st[0], nx = b.st[1];
        if (nloc == 0u) { xcd_barrier_complete(bar, b.x, nloc, nx); b.st[0] = nloc; b.st[1] = nx; }
        const unsigned old = xb_add(&bar[XB_XSUB(b.x)], 1u);
        const unsigned gen = old / nloc;
        if (old + 1u == (gen + 1u) * nloc) {
            __builtin_amdgcn_fence(__ATOMIC_RELEASE, "agent");
            asm volatile("s_waitcnt vmcnt(0)" ::: "memory");
            const unsigned og = xb_add(&bar[XB_TOP], 1u);
            const unsigned tg = og / nx;
            if (og + 1u == (tg + 1u) * nx) xb_add(&bar[XB_TOPGEN], 1u);
            else XB_SPIN(xb_ld(&bar[XB_TOPGEN]) == tg, bar);
            __builtin_amdgcn_fence(__ATOMIC_ACQUIRE, "agent");
            xb_add(&bar[XB_XGEN(b.x)], 1u);
            asm volatile("s_waitcnt vmcnt(0)" ::: "memory");
        } else {
            XB_SPIN(xb_ld(&bar[XB_XGEN(b.x)]) == gen, bar);
            __builtin_amdgcn_fence(__ATOMIC_ACQUIRE, "agent");
            asm volatile("s_waitcnt vmcnt(0)" ::: "memory");
        }
    }
    __syncthreads();
}
#undef LAS
#ifndef RET_MODE
#define RET_MODE 1
#endif
#ifndef NSA_INLINE
#define NSA_INLINE __forceinline__
#endif
#ifndef DRY_MODE
#define DRY_MODE 0
#endif
#ifndef NSA_WG
#define NSA_WG 1
#endif
#ifndef D3_WG
#define D3_WG 1
#endif
#ifndef RET_WG
#define RET_WG 1
#endif
#ifndef PROBE_DUP
#define PROBE_DUP 0
#endif
#ifndef DBG_BRUTE
#define DBG_BRUTE 0
#endif
#ifndef DBG_ZERO
#define DBG_ZERO 0
#endif
constexpr int NWAVES = 8;
constexpr int NB = 16, SEQ = 2048, DM = 1024, MTOK = NB * SEQ, FF = 2816, NMEMT = 256, MMEM = NB * NMEMT, DEPTH = 4;
constexpr float EPS = 1e-6f;
constexpr float QSCALE = 0.125f * 1.4426950408889634f;
constexpr int RET_LD = 2560, RET_Q = 0, RET_K = 384, RET_V = 768, RET_G = 1536, RET_QM = 2304;
constexpr int DSA_LD = 1792, DSA_Q = 0, DSA_K = 768, DSA_V = 832, DSA_IQ = 896, DSA_IK = 1408, DSA_IW = 1472, DSA_QM = 1480, DSA_COLS = 1736;
constexpr int NSA_LD = 2816, NSA_Q = 0, NSA_KC = 768, NSA_VC = 1024, NSA_KS = 1280, NSA_VS = 1536, NSA_KW = 1792, NSA_VW = 2048, NSA_QM = 2304, NSA_GT = 2560;
constexpr int NSA_SRC_GT = 2304, NSA_SRC_QM = 2340, NSA_COLS = 2596;

constexpr size_t MiB = 1u << 20;
constexpr size_t WS_CTL = 0, CTL_ZERO_BYTES = 1 * MiB;
constexpr size_t WS_PART = 1 * MiB;
constexpr size_t WS_PARTM = 3 * MiB;
constexpr size_t WS_ROPE = 3 * MiB + 512 * 1024;
constexpr size_t WS_MISC = 4 * MiB;
constexpr size_t WS_CMPW = 4 * MiB + 64 * 1024;
constexpr size_t WS_KCMP = 5 * MiB;
constexpr size_t WS_VCMPT = 6 * MiB;
constexpr size_t WS_MK = 7 * MiB;
constexpr size_t WS_MVT = 15 * MiB;
constexpr size_t WS_MEMB = 23 * MiB;
constexpr size_t WS_MKV = 31 * MiB;
constexpr size_t WS_WKV = 47 * MiB;
constexpr size_t WS_WBUF0 = 51 * MiB, WBUF_BYTES = 41 * MiB;
constexpr size_t WS_XB = 133 * MiB;
constexpr size_t WS_Y = 197 * MiB;
constexpr size_t WS_HID = 261 * MiB;
constexpr size_t WS_SC = 373 * MiB;
constexpr size_t WS_MB = 501 * MiB;
constexpr size_t WS_END = 509 * MiB;
static_assert(WS_HID + (size_t)MTOK * FF * 2 <= WS_MB && WS_SC + (size_t)MTOK * SEQ * 2 <= WS_MB && WS_WBUF0 + 2 * WBUF_BYTES <= WS_XB, "d_ws map");
constexpr size_t WB_W1A = 0, WB_W2A = WB_W1A + (size_t)2 * FF * DM, WB_W1B = WB_W2A + (size_t)DM * FF, WB_W2B = WB_W1B + (size_t)2 * FF * DM,
                 WB_WIN = WB_W2B + (size_t)DM * FF, WB_WO = WB_WIN + (size_t)NSA_LD * DM, WB_END = WB_WO + (size_t)DM * DM;
static_assert(WB_END * 2 <= WBUF_BYTES, "weight buffer");
constexpr int LDS_CTRL = 147456 - 1024;
constexpr int CW_BAR = 4096;
constexpr int CW_CK = 32768;
constexpr int CW_Q = 16384;

#define GAS __attribute__((address_space(1)))
#define LAS __attribute__((address_space(3)))
typedef unsigned short bf16;
typedef unsigned v4u __attribute__((ext_vector_type(4)));
typedef unsigned v2u __attribute__((ext_vector_type(2)));
typedef float f32x4 __attribute__((ext_vector_type(4)));
typedef float f32x16 __attribute__((ext_vector_type(16)));
typedef short bf16x8 __attribute__((ext_vector_type(8)));
typedef GAS unsigned gu32;
#define RLX_AGENT __ATOMIC_RELAXED, __HIP_MEMORY_SCOPE_AGENT
#define LDS_WAIT() asm volatile("s_waitcnt lgkmcnt(0)" ::: "memory")
#define VM_WAIT() asm volatile("s_waitcnt vmcnt(0)" ::: "memory")
__device__ __forceinline__ unsigned f2bf(float f) { unsigned u = __builtin_bit_cast(unsigned, f); return (u + 0x7fffu + ((u >> 16) & 1u)) >> 16; }
__device__ __forceinline__ unsigned pk2(float lo, float hi) { return pg8::cvt_pk_bf16(lo, hi); }
__device__ __forceinline__ float bf2f(unsigned h) { return __builtin_bit_cast(float, h << 16); }
__device__ __forceinline__ float bflo(unsigned w) { return __builtin_bit_cast(float, w << 16); }
__device__ __forceinline__ float bfhi(unsigned w) { return __builtin_bit_cast(float, w & 0xffff0000u); }
struct Args { const float* in[23]; float* out; unsigned char* ws; int ph_lo, ph_hi, dry, pad; };
typedef const __attribute__((address_space(4))) Args* KArgs;
struct Frame {
    LAS unsigned char* lds;
    volatile LAS unsigned* MISC;
    gu32* ctl;
    int tid, lane, wave, G, gw, NGW;
    unsigned char* ws;
    KArgs ka;
    float* out;
};
__device__ __forceinline__ float wave_sum(float v) {
#pragma unroll
    for (int o = 1; o < 64; o <<= 1) v += __shfl_xor(v, o);
    return v;
}
__device__ __forceinline__ float wave_max(float v) {
#pragma unroll
    for (int o = 1; o < 64; o <<= 1) v = fmaxf(v, __shfl_xor(v, o));
    return v;
}
__device__ __forceinline__ int grab(gu32* ctr, int lane) { unsigned v = 0; if (lane == 0) v = __hip_atomic_fetch_add(ctr, 1u, RLX_AGENT); return __builtin_amdgcn_readfirstlane((int)v); }

__device__ __forceinline__ void cvt_item(const float* W, int ldw, const float* gain, bf16* WT, int K, LAS float* scr, int k0, int src_col0, int nvalid, int dst_row0, int lane) {
    const int c = lane & 31;
    float wv[32], gv2[32];
#pragma unroll
    for (int i = 0; i < 32; ++i) { const int kk = 2 * i + (lane >> 5); wv[i] = (c < nvalid) ? W[(size_t)(k0 + kk) * ldw + src_col0 + c] : 0.f; gv2[i] = gain ? gain[k0 + kk] : 1.f; }
#pragma unroll
    for (int i = 0; i < 32; ++i) { const int kk = 2 * i + (lane >> 5); scr[kk * 33 + c] = wv[i] * gv2[i]; }
    LDS_WAIT(); asm volatile("" ::: "memory");
    const int c8 = lane & 7;
#pragma unroll
    for (int j = 0; j < 4; ++j) { const int n = (lane >> 3) + 8 * j; const LAS float* s = scr + (8 * c8) * 33 + n;
        v4u o; o.x = pk2(s[0 * 33], s[1 * 33]); o.y = pk2(s[2 * 33], s[3 * 33]); o.z = pk2(s[4 * 33], s[5 * 33]); o.w = pk2(s[6 * 33], s[7 * 33]);
        *(GAS v4u*)(WT + (size_t)(dst_row0 + n) * K + k0 + 8 * c8) = o; }
    LDS_WAIT(); asm volatile("" ::: "memory");
}
__device__ __forceinline__ void cvt_matrix(Frame& F, int& it_base, const float* W, const float* W2, int ldw, int ncols, const float* gain, bf16* WT, int K, int nrows_dst, int kind) {
    LAS float* scr = (LAS float*)(F.lds + F.wave * 16384);
    const int nkb = K / 64, njb = nrows_dst / 32, nitems = nkb * njb;
    int first = (F.gw - it_base % F.NGW + F.NGW) % F.NGW;
    for (int i = first; i < nitems; i += F.NGW) {
        const int kb = i / njb, jb = i % njb; const float* src = W; int sc0 = jb * 32, nv = 32;
        if (kind == 0) { nv = ncols - sc0; nv = nv < 0 ? 0 : (nv > 32 ? 32 : nv); }
        else if (kind == 1) { const int c = jb * 32, pn = c >> 8, bj = (c >> 7) & 1, j = c & 127; src = bj ? W2 : W; sc0 = pn * 128 + j; }
        else { const int c = jb * 32;
            if (c < NSA_QM) { sc0 = c; }
            else if (c < NSA_GT) { sc0 = NSA_SRC_QM + (c - NSA_QM); }
            else { sc0 = NSA_SRC_GT + (c - NSA_GT); nv = NSA_SRC_QM - sc0; nv = nv < 0 ? 0 : (nv > 32 ? 32 : nv); } }
        cvt_item(src, ldw, gain, WT, K, scr, kb * 64, sc0, nv, jb * 32, F.lane);
    }
    it_base += nitems;
}
__device__ __forceinline__ void convert_layer(Frame& F, int Ly) {
    bf16* WB = (bf16*)(F.ws + WS_WBUF0 + (size_t)(Ly & 1) * WBUF_BYTES);
    const float* fnorm = F.ka->in[2]; const float* wg = F.ka->in[3]; const float* wu = F.ka->in[4]; const float* wd = F.ka->in[5];
    int itb = 0;
#pragma unroll 1
    for (int hf = 0; hf < 2; ++hf) {
        const size_t o1 = (size_t)(Ly * 2 + hf) * DM * FF;
        cvt_matrix(F, itb, wg + o1, wu + o1, FF, FF, fnorm + (size_t)(Ly * 2 + hf) * DM, WB + (hf ? WB_W1B : WB_W1A), DM, 2 * FF, 1);
        cvt_matrix(F, itb, wd + o1, nullptr, DM, DM, nullptr, WB + (hf ? WB_W2B : WB_W2A), FF, DM, 0);
    }
    const float* mnorm = F.ka->in[6] + (size_t)Ly * DM;
    const int kind = Ly % 3, j = Ly / 3;
    if (kind == 0) cvt_matrix(F, itb, F.ka->in[12] + (size_t)j * DM * RET_LD, nullptr, RET_LD, RET_LD, mnorm, WB + WB_WIN, DM, RET_LD, 0);
    else if (kind == 1) cvt_matrix(F, itb, F.ka->in[13] + (size_t)j * DM * DSA_COLS, nullptr, DSA_COLS, DSA_COLS, mnorm, WB + WB_WIN, DM, DSA_LD, 0);
    else cvt_matrix(F, itb, F.ka->in[16] + (size_t)j * DM * NSA_COLS, nullptr, NSA_COLS, NSA_COLS, mnorm, WB + WB_WIN, DM, NSA_LD, 2);
    cvt_matrix(F, itb, F.ka->in[7] + (size_t)Ly * DM * DM, nullptr, DM, DM, nullptr, WB + WB_WO, DM, DM, 0);
}

__device__ __forceinline__ void xform(Frame& F, const bf16* src, int spitch, int scol0, int nheads, int rows, int Lr, bf16* dst, int dmode, int dpitch, int dcol0,
                                      const float* gain, bool rope, float cscale, int decay  ) {
    const float* tab = (const float*)(F.ws + WS_ROPE);
    const int i8 = F.lane & 7, sub = F.lane >> 3; const int items = rows * nheads;
    float gn[8];
#pragma unroll
    for (int j = 0; j < 8; ++j) gn[j] = gain ? gain[8 * i8 + j] : 1.f;
    constexpr int U = 4;
    for (int it0 = F.gw * (8 * U); it0 < items; it0 += F.NGW * (8 * U)) {
        v4u raw[U]; f32x4 c0[U], c1[U], s0[U], s1[U];
#pragma unroll
        for (int u = 0; u < U; ++u) { const int it = it0 + 8 * u + sub; const int row = it / nheads, h = it % nheads, t = row % Lr;
            raw[u] = *(const GAS v4u*)(src + (size_t)row * spitch + scol0 + h * 64 + 8 * i8);
            if (rope) { const float* tr = tab + (size_t)t * 64 + 8 * (i8 & 3);
                c0[u] = *(const GAS f32x4*)(tr); c1[u] = *(const GAS f32x4*)(tr + 4); s0[u] = *(const GAS f32x4*)(tr + 32); s1[u] = *(const GAS f32x4*)(tr + 36); } }
#pragma unroll
        for (int u = 0; u < U; ++u) { const int it = it0 + 8 * u + sub; const int row = it / nheads, h = it % nheads, t = row % Lr;
            float v[8] = {bflo(raw[u].x), bfhi(raw[u].x), bflo(raw[u].y), bfhi(raw[u].y), bflo(raw[u].z), bfhi(raw[u].z), bflo(raw[u].w), bfhi(raw[u].w)};
            if (gain) { float ss = 0.f;
#pragma unroll
                for (int j = 0; j < 8; ++j) ss += v[j] * v[j];
                ss += __shfl_xor(ss, 1); ss += __shfl_xor(ss, 2); ss += __shfl_xor(ss, 4);
                const float r = __builtin_amdgcn_rsqf(ss * (1.f / 64.f) + EPS);
#pragma unroll
                for (int j = 0; j < 8; ++j) v[j] = v[j] * r * gn[j]; }
            if (rope) {
                const float cs[8] = {c0[u][0], c0[u][1], c0[u][2], c0[u][3], c1[u][0], c1[u][1], c1[u][2], c1[u][3]}, sn[8] = {s0[u][0], s0[u][1], s0[u][2], s0[u][3], s1[u][0], s1[u][1], s1[u][2], s1[u][3]};
#pragma unroll
                for (int j = 0; j < 8; ++j) { const float p = __shfl_xor(v[j], 4); v[j] = (i8 < 4) ? (v[j] * cs[j] - p * sn[j]) : (v[j] * cs[j] + p * sn[j]); } }
            float f = cscale;
            if (decay) { const float lg = __builtin_amdgcn_logf(1.0f - __builtin_amdgcn_exp2f(-5.0f - (float)h)); f *= __builtin_amdgcn_exp2f((float)(decay * t) * lg); }
            v4u o; o.x = pk2(v[0] * f, v[1] * f); o.y = pk2(v[2] * f, v[3] * f); o.z = pk2(v[4] * f, v[5] * f); o.w = pk2(v[6] * f, v[7] * f);
            bf16* dp = dmode == 0 ? dst + (size_t)row * dpitch + dcol0 + h * 64 + 8 * i8 : dst + ((size_t)((row / Lr) * nheads + h) * Lr + t) * 64 + 8 * i8;
            *(GAS v4u*)dp = o; }
    }
}
__device__ __forceinline__ void transpose_cols(Frame& F, const bf16* src, int spitch, int scol0, int ncols, int nb, int Lr, bf16* dst) {
    LAS bf16* scr = (LAS bf16*)(F.lds + F.wave * 16384);
    const int ntt = Lr / 64, nct = ncols / 64, ntiles = nb * ntt * nct; const int i8 = F.lane & 7, sub = F.lane >> 3;
    for (int tl = F.gw; tl < ntiles; tl += F.NGW) {
        const int ct = tl % nct, tt = (tl / nct) % ntt, b = tl / (nct * ntt); const int t0 = tt * 64, c0 = ct * 64;
#pragma unroll
        for (int k = 0; k < 8; ++k) { const int r = sub + 8 * k;
            const v4u raw = *(const GAS v4u*)(src + (size_t)(b * Lr + t0 + r) * spitch + scol0 + c0 + 8 * i8);
            *(LAS v4u*)(scr + r * 72 + 8 * i8) = raw; }
        LDS_WAIT(); asm volatile("" ::: "memory");
        bf16* drow = dst + ((size_t)b * ncols + c0 + F.lane) * Lr + t0;
#pragma unroll
        for (int k = 0; k < 8; ++k) { unsigned w[4];
#pragma unroll
            for (int q = 0; q < 4; ++q) { const unsigned lo = scr[(8 * k + 2 * q) * 72 + F.lane], hi = scr[(8 * k + 2 * q + 1) * 72 + F.lane]; w[q] = lo | (hi << 16); }
            v4u o; o.x = w[0]; o.y = w[1]; o.z = w[2]; o.w = w[3]; *(GAS v4u*)(drow + 8 * k) = o; }
        LDS_WAIT(); asm volatile("" ::: "memory");
    }
}
__device__ __forceinline__ void row_to_bf16(Frame& F, const float* xrow, bf16* orow, float* part) {
    const GAS f32x4* xr = (const GAS f32x4*)xrow + F.lane;
    f32x4 v[4]; float s = 0.f;
#pragma unroll
    for (int j = 0; j < 4; ++j) { v[j] = xr[64 * j]; s += (v[j].x * v[j].x + v[j].y * v[j].y) + (v[j].z * v[j].z + v[j].w * v[j].w); }
    s = wave_sum(s);
    GAS v2u* o8 = (GAS v2u*)orow + F.lane;
#pragma unroll
    for (int j = 0; j < 4; ++j) { v2u o; o.x = pk2(v[j].x, v[j].y); o.y = pk2(v[j].z, v[j].w); o8[64 * j] = o; }
    if (F.lane < 16) part[F.lane] = F.lane == 0 ? s : 0.f;
}
enum { MK_NONE = 0, MK_CAUSAL = 1, MK_WIN = 2, MK_BITS = 3, MK_SLC = 4, MK_CMP = 5 };
struct KVp { const bf16* K; int kpitch; const bf16* VT; int vpitch; };
struct MaskArg { int q0[3]; const unsigned* mb; unsigned sel; int nmax; float lg; };
__device__ __forceinline__ bf16x8 ld8(const bf16* p) { return *(const GAS bf16x8*)p; }
__device__ __forceinline__ float fast_exp2(float x) { return __builtin_amdgcn_exp2f(x); }

template <int NS, int NT, int MODE, int MT, int PF = 2>
__device__ __forceinline__ void attn_core(const LAS bf16x8* ql, const KVp kv, int kt0, int kt1, float negb, const MaskArg& ma, const unsigned* const (&mbrow)[NS],
                                          f32x16 (&O)[NS][NT], float (&lsum)[NS], int lane) {
    const int r32 = lane & 31, hi = lane >> 5;
    const int kperm = (r32 & 0x13) | ((r32 & 4) << 1) | ((r32 & 8) >> 1);
    const bf16* kp = kv.K + (size_t)kperm * kv.kpitch + 8 * hi;
    const bf16* vp = kv.VT + (size_t)r32 * kv.vpitch + 8 * hi;
    bf16x8 kf[4], vf[2][NT], kfn[4], vfn[2][NT];
#define AC_LOADK(dst, kt_) do { const bf16* kq_ = kp + (size_t)(32 * (kt_)) * kv.kpitch; _Pragma("unroll") for (int ks = 0; ks < 4; ++ks) dst[ks] = ld8(kq_ + 16 * ks); } while (0)
#define AC_LOADV(dst, kt_) do { _Pragma("unroll") for (int nt = 0; nt < NT; ++nt) { const bf16* vq_ = vp + (size_t)(32 * nt) * kv.vpitch + 32 * (kt_); dst[0][nt] = ld8(vq_); dst[1][nt] = ld8(vq_ + 16); } } while (0)
    unsigned mw[NS], mwn[NS];
    if (kt0 < kt1) { if (PF >= 1) AC_LOADK(kf, kt0); if (PF >= 2) AC_LOADV(vf, kt0);
        if (MT == MK_BITS) { _Pragma("unroll") for (int s = 0; s < NS; ++s) mw[s] = mbrow[s][kt0]; } }
#pragma unroll 1
    for (int kt = kt0; kt < kt1; ++kt) {
        unsigned selbit = 1u; bool active = true;
        if (MT == MK_SLC) { selbit = (ma.sel >> (kt >> 1)) & 1u; active = __any(selbit != 0u); }
        const int ktn = (kt + 1 < kt1) ? kt + 1 : kt;
        if (PF == 0) { if (active) { AC_LOADK(kf, kt); AC_LOADV(vf, kt); } }
        else { AC_LOADK(kfn, ktn); if (PF >= 2) AC_LOADV(vfn, ktn); else if (active) AC_LOADV(vf, kt); }
        if (MT == MK_BITS) { _Pragma("unroll") for (int s = 0; s < NS; ++s) mwn[s] = mbrow[s][ktn]; }
        if (active) {
        const LAS bf16x8* qlp = ql; asm volatile("" : "+v"(qlp));
#pragma unroll
        for (int s = 0; s < NS; ++s) {
            f32x16 acc;
#pragma unroll
            for (int r = 0; r < 16; ++r) acc[r] = 0.f;
#pragma unroll
            for (int ks = 0; ks < 4; ++ks) acc = __builtin_amdgcn_mfma_f32_32x32x16_bf16(kf[ks], qlp[(s * 4 + ks) * 64], acc, 0, 0, 0);
            const int tq = ma.q0[s] + r32, kb = 32 * kt + 8 * hi;
            bool full = true;
            if (MT == MK_CAUSAL) full = (32 * kt + 31 <= ma.q0[s]);
            if (MT == MK_WIN) full = (32 * kt + 31 <= ma.q0[s]) && (32 * kt >= ma.q0[s] + 31 - 511);
            if (MT == MK_SLC) full = (32 * kt + 31 <= ma.q0[s]) && __all(selbit != 0u);
            if (MT == MK_BITS || MT == MK_CMP) full = false;
            float p[16];
            if (full) {
#pragma unroll
                for (int r = 0; r < 16; ++r) { const int key = kb + 16 * (r >> 3) + (r & 7); p[r] = MODE == 0 ? fast_exp2(acc[r]) : (MODE == 1 ? acc[r] : acc[r] * fast_exp2((float)(tq - key) * ma.lg)); }
            } else {
                unsigned w = 0;
                if (MT == MK_BITS) w = mw[s];
#pragma unroll
                for (int r = 0; r < 16; ++r) { const int key = kb + 16 * (r >> 3) + (r & 7); bool v = true;
                    if (MT == MK_CAUSAL) v = key <= tq;
                    if (MT == MK_WIN) v = (key <= tq) && (key >= tq - 511);
                    if (MT == MK_SLC) v = (key <= tq) && (selbit != 0u);
                    if (MT == MK_BITS) v = (w >> (8 * hi + 16 * (r >> 3) + (r & 7))) & 1u;
                    if (MT == MK_CMP) v = key <= ma.nmax;
                    const float e = MODE == 0 ? fast_exp2(acc[r]) : (MODE == 1 ? acc[r] : acc[r] * fast_exp2((float)((tq - key) < 0 ? 0 : (tq - key)) * ma.lg));
                    p[r] = v ? e : 0.f; }
            }
            if (MODE == 0) { float a = 0.f;
#pragma unroll
                for (int r = 0; r < 16; ++r) a += p[r];
                lsum[s] += a; }
            bf16x8 pk0, pk1;
            { v4u t0, t1; t0.x = pk2(p[0], p[1]); t0.y = pk2(p[2], p[3]); t0.z = pk2(p[4], p[5]); t0.w = pk2(p[6], p[7]);
              t1.x = pk2(p[8], p[9]); t1.y = pk2(p[10], p[11]); t1.z = pk2(p[12], p[13]); t1.w = pk2(p[14], p[15]);
              pk0 = __builtin_bit_cast(bf16x8, t0); pk1 = __builtin_bit_cast(bf16x8, t1); }
#pragma unroll
            for (int nt = 0; nt < NT; ++nt) { O[s][nt] = __builtin_amdgcn_mfma_f32_32x32x16_bf16(pk0, vf[0][nt], O[s][nt], 0, 0, 0);
                                              O[s][nt] = __builtin_amdgcn_mfma_f32_32x32x16_bf16(pk1, vf[1][nt], O[s][nt], 0, 0, 0); }
            if (NS >= 3) __builtin_amdgcn_sched_barrier(0);
        }
        }
        if (MT == MK_BITS) { _Pragma("unroll") for (int s = 0; s < NS; ++s) mw[s] = mwn[s]; }
        if (PF >= 1) {
#pragma unroll
            for (int ks = 0; ks < 4; ++ks) kf[ks] = kfn[ks];
            if (PF >= 2) {
#pragma unroll
                for (int nt = 0; nt < NT; ++nt) { vf[0][nt] = vfn[0][nt]; vf[1][nt] = vfn[1][nt]; } }
        }
    }
#undef AC_LOADK
#undef AC_LOADV
}
template <int NS, int NT, int MODE, int MT>
__device__ __forceinline__ void tile_math(const bf16x8 (&kf)[4], const bf16x8 (&vf)[2][NT], const LAS bf16x8* ql, int kt, const MaskArg& ma, const unsigned (&mw)[NS], unsigned selbit,
                                          f32x16 (&O)[NS][NT], float (&lsum)[NS], int lane) {
    const int r32 = lane & 31, hi = lane >> 5;
    const LAS bf16x8* qlp = ql; asm volatile("" : "+v"(qlp));
#pragma unroll
    for (int s = 0; s < NS; ++s) {
        f32x16 acc;
#pragma unroll
        for (int r = 0; r < 16; ++r) acc[r] = 0.f;
#pragma unroll
        for (int ks = 0; ks < 4; ++ks) acc = __builtin_amdgcn_mfma_f32_32x32x16_bf16(kf[ks], qlp[(s * 4 + ks) * 64], acc, 0, 0, 0);
        const int tq = ma.q0[s] + r32, kb = 32 * kt + 8 * hi;
        bool full = true;
        if (MT == MK_CAUSAL) full = (32 * kt + 31 <= ma.q0[s]);
        if (MT == MK_WIN) full = (32 * kt + 31 <= ma.q0[s]) && (32 * kt >= ma.q0[s] + 31 - 511);
        if (MT == MK_SLC) full = (32 * kt + 31 <= ma.q0[s]) && __all(selbit != 0u);
        if (MT == MK_BITS || MT == MK_CMP) full = false;
        float p[16];
        if (full) {
#pragma unroll
            for (int r = 0; r < 16; ++r) p[r] = MODE == 0 ? fast_exp2(acc[r]) : acc[r];
        } else if (MT == MK_BITS) {
            const unsigned wsh = mw[s] >> (8 * hi);
#pragma unroll
            for (int r = 0; r < 16; ++r) { const int m = ((int)(wsh << (31 - (16 * (r >> 3) + (r & 7))))) >> 31;
                p[r] = __builtin_bit_cast(float, __builtin_bit_cast(unsigned, fast_exp2(acc[r])) & (unsigned)m); }
        } else {
            const unsigned w = mw[s];
#pragma unroll
            for (int r = 0; r < 16; ++r) { const int key = kb + 16 * (r >> 3) + (r & 7); bool v = true;
                if (MT == MK_CAUSAL) v = key <= tq;
                if (MT == MK_WIN) v = (key <= tq) && (key >= tq - 511);
                if (MT == MK_SLC) v = (key <= tq) && (selbit != 0u);
                if (MT == MK_BITS) v = (w >> (8 * hi + 16 * (r >> 3) + (r & 7))) & 1u;
                if (MT == MK_CMP) v = key <= ma.nmax;
                const float e = MODE == 0 ? fast_exp2(acc[r]) : acc[r];
                p[r] = v ? e : 0.f; }
        }
        if (MODE == 0) { float a = 0.f;
#pragma unroll
            for (int r = 0; r < 16; ++r) a += p[r];
            lsum[s] += a; }
        bf16x8 pk0, pk1;
        { v4u t0, t1; t0.x = pk2(p[0], p[1]); t0.y = pk2(p[2], p[3]); t0.z = pk2(p[4], p[5]); t0.w = pk2(p[6], p[7]);
          t1.x = pk2(p[8], p[9]); t1.y = pk2(p[10], p[11]); t1.z = pk2(p[12], p[13]); t1.w = pk2(p[14], p[15]);
          pk0 = __builtin_bit_cast(bf16x8, t0); pk1 = __builtin_bit_cast(bf16x8, t1); }
#pragma unroll
        for (int nt = 0; nt < NT; ++nt) { O[s][nt] = __builtin_amdgcn_mfma_f32_32x32x16_bf16(pk0, vf[0][nt], O[s][nt], 0, 0, 0);
                                          O[s][nt] = __builtin_amdgcn_mfma_f32_32x32x16_bf16(pk1, vf[1][nt], O[s][nt], 0, 0, 0); }
        if (NS >= 3) __builtin_amdgcn_sched_barrier(0);
    }
}
__device__ __forceinline__ int crow(int r, int hi) { return (r & 3) + 8 * (r >> 2) + 4 * hi; }
template <int NT, bool ADD>
__device__ __forceinline__ void store_o(const f32x16 (&O)[NT], float f, bf16* Y, int row0, int col0, int lane) {
    const int r32 = lane & 31, hi = lane >> 5;
    unsigned ybase = (unsigned)((row0 + 4 * hi) * 1024 + col0 + r32); asm volatile("" : "+v"(ybase));
#pragma unroll
    for (int rh = 0; rh < 2; ++rh) {
        unsigned short old[NT][8];
        if (ADD) {
#pragma unroll
            for (int ri = 0; ri < 8; ++ri)
#pragma unroll
                for (int nt = 0; nt < NT; ++nt) { const int r = 8 * rh + ri; old[nt][ri] = Y[ybase + (unsigned)(((r & 3) + 8 * (r >> 2)) * 1024) + 32 * nt]; }
        }
#pragma unroll
        for (int ri = 0; ri < 8; ++ri) { const int r = 8 * rh + ri; const int q = crow(r, hi); const float fr = __shfl(f, q);
            const unsigned yo = ybase + (unsigned)(((r & 3) + 8 * (r >> 2)) * 1024);
#pragma unroll
            for (int nt = 0; nt < NT; ++nt) { float v = O[nt][r] * fr; if (ADD) v += bf2f(old[nt][ri]); Y[yo + 32 * nt] = (bf16)f2bf(v); } }
    }
}
template <int NS> __device__ __forceinline__ void stage_q(LAS bf16x8* ql, const bf16* const (&qrow)[NS], int lane) {
    const int hi = lane >> 5;
#pragma unroll
    for (int s = 0; s < NS; ++s)
#pragma unroll
        for (int ks = 0; ks < 4; ++ks) ql[(s * 4 + ks) * 64] = ld8(qrow[s] + 16 * ks + 8 * hi);
    LDS_WAIT(); asm volatile("" ::: "memory");
}
__device__ __forceinline__ void q32_load(const bf16* p  , float (&v)[4][8]) {
    v4u raw[4];
#pragma unroll
    for (int ks = 0; ks < 4; ++ks) raw[ks] = *(const GAS v4u*)(p + 16 * ks);
#pragma unroll
    for (int ks = 0; ks < 4; ++ks) { v[ks][0] = bflo(raw[ks].x); v[ks][1] = bfhi(raw[ks].x); v[ks][2] = bflo(raw[ks].y); v[ks][3] = bfhi(raw[ks].y);
        v[ks][4] = bflo(raw[ks].z); v[ks][5] = bfhi(raw[ks].z); v[ks][6] = bflo(raw[ks].w); v[ks][7] = bfhi(raw[ks].w); }
}
__device__ __forceinline__ void q32_xf(float (&v)[4][8], const float* gain, bool rope, int t, float scale, int hi, const float* tab) {
    if (gain) { float ss = 0.f;
#pragma unroll
        for (int ks = 0; ks < 4; ++ks)
#pragma unroll
            for (int j = 0; j < 8; ++j) ss += v[ks][j] * v[ks][j];
        ss += __shfl_xor(ss, 32);
        const float r = __builtin_amdgcn_rsqf(ss * (1.f / 64.f) + EPS);
#pragma unroll
        for (int ks = 0; ks < 4; ++ks) { const f32x4 g0 = *(const GAS f32x4*)(gain + 16 * ks + 8 * hi), g1 = *(const GAS f32x4*)(gain + 16 * ks + 8 * hi + 4);
#pragma unroll
            for (int j = 0; j < 4; ++j) { v[ks][j] *= r * g0[j]; v[ks][4 + j] *= r * g1[j]; } } }
    if (rope) { const float* tr = tab + (size_t)t * 64 + 8 * hi;
#pragma unroll
        for (int ks = 0; ks < 2; ++ks) { const f32x4 c0 = *(const GAS f32x4*)(tr + 16 * ks), c1 = *(const GAS f32x4*)(tr + 16 * ks + 4), s0 = *(const GAS f32x4*)(tr + 32 + 16 * ks), s1 = *(const GAS f32x4*)(tr + 36 + 16 * ks);
#pragma unroll
            for (int j = 0; j < 8; ++j) { const float c = j < 4 ? c0[j & 3] : c1[j & 3], sn = j < 4 ? s0[j & 3] : s1[j & 3]; const float a = v[ks][j], b = v[ks + 2][j];
                v[ks][j] = a * c - b * sn; v[ks + 2][j] = b * c + a * sn; } } }
#pragma unroll
    for (int ks = 0; ks < 4; ++ks)
#pragma unroll
        for (int j = 0; j < 8; ++j) v[ks][j] *= scale;
}
__device__ __forceinline__ bf16x8 q32_pack(const float (&v)[8]) { v4u o; o.x = pk2(v[0], v[1]); o.y = pk2(v[2], v[3]); o.z = pk2(v[4], v[5]); o.w = pk2(v[6], v[7]); return __builtin_bit_cast(bf16x8, o); }
template <int NS> __device__ __forceinline__ void stage_q_xf(Frame& F, LAS bf16x8* ql, const bf16* const (&qrow)[NS], const int (&tpos)[NS], const float* gain, bool rope, float scale) {
    const int hi = F.lane >> 5; const float* tab = (const float*)(F.ws + WS_ROPE);
#pragma unroll
    for (int s = 0; s < NS; ++s) { float v[4][8]; q32_load(qrow[s] + 8 * hi, v); q32_xf(v, gain, rope, tpos[s], scale, hi, tab);
#pragma unroll
        for (int ks = 0; ks < 4; ++ks) ql[(s * 4 + ks) * 64] = q32_pack(v[ks]); }
    LDS_WAIT(); asm volatile("" ::: "memory");
}
__device__ __forceinline__ LAS bf16x8* wave_q(Frame& F) { return (LAS bf16x8*)(F.lds + F.wave * 16384) + F.lane; }
template <int NS, int NT> __device__ __forceinline__ void zero_o(f32x16 (&O)[NS][NT], float (&l)[NS]) {
#pragma unroll
    for (int s = 0; s < NS; ++s) { l[s] = 0.f;
#pragma unroll
        for (int nt = 0; nt < NT; ++nt)
#pragma unroll
            for (int r = 0; r < 16; ++r) O[s][nt][r] = 0.f; }
}

__device__ __forceinline__ void mem_task(Frame& F, int task, int Ly, const bf16* PROJ, int ldp, int qmcol) {
    const int qb = task & 31, h = (task >> 5) & 3, b = task >> 7; const int r32 = F.lane & 31;
    const int row0 = b * SEQ + 64 * qb;
    const bf16* qrow[2] = {PROJ + (size_t)(row0 + r32) * ldp + qmcol + h * 64, PROJ + (size_t)(row0 + 32 + r32) * ldp + qmcol + h * 64};
    LAS bf16x8* ql = wave_q(F); { const int tp[2] = {0, 0}; stage_q_xf<2>(F, ql, qrow, tp, F.ka->in[10] + Ly * 64, false, QSCALE); }
    KVp kv{(const bf16*)(F.ws + WS_MK) + ((size_t)((Ly * NB + b) * 4 + h) * NMEMT) * 64, 64, (const bf16*)(F.ws + WS_MVT) + ((size_t)(Ly * NB + b) * 256 + h * 64) * NMEMT, NMEMT};
    f32x16 O[2][2]; float l[2]; zero_o<2, 2>(O, l);
    MaskArg ma{}; const unsigned* mbr[2] = {nullptr, nullptr};
    const float negb = 0.f;
    attn_core<2, 2, 0, MK_NONE>(ql, kv, 0, NMEMT / 32, negb, ma, mbr, O, l, F.lane);
    bf16* Y = (bf16*)(F.ws + WS_Y);
#pragma unroll
    for (int s = 0; s < 2; ++s) { const float lt = l[s] + __shfl_xor(l[s], 32); store_o<2, false>(O[s], (DBG_ZERO & 8) ? 0.f : 1.f / lt, Y, row0 + 32 * s, 768 + h * 64, F.lane); }
}
__device__ __forceinline__ void ret_epilogue(Frame& F, const f32x16 (&O)[4], int rowb, int h, const bf16* PROJ) {
    const int r32 = F.lane & 31, hi = F.lane >> 5;
    bf16* Y = (bf16*)(F.ws + WS_Y);
#pragma unroll
    for (int rh = 0; rh < 2; ++rh) {
        unsigned short gv[8][4];
#pragma unroll
        for (int ri = 0; ri < 8; ++ri) { const int r = 8 * rh + ri; const bf16* gp = PROJ + (size_t)(rowb + crow(r, hi)) * RET_LD + RET_G + h * 128 + r32;
#pragma unroll
            for (int nt = 0; nt < 4; ++nt) gv[ri][nt] = gp[32 * nt]; }
#pragma unroll
        for (int ri = 0; ri < 8; ++ri) { const int r = 8 * rh + ri;
            float a = (O[0][r] + O[1][r]) + (O[2][r] + O[3][r]);
#pragma unroll
            for (int o = 1; o < 32; o <<= 1) a += __shfl_xor(a, o);
            const float mu = a * (1.f / 128.f);
            float d0 = O[0][r] - mu, d1 = O[1][r] - mu, d2 = O[2][r] - mu, d3 = O[3][r] - mu;
            float q = (d0 * d0 + d1 * d1) + (d2 * d2 + d3 * d3);
#pragma unroll
            for (int o = 1; o < 32; o <<= 1) q += __shfl_xor(q, o);
            const float rstd = __builtin_amdgcn_rsqf(q * (1.f / 128.f) + EPS);
            const int row = rowb + crow(r, hi);
            bf16* yp = Y + (size_t)row * 1024 + h * 128 + r32;
            const float dd[4] = {d0, d1, d2, d3};
#pragma unroll
            for (int nt = 0; nt < 4; ++nt) { const float g = bf2f(gv[ri][nt]); const float sg = g * __builtin_amdgcn_rcpf(1.f + fast_exp2(-1.4426950408889634f * g));
                yp[32 * nt] = (DBG_ZERO & 1) ? (bf16)0 : (bf16)f2bf(sg * dd[nt] * rstd); }
        }
    }
}
__device__ __forceinline__ void glds16(const void* gsrc, unsigned lds_dst) { unsigned keep;
    asm volatile("s_mov_b32 %0, m0\n\ts_mov_b32 m0, %2\n\ts_nop 0\n\tglobal_load_lds_dwordx4 %1, off\n\ts_mov_b32 m0, %0" : "=&s"(keep) : "v"(gsrc), "s"(lds_dst) : "memory"); }
template <int NS, int MT, int R>
__device__ __forceinline__ void wg_attn(Frame& F, const LAS bf16x8* ql, const bf16* psrc, int pstep, unsigned ring_off, int kt0, int kt1, unsigned blk, int my0, int my1,
                                        const MaskArg& ma, const LAS unsigned* mlds, f32x16 (&O)[NS][2], float (&lsum)[NS]) {
    const unsigned pdst = (unsigned)(uintptr_t)F.lds + ring_off + (unsigned)F.wave * 1024u;
#define WG_NEED(k_) ((MT != MK_SLC) || (((blk) >> ((k_) >> 1)) & 1u))
#define WG_ADV(k_) do { ++(k_); } while ((k_) < kt1 && !WG_NEED(k_))
    int kd = kt0; if (kd < kt1 && !WG_NEED(kd)) WG_ADV(kd);
    int kc = kd;
    int sd = 0, sc = 0, nd = 0;
#pragma unroll 1
    for (int j = 0; j < R - 1; ++j) if (kd < kt1) { glds16(psrc + (size_t)kd * pstep, (unsigned)__builtin_amdgcn_readfirstlane(pdst + (unsigned)sd * 8192u)); WG_ADV(kd); sd = sd + 1 == R ? 0 : sd + 1; ++nd; }
#pragma unroll 1
    while (kc < kt1) {
        const int yo = nd - 1;
        if (yo >= 3) asm volatile("s_waitcnt vmcnt(3)\n\ts_barrier" ::: "memory");
        else if (yo == 2) asm volatile("s_waitcnt vmcnt(2)\n\ts_barrier" ::: "memory");
        else if (yo == 1) asm volatile("s_waitcnt vmcnt(1)\n\ts_barrier" ::: "memory");
        else asm volatile("s_waitcnt vmcnt(0)\n\ts_barrier" ::: "memory");
        if (kd < kt1) { glds16(psrc + (size_t)kd * pstep, (unsigned)__builtin_amdgcn_readfirstlane(pdst + (unsigned)sd * 8192u)); WG_ADV(kd); sd = sd + 1 == R ? 0 : sd + 1; ++nd; }
        if (kc >= my0 && kc < my1) {
            unsigned selbit = 1u; bool active = true;
            if (MT == MK_SLC) { selbit = (ma.sel >> (kc >> 1)) & 1u; active = __any(selbit != 0u); }
            if (active) {
                const LAS bf16x8* sp = (const LAS bf16x8*)(F.lds + ring_off + sc * 8192) + F.lane;
                bf16x8 kf[4], vf[2][2];
#pragma unroll
                for (int ks = 0; ks < 4; ++ks) kf[ks] = sp[ks * 64];
#pragma unroll
                for (int nt = 0; nt < 2; ++nt) { vf[0][nt] = sp[(4 + 2 * nt) * 64]; vf[1][nt] = sp[(5 + 2 * nt) * 64]; }
                unsigned mw[NS];
#pragma unroll
                for (int s = 0; s < NS; ++s) mw[s] = (MT == MK_BITS) ? mlds[kc] : 0u;
                tile_math<NS, 2, 0, MT>(kf, vf, ql, kc, ma, mw, selbit, O, lsum, F.lane);
            }
        }
        WG_ADV(kc); sc = sc + 1 == R ? 0 : sc + 1; --nd;
    }
    asm volatile("s_waitcnt vmcnt(0)\n\ts_barrier" ::: "memory");
#undef WG_NEED
#undef WG_ADV
}
constexpr int RWG_SLOT = 12288, RWG_R = 9;
__device__ __forceinline__ void ret_wg_task(Frame& F, int task, const bf16* PROJ) {
    const int qb = 7 - (task & 7), h = (task >> 3) % 6, b = (task >> 3) / 6, w = F.wave; const int r32 = F.lane & 31, hi = F.lane >> 5;
    const int rowb = b * SEQ + 256 * qb + 32 * w;
    bf16x8 qf[4];
    { float v[4][8]; q32_load(PROJ + (size_t)(rowb + r32) * RET_LD + RET_Q + h * 64 + 8 * hi, v);
      const int t = 256 * qb + 32 * w + r32; const float lg = __builtin_amdgcn_logf(1.0f - __builtin_amdgcn_exp2f(-5.0f - (float)h));
      q32_xf(v, nullptr, true, t, __builtin_amdgcn_exp2f((float)t * lg), hi, (const float*)(F.ws + WS_ROPE));
#pragma unroll
      for (int ks = 0; ks < 4; ++ks) qf[ks] = q32_pack(v[ks]); }
    asm volatile("s_waitcnt vmcnt(0)" : "+v"(qf[0]), "+v"(qf[1]), "+v"(qf[2]), "+v"(qf[3]) :: "memory");
    const int kperm = (r32 & 0x13) | ((r32 & 4) << 1) | ((r32 & 8) >> 1);
    const bf16* ksrc = PROJ + (size_t)(b * SEQ + kperm) * RET_LD + RET_K + h * 64 + 16 * (w & 3) + 8 * hi;
    const bf16* vsrc = (const bf16*)F.out + ((size_t)b * 768 + h * 128 + 32 * (w >> 1) + r32) * SEQ + 16 * (w & 1) + 8 * hi;
    const unsigned lds0 = (unsigned)(uintptr_t)F.lds;
    const unsigned kdst = lds0 + (unsigned)(w & 3) * 1024u, vdst = lds0 + 4096u + (unsigned)w * 1024u;
    const int kt1 = 8 * qb + 8, my1 = 8 * qb + w + 1;
#define RWG_DMA(t_, slot_) do { const int tt_ = (t_) < kt1 ? (t_) : kt1 - 1; const unsigned so_ = (unsigned)(((t_) < kt1) ? (slot_) : RWG_R) * RWG_SLOT; \
        if (w < 4) glds16(ksrc + (size_t)(32 * tt_) * RET_LD, (unsigned)__builtin_amdgcn_readfirstlane(kdst + so_)); \
        glds16(vsrc + 32 * tt_, (unsigned)__builtin_amdgcn_readfirstlane(vdst + so_)); } while (0)
    f32x16 O[4];
#pragma unroll
    for (int nt = 0; nt < 4; ++nt)
#pragma unroll
        for (int r = 0; r < 16; ++r) O[nt][r] = 0.f;
#pragma unroll 1
    for (int j = 0; j < RWG_R - 1; ++j) RWG_DMA(j, j);
    int slot = 0, fslot = RWG_R - 1;
#pragma unroll 1
    for (int kt = 0; kt < kt1; ++kt) {
        if (w < 4) asm volatile("s_waitcnt vmcnt(%0)\n\ts_barrier" :: "n"(2 * (RWG_R - 2)) : "memory");
        else       asm volatile("s_waitcnt vmcnt(%0)\n\ts_barrier" :: "n"(RWG_R - 2) : "memory");
        RWG_DMA(kt + RWG_R - 1, fslot);
        if (kt < my1) {
            const LAS bf16x8* sp = (const LAS bf16x8*)(F.lds + slot * RWG_SLOT) + F.lane;
            bf16x8 kf[4], vf[2][4];
#pragma unroll
            for (int ks = 0; ks < 4; ++ks) kf[ks] = sp[ks * 64];
#pragma unroll
            for (int nt = 0; nt < 4; ++nt) { vf[0][nt] = sp[(4 + 2 * nt) * 64]; vf[1][nt] = sp[(5 + 2 * nt) * 64]; }
            f32x16 acc;
#pragma unroll
            for (int r = 0; r < 16; ++r) acc[r] = 0.f;
#pragma unroll
            for (int ks = 0; ks < 4; ++ks) acc = __builtin_amdgcn_mfma_f32_32x32x16_bf16(kf[ks], qf[ks], acc, 0, 0, 0);
            float p[16];
            if (kt + 1 < my1) {
#pragma unroll
                for (int r = 0; r < 16; ++r) p[r] = acc[r];
            } else {
#pragma unroll
                for (int r = 0; r < 16; ++r) p[r] = (8 * hi + 16 * (r >> 3) + (r & 7) <= r32) ? acc[r] : 0.f;
            }
            bf16x8 pk0, pk1;
            { v4u t0, t1; t0.x = pk2(p[0], p[1]); t0.y = pk2(p[2], p[3]); t0.z = pk2(p[4], p[5]); t0.w = pk2(p[6], p[7]);
              t1.x = pk2(p[8], p[9]); t1.y = pk2(p[10], p[11]); t1.z = pk2(p[12], p[13]); t1.w = pk2(p[14], p[15]);
              pk0 = __builtin_bit_cast(bf16x8, t0); pk1 = __builtin_bit_cast(bf16x8, t1); }
#pragma unroll
            for (int nt = 0; nt < 4; ++nt) { O[nt] = __builtin_amdgcn_mfma_f32_32x32x16_bf16(pk0, vf[0][nt], O[nt], 0, 0, 0);
                                             O[nt] = __builtin_amdgcn_mfma_f32_32x32x16_bf16(pk1, vf[1][nt], O[nt], 0, 0, 0); }
        }
        fslot = slot; slot = slot + 1 == RWG_R ? 0 : slot + 1;
    }
    asm volatile("s_waitcnt vmcnt(0)\n\ts_barrier" ::: "memory");
#undef RWG_DMA
    ret_epilogue(F, O, rowb, h, PROJ);
}
__device__ __forceinline__ void ret_task(Frame& F, int task, const bf16* PROJ) {
    const int qb = 31 - (task & 31), h = (task >> 5) % 6, b = (task >> 5) / 6; const int r32 = F.lane & 31, hi = F.lane >> 5;
    const int row0 = b * SEQ + 64 * qb;
    const bf16* qrow[2] = {PROJ + (size_t)(row0 + r32) * RET_LD + RET_Q + h * 64, PROJ + (size_t)(row0 + 32 + r32) * RET_LD + RET_Q + h * 64};
    LAS bf16x8* ql = wave_q(F); stage_q<2>(ql, qrow, F.lane);
    KVp kv{PROJ + (size_t)(b * SEQ) * RET_LD + RET_K + h * 64, RET_LD, (const bf16*)F.out + ((size_t)b * 768 + h * 128) * SEQ, SEQ};
    f32x16 O[2][4]; float l[2]; zero_o<2, 4>(O, l);
    MaskArg ma{}; ma.q0[0] = 64 * qb; ma.q0[1] = 64 * qb + 32; const unsigned* mbr[2] = {nullptr, nullptr};
    ma.lg = __builtin_amdgcn_logf(1.0f - __builtin_amdgcn_exp2f(-5.0f - (float)h));
    attn_core<2, 4, RET_MODE, MK_CAUSAL, 1>(ql, kv, 0, 2 * qb + 2, 0.f, ma, mbr, O, l, F.lane);
#pragma unroll
    for (int s = 0; s < 2; ++s) ret_epilogue(F, O[s], row0 + 32 * s, h, PROJ);
}

typedef _Float16 h2_t __attribute__((ext_vector_type(2)));
__device__ __forceinline__ unsigned pkh(float a, float b) { h2_t v = {(_Float16)a, (_Float16)b}; return __builtin_bit_cast(unsigned, v); }
__device__ __forceinline__ void dsa_d1_task(Frame& F, int task, const bf16* PROJ) {
    const int b = task / 288; int rem = task % 288; int qb = 63, kc = 0;
    { int grp = 7; while (rem >= 8 * (grp + 1)) { rem -= 8 * (grp + 1); --grp; }
      qb = 8 * grp + 7 - rem / (grp + 1); kc = rem % (grp + 1); }
    const int r32 = F.lane & 31, hi = F.lane >> 5; const int row = b * SEQ + 32 * qb + r32;
    const bf16* qp = PROJ + (size_t)row * DSA_LD + DSA_IQ + 8 * hi;
    bf16x8 qf[4][4]; LAS bf16x8* ql = wave_q(F);
    { const int tpos = 32 * qb + r32; const float* tab = (const float*)(F.ws + WS_ROPE);
#pragma unroll
      for (int h = 0; h < 8; ++h) { float v[4][8]; q32_load(qp + h * 64, v); q32_xf(v, nullptr, true, tpos, 1.f, hi, tab);
#pragma unroll
          for (int ks = 0; ks < 4; ++ks) { const bf16x8 f = q32_pack(v[ks]); if (h < 4) qf[h & 3][ks] = f; else ql[((h & 3) * 4 + ks) * 64] = f; } } }
    LDS_WAIT(); asm volatile("" ::: "memory");
    float iw[8];
    { const v4u w = *(const GAS v4u*)(PROJ + (size_t)row * DSA_LD + DSA_IW); iw[0] = bflo(w.x); iw[1] = bfhi(w.x); iw[2] = bflo(w.y); iw[3] = bfhi(w.y); iw[4] = bflo(w.z); iw[5] = bfhi(w.z); iw[6] = bflo(w.w); iw[7] = bfhi(w.w); }
    const int kperm = (r32 & 0x13) | ((r32 & 4) << 1) | ((r32 & 8) >> 1);
    const bf16* kp = PROJ + (size_t)(b * SEQ + kperm) * DSA_LD + DSA_IK + 8 * hi;
    _Float16* sc = (_Float16*)(F.ws + WS_SC) + (size_t)row * SEQ + 8 * hi;
    const int kt1 = (8 * kc + 8 < qb + 1) ? 8 * kc + 8 : qb + 1;
    bf16x8 kf[4], kfn[4];
#pragma unroll
    for (int ks = 0; ks < 4; ++ks) kf[ks] = ld8(kp + (size_t)(32 * (8 * kc)) * DSA_LD + 16 * ks);
#pragma unroll 1
    for (int kt = 8 * kc; kt < kt1; ++kt) {
        { const int ktn = kt + 1 < kt1 ? kt + 1 : kt;
#pragma unroll
          for (int ks = 0; ks < 4; ++ks) kfn[ks] = ld8(kp + (size_t)(32 * ktn) * DSA_LD + 16 * ks); }
        float s[16];
#pragma unroll
        for (int r = 0; r < 16; ++r) s[r] = 0.f;
#pragma unroll
        for (int h = 0; h < 8; ++h) { f32x16 acc;
#pragma unroll
            for (int r = 0; r < 16; ++r) acc[r] = 0.f;
#pragma unroll
            for (int ks = 0; ks < 4; ++ks) acc = __builtin_amdgcn_mfma_f32_32x32x16_bf16(kf[ks], h < 4 ? qf[h & 3][ks] : ql[((h & 3) * 4 + ks) * 64], acc, 0, 0, 0);
#pragma unroll
            for (int r = 0; r < 16; ++r) s[r] += iw[h] * fmaxf(acc[r], 0.f);
            __builtin_amdgcn_sched_barrier(0); }
        v4u o0, o1; o0.x = pkh(s[0], s[1]); o0.y = pkh(s[2], s[3]); o0.z = pkh(s[4], s[5]); o0.w = pkh(s[6], s[7]);
        o1.x = pkh(s[8], s[9]); o1.y = pkh(s[10], s[11]); o1.z = pkh(s[12], s[13]); o1.w = pkh(s[14], s[15]);
        *(GAS v4u*)(sc + 32 * kt) = o0; *(GAS v4u*)(sc + 32 * kt + 16) = o1;
#pragma unroll
        for (int ks = 0; ks < 4; ++ks) kf[ks] = kfn[ks];
    }
}
__device__ __forceinline__ int hist_select(LAS unsigned* hist, const unsigned (&key)[32], bool lvl2, unsigned B, int target, int lane) {
    { unsigned z = 0u; asm volatile("" : "+v"(z)); *(LAS v4u*)(hist + 4 * lane) = (v4u){z, z, z, z}; }
    LDS_WAIT(); asm volatile("" ::: "memory");
#pragma unroll
    for (int e = 0; e < 32; ++e) { const unsigned d = lvl2 ? (key[e] & 255u) : (key[e] >> 8); const bool m = lvl2 ? ((key[e] >> 8) == B) : true;
        if (m) __hip_atomic_fetch_add(hist + d, 1u, __ATOMIC_RELAXED, __HIP_MEMORY_SCOPE_WAVEFRONT); }
    LDS_WAIT(); asm volatile("" ::: "memory");
    const v4u c = *(LAS v4u*)(hist + 4 * lane);
    const int s = (int)(c.x + c.y + c.z + c.w);
    int S = s;
#pragma unroll
    for (int o = 1; o < 64; o <<= 1) { const int v = __shfl_down(S, o); if (lane + o < 64) S += v; }
    const unsigned long long bm = __ballot(S >= target);
    const int Ls = 63 - __clzll(bm);
    int a = S - s, dig, abv;
    if (a + (int)c.w >= target) { dig = 3; abv = a; } else { a += (int)c.w;
        if (a + (int)c.z >= target) { dig = 2; abv = a; } else { a += (int)c.z;
            if (a + (int)c.y >= target) { dig = 1; abv = a; } else { a += (int)c.y; dig = 0; abv = a; } } }
    const int packed = ((4 * lane + dig) << 12) | abv;
    const int r = __shfl(packed, Ls);
    LDS_WAIT(); asm volatile("" ::: "memory");
    return r;
}
__device__ __forceinline__ void d2_load(Frame& F, int row, v4u (&raw)[4]) {
    const int t = row % SEQ, lane = F.lane;
    const unsigned short* sp = (const unsigned short*)(F.ws + WS_SC) + (size_t)row * SEQ + (32 * lane <= t ? 32 * lane : 0);
#pragma unroll
    for (int i = 0; i < 4; ++i) raw[i] = *(const GAS v4u*)(sp + 8 * i);
}
__device__ __forceinline__ void dsa_d2_row(Frame& F, int row, const v4u (&raw)[4]) {
    const int t = row % SEQ, lane = F.lane;
    unsigned* mbp = (unsigned*)(F.ws + WS_MB) + (size_t)row * 64;
    int nvalid = t + 1 - 32 * lane; nvalid = nvalid < 0 ? 0 : (nvalid > 32 ? 32 : nvalid);
    const unsigned cb = nvalid == 32 ? 0xffffffffu : ((1u << nvalid) - 1u);
    if (t < 256) { mbp[lane] = cb; return; }
    unsigned key[32];
#pragma unroll
    for (int i = 0; i < 4; ++i) { const unsigned w[4] = {raw[i].x, raw[i].y, raw[i].z, raw[i].w};
#pragma unroll
        for (int j = 0; j < 4; ++j) {
#pragma unroll
            for (int k = 0; k < 2; ++k) { const int e = 8 * i + 2 * j + k; const unsigned u = (w[j] >> (16 * k)) & 0xffffu;
                const unsigned sk = (u & 0x8000u) ? (~u & 0xffffu) : (u | 0x8000u);
                key[e] = (e < nvalid) ? sk : 0u; } } }
    LAS unsigned* hist = (LAS unsigned*)(F.lds + F.wave * 16384);
    const int d1 = hist_select(hist, key, false, 0u, 256, lane);
    const unsigned Bh = (unsigned)d1 >> 12; const int above1 = d1 & 0xfff;
    const int d2 = hist_select(hist, key, true, Bh, 256 - above1, lane);
    const unsigned T = (Bh << 8) | ((unsigned)d2 >> 12);
    const int cgt = above1 + (d2 & 0xfff);
    unsigned g = 0, eq = 0;
#pragma unroll
    for (int e = 0; e < 32; ++e) { unsigned bg = key[e] > T ? 1u : 0u, be = key[e] == T ? 1u : 0u; asm volatile("" : "+v"(bg), "+v"(be));
        g |= bg << e; eq |= be << e; }
    const int need = 256 - cgt; const int myeq = __popc(eq);
    int incl = myeq;
#pragma unroll
    for (int o = 1; o < 64; o <<= 1) { const int v = __shfl_up(incl, o); if (lane >= o) incl += v; }
    const int pre = incl - myeq; int take = need - pre; take = take < 0 ? 0 : (take > myeq ? myeq : take);
    unsigned te = eq; int cnt = myeq;
    while (cnt > take) { te &= ~(1u << (31 - __clz(te))); --cnt; }
    mbp[lane] = (g | te) & cb;
}
__device__ __forceinline__ void dsa_d3_task(Frame& F, int task, const bf16* PROJ) {
    const int hg = task & 3, qb = 63 - ((task >> 2) & 63), b = task >> 8; const int r32 = F.lane & 31;
    const int row0 = b * SEQ + 32 * qb;
    const bf16* qrow[3]; const unsigned* mbr[3];
#pragma unroll
    for (int s = 0; s < 3; ++s) { qrow[s] = PROJ + (size_t)(row0 + r32) * DSA_LD + DSA_Q + (3 * hg + s) * 64; mbr[s] = (const unsigned*)(F.ws + WS_MB) + (size_t)(row0 + r32) * 64; }
    LAS bf16x8* ql = wave_q(F); stage_q<3>(ql, qrow, F.lane);
    KVp kv{PROJ + (size_t)(b * SEQ) * DSA_LD + DSA_K, DSA_LD, (const bf16*)F.out + (size_t)b * 64 * SEQ, SEQ};
    f32x16 O[3][2]; float l[3]; zero_o<3, 2>(O, l);
    MaskArg ma{}; ma.q0[0] = ma.q0[1] = ma.q0[2] = 32 * qb;
    const float negb = 0.f;
    attn_core<3, 2, 0, MK_BITS, 2>(ql, kv, 0, qb + 1, negb, ma, mbr, O, l, F.lane);
    bf16* Y = (bf16*)(F.ws + WS_Y);
#pragma unroll
    for (int s = 0; s < 3; ++s) { const float lt = l[s] + __shfl_xor(l[s], 32); store_o<2, false>(O[s], (DBG_ZERO & 2) ? 0.f : 1.f / lt, Y, row0, (3 * hg + s) * 64, F.lane); }
}

constexpr unsigned D3_MOFF = 98304u, D3_ROFF = 98304u + 64u * 65u * 4u;
__device__ __forceinline__ void dsa_d3_wg_task(Frame& F, int task, const bf16* PROJ) {
    const int qb = 31 - (task & 31), b = task >> 5, w = F.wave, qs = w >> 2, hg = w & 3; const int r32 = F.lane & 31, hi = F.lane >> 5;
    const int row0 = b * SEQ + 64 * qb + 32 * qs;
    const bf16* qrow[3];
#pragma unroll
    for (int s = 0; s < 3; ++s) qrow[s] = PROJ + (size_t)(row0 + r32) * DSA_LD + DSA_Q + (3 * hg + s) * 64;
    LAS bf16x8* ql = (LAS bf16x8*)(F.lds + w * 12288) + F.lane; { const int tq_ = 64 * qb + 32 * qs + r32; const int tp[3] = {tq_, tq_, tq_}; stage_q_xf<3>(F, ql, qrow, tp, F.ka->in[14], true, QSCALE); }
    { const unsigned* mb = (const unsigned*)(F.ws + WS_MB) + (size_t)(b * SEQ + 64 * qb) * 64; LAS unsigned* ml = (LAS unsigned*)(F.lds + D3_MOFF);
#pragma unroll
      for (int j = 0; j < 2; ++j) { const int e = (F.tid + 512 * j) * 4, row = e >> 6, col = e & 63; const v4u m = *(const GAS v4u*)(mb + e);
          ml[row * 65 + col] = m.x; ml[row * 65 + col + 1] = m.y; ml[row * 65 + col + 2] = m.z; ml[row * 65 + col + 3] = m.w; } }
    asm volatile("s_waitcnt vmcnt(0) lgkmcnt(0)\n\ts_barrier" ::: "memory");
    const int kperm = (r32 & 0x13) | ((r32 & 4) << 1) | ((r32 & 8) >> 1);
    const bf16* psrc; int pstep;
    if (w < 4) { psrc = PROJ + (size_t)(b * SEQ + kperm) * DSA_LD + DSA_K + 16 * w + 8 * hi; pstep = 32 * DSA_LD; }
    else { const int j = w - 4; psrc = (const bf16*)F.out + ((size_t)b * 64 + 32 * (j >> 1) + r32) * SEQ + 16 * (j & 1) + 8 * hi; pstep = 32; }
    f32x16 O[3][2]; float l[3]; zero_o<3, 2>(O, l);
    MaskArg ma{}; ma.q0[0] = ma.q0[1] = ma.q0[2] = 64 * qb + 32 * qs;
    const LAS unsigned* mlds = (const LAS unsigned*)(F.lds + D3_MOFF) + (qs * 32 + r32) * 65;
    wg_attn<3, MK_BITS, 3>(F, ql, psrc, pstep, D3_ROFF, 0, 2 * qb + 2, 0xffffffffu, 0, 2 * qb + qs + 1, ma, mlds, O, l);
    bf16* Y = (bf16*)(F.ws + WS_Y);
#pragma unroll
    for (int s = 0; s < 3; ++s) { const float lt = l[s] + __shfl_xor(l[s], 32); store_o<2, false>(O[s], (DBG_ZERO & 2) ? 0.f : 1.f / lt, Y, row0, (3 * hg + s) * 64, F.lane); }
}

__device__ __forceinline__ void nsa_cmp_task(Frame& F, int task, int chunk, const bf16* PROJ, const float* kn0) {
    const int nb = task & 3, g = (task >> 2) & 3, b = task >> 4; const int r32 = F.lane & 31, hi = F.lane >> 5;
    const int n = 32 * nb + r32, nc = n > 126 ? 126 : n;
    const bf16* arow = PROJ + (size_t)(b * SEQ + 16 * nc) * NSA_LD + 64 * g + 8 * hi;
    const bf16* WkT = (const bf16*)(F.ws + WS_CMPW); const bf16* WvT = WkT + 64 * 2048;
    const bf16* wkp = WkT + (size_t)r32 * 2048 + 8 * hi; const bf16* wvp = WvT + (size_t)r32 * 2048 + 8 * hi;
    f32x16 Dk[2], Dv[2];
#pragma unroll
    for (int et = 0; et < 2; ++et)
#pragma unroll
        for (int r = 0; r < 16; ++r) { Dk[et][r] = 0.f; Dv[et][r] = 0.f; }
#pragma unroll 4
    for (int kk = 32 * chunk; kk < 32 * chunk + 32; ++kk) {
        const bf16* ap = arow + (size_t)(kk >> 2) * NSA_LD + 16 * (kk & 3);
        const bf16x8 kcf = ld8(ap + NSA_KC), vcf = ld8(ap + NSA_VC);
#pragma unroll
        for (int et = 0; et < 2; ++et) { const bf16x8 wk = ld8(wkp + (size_t)(32 * et) * 2048 + 16 * kk), wv = ld8(wvp + (size_t)(32 * et) * 2048 + 16 * kk);
            Dk[et] = __builtin_amdgcn_mfma_f32_32x32x16_bf16(wk, kcf, Dk[et], 0, 0, 0);
            Dv[et] = __builtin_amdgcn_mfma_f32_32x32x16_bf16(vcf, wv, Dv[et], 0, 0, 0); }
    }
    { LAS f32x4* pl = (LAS f32x4*)(F.lds + F.wave * 16384) + F.lane;
      if (chunk != 0) {
#pragma unroll
          for (int et = 0; et < 2; ++et)
#pragma unroll
              for (int c = 0; c < 4; ++c) { pl[(et * 4 + c) * 64] = (f32x4){Dk[et][4 * c], Dk[et][4 * c + 1], Dk[et][4 * c + 2], Dk[et][4 * c + 3]};
                                            pl[(8 + et * 4 + c) * 64] = (f32x4){Dv[et][4 * c], Dv[et][4 * c + 1], Dv[et][4 * c + 2], Dv[et][4 * c + 3]}; } }
      asm volatile("s_waitcnt vmcnt(0) lgkmcnt(0)\n\ts_barrier" ::: "memory");
      if (chunk != 0) return;
#pragma unroll 1
      for (int o = 1; o < 4; ++o) { const LAS f32x4* ql_ = pl + o * (16384 / 16);
#pragma unroll
          for (int et = 0; et < 2; ++et)
#pragma unroll
              for (int c = 0; c < 4; ++c) { const f32x4 a = ql_[(et * 4 + c) * 64], d = ql_[(8 + et * 4 + c) * 64];
#pragma unroll
                  for (int i = 0; i < 4; ++i) { Dk[et][4 * c + i] += a[i]; Dv[et][4 * c + i] += d[i]; } } } }
    const float* ck = (const float*)(F.ws + WS_CTL) + CW_CK; const float* cv = ck + 64;
    const float* tab = (const float*)(F.ws + WS_ROPE) + (size_t)(16 * nc + 31) * 64;
    float ss = 0.f;
#pragma unroll
    for (int et = 0; et < 2; ++et)
#pragma unroll
        for (int r = 0; r < 16; ++r) { Dk[et][r] += ck[32 * et + crow(r, hi)]; ss += Dk[et][r] * Dk[et][r]; }
    ss += __shfl_xor(ss, 32);
    const float rs = __builtin_amdgcn_rsqf(ss * (1.f / 64.f) + EPS);
    bf16* kout = (bf16*)(F.ws + WS_KCMP) + ((size_t)((b * 4 + g) * 128 + n)) * 64;
#pragma unroll
    for (int rq = 0; rq < 4; ++rq) { float o0[4], o1[4];
#pragma unroll
        for (int i = 0; i < 4; ++i) { const int r = 4 * rq + i, idx = crow(r, hi); const float v0 = Dk[0][r] * rs * kn0[idx], v1 = Dk[1][r] * rs * kn0[32 + idx];
            const float c = tab[idx], s = tab[32 + idx]; o0[i] = v0 * c - v1 * s; o1[i] = v1 * c + v0 * s; if (n > 126) { o0[i] = 0.f; o1[i] = 0.f; } }
        v2u w0, w1; w0.x = pk2(o0[0], o0[1]); w0.y = pk2(o0[2], o0[3]); w1.x = pk2(o1[0], o1[1]); w1.y = pk2(o1[2], o1[3]);
        *(GAS v2u*)(kout + 8 * rq + 4 * hi) = w0; *(GAS v2u*)(kout + 32 + 8 * rq + 4 * hi) = w1; }
    bf16* vout = (bf16*)(F.ws + WS_VCMPT) + ((size_t)((b * 4 + g) * 64)) * 128 + 32 * nb;
#pragma unroll
    for (int et = 0; et < 2; ++et) { const float cve = cv[32 * et + r32];
#pragma unroll
        for (int rq = 0; rq < 4; ++rq) { float o[4];
#pragma unroll
            for (int i = 0; i < 4; ++i) { const int nl = 8 * rq + 4 * hi + i; o[i] = (32 * nb + nl > 126) ? 0.f : Dv[et][4 * rq + i] + cve; }
            v2u w; w.x = pk2(o[0], o[1]); w.y = pk2(o[2], o[3]);
            *(GAS v2u*)(vout + (size_t)(32 * et + r32) * 128 + 8 * rq + 4 * hi) = w; } }
}
constexpr unsigned NSA_ROFF = 98304u;
template <bool WG>
__device__ NSA_INLINE void nsa_task(KArgs ka_, unsigned char* ws_, float* out_, LAS unsigned char* lds_, int wave_, int task, const bf16* PROJ) {
    Frame F; F.ka = ka_; F.ws = ws_; F.out = out_; F.lds = lds_; F.wave = wave_; F.MISC = (volatile LAS unsigned*)(lds_ + LDS_CTRL + 64);
    asm volatile("v_mbcnt_lo_u32_b32 %0, -1, 0\n\tv_mbcnt_hi_u32_b32 %0, -1, %0" : "=v"(F.lane));
    const int qb8 = 7 - (task & 7);
    const int g = WG ? (task >> 3) & 3 : task & 3, qb = WG ? 8 * qb8 + wave_ : 63 - ((task >> 2) & 63), b = WG ? task >> 5 : task >> 8; const int r32 = F.lane & 31, hi = F.lane >> 5;
    const int row0 = b * SEQ + 32 * qb, tq = 32 * qb + r32;
    const bf16* qrow[3];
#pragma unroll
    for (int s = 0; s < 3; ++s) qrow[s] = PROJ + (size_t)(row0 + r32) * NSA_LD + NSA_Q + (3 * g + s) * 64;
    LAS bf16x8* ql = WG ? (LAS bf16x8*)(F.lds + F.wave * 12288) + F.lane : wave_q(F); { const int tp[3] = {tq, tq, tq}; stage_q_xf<3>(F, ql, qrow, tp, F.ka->in[17], true, QSCALE); }
#define NSA_GATE(s_, c_) (__builtin_amdgcn_rcpf(1.f + fast_exp2(-1.4426950408889634f * bf2f(PROJ[(size_t)(row0 + r32) * NSA_LD + NSA_GT + 9 * g + 3 * (s_) + (c_)]))))
    bf16* Y = (bf16*)(F.ws + WS_Y);
    MaskArg ma{}; ma.q0[0] = ma.q0[1] = ma.q0[2] = 32 * qb; ma.nmax = tq >= 31 ? (tq - 31) >> 4 : -1;
    const KVp kvc{(const bf16*)(F.ws + WS_KCMP) + (size_t)((b * 4 + g) * 128) * 64, 64, (const bf16*)(F.ws + WS_VCMPT) + (size_t)((b * 4 + g) * 64) * 128, 128};
    float imp[16];
#pragma unroll
    for (int r = 0; r < 16; ++r) imp[r] = 0.f;
#ifndef NSA_NO_A
    {   const int kperm = (r32 & 0x13) | ((r32 & 4) << 1) | ((r32 & 8) >> 1);
        const bf16* kp = kvc.K + (size_t)kperm * 64 + 8 * hi;
#pragma unroll 1
        for (int s = 0; s < 3; ++s) { f32x16 ia; float ls = 0.f;
#pragma unroll
            for (int r = 0; r < 16; ++r) ia[r] = 0.f;
#pragma unroll 1
            for (int kt = 0; kt < 4; ++kt) { f32x16 acc;
#pragma unroll
                for (int r = 0; r < 16; ++r) acc[r] = 0.f;
#pragma unroll
                for (int ks = 0; ks < 4; ++ks) acc = __builtin_amdgcn_mfma_f32_32x32x16_bf16(ld8(kp + (size_t)(32 * kt) * 64 + 16 * ks), ql[(s * 4 + ks) * 64], acc, 0, 0, 0);
                float p[16];
#pragma unroll
                for (int r = 0; r < 16; ++r) { const int key = 32 * kt + 8 * hi + 16 * (r >> 3) + (r & 7); p[r] = key <= ma.nmax ? fast_exp2(acc[r]) : 0.f; ls += p[r]; }
#pragma unroll
                for (int ks2 = 0; ks2 < 2; ++ks2) { v4u pw, cw; unsigned short cvv[8];
                    pw.x = pk2(p[8 * ks2], p[8 * ks2 + 1]); pw.y = pk2(p[8 * ks2 + 2], p[8 * ks2 + 3]); pw.z = pk2(p[8 * ks2 + 4], p[8 * ks2 + 5]); pw.w = pk2(p[8 * ks2 + 6], p[8 * ks2 + 7]);
#pragma unroll
                    for (int jj = 0; jj < 8; ++jj) { const int nn = 32 * kt + 16 * ks2 + 8 * hi + jj; cvv[jj] = (nn >= 4 * r32 - 1 && nn <= 4 * r32 + 3) ? 0x3f80 : 0; }
                    cw.x = cvv[0] | (cvv[1] << 16); cw.y = cvv[2] | (cvv[3] << 16); cw.z = cvv[4] | (cvv[5] << 16); cw.w = cvv[6] | (cvv[7] << 16);
                    ia = __builtin_amdgcn_mfma_f32_32x32x16_bf16(__builtin_bit_cast(bf16x8, cw), __builtin_bit_cast(bf16x8, pw), ia, 0, 0, 0); }
            }
            const float lt = ls + __shfl_xor(ls, 32); const float inv = lt > 0.f ? 1.f / lt : 0.f;
#pragma unroll
            for (int r = 0; r < 16; ++r) imp[r] += ia[r] * inv;
        }
    }
#endif
    unsigned sel;
    { const int qblk = tq >> 6;
      if (32 * qb + 31 < 1024) sel = (2u << qblk) - 1u;
      else { float val[16], oth[16];
#pragma unroll
        for (int r = 0; r < 16; ++r) { const int j = crow(r, hi); val[r] = j > qblk ? -1e30f : ((j == 0 || j == qblk || j == qblk - 1) ? 1e9f : imp[r]); oth[r] = __shfl_xor(val[r], 32); }
        unsigned mine = 0;
#pragma unroll
        for (int r = 0; r < 16; ++r) { const int j = crow(r, hi); int rank = 0;
#pragma unroll
            for (int r2 = 0; r2 < 16; ++r2) { const int j2 = crow(r2, hi), j3 = crow(r2, hi ^ 1);
                rank += (val[r2] > val[r] || (val[r2] == val[r] && j2 < j)) ? 1 : 0;
                rank += (oth[r2] > val[r] || (oth[r2] == val[r] && j3 < j)) ? 1 : 0; }
            mine |= ((rank < 16 && j <= qblk) ? 1u : 0u) << ((r & 3) + 8 * (r >> 2)); }
        mine <<= 4 * hi;
        sel = mine | __shfl_xor(mine, 32); } }
    const unsigned* mbr2[2] = {nullptr, nullptr}; const unsigned* mbr1[1] = {nullptr};
    const KVp kvs{PROJ + (size_t)(b * SEQ) * NSA_LD + NSA_KS + 64 * g, NSA_LD, (const bf16*)F.out + ((size_t)b * 256 + 64 * g) * SEQ, SEQ};
    const KVp kvw{PROJ + (size_t)(b * SEQ) * NSA_LD + NSA_KW + 64 * g, NSA_LD, (const bf16*)F.out + (size_t)NB * 256 * SEQ + ((size_t)b * 256 + 64 * g) * SEQ, SEQ};
    ma.sel = sel;
#define NSA_BRANCH(MT_, KV_, KT0_, KT1_, C_, ADD_, ZBIT_) do { \
      { f32x16 O2[2][2]; float l2[2]; zero_o<2, 2>(O2, l2); attn_core<2, 2, 0, MT_>(ql, KV_, KT0_, KT1_, 0.f, ma, mbr2, O2, l2, F.lane); VM_WAIT(); \
        _Pragma("unroll") for (int s = 0; s < 2; ++s) { const float lt = l2[s] + __shfl_xor(l2[s], 32); \
          store_o<2, ADD_>(O2[s], (lt > 0.f && !(DBG_ZERO & ZBIT_)) ? NSA_GATE(s, C_) / lt : 0.f, Y, row0, (3 * g + s) * 64, F.lane); } } \
      { f32x16 O1[1][2]; float l1[1]; zero_o<1, 2>(O1, l1); attn_core<1, 2, 0, MT_>(ql + 2 * 4 * 64, KV_, KT0_, KT1_, 0.f, ma, mbr1, O1, l1, F.lane); VM_WAIT(); \
        const float lt = l1[0] + __shfl_xor(l1[0], 32); \
        store_o<2, ADD_>(O1[0], (lt > 0.f && !(DBG_ZERO & ZBIT_)) ? NSA_GATE(2, C_) / lt : 0.f, Y, row0, (3 * g + 2) * 64, F.lane); } } while (0)
    NSA_BRANCH(MK_CMP, kvc, 0, 4, 0, false, 4);
    if (!WG) {
    NSA_BRANCH(MK_SLC, kvs, 0, qb + 1, 1, true, 16);
    NSA_BRANCH(MK_WIN, kvw, (qb > 16 ? qb - 16 : 0), qb + 1, 2, true, 32);
    } else {
        unsigned wsel = sel;
#pragma unroll
        for (int o = 1; o < 32; o <<= 1) wsel |= __shfl_xor(wsel, o);
        if (F.lane == 0) __hip_atomic_fetch_or((LAS unsigned*)(F.lds + LDS_CTRL + 64) + 17, wsel, __ATOMIC_RELAXED, __HIP_MEMORY_SCOPE_WORKGROUP);
        asm volatile("s_waitcnt vmcnt(0) lgkmcnt(0)\n\ts_barrier" ::: "memory");
        const unsigned blk = (unsigned)__builtin_amdgcn_readfirstlane((int)F.MISC[17]);
        const int kperm = (r32 & 0x13) | ((r32 & 4) << 1) | ((r32 & 8) >> 1), w = F.wave;
#define NSA_WGBRANCH(MT_, KCOL_, VTOFF_, KT0_, KT1_, MY0_, MY1_, BLK_, C_, ZBIT_) do { \
        const bf16* psrc; int pstep; \
        if (w < 4) { psrc = PROJ + (size_t)(b * SEQ + kperm) * NSA_LD + (KCOL_) + 64 * g + 16 * w + 8 * hi; pstep = 32 * NSA_LD; } \
        else { const int j_ = w - 4; psrc = (const bf16*)F.out + (VTOFF_) + ((size_t)b * 256 + 64 * g + 32 * (j_ >> 1) + r32) * SEQ + 16 * (j_ & 1) + 8 * hi; pstep = 32; } \
        f32x16 O3[3][2]; float l3[3]; zero_o<3, 2>(O3, l3); \
        wg_attn<3, MT_, 5>(F, ql, psrc, pstep, NSA_ROFF, KT0_, KT1_, BLK_, MY0_, MY1_, ma, (const LAS unsigned*)nullptr, O3, l3); \
        _Pragma("unroll") for (int s = 0; s < 3; ++s) { const float lt = l3[s] + __shfl_xor(l3[s], 32); \
          store_o<2, true>(O3[s], (lt > 0.f && !(DBG_ZERO & ZBIT_)) ? NSA_GATE(s, C_) / lt : 0.f, Y, row0, (3 * g + s) * 64, F.lane); } } while (0)
        NSA_WGBRANCH(MK_SLC, NSA_KS, (size_t)0, 0, 8 * qb8 + 8, 0, qb + 1, blk, 1, 16);
        NSA_WGBRANCH(MK_WIN, NSA_KW, (size_t)NB * 256 * SEQ, (8 * qb8 > 16 ? 8 * qb8 - 16 : 0), 8 * qb8 + 8, (qb > 16 ? qb - 16 : 0), qb + 1, 0xffffffffu, 2, 32);
#undef NSA_WGBRANCH
    }
#undef NSA_BRANCH
}
__device__ __forceinline__ void prologue_misc(Frame& F) {
    float* tab = (float*)(F.ws + WS_ROPE);
    for (int idx = blockIdx.x * (NWAVES * 64) + F.tid; idx < SEQ * 32; idx += F.G * NWAVES * 64) {
        const int t = idx >> 5, i = idx & 31;
        const float inv = exp2f(-(float)i * (13.287712379549449f / 32.0f));
        const float ang = (float)t * inv; float s, c; sincosf(ang, &s, &c);
        tab[t * 64 + i] = c; tab[t * 64 + 32 + i] = s; }
    if (blockIdx.x < 4) {
        const int kv = F.wave & 1, part = blockIdx.x * 4 + (F.wave >> 1);
        const float* pos = kv ? F.ka->in[20] : F.ka->in[19]; const float* w = kv ? F.ka->in[22] : F.ka->in[21]; float a = 0.f;
#pragma unroll 8
        for (int i = part * 128; i < part * 128 + 128; ++i) a += pos[i] * w[(size_t)i * 64 + F.lane];
        atomicAdd((float*)(F.ws + WS_CTL) + CW_CK + 64 * kv + F.lane, a);
    }
}
__device__ __forceinline__ void prologue_phase(Frame& F) {
    prologue_misc(F);
    bf16* XB = (bf16*)(F.ws + WS_XB); float* PART = (float*)(F.ws + WS_PART);
    for (int m = F.gw; m < MTOK; m += F.NGW) row_to_bf16(F, F.ka->in[0] + (size_t)m * DM, XB + (size_t)m * DM, PART + (size_t)m * 16);
    bf16* MEMB = (bf16*)(F.ws + WS_MEMB); float* PARTM = (float*)(F.ws + WS_PARTM);
    for (int m = F.gw; m < MMEM; m += F.NGW) row_to_bf16(F, F.ka->in[1] + (size_t)m * DM, MEMB + (size_t)m * DM, PARTM + (size_t)m * 16);
    int itb = 0;
#pragma unroll 1
    for (int ly = 0; ly < DEPTH; ++ly) cvt_matrix(F, itb, F.ka->in[9] + (size_t)ly * DM * 512, nullptr, 512, 512, F.ka->in[8] + (size_t)ly * DM, (bf16*)(F.ws + WS_WKV) + (size_t)ly * 512 * DM, DM, 512, 0);
    cvt_matrix(F, itb, F.ka->in[21], nullptr, 64, 64, nullptr, (bf16*)(F.ws + WS_CMPW), 2048, 64, 0);
    cvt_matrix(F, itb, F.ka->in[22], nullptr, 64, 64, nullptr, (bf16*)(F.ws + WS_CMPW) + 64 * 2048, 2048, 64, 0);
    convert_layer(F, 0);
}

template <unsigned PHASE_MASK> __global__ void __launch_bounds__(NWAVES * 64, 2) mk_fwd(Args args) {
    extern __shared__ __attribute__((aligned(16))) unsigned char lds[];
    Frame F;
    F.lds = (LAS unsigned char*)lds;
    F.MISC = (volatile LAS unsigned*)(F.lds + LDS_CTRL + 64);
    F.tid = threadIdx.x; F.lane = F.tid & 63; F.wave = __builtin_amdgcn_readfirstlane(F.tid >> 6);
    F.G = gridDim.x; F.gw = blockIdx.x * NWAVES + F.wave; F.NGW = F.G * NWAVES;
    F.ws = args.ws; F.ctl = (gu32*)(args.ws + WS_CTL); F.out = args.out;
    F.ka = (KArgs)__builtin_amdgcn_kernarg_segment_ptr();
    for (int u = F.tid; u < 1024 / 4; u += NWAVES * 64) ((LAS unsigned*)(F.lds + LDS_CTRL))[u] = 0u;
    __syncthreads();
    XcdBarrier bar = xcd_barrier_post((unsigned*)(F.ctl + CW_BAR), F.MISC + 8);
    constexpr bool ALLPH = PHASE_MASK == 0xffffffffu;
    const int lo = ALLPH ? 0 : args.ph_lo, hi = ALLPH ? 0 : args.ph_hi; int pc = 0;
    const bool dry = ALLPH ? false : (args.dry != 0);
#define PH_BEGIN(id) if (ALLPH || ((((PHASE_MASK) >> (id)) & 1u) && lo <= pc && pc < hi)) { asm volatile("" : "+s"(F.ka), "+s"(F.ws), "+s"(F.out), "+s"(F.gw), "+s"(F.NGW), "+s"(F.G), "+s"(F.wave)); asm volatile("v_mbcnt_lo_u32_b32 %0, -1, 0\n\tv_mbcnt_hi_u32_b32 %0, -1, %0" : "=v"(F.lane)); F.tid = F.wave * 64 + F.lane;
#define PH_END_(islast)   if (ALLPH ? !(islast) : (pc + 1 < hi)) { XcdBarrier b2_ = bar; asm volatile("" : "+s"(b2_.bar), "+s"(b2_.x)); xcd_barrier(b2_); } } if (!ALLPH) ++pc;
#define PH_END PH_END_(false)
#define QCTR(i) (F.ctl + CW_Q + 64 * (i))

#define XB ((bf16*)(F.ws + WS_XB))
#define VTB ((bf16*)F.out)
#define Yb ((bf16*)(F.ws + WS_Y))
#define HID ((bf16*)(F.ws + WS_HID))
#define PART ((float*)(F.ws + WS_PART))
    LAS unsigned char* ring = F.lds;

    PH_BEGIN(0) prologue_phase(F); PH_END
    PH_BEGIN(1) { pg8::Gemm g{(const bf16*)(F.ws + WS_MEMB), (const bf16*)(F.ws + WS_WKV), MMEM, 2048, DM}; pg8::StaticOrder S; S.init(MMEM, 2048, F.G, (int)blockIdx.x);
        pg8::EpiScale E{(bf16*)(F.ws + WS_MKV), 2048, (const float*)(F.ws + WS_PARTM)};
        pg8::gemm_phase<pg8::EpiScale, pg8::StaticOrder, true, true>(ring, g, S, E, F.wave); } PH_END

#pragma unroll 1
    for (int Ly = 0; Ly < DEPTH; ++Ly) {
#define WB ((const bf16*)(F.ws + WS_WBUF0 + (size_t)(Ly & 1) * WBUF_BYTES))
        const int kind = Ly % 3;
        const int ldp = kind == 0 ? RET_LD : (kind == 1 ? DSA_LD : NSA_LD);
        PH_BEGIN(3) { pg8::Gemm g{XB, WB + WB_W1A, MTOK, 2 * FF, DM}; pg8::StaticOrder S; S.init(MTOK, 2 * FF, F.G, (int)blockIdx.x);
            pg8::EpiSwiglu E{HID, FF, PART, dry ? DRY_MODE : 0};
            pg8::gemm_phase<pg8::EpiSwiglu, pg8::StaticOrder, true, true>(ring, g, S, E, F.wave); } PH_END
        PH_BEGIN(4) { pg8::Gemm g{HID, WB + WB_W2A, MTOK, DM, FF}; pg8::StaticOrder S; S.init(MTOK, DM, F.G, (int)blockIdx.x);
            pg8::EpiResid E{XB, XB, nullptr, PART, dry ? 0.f : 0.5f};
            pg8::gemm_phase<pg8::EpiResid, pg8::StaticOrder, true, true>(ring, g, S, E, F.wave); } PH_END
        PH_BEGIN(5) { pg8::Gemm g{XB, WB + WB_WIN, MTOK, ldp, DM}; pg8::StaticOrder S; S.init(MTOK, ldp, F.G, (int)blockIdx.x);
            pg8::EpiScale E{HID, ldp, PART};
            pg8::gemm_phase<pg8::EpiScale, pg8::StaticOrder, true, true>(ring, g, S, E, F.wave); } PH_END
        PH_BEGIN(6)
#define DO_X (!dry || DRY_MODE == 0 || DRY_MODE == 11)
#define DO_T (!dry || DRY_MODE == 0 || DRY_MODE == 12)
#define DO_C (!dry || DRY_MODE == 0 || DRY_MODE == 13)
            if (kind == 0) {
                if (DO_X) xform(F, HID, ldp, RET_K, 6, MTOK, SEQ, (dry ? Yb : HID), 0, (dry ? 1024 : ldp), (dry ? 0 : RET_K), nullptr, true, 0.125f, RET_MODE == 1 ? -1 : 0);
                if (DO_T) transpose_cols(F, HID, ldp, RET_V, 768, NB, SEQ, VTB);
            } else if (kind == 1) {
                if (DO_X) xform(F, HID, ldp, DSA_K, 1, MTOK, SEQ, (dry ? Yb : HID), 0, (dry ? 1024 : ldp), (dry ? 0 : DSA_K), F.ka->in[15], true, 1.f, 0);
                if (DO_X) xform(F, HID, ldp, DSA_IK, 1, MTOK, SEQ, (dry ? Yb : HID), 0, (dry ? 1024 : ldp), (dry ? 0 : DSA_IK), nullptr, true, 1.f, 0);
                if (DO_T) transpose_cols(F, HID, ldp, DSA_V, 64, NB, SEQ, VTB);
            } else {
                if (DO_T && blockIdx.x < 128) nsa_cmp_task(F, 2 * (int)blockIdx.x + (F.wave >> 2), F.wave & 3, HID, F.ka->in[18]);
                if (DO_X) xform(F, HID, ldp, NSA_KS, 4, MTOK, SEQ, (dry ? Yb : HID), 0, (dry ? 1024 : ldp), (dry ? 0 : NSA_KS), F.ka->in[18] + 64, true, 1.f, 0);
                if (DO_X) xform(F, HID, ldp, NSA_KW, 4, MTOK, SEQ, (dry ? Yb : HID), 0, (dry ? 1024 : ldp), (dry ? 0 : NSA_KW), F.ka->in[18] + 128, true, 1.f, 0);
                if (DO_T) transpose_cols(F, HID, ldp, NSA_VS, 256, NB, SEQ, VTB);
                if (DO_T) transpose_cols(F, HID, ldp, NSA_VW, 256, NB, SEQ, VTB + (size_t)NB * 256 * SEQ);
            }
            if (Ly == 0 && !dry) {
#pragma unroll 1
        for (int ly = 0; ly < DEPTH; ++ly) {
            xform(F, (const bf16*)(F.ws + WS_MKV), 2048, ly * 512, 4, MMEM, NMEMT, (bf16*)(F.ws + WS_MK) + (size_t)ly * NB * 4 * NMEMT * 64, 1, 0, 0, F.ka->in[11] + ly * 64, false, 1.f, 0);
            transpose_cols(F, (const bf16*)(F.ws + WS_MKV), 2048, ly * 512 + 256, 256, NB, NMEMT, (bf16*)(F.ws + WS_MVT) + (size_t)ly * NB * 256 * NMEMT);
        }
            }
            if (DO_C && Ly + 1 < DEPTH) convert_layer(F, Ly + 1);
#undef DO_X
#undef DO_T
#undef DO_C
        PH_END
        if (kind == 0) {
            PH_BEGIN(7)
                for (;;) {
                    asm volatile("s_waitcnt vmcnt(0) lgkmcnt(0)\n\ts_barrier" ::: "memory");
                    if (F.tid == 0) F.MISC[16] = __hip_atomic_fetch_add(QCTR(Ly * 8 + 3), 1u, RLX_AGENT);
                    asm volatile("s_waitcnt vmcnt(0) lgkmcnt(0)\n\ts_barrier" ::: "memory");
                    const int t = __builtin_amdgcn_readfirstlane((int)F.MISC[16]);
                    if (t >= NB * 6 * 8) break;
                    asm volatile("v_mbcnt_lo_u32_b32 %0, -1, 0\n\tv_mbcnt_hi_u32_b32 %0, -1, %0" : "=v"(F.lane));
                    ret_wg_task(F, t, HID);
                }
                for (;;) { asm volatile("v_mbcnt_lo_u32_b32 %0, -1, 0\n\tv_mbcnt_hi_u32_b32 %0, -1, %0" : "=v"(F.lane)); const int t = grab(QCTR(Ly * 8 + 0), F.lane) + (RET_WG ? 3072 : 0); if (t >= 3072 + 2048) break; mem_task(F, t - 3072, Ly, HID, ldp, RET_QM); }
            PH_END
        } else if (kind == 1) {
            PH_BEGIN(8)
                for (;;) { asm volatile("v_mbcnt_lo_u32_b32 %0, -1, 0\n\tv_mbcnt_hi_u32_b32 %0, -1, %0" : "=v"(F.lane)); const int t = grab(QCTR(Ly * 8 + 0), F.lane); if (t >= 4608 + 2048) break; if (t < 4608) dsa_d1_task(F, t, HID); else mem_task(F, t - 4608, Ly, HID, ldp, DSA_QM); }
            PH_END
            PH_BEGIN(9)
                for (;;) { asm volatile("v_mbcnt_lo_u32_b32 %0, -1, 0\n\tv_mbcnt_hi_u32_b32 %0, -1, %0" : "=v"(F.lane)); const int t = grab(QCTR(Ly * 8 + 1), F.lane); if (t >= MTOK / 8) break;
{ v4u ra[4], rb[4]; d2_load(F, MTOK - 1 - 8 * t, ra);
#pragma unroll 1
                      for (int i = 0; i < 8; i += 2) { d2_load(F, MTOK - 1 - (8 * t + i + 1), rb); dsa_d2_row(F, MTOK - 1 - (8 * t + i), ra);
                          if (i + 2 < 8) d2_load(F, MTOK - 1 - (8 * t + i + 2), ra); dsa_d2_row(F, MTOK - 1 - (8 * t + i + 1), rb); } } }
            PH_END
            PH_BEGIN(10)
                                for (;;) {
                    asm volatile("s_waitcnt vmcnt(0) lgkmcnt(0)\n\ts_barrier" ::: "memory");
                    if (F.tid == 0) F.MISC[16] = __hip_atomic_fetch_add(QCTR(Ly * 8 + 3), 1u, RLX_AGENT);
                    asm volatile("s_waitcnt vmcnt(0) lgkmcnt(0)\n\ts_barrier" ::: "memory");
                    const int t = __builtin_amdgcn_readfirstlane((int)F.MISC[16]);
                    if (t >= NB * 32) break;
                    asm volatile("v_mbcnt_lo_u32_b32 %0, -1, 0\n\tv_mbcnt_hi_u32_b32 %0, -1, %0" : "=v"(F.lane)); F.tid = F.wave * 64 + F.lane;
                    dsa_d3_wg_task(F, t, HID);
                }

            PH_END
        } else {
            PH_BEGIN(11)
                for (;;) {
                    asm volatile("s_waitcnt vmcnt(0) lgkmcnt(0)\n\ts_barrier" ::: "memory");
                    if (F.tid == 0) { F.MISC[16] = __hip_atomic_fetch_add(QCTR(Ly * 8 + 3), 1u, RLX_AGENT); F.MISC[17] = 0u; }
                    asm volatile("s_waitcnt vmcnt(0) lgkmcnt(0)\n\ts_barrier" ::: "memory");
                    const int t = __builtin_amdgcn_readfirstlane((int)F.MISC[16]);
                    if (t >= NB * 4 * 8) break;
                    nsa_task<true>(F.ka, F.ws, F.out, F.lds, F.wave, t, HID);
                }
                for (;;) { asm volatile("v_mbcnt_lo_u32_b32 %0, -1, 0\n\tv_mbcnt_hi_u32_b32 %0, -1, %0" : "=v"(F.lane)); const int t = grab(QCTR(Ly * 8 + 0), F.lane) + (NSA_WG ? 4096 : 0); if (t >= 4096 + 2048) break; mem_task(F, t - 4096, Ly, HID, ldp, NSA_QM); }
            PH_END
        }
        PH_BEGIN(12) { pg8::Gemm g{Yb, WB + WB_WO, MTOK, DM, DM}; pg8::StaticOrder S; S.init(MTOK, DM, F.G, (int)blockIdx.x);
            pg8::EpiResid E{XB, XB, nullptr, PART, dry ? 0.f : 1.0f};
            pg8::gemm_phase<pg8::EpiResid, pg8::StaticOrder, true, true>(ring, g, S, E, F.wave); } PH_END
        PH_BEGIN(13) { pg8::Gemm g{XB, WB + WB_W1B, MTOK, 2 * FF, DM}; pg8::StaticOrder S; S.init(MTOK, 2 * FF, F.G, (int)blockIdx.x);
            pg8::EpiSwiglu E{HID, FF, PART, dry ? DRY_MODE : 0};
            pg8::gemm_phase<pg8::EpiSwiglu, pg8::StaticOrder, true, true>(ring, g, S, E, F.wave); } PH_END
        PH_BEGIN(14) { pg8::Gemm g{HID, WB + WB_W2B, MTOK, DM, FF}; pg8::StaticOrder S; S.init(MTOK, DM, F.G, (int)blockIdx.x);
            pg8::EpiResid E{XB, XB, Ly == DEPTH - 1 ? F.out : nullptr, PART, dry ? 0.f : 0.5f};
            pg8::gemm_phase<pg8::EpiResid, pg8::StaticOrder, true, true>(ring, g, S, E, F.wave); } PH_END_(Ly == DEPTH - 1)
    }
#undef XB
#undef VTB
#undef Yb
#undef HID
#undef PART
#undef WB
#undef PH_BEGIN
#undef PH_END
#undef PH_END_
}

constexpr int LDS_BYTES = 147456;
#ifndef MK_PER_PHASE
#define MK_PER_PHASE 0
#endif
typedef void (*kern_t)(Args);
template <unsigned M> static kern_t kern_of() { return mk_fwd<M>; }
#if MK_PER_PHASE
static kern_t phase_kernel(int id) {
    switch (id) {
        case 0: return kern_of<1u << 0>(); case 1: return kern_of<1u << 1>(); case 2: return kern_of<1u << 2>(); case 3: return kern_of<1u << 3>(); case 4: return kern_of<1u << 4>();
        case 5: return kern_of<1u << 5>(); case 6: return kern_of<1u << 6>(); case 7: return kern_of<1u << 7>(); case 8: return kern_of<1u << 8>(); case 9: return kern_of<1u << 9>();
        case 10: return kern_of<1u << 10>(); case 11: return kern_of<1u << 11>(); case 12: return kern_of<1u << 12>(); case 13: return kern_of<1u << 13>(); default: return kern_of<1u << 14>();
    }
}
#endif
extern "C" void kernel_launch(void* const* d_in, const int* in_sizes, int n_in, void* d_out, int out_size, void* d_ws, size_t ws_size, hipStream_t stream) {
    static int grid = 0;
    if (grid == 0) {
        if (n_in != 23 || out_size != MTOK * DM || ws_size < WS_END) { fprintf(stderr, "kernel_launch: unexpected shapes (n_in %d, out %d, ws %zu)\n", n_in, out_size, ws_size); grid = -1; return; }
        int dev = 0, cus = 0;
        if (hipGetDevice(&dev) != hipSuccess || hipDeviceGetAttribute(&cus, hipDeviceAttributeMultiprocessorCount, dev) != hipSuccess) { grid = -1; return; }
#if MK_PER_PHASE
        for (int id = 0; id < 15; ++id) if (hipFuncSetAttribute((const void*)phase_kernel(id), hipFuncAttributeMaxDynamicSharedMemorySize, LDS_BYTES) != hipSuccess) { fprintf(stderr, "kernel_launch: hipFuncSetAttribute failed\n"); grid = -1; return; }
#else
        if (hipFuncSetAttribute((const void*)kern_of<0xffffffffu>(), hipFuncAttributeMaxDynamicSharedMemorySize, LDS_BYTES) != hipSuccess) { fprintf(stderr, "kernel_launch: hipFuncSetAttribute failed\n"); grid = -1; return; }
#endif
        (void)hipGetLastError();
        grid = cus;
    }
    if (grid < 0) return;
    if (hipMemsetAsync((char*)d_ws + WS_CTL, 0, CTL_ZERO_BYTES, stream) != hipSuccess) return;
    Args a{};
    for (int i = 0; i < 23; ++i) a.in[i] = (const float*)d_in[i];
    a.out = (float*)d_out; a.ws = (unsigned char*)d_ws;
    constexpr int NPH = 2 + 8 * DEPTH + 2;
#if MK_PER_PHASE
    int ids[NPH]; int n = 0; ids[n++] = 0; ids[n++] = 1;
    for (int ly = 0; ly < DEPTH; ++ly) { ids[n++] = 3; ids[n++] = 4; ids[n++] = 5; ids[n++] = 6;
        if (ly % 3 == 0) ids[n++] = 7; else if (ly % 3 == 1) { ids[n++] = 8; ids[n++] = 9; ids[n++] = 10; } else ids[n++] = 11;
        ids[n++] = 12; ids[n++] = 13; ids[n++] = 14; }
    for (int p = 0; p < NPH; ++p) { a.ph_lo = p; a.ph_hi = p + 1;
#if PROBE_DUP
        if ((PROBE_DUP >> ids[p]) & 1) {
            a.dry = 1; hipLaunchKernelGGL(phase_kernel(ids[p]), dim3(grid), dim3(NWAVES * 64), LDS_BYTES, stream, a); a.dry = 0;
            hipMemsetAsync((char*)d_ws + WS_CTL + CW_Q * 4, 0, 64 * 4 * 64, stream); }
#endif
        hipLaunchKernelGGL(phase_kernel(ids[p]), dim3(grid), dim3(NWAVES * 64), LDS_BYTES, stream, a);
    }
#else
    a.ph_lo = 0; a.ph_hi = NPH; hipLaunchKernelGGL(kern_of<0xffffffffu>(), dim3(grid), dim3(NWAVES * 64), LDS_BYTES, stream, a);
#endif
}
```

```cpp
#include <hip/hip_runtime.h>
#include <cstdio>
#include <cstdint>
namespace pg8 {
#define PG8_LAS __attribute__((address_space(3)))
typedef unsigned short bf16_t;
typedef short bf16x8 __attribute__((ext_vector_type(8)));
typedef float f32x4 __attribute__((ext_vector_type(4)));
typedef unsigned u32x4 __attribute__((ext_vector_type(4)));
constexpr int BM = 256, BK = 64, HALF = 128, HTB = HALF * BK * 2  , STAGE_BYTES = 8 * HTB, NXCD = 8, WGM = 8;

__host__ __device__ __forceinline__ int lds_byte(int r, int c) { const int st = (r >> 4) * 2 + (c >> 5), rr = r & 15, cc = c & 31, ob = rr * 64 + cc * 2; return st * 1024 + (ob ^ (((ob >> 9) & 1) << 5)); }
__host__ __device__ __forceinline__ void stage_rc(int b, int& R, int& C) { const int st = b / 1024, sb = b % 1024, swz = sb ^ (((sb >> 9) & 1) << 5); R = (st >> 1) * 16 + swz / 64; C = (st & 1) * 32 + (swz % 64) / 2; }
__host__ __device__ __forceinline__ int perm32(int rho) { const int n = rho >> 4, i = rho & 15; return 8 * (i >> 2) + 4 * n + (i & 3); }

struct Unit { int pm, pn; };
struct Gemm { const bf16_t* A; const bf16_t* Bt; int M, N, K; };

struct StaticOrder {
    int nM, nN, nwg, G, c;
    __host__ __device__ void init(int M, int N, int G_, int c_) { nM = M / BM; nN = N / BM; nwg = nM * nN; G = G_; c = c_; }
    __host__ __device__ bool next(int i, Unit& u) const {
        const long L = (long)i * G + c; if (L >= nwg) return false;
        int wgid = (int)L; { const int q = nwg / NXCD, r = nwg % NXCD, xcd = wgid % NXCD, off = wgid / NXCD; wgid = (xcd < r ? xcd * (q + 1) : r * (q + 1) + (xcd - r) * q) + off; }
        const int nig = WGM * nN, gid = wgid / nig, fm = gid * WGM, gsz = (nM - fm) < WGM ? (nM - fm) : WGM;
        u.pm = fm + ((wgid % nig) % gsz); u.pn = (wgid % nig) / gsz; return true;
    }
    __device__ __forceinline__ void a_ready(const Unit&) const {}
    __device__ __forceinline__ void done(const Unit&) const {}
};

__device__ __forceinline__ int lane_now() { int l; asm volatile("v_mbcnt_lo_u32_b32 %0, -1, 0\n\tv_mbcnt_hi_u32_b32 %0, -1, %0" : "=v"(l)); return l; }
__device__ __forceinline__ float shfl_idx_(float v, int src) { return __builtin_bit_cast(float, __builtin_amdgcn_ds_bpermute(src << 2, __builtin_bit_cast(int, v))); }
__device__ __forceinline__ int shfl_idx_(int v, int src) { return __builtin_amdgcn_ds_bpermute(src << 2, v); }
__device__ __forceinline__ unsigned shfl_idx_(unsigned v, int src) { return (unsigned)__builtin_amdgcn_ds_bpermute(src << 2, (int)v); }
#define __shfl_xor(v, o) pg8::shfl_idx_((v), pg8::lane_now() ^ (o))
#define __shfl(v, src) pg8::shfl_idx_((v), (src))
#define __shfl_down(v, o) pg8::shfl_idx_((v), pg8::lane_now() + (o))
#define __shfl_up(v, o) pg8::shfl_idx_((v), pg8::lane_now() - (o))
typedef float f32x2_cv __attribute__((ext_vector_type(2))); typedef __bf16 bf16x2_cv __attribute__((ext_vector_type(2)));
__device__ __forceinline__ unsigned cvt_pk_bf16(float lo, float hi) { f32x2_cv v = {lo, hi}; bf16x2_cv b = __builtin_convertvector(v, bf16x2_cv); return __builtin_bit_cast(unsigned, b); }
constexpr float RMS_EPS = 1e-6f;
__device__ __forceinline__ void rows_rs(const float* part, int row0, int fq, float (&rs)[2][4]) {
    f32x4 pr[2][4];
#pragma unroll
    for (int ai = 0; ai < 2; ++ai)
#pragma unroll
        for (int m = 0; m < 4; ++m) pr[ai][m] = *(const f32x4*)(part + (size_t)(row0 + ai * HALF + m * 16) * 16 + 4 * fq);
#pragma unroll
    for (int ai = 0; ai < 2; ++ai)
#pragma unroll
        for (int m = 0; m < 4; ++m) { float s = (pr[ai][m][0] + pr[ai][m][1]) + (pr[ai][m][2] + pr[ai][m][3]); s += __shfl_xor(s, 16); s += __shfl_xor(s, 32);
            rs[ai][m] = __builtin_amdgcn_rsqf(s * (1.0f / 1024.0f) + RMS_EPS); }
}
__device__ __forceinline__ float silu_mul(float g, float u) { return g * u * __builtin_amdgcn_rcpf(1.0f + __builtin_amdgcn_exp2f(-1.4426950408889634f * g)); }
struct EpiSwiglu {
    static constexpr bool PERM = true, AFTER_DRAIN = false;
    bf16_t* H; int ldh; const float* part; int dmode;
    __device__ __forceinline__ void operator()(const f32x4 (&acc)[2][2][4][2], const Unit& u, int wr, int wc, int fr_, int fq_) const {
        int le_; asm volatile("v_mbcnt_lo_u32_b32 %0, -1, 0\n\tv_mbcnt_hi_u32_b32 %0, -1, %0" : "=v"(le_)); const int fr = le_ & 15, fq = le_ >> 4;
        const int row0 = u.pm * BM + wr * 64 + fr, col0 = u.pn * HALF + wc * 32 + 8 * fq;
        if (dmode == 2) return;
        float rsv[2][4]; rows_rs(part, row0, fq, rsv);
#pragma unroll
        for (int ai = 0; ai < 2; ++ai)
#pragma unroll
            for (int m = 0; m < 4; ++m) { const int row = row0 + ai * HALF + m * 16; const float rs = rsv[ai][m];
                const f32x4 g0 = acc[ai][0][m][0] * rs, g1 = acc[ai][0][m][1] * rs, u0 = acc[ai][1][m][0] * rs, u1 = acc[ai][1][m][1] * rs;
                u32x4 w; w.x = cvt_pk_bf16(silu_mul(g0[0], u0[0]), silu_mul(g0[1], u0[1])); w.y = cvt_pk_bf16(silu_mul(g0[2], u0[2]), silu_mul(g0[3], u0[3]));
                w.z = cvt_pk_bf16(silu_mul(g1[0], u1[0]), silu_mul(g1[1], u1[1])); w.w = cvt_pk_bf16(silu_mul(g1[2], u1[2]), silu_mul(g1[3], u1[3]));
                if (dmode == 0 || w.x == 0x12345678u) *(u32x4*)(H + (size_t)row * ldh + col0) = w; }
    }
};
struct EpiScale {
    static constexpr bool PERM = true, AFTER_DRAIN = false;
    bf16_t* O; int ldc; const float* part;
    __device__ __forceinline__ void operator()(const f32x4 (&acc)[2][2][4][2], const Unit& u, int wr, int wc, int fr_, int fq_) const {
        int le_; asm volatile("v_mbcnt_lo_u32_b32 %0, -1, 0\n\tv_mbcnt_hi_u32_b32 %0, -1, %0" : "=v"(le_)); const int fr = le_ & 15, fq = le_ >> 4;
        const int row0 = u.pm * BM + wr * 64 + fr, col0 = u.pn * BM + wc * 32 + 8 * fq;
        float rsv[2][4]; rows_rs(part, row0, fq, rsv);
#pragma unroll
        for (int ai = 0; ai < 2; ++ai)
#pragma unroll
            for (int m = 0; m < 4; ++m) { const int row = row0 + ai * HALF + m * 16; const float rs = rsv[ai][m]; bf16_t* rowp = O + (size_t)row * ldc + col0;
#pragma unroll
                for (int bj = 0; bj < 2; ++bj) { const f32x4 v0 = acc[ai][bj][m][0] * rs, v1 = acc[ai][bj][m][1] * rs;
                    u32x4 w; w.x = cvt_pk_bf16(v0[0], v0[1]); w.y = cvt_pk_bf16(v0[2], v0[3]); w.z = cvt_pk_bf16(v1[0], v1[1]); w.w = cvt_pk_bf16(v1[2], v1[3]);
                    *(u32x4*)(rowp + bj * HALF) = w; } }
    }
};
struct EpiResid {
    static constexpr bool PERM = true, AFTER_DRAIN = false;
    const bf16_t* base; bf16_t* xb; float* out; float* part_out; float coef;
    __device__ __forceinline__ void operator()(const f32x4 (&acc)[2][2][4][2], const Unit& u, int wr, int wc, int fr_, int fq_) const {
        int le_; asm volatile("v_mbcnt_lo_u32_b32 %0, -1, 0\n\tv_mbcnt_hi_u32_b32 %0, -1, %0" : "=v"(le_)); const int fr = le_ & 15, fq = le_ >> 4;
        const int row0 = u.pm * BM + wr * 64 + fr, col0 = u.pn * BM + wc * 32 + 8 * fq;
        u32x4 bs[2][4][2];
#pragma unroll
        for (int ai = 0; ai < 2; ++ai)
#pragma unroll
            for (int m = 0; m < 4; ++m)
#pragma unroll
                for (int bj = 0; bj < 2; ++bj) bs[ai][m][bj] = *(const u32x4*)(base + (size_t)(row0 + ai * HALF + m * 16) * 1024 + col0 + bj * HALF);
#pragma unroll
        for (int ai = 0; ai < 2; ++ai)
#pragma unroll
            for (int m = 0; m < 4; ++m) { const int row = row0 + ai * HALF + m * 16; const size_t off = (size_t)row * 1024 + col0; float ss = 0.f;
#pragma unroll
                for (int bj = 0; bj < 2; ++bj) { const u32x4 b = bs[ai][m][bj];
                    const f32x4 b0 = {__builtin_bit_cast(float, b.x << 16), __builtin_bit_cast(float, b.x & 0xffff0000u), __builtin_bit_cast(float, b.y << 16), __builtin_bit_cast(float, b.y & 0xffff0000u)};
                    const f32x4 b1 = {__builtin_bit_cast(float, b.z << 16), __builtin_bit_cast(float, b.z & 0xffff0000u), __builtin_bit_cast(float, b.w << 16), __builtin_bit_cast(float, b.w & 0xffff0000u)};
                    const f32x4 v0 = b0 + acc[ai][bj][m][0] * coef, v1 = b1 + acc[ai][bj][m][1] * coef;
                    if (out) { *(f32x4*)(out + off + bj * HALF) = v0; *(f32x4*)(out + off + bj * HALF + 4) = v1; }
                    u32x4 w; w.x = cvt_pk_bf16(v0[0], v0[1]); w.y = cvt_pk_bf16(v0[2], v0[3]); w.z = cvt_pk_bf16(v1[0], v1[1]); w.w = cvt_pk_bf16(v1[2], v1[3]);
                    *(u32x4*)(xb + off + bj * HALF) = w;
                    ss += (v0[0] * v0[0] + v0[1] * v0[1]) + (v0[2] * v0[2] + v0[3] * v0[3]) + (v1[0] * v1[0] + v1[1] * v1[1]) + (v1[2] * v1[2] + v1[3] * v1[3]); }
                ss += __shfl_xor(ss, 16); ss += __shfl_xor(ss, 32);
                if (fq == 0) part_out[(size_t)row * 16 + u.pn * 4 + wc] = ss; }
    }
};
template <class Epi, class Sched, bool ALIGN_EPI = false, bool SP2 = false>
__device__ __forceinline__ void gemm_phase(PG8_LAS unsigned char* lds, const Gemm g, const Sched& S, const Epi& E, int wave_id) {
    int lane_; asm volatile("v_mbcnt_lo_u32_b32 %0, -1, 0\n\tv_mbcnt_hi_u32_b32 %0, -1, %0" : "=v"(lane_));
    const int wid = wave_id, lane = lane_, tid = wid * 64 + lane, wr = wid >> 2, wc = wid & 3, fr = lane & 15, fq = lane >> 4;
    const int K = g.K, nt = K / BK;
    unsigned voffA[2], voffB[2];
#pragma unroll
    for (int i = 0; i < 2; ++i) { int R, C; stage_rc(tid * 16 + i * 8192, R, C); const int Rb = Epi::PERM ? ((R & ~31) + perm32(R & 31)) : R;
        voffA[i] = (unsigned)(R * K + C) * 2u; voffB[i] = (unsigned)(Rb * K + C) * 2u; }
    const size_t kstep = (size_t)(BK * 2);
    const size_t hstep = (size_t)HALF * K * 2;
    const size_t tstep = 2 * hstep;
    const unsigned ldsw = (unsigned)wid * 1024u;
    const int aoff = lds_byte(wr * 64 + fr, fq * 8), boff = lds_byte(wc * 32 + fr, fq * 8);
#define PG8_SA(b, h) (((b) * 2 + (h)) * HTB)
#define PG8_SB(b, h) ((4 + (b) * 2 + (h)) * HTB)
#define PG8_STAGE(bufoff, gbase, voff) do { _Pragma("unroll") for (int _i = 0; _i < 2; ++_i) \
        __builtin_amdgcn_global_load_lds((const unsigned*)((const char*)(gbase) + (voff)[_i]), (PG8_LAS unsigned*)(lds + (bufoff) + ldsw + _i * 8192), 16, 0, 0); } while (0)
#define PG8_LDA(dst, b, h) do { _Pragma("unroll") for (int m = 0; m < 4; ++m) _Pragma("unroll") for (int k = 0; k < 2; ++k) dst[m][k] = *(const PG8_LAS bf16x8*)(lds + PG8_SA(b, h) + aoff + m * 2048 + k * 1024); } while (0)
#define PG8_LDB(dst, b, h) do { _Pragma("unroll") for (int n = 0; n < 2; ++n) _Pragma("unroll") for (int k = 0; k < 2; ++k) dst[n][k] = *(const PG8_LAS bf16x8*)(lds + PG8_SB(b, h) + boff + n * 2048 + k * 1024); } while (0)
#define PG8_MMA(ai, bj, At, Bt) do { __builtin_amdgcn_s_setprio(1); _Pragma("unroll") for (int m = 0; m < 4; ++m) _Pragma("unroll") for (int n = 0; n < 2; ++n) _Pragma("unroll") for (int k = 0; k < 2; ++k) \
        acc[ai][bj][m][n] = __builtin_amdgcn_mfma_f32_16x16x32_bf16(Bt[n][k], At[m][k], acc[ai][bj][m][n], 0, 0, 0); __builtin_amdgcn_s_setprio(0); } while (0)
#define PG8_WAIT_V(n) asm volatile("s_waitcnt vmcnt(" #n ")" ::: "memory")
#define PG8_WAIT_L(n) asm volatile("s_waitcnt lgkmcnt(" #n ")" ::: "memory")
#define PG8_BAR __builtin_amdgcn_s_barrier()
#define PG8_SCHED __builtin_amdgcn_sched_barrier(0)
    Unit cur, nxt; int ui = 0;
    if (!S.next(0, cur)) return;
    f32x4 acc[2][2][4][2];
#pragma unroll
    for (int a = 0; a < 2; ++a)
#pragma unroll
        for (int b = 0; b < 2; ++b)
#pragma unroll
            for (int m = 0; m < 4; ++m)
#pragma unroll
                for (int n = 0; n < 2; ++n) acc[a][b][m][n] = (f32x4){0.f, 0.f, 0.f, 0.f};
    bf16x8 At[4][2], B0[2][2], B1[2][2];
    const char* cA = (const char*)g.A + (size_t)cur.pm * tstep; const char* cB = (const char*)g.Bt + (size_t)cur.pn * tstep;
    S.a_ready(cur);
    if constexpr (SP2) {
        PG8_STAGE(PG8_SB(0, 0), cB, voffB); PG8_STAGE(PG8_SB(0, 1), cB + hstep, voffB); PG8_STAGE(PG8_SA(0, 0), cA, voffA); PG8_STAGE(PG8_SA(0, 1), cA + hstep, voffA);
        if (wr == 1) PG8_BAR;
        PG8_WAIT_V(2); PG8_BAR;
        PG8_STAGE(PG8_SB(1, 0), cB + kstep, voffB); PG8_STAGE(PG8_SA(1, 0), cA + kstep, voffA); PG8_STAGE(PG8_SB(1, 1), cB + hstep + kstep, voffB);
        PG8_WAIT_V(6); PG8_BAR;
    } else {
        PG8_STAGE(PG8_SB(0, 0), cB, voffB); PG8_STAGE(PG8_SA(0, 0), cA, voffA); PG8_STAGE(PG8_SB(0, 1), cB + hstep, voffB); PG8_STAGE(PG8_SA(0, 1), cA + hstep, voffA);
        if (wr == 1) PG8_BAR;
        PG8_WAIT_V(4); PG8_BAR;
        PG8_STAGE(PG8_SB(1, 0), cB + kstep, voffB); PG8_STAGE(PG8_SA(1, 0), cA + kstep, voffA); PG8_STAGE(PG8_SB(1, 1), cB + hstep + kstep, voffB);
        PG8_WAIT_V(6); PG8_BAR;
    }
    for (;;) {
        const bool has_next = S.next(ui + 1, nxt);
        const char* nA = has_next ? (const char*)g.A + (size_t)nxt.pm * tstep : cA; const char* nB = has_next ? (const char*)g.Bt + (size_t)nxt.pn * tstep : cB;
        for (int t = 0; t < nt; t += 2) {
            const bool last = (t == nt - 2);
            const char* a1 = cA + (size_t)(t + 1) * kstep;
            const char* a2 = last ? nA : cA + (size_t)(t + 2) * kstep; const char* b2 = last ? nB : cB + (size_t)(t + 2) * kstep;
            const char* a3 = a2 + kstep; const char* b3 = b2 + kstep;
            if (last && has_next) S.a_ready(nxt);
            if constexpr (SP2) {
            PG8_LDB(B0, 0, 0); PG8_LDB(B1, 0, 1); PG8_SCHED; PG8_LDA(At, 0, 0); PG8_STAGE(PG8_SA(1, 1), a1 + hstep, voffA);
            PG8_WAIT_V(8); PG8_WAIT_L(0); PG8_BAR; PG8_MMA(0, 0, At, B0); PG8_MMA(0, 1, At, B1); PG8_BAR; PG8_SCHED;
            PG8_LDA(At, 0, 1); PG8_STAGE(PG8_SB(0, 0), b2, voffB); PG8_STAGE(PG8_SB(0, 1), b2 + hstep, voffB); PG8_STAGE(PG8_SA(0, 0), a2, voffA);
            PG8_WAIT_V(8); PG8_WAIT_L(0); PG8_BAR; PG8_MMA(1, 0, At, B0); PG8_MMA(1, 1, At, B1); PG8_BAR; PG8_SCHED;
            PG8_LDB(B0, 1, 0); PG8_LDB(B1, 1, 1); PG8_SCHED; PG8_LDA(At, 1, 0); PG8_STAGE(PG8_SA(0, 1), a2 + hstep, voffA);
            PG8_WAIT_V(8); PG8_WAIT_L(0); PG8_BAR; PG8_MMA(0, 0, At, B0); PG8_MMA(0, 1, At, B1); PG8_BAR; PG8_SCHED;
            PG8_LDA(At, 1, 1); PG8_STAGE(PG8_SB(1, 0), b3, voffB); PG8_STAGE(PG8_SB(1, 1), b3 + hstep, voffB); PG8_STAGE(PG8_SA(1, 0), a3, voffA);
            PG8_WAIT_V(8); PG8_WAIT_L(0); PG8_BAR; PG8_MMA(1, 0, At, B0); PG8_MMA(1, 1, At, B1); PG8_BAR; PG8_SCHED;
            } else {
            PG8_LDB(B0, 0, 0); PG8_SCHED; PG8_LDA(At, 0, 0); PG8_STAGE(PG8_SA(1, 1), a1 + hstep, voffA);
            PG8_WAIT_L(8); PG8_BAR; PG8_WAIT_L(0); PG8_MMA(0, 0, At, B0); PG8_BAR; PG8_SCHED;
            PG8_LDB(B1, 0, 1); PG8_STAGE(PG8_SB(0, 0), b2, voffB);
            PG8_BAR; PG8_WAIT_L(0); PG8_MMA(0, 1, At, B1); PG8_BAR;
            PG8_LDA(At, 0, 1); PG8_STAGE(PG8_SA(0, 0), a2, voffA);
            PG8_BAR; PG8_WAIT_L(0); PG8_MMA(1, 0, At, B0); PG8_BAR; PG8_SCHED;
            PG8_STAGE(PG8_SB(0, 1), b2 + hstep, voffB);
            PG8_WAIT_V(6); PG8_BAR; PG8_MMA(1, 1, At, B1); PG8_BAR;
            PG8_LDB(B0, 1, 0); PG8_SCHED; PG8_LDA(At, 1, 0); PG8_STAGE(PG8_SA(0, 1), a2 + hstep, voffA);
            PG8_WAIT_L(8); PG8_BAR; PG8_WAIT_L(0); PG8_MMA(0, 0, At, B0); PG8_BAR; PG8_SCHED;
            PG8_LDB(B1, 1, 1); PG8_STAGE(PG8_SB(1, 0), b3, voffB);
            PG8_BAR; PG8_WAIT_L(0); PG8_MMA(0, 1, At, B1); PG8_BAR;
            PG8_LDA(At, 1, 1); PG8_STAGE(PG8_SA(1, 0), a3, voffA);
            PG8_BAR; PG8_WAIT_L(0); PG8_MMA(1, 0, At, B0); PG8_BAR; PG8_SCHED;
            PG8_STAGE(PG8_SB(1, 1), b3 + hstep, voffB);
            PG8_WAIT_V(6); PG8_BAR; PG8_MMA(1, 1, At, B1); PG8_BAR;
            }
        }
        if constexpr (ALIGN_EPI) { if (wr == 0) PG8_BAR; }
        if constexpr (!Epi::AFTER_DRAIN) { E(acc, cur, wr, wc, fr, fq); S.done(cur); }
        if (!has_next) break;
#pragma unroll
        for (int a = 0; a < 2; ++a)
#pragma unroll
            for (int b = 0; b < 2; ++b)
#pragma unroll
                for (int m = 0; m < 4; ++m)
#pragma unroll
                    for (int n = 0; n < 2; ++n) acc[a][b][m][n] = (f32x4){0.f, 0.f, 0.f, 0.f};
        cur = nxt; cA = nA; cB = nB; ++ui;
        if constexpr (ALIGN_EPI) { if (wr == 1) PG8_BAR; }
    }
    PG8_WAIT_V(0);
    if constexpr (!ALIGN_EPI) { if (wr == 0) PG8_BAR; }
    PG8_BAR;
    if constexpr (Epi::AFTER_DRAIN) { E.fused(acc, cur, wr, wc, fr, fq, lds, wid, lane); S.done(cur); }
#undef PG8_SA
#undef PG8_SB
#undef PG8_STAGE
#undef PG8_LDA
#undef PG8_LDB
#undef PG8_MMA
#undef PG8_WAIT_V
#undef PG8_WAIT_L
#undef PG8_BAR
#undef PG8_SCHED
}
}
#define LAS __attribute__((address_space(3)))
#define XB_TMO      128
#define XB_XCNT(j)  (256  + 64 * (j))
#define XB_XSUB(j)  (1280 + 64 * (j))
#define XB_XGEN(j)  (2304 + 64 * (j))
#define XB_TOP      3328
#define XB_TOPGEN   3392
#define XCD_BAR_WORDS 3456
#define XB_SPIN_CAP (1u << 18)

__device__ __forceinline__ unsigned xb_ld(unsigned* p)              { return __hip_atomic_load(p, __ATOMIC_RELAXED, __HIP_MEMORY_SCOPE_AGENT); }
__device__ __forceinline__ unsigned xb_add(unsigned* p, unsigned v) { return __hip_atomic_fetch_add(p, v, __ATOMIC_RELAXED, __HIP_MEMORY_SCOPE_AGENT); }
__device__ __forceinline__ unsigned xb_xcc_id() { return (unsigned)__builtin_amdgcn_s_getreg((3 << 11) | 20) & 0xFu; }
#define XB_SPIN(cond, bar) do { unsigned _sp = 0; while (cond) { __builtin_amdgcn_s_sleep(1); \
    if ((++_sp & 255u) == 0u) { if (xb_ld(&(bar)[XB_TMO])) break; if (_sp > XB_SPIN_CAP) { atomicAdd(&(bar)[XB_TMO], 1u); break; } } } } while (0)

struct XcdBarrier {
    unsigned* bar; unsigned x;
    volatile LAS unsigned* st;
};

__device__ __forceinline__ XcdBarrier xcd_barrier_post(unsigned* bar, volatile LAS unsigned* st) {
    XcdBarrier b; b.bar = bar; b.x = xb_xcc_id(); b.st = st;
    if (threadIdx.x == 0) (void)xb_add(&bar[XB_XCNT(b.x)], 1u);
    return b;
}
__device__ __forceinline__ void xcd_barrier_complete(unsigned* bar, unsigned x, unsigned& nloc, unsigned& nx) {
    const unsigned G = gridDim.x * gridDim.y * gridDim.z;
    unsigned sum, cnt, mine, sp = 0u;
    for (;;) {
        sum = 0u; cnt = 0u; mine = 0u;
#pragma unroll
        for (unsigned j = 0; j < 16; ++j) { const unsigned c = xb_ld(&bar[XB_XCNT(j)]); sum += c; cnt += (c > 0u) ? 1u : 0u; mine = (j == x) ? c : mine; }
        if (sum == G) break;
        __builtin_amdgcn_s_sleep(1);
        if ((++sp & 255u) == 0u) { if (xb_ld(&bar[XB_TMO])) break; if (sp > XB_SPIN_CAP) { atomicAdd(&bar[XB_TMO], 1u); break; } }
    }
    nloc = mine > 0u ? mine : 1u; nx = cnt > 0u ? cnt : 1u;
}

__device__ __forceinline__ void xcd_barrier(const XcdBarrier& b) {
    asm volatile("s_waitcnt vmcnt(0)" ::: "memory");
    __syncthreads();
    if (threadIdx.x == 0) {
        unsigned* bar = b.bar;
        __builtin_amdgcn_s_waitcnt(0);
        unsigned nloc = b.st[0], nx = b.st[1];
        if (nloc == 0u) { xcd_barrier_complete(bar, b.x, nloc, nx); b.st[0] = nloc; b.st[1] = nx; }
        const unsigned old = xb_add(&bar[XB_XSUB(b.x)], 1u);
        const unsigned gen = old / nloc;
        if (old + 1u == (gen + 1u) * nloc) {
            __builtin_amdgcn_fence(__ATOMIC_RELEASE, "agent");
            asm volatile("s_waitcnt vmcnt(0)" ::: "memory");
            const unsigned og = xb_add(&bar[XB_TOP], 1u);
            const unsigned tg = og / nx;
            if (og + 1u == (tg + 1u) * nx) xb_add(&bar[XB_TOPGEN], 1u);
            else XB_SPIN(xb_ld(&bar[XB_TOPGEN]) == tg, bar);
            __builtin_amdgcn_fence(__ATOMIC_ACQUIRE, "agent");
            xb_add(&bar[XB_XGEN(b.x)], 1u);
            asm volatile("s_waitcnt vmcnt(0)" ::: "memory");
        } else {
            XB_SPIN(xb_ld(&bar[XB_XGEN(b.x)]) == gen, bar);
            __builtin_amdgcn_fence(__ATOMIC_ACQUIRE, "agent");
            asm volatile("s_waitcnt vmcnt(0)" ::: "memory");
        }
    }
    __syncthreads();
}
#undef LAS
#ifndef RET_MODE
#define RET_MODE 1
#endif
#ifndef NSA_INLINE
#define NSA_INLINE __forceinline__
#endif
#ifndef DRY_MODE
#define DRY_MODE 0
#endif
#ifndef QF_MEM
#define QF_MEM 0
#endif
#ifndef TM_FENCE
#define TM_FENCE 0
#endif
#ifndef NSA_WG
#define NSA_WG 1
#endif
#ifndef D3_WG
#define D3_WG 1
#endif
#ifndef RET_WG
#define RET_WG 1
#endif
#ifndef PROBE_DUP
#define PROBE_DUP 0
#endif
#ifndef DBG_BRUTE
#define DBG_BRUTE 0
#endif
#ifndef DBG_ZERO
#define DBG_ZERO 0
#endif
constexpr int NWAVES = 8;
constexpr int NB = 16, SEQ = 2048, DM = 1024, MTOK = NB * SEQ, FF = 2816, NMEMT = 256, MMEM = NB * NMEMT, DEPTH = 4;
constexpr float EPS = 1e-6f;
constexpr float QSCALE = 0.125f * 1.4426950408889634f;
constexpr int RET_LD = 2560, RET_Q = 0, RET_K = 384, RET_V = 768, RET_G = 1536, RET_QM = 2304;
constexpr int DSA_LD = 1792, DSA_Q = 0, DSA_K = 768, DSA_V = 832, DSA_IQ = 896, DSA_IK = 1408, DSA_IW = 1472, DSA_QM = 1480, DSA_COLS = 1736;
constexpr int NSA_LD = 2816, NSA_Q = 0, NSA_KC = 768, NSA_VC = 1024, NSA_KS = 1280, NSA_VS = 1536, NSA_KW = 1792, NSA_VW = 2048, NSA_QM = 2304, NSA_GT = 2560;
constexpr int NSA_SRC_GT = 2304, NSA_SRC_QM = 2340, NSA_COLS = 2596;

constexpr size_t MiB = 1u << 20;
constexpr size_t WS_CTL = 0, CTL_ZERO_BYTES = 1 * MiB;
constexpr size_t WS_PART = 1 * MiB;
constexpr size_t WS_PARTM = 3 * MiB;
constexpr size_t WS_ROPE = 3 * MiB + 512 * 1024;
constexpr size_t WS_MISC = 4 * MiB;
constexpr size_t WS_CMPW = 4 * MiB + 64 * 1024;
constexpr size_t WS_KCMP = 5 * MiB;
constexpr size_t WS_VCMPT = 6 * MiB;
constexpr size_t WS_MK = 7 * MiB;
constexpr size_t WS_MVT = 15 * MiB;
constexpr size_t WS_MEMB = 23 * MiB;
constexpr size_t WS_MKV = 31 * MiB;
constexpr size_t WS_WKV = 47 * MiB;
constexpr size_t WS_WBUF0 = 51 * MiB, WBUF_BYTES = 41 * MiB;
constexpr size_t WS_XB = 133 * MiB;
constexpr size_t WS_Y = 197 * MiB;
constexpr size_t WS_HID = 261 * MiB;
constexpr size_t WS_SC = 373 * MiB;
constexpr size_t WS_MB = 501 * MiB;
constexpr size_t WS_END = 509 * MiB;
static_assert(WS_HID + (size_t)MTOK * FF * 2 <= WS_MB && WS_SC + (size_t)MTOK * SEQ * 2 <= WS_MB && WS_WBUF0 + 2 * WBUF_BYTES <= WS_XB, "d_ws map");
constexpr size_t WB_W1A = 0, WB_W2A = WB_W1A + (size_t)2 * FF * DM, WB_W1B = WB_W2A + (size_t)DM * FF, WB_W2B = WB_W1B + (size_t)2 * FF * DM,
                 WB_WIN = WB_W2B + (size_t)DM * FF, WB_WO = WB_WIN + (size_t)NSA_LD * DM, WB_END = WB_WO + (size_t)DM * DM;
static_assert(WB_END * 2 <= WBUF_BYTES, "weight buffer");
constexpr int LDS_CTRL = 147456 - 1024;
constexpr int CW_BAR = 4096;
constexpr int CW_CK = 32768;
constexpr int CW_Q = 16384;

#define GAS __attribute__((address_space(1)))
#define LAS __attribute__((address_space(3)))
typedef unsigned short bf16;
typedef unsigned v4u __attribute__((ext_vector_type(4)));
typedef unsigned v2u __attribute__((ext_vector_type(2)));
typedef float f32x4 __attribute__((ext_vector_type(4)));
typedef float f32x16 __attribute__((ext_vector_type(16)));
typedef short bf16x8 __attribute__((ext_vector_type(8)));
typedef GAS unsigned gu32;
#define RLX_AGENT __ATOMIC_RELAXED, __HIP_MEMORY_SCOPE_AGENT
#define LDS_WAIT() asm volatile("s_waitcnt lgkmcnt(0)" ::: "memory")
#define VM_WAIT() asm volatile("s_waitcnt vmcnt(0)" ::: "memory")
__device__ __forceinline__ unsigned f2bf(float f) { unsigned u = __builtin_bit_cast(unsigned, f); return (u + 0x7fffu + ((u >> 16) & 1u)) >> 16; }
__device__ __forceinline__ unsigned pk2(float lo, float hi) { return pg8::cvt_pk_bf16(lo, hi); }
__device__ __forceinline__ float bf2f(unsigned h) { return __builtin_bit_cast(float, h << 16); }
__device__ __forceinline__ float bflo(unsigned w) { return __builtin_bit_cast(float, w << 16); }
__device__ __forceinline__ float bfhi(unsigned w) { return __builtin_bit_cast(float, w & 0xffff0000u); }
struct Args { const float* in[23]; float* out; unsigned char* ws; int ph_lo, ph_hi, dry, pad; };
typedef const __attribute__((address_space(4))) Args* KArgs;
struct Frame {
    LAS unsigned char* lds;
    volatile LAS unsigned* MISC;
    gu32* ctl;
    int tid, lane, wave, G, gw, NGW;
    unsigned char* ws;
    KArgs ka;
    float* out;
};
__device__ __forceinline__ float wave_sum(float v) {
#pragma unroll
    for (int o = 1; o < 64; o <<= 1) v += __shfl_xor(v, o);
    return v;
}
__device__ __forceinline__ float wave_max(float v) {
#pragma unroll
    for (int o = 1; o < 64; o <<= 1) v = fmaxf(v, __shfl_xor(v, o));
    return v;
}
__device__ __forceinline__ int grab(gu32* ctr, int lane) { unsigned v = 0; if (lane == 0) v = __hip_atomic_fetch_add(ctr, 1u, RLX_AGENT); return __builtin_amdgcn_readfirstlane((int)v); }

__device__ __forceinline__ void cvt_item(const float* W, int ldw, const float* gain, bf16* WT, int K, LAS float* scr, int k0, int src_col0, int nvalid, int dst_row0, int lane) {
    const int c = lane & 31;
    float wv[32], gv2[32];
#pragma unroll
    for (int i = 0; i < 32; ++i) { const int kk = 2 * i + (lane >> 5); wv[i] = (c < nvalid) ? W[(size_t)(k0 + kk) * ldw + src_col0 + c] : 0.f; gv2[i] = gain ? gain[k0 + kk] : 1.f; }
#pragma unroll
    for (int i = 0; i < 32; ++i) { const int kk = 2 * i + (lane >> 5); scr[kk * 33 + c] = wv[i] * gv2[i]; }
    LDS_WAIT(); asm volatile("" ::: "memory");
    const int c8 = lane & 7;
#pragma unroll
    for (int j = 0; j < 4; ++j) { const int n = (lane >> 3) + 8 * j; const LAS float* s = scr + (8 * c8) * 33 + n;
        v4u o; o.x = pk2(s[0 * 33], s[1 * 33]); o.y = pk2(s[2 * 33], s[3 * 33]); o.z = pk2(s[4 * 33], s[5 * 33]); o.w = pk2(s[6 * 33], s[7 * 33]);
        *(GAS v4u*)(WT + (size_t)(dst_row0 + n) * K + k0 + 8 * c8) = o; }
    LDS_WAIT(); asm volatile("" ::: "memory");
}
__device__ __forceinline__ void cvt_matrix(Frame& F, int& it_base, const float* W, const float* W2, int ldw, int ncols, const float* gain, bf16* WT, int K, int nrows_dst, int kind) {
    LAS float* scr = (LAS float*)(F.lds + F.wave * 16384);
    const int nkb = K / 64, njb = nrows_dst / 32, nitems = nkb * njb;
    int first = (F.gw - it_base % F.NGW + F.NGW) % F.NGW;
    for (int i = first; i < nitems; i += F.NGW) {
        const int kb = i / njb, jb = i % njb; const float* src = W; int sc0 = jb * 32, nv = 32;
        if (kind == 0) { nv = ncols - sc0; nv = nv < 0 ? 0 : (nv > 32 ? 32 : nv); }
        else if (kind == 1) { const int c = jb * 32, pn = c >> 8, bj = (c >> 7) & 1, j = c & 127; src = bj ? W2 : W; sc0 = pn * 128 + j; }
        else { const int c = jb * 32;
            if (c < NSA_QM) { sc0 = c; }
            else if (c < NSA_GT) { sc0 = NSA_SRC_QM + (c - NSA_QM); }
            else { sc0 = NSA_SRC_GT + (c - NSA_GT); nv = NSA_SRC_QM - sc0; nv = nv < 0 ? 0 : (nv > 32 ? 32 : nv); } }
        cvt_item(src, ldw, gain, WT, K, scr, kb * 64, sc0, nv, jb * 32, F.lane);
    }
    it_base += nitems;
}
__device__ __forceinline__ void convert_layer(Frame& F, int Ly) {
    bf16* WB = (bf16*)(F.ws + WS_WBUF0 + (size_t)(Ly & 1) * WBUF_BYTES);
    const float* fnorm = F.ka->in[2]; const float* wg = F.ka->in[3]; const float* wu = F.ka->in[4]; const float* wd = F.ka->in[5];
    int itb = 0;
#pragma unroll 1
    for (int hf = 0; hf < 2; ++hf) {
        const size_t o1 = (size_t)(Ly * 2 + hf) * DM * FF;
        cvt_matrix(F, itb, wg + o1, wu + o1, FF, FF, fnorm + (size_t)(Ly * 2 + hf) * DM, WB + (hf ? WB_W1B : WB_W1A), DM, 2 * FF, 1);
        cvt_matrix(F, itb, wd + o1, nullptr, DM, DM, nullptr, WB + (hf ? WB_W2B : WB_W2A), FF, DM, 0);
    }
    const float* mnorm = F.ka->in[6] + (size_t)Ly * DM;
    const int kind = Ly % 3, j = Ly / 3;
    if (kind == 0) cvt_matrix(F, itb, F.ka->in[12] + (size_t)j * DM * RET_LD, nullptr, RET_LD, RET_LD, mnorm, WB + WB_WIN, DM, RET_LD, 0);
    else if (kind == 1) cvt_matrix(F, itb, F.ka->in[13] + (size_t)j * DM * DSA_COLS, nullptr, DSA_COLS, DSA_COLS, mnorm, WB + WB_WIN, DM, DSA_LD, 0);
    else cvt_matrix(F, itb, F.ka->in[16] + (size_t)j * DM * NSA_COLS, nullptr, NSA_COLS, NSA_COLS, mnorm, WB + WB_WIN, DM, NSA_LD, 2);
    cvt_matrix(F, itb, F.ka->in[7] + (size_t)Ly * DM * DM, nullptr, DM, DM, nullptr, WB + WB_WO, DM, DM, 0);
}

__device__ __forceinline__ void xform(Frame& F, const bf16* src, int spitch, int scol0, int nheads, int rows, int Lr, bf16* dst, int dmode, int dpitch, int dcol0,
                                      const float* gain, bool rope, float cscale, int decay  ) {
    const float* tab = (const float*)(F.ws + WS_ROPE);
    const int i8 = F.lane & 7, sub = F.lane >> 3; const int items = rows * nheads;
    float gn[8];
#pragma unroll
    for (int j = 0; j < 8; ++j) gn[j] = gain ? gain[8 * i8 + j] : 1.f;
    constexpr int U = 4;
    for (int it0 = F.gw * (8 * U); it0 < items; it0 += F.NGW * (8 * U)) {
        v4u raw[U]; f32x4 c0[U], c1[U], s0[U], s1[U];
#pragma unroll
        for (int u = 0; u < U; ++u) { const int it = it0 + 8 * u + sub; const int row = it / nheads, h = it % nheads, t = row % Lr;
            raw[u] = *(const GAS v4u*)(src + (size_t)row * spitch + scol0 + h * 64 + 8 * i8);
            if (rope) { const float* tr = tab + (size_t)t * 64 + 8 * (i8 & 3);
                c0[u] = *(const GAS f32x4*)(tr); c1[u] = *(const GAS f32x4*)(tr + 4); s0[u] = *(const GAS f32x4*)(tr + 32); s1[u] = *(const GAS f32x4*)(tr + 36); } }
#pragma unroll
        for (int u = 0; u < U; ++u) { const int it = it0 + 8 * u + sub; const int row = it / nheads, h = it % nheads, t = row % Lr;
            float v[8] = {bflo(raw[u].x), bfhi(raw[u].x), bflo(raw[u].y), bfhi(raw[u].y), bflo(raw[u].z), bfhi(raw[u].z), bflo(raw[u].w), bfhi(raw[u].w)};
            if (gain) { float ss = 0.f;
#pragma unroll
                for (int j = 0; j < 8; ++j) ss += v[j] * v[j];
                ss += __shfl_xor(ss, 1); ss += __shfl_xor(ss, 2); ss += __shfl_xor(ss, 4);
                const float r = __builtin_amdgcn_rsqf(ss * (1.f / 64.f) + EPS);
#pragma unroll
                for (int j = 0; j < 8; ++j) v[j] = v[j] * r * gn[j]; }
            if (rope) {
                const float cs[8] = {c0[u][0], c0[u][1], c0[u][2], c0[u][3], c1[u][0], c1[u][1], c1[u][2], c1[u][3]}, sn[8] = {s0[u][0], s0[u][1], s0[u][2], s0[u][3], s1[u][0], s1[u][1], s1[u][2], s1[u][3]};
#pragma unroll
                for (int j = 0; j < 8; ++j) { const float p = __shfl_xor(v[j], 4); v[j] = (i8 < 4) ? (v[j] * cs[j] - p * sn[j]) : (v[j] * cs[j] + p * sn[j]); } }
            float f = cscale;
            if (decay) { const float lg = __builtin_amdgcn_logf(1.0f - __builtin_amdgcn_exp2f(-5.0f - (float)h)); f *= __builtin_amdgcn_exp2f((float)(decay * t) * lg); }
            v4u o; o.x = pk2(v[0] * f, v[1] * f); o.y = pk2(v[2] * f, v[3] * f); o.z = pk2(v[4] * f, v[5] * f); o.w = pk2(v[6] * f, v[7] * f);
            bf16* dp = dmode == 0 ? dst + (size_t)row * dpitch + dcol0 + h * 64 + 8 * i8 : dst + ((size_t)((row / Lr) * nheads + h) * Lr + t) * 64 + 8 * i8;
            *(GAS v4u*)dp = o; }
    }
}
__device__ __forceinline__ void transpose_cols(Frame& F, const bf16* src, int spitch, int scol0, int ncols, int nb, int Lr, bf16* dst) {
    LAS bf16* scr = (LAS bf16*)(F.lds + F.wave * 16384);
    const int ntt = Lr / 64, nct = ncols / 64, ntiles = nb * ntt * nct; const int i8 = F.lane & 7, sub = F.lane >> 3;
    for (int tl = F.gw; tl < ntiles; tl += F.NGW) {
        const int ct = tl % nct, tt = (tl / nct) % ntt, b = tl / (nct * ntt); const int t0 = tt * 64, c0 = ct * 64;
#pragma unroll
        for (int k = 0; k < 8; ++k) { const int r = sub + 8 * k;
            const v4u raw = *(const GAS v4u*)(src + (size_t)(b * Lr + t0 + r) * spitch + scol0 + c0 + 8 * i8);
            *(LAS v4u*)(scr + r * 72 + 8 * i8) = raw; }
        LDS_WAIT(); asm volatile("" ::: "memory");
        bf16* drow = dst + ((size_t)b * ncols + c0 + F.lane) * Lr + t0;
#pragma unroll
        for (int k = 0; k < 8; ++k) { unsigned w[4];
#pragma unroll
            for (int q = 0; q < 4; ++q) { const unsigned lo = scr[(8 * k + 2 * q) * 72 + F.lane], hi = scr[(8 * k + 2 * q + 1) * 72 + F.lane]; w[q] = lo | (hi << 16); }
            v4u o; o.x = w[0]; o.y = w[1]; o.z = w[2]; o.w = w[3]; *(GAS v4u*)(drow + 8 * k) = o; }
        LDS_WAIT(); asm volatile("" ::: "memory");
    }
}
__device__ __forceinline__ void row_to_bf16(Frame& F, const float* xrow, bf16* orow, float* part) {
    const GAS f32x4* xr = (const GAS f32x4*)xrow + F.lane;
    f32x4 v[4]; float s = 0.f;
#pragma unroll
    for (int j = 0; j < 4; ++j) { v[j] = xr[64 * j]; s += (v[j].x * v[j].x + v[j].y * v[j].y) + (v[j].z * v[j].z + v[j].w * v[j].w); }
    s = wave_sum(s);
    GAS v2u* o8 = (GAS v2u*)orow + F.lane;
#pragma unroll
    for (int j = 0; j < 4; ++j) { v2u o; o.x = pk2(v[j].x, v[j].y); o.y = pk2(v[j].z, v[j].w); o8[64 * j] = o; }
    if (F.lane < 16) part[F.lane] = F.lane == 0 ? s : 0.f;
}
enum { MK_NONE = 0, MK_CAUSAL = 1, MK_WIN = 2, MK_BITS = 3, MK_SLC = 4, MK_CMP = 5 };
struct KVp { const bf16* K; int kpitch; const bf16* VT; int vpitch; };
struct MaskArg { int q0[3]; const unsigned* mb; unsigned sel; int nmax; float lg; };
__device__ __forceinline__ bf16x8 ld8(const bf16* p) { return *(const GAS bf16x8*)p; }
__device__ __forceinline__ float fast_exp2(float x) { return __builtin_amdgcn_exp2f(x); }

template <int NS, int NT, int MODE, int MT, int PF = 2>
__device__ __forceinline__ void attn_core(const LAS bf16x8* ql, const KVp kv, int kt0, int kt1, float negb, const MaskArg& ma, const unsigned* const (&mbrow)[NS],
                                          f32x16 (&O)[NS][NT], float (&lsum)[NS], int lane) {
    const int r32 = lane & 31, hi = lane >> 5;
    const int kperm = (r32 & 0x13) | ((r32 & 4) << 1) | ((r32 & 8) >> 1);
    const bf16* kp = kv.K + (size_t)kperm * kv.kpitch + 8 * hi;
    const bf16* vp = kv.VT + (size_t)r32 * kv.vpitch + 8 * hi;
    bf16x8 kf[4], vf[2][NT], kfn[4], vfn[2][NT];
#define AC_LOADK(dst, kt_) do { const bf16* kq_ = kp + (size_t)(32 * (kt_)) * kv.kpitch; _Pragma("unroll") for (int ks = 0; ks < 4; ++ks) dst[ks] = ld8(kq_ + 16 * ks); } while (0)
#define AC_LOADV(dst, kt_) do { _Pragma("unroll") for (int nt = 0; nt < NT; ++nt) { const bf16* vq_ = vp + (size_t)(32 * nt) * kv.vpitch + 32 * (kt_); dst[0][nt] = ld8(vq_); dst[1][nt] = ld8(vq_ + 16); } } while (0)
    unsigned mw[NS], mwn[NS];
    if (kt0 < kt1) { if (PF >= 1) AC_LOADK(kf, kt0); if (PF >= 2) AC_LOADV(vf, kt0);
        if (MT == MK_BITS) { _Pragma("unroll") for (int s = 0; s < NS; ++s) mw[s] = mbrow[s][kt0]; } }
#pragma unroll 1
    for (int kt = kt0; kt < kt1; ++kt) {
        unsigned selbit = 1u; bool active = true;
        if (MT == MK_SLC) { selbit = (ma.sel >> (kt >> 1)) & 1u; active = __any(selbit != 0u); }
        const int ktn = (kt + 1 < kt1) ? kt + 1 : kt;
        if (PF == 0) { if (active) { AC_LOADK(kf, kt); AC_LOADV(vf, kt); } }
        else { AC_LOADK(kfn, ktn); if (PF >= 2) AC_LOADV(vfn, ktn); else if (active) AC_LOADV(vf, kt); }
        if (MT == MK_BITS) { _Pragma("unroll") for (int s = 0; s < NS; ++s) mwn[s] = mbrow[s][ktn]; }
        if (active) {
        const LAS bf16x8* qlp = ql; asm volatile("" : "+v"(qlp));
#pragma unroll
        for (int s = 0; s < NS; ++s) {
            f32x16 acc;
#pragma unroll
            for (int r = 0; r < 16; ++r) acc[r] = 0.f;
            bf16x8 qq[4];
#pragma unroll
            for (int ks = 0; ks < 4; ++ks) qq[ks] = qlp[(s * 4 + ks) * 64];
#pragma unroll
            for (int ks = 0; ks < 4; ++ks) acc = __builtin_amdgcn_mfma_f32_32x32x16_bf16(kf[ks], qq[ks], acc, 0, 0, 0);
            const int tq = ma.q0[s] + r32, kb = 32 * kt + 8 * hi;
            bool full = true;
            if (MT == MK_CAUSAL) full = (32 * kt + 31 <= ma.q0[s]);
            if (MT == MK_WIN) full = (32 * kt + 31 <= ma.q0[s]) && (32 * kt >= ma.q0[s] + 31 - 511);
            if (MT == MK_SLC) full = (32 * kt + 31 <= ma.q0[s]) && __all(selbit != 0u);
            if (MT == MK_BITS || MT == MK_CMP) full = false;
            float p[16];
            if (full) {
#pragma unroll
                for (int r = 0; r < 16; ++r) { const int key = kb + 16 * (r >> 3) + (r & 7); p[r] = MODE == 0 ? fast_exp2(acc[r]) : (MODE == 1 ? acc[r] : acc[r] * fast_exp2((float)(tq - key) * ma.lg)); }
            } else {
                unsigned w = 0;
                if (MT == MK_BITS) w = mw[s];
#pragma unroll
                for (int r = 0; r < 16; ++r) { const int key = kb + 16 * (r >> 3) + (r & 7); bool v = true;
                    if (MT == MK_CAUSAL) v = key <= tq;
                    if (MT == MK_WIN) v = (key <= tq) && (key >= tq - 511);
                    if (MT == MK_SLC) v = (key <= tq) && (selbit != 0u);
                    if (MT == MK_BITS) v = (w >> (8 * hi + 16 * (r >> 3) + (r & 7))) & 1u;
                    if (MT == MK_CMP) v = key <= ma.nmax;
                    const float e = MODE == 0 ? fast_exp2(acc[r]) : (MODE == 1 ? acc[r] : acc[r] * fast_exp2((float)((tq - key) < 0 ? 0 : (tq - key)) * ma.lg));
                    p[r] = v ? e : 0.f; }
            }
            if (MODE == 0) { float a = 0.f;
#pragma unroll
                for (int r = 0; r < 16; ++r) a += p[r];
                lsum[s] += a; }
            bf16x8 pk0, pk1;
            { v4u t0, t1; t0.x = pk2(p[0], p[1]); t0.y = pk2(p[2], p[3]); t0.z = pk2(p[4], p[5]); t0.w = pk2(p[6], p[7]);
              t1.x = pk2(p[8], p[9]); t1.y = pk2(p[10], p[11]); t1.z = pk2(p[12], p[13]); t1.w = pk2(p[14], p[15]);
              pk0 = __builtin_bit_cast(bf16x8, t0); pk1 = __builtin_bit_cast(bf16x8, t1); }
#pragma unroll
            for (int nt = 0; nt < NT; ++nt) { O[s][nt] = __builtin_amdgcn_mfma_f32_32x32x16_bf16(pk0, vf[0][nt], O[s][nt], 0, 0, 0);
                                              O[s][nt] = __builtin_amdgcn_mfma_f32_32x32x16_bf16(pk1, vf[1][nt], O[s][nt], 0, 0, 0); }
            if (NS >= 3) __builtin_amdgcn_sched_barrier(0);
        }
        }
        if (MT == MK_BITS) { _Pragma("unroll") for (int s = 0; s < NS; ++s) mw[s] = mwn[s]; }
        if (PF >= 1) {
#pragma unroll
            for (int ks = 0; ks < 4; ++ks) kf[ks] = kfn[ks];
            if (PF >= 2) {
#pragma unroll
                for (int nt = 0; nt < NT; ++nt) { vf[0][nt] = vfn[0][nt]; vf[1][nt] = vfn[1][nt]; } }
        }
    }
#undef AC_LOADK
#undef AC_LOADV
}
template <int NS, int NT, int MODE, int MT>
__device__ __forceinline__ void tile_math(const bf16x8 (&kf)[4], const bf16x8 (&vf)[2][NT], const LAS bf16x8* ql, int kt, const MaskArg& ma, const unsigned (&mw)[NS], unsigned selbit,
                                          f32x16 (&O)[NS][NT], float (&lsum)[NS], int lane) {
    const int r32 = lane & 31, hi = lane >> 5;
    const LAS bf16x8* qlp = ql; asm volatile("" : "+v"(qlp));
    f32x16 acc[NS];
#pragma unroll
    for (int s = 0; s < NS; ++s)
#pragma unroll
        for (int r = 0; r < 16; ++r) acc[s][r] = 0.f;
    {
        bf16x8 qa[NS][4];
#pragma unroll
        for (int s = 0; s < NS; ++s)
#pragma unroll
            for (int ks = 0; ks < 4; ++ks) qa[s][ks] = qlp[(s * 4 + ks) * 64];
        __builtin_amdgcn_sched_barrier(0);
#pragma unroll
        for (int ks = 0; ks < 4; ++ks)
#pragma unroll
            for (int s = 0; s < NS; ++s) acc[s] = __builtin_amdgcn_mfma_f32_32x32x16_bf16(kf[ks], qa[s][ks], acc[s], 0, 0, 0);
        __builtin_amdgcn_sched_barrier(0);
    }
#pragma unroll
    for (int s = 0; s < NS; ++s) {
        const int tq = ma.q0[s] + r32, kb = 32 * kt + 8 * hi;
        bool full = true;
        if (MT == MK_CAUSAL) full = (32 * kt + 31 <= ma.q0[s]);
        if (MT == MK_WIN) full = (32 * kt + 31 <= ma.q0[s]) && (32 * kt >= ma.q0[s] + 31 - 511);
        if (MT == MK_SLC) full = (32 * kt + 31 <= ma.q0[s]) && __all(selbit != 0u);
        if (MT == MK_BITS || MT == MK_CMP) full = false;
        float p[16];
        if (full) {
#pragma unroll
            for (int r = 0; r < 16; ++r) p[r] = MODE == 0 ? fast_exp2(acc[s][r]) : acc[s][r];
        } else if (MT == MK_BITS) {
            const unsigned wsh = mw[s] >> (8 * hi);
#pragma unroll
            for (int r = 0; r < 16; ++r) { const int m = ((int)(wsh << (31 - (16 * (r >> 3) + (r & 7))))) >> 31;
                p[r] = __builtin_bit_cast(float, __builtin_bit_cast(unsigned, fast_exp2(acc[s][r])) & (unsigned)m); }
        } else {
#pragma unroll
            for (int r = 0; r < 16; ++r) { const int key = kb + 16 * (r >> 3) + (r & 7); bool v = true;
                if (MT == MK_CAUSAL) v = key <= tq;
                if (MT == MK_WIN) v = (key <= tq) && (key >= tq - 511);
                if (MT == MK_SLC) v = (key <= tq) && (selbit != 0u);
                if (MT == MK_CMP) v = key <= ma.nmax;
                const float e = MODE == 0 ? fast_exp2(acc[s][r]) : acc[s][r];
                p[r] = v ? e : 0.f; }
        }
        if (MODE == 0) { float a = 0.f;
#pragma unroll
            for (int r = 0; r < 16; ++r) a += p[r];
            lsum[s] += a; }
        bf16x8 pk0, pk1;
        { v4u t0, t1; t0.x = pk2(p[0], p[1]); t0.y = pk2(p[2], p[3]); t0.z = pk2(p[4], p[5]); t0.w = pk2(p[6], p[7]);
          t1.x = pk2(p[8], p[9]); t1.y = pk2(p[10], p[11]); t1.z = pk2(p[12], p[13]); t1.w = pk2(p[14], p[15]);
          pk0 = __builtin_bit_cast(bf16x8, t0); pk1 = __builtin_bit_cast(bf16x8, t1); }
#pragma unroll
        for (int nt = 0; nt < NT; ++nt) { O[s][nt] = __builtin_amdgcn_mfma_f32_32x32x16_bf16(pk0, vf[0][nt], O[s][nt], 0, 0, 0);
                                          O[s][nt] = __builtin_amdgcn_mfma_f32_32x32x16_bf16(pk1, vf[1][nt], O[s][nt], 0, 0, 0); }
    }
}
__device__ __forceinline__ int crow(int r, int hi) { return (r & 3) + 8 * (r >> 2) + 4 * hi; }
template <int NT, bool ADD>
__device__ __forceinline__ void store_o(const f32x16 (&O)[NT], float f, bf16* Y, int row0, int col0, int lane) {
    const int r32 = lane & 31, hi = lane >> 5;
    unsigned ybase = (unsigned)((row0 + 4 * hi) * 1024 + col0 + r32); asm volatile("" : "+v"(ybase));
#pragma unroll
    for (int rh = 0; rh < 2; ++rh) {
        unsigned short old[NT][8];
        if (ADD) {
#pragma unroll
            for (int ri = 0; ri < 8; ++ri)
#pragma unroll
                for (int nt = 0; nt < NT; ++nt) { const int r = 8 * rh + ri; old[nt][ri] = Y[ybase + (unsigned)(((r & 3) + 8 * (r >> 2)) * 1024) + 32 * nt]; }
        }
#pragma unroll
        for (int ri = 0; ri < 8; ++ri) { const int r = 8 * rh + ri; const int q = crow(r, hi); const float fr = __shfl(f, q);
            const unsigned yo = ybase + (unsigned)(((r & 3) + 8 * (r >> 2)) * 1024);
#pragma unroll
            for (int nt = 0; nt < NT; ++nt) { float v = O[nt][r] * fr; if (ADD) v += bf2f(old[nt][ri]); Y[yo + 32 * nt] = (bf16)f2bf(v); } }
    }
}
template <int NS> __device__ __forceinline__ void stage_q(LAS bf16x8* ql, const bf16* const (&qrow)[NS], int lane) {
    const int hi = lane >> 5;
#pragma unroll
    for (int s = 0; s < NS; ++s)
#pragma unroll
        for (int ks = 0; ks < 4; ++ks) ql[(s * 4 + ks) * 64] = ld8(qrow[s] + 16 * ks + 8 * hi);
    LDS_WAIT(); asm volatile("" ::: "memory");
}
__device__ __forceinline__ void q32_load(const bf16* p  , float (&v)[4][8]) {
    v4u raw[4];
#pragma unroll
    for (int ks = 0; ks < 4; ++ks) raw[ks] = *(const GAS v4u*)(p + 16 * ks);
#pragma unroll
    for (int ks = 0; ks < 4; ++ks) { v[ks][0] = bflo(raw[ks].x); v[ks][1] = bfhi(raw[ks].x); v[ks][2] = bflo(raw[ks].y); v[ks][3] = bfhi(raw[ks].y);
        v[ks][4] = bflo(raw[ks].z); v[ks][5] = bfhi(raw[ks].z); v[ks][6] = bflo(raw[ks].w); v[ks][7] = bfhi(raw[ks].w); }
}
__device__ __forceinline__ void q32_xf(float (&v)[4][8], const float* gain, bool rope, int t, float scale, int hi, const float* tab) {
    if (gain) { float ss = 0.f;
#pragma unroll
        for (int ks = 0; ks < 4; ++ks)
#pragma unroll
            for (int j = 0; j < 8; ++j) ss += v[ks][j] * v[ks][j];
        ss += __shfl_xor(ss, 32);
        const float r = __builtin_amdgcn_rsqf(ss * (1.f / 64.f) + EPS);
#pragma unroll
        for (int ks = 0; ks < 4; ++ks) { const f32x4 g0 = *(const GAS f32x4*)(gain + 16 * ks + 8 * hi), g1 = *(const GAS f32x4*)(gain + 16 * ks + 8 * hi + 4);
#pragma unroll
            for (int j = 0; j < 4; ++j) { v[ks][j] *= r * g0[j]; v[ks][4 + j] *= r * g1[j]; } } }
    if (rope) { const float* tr = tab + (size_t)t * 64 + 8 * hi;
#pragma unroll
        for (int ks = 0; ks < 2; ++ks) { const f32x4 c0 = *(const GAS f32x4*)(tr + 16 * ks), c1 = *(const GAS f32x4*)(tr + 16 * ks + 4), s0 = *(const GAS f32x4*)(tr + 32 + 16 * ks), s1 = *(const GAS f32x4*)(tr + 36 + 16 * ks);
#pragma unroll
            for (int j = 0; j < 8; ++j) { const float c = j < 4 ? c0[j & 3] : c1[j & 3], sn = j < 4 ? s0[j & 3] : s1[j & 3]; const float a = v[ks][j], b = v[ks + 2][j];
                v[ks][j] = a * c - b * sn; v[ks + 2][j] = b * c + a * sn; } } }
#pragma unroll
    for (int ks = 0; ks < 4; ++ks)
#pragma unroll
        for (int j = 0; j < 8; ++j) v[ks][j] *= scale;
}
__device__ __forceinline__ bf16x8 q32_pack(const float (&v)[8]) { v4u o; o.x = pk2(v[0], v[1]); o.y = pk2(v[2], v[3]); o.z = pk2(v[4], v[5]); o.w = pk2(v[6], v[7]); return __builtin_bit_cast(bf16x8, o); }
template <int NS> __device__ __forceinline__ void stage_q_xf(Frame& F, LAS bf16x8* ql, const bf16* const (&qrow)[NS], const int (&tpos)[NS], const float* gain, bool rope, float scale) {
    const int hi = F.lane >> 5; const float* tab = (const float*)(F.ws + WS_ROPE);
#pragma unroll
    for (int s = 0; s < NS; ++s) { float v[4][8]; q32_load(qrow[s] + 8 * hi, v); q32_xf(v, gain, rope, tpos[s], scale, hi, tab);
#pragma unroll
        for (int ks = 0; ks < 4; ++ks) ql[(s * 4 + ks) * 64] = q32_pack(v[ks]); }
    LDS_WAIT(); asm volatile("" ::: "memory");
}
__device__ __forceinline__ LAS bf16x8* wave_q(Frame& F) { return (LAS bf16x8*)(F.lds + F.wave * 16384) + F.lane; }
template <int NS, int NT> __device__ __forceinline__ void zero_o(f32x16 (&O)[NS][NT], float (&l)[NS]) {
#pragma unroll
    for (int s = 0; s < NS; ++s) { l[s] = 0.f;
#pragma unroll
        for (int nt = 0; nt < NT; ++nt)
#pragma unroll
            for (int r = 0; r < 16; ++r) O[s][nt][r] = 0.f; }
}

__device__ __forceinline__ void mem_task(Frame& F, int task, int Ly, const bf16* PROJ, int ldp, int qmcol) {
    const int qb = task & 31, h = (task >> 5) & 3, b = task >> 7; const int r32 = F.lane & 31;
    const int row0 = b * SEQ + 64 * qb;
    const bf16* qrow[2] = {PROJ + (size_t)(row0 + r32) * ldp + qmcol + h * 64, PROJ + (size_t)(row0 + 32 + r32) * ldp + qmcol + h * 64};
#if QF_MEM
    LAS bf16x8* ql = wave_q(F); { const int tp[2] = {0, 0}; stage_q_xf<2>(F, ql, qrow, tp, F.ka->in[10] + Ly * 64, false, QSCALE); }
#else
    LAS bf16x8* ql = wave_q(F); stage_q<2>(ql, qrow, F.lane);
#endif
    KVp kv{(const bf16*)(F.ws + WS_MK) + ((size_t)((Ly * NB + b) * 4 + h) * NMEMT) * 64, 64, (const bf16*)(F.ws + WS_MVT) + ((size_t)(Ly * NB + b) * 256 + h * 64) * NMEMT, NMEMT};
    f32x16 O[2][2]; float l[2]; zero_o<2, 2>(O, l);
    MaskArg ma{}; const unsigned* mbr[2] = {nullptr, nullptr};
    const float negb = 0.f;
    attn_core<2, 2, 0, MK_NONE>(ql, kv, 0, NMEMT / 32, negb, ma, mbr, O, l, F.lane);
    bf16* Y = (bf16*)(F.ws + WS_Y);
#pragma unroll
    for (int s = 0; s < 2; ++s) { const float lt = l[s] + __shfl_xor(l[s], 32); store_o<2, false>(O[s], (DBG_ZERO & 8) ? 0.f : 1.f / lt, Y, row0 + 32 * s, 768 + h * 64, F.lane); }
}
__device__ __forceinline__ void ret_epilogue(Frame& F, const f32x16 (&O)[4], int rowb, int h, const bf16* PROJ) {
    const int r32 = F.lane & 31, hi = F.lane >> 5;
    bf16* Y = (bf16*)(F.ws + WS_Y);
#pragma unroll
    for (int rh = 0; rh < 2; ++rh) {
        unsigned short gv[8][4];
#pragma unroll
        for (int ri = 0; ri < 8; ++ri) { const int r = 8 * rh + ri; const bf16* gp = PROJ + (size_t)(rowb + crow(r, hi)) * RET_LD + RET_G + h * 128 + r32;
#pragma unroll
            for (int nt = 0; nt < 4; ++nt) gv[ri][nt] = gp[32 * nt]; }
#pragma unroll
        for (int ri = 0; ri < 8; ++ri) { const int r = 8 * rh + ri;
            float a = (O[0][r] + O[1][r]) + (O[2][r] + O[3][r]);
#pragma unroll
            for (int o = 1; o < 32; o <<= 1) a += __shfl_xor(a, o);
            const float mu = a * (1.f / 128.f);
            float d0 = O[0][r] - mu, d1 = O[1][r] - mu, d2 = O[2][r] - mu, d3 = O[3][r] - mu;
            float q = (d0 * d0 + d1 * d1) + (d2 * d2 + d3 * d3);
#pragma unroll
            for (int o = 1; o < 32; o <<= 1) q += __shfl_xor(q, o);
            const float rstd = __builtin_amdgcn_rsqf(q * (1.f / 128.f) + EPS);
            const int row = rowb + crow(r, hi);
            bf16* yp = Y + (size_t)row * 1024 + h * 128 + r32;
            const float dd[4] = {d0, d1, d2, d3};
#pragma unroll
            for (int nt = 0; nt < 4; ++nt) { const float g = bf2f(gv[ri][nt]); const float sg = g * __builtin_amdgcn_rcpf(1.f + fast_exp2(-1.4426950408889634f * g));
                yp[32 * nt] = (DBG_ZERO & 1) ? (bf16)0 : (bf16)f2bf(sg * dd[nt] * rstd); }
        }
    }
}
__device__ __forceinline__ void glds16(const void* gsrc, unsigned lds_dst) { unsigned keep;
    asm volatile("s_mov_b32 %0, m0\n\ts_mov_b32 m0, %2\n\ts_nop 0\n\tglobal_load_lds_dwordx4 %1, off\n\ts_mov_b32 m0, %0" : "=&s"(keep) : "v"(gsrc), "s"(lds_dst) : "memory"); }
template <int NS, int MT, int R>
__device__ __forceinline__ void wg_attn(Frame& F, const LAS bf16x8* ql, const bf16* psrc, int pstep, unsigned ring_off, int kt0, int kt1, unsigned blk, int my0, int my1,
                                        const MaskArg& ma, const LAS unsigned* mlds, f32x16 (&O)[NS][2], float (&lsum)[NS]) {
    const unsigned pdst = (unsigned)(uintptr_t)F.lds + ring_off + (unsigned)F.wave * 1024u;
#define WG_NEED(k_) ((MT != MK_SLC) || (((blk) >> ((k_) >> 1)) & 1u))
#define WG_ADV(k_) do { ++(k_); } while ((k_) < kt1 && !WG_NEED(k_))
    int kd = kt0; if (kd < kt1 && !WG_NEED(kd)) WG_ADV(kd);
    int kc = kd;
    int sd = 0, sc = 0, nd = 0;
#pragma unroll 1
    for (int j = 0; j < R - 1; ++j) if (kd < kt1) { glds16(psrc + (size_t)kd * pstep, (unsigned)__builtin_amdgcn_readfirstlane(pdst + (unsigned)sd * 8192u)); WG_ADV(kd); sd = sd + 1 == R ? 0 : sd + 1; ++nd; }
#pragma unroll 1
    while (kc < kt1) {
        const int yo = nd - 1;
        if (yo >= 3) asm volatile("s_waitcnt vmcnt(3)\n\ts_barrier" ::: "memory");
        else if (yo == 2) asm volatile("s_waitcnt vmcnt(2)\n\ts_barrier" ::: "memory");
        else if (yo == 1) asm volatile("s_waitcnt vmcnt(1)\n\ts_barrier" ::: "memory");
        else asm volatile("s_waitcnt vmcnt(0)\n\ts_barrier" ::: "memory");
        if (kd < kt1) { glds16(psrc + (size_t)kd * pstep, (unsigned)__builtin_amdgcn_readfirstlane(pdst + (unsigned)sd * 8192u)); WG_ADV(kd); sd = sd + 1 == R ? 0 : sd + 1; ++nd; }
        if (kc >= my0 && kc < my1) {
            unsigned selbit = 1u; bool active = true;
            if (MT == MK_SLC) { selbit = (ma.sel >> (kc >> 1)) & 1u; active = __any(selbit != 0u); }
            if (active) {
                const LAS bf16x8* sp = (const LAS bf16x8*)(F.lds + ring_off + sc * 8192) + F.lane;
                bf16x8 kf[4], vf[2][2];
#pragma unroll
                for (int ks = 0; ks < 4; ++ks) kf[ks] = sp[ks * 64];
#pragma unroll
                for (int nt = 0; nt < 2; ++nt) { vf[0][nt] = sp[(4 + 2 * nt) * 64]; vf[1][nt] = sp[(5 + 2 * nt) * 64]; }
                unsigned mw[NS];
#pragma unroll
                for (int s = 0; s < NS; ++s) mw[s] = (MT == MK_BITS) ? mlds[kc] : 0u;
                tile_math<NS, 2, 0, MT>(kf, vf, ql, kc, ma, mw, selbit, O, lsum, F.lane);
            }
        }
        WG_ADV(kc); sc = sc + 1 == R ? 0 : sc + 1; --nd;
    }
    asm volatile("s_waitcnt vmcnt(0)\n\ts_barrier" ::: "memory");
#undef WG_NEED
#undef WG_ADV
}
constexpr int RWG_SLOT = 12288, RWG_R = 9;
__device__ __forceinline__ void ret_wg_task(Frame& F, int task, const bf16* PROJ) {
    const int qb = 7 - (task & 7), h = (task >> 3) % 6, b = (task >> 3) / 6, w = F.wave; const int r32 = F.lane & 31, hi = F.lane >> 5;
    const int rowb = b * SEQ + 256 * qb + 32 * w;
    bf16x8 qf[4];
    { float v[4][8]; q32_load(PROJ + (size_t)(rowb + r32) * RET_LD + RET_Q + h * 64 + 8 * hi, v);
      const int t = 256 * qb + 32 * w + r32; const float lg = __builtin_amdgcn_logf(1.0f - __builtin_amdgcn_exp2f(-5.0f - (float)h));
      q32_xf(v, nullptr, true, t, __builtin_amdgcn_exp2f((float)t * lg), hi, (const float*)(F.ws + WS_ROPE));
#pragma unroll
      for (int ks = 0; ks < 4; ++ks) qf[ks] = q32_pack(v[ks]); }
    asm volatile("s_waitcnt vmcnt(0)" : "+v"(qf[0]), "+v"(qf[1]), "+v"(qf[2]), "+v"(qf[3]) :: "memory");
    const int kperm = (r32 & 0x13) | ((r32 & 4) << 1) | ((r32 & 8) >> 1);
    const bf16* ksrc = PROJ + (size_t)(b * SEQ + kperm) * RET_LD + RET_K + h * 64 + 16 * (w & 3) + 8 * hi;
    const bf16* vsrc = (const bf16*)F.out + ((size_t)b * 768 + h * 128 + 32 * (w >> 1) + r32) * SEQ + 16 * (w & 1) + 8 * hi;
    const unsigned lds0 = (unsigned)(uintptr_t)F.lds;
    const unsigned kdst = lds0 + (unsigned)(w & 3) * 1024u, vdst = lds0 + 4096u + (unsigned)w * 1024u;
    const int kt1 = 8 * qb + 8, my1 = 8 * qb + w + 1;
#define RWG_DMA(t_, slot_) do { const int tt_ = (t_) < kt1 ? (t_) : kt1 - 1; const unsigned so_ = (unsigned)(((t_) < kt1) ? (slot_) : RWG_R) * RWG_SLOT; \
        if (w < 4) glds16(ksrc + (size_t)(32 * tt_) * RET_LD, (unsigned)__builtin_amdgcn_readfirstlane(kdst + so_)); \
        glds16(vsrc + 32 * tt_, (unsigned)__builtin_amdgcn_readfirstlane(vdst + so_)); } while (0)
    f32x16 O[4];
#pragma unroll
    for (int nt = 0; nt < 4; ++nt)
#pragma unroll
        for (int r = 0; r < 16; ++r) O[nt][r] = 0.f;
#pragma unroll 1
    for (int j = 0; j < RWG_R - 1; ++j) RWG_DMA(j, j);
    int slot = 0, fslot = RWG_R - 1;
#pragma unroll 1
    for (int kt = 0; kt < kt1; ++kt) {
        if (w < 4) asm volatile("s_waitcnt vmcnt(%0)\n\ts_barrier" :: "n"(2 * (RWG_R - 2)) : "memory");
        else       asm volatile("s_waitcnt vmcnt(%0)\n\ts_barrier" :: "n"(RWG_R - 2) : "memory");
        RWG_DMA(kt + RWG_R - 1, fslot);
        if (kt < my1) {
            const LAS bf16x8* sp = (const LAS bf16x8*)(F.lds + slot * RWG_SLOT) + F.lane;
            bf16x8 kf[4], vf[2][4];
#pragma unroll
            for (int ks = 0; ks < 4; ++ks) kf[ks] = sp[ks * 64];
#pragma unroll
            for (int nt = 0; nt < 4; ++nt) { vf[0][nt] = sp[(4 + 2 * nt) * 64]; vf[1][nt] = sp[(5 + 2 * nt) * 64]; }
            f32x16 acc;
#pragma unroll
            for (int r = 0; r < 16; ++r) acc[r] = 0.f;
#pragma unroll
            for (int ks = 0; ks < 4; ++ks) acc = __builtin_amdgcn_mfma_f32_32x32x16_bf16(kf[ks], qf[ks], acc, 0, 0, 0);
            float p[16];
            if (kt + 1 < my1) {
#pragma unroll
                for (int r = 0; r < 16; ++r) p[r] = acc[r];
            } else {
#pragma unroll
                for (int r = 0; r < 16; ++r) p[r] = (8 * hi + 16 * (r >> 3) + (r & 7) <= r32) ? acc[r] : 0.f;
            }
            bf16x8 pk0, pk1;
            { v4u t0, t1; t0.x = pk2(p[0], p[1]); t0.y = pk2(p[2], p[3]); t0.z = pk2(p[4], p[5]); t0.w = pk2(p[6], p[7]);
              t1.x = pk2(p[8], p[9]); t1.y = pk2(p[10], p[11]); t1.z = pk2(p[12], p[13]); t1.w = pk2(p[14], p[15]);
              pk0 = __builtin_bit_cast(bf16x8, t0); pk1 = __builtin_bit_cast(bf16x8, t1); }
#pragma unroll
            for (int nt = 0; nt < 4; ++nt) { O[nt] = __builtin_amdgcn_mfma_f32_32x32x16_bf16(pk0, vf[0][nt], O[nt], 0, 0, 0);
                                             O[nt] = __builtin_amdgcn_mfma_f32_32x32x16_bf16(pk1, vf[1][nt], O[nt], 0, 0, 0); }
        }
        fslot = slot; slot = slot + 1 == RWG_R ? 0 : slot + 1;
    }
    asm volatile("s_waitcnt vmcnt(0)\n\ts_barrier" ::: "memory");
#undef RWG_DMA
    ret_epilogue(F, O, rowb, h, PROJ);
}
__device__ __forceinline__ void ret_task(Frame& F, int task, const bf16* PROJ) {
    const int qb = 31 - (task & 31), h = (task >> 5) % 6, b = (task >> 5) / 6; const int r32 = F.lane & 31, hi = F.lane >> 5;
    const int row0 = b * SEQ + 64 * qb;
    const bf16* qrow[2] = {PROJ + (size_t)(row0 + r32) * RET_LD + RET_Q + h * 64, PROJ + (size_t)(row0 + 32 + r32) * RET_LD + RET_Q + h * 64};
    LAS bf16x8* ql = wave_q(F); stage_q<2>(ql, qrow, F.lane);
    KVp kv{PROJ + (size_t)(b * SEQ) * RET_LD + RET_K + h * 64, RET_LD, (const bf16*)F.out + ((size_t)b * 768 + h * 128) * SEQ, SEQ};
    f32x16 O[2][4]; float l[2]; zero_o<2, 4>(O, l);
    MaskArg ma{}; ma.q0[0] = 64 * qb; ma.q0[1] = 64 * qb + 32; const unsigned* mbr[2] = {nullptr, nullptr};
    ma.lg = __builtin_amdgcn_logf(1.0f - __builtin_amdgcn_exp2f(-5.0f - (float)h));
    attn_core<2, 4, RET_MODE, MK_CAUSAL, 1>(ql, kv, 0, 2 * qb + 2, 0.f, ma, mbr, O, l, F.lane);
#pragma unroll
    for (int s = 0; s < 2; ++s) ret_epilogue(F, O[s], row0 + 32 * s, h, PROJ);
}

typedef _Float16 h2_t __attribute__((ext_vector_type(2)));
__device__ __forceinline__ unsigned pkh(float a, float b) { h2_t v = {(_Float16)a, (_Float16)b}; return __builtin_bit_cast(unsigned, v); }
__device__ __forceinline__ void dsa_d1_task(Frame& F, int task, const bf16* PROJ) {
    const int b = task / 288; int rem = task % 288; int qb = 63, kc = 0;
    { int grp = 7; while (rem >= 8 * (grp + 1)) { rem -= 8 * (grp + 1); --grp; }
      qb = 8 * grp + 7 - rem / (grp + 1); kc = rem % (grp + 1); }
    const int r32 = F.lane & 31, hi = F.lane >> 5; const int row = b * SEQ + 32 * qb + r32;
    const bf16* qp = PROJ + (size_t)row * DSA_LD + DSA_IQ + 8 * hi;
    bf16x8 qf[4][4]; LAS bf16x8* ql = wave_q(F);
    { const int tpos = 32 * qb + r32; const float* tab = (const float*)(F.ws + WS_ROPE);
#pragma unroll
      for (int h = 0; h < 8; ++h) { float v[4][8]; q32_load(qp + h * 64, v); q32_xf(v, nullptr, true, tpos, 1.f, hi, tab);
#pragma unroll
          for (int ks = 0; ks < 4; ++ks) { const bf16x8 f = q32_pack(v[ks]); if (h < 4) qf[h & 3][ks] = f; else ql[((h & 3) * 4 + ks) * 64] = f; } } }
    LDS_WAIT(); asm volatile("" ::: "memory");
    float iw[8];
    { const v4u w = *(const GAS v4u*)(PROJ + (size_t)row * DSA_LD + DSA_IW); iw[0] = bflo(w.x); iw[1] = bfhi(w.x); iw[2] = bflo(w.y); iw[3] = bfhi(w.y); iw[4] = bflo(w.z); iw[5] = bfhi(w.z); iw[6] = bflo(w.w); iw[7] = bfhi(w.w); }
    const int kperm = (r32 & 0x13) | ((r32 & 4) << 1) | ((r32 & 8) >> 1);
    const bf16* kp = PROJ + (size_t)(b * SEQ + kperm) * DSA_LD + DSA_IK + 8 * hi;
    _Float16* sc = (_Float16*)(F.ws + WS_SC) + (size_t)row * SEQ + 8 * hi;
    const int kt1 = (8 * kc + 8 < qb + 1) ? 8 * kc + 8 : qb + 1;
    bf16x8 kf[4], kfn[4];
#pragma unroll
    for (int ks = 0; ks < 4; ++ks) kf[ks] = ld8(kp + (size_t)(32 * (8 * kc)) * DSA_LD + 16 * ks);
#pragma unroll 1
    for (int kt = 8 * kc; kt < kt1; ++kt) {
        { const int ktn = kt + 1 < kt1 ? kt + 1 : kt;
#pragma unroll
          for (int ks = 0; ks < 4; ++ks) kfn[ks] = ld8(kp + (size_t)(32 * ktn) * DSA_LD + 16 * ks); }
        float s[16];
#pragma unroll
        for (int r = 0; r < 16; ++r) s[r] = 0.f;
#pragma unroll
        for (int h = 0; h < 8; ++h) { f32x16 acc;
#pragma unroll
            for (int r = 0; r < 16; ++r) acc[r] = 0.f;
#pragma unroll
            for (int ks = 0; ks < 4; ++ks) acc = __builtin_amdgcn_mfma_f32_32x32x16_bf16(kf[ks], h < 4 ? qf[h & 3][ks] : ql[((h & 3) * 4 + ks) * 64], acc, 0, 0, 0);
#pragma unroll
            for (int r = 0; r < 16; ++r) s[r] += iw[h] * fmaxf(acc[r], 0.f);
            __builtin_amdgcn_sched_barrier(0); }
        v4u o0, o1; o0.x = pkh(s[0], s[1]); o0.y = pkh(s[2], s[3]); o0.z = pkh(s[4], s[5]); o0.w = pkh(s[6], s[7]);
        o1.x = pkh(s[8], s[9]); o1.y = pkh(s[10], s[11]); o1.z = pkh(s[12], s[13]); o1.w = pkh(s[14], s[15]);
        *(GAS v4u*)(sc + 32 * kt) = o0; *(GAS v4u*)(sc + 32 * kt + 16) = o1;
#pragma unroll
        for (int ks = 0; ks < 4; ++ks) kf[ks] = kfn[ks];
    }
}
__device__ __forceinline__ int hist_select(LAS unsigned* hist, const unsigned (&key)[32], bool lvl2, unsigned B, int target, int lane) {
    { unsigned z = 0u; asm volatile("" : "+v"(z)); *(LAS v4u*)(hist + 4 * lane) = (v4u){z, z, z, z}; }
    LDS_WAIT(); asm volatile("" ::: "memory");
#pragma unroll
    for (int e = 0; e < 32; ++e) { const unsigned d = lvl2 ? (key[e] & 255u) : (key[e] >> 8); const bool m = lvl2 ? ((key[e] >> 8) == B) : true;
        if (m) __hip_atomic_fetch_add(hist + d, 1u, __ATOMIC_RELAXED, __HIP_MEMORY_SCOPE_WAVEFRONT); }
    LDS_WAIT(); asm volatile("" ::: "memory");
    const v4u c = *(LAS v4u*)(hist + 4 * lane);
    const int s = (int)(c.x + c.y + c.z + c.w);
    int S = s;
#pragma unroll
    for (int o = 1; o < 64; o <<= 1) { const int v = __shfl_down(S, o); if (lane + o < 64) S += v; }
    const unsigned long long bm = __ballot(S >= target);
    const int Ls = 63 - __clzll(bm);
    int a = S - s, dig, abv;
    if (a + (int)c.w >= target) { dig = 3; abv = a; } else { a += (int)c.w;
        if (a + (int)c.z >= target) { dig = 2; abv = a; } else { a += (int)c.z;
            if (a + (int)c.y >= target) { dig = 1; abv = a; } else { a += (int)c.y; dig = 0; abv = a; } } }
    const int packed = ((4 * lane + dig) << 12) | abv;
    const int r = __shfl(packed, Ls);
    LDS_WAIT(); asm volatile("" ::: "memory");
    return r;
}
__device__ __forceinline__ void d2_load(Frame& F, int row, v4u (&raw)[4]) {
    const int t = row % SEQ, lane = F.lane;
    const unsigned short* sp = (const unsigned short*)(F.ws + WS_SC) + (size_t)row * SEQ + (32 * lane <= t ? 32 * lane : 0);
#pragma unroll
    for (int i = 0; i < 4; ++i) raw[i] = *(const GAS v4u*)(sp + 8 * i);
}
__device__ __forceinline__ void dsa_d2_row(Frame& F, int row, const v4u (&raw)[4]) {
    const int t = row % SEQ, lane = F.lane;
    unsigned* mbp = (unsigned*)(F.ws + WS_MB) + (size_t)row * 64;
    int nvalid = t + 1 - 32 * lane; nvalid = nvalid < 0 ? 0 : (nvalid > 32 ? 32 : nvalid);
    const unsigned cb = nvalid == 32 ? 0xffffffffu : ((1u << nvalid) - 1u);
    if (t < 256) { mbp[lane] = cb; return; }
    unsigned key[32];
#pragma unroll
    for (int i = 0; i < 4; ++i) { const unsigned w[4] = {raw[i].x, raw[i].y, raw[i].z, raw[i].w};
#pragma unroll
        for (int j = 0; j < 4; ++j) {
#pragma unroll
            for (int k = 0; k < 2; ++k) { const int e = 8 * i + 2 * j + k; const unsigned u = (w[j] >> (16 * k)) & 0xffffu;
                const unsigned sk = (u & 0x8000u) ? (~u & 0xffffu) : (u | 0x8000u);
                key[e] = (e < nvalid) ? sk : 0u; } } }
    LAS unsigned* hist = (LAS unsigned*)(F.lds + F.wave * 16384);
    const int d1 = hist_select(hist, key, false, 0u, 256, lane);
    const unsigned Bh = (unsigned)d1 >> 12; const int above1 = d1 & 0xfff;
    const int d2 = hist_select(hist, key, true, Bh, 256 - above1, lane);
    const unsigned T = (Bh << 8) | ((unsigned)d2 >> 12);
    const int cgt = above1 + (d2 & 0xfff);
    unsigned g = 0, eq = 0;
#pragma unroll
    for (int e = 0; e < 32; ++e) { unsigned bg = key[e] > T ? 1u : 0u, be = key[e] == T ? 1u : 0u; asm volatile("" : "+v"(bg), "+v"(be));
        g |= bg << e; eq |= be << e; }
    const int need = 256 - cgt; const int myeq = __popc(eq);
    int incl = myeq;
#pragma unroll
    for (int o = 1; o < 64; o <<= 1) { const int v = __shfl_up(incl, o); if (lane >= o) incl += v; }
    const int pre = incl - myeq; int take = need - pre; take = take < 0 ? 0 : (take > myeq ? myeq : take);
    unsigned te = eq; int cnt = myeq;
    while (cnt > take) { te &= ~(1u << (31 - __clz(te))); --cnt; }
    mbp[lane] = (g | te) & cb;
}
__device__ __forceinline__ void dsa_d3_task(Frame& F, int task, const bf16* PROJ) {
    const int hg = task & 3, qb = 63 - ((task >> 2) & 63), b = task >> 8; const int r32 = F.lane & 31;
    const int row0 = b * SEQ + 32 * qb;
    const bf16* qrow[3]; const unsigned* mbr[3];
#pragma unroll
    for (int s = 0; s < 3; ++s) { qrow[s] = PROJ + (size_t)(row0 + r32) * DSA_LD + DSA_Q + (3 * hg + s) * 64; mbr[s] = (const unsigned*)(F.ws + WS_MB) + (size_t)(row0 + r32) * 64; }
    LAS bf16x8* ql = wave_q(F); stage_q<3>(ql, qrow, F.lane);
    KVp kv{PROJ + (size_t)(b * SEQ) * DSA_LD + DSA_K, DSA_LD, (const bf16*)F.out + (size_t)b * 64 * SEQ, SEQ};
    f32x16 O[3][2]; float l[3]; zero_o<3, 2>(O, l);
    MaskArg ma{}; ma.q0[0] = ma.q0[1] = ma.q0[2] = 32 * qb;
    const float negb = 0.f;
    attn_core<3, 2, 0, MK_BITS, 2>(ql, kv, 0, qb + 1, negb, ma, mbr, O, l, F.lane);
    bf16* Y = (bf16*)(F.ws + WS_Y);
#pragma unroll
    for (int s = 0; s < 3; ++s) { const float lt = l[s] + __shfl_xor(l[s], 32); store_o<2, false>(O[s], (DBG_ZERO & 2) ? 0.f : 1.f / lt, Y, row0, (3 * hg + s) * 64, F.lane); }
}

constexpr unsigned D3_MOFF = 98304u, D3_ROFF = 98304u + 64u * 65u * 4u;
__device__ __forceinline__ void dsa_d3_wg_task(Frame& F, int task, const bf16* PROJ) {
    const int qb = 31 - (task & 31), b = task >> 5, w = F.wave, qs = w >> 2, hg = w & 3; const int r32 = F.lane & 31, hi = F.lane >> 5;
    const int row0 = b * SEQ + 64 * qb + 32 * qs;
    const bf16* qrow[3];
#pragma unroll
    for (int s = 0; s < 3; ++s) qrow[s] = PROJ + (size_t)(row0 + r32) * DSA_LD + DSA_Q + (3 * hg + s) * 64;
    LAS bf16x8* ql = (LAS bf16x8*)(F.lds + w * 12288) + F.lane; { const int tq_ = 64 * qb + 32 * qs + r32; const int tp[3] = {tq_, tq_, tq_}; stage_q_xf<3>(F, ql, qrow, tp, F.ka->in[14], true, QSCALE); }
    { const unsigned* mb = (const unsigned*)(F.ws + WS_MB) + (size_t)(b * SEQ + 64 * qb) * 64; LAS unsigned* ml = (LAS unsigned*)(F.lds + D3_MOFF);
#pragma unroll
      for (int j = 0; j < 2; ++j) { const int e = (F.tid + 512 * j) * 4, row = e >> 6, col = e & 63; const v4u m = *(const GAS v4u*)(mb + e);
          ml[row * 65 + col] = m.x; ml[row * 65 + col + 1] = m.y; ml[row * 65 + col + 2] = m.z; ml[row * 65 + col + 3] = m.w; } }
    asm volatile("s_waitcnt vmcnt(0) lgkmcnt(0)\n\ts_barrier" ::: "memory");
    const int kperm = (r32 & 0x13) | ((r32 & 4) << 1) | ((r32 & 8) >> 1);
    const bf16* psrc; int pstep;
    if (w < 4) { psrc = PROJ + (size_t)(b * SEQ + kperm) * DSA_LD + DSA_K + 16 * w + 8 * hi; pstep = 32 * DSA_LD; }
    else { const int j = w - 4; psrc = (const bf16*)F.out + ((size_t)b * 64 + 32 * (j >> 1) + r32) * SEQ + 16 * (j & 1) + 8 * hi; pstep = 32; }
    f32x16 O[3][2]; float l[3]; zero_o<3, 2>(O, l);
    MaskArg ma{}; ma.q0[0] = ma.q0[1] = ma.q0[2] = 64 * qb + 32 * qs;
    const LAS unsigned* mlds = (const LAS unsigned*)(F.lds + D3_MOFF) + (qs * 32 + r32) * 65;
    wg_attn<3, MK_BITS, 3>(F, ql, psrc, pstep, D3_ROFF, 0, 2 * qb + 2, 0xffffffffu, 0, 2 * qb + qs + 1, ma, mlds, O, l);
    bf16* Y = (bf16*)(F.ws + WS_Y);
#pragma unroll
    for (int s = 0; s < 3; ++s) { const float lt = l[s] + __shfl_xor(l[s], 32); store_o<2, false>(O[s], (DBG_ZERO & 2) ? 0.f : 1.f / lt, Y, row0, (3 * hg + s) * 64, F.lane); }
}

__device__ __forceinline__ void nsa_cmp_task(Frame& F, int task, int chunk, const bf16* PROJ, const float* kn0) {
    const int nb = task & 3, g = (task >> 2) & 3, b = task >> 4; const int r32 = F.lane & 31, hi = F.lane >> 5;
    const int n = 32 * nb + r32, nc = n > 126 ? 126 : n;
    const bf16* arow = PROJ + (size_t)(b * SEQ + 16 * nc) * NSA_LD + 64 * g + 8 * hi;
    const bf16* WkT = (const bf16*)(F.ws + WS_CMPW); const bf16* WvT = WkT + 64 * 2048;
    const bf16* wkp = WkT + (size_t)r32 * 2048 + 8 * hi; const bf16* wvp = WvT + (size_t)r32 * 2048 + 8 * hi;
    f32x16 Dk[2], Dv[2];
#pragma unroll
    for (int et = 0; et < 2; ++et)
#pragma unroll
        for (int r = 0; r < 16; ++r) { Dk[et][r] = 0.f; Dv[et][r] = 0.f; }
#pragma unroll 4
    for (int kk = 32 * chunk; kk < 32 * chunk + 32; ++kk) {
        const bf16* ap = arow + (size_t)(kk >> 2) * NSA_LD + 16 * (kk & 3);
        const bf16x8 kcf = ld8(ap + NSA_KC), vcf = ld8(ap + NSA_VC);
#pragma unroll
        for (int et = 0; et < 2; ++et) { const bf16x8 wk = ld8(wkp + (size_t)(32 * et) * 2048 + 16 * kk), wv = ld8(wvp + (size_t)(32 * et) * 2048 + 16 * kk);
            Dk[et] = __builtin_amdgcn_mfma_f32_32x32x16_bf16(wk, kcf, Dk[et], 0, 0, 0);
            Dv[et] = __builtin_amdgcn_mfma_f32_32x32x16_bf16(vcf, wv, Dv[et], 0, 0, 0); }
    }
    { LAS f32x4* pl = (LAS f32x4*)(F.lds + F.wave * 16384) + F.lane;
      if (chunk != 0) {
#pragma unroll
          for (int et = 0; et < 2; ++et)
#pragma unroll
              for (int c = 0; c < 4; ++c) { pl[(et * 4 + c) * 64] = (f32x4){Dk[et][4 * c], Dk[et][4 * c + 1], Dk[et][4 * c + 2], Dk[et][4 * c + 3]};
                                            pl[(8 + et * 4 + c) * 64] = (f32x4){Dv[et][4 * c], Dv[et][4 * c + 1], Dv[et][4 * c + 2], Dv[et][4 * c + 3]}; } }
      asm volatile("s_waitcnt vmcnt(0) lgkmcnt(0)\n\ts_barrier" ::: "memory");
      if (chunk != 0) return;
#pragma unroll 1
      for (int o = 1; o < 4; ++o) { const LAS f32x4* ql_ = pl + o * (16384 / 16);
#pragma unroll
          for (int et = 0; et < 2; ++et)
#pragma unroll
              for (int c = 0; c < 4; ++c) { const f32x4 a = ql_[(et * 4 + c) * 64], d = ql_[(8 + et * 4 + c) * 64];
#pragma unroll
                  for (int i = 0; i < 4; ++i) { Dk[et][4 * c + i] += a[i]; Dv[et][4 * c + i] += d[i]; } } } }
    const float* ck = (const float*)(F.ws + WS_CTL) + CW_CK; const float* cv = ck + 64;
    const float* tab = (const float*)(F.ws + WS_ROPE) + (size_t)(16 * nc + 31) * 64;
    float ss = 0.f;
#pragma unroll
    for (int et = 0; et < 2; ++et)
#pragma unroll
        for (int r = 0; r < 16; ++r) { Dk[et][r] += ck[32 * et + crow(r, hi)]; ss += Dk[et][r] * Dk[et][r]; }
    ss += __shfl_xor(ss, 32);
    const float rs = __builtin_amdgcn_rsqf(ss * (1.f / 64.f) + EPS);
    bf16* kout = (bf16*)(F.ws + WS_KCMP) + ((size_t)((b * 4 + g) * 128 + n)) * 64;
#pragma unroll
    for (int rq = 0; rq < 4; ++rq) { float o0[4], o1[4];
#pragma unroll
        for (int i = 0; i < 4; ++i) { const int r = 4 * rq + i, idx = crow(r, hi); const float v0 = Dk[0][r] * rs * kn0[idx], v1 = Dk[1][r] * rs * kn0[32 + idx];
            const float c = tab[idx], s = tab[32 + idx]; o0[i] = v0 * c - v1 * s; o1[i] = v1 * c + v0 * s; if (n > 126) { o0[i] = 0.f; o1[i] = 0.f; } }
        v2u w0, w1; w0.x = pk2(o0[0], o0[1]); w0.y = pk2(o0[2], o0[3]); w1.x = pk2(o1[0], o1[1]); w1.y = pk2(o1[2], o1[3]);
        *(GAS v2u*)(kout + 8 * rq + 4 * hi) = w0; *(GAS v2u*)(kout + 32 + 8 * rq + 4 * hi) = w1; }
    bf16* vout = (bf16*)(F.ws + WS_VCMPT) + ((size_t)((b * 4 + g) * 64)) * 128 + 32 * nb;
#pragma unroll
    for (int et = 0; et < 2; ++et) { const float cve = cv[32 * et + r32];
#pragma unroll
        for (int rq = 0; rq < 4; ++rq) { float o[4];
#pragma unroll
            for (int i = 0; i < 4; ++i) { const int nl = 8 * rq + 4 * hi + i; o[i] = (32 * nb + nl > 126) ? 0.f : Dv[et][4 * rq + i] + cve; }
            v2u w; w.x = pk2(o[0], o[1]); w.y = pk2(o[2], o[3]);
            *(GAS v2u*)(vout + (size_t)(32 * et + r32) * 128 + 8 * rq + 4 * hi) = w; } }
}
constexpr unsigned NSA_ROFF = 98304u;
template <bool WG>
__device__ NSA_INLINE void nsa_task(KArgs ka_, unsigned char* ws_, float* out_, LAS unsigned char* lds_, int wave_, int task, const bf16* PROJ) {
    Frame F; F.ka = ka_; F.ws = ws_; F.out = out_; F.lds = lds_; F.wave = wave_; F.MISC = (volatile LAS unsigned*)(lds_ + LDS_CTRL + 64);
    asm volatile("v_mbcnt_lo_u32_b32 %0, -1, 0\n\tv_mbcnt_hi_u32_b32 %0, -1, %0" : "=v"(F.lane));
    const int qb8 = 7 - (task & 7);
    const int g = WG ? (task >> 3) & 3 : task & 3, qb = WG ? 8 * qb8 + wave_ : 63 - ((task >> 2) & 63), b = WG ? task >> 5 : task >> 8; const int r32 = F.lane & 31, hi = F.lane >> 5;
    const int row0 = b * SEQ + 32 * qb, tq = 32 * qb + r32;
    const bf16* qrow[3];
#pragma unroll
    for (int s = 0; s < 3; ++s) qrow[s] = PROJ + (size_t)(row0 + r32) * NSA_LD + NSA_Q + (3 * g + s) * 64;
    LAS bf16x8* ql = WG ? (LAS bf16x8*)(F.lds + F.wave * 12288) + F.lane : wave_q(F); { const int tp[3] = {tq, tq, tq}; stage_q_xf<3>(F, ql, qrow, tp, F.ka->in[17], true, QSCALE); }
#define NSA_GATE(s_, c_) (__builtin_amdgcn_rcpf(1.f + fast_exp2(-1.4426950408889634f * bf2f(PROJ[(size_t)(row0 + r32) * NSA_LD + NSA_GT + 9 * g + 3 * (s_) + (c_)]))))
    bf16* Y = (bf16*)(F.ws + WS_Y);
    MaskArg ma{}; ma.q0[0] = ma.q0[1] = ma.q0[2] = 32 * qb; ma.nmax = tq >= 31 ? (tq - 31) >> 4 : -1;
    const KVp kvc{(const bf16*)(F.ws + WS_KCMP) + (size_t)((b * 4 + g) * 128) * 64, 64, (const bf16*)(F.ws + WS_VCMPT) + (size_t)((b * 4 + g) * 64) * 128, 128};
    float imp[16];
#pragma unroll
    for (int r = 0; r < 16; ++r) imp[r] = 0.f;
#ifndef NSA_NO_A
    {   const int kperm = (r32 & 0x13) | ((r32 & 4) << 1) | ((r32 & 8) >> 1);
        const bf16* kp = kvc.K + (size_t)kperm * 64 + 8 * hi;
#pragma unroll 1
        for (int s = 0; s < 3; ++s) { f32x16 ia; float ls = 0.f;
#pragma unroll
            for (int r = 0; r < 16; ++r) ia[r] = 0.f;
#pragma unroll 1
            for (int kt = 0; kt < 4; ++kt) { f32x16 acc;
#pragma unroll
                for (int r = 0; r < 16; ++r) acc[r] = 0.f;
#pragma unroll
                for (int ks = 0; ks < 4; ++ks) acc = __builtin_amdgcn_mfma_f32_32x32x16_bf16(ld8(kp + (size_t)(32 * kt) * 64 + 16 * ks), ql[(s * 4 + ks) * 64], acc, 0, 0, 0);
                float p[16];
#pragma unroll
                for (int r = 0; r < 16; ++r) { const int key = 32 * kt + 8 * hi + 16 * (r >> 3) + (r & 7); p[r] = key <= ma.nmax ? fast_exp2(acc[r]) : 0.f; ls += p[r]; }
#pragma unroll
                for (int ks2 = 0; ks2 < 2; ++ks2) { v4u pw, cw; unsigned short cvv[8];
                    pw.x = pk2(p[8 * ks2], p[8 * ks2 + 1]); pw.y = pk2(p[8 * ks2 + 2], p[8 * ks2 + 3]); pw.z = pk2(p[8 * ks2 + 4], p[8 * ks2 + 5]); pw.w = pk2(p[8 * ks2 + 6], p[8 * ks2 + 7]);
#pragma unroll
                    for (int jj = 0; jj < 8; ++jj) { const int nn = 32 * kt + 16 * ks2 + 8 * hi + jj; cvv[jj] = (nn >= 4 * r32 - 1 && nn <= 4 * r32 + 3) ? 0x3f80 : 0; }
                    cw.x = cvv[0] | (cvv[1] << 16); cw.y = cvv[2] | (cvv[3] << 16); cw.z = cvv[4] | (cvv[5] << 16); cw.w = cvv[6] | (cvv[7] << 16);
                    ia = __builtin_amdgcn_mfma_f32_32x32x16_bf16(__builtin_bit_cast(bf16x8, cw), __builtin_bit_cast(bf16x8, pw), ia, 0, 0, 0); }
            }
            const float lt = ls + __shfl_xor(ls, 32); const float inv = lt > 0.f ? 1.f / lt : 0.f;
#pragma unroll
            for (int r = 0; r < 16; ++r) imp[r] += ia[r] * inv;
        }
    }
#endif
    unsigned sel;
    { const int qblk = tq >> 6;
      if (32 * qb + 31 < 1024) sel = (2u << qblk) - 1u;
      else { float val[16], oth[16];
#pragma unroll
        for (int r = 0; r < 16; ++r) { const int j = crow(r, hi); val[r] = j > qblk ? -1e30f : ((j == 0 || j == qblk || j == qblk - 1) ? 1e9f : imp[r]); oth[r] = __shfl_xor(val[r], 32); }
        unsigned mine = 0;
#pragma unroll
        for (int r = 0; r < 16; ++r) { const int j = crow(r, hi); int rank = 0;
#pragma unroll
            for (int r2 = 0; r2 < 16; ++r2) { const int j2 = crow(r2, hi), j3 = crow(r2, hi ^ 1);
                rank += (val[r2] > val[r] || (val[r2] == val[r] && j2 < j)) ? 1 : 0;
                rank += (oth[r2] > val[r] || (oth[r2] == val[r] && j3 < j)) ? 1 : 0; }
            mine |= ((rank < 16 && j <= qblk) ? 1u : 0u) << ((r & 3) + 8 * (r >> 2)); }
        mine <<= 4 * hi;
        sel = mine | __shfl_xor(mine, 32); } }
    const unsigned* mbr2[2] = {nullptr, nullptr}; const unsigned* mbr1[1] = {nullptr};
    const KVp kvs{PROJ + (size_t)(b * SEQ) * NSA_LD + NSA_KS + 64 * g, NSA_LD, (const bf16*)F.out + ((size_t)b * 256 + 64 * g) * SEQ, SEQ};
    const KVp kvw{PROJ + (size_t)(b * SEQ) * NSA_LD + NSA_KW + 64 * g, NSA_LD, (const bf16*)F.out + (size_t)NB * 256 * SEQ + ((size_t)b * 256 + 64 * g) * SEQ, SEQ};
    ma.sel = sel;
#define NSA_BRANCH(MT_, KV_, KT0_, KT1_, C_, ADD_, ZBIT_) do { \
      { f32x16 O2[2][2]; float l2[2]; zero_o<2, 2>(O2, l2); attn_core<2, 2, 0, MT_>(ql, KV_, KT0_, KT1_, 0.f, ma, mbr2, O2, l2, F.lane); VM_WAIT(); \
        _Pragma("unroll") for (int s = 0; s < 2; ++s) { const float lt = l2[s] + __shfl_xor(l2[s], 32); \
          store_o<2, ADD_>(O2[s], (lt > 0.f && !(DBG_ZERO & ZBIT_)) ? NSA_GATE(s, C_) / lt : 0.f, Y, row0, (3 * g + s) * 64, F.lane); } } \
      { f32x16 O1[1][2]; float l1[1]; zero_o<1, 2>(O1, l1); attn_core<1, 2, 0, MT_>(ql + 2 * 4 * 64, KV_, KT0_, KT1_, 0.f, ma, mbr1, O1, l1, F.lane); VM_WAIT(); \
        const float lt = l1[0] + __shfl_xor(l1[0], 32); \
        store_o<2, ADD_>(O1[0], (lt > 0.f && !(DBG_ZERO & ZBIT_)) ? NSA_GATE(2, C_) / lt : 0.f, Y, row0, (3 * g + 2) * 64, F.lane); } } while (0)
    NSA_BRANCH(MK_CMP, kvc, 0, 4, 0, false, 4);
    if (!WG) {
    NSA_BRANCH(MK_SLC, kvs, 0, qb + 1, 1, true, 16);
    NSA_BRANCH(MK_WIN, kvw, (qb > 16 ? qb - 16 : 0), qb + 1, 2, true, 32);
    } else {
        unsigned wsel = sel;
#pragma unroll
        for (int o = 1; o < 32; o <<= 1) wsel |= __shfl_xor(wsel, o);
        if (F.lane == 0) __hip_atomic_fetch_or((LAS unsigned*)(F.lds + LDS_CTRL + 64) + 17, wsel, __ATOMIC_RELAXED, __HIP_MEMORY_SCOPE_WORKGROUP);
        asm volatile("s_waitcnt vmcnt(0) lgkmcnt(0)\n\ts_barrier" ::: "memory");
        const unsigned blk = (unsigned)__builtin_amdgcn_readfirstlane((int)F.MISC[17]);
        const int kperm = (r32 & 0x13) | ((r32 & 4) << 1) | ((r32 & 8) >> 1), w = F.wave;
#define NSA_WGBRANCH(MT_, KCOL_, VTOFF_, KT0_, KT1_, MY0_, MY1_, BLK_, C_, ZBIT_) do { \
        const bf16* psrc; int pstep; \
        if (w < 4) { psrc = PROJ + (size_t)(b * SEQ + kperm) * NSA_LD + (KCOL_) + 64 * g + 16 * w + 8 * hi; pstep = 32 * NSA_LD; } \
        else { const int j_ = w - 4; psrc = (const bf16*)F.out + (VTOFF_) + ((size_t)b * 256 + 64 * g + 32 * (j_ >> 1) + r32) * SEQ + 16 * (j_ & 1) + 8 * hi; pstep = 32; } \
        f32x16 O3[3][2]; float l3[3]; zero_o<3, 2>(O3, l3); \
        wg_attn<3, MT_, 5>(F, ql, psrc, pstep, NSA_ROFF, KT0_, KT1_, BLK_, MY0_, MY1_, ma, (const LAS unsigned*)nullptr, O3, l3); \
        _Pragma("unroll") for (int s = 0; s < 3; ++s) { const float lt = l3[s] + __shfl_xor(l3[s], 32); \
          store_o<2, true>(O3[s], (lt > 0.f && !(DBG_ZERO & ZBIT_)) ? NSA_GATE(s, C_) / lt : 0.f, Y, row0, (3 * g + s) * 64, F.lane); } } while (0)
        NSA_WGBRANCH(MK_SLC, NSA_KS, (size_t)0, 0, 8 * qb8 + 8, 0, qb + 1, blk, 1, 16);
        NSA_WGBRANCH(MK_WIN, NSA_KW, (size_t)NB * 256 * SEQ, (8 * qb8 > 16 ? 8 * qb8 - 16 : 0), 8 * qb8 + 8, (qb > 16 ? qb - 16 : 0), qb + 1, 0xffffffffu, 2, 32);
#undef NSA_WGBRANCH
    }
#undef NSA_BRANCH
}
__device__ __forceinline__ void prologue_misc(Frame& F) {
    float* tab = (float*)(F.ws + WS_ROPE);
    for (int idx = blockIdx.x * (NWAVES * 64) + F.tid; idx < SEQ * 32; idx += F.G * NWAVES * 64) {
        const int t = idx >> 5, i = idx & 31;
        const float inv = exp2f(-(float)i * (13.287712379549449f / 32.0f));
        const float ang = (float)t * inv; float s, c; sincosf(ang, &s, &c);
        tab[t * 64 + i] = c; tab[t * 64 + 32 + i] = s; }
    if (blockIdx.x < 4) {
        const int kv = F.wave & 1, part = blockIdx.x * 4 + (F.wave >> 1);
        const float* pos = kv ? F.ka->in[20] : F.ka->in[19]; const float* w = kv ? F.ka->in[22] : F.ka->in[21]; float a = 0.f;
#pragma unroll 8
        for (int i = part * 128; i < part * 128 + 128; ++i) a += pos[i] * w[(size_t)i * 64 + F.lane];
        atomicAdd((float*)(F.ws + WS_CTL) + CW_CK + 64 * kv + F.lane, a);
    }
}
__device__ __forceinline__ void prologue_phase(Frame& F) {
    prologue_misc(F);
    bf16* XB = (bf16*)(F.ws + WS_XB); float* PART = (float*)(F.ws + WS_PART);
    for (int m = F.gw; m < MTOK; m += F.NGW) row_to_bf16(F, F.ka->in[0] + (size_t)m * DM, XB + (size_t)m * DM, PART + (size_t)m * 16);
    bf16* MEMB = (bf16*)(F.ws + WS_MEMB); float* PARTM = (float*)(F.ws + WS_PARTM);
    for (int m = F.gw; m < MMEM; m += F.NGW) row_to_bf16(F, F.ka->in[1] + (size_t)m * DM, MEMB + (size_t)m * DM, PARTM + (size_t)m * 16);
    int itb = 0;
#pragma unroll 1
    for (int ly = 0; ly < DEPTH; ++ly) cvt_matrix(F, itb, F.ka->in[9] + (size_t)ly * DM * 512, nullptr, 512, 512, F.ka->in[8] + (size_t)ly * DM, (bf16*)(F.ws + WS_WKV) + (size_t)ly * 512 * DM, DM, 512, 0);
    cvt_matrix(F, itb, F.ka->in[21], nullptr, 64, 64, nullptr, (bf16*)(F.ws + WS_CMPW), 2048, 64, 0);
    cvt_matrix(F, itb, F.ka->in[22], nullptr, 64, 64, nullptr, (bf16*)(F.ws + WS_CMPW) + 64 * 2048, 2048, 64, 0);
    convert_layer(F, 0);
}

template <unsigned PHASE_MASK> __global__ void __launch_bounds__(NWAVES * 64, 2) mk_fwd(Args args) {
    extern __shared__ __attribute__((aligned(16))) unsigned char lds[];
    Frame F;
    F.lds = (LAS unsigned char*)lds;
    F.MISC = (volatile LAS unsigned*)(F.lds + LDS_CTRL + 64);
    F.tid = threadIdx.x; F.lane = F.tid & 63; F.wave = __builtin_amdgcn_readfirstlane(F.tid >> 6);
    F.G = gridDim.x; F.gw = blockIdx.x * NWAVES + F.wave; F.NGW = F.G * NWAVES;
    F.ws = args.ws; F.ctl = (gu32*)(args.ws + WS_CTL); F.out = args.out;
    F.ka = (KArgs)__builtin_amdgcn_kernarg_segment_ptr();
    for (int u = F.tid; u < 1024 / 4; u += NWAVES * 64) ((LAS unsigned*)(F.lds + LDS_CTRL))[u] = 0u;
    __syncthreads();
    XcdBarrier bar = xcd_barrier_post((unsigned*)(F.ctl + CW_BAR), F.MISC + 8);
    constexpr bool ALLPH = PHASE_MASK == 0xffffffffu;
    const int lo = ALLPH ? 0 : args.ph_lo, hi = ALLPH ? 0 : args.ph_hi; int pc = 0;
    const bool dry = ALLPH ? false : (args.dry != 0);
#define PH_BEGIN(id) if (ALLPH || ((((PHASE_MASK) >> (id)) & 1u) && lo <= pc && pc < hi)) { asm volatile("" : "+s"(F.ka), "+s"(F.ws), "+s"(F.out), "+s"(F.gw), "+s"(F.NGW), "+s"(F.G), "+s"(F.wave)); asm volatile("v_mbcnt_lo_u32_b32 %0, -1, 0\n\tv_mbcnt_hi_u32_b32 %0, -1, %0" : "=v"(F.lane)); F.tid = F.wave * 64 + F.lane;
#define PH_END_(islast)   if (ALLPH ? !(islast) : (pc + 1 < hi)) { XcdBarrier b2_ = bar; asm volatile("" : "+s"(b2_.bar), "+s"(b2_.x)); xcd_barrier(b2_); } } if (!ALLPH) ++pc;
#define PH_END PH_END_(false)
#define QCTR(i) (F.ctl + CW_Q + 64 * (i))

#define XB ((bf16*)(F.ws + WS_XB))
#define VTB ((bf16*)F.out)
#define Yb ((bf16*)(F.ws + WS_Y))
#define HID ((bf16*)(F.ws + WS_HID))
#define PART ((float*)(F.ws + WS_PART))
    LAS unsigned char* ring = F.lds;

    PH_BEGIN(0) prologue_phase(F); PH_END
    PH_BEGIN(1) { pg8::Gemm g{(const bf16*)(F.ws + WS_MEMB), (const bf16*)(F.ws + WS_WKV), MMEM, 2048, DM}; pg8::StaticOrder S; S.init(MMEM, 2048, F.G, (int)blockIdx.x);
        pg8::EpiScale E{(bf16*)(F.ws + WS_MKV), 2048, (const float*)(F.ws + WS_PARTM)};
        pg8::gemm_phase<pg8::EpiScale, pg8::StaticOrder, true, true>(ring, g, S, E, F.wave); } PH_END

#pragma unroll 1
    for (int Ly = 0; Ly < DEPTH; ++Ly) {
#define WB ((const bf16*)(F.ws + WS_WBUF0 + (size_t)(Ly & 1) * WBUF_BYTES))
        const int kind = Ly % 3;
        const int ldp = kind == 0 ? RET_LD : (kind == 1 ? DSA_LD : NSA_LD);
        PH_BEGIN(3) { pg8::Gemm g{XB, WB + WB_W1A, MTOK, 2 * FF, DM}; pg8::StaticOrder S; S.init(MTOK, 2 * FF, F.G, (int)blockIdx.x);
            pg8::EpiSwiglu E{HID, FF, PART, dry ? DRY_MODE : 0};
            pg8::gemm_phase<pg8::EpiSwiglu, pg8::StaticOrder, true, true>(ring, g, S, E, F.wave); } PH_END
        PH_BEGIN(4) { pg8::Gemm g{HID, WB + WB_W2A, MTOK, DM, FF}; pg8::StaticOrder S; S.init(MTOK, DM, F.G, (int)blockIdx.x);
            pg8::EpiResid E{XB, XB, nullptr, PART, dry ? 0.f : 0.5f};
            pg8::gemm_phase<pg8::EpiResid, pg8::StaticOrder, true, true>(ring, g, S, E, F.wave); } PH_END
        PH_BEGIN(5) { pg8::Gemm g{XB, WB + WB_WIN, MTOK, ldp, DM}; pg8::StaticOrder S; S.init(MTOK, ldp, F.G, (int)blockIdx.x);
            pg8::EpiScale E{HID, ldp, PART};
            pg8::gemm_phase<pg8::EpiScale, pg8::StaticOrder, true, true>(ring, g, S, E, F.wave); } PH_END
        PH_BEGIN(6)
#define DO_X (!dry || DRY_MODE == 0 || DRY_MODE == 11)
#define DO_T (!dry || DRY_MODE == 0 || DRY_MODE == 12)
#define DO_C (!dry || DRY_MODE == 0 || DRY_MODE == 13)
            if (kind == 0) {
                if (DO_X) xform(F, HID, ldp, RET_K, 6, MTOK, SEQ, (dry ? Yb : HID), 0, (dry ? 1024 : ldp), (dry ? 0 : RET_K), nullptr, true, 0.125f, RET_MODE == 1 ? -1 : 0);
#if !QF_MEM
                xform(F, HID, ldp, RET_QM, 4, MTOK, SEQ, HID, 0, ldp, RET_QM, F.ka->in[10] + Ly * 64, false, QSCALE, 0);
#endif
                if (DO_T) transpose_cols(F, HID, ldp, RET_V, 768, NB, SEQ, VTB);
            } else if (kind == 1) {
                if (DO_X) xform(F, HID, ldp, DSA_K, 1, MTOK, SEQ, (dry ? Yb : HID), 0, (dry ? 1024 : ldp), (dry ? 0 : DSA_K), F.ka->in[15], true, 1.f, 0);
                if (DO_X) xform(F, HID, ldp, DSA_IK, 1, MTOK, SEQ, (dry ? Yb : HID), 0, (dry ? 1024 : ldp), (dry ? 0 : DSA_IK), nullptr, true, 1.f, 0);
#if !QF_MEM
                xform(F, HID, ldp, DSA_QM, 4, MTOK, SEQ, HID, 0, ldp, DSA_QM, F.ka->in[10] + Ly * 64, false, QSCALE, 0);
#endif
                if (DO_T) transpose_cols(F, HID, ldp, DSA_V, 64, NB, SEQ, VTB);
            } else {
                if (DO_T && blockIdx.x < 128) nsa_cmp_task(F, 2 * (int)blockIdx.x + (F.wave >> 2), F.wave & 3, HID, F.ka->in[18]);
                if (DO_X) xform(F, HID, ldp, NSA_KS, 4, MTOK, SEQ, (dry ? Yb : HID), 0, (dry ? 1024 : ldp), (dry ? 0 : NSA_KS), F.ka->in[18] + 64, true, 1.f, 0);
                if (DO_X) xform(F, HID, ldp, NSA_KW, 4, MTOK, SEQ, (dry ? Yb : HID), 0, (dry ? 1024 : ldp), (dry ? 0 : NSA_KW), F.ka->in[18] + 128, true, 1.f, 0);
#if !QF_MEM
                xform(F, HID, ldp, NSA_QM, 4, MTOK, SEQ, HID, 0, ldp, NSA_QM, F.ka->in[10] + Ly * 64, false, QSCALE, 0);
#endif
                if (DO_T) transpose_cols(F, HID, ldp, NSA_VS, 256, NB, SEQ, VTB);
                if (DO_T) transpose_cols(F, HID, ldp, NSA_VW, 256, NB, SEQ, VTB + (size_t)NB * 256 * SEQ);
            }
            if (Ly == 0 && !dry) {
#pragma unroll 1
        for (int ly = 0; ly < DEPTH; ++ly) {
            xform(F, (const bf16*)(F.ws + WS_MKV), 2048, ly * 512, 4, MMEM, NMEMT, (bf16*)(F.ws + WS_MK) + (size_t)ly * NB * 4 * NMEMT * 64, 1, 0, 0, F.ka->in[11] + ly * 64, false, 1.f, 0);
            transpose_cols(F, (const bf16*)(F.ws + WS_MKV), 2048, ly * 512 + 256, 256, NB, NMEMT, (bf16*)(F.ws + WS_MVT) + (size_t)ly * NB * 256 * NMEMT);
        }
            }
            if (DO_C && Ly + 1 < DEPTH) convert_layer(F, Ly + 1);
#undef DO_X
#undef DO_T
#undef DO_C
        PH_END
        if (kind == 0) {
            PH_BEGIN(7)
                for (;;) {
                    asm volatile("s_waitcnt vmcnt(0) lgkmcnt(0)\n\ts_barrier" ::: "memory");
                    if (F.tid == 0) F.MISC[16] = __hip_atomic_fetch_add(QCTR(Ly * 8 + 3), 1u, RLX_AGENT);
                    asm volatile("s_waitcnt vmcnt(0) lgkmcnt(0)\n\ts_barrier" ::: "memory");
                    const int t = __builtin_amdgcn_readfirstlane((int)F.MISC[16]);
                    if (t >= NB * 6 * 8) break;
                    asm volatile("v_mbcnt_lo_u32_b32 %0, -1, 0\n\tv_mbcnt_hi_u32_b32 %0, -1, %0" : "=v"(F.lane));
                    ret_wg_task(F, t, HID);
                }
                for (;;) { asm volatile("v_mbcnt_lo_u32_b32 %0, -1, 0\n\tv_mbcnt_hi_u32_b32 %0, -1, %0" : "=v"(F.lane)); const int t = grab(QCTR(Ly * 8 + 0), F.lane) + (RET_WG ? 3072 : 0); if (t >= 3072 + 2048) break; mem_task(F, t - 3072, Ly, HID, ldp, RET_QM); }
            PH_END
        } else if (kind == 1) {
            PH_BEGIN(8)
                for (;;) { asm volatile("v_mbcnt_lo_u32_b32 %0, -1, 0\n\tv_mbcnt_hi_u32_b32 %0, -1, %0" : "=v"(F.lane)); const int t = grab(QCTR(Ly * 8 + 0), F.lane); if (t >= 4608 + 2048) break; if (t < 4608) dsa_d1_task(F, t, HID); else mem_task(F, t - 4608, Ly, HID, ldp, DSA_QM); }
            PH_END
            PH_BEGIN(9)
                for (;;) { asm volatile("v_mbcnt_lo_u32_b32 %0, -1, 0\n\tv_mbcnt_hi_u32_b32 %0, -1, %0" : "=v"(F.lane)); const int t = grab(QCTR(Ly * 8 + 1), F.lane); if (t >= MTOK / 8) break;
{ v4u ra[4], rb[4]; d2_load(F, MTOK - 1 - 8 * t, ra);
#pragma unroll 1
                      for (int i = 0; i < 8; i += 2) { d2_load(F, MTOK - 1 - (8 * t + i + 1), rb); dsa_d2_row(F, MTOK - 1 - (8 * t + i), ra);
                          if (i + 2 < 8) d2_load(F, MTOK - 1 - (8 * t + i + 2), ra); dsa_d2_row(F, MTOK - 1 - (8 * t + i + 1), rb); } } }
            PH_END
            PH_BEGIN(10)
                                for (;;) {
                    asm volatile("s_waitcnt vmcnt(0) lgkmcnt(0)\n\ts_barrier" ::: "memory");
                    if (F.tid == 0) F.MISC[16] = __hip_atomic_fetch_add(QCTR(Ly * 8 + 3), 1u, RLX_AGENT);
                    asm volatile("s_waitcnt vmcnt(0) lgkmcnt(0)\n\ts_barrier" ::: "memory");
                    const int t = __builtin_amdgcn_readfirstlane((int)F.MISC[16]);
                    if (t >= NB * 32) break;
                    asm volatile("v_mbcnt_lo_u32_b32 %0, -1, 0\n\tv_mbcnt_hi_u32_b32 %0, -1, %0" : "=v"(F.lane)); F.tid = F.wave * 64 + F.lane;
                    dsa_d3_wg_task(F, t, HID);
                }

            PH_END
        } else {
            PH_BEGIN(11)
                for (;;) {
                    asm volatile("s_waitcnt vmcnt(0) lgkmcnt(0)\n\ts_barrier" ::: "memory");
                    if (F.tid == 0) { F.MISC[16] = __hip_atomic_fetch_add(QCTR(Ly * 8 + 3), 1u, RLX_AGENT); F.MISC[17] = 0u; }
                    asm volatile("s_waitcnt vmcnt(0) lgkmcnt(0)\n\ts_barrier" ::: "memory");
                    const int t = __builtin_amdgcn_readfirstlane((int)F.MISC[16]);
                    if (t >= NB * 4 * 8) break;
                    nsa_task<true>(F.ka, F.ws, F.out, F.lds, F.wave, t, HID);
                }
                for (;;) { asm volatile("v_mbcnt_lo_u32_b32 %0, -1, 0\n\tv_mbcnt_hi_u32_b32 %0, -1, %0" : "=v"(F.lane)); const int t = grab(QCTR(Ly * 8 + 0), F.lane) + (NSA_WG ? 4096 : 0); if (t >= 4096 + 2048) break; mem_task(F, t - 4096, Ly, HID, ldp, NSA_QM); }
            PH_END
        }
        PH_BEGIN(12) { pg8::Gemm g{Yb, WB + WB_WO, MTOK, DM, DM}; pg8::StaticOrder S; S.init(MTOK, DM, F.G, (int)blockIdx.x);
            pg8::EpiResid E{XB, XB, nullptr, PART, dry ? 0.f : 1.0f};
            pg8::gemm_phase<pg8::EpiResid, pg8::StaticOrder, true, true>(ring, g, S, E, F.wave); } PH_END
        PH_BEGIN(13) { pg8::Gemm g{XB, WB + WB_W1B, MTOK, 2 * FF, DM}; pg8::StaticOrder S; S.init(MTOK, 2 * FF, F.G, (int)blockIdx.x);
            pg8::EpiSwiglu E{HID, FF, PART, dry ? DRY_MODE : 0};
            pg8::gemm_phase<pg8::EpiSwiglu, pg8::StaticOrder, true, true>(ring, g, S, E, F.wave); } PH_END
        PH_BEGIN(14) { pg8::Gemm g{HID, WB + WB_W2B, MTOK, DM, FF}; pg8::StaticOrder S; S.init(MTOK, DM, F.G, (int)blockIdx.x);
            pg8::EpiResid E{XB, XB, Ly == DEPTH - 1 ? F.out : nullptr, PART, dry ? 0.f : 0.5f};
            pg8::gemm_phase<pg8::EpiResid, pg8::StaticOrder, true, true>(ring, g, S, E, F.wave); } PH_END_(Ly == DEPTH - 1)
    }
#undef XB
#undef VTB
#undef Yb
#undef HID
#undef PART
#undef WB
#undef PH_BEGIN
#undef PH_END
#undef PH_END_
}

constexpr int LDS_BYTES = 147456;
#ifndef MK_PER_PHASE
#define MK_PER_PHASE 0
#endif
typedef void (*kern_t)(Args);
template <unsigned M> static kern_t kern_of() { return mk_fwd<M>; }
#if MK_PER_PHASE
static kern_t phase_kernel(int id) {
    switch (id) {
        case 0: return kern_of<1u << 0>(); case 1: return kern_of<1u << 1>(); case 2: return kern_of<1u << 2>(); case 3: return kern_of<1u << 3>(); case 4: return kern_of<1u << 4>();
        case 5: return kern_of<1u << 5>(); case 6: return kern_of<1u << 6>(); case 7: return kern_of<1u << 7>(); case 8: return kern_of<1u << 8>(); case 9: return kern_of<1u << 9>();
        case 10: return kern_of<1u << 10>(); case 11: return kern_of<1u << 11>(); case 12: return kern_of<1u << 12>(); case 13: return kern_of<1u << 13>(); default: return kern_of<1u << 14>();
    }
}
#endif
extern "C" void kernel_launch(void* const* d_in, const int* in_sizes, int n_in, void* d_out, int out_size, void* d_ws, size_t ws_size, hipStream_t stream) {
    static int grid = 0;
    if (grid == 0) {
        if (n_in != 23 || out_size != MTOK * DM || ws_size < WS_END) { fprintf(stderr, "kernel_launch: unexpected shapes (n_in %d, out %d, ws %zu)\n", n_in, out_size, ws_size); grid = -1; return; }
        int dev = 0, cus = 0;
        if (hipGetDevice(&dev) != hipSuccess || hipDeviceGetAttribute(&cus, hipDeviceAttributeMultiprocessorCount, dev) != hipSuccess) { grid = -1; return; }
#if MK_PER_PHASE
        for (int id = 0; id < 15; ++id) if (hipFuncSetAttribute((const void*)phase_kernel(id), hipFuncAttributeMaxDynamicSharedMemorySize, LDS_BYTES) != hipSuccess) { fprintf(stderr, "kernel_launch: hipFuncSetAttribute failed\n"); grid = -1; return; }
#else
        if (hipFuncSetAttribute((const void*)kern_of<0xffffffffu>(), hipFuncAttributeMaxDynamicSharedMemorySize, LDS_BYTES) != hipSuccess) { fprintf(stderr, "kernel_launch: hipFuncSetAttribute failed\n"); grid = -1; return; }
#endif
        (void)hipGetLastError();
        grid = cus;
    }
    if (grid < 0) return;
    if (hipMemsetAsync((char*)d_ws + WS_CTL, 0, CTL_ZERO_BYTES, stream) != hipSuccess) return;
    Args a{};
    for (int i = 0; i < 23; ++i) a.in[i] = (const float*)d_in[i];
    a.out = (float*)d_out; a.ws = (unsigned char*)d_ws;
    constexpr int NPH = 2 + 8 * DEPTH + 2;
#if MK_PER_PHASE
    int ids[NPH]; int n = 0; ids[n++] = 0; ids[n++] = 1;
    for (int ly = 0; ly < DEPTH; ++ly) { ids[n++] = 3; ids[n++] = 4; ids[n++] = 5; ids[n++] = 6;
        if (ly % 3 == 0) ids[n++] = 7; else if (ly % 3 == 1) { ids[n++] = 8; ids[n++] = 9; ids[n++] = 10; } else ids[n++] = 11;
        ids[n++] = 12; ids[n++] = 13; ids[n++] = 14; }
    for (int p = 0; p < NPH; ++p) { a.ph_lo = p; a.ph_hi = p + 1;
#if PROBE_DUP
        if ((PROBE_DUP >> ids[p]) & 1) {
            a.dry = 1; hipLaunchKernelGGL(phase_kernel(ids[p]), dim3(grid), dim3(NWAVES * 64), LDS_BYTES, stream, a); a.dry = 0;
            hipMemsetAsync((char*)d_ws + WS_CTL + CW_Q * 4, 0, 64 * 4 * 64, stream); }
#endif
        hipLaunchKernelGGL(phase_kernel(ids[p]), dim3(grid), dim3(NWAVES * 64), LDS_BYTES, stream, a);
    }
#else
    a.ph_lo = 0; a.ph_hi = NPH; hipLaunchKernelGGL(kern_of<0xffffffffu>(), dim3(grid), dim3(NWAVES * 64), LDS_BYTES, stream, a);
#endif
}
```

```cpp
#include <hip/hip_runtime.h>
#include <cstdio>
#include <cstdint>
namespace pg8 {
#define PG8_LAS __attribute__((address_space(3)))
typedef unsigned short bf16_t;
typedef short bf16x8 __attribute__((ext_vector_type(8)));
typedef float f32x4 __attribute__((ext_vector_type(4)));
typedef unsigned u32x4 __attribute__((ext_vector_type(4)));
constexpr int BM = 256, BK = 64, HALF = 128, HTB = HALF * BK * 2  , STAGE_BYTES = 8 * HTB, NXCD = 8, WGM = 8;

__host__ __device__ __forceinline__ int lds_byte(int r, int c) { const int st = (r >> 4) * 2 + (c >> 5), rr = r & 15, cc = c & 31, ob = rr * 64 + cc * 2; return st * 1024 + (ob ^ (((ob >> 9) & 1) << 5)); }
__host__ __device__ __forceinline__ void stage_rc(int b, int& R, int& C) { const int st = b / 1024, sb = b % 1024, swz = sb ^ (((sb >> 9) & 1) << 5); R = (st >> 1) * 16 + swz / 64; C = (st & 1) * 32 + (swz % 64) / 2; }
__host__ __device__ __forceinline__ int perm32(int rho) { const int n = rho >> 4, i = rho & 15; return 8 * (i >> 2) + 4 * n + (i & 3); }

struct Unit { int pm, pn; };
struct Gemm { const bf16_t* A; const bf16_t* Bt; int M, N, K; };

struct StaticOrder {
    int nM, nN, nwg, G, c;
    __host__ __device__ void init(int M, int N, int G_, int c_) { nM = M / BM; nN = N / BM; nwg = nM * nN; G = G_; c = c_; }
    __host__ __device__ bool next(int i, Unit& u) const {
        const long L = (long)i * G + c; if (L >= nwg) return false;
        int wgid = (int)L; { const int q = nwg / NXCD, r = nwg % NXCD, xcd = wgid % NXCD, off = wgid / NXCD; wgid = (xcd < r ? xcd * (q + 1) : r * (q + 1) + (xcd - r) * q) + off; }
        const int nig = WGM * nN, gid = wgid / nig, fm = gid * WGM, gsz = (nM - fm) < WGM ? (nM - fm) : WGM;
        u.pm = fm + ((wgid % nig) % gsz); u.pn = (wgid % nig) / gsz; return true;
    }
    __device__ __forceinline__ void a_ready(const Unit&) const {}
    __device__ __forceinline__ void done(const Unit&) const {}
};

__device__ __forceinline__ int lane_now() { int l; asm volatile("v_mbcnt_lo_u32_b32 %0, -1, 0\n\tv_mbcnt_hi_u32_b32 %0, -1, %0" : "=v"(l)); return l; }
__device__ __forceinline__ float shfl_idx_(float v, int src) { return __builtin_bit_cast(float, __builtin_amdgcn_ds_bpermute(src << 2, __builtin_bit_cast(int, v))); }
__device__ __forceinline__ int shfl_idx_(int v, int src) { return __builtin_amdgcn_ds_bpermute(src << 2, v); }
__device__ __forceinline__ unsigned shfl_idx_(unsigned v, int src) { return (unsigned)__builtin_amdgcn_ds_bpermute(src << 2, (int)v); }
#define __shfl_xor(v, o) pg8::shfl_idx_((v), pg8::lane_now() ^ (o))
#define __shfl(v, src) pg8::shfl_idx_((v), (src))
#define __shfl_down(v, o) pg8::shfl_idx_((v), pg8::lane_now() + (o))
#define __shfl_up(v, o) pg8::shfl_idx_((v), pg8::lane_now() - (o))
typedef float f32x2_cv __attribute__((ext_vector_type(2))); typedef __bf16 bf16x2_cv __attribute__((ext_vector_type(2)));
__device__ __forceinline__ unsigned cvt_pk_bf16(float lo, float hi) { f32x2_cv v = {lo, hi}; bf16x2_cv b = __builtin_convertvector(v, bf16x2_cv); return __builtin_bit_cast(unsigned, b); }
constexpr float RMS_EPS = 1e-6f;
__device__ __forceinline__ void rows_rs(const float* part, int row0, int fq, float (&rs)[2][4]) {
    f32x4 pr[2][4];
#pragma unroll
    for (int ai = 0; ai < 2; ++ai)
#pragma unroll
        for (int m = 0; m < 4; ++m) pr[ai][m] = *(const f32x4*)(part + (size_t)(row0 + ai * HALF + m * 16) * 16 + 4 * fq);
#pragma unroll
    for (int ai = 0; ai < 2; ++ai)
#pragma unroll
        for (int m = 0; m < 4; ++m) { float s = (pr[ai][m][0] + pr[ai][m][1]) + (pr[ai][m][2] + pr[ai][m][3]); s += __shfl_xor(s, 16); s += __shfl_xor(s, 32);
            rs[ai][m] = __builtin_amdgcn_rsqf(s * (1.0f / 1024.0f) + RMS_EPS); }
}
__device__ __forceinline__ float silu_mul(float g, float u) { return g * u * __builtin_amdgcn_rcpf(1.0f + __builtin_amdgcn_exp2f(-1.4426950408889634f * g)); }
struct EpiSwiglu {
    static constexpr bool PERM = true, AFTER_DRAIN = false;
    bf16_t* H; int ldh; const float* part; int dmode;
    __device__ __forceinline__ void operator()(const f32x4 (&acc)[2][2][4][2], const Unit& u, int wr, int wc, int fr_, int fq_) const {
        int le_; asm volatile("v_mbcnt_lo_u32_b32 %0, -1, 0\n\tv_mbcnt_hi_u32_b32 %0, -1, %0" : "=v"(le_)); const int fr = le_ & 15, fq = le_ >> 4;
        const int row0 = u.pm * BM + wr * 64 + fr, col0 = u.pn * HALF + wc * 32 + 8 * fq;
        if (dmode == 2) return;
        float rsv[2][4]; rows_rs(part, row0, fq, rsv);
#pragma unroll
        for (int ai = 0; ai < 2; ++ai)
#pragma unroll
            for (int m = 0; m < 4; ++m) { const int row = row0 + ai * HALF + m * 16; const float rs = rsv[ai][m];
                const f32x4 g0 = acc[ai][0][m][0] * rs, g1 = acc[ai][0][m][1] * rs, u0 = acc[ai][1][m][0] * rs, u1 = acc[ai][1][m][1] * rs;
                u32x4 w; w.x = cvt_pk_bf16(silu_mul(g0[0], u0[0]), silu_mul(g0[1], u0[1])); w.y = cvt_pk_bf16(silu_mul(g0[2], u0[2]), silu_mul(g0[3], u0[3]));
                w.z = cvt_pk_bf16(silu_mul(g1[0], u1[0]), silu_mul(g1[1], u1[1])); w.w = cvt_pk_bf16(silu_mul(g1[2], u1[2]), silu_mul(g1[3], u1[3]));
                if (dmode == 0 || w.x == 0x12345678u) *(u32x4*)(H + (size_t)row * ldh + col0) = w; }
    }
};
struct EpiScale {
    static constexpr bool PERM = true, AFTER_DRAIN = false;
    bf16_t* O; int ldc; const float* part;
    __device__ __forceinline__ void operator()(const f32x4 (&acc)[2][2][4][2], const Unit& u, int wr, int wc, int fr_, int fq_) const {
        int le_; asm volatile("v_mbcnt_lo_u32_b32 %0, -1, 0\n\tv_mbcnt_hi_u32_b32 %0, -1, %0" : "=v"(le_)); const int fr = le_ & 15, fq = le_ >> 4;
        const int row0 = u.pm * BM + wr * 64 + fr, col0 = u.pn * BM + wc * 32 + 8 * fq;
        float rsv[2][4]; rows_rs(part, row0, fq, rsv);
#pragma unroll
        for (int ai = 0; ai < 2; ++ai)
#pragma unroll
            for (int m = 0; m < 4; ++m) { const int row = row0 + ai * HALF + m * 16; const float rs = rsv[ai][m]; bf16_t* rowp = O + (size_t)row * ldc + col0;
#pragma unroll
                for (int bj = 0; bj < 2; ++bj) { const f32x4 v0 = acc[ai][bj][m][0] * rs, v1 = acc[ai][bj][m][1] * rs;
                    u32x4 w; w.x = cvt_pk_bf16(v0[0], v0[1]); w.y = cvt_pk_bf16(v0[2], v0[3]); w.z = cvt_pk_bf16(v1[0], v1[1]); w.w = cvt_pk_bf16(v1[2], v1[3]);
                    *(u32x4*)(rowp + bj * HALF) = w; } }
    }
};
struct EpiResid {
    static constexpr bool PERM = true, AFTER_DRAIN = false;
    const bf16_t* base; bf16_t* xb; float* out; float* part_out; float coef;
    __device__ __forceinline__ void operator()(const f32x4 (&acc)[2][2][4][2], const Unit& u, int wr, int wc, int fr_, int fq_) const {
        int le_; asm volatile("v_mbcnt_lo_u32_b32 %0, -1, 0\n\tv_mbcnt_hi_u32_b32 %0, -1, %0" : "=v"(le_)); const int fr = le_ & 15, fq = le_ >> 4;
        const int row0 = u.pm * BM + wr * 64 + fr, col0 = u.pn * BM + wc * 32 + 8 * fq;
        u32x4 bs[2][4][2];
#pragma unroll
        for (int ai = 0; ai < 2; ++ai)
#pragma unroll
            for (int m = 0; m < 4; ++m)
#pragma unroll
                for (int bj = 0; bj < 2; ++bj) bs[ai][m][bj] = *(const u32x4*)(base + (size_t)(row0 + ai * HALF + m * 16) * 1024 + col0 + bj * HALF);
#pragma unroll
        for (int ai = 0; ai < 2; ++ai)
#pragma unroll
            for (int m = 0; m < 4; ++m) { const int row = row0 + ai * HALF + m * 16; const size_t off = (size_t)row * 1024 + col0; float ss = 0.f;
#pragma unroll
                for (int bj = 0; bj < 2; ++bj) { const u32x4 b = bs[ai][m][bj];
                    const f32x4 b0 = {__builtin_bit_cast(float, b.x << 16), __builtin_bit_cast(float, b.x & 0xffff0000u), __builtin_bit_cast(float, b.y << 16), __builtin_bit_cast(float, b.y & 0xffff0000u)};
                    const f32x4 b1 = {__builtin_bit_cast(float, b.z << 16), __builtin_bit_cast(float, b.z & 0xffff0000u), __builtin_bit_cast(float, b.w << 16), __builtin_bit_cast(float, b.w & 0xffff0000u)};
                    const f32x4 v0 = b0 + acc[ai][bj][m][0] * coef, v1 = b1 + acc[ai][bj][m][1] * coef;
                    if (out) { *(f32x4*)(out + off + bj * HALF) = v0; *(f32x4*)(out + off + bj * HALF + 4) = v1; }
                    u32x4 w; w.x = cvt_pk_bf16(v0[0], v0[1]); w.y = cvt_pk_bf16(v0[2], v0[3]); w.z = cvt_pk_bf16(v1[0], v1[1]); w.w = cvt_pk_bf16(v1[2], v1[3]);
                    *(u32x4*)(xb + off + bj * HALF) = w;
                    ss += (v0[0] * v0[0] + v0[1] * v0[1]) + (v0[2] * v0[2] + v0[3] * v0[3]) + (v1[0] * v1[0] + v1[1] * v1[1]) + (v1[2] * v1[2] + v1[3] * v1[3]); }
                ss += __shfl_xor(ss, 16); ss += __shfl_xor(ss, 32);
                if (fq == 0) part_out[(size_t)row * 16 + u.pn * 4 + wc] = ss; }
    }
};
template <class Epi, class Sched, bool ALIGN_EPI = false, bool SP2 = false>
__device__ __forceinline__ void gemm_phase(PG8_LAS unsigned char* lds, const Gemm g, const Sched& S, const Epi& E, int wave_id) {
    int lane_; asm volatile("v_mbcnt_lo_u32_b32 %0, -1, 0\n\tv_mbcnt_hi_u32_b32 %0, -1, %0" : "=v"(lane_));
    const int wid = wave_id, lane = lane_, tid = wid * 64 + lane, wr = wid >> 2, wc = wid & 3, fr = lane & 15, fq = lane >> 4;
    const int K = g.K, nt = K / BK;
    unsigned voffA[2], voffB[2];
#pragma unroll
    for (int i = 0; i < 2; ++i) { int R, C; stage_rc(tid * 16 + i * 8192, R, C); const int Rb = Epi::PERM ? ((R & ~31) + perm32(R & 31)) : R;
        voffA[i] = (unsigned)(R * K + C) * 2u; voffB[i] = (unsigned)(Rb * K + C) * 2u; }
    const size_t kstep = (size_t)(BK * 2);
    const size_t hstep = (size_t)HALF * K * 2;
    const size_t tstep = 2 * hstep;
    const unsigned ldsw = (unsigned)wid * 1024u;
    const int aoff = lds_byte(wr * 64 + fr, fq * 8), boff = lds_byte(wc * 32 + fr, fq * 8);
#define PG8_SA(b, h) (((b) * 2 + (h)) * HTB)
#define PG8_SB(b, h) ((4 + (b) * 2 + (h)) * HTB)
#define PG8_STAGE(bufoff, gbase, voff) do { _Pragma("unroll") for (int _i = 0; _i < 2; ++_i) \
        __builtin_amdgcn_global_load_lds((const unsigned*)((const char*)(gbase) + (voff)[_i]), (PG8_LAS unsigned*)(lds + (bufoff) + ldsw + _i * 8192), 16, 0, 0); } while (0)
#define PG8_LDA(dst, b, h) do { _Pragma("unroll") for (int m = 0; m < 4; ++m) _Pragma("unroll") for (int k = 0; k < 2; ++k) dst[m][k] = *(const PG8_LAS bf16x8*)(lds + PG8_SA(b, h) + aoff + m * 2048 + k * 1024); } while (0)
#define PG8_LDB(dst, b, h) do { _Pragma("unroll") for (int n = 0; n < 2; ++n) _Pragma("unroll") for (int k = 0; k < 2; ++k) dst[n][k] = *(const PG8_LAS bf16x8*)(lds + PG8_SB(b, h) + boff + n * 2048 + k * 1024); } while (0)
#define PG8_MMA(ai, bj, At, Bt) do { __builtin_amdgcn_s_setprio(1); _Pragma("unroll") for (int m = 0; m < 4; ++m) _Pragma("unroll") for (int n = 0; n < 2; ++n) _Pragma("unroll") for (int k = 0; k < 2; ++k) \
        acc[ai][bj][m][n] = __builtin_amdgcn_mfma_f32_16x16x32_bf16(Bt[n][k], At[m][k], acc[ai][bj][m][n], 0, 0, 0); __builtin_amdgcn_s_setprio(0); } while (0)
#define PG8_WAIT_V(n) asm volatile("s_waitcnt vmcnt(" #n ")" ::: "memory")
#define PG8_WAIT_L(n) asm volatile("s_waitcnt lgkmcnt(" #n ")" ::: "memory")
#define PG8_BAR __builtin_amdgcn_s_barrier()
#define PG8_SCHED __builtin_amdgcn_sched_barrier(0)
    Unit cur, nxt; int ui = 0;
    if (!S.next(0, cur)) return;
    f32x4 acc[2][2][4][2];
#pragma unroll
    for (int a = 0; a < 2; ++a)
#pragma unroll
        for (int b = 0; b < 2; ++b)
#pragma unroll
            for (int m = 0; m < 4; ++m)
#pragma unroll
                for (int n = 0; n < 2; ++n) acc[a][b][m][n] = (f32x4){0.f, 0.f, 0.f, 0.f};
    bf16x8 At[4][2], B0[2][2], B1[2][2];
    const char* cA = (const char*)g.A + (size_t)cur.pm * tstep; const char* cB = (const char*)g.Bt + (size_t)cur.pn * tstep;
    S.a_ready(cur);
    if constexpr (SP2) {
        PG8_STAGE(PG8_SB(0, 0), cB, voffB); PG8_STAGE(PG8_SB(0, 1), cB + hstep, voffB); PG8_STAGE(PG8_SA(0, 0), cA, voffA); PG8_STAGE(PG8_SA(0, 1), cA + hstep, voffA);
        if (wr == 1) PG8_BAR;
        PG8_WAIT_V(2); PG8_BAR;
        PG8_STAGE(PG8_SB(1, 0), cB + kstep, voffB); PG8_STAGE(PG8_SA(1, 0), cA + kstep, voffA); PG8_STAGE(PG8_SB(1, 1), cB + hstep + kstep, voffB);
        PG8_WAIT_V(6); PG8_BAR;
    } else {
        PG8_STAGE(PG8_SB(0, 0), cB, voffB); PG8_STAGE(PG8_SA(0, 0), cA, voffA); PG8_STAGE(PG8_SB(0, 1), cB + hstep, voffB); PG8_STAGE(PG8_SA(0, 1), cA + hstep, voffA);
        if (wr == 1) PG8_BAR;
        PG8_WAIT_V(4); PG8_BAR;
        PG8_STAGE(PG8_SB(1, 0), cB + kstep, voffB); PG8_STAGE(PG8_SA(1, 0), cA + kstep, voffA); PG8_STAGE(PG8_SB(1, 1), cB + hstep + kstep, voffB);
        PG8_WAIT_V(6); PG8_BAR;
    }
    for (;;) {
        const bool has_next = S.next(ui + 1, nxt);
        const char* nA = has_next ? (const char*)g.A + (size_t)nxt.pm * tstep : cA; const char* nB = has_next ? (const char*)g.Bt + (size_t)nxt.pn * tstep : cB;
        for (int t = 0; t < nt; t += 2) {
            const bool last = (t == nt - 2);
            const char* a1 = cA + (size_t)(t + 1) * kstep;
            const char* a2 = last ? nA : cA + (size_t)(t + 2) * kstep; const char* b2 = last ? nB : cB + (size_t)(t + 2) * kstep;
            const char* a3 = a2 + kstep; const char* b3 = b2 + kstep;
            if (last && has_next) S.a_ready(nxt);
            if constexpr (SP2) {
            PG8_LDB(B0, 0, 0); PG8_LDB(B1, 0, 1); PG8_SCHED; PG8_LDA(At, 0, 0); PG8_STAGE(PG8_SA(1, 1), a1 + hstep, voffA);
            PG8_WAIT_V(8); PG8_WAIT_L(0); PG8_BAR; PG8_MMA(0, 0, At, B0); PG8_MMA(0, 1, At, B1); PG8_BAR; PG8_SCHED;
            PG8_LDA(At, 0, 1); PG8_STAGE(PG8_SB(0, 0), b2, voffB); PG8_STAGE(PG8_SB(0, 1), b2 + hstep, voffB); PG8_STAGE(PG8_SA(0, 0), a2, voffA);
            PG8_WAIT_V(8); PG8_WAIT_L(0); PG8_BAR; PG8_MMA(1, 0, At, B0); PG8_MMA(1, 1, At, B1); PG8_BAR; PG8_SCHED;
            PG8_LDB(B0, 1, 0); PG8_LDB(B1, 1, 1); PG8_SCHED; PG8_LDA(At, 1, 0); PG8_STAGE(PG8_SA(0, 1), a2 + hstep, voffA);
            PG8_WAIT_V(8); PG8_WAIT_L(0); PG8_BAR; PG8_MMA(0, 0, At, B0); PG8_MMA(0, 1, At, B1); PG8_BAR; PG8_SCHED;
            PG8_LDA(At, 1, 1); PG8_STAGE(PG8_SB(1, 0), b3, voffB); PG8_STAGE(PG8_SB(1, 1), b3 + hstep, voffB); PG8_STAGE(PG8_SA(1, 0), a3, voffA);
            PG8_WAIT_V(8); PG8_WAIT_L(0); PG8_BAR; PG8_MMA(1, 0, At, B0); PG8_MMA(1, 1, At, B1); PG8_BAR; PG8_SCHED;
            } else {
            PG8_LDB(B0, 0, 0); PG8_SCHED; PG8_LDA(At, 0, 0); PG8_STAGE(PG8_SA(1, 1), a1 + hstep, voffA);
            PG8_WAIT_L(8); PG8_BAR; PG8_WAIT_L(0); PG8_MMA(0, 0, At, B0); PG8_BAR; PG8_SCHED;
            PG8_LDB(B1, 0, 1); PG8_STAGE(PG8_SB(0, 0), b2, voffB);
            PG8_BAR; PG8_WAIT_L(0); PG8_MMA(0, 1, At, B1); PG8_BAR;
            PG8_LDA(At, 0, 1); PG8_STAGE(PG8_SA(0, 0), a2, voffA);
            PG8_BAR; PG8_WAIT_L(0); PG8_MMA(1, 0, At, B0); PG8_BAR; PG8_SCHED;
            PG8_STAGE(PG8_SB(0, 1), b2 + hstep, voffB);
            PG8_WAIT_V(6); PG8_BAR; PG8_MMA(1, 1, At, B1); PG8_BAR;
            PG8_LDB(B0, 1, 0); PG8_SCHED; PG8_LDA(At, 1, 0); PG8_STAGE(PG8_SA(0, 1), a2 + hstep, voffA);
            PG8_WAIT_L(8); PG8_BAR; PG8_WAIT_L(0); PG8_MMA(0, 0, At, B0); PG8_BAR; PG8_SCHED;
            PG8_LDB(B1, 1, 1); PG8_STAGE(PG8_SB(1, 0), b3, voffB);
            PG8_BAR; PG8_WAIT_L(0); PG8_MMA(0, 1, At, B1); PG8_BAR;
            PG8_LDA(At, 1, 1); PG8_STAGE(PG8_SA(1, 0), a3, voffA);
            PG8_BAR; PG8_WAIT_L(0); PG8_MMA(1, 0, At, B0); PG8_BAR; PG8_SCHED;
            PG8_STAGE(PG8_SB(1, 1), b3 + hstep, voffB);
            PG8_WAIT_V(6); PG8_BAR; PG8_MMA(1, 1, At, B1); PG8_BAR;
            }
        }
        if constexpr (ALIGN_EPI) { if (wr == 0) PG8_BAR; }
        if constexpr (!Epi::AFTER_DRAIN) { E(acc, cur, wr, wc, fr, fq); S.done(cur); }
        if (!has_next) break;
#pragma unroll
        for (int a = 0; a < 2; ++a)
#pragma unroll
            for (int b = 0; b < 2; ++b)
#pragma unroll
                for (int m = 0; m < 4; ++m)
#pragma unroll
                    for (int n = 0; n < 2; ++n) acc[a][b][m][n] = (f32x4){0.f, 0.f, 0.f, 0.f};
        cur = nxt; cA = nA; cB = nB; ++ui;
        if constexpr (ALIGN_EPI) { if (wr == 1) PG8_BAR; }
    }
    PG8_WAIT_V(0);
    if constexpr (!ALIGN_EPI) { if (wr == 0) PG8_BAR; }
    PG8_BAR;
    if constexpr (Epi::AFTER_DRAIN) { E.fused(acc, cur, wr, wc, fr, fq, lds, wid, lane); S.done(cur); }
#undef PG8_SA
#undef PG8_SB
#undef PG8_STAGE
#undef PG8_LDA
#undef PG8_LDB
#undef PG8_MMA
#undef PG8_WAIT_V
#undef PG8_WAIT_L
#undef PG8_BAR
#undef PG8_SCHED
}
}
#define LAS __attribute__((address_space(3)))
#define XB_TMO      128
#define XB_XCNT(j)  (256  + 64 * (j))
#define XB_XSUB(j)  (1280 + 64 * (j))
#define XB_XGEN(j)  (2304 + 64 * (j))
#define XB_TOP      3328
#define XB_TOPGEN   3392
#define XCD_BAR_WORDS 3456
#define XB_SPIN_CAP (1u << 18)

__device__ __forceinline__ unsigned xb_ld(unsigned* p)              { return __hip_atomic_load(p, __ATOMIC_RELAXED, __HIP_MEMORY_SCOPE_AGENT); }
__device__ __forceinline__ unsigned xb_add(unsigned* p, unsigned v) { return __hip_atomic_fetch_add(p, v, __ATOMIC_RELAXED, __HIP_MEMORY_SCOPE_AGENT); }
__device__ __forceinline__ unsigned xb_xcc_id() { return (unsigned)__builtin_amdgcn_s_getreg((3 << 11) | 20) & 0xFu; }
#define XB_SPIN(cond, bar) do { unsigned _sp = 0; while (cond) { __builtin_amdgcn_s_sleep(1); \
    if ((++_sp & 255u) == 0u) { if (xb_ld(&(bar)[XB_TMO])) break; if (_sp > XB_SPIN_CAP) { atomicAdd(&(bar)[XB_TMO], 1u); break; } } } } while (0)

struct XcdBarrier {
    unsigned* bar; unsigned x;
    volatile LAS unsigned* st;
};

__device__ __forceinline__ XcdBarrier xcd_barrier_post(unsigned* bar, volatile LAS unsigned* st) {
    XcdBarrier b; b.bar = bar; b.x = xb_xcc_id(); b.st = st;
    if (threadIdx.x == 0) (void)xb_add(&bar[XB_XCNT(b.x)], 1u);
    return b;
}
__device__ __forceinline__ void xcd_barrier_complete(unsigned* bar, unsigned x, unsigned& nloc, unsigned& nx) {
    const unsigned G = gridDim.x * gridDim.y * gridDim.z;
    unsigned sum, cnt, mine, sp = 0u;
    for (;;) {
        sum = 0u; cnt = 0u; mine = 0u;
#pragma unroll
        for (unsigned j = 0; j < 16; ++j) { const unsigned c = xb_ld(&bar[XB_XCNT(j)]); sum += c; cnt += (c > 0u) ? 1u : 0u; mine = (j == x) ? c : mine; }
        if (sum == G) break;
        __builtin_amdgcn_s_sleep(1);
        if ((++sp & 255u) == 0u) { if (xb_ld(&bar[XB_TMO])) break; if (sp > XB_SPIN_CAP) { atomicAdd(&bar[XB_TMO], 1u); break; } }
    }
    nloc = mine > 0u ? mine : 1u; nx = cnt > 0u ? cnt : 1u;
}

__device__ __forceinline__ void xcd_barrier(const XcdBarrier& b) {
    asm volatile("s_waitcnt vmcnt(0)" ::: "memory");
    __syncthreads();
    if (threadIdx.x == 0) {
        unsigned* bar = b.bar;
        __builtin_amdgcn_s_waitcnt(0);
        unsigned nloc = b.st[0], nx = b.st[1];
        if (nloc == 0u) { xcd_barrier_complete(bar, b.x, nloc, nx); b.st[0] = nloc; b.st[1] = nx; }
        const unsigned old = xb_add(&bar[XB_XSUB(b.x)], 1u);
        const unsigned gen = old / nloc;
        if (old + 1u == (gen + 1u) * nloc) {
            __builtin_amdgcn_fence(__ATOMIC_RELEASE, "agent");
            asm volatile("s_waitcnt vmcnt(0)" ::: "memory");
            const unsigned og = xb_add(&bar[XB_TOP], 1u);
            const unsigned tg = og / nx;
            if (og + 1u == (tg + 1u) * nx) xb_add(&bar[XB_TOPGEN], 1u);
            else XB_SPIN(xb_ld(&bar[XB_TOPGEN]) == tg, bar);
            __builtin_amdgcn_fence(__ATOMIC_ACQUIRE, "agent");
            xb_add(&bar[XB_XGEN(b.x)], 1u);
            asm volatile("s_waitcnt vmcnt(0)" ::: "memory");
        } else {
            XB_SPIN(xb_ld(&bar[XB_XGEN(b.x)]) == gen, bar);
            __builtin_amdgcn_fence(__ATOMIC_ACQUIRE, "agent");
            asm volatile("s_waitcnt vmcnt(0)" ::: "memory");
        }
    }
    __syncthreads();
}
#undef LAS
#ifndef RET_MODE
#define RET_MODE 1
#endif
#ifndef NSA_INLINE
#define NSA_INLINE __forceinline__
#endif
#ifndef DRY_MODE
#define DRY_MODE 0
#endif
#ifndef QF_MEM
#define QF_MEM 0
#endif
#ifndef TM_FENCE
#define TM_FENCE 0
#endif
#ifndef NSA_WG
#define NSA_WG 1
#endif
#ifndef D3_WG
#define D3_WG 1
#endif
#ifndef RET_WG
#define RET_WG 1
#endif
#ifndef PROBE_EMPTY
#define PROBE_EMPTY 0
#endif
#ifndef PROBE_DUP
#define PROBE_DUP 0
#endif
#ifndef DBG_BRUTE
#define DBG_BRUTE 0
#endif
#ifndef DBG_ZERO
#define DBG_ZERO 0
#endif
constexpr int NWAVES = 8;
constexpr int NB = 16, SEQ = 2048, DM = 1024, MTOK = NB * SEQ, FF = 2816, NMEMT = 256, MMEM = NB * NMEMT, DEPTH = 4;
constexpr float EPS = 1e-6f;
constexpr float QSCALE = 0.125f * 1.4426950408889634f;
constexpr int RET_LD = 2560, RET_Q = 0, RET_K = 384, RET_V = 768, RET_G = 1536, RET_QM = 2304;
constexpr int DSA_LD = 1792, DSA_Q = 0, DSA_K = 768, DSA_V = 832, DSA_IQ = 896, DSA_IK = 1408, DSA_IW = 1472, DSA_QM = 1480, DSA_COLS = 1736;
constexpr int NSA_LD = 2816, NSA_Q = 0, NSA_KC = 768, NSA_VC = 1024, NSA_KS = 1280, NSA_VS = 1536, NSA_KW = 1792, NSA_VW = 2048, NSA_QM = 2304, NSA_GT = 2560;
constexpr int NSA_SRC_GT = 2304, NSA_SRC_QM = 2340, NSA_COLS = 2596;

constexpr size_t MiB = 1u << 20;
constexpr size_t WS_CTL = 0, CTL_ZERO_BYTES = 1 * MiB;
constexpr size_t WS_PART = 1 * MiB;
constexpr size_t WS_PARTM = 3 * MiB;
constexpr size_t WS_ROPE = 3 * MiB + 512 * 1024;
constexpr size_t WS_MISC = 4 * MiB;
constexpr size_t WS_CMPW = 4 * MiB + 64 * 1024;
constexpr size_t WS_KCMP = 5 * MiB;
constexpr size_t WS_VCMPT = 6 * MiB;
constexpr size_t WS_MK = 7 * MiB;
constexpr size_t WS_MVT = 15 * MiB;
constexpr size_t WS_MEMB = 23 * MiB;
constexpr size_t WS_MKV = 31 * MiB;
constexpr size_t WS_WKV = 47 * MiB;
constexpr size_t WS_WBUF0 = 51 * MiB, WBUF_BYTES = 41 * MiB;
constexpr size_t WS_XB = 133 * MiB;
constexpr size_t WS_Y = 197 * MiB;
constexpr size_t WS_HID = 261 * MiB;
constexpr size_t WS_SC = 373 * MiB;
constexpr size_t WS_MB = 501 * MiB;
constexpr size_t WS_END = 509 * MiB;
static_assert(WS_HID + (size_t)MTOK * FF * 2 <= WS_MB && WS_SC + (size_t)MTOK * SEQ * 2 <= WS_MB && WS_WBUF0 + 2 * WBUF_BYTES <= WS_XB, "d_ws map");
constexpr size_t WB_W1A = 0, WB_W2A = WB_W1A + (size_t)2 * FF * DM, WB_W1B = WB_W2A + (size_t)DM * FF, WB_W2B = WB_W1B + (size_t)2 * FF * DM,
                 WB_WIN = WB_W2B + (size_t)DM * FF, WB_WO = WB_WIN + (size_t)NSA_LD * DM, WB_END = WB_WO + (size_t)DM * DM;
static_assert(WB_END * 2 <= WBUF_BYTES, "weight buffer");
constexpr int LDS_CTRL = 147456 - 1024;
constexpr int CW_BAR = 4096;
constexpr int CW_CK = 32768;
constexpr int CW_Q = 16384;

#define GAS __attribute__((address_space(1)))
#define LAS __attribute__((address_space(3)))
typedef unsigned short bf16;
typedef unsigned v4u __attribute__((ext_vector_type(4)));
typedef unsigned v2u __attribute__((ext_vector_type(2)));
typedef float f32x4 __attribute__((ext_vector_type(4)));
typedef float f32x16 __attribute__((ext_vector_type(16)));
typedef short bf16x8 __attribute__((ext_vector_type(8)));
typedef GAS unsigned gu32;
#define RLX_AGENT __ATOMIC_RELAXED, __HIP_MEMORY_SCOPE_AGENT
#define LDS_WAIT() asm volatile("s_waitcnt lgkmcnt(0)" ::: "memory")
#define VM_WAIT() asm volatile("s_waitcnt vmcnt(0)" ::: "memory")
__device__ __forceinline__ unsigned f2bf(float f) { unsigned u = __builtin_bit_cast(unsigned, f); return (u + 0x7fffu + ((u >> 16) & 1u)) >> 16; }
__device__ __forceinline__ unsigned pk2(float lo, float hi) { return pg8::cvt_pk_bf16(lo, hi); }
__device__ __forceinline__ float bf2f(unsigned h) { return __builtin_bit_cast(float, h << 16); }
__device__ __forceinline__ float bflo(unsigned w) { return __builtin_bit_cast(float, w << 16); }
__device__ __forceinline__ float bfhi(unsigned w) { return __builtin_bit_cast(float, w & 0xffff0000u); }
struct Args { const float* in[23]; float* out; unsigned char* ws; int ph_lo, ph_hi, dry, pad; };
typedef const __attribute__((address_space(4))) Args* KArgs;
struct Frame {
    LAS unsigned char* lds;
    volatile LAS unsigned* MISC;
    gu32* ctl;
    int tid, lane, wave, G, gw, NGW;
    unsigned char* ws;
    KArgs ka;
    float* out;
};
__device__ __forceinline__ float wave_sum(float v) {
#pragma unroll
    for (int o = 1; o < 64; o <<= 1) v += __shfl_xor(v, o);
    return v;
}
__device__ __forceinline__ float wave_max(float v) {
#pragma unroll
    for (int o = 1; o < 64; o <<= 1) v = fmaxf(v, __shfl_xor(v, o));
    return v;
}
__device__ __forceinline__ int grab(gu32* ctr, int lane) { unsigned v = 0; if (lane == 0) v = __hip_atomic_fetch_add(ctr, 1u, RLX_AGENT); return __builtin_amdgcn_readfirstlane((int)v); }

__device__ __forceinline__ void cvt_item(const float* W, int ldw, const float* gain, bf16* WT, int K, LAS float* scr, int k0, int src_col0, int nvalid, int dst_row0, int lane) {
    const int c = lane & 31;
    float wv[32], gv2[32];
#pragma unroll
    for (int i = 0; i < 32; ++i) { const int kk = 2 * i + (lane >> 5); wv[i] = (c < nvalid) ? W[(size_t)(k0 + kk) * ldw + src_col0 + c] : 0.f; gv2[i] = gain ? gain[k0 + kk] : 1.f; }
#pragma unroll
    for (int i = 0; i < 32; ++i) { const int kk = 2 * i + (lane >> 5); scr[kk * 33 + c] = wv[i] * gv2[i]; }
    LDS_WAIT(); asm volatile("" ::: "memory");
    const int c8 = lane & 7;
#pragma unroll
    for (int j = 0; j < 4; ++j) { const int n = (lane >> 3) + 8 * j; const LAS float* s = scr + (8 * c8) * 33 + n;
        v4u o; o.x = pk2(s[0 * 33], s[1 * 33]); o.y = pk2(s[2 * 33], s[3 * 33]); o.z = pk2(s[4 * 33], s[5 * 33]); o.w = pk2(s[6 * 33], s[7 * 33]);
        *(GAS v4u*)(WT + (size_t)(dst_row0 + n) * K + k0 + 8 * c8) = o; }
    LDS_WAIT(); asm volatile("" ::: "memory");
}
__device__ __forceinline__ void cvt_matrix(Frame& F, int& it_base, const float* W, const float* W2, int ldw, int ncols, const float* gain, bf16* WT, int K, int nrows_dst, int kind) {
    LAS float* scr = (LAS float*)(F.lds + F.wave * 16384);
    const int nkb = K / 64, njb = nrows_dst / 32, nitems = nkb * njb;
    int first = (F.gw - it_base % F.NGW + F.NGW) % F.NGW;
    for (int i = first; i < nitems; i += F.NGW) {
        const int kb = i / njb, jb = i % njb; const float* src = W; int sc0 = jb * 32, nv = 32;
        if (kind == 0) { nv = ncols - sc0; nv = nv < 0 ? 0 : (nv > 32 ? 32 : nv); }
        else if (kind == 1) { const int c = jb * 32, pn = c >> 8, bj = (c >> 7) & 1, j = c & 127; src = bj ? W2 : W; sc0 = pn * 128 + j; }
        else { const int c = jb * 32;
            if (c < NSA_QM) { sc0 = c; }
            else if (c < NSA_GT) { sc0 = NSA_SRC_QM + (c - NSA_QM); }
            else { sc0 = NSA_SRC_GT + (c - NSA_GT); nv = NSA_SRC_QM - sc0; nv = nv < 0 ? 0 : (nv > 32 ? 32 : nv); } }
        cvt_item(src, ldw, gain, WT, K, scr, kb * 64, sc0, nv, jb * 32, F.lane);
    }
    it_base += nitems;
}
__device__ __forceinline__ void convert_layer(Frame& F, int Ly) {
    bf16* WB = (bf16*)(F.ws + WS_WBUF0 + (size_t)(Ly & 1) * WBUF_BYTES);
    const float* fnorm = F.ka->in[2]; const float* wg = F.ka->in[3]; const float* wu = F.ka->in[4]; const float* wd = F.ka->in[5];
    int itb = 0;
#pragma unroll 1
    for (int hf = 0; hf < 2; ++hf) {
        const size_t o1 = (size_t)(Ly * 2 + hf) * DM * FF;
        cvt_matrix(F, itb, wg + o1, wu + o1, FF, FF, fnorm + (size_t)(Ly * 2 + hf) * DM, WB + (hf ? WB_W1B : WB_W1A), DM, 2 * FF, 1);
        cvt_matrix(F, itb, wd + o1, nullptr, DM, DM, nullptr, WB + (hf ? WB_W2B : WB_W2A), FF, DM, 0);
    }
    const float* mnorm = F.ka->in[6] + (size_t)Ly * DM;
    const int kind = Ly % 3, j = Ly / 3;
    if (kind == 0) cvt_matrix(F, itb, F.ka->in[12] + (size_t)j * DM * RET_LD, nullptr, RET_LD, RET_LD, mnorm, WB + WB_WIN, DM, RET_LD, 0);
    else if (kind == 1) cvt_matrix(F, itb, F.ka->in[13] + (size_t)j * DM * DSA_COLS, nullptr, DSA_COLS, DSA_COLS, mnorm, WB + WB_WIN, DM, DSA_LD, 0);
    else cvt_matrix(F, itb, F.ka->in[16] + (size_t)j * DM * NSA_COLS, nullptr, NSA_COLS, NSA_COLS, mnorm, WB + WB_WIN, DM, NSA_LD, 2);
    cvt_matrix(F, itb, F.ka->in[7] + (size_t)Ly * DM * DM, nullptr, DM, DM, nullptr, WB + WB_WO, DM, DM, 0);
}

__device__ __forceinline__ void xform(Frame& F, const bf16* src, int spitch, int scol0, int nheads, int rows, int Lr, bf16* dst, int dmode, int dpitch, int dcol0,
                                      const float* gain, bool rope, float cscale, int decay  ) {
    const float* tab = (const float*)(F.ws + WS_ROPE);
    const int i8 = F.lane & 7, sub = F.lane >> 3; const int items = rows * nheads;
    float gn[8];
#pragma unroll
    for (int j = 0; j < 8; ++j) gn[j] = gain ? gain[8 * i8 + j] : 1.f;
    constexpr int U = 4;
    for (int it0 = F.gw * (8 * U); it0 < items; it0 += F.NGW * (8 * U)) {
        v4u raw[U]; f32x4 c0[U], c1[U], s0[U], s1[U];
#pragma unroll
        for (int u = 0; u < U; ++u) { const int it = it0 + 8 * u + sub; const int row = it / nheads, h = it % nheads, t = row % Lr;
            raw[u] = *(const GAS v4u*)(src + (size_t)row * spitch + scol0 + h * 64 + 8 * i8);
            if (rope) { const float* tr = tab + (size_t)t * 64 + 8 * (i8 & 3);
                c0[u] = *(const GAS f32x4*)(tr); c1[u] = *(const GAS f32x4*)(tr + 4); s0[u] = *(const GAS f32x4*)(tr + 32); s1[u] = *(const GAS f32x4*)(tr + 36); } }
#pragma unroll
        for (int u = 0; u < U; ++u) { const int it = it0 + 8 * u + sub; const int row = it / nheads, h = it % nheads, t = row % Lr;
            float v[8] = {bflo(raw[u].x), bfhi(raw[u].x), bflo(raw[u].y), bfhi(raw[u].y), bflo(raw[u].z), bfhi(raw[u].z), bflo(raw[u].w), bfhi(raw[u].w)};
            if (gain) { float ss = 0.f;
#pragma unroll
                for (int j = 0; j < 8; ++j) ss += v[j] * v[j];
                ss += __shfl_xor(ss, 1); ss += __shfl_xor(ss, 2); ss += __shfl_xor(ss, 4);
                const float r = __builtin_amdgcn_rsqf(ss * (1.f / 64.f) + EPS);
#pragma unroll
                for (int j = 0; j < 8; ++j) v[j] = v[j] * r * gn[j]; }
            if (rope) {
                const float cs[8] = {c0[u][0], c0[u][1], c0[u][2], c0[u][3], c1[u][0], c1[u][1], c1[u][2], c1[u][3]}, sn[8] = {s0[u][0], s0[u][1], s0[u][2], s0[u][3], s1[u][0], s1[u][1], s1[u][2], s1[u][3]};
#pragma unroll
                for (int j = 0; j < 8; ++j) { const float p = __shfl_xor(v[j], 4); v[j] = (i8 < 4) ? (v[j] * cs[j] - p * sn[j]) : (v[j] * cs[j] + p * sn[j]); } }
            float f = cscale;
            if (decay) { const float lg = __builtin_amdgcn_logf(1.0f - __builtin_amdgcn_exp2f(-5.0f - (float)h)); f *= __builtin_amdgcn_exp2f((float)(decay * t) * lg); }
            v4u o; o.x = pk2(v[0] * f, v[1] * f); o.y = pk2(v[2] * f, v[3] * f); o.z = pk2(v[4] * f, v[5] * f); o.w = pk2(v[6] * f, v[7] * f);
            bf16* dp = dmode == 0 ? dst + (size_t)row * dpitch + dcol0 + h * 64 + 8 * i8 : dst + ((size_t)((row / Lr) * nheads + h) * Lr + t) * 64 + 8 * i8;
            *(GAS v4u*)dp = o; }
    }
}
__device__ __forceinline__ void transpose_cols(Frame& F, const bf16* src, int spitch, int scol0, int ncols, int nb, int Lr, bf16* dst) {
    LAS bf16* scr = (LAS bf16*)(F.lds + F.wave * 16384);
    const int ntt = Lr / 64, nct = ncols / 64, ntiles = nb * ntt * nct; const int i8 = F.lane & 7, sub = F.lane >> 3;
    for (int tl = F.gw; tl < ntiles; tl += F.NGW) {
        const int ct = tl % nct, tt = (tl / nct) % ntt, b = tl / (nct * ntt); const int t0 = tt * 64, c0 = ct * 64;
#pragma unroll
        for (int k = 0; k < 8; ++k) { const int r = sub + 8 * k;
            const v4u raw = *(const GAS v4u*)(src + (size_t)(b * Lr + t0 + r) * spitch + scol0 + c0 + 8 * i8);
            *(LAS v4u*)(scr + r * 72 + 8 * i8) = raw; }
        LDS_WAIT(); asm volatile("" ::: "memory");
        bf16* drow = dst + ((size_t)b * ncols + c0 + F.lane) * Lr + t0;
#pragma unroll
        for (int k = 0; k < 8; ++k) { unsigned w[4];
#pragma unroll
            for (int q = 0; q < 4; ++q) { const unsigned lo = scr[(8 * k + 2 * q) * 72 + F.lane], hi = scr[(8 * k + 2 * q + 1) * 72 + F.lane]; w[q] = lo | (hi << 16); }
            v4u o; o.x = w[0]; o.y = w[1]; o.z = w[2]; o.w = w[3]; *(GAS v4u*)(drow + 8 * k) = o; }
        LDS_WAIT(); asm volatile("" ::: "memory");
    }
}
__device__ __forceinline__ void row_to_bf16(Frame& F, const float* xrow, bf16* orow, float* part) {
    const GAS f32x4* xr = (const GAS f32x4*)xrow + F.lane;
    f32x4 v[4]; float s = 0.f;
#pragma unroll
    for (int j = 0; j < 4; ++j) { v[j] = xr[64 * j]; s += (v[j].x * v[j].x + v[j].y * v[j].y) + (v[j].z * v[j].z + v[j].w * v[j].w); }
    s = wave_sum(s);
    GAS v2u* o8 = (GAS v2u*)orow + F.lane;
#pragma unroll
    for (int j = 0; j < 4; ++j) { v2u o; o.x = pk2(v[j].x, v[j].y); o.y = pk2(v[j].z, v[j].w); o8[64 * j] = o; }
    if (F.lane < 16) part[F.lane] = F.lane == 0 ? s : 0.f;
}
enum { MK_NONE = 0, MK_CAUSAL = 1, MK_WIN = 2, MK_BITS = 3, MK_SLC = 4, MK_CMP = 5 };
struct KVp { const bf16* K; int kpitch; const bf16* VT; int vpitch; };
struct MaskArg { int q0[3]; const unsigned* mb; unsigned sel; int nmax; float lg; };
__device__ __forceinline__ bf16x8 ld8(const bf16* p) { return *(const GAS bf16x8*)p; }
__device__ __forceinline__ float fast_exp2(float x) { return __builtin_amdgcn_exp2f(x); }

template <int NS, int NT, int MODE, int MT, int PF = 2>
__device__ __forceinline__ void attn_core(const LAS bf16x8* ql, const KVp kv, int kt0, int kt1, float negb, const MaskArg& ma, const unsigned* const (&mbrow)[NS],
                                          f32x16 (&O)[NS][NT], float (&lsum)[NS], int lane) {
    const int r32 = lane & 31, hi = lane >> 5;
    const int kperm = (r32 & 0x13) | ((r32 & 4) << 1) | ((r32 & 8) >> 1);
    const bf16* kp = kv.K + (size_t)kperm * kv.kpitch + 8 * hi;
    const bf16* vp = kv.VT + (size_t)r32 * kv.vpitch + 8 * hi;
    bf16x8 kf[4], vf[2][NT], kfn[4], vfn[2][NT];
#define AC_LOADK(dst, kt_) do { const bf16* kq_ = kp + (size_t)(32 * (kt_)) * kv.kpitch; _Pragma("unroll") for (int ks = 0; ks < 4; ++ks) dst[ks] = ld8(kq_ + 16 * ks); } while (0)
#define AC_LOADV(dst, kt_) do { _Pragma("unroll") for (int nt = 0; nt < NT; ++nt) { const bf16* vq_ = vp + (size_t)(32 * nt) * kv.vpitch + 32 * (kt_); dst[0][nt] = ld8(vq_); dst[1][nt] = ld8(vq_ + 16); } } while (0)
    unsigned mw[NS], mwn[NS];
    if (kt0 < kt1) { if (PF >= 1) AC_LOADK(kf, kt0); if (PF >= 2) AC_LOADV(vf, kt0);
        if (MT == MK_BITS) { _Pragma("unroll") for (int s = 0; s < NS; ++s) mw[s] = mbrow[s][kt0]; } }
#pragma unroll 1
    for (int kt = kt0; kt < kt1; ++kt) {
        unsigned selbit = 1u; bool active = true;
        if (MT == MK_SLC) { selbit = (ma.sel >> (kt >> 1)) & 1u; active = __any(selbit != 0u); }
        const int ktn = (kt + 1 < kt1) ? kt + 1 : kt;
        if (PF == 0) { if (active) { AC_LOADK(kf, kt); AC_LOADV(vf, kt); } }
        else { AC_LOADK(kfn, ktn); if (PF >= 2) AC_LOADV(vfn, ktn); else if (active) AC_LOADV(vf, kt); }
        if (MT == MK_BITS) { _Pragma("unroll") for (int s = 0; s < NS; ++s) mwn[s] = mbrow[s][ktn]; }
        if (active) {
        const LAS bf16x8* qlp = ql; asm volatile("" : "+v"(qlp));
#pragma unroll
        for (int s = 0; s < NS; ++s) {
            f32x16 acc;
#pragma unroll
            for (int r = 0; r < 16; ++r) acc[r] = 0.f;
            bf16x8 qq[4];
#pragma unroll
            for (int ks = 0; ks < 4; ++ks) qq[ks] = qlp[(s * 4 + ks) * 64];
#pragma unroll
            for (int ks = 0; ks < 4; ++ks) acc = __builtin_amdgcn_mfma_f32_32x32x16_bf16(kf[ks], qq[ks], acc, 0, 0, 0);
            const int tq = ma.q0[s] + r32, kb = 32 * kt + 8 * hi;
            bool full = true;
            if (MT == MK_CAUSAL) full = (32 * kt + 31 <= ma.q0[s]);
            if (MT == MK_WIN) full = (32 * kt + 31 <= ma.q0[s]) && (32 * kt >= ma.q0[s] + 31 - 511);
            if (MT == MK_SLC) full = (32 * kt + 31 <= ma.q0[s]) && __all(selbit != 0u);
            if (MT == MK_BITS || MT == MK_CMP) full = false;
            float p[16];
            if (full) {
#pragma unroll
                for (int r = 0; r < 16; ++r) { const int key = kb + 16 * (r >> 3) + (r & 7); p[r] = MODE == 0 ? fast_exp2(acc[r]) : (MODE == 1 ? acc[r] : acc[r] * fast_exp2((float)(tq - key) * ma.lg)); }
            } else {
                unsigned w = 0;
                if (MT == MK_BITS) w = mw[s];
#pragma unroll
                for (int r = 0; r < 16; ++r) { const int key = kb + 16 * (r >> 3) + (r & 7); bool v = true;
                    if (MT == MK_CAUSAL) v = key <= tq;
                    if (MT == MK_WIN) v = (key <= tq) && (key >= tq - 511);
                    if (MT == MK_SLC) v = (key <= tq) && (selbit != 0u);
                    if (MT == MK_BITS) v = (w >> (8 * hi + 16 * (r >> 3) + (r & 7))) & 1u;
                    if (MT == MK_CMP) v = key <= ma.nmax;
                    const float e = MODE == 0 ? fast_exp2(acc[r]) : (MODE == 1 ? acc[r] : acc[r] * fast_exp2((float)((tq - key) < 0 ? 0 : (tq - key)) * ma.lg));
                    p[r] = v ? e : 0.f; }
            }
            if (MODE == 0) { float a = 0.f;
#pragma unroll
                for (int r = 0; r < 16; ++r) a += p[r];
                lsum[s] += a; }
            bf16x8 pk0, pk1;
            { v4u t0, t1; t0.x = pk2(p[0], p[1]); t0.y = pk2(p[2], p[3]); t0.z = pk2(p[4], p[5]); t0.w = pk2(p[6], p[7]);
              t1.x = pk2(p[8], p[9]); t1.y = pk2(p[10], p[11]); t1.z = pk2(p[12], p[13]); t1.w = pk2(p[14], p[15]);
              pk0 = __builtin_bit_cast(bf16x8, t0); pk1 = __builtin_bit_cast(bf16x8, t1); }
#pragma unroll
            for (int nt = 0; nt < NT; ++nt) { O[s][nt] = __builtin_amdgcn_mfma_f32_32x32x16_bf16(pk0, vf[0][nt], O[s][nt], 0, 0, 0);
                                              O[s][nt] = __builtin_amdgcn_mfma_f32_32x32x16_bf16(pk1, vf[1][nt], O[s][nt], 0, 0, 0); }
            if (NS >= 3) __builtin_amdgcn_sched_barrier(0);
        }
        }
        if (MT == MK_BITS) { _Pragma("unroll") for (int s = 0; s < NS; ++s) mw[s] = mwn[s]; }
        if (PF >= 1) {
#pragma unroll
            for (int ks = 0; ks < 4; ++ks) kf[ks] = kfn[ks];
            if (PF >= 2) {
#pragma unroll
                for (int nt = 0; nt < NT; ++nt) { vf[0][nt] = vfn[0][nt]; vf[1][nt] = vfn[1][nt]; } }
        }
    }
#undef AC_LOADK
#undef AC_LOADV
}
template <int NS, int NT, int MODE, int MT>
__device__ __forceinline__ void tile_math(const bf16x8 (&kf)[4], const bf16x8 (&vf)[2][NT], const LAS bf16x8* ql, int kt, const MaskArg& ma, const unsigned (&mw)[NS], unsigned selbit,
                                          f32x16 (&O)[NS][NT], float (&lsum)[NS], int lane) {
    const int r32 = lane & 31, hi = lane >> 5;
    const LAS bf16x8* qlp = ql; asm volatile("" : "+v"(qlp));
    f32x16 acc[NS];
#pragma unroll
    for (int s = 0; s < NS; ++s)
#pragma unroll
        for (int r = 0; r < 16; ++r) acc[s][r] = 0.f;
    {
        bf16x8 qa[NS][4];
#pragma unroll
        for (int s = 0; s < NS; ++s)
#pragma unroll
            for (int ks = 0; ks < 4; ++ks) qa[s][ks] = qlp[(s * 4 + ks) * 64];
        __builtin_amdgcn_sched_barrier(0);
#pragma unroll
        for (int ks = 0; ks < 4; ++ks)
#pragma unroll
            for (int s = 0; s < NS; ++s) acc[s] = __builtin_amdgcn_mfma_f32_32x32x16_bf16(kf[ks], qa[s][ks], acc[s], 0, 0, 0);
        __builtin_amdgcn_sched_barrier(0);
    }
#pragma unroll
    for (int s = 0; s < NS; ++s) {
        const int tq = ma.q0[s] + r32, kb = 32 * kt + 8 * hi;
        bool full = true;
        if (MT == MK_CAUSAL) full = (32 * kt + 31 <= ma.q0[s]);
        if (MT == MK_WIN) full = (32 * kt + 31 <= ma.q0[s]) && (32 * kt >= ma.q0[s] + 31 - 511);
        if (MT == MK_SLC) full = (32 * kt + 31 <= ma.q0[s]) && __all(selbit != 0u);
        if (MT == MK_BITS || MT == MK_CMP) full = false;
        float p[16];
        if (full) {
#pragma unroll
            for (int r = 0; r < 16; ++r) p[r] = MODE == 0 ? fast_exp2(acc[s][r]) : acc[s][r];
        } else if (MT == MK_BITS) {
            const unsigned wsh = mw[s] >> (8 * hi);
#pragma unroll
            for (int r = 0; r < 16; ++r) { const int m = ((int)(wsh << (31 - (16 * (r >> 3) + (r & 7))))) >> 31;
                p[r] = __builtin_bit_cast(float, __builtin_bit_cast(unsigned, fast_exp2(acc[s][r])) & (unsigned)m); }
        } else {
#pragma unroll
            for (int r = 0; r < 16; ++r) { const int key = kb + 16 * (r >> 3) + (r & 7); bool v = true;
                if (MT == MK_CAUSAL) v = key <= tq;
                if (MT == MK_WIN) v = (key <= tq) && (key >= tq - 511);
                if (MT == MK_SLC) v = (key <= tq) && (selbit != 0u);
                if (MT == MK_CMP) v = key <= ma.nmax;
                const float e = MODE == 0 ? fast_exp2(acc[s][r]) : acc[s][r];
                p[r] = v ? e : 0.f; }
        }
        if (MODE == 0) { float a = 0.f;
#pragma unroll
            for (int r = 0; r < 16; ++r) a += p[r];
            lsum[s] += a; }
        bf16x8 pk0, pk1;
        { v4u t0, t1; t0.x = pk2(p[0], p[1]); t0.y = pk2(p[2], p[3]); t0.z = pk2(p[4], p[5]); t0.w = pk2(p[6], p[7]);
          t1.x = pk2(p[8], p[9]); t1.y = pk2(p[10], p[11]); t1.z = pk2(p[12], p[13]); t1.w = pk2(p[14], p[15]);
          pk0 = __builtin_bit_cast(bf16x8, t0); pk1 = __builtin_bit_cast(bf16x8, t1); }
#pragma unroll
        for (int nt = 0; nt < NT; ++nt) { O[s][nt] = __builtin_amdgcn_mfma_f32_32x32x16_bf16(pk0, vf[0][nt], O[s][nt], 0, 0, 0);
                                          O[s][nt] = __builtin_amdgcn_mfma_f32_32x32x16_bf16(pk1, vf[1][nt], O[s][nt], 0, 0, 0); }
    }
}
__device__ __forceinline__ int crow(int r, int hi) { return (r & 3) + 8 * (r >> 2) + 4 * hi; }
template <int NT, bool ADD>
__device__ __forceinline__ void store_o(const f32x16 (&O)[NT], float f, bf16* Y, int row0, int col0, int lane) {
    const int r32 = lane & 31, hi = lane >> 5;
    unsigned ybase = (unsigned)((row0 + 4 * hi) * 1024 + col0 + r32); asm volatile("" : "+v"(ybase));
#pragma unroll
    for (int rh = 0; rh < 2; ++rh) {
        unsigned short old[NT][8];
        if (ADD) {
#pragma unroll
            for (int ri = 0; ri < 8; ++ri)
#pragma unroll
                for (int nt = 0; nt < NT; ++nt) { const int r = 8 * rh + ri; old[nt][ri] = Y[ybase + (unsigned)(((r & 3) + 8 * (r >> 2)) * 1024) + 32 * nt]; }
        }
#pragma unroll
        for (int ri = 0; ri < 8; ++ri) { const int r = 8 * rh + ri; const int q = crow(r, hi); const float fr = __shfl(f, q);
            const unsigned yo = ybase + (unsigned)(((r & 3) + 8 * (r >> 2)) * 1024);
#pragma unroll
            for (int nt = 0; nt < NT; ++nt) { float v = O[nt][r] * fr; if (ADD) v += bf2f(old[nt][ri]); Y[yo + 32 * nt] = (bf16)f2bf(v); } }
    }
}
template <int NS> __device__ __forceinline__ void stage_q(LAS bf16x8* ql, const bf16* const (&qrow)[NS], int lane) {
    const int hi = lane >> 5;
#pragma unroll
    for (int s = 0; s < NS; ++s)
#pragma unroll
        for (int ks = 0; ks < 4; ++ks) ql[(s * 4 + ks) * 64] = ld8(qrow[s] + 16 * ks + 8 * hi);
    LDS_WAIT(); asm volatile("" ::: "memory");
}
__device__ __forceinline__ void q32_load(const bf16* p  , float (&v)[4][8]) {
    v4u raw[4];
#pragma unroll
    for (int ks = 0; ks < 4; ++ks) raw[ks] = *(const GAS v4u*)(p + 16 * ks);
#pragma unroll
    for (int ks = 0; ks < 4; ++ks) { v[ks][0] = bflo(raw[ks].x); v[ks][1] = bfhi(raw[ks].x); v[ks][2] = bflo(raw[ks].y); v[ks][3] = bfhi(raw[ks].y);
        v[ks][4] = bflo(raw[ks].z); v[ks][5] = bfhi(raw[ks].z); v[ks][6] = bflo(raw[ks].w); v[ks][7] = bfhi(raw[ks].w); }
}
__device__ __forceinline__ void q32_xf(float (&v)[4][8], const float* gain, bool rope, int t, float scale, int hi, const float* tab) {
    if (gain) { float ss = 0.f;
#pragma unroll
        for (int ks = 0; ks < 4; ++ks)
#pragma unroll
            for (int j = 0; j < 8; ++j) ss += v[ks][j] * v[ks][j];
        ss += __shfl_xor(ss, 32);
        const float r = __builtin_amdgcn_rsqf(ss * (1.f / 64.f) + EPS);
#pragma unroll
        for (int ks = 0; ks < 4; ++ks) { const f32x4 g0 = *(const GAS f32x4*)(gain + 16 * ks + 8 * hi), g1 = *(const GAS f32x4*)(gain + 16 * ks + 8 * hi + 4);
#pragma unroll
            for (int j = 0; j < 4; ++j) { v[ks][j] *= r * g0[j]; v[ks][4 + j] *= r * g1[j]; } } }
    if (rope) { const float* tr = tab + (size_t)t * 64 + 8 * hi;
#pragma unroll
        for (int ks = 0; ks < 2; ++ks) { const f32x4 c0 = *(const GAS f32x4*)(tr + 16 * ks), c1 = *(const GAS f32x4*)(tr + 16 * ks + 4), s0 = *(const GAS f32x4*)(tr + 32 + 16 * ks), s1 = *(const GAS f32x4*)(tr + 36 + 16 * ks);
#pragma unroll
            for (int j = 0; j < 8; ++j) { const float c = j < 4 ? c0[j & 3] : c1[j & 3], sn = j < 4 ? s0[j & 3] : s1[j & 3]; const float a = v[ks][j], b = v[ks + 2][j];
                v[ks][j] = a * c - b * sn; v[ks + 2][j] = b * c + a * sn; } } }
#pragma unroll
    for (int ks = 0; ks < 4; ++ks)
#pragma unroll
        for (int j = 0; j < 8; ++j) v[ks][j] *= scale;
}
__device__ __forceinline__ bf16x8 q32_pack(const float (&v)[8]) { v4u o; o.x = pk2(v[0], v[1]); o.y = pk2(v[2], v[3]); o.z = pk2(v[4], v[5]); o.w = pk2(v[6], v[7]); return __builtin_bit_cast(bf16x8, o); }
template <int NS> __device__ __forceinline__ void stage_q_xf(Frame& F, LAS bf16x8* ql, const bf16* const (&qrow)[NS], const int (&tpos)[NS], const float* gain, bool rope, float scale) {
    const int hi = F.lane >> 5; const float* tab = (const float*)(F.ws + WS_ROPE);
#pragma unroll
    for (int s = 0; s < NS; ++s) { float v[4][8]; q32_load(qrow[s] + 8 * hi, v); q32_xf(v, gain, rope, tpos[s], scale, hi, tab);
#pragma unroll
        for (int ks = 0; ks < 4; ++ks) ql[(s * 4 + ks) * 64] = q32_pack(v[ks]); }
    LDS_WAIT(); asm volatile("" ::: "memory");
}
__device__ __forceinline__ LAS bf16x8* wave_q(Frame& F) { return (LAS bf16x8*)(F.lds + F.wave * 16384) + F.lane; }
template <int NS, int NT> __device__ __forceinline__ void zero_o(f32x16 (&O)[NS][NT], float (&l)[NS]) {
#pragma unroll
    for (int s = 0; s < NS; ++s) { l[s] = 0.f;
#pragma unroll
        for (int nt = 0; nt < NT; ++nt)
#pragma unroll
            for (int r = 0; r < 16; ++r) O[s][nt][r] = 0.f; }
}

__device__ __forceinline__ void mem_task(Frame& F, int task, int Ly, const bf16* PROJ, int ldp, int qmcol) {
    const int qb = task & 31, h = (task >> 5) & 3, b = task >> 7; const int r32 = F.lane & 31;
    const int row0 = b * SEQ + 64 * qb;
    const bf16* qrow[2] = {PROJ + (size_t)(row0 + r32) * ldp + qmcol + h * 64, PROJ + (size_t)(row0 + 32 + r32) * ldp + qmcol + h * 64};
#if QF_MEM
    LAS bf16x8* ql = wave_q(F); { const int tp[2] = {0, 0}; stage_q_xf<2>(F, ql, qrow, tp, F.ka->in[10] + Ly * 64, false, QSCALE); }
#else
    LAS bf16x8* ql = wave_q(F); stage_q<2>(ql, qrow, F.lane);
#endif
    KVp kv{(const bf16*)(F.ws + WS_MK) + ((size_t)((Ly * NB + b) * 4 + h) * NMEMT) * 64, 64, (const bf16*)(F.ws + WS_MVT) + ((size_t)(Ly * NB + b) * 256 + h * 64) * NMEMT, NMEMT};
    f32x16 O[2][2]; float l[2]; zero_o<2, 2>(O, l);
    MaskArg ma{}; const unsigned* mbr[2] = {nullptr, nullptr};
    const float negb = 0.f;
    attn_core<2, 2, 0, MK_NONE>(ql, kv, 0, NMEMT / 32, negb, ma, mbr, O, l, F.lane);
    bf16* Y = (bf16*)(F.ws + WS_Y);
#pragma unroll
    for (int s = 0; s < 2; ++s) { const float lt = l[s] + __shfl_xor(l[s], 32); store_o<2, false>(O[s], (DBG_ZERO & 8) ? 0.f : 1.f / lt, Y, row0 + 32 * s, 768 + h * 64, F.lane); }
}
__device__ __forceinline__ void ret_epilogue(Frame& F, const f32x16 (&O)[4], int rowb, int h, const bf16* PROJ) {
    const int r32 = F.lane & 31, hi = F.lane >> 5;
    bf16* Y = (bf16*)(F.ws + WS_Y);
#pragma unroll
    for (int rh = 0; rh < 2; ++rh) {
        unsigned short gv[8][4];
#pragma unroll
        for (int ri = 0; ri < 8; ++ri) { const int r = 8 * rh + ri; const bf16* gp = PROJ + (size_t)(rowb + crow(r, hi)) * RET_LD + RET_G + h * 128 + r32;
#pragma unroll
            for (int nt = 0; nt < 4; ++nt) gv[ri][nt] = gp[32 * nt]; }
#pragma unroll
        for (int ri = 0; ri < 8; ++ri) { const int r = 8 * rh + ri;
            float a = (O[0][r] + O[1][r]) + (O[2][r] + O[3][r]);
#pragma unroll
            for (int o = 1; o < 32; o <<= 1) a += __shfl_xor(a, o);
            const float mu = a * (1.f / 128.f);
            float d0 = O[0][r] - mu, d1 = O[1][r] - mu, d2 = O[2][r] - mu, d3 = O[3][r] - mu;
            float q = (d0 * d0 + d1 * d1) + (d2 * d2 + d3 * d3);
#pragma unroll
            for (int o = 1; o < 32; o <<= 1) q += __shfl_xor(q, o);
            const float rstd = __builtin_amdgcn_rsqf(q * (1.f / 128.f) + EPS);
            const int row = rowb + crow(r, hi);
            bf16* yp = Y + (size_t)row * 1024 + h * 128 + r32;
            const float dd[4] = {d0, d1, d2, d3};
#pragma unroll
            for (int nt = 0; nt < 4; ++nt) { const float g = bf2f(gv[ri][nt]); const float sg = g * __builtin_amdgcn_rcpf(1.f + fast_exp2(-1.4426950408889634f * g));
                yp[32 * nt] = (DBG_ZERO & 1) ? (bf16)0 : (bf16)f2bf(sg * dd[nt] * rstd); }
        }
    }
}
__device__ __forceinline__ void glds16(const void* gsrc, unsigned lds_dst) { unsigned keep;
    asm volatile("s_mov_b32 %0, m0\n\ts_mov_b32 m0, %2\n\ts_nop 0\n\tglobal_load_lds_dwordx4 %1, off\n\ts_mov_b32 m0, %0" : "=&s"(keep) : "v"(gsrc), "s"(lds_dst) : "memory"); }
template <int NS, int MT, int R>
__device__ __forceinline__ void wg_attn(Frame& F, const LAS bf16x8* ql, const bf16* psrc, int pstep, unsigned ring_off, int kt0, int kt1, unsigned blk, int my0, int my1,
                                        const MaskArg& ma, const LAS unsigned* mlds, f32x16 (&O)[NS][2], float (&lsum)[NS]) {
    const unsigned pdst = (unsigned)(uintptr_t)F.lds + ring_off + (unsigned)F.wave * 1024u;
#define WG_NEED(k_) ((MT != MK_SLC) || (((blk) >> ((k_) >> 1)) & 1u))
#define WG_ADV(k_) do { ++(k_); } while ((k_) < kt1 && !WG_NEED(k_))
    int kd = kt0; if (kd < kt1 && !WG_NEED(kd)) WG_ADV(kd);
    int kc = kd;
    int sd = 0, sc = 0, nd = 0;
#pragma unroll 1
    for (int j = 0; j < R - 1; ++j) if (kd < kt1) { glds16(psrc + (size_t)kd * pstep, (unsigned)__builtin_amdgcn_readfirstlane(pdst + (unsigned)sd * 8192u)); WG_ADV(kd); sd = sd + 1 == R ? 0 : sd + 1; ++nd; }
#pragma unroll 1
    while (kc < kt1) {
        const int yo = nd - 1;
        if (yo >= 3) asm volatile("s_waitcnt vmcnt(3)\n\ts_barrier" ::: "memory");
        else if (yo == 2) asm volatile("s_waitcnt vmcnt(2)\n\ts_barrier" ::: "memory");
        else if (yo == 1) asm volatile("s_waitcnt vmcnt(1)\n\ts_barrier" ::: "memory");
        else asm volatile("s_waitcnt vmcnt(0)\n\ts_barrier" ::: "memory");
        if (kd < kt1) { glds16(psrc + (size_t)kd * pstep, (unsigned)__builtin_amdgcn_readfirstlane(pdst + (unsigned)sd * 8192u)); WG_ADV(kd); sd = sd + 1 == R ? 0 : sd + 1; ++nd; }
        if (kc >= my0 && kc < my1) {
            unsigned selbit = 1u; bool active = true;
            if (MT == MK_SLC) { selbit = (ma.sel >> (kc >> 1)) & 1u; active = __any(selbit != 0u); }
            if (active) {
                const LAS bf16x8* sp = (const LAS bf16x8*)(F.lds + ring_off + sc * 8192) + F.lane;
                bf16x8 kf[4], vf[2][2];
#pragma unroll
                for (int ks = 0; ks < 4; ++ks) kf[ks] = sp[ks * 64];
#pragma unroll
                for (int nt = 0; nt < 2; ++nt) { vf[0][nt] = sp[(4 + 2 * nt) * 64]; vf[1][nt] = sp[(5 + 2 * nt) * 64]; }
                unsigned mw[NS];
#pragma unroll
                for (int s = 0; s < NS; ++s) mw[s] = (MT == MK_BITS) ? mlds[kc] : 0u;
                tile_math<NS, 2, 0, MT>(kf, vf, ql, kc, ma, mw, selbit, O, lsum, F.lane);
            }
        }
        WG_ADV(kc); sc = sc + 1 == R ? 0 : sc + 1; --nd;
    }
    asm volatile("s_waitcnt vmcnt(0)\n\ts_barrier" ::: "memory");
#undef WG_NEED
#undef WG_ADV
}
__device__ __forceinline__ void mem_wg_task(Frame& F, int task, int Ly, const bf16* PROJ, int ldp, int qmcol) {
    const int qb = task & 3, h = (task >> 2) & 3, b = task >> 4, w = F.wave; const int r32 = F.lane & 31, hi = F.lane >> 5;
    const int row0 = b * SEQ + 512 * qb + 64 * w;
    const bf16* qrow[2] = {PROJ + (size_t)(row0 + r32) * ldp + qmcol + h * 64, PROJ + (size_t)(row0 + 32 + r32) * ldp + qmcol + h * 64};
    LAS bf16x8* ql = (LAS bf16x8*)(F.lds + 65536 + w * 8192) + F.lane;
#if QF_MEM
    { const int tp[2] = {0, 0}; stage_q_xf<2>(F, ql, qrow, tp, F.ka->in[10] + Ly * 64, false, QSCALE); }
#else
    stage_q<2>(ql, qrow, F.lane);
#endif
    asm volatile("s_waitcnt vmcnt(0) lgkmcnt(0)" ::: "memory");
    { const int kperm = (r32 & 0x13) | ((r32 & 4) << 1) | ((r32 & 8) >> 1);
      const bf16* Kb = (const bf16*)(F.ws + WS_MK) + ((size_t)((Ly * NB + b) * 4 + h) * NMEMT + 32 * w + kperm) * 64 + 8 * hi;
      const bf16* Vb = (const bf16*)(F.ws + WS_MVT) + ((size_t)(Ly * NB + b) * 256 + h * 64 + r32) * NMEMT + 32 * w + 8 * hi;
      const unsigned dst = (unsigned)(uintptr_t)F.lds + (unsigned)w * 8192u;
#pragma unroll
      for (int ks = 0; ks < 4; ++ks) glds16(Kb + 16 * ks, (unsigned)__builtin_amdgcn_readfirstlane(dst + ks * 1024u));
#pragma unroll
      for (int j = 0; j < 4; ++j) glds16(Vb + (size_t)(32 * (j >> 1)) * NMEMT + 16 * (j & 1), (unsigned)__builtin_amdgcn_readfirstlane(dst + (4 + j) * 1024u)); }
    asm volatile("s_waitcnt vmcnt(0)\n\ts_barrier" ::: "memory");
    f32x16 O[2][2]; float l[2]; zero_o<2, 2>(O, l);
    MaskArg ma{}; const unsigned mw[2] = {0u, 0u};
#pragma unroll 1
    for (int kt = 0; kt < 8; ++kt) {
        const LAS bf16x8* sp = (const LAS bf16x8*)(F.lds + kt * 8192) + F.lane;
        bf16x8 kf[4], vf[2][2];
#pragma unroll
        for (int ks = 0; ks < 4; ++ks) kf[ks] = sp[ks * 64];
#pragma unroll
        for (int nt = 0; nt < 2; ++nt) { vf[0][nt] = sp[(4 + 2 * nt) * 64]; vf[1][nt] = sp[(5 + 2 * nt) * 64]; }
        tile_math<2, 2, 0, MK_NONE>(kf, vf, ql, kt, ma, mw, 1u, O, l, F.lane);
    }
    bf16* Y = (bf16*)(F.ws + WS_Y);
#pragma unroll
    for (int s = 0; s < 2; ++s) { const float lt = l[s] + __shfl_xor(l[s], 32); store_o<2, false>(O[s], (DBG_ZERO & 8) ? 0.f : 1.f / lt, Y, row0 + 32 * s, 768 + h * 64, F.lane); }
}
constexpr int RWG_SLOT = 12288, RWG_R = 9;
__device__ __forceinline__ void ret_wg_task(Frame& F, int task, const bf16* PROJ) {
    const int qb = 7 - (task & 7), h = (task >> 3) % 6, b = (task >> 3) / 6, w = F.wave; const int r32 = F.lane & 31, hi = F.lane >> 5;
    const int rowb = b * SEQ + 256 * qb + 32 * w;
    bf16x8 qf[4];
    { float v[4][8]; q32_load(PROJ + (size_t)(rowb + r32) * RET_LD + RET_Q + h * 64 + 8 * hi, v);
      const int t = 256 * qb + 32 * w + r32; const float lg = __builtin_amdgcn_logf(1.0f - __builtin_amdgcn_exp2f(-5.0f - (float)h));
      q32_xf(v, nullptr, true, t, __builtin_amdgcn_exp2f((float)t * lg), hi, (const float*)(F.ws + WS_ROPE));
#pragma unroll
      for (int ks = 0; ks < 4; ++ks) qf[ks] = q32_pack(v[ks]); }
    asm volatile("s_waitcnt vmcnt(0)" : "+v"(qf[0]), "+v"(qf[1]), "+v"(qf[2]), "+v"(qf[3]) :: "memory");
    const int kperm = (r32 & 0x13) | ((r32 & 4) << 1) | ((r32 & 8) >> 1);
    const bf16* ksrc = PROJ + (size_t)(b * SEQ + kperm) * RET_LD + RET_K + h * 64 + 16 * (w & 3) + 8 * hi;
    const bf16* vsrc = (const bf16*)F.out + ((size_t)b * 768 + h * 128 + 32 * (w >> 1) + r32) * SEQ + 16 * (w & 1) + 8 * hi;
    const unsigned lds0 = (unsigned)(uintptr_t)F.lds;
    const unsigned kdst = lds0 + (unsigned)(w & 3) * 1024u, vdst = lds0 + 4096u + (unsigned)w * 1024u;
    const int kt1 = 8 * qb + 8, my1 = 8 * qb + w + 1;
#define RWG_DMA(t_, slot_) do { const int tt_ = (t_) < kt1 ? (t_) : kt1 - 1; const unsigned so_ = (unsigned)(((t_) < kt1) ? (slot_) : RWG_R) * RWG_SLOT; \
        if (w < 4) glds16(ksrc + (size_t)(32 * tt_) * RET_LD, (unsigned)__builtin_amdgcn_readfirstlane(kdst + so_)); \
        glds16(vsrc + 32 * tt_, (unsigned)__builtin_amdgcn_readfirstlane(vdst + so_)); } while (0)
    f32x16 O[4];
#pragma unroll
    for (int nt = 0; nt < 4; ++nt)
#pragma unroll
        for (int r = 0; r < 16; ++r) O[nt][r] = 0.f;
#pragma unroll 1
    for (int j = 0; j < RWG_R - 1; ++j) RWG_DMA(j, j);
    int slot = 0, fslot = RWG_R - 1;
#pragma unroll 1
    for (int kt = 0; kt < kt1; ++kt) {
        if (w < 4) asm volatile("s_waitcnt vmcnt(%0)\n\ts_barrier" :: "n"(2 * (RWG_R - 2)) : "memory");
        else       asm volatile("s_waitcnt vmcnt(%0)\n\ts_barrier" :: "n"(RWG_R - 2) : "memory");
        RWG_DMA(kt + RWG_R - 1, fslot);
        if (kt < my1) {
            const LAS bf16x8* sp = (const LAS bf16x8*)(F.lds + slot * RWG_SLOT) + F.lane;
            bf16x8 kf[4], vf[2][4];
#pragma unroll
            for (int ks = 0; ks < 4; ++ks) kf[ks] = sp[ks * 64];
#pragma unroll
            for (int nt = 0; nt < 4; ++nt) { vf[0][nt] = sp[(4 + 2 * nt) * 64]; vf[1][nt] = sp[(5 + 2 * nt) * 64]; }
            f32x16 acc;
#pragma unroll
            for (int r = 0; r < 16; ++r) acc[r] = 0.f;
#pragma unroll
            for (int ks = 0; ks < 4; ++ks) acc = __builtin_amdgcn_mfma_f32_32x32x16_bf16(kf[ks], qf[ks], acc, 0, 0, 0);
            float p[16];
            if (kt + 1 < my1) {
#pragma unroll
                for (int r = 0; r < 16; ++r) p[r] = acc[r];
            } else {
#pragma unroll
                for (int r = 0; r < 16; ++r) p[r] = (8 * hi + 16 * (r >> 3) + (r & 7) <= r32) ? acc[r] : 0.f;
            }
            bf16x8 pk0, pk1;
            { v4u t0, t1; t0.x = pk2(p[0], p[1]); t0.y = pk2(p[2], p[3]); t0.z = pk2(p[4], p[5]); t0.w = pk2(p[6], p[7]);
              t1.x = pk2(p[8], p[9]); t1.y = pk2(p[10], p[11]); t1.z = pk2(p[12], p[13]); t1.w = pk2(p[14], p[15]);
              pk0 = __builtin_bit_cast(bf16x8, t0); pk1 = __builtin_bit_cast(bf16x8, t1); }
#pragma unroll
            for (int nt = 0; nt < 4; ++nt) { O[nt] = __builtin_amdgcn_mfma_f32_32x32x16_bf16(pk0, vf[0][nt], O[nt], 0, 0, 0);
                                             O[nt] = __builtin_amdgcn_mfma_f32_32x32x16_bf16(pk1, vf[1][nt], O[nt], 0, 0, 0); }
        }
        fslot = slot; slot = slot + 1 == RWG_R ? 0 : slot + 1;
    }
    asm volatile("s_waitcnt vmcnt(0)\n\ts_barrier" ::: "memory");
#undef RWG_DMA
    ret_epilogue(F, O, rowb, h, PROJ);
}
__device__ __forceinline__ void ret_task(Frame& F, int task, const bf16* PROJ) {
    const int qb = 31 - (task & 31), h = (task >> 5) % 6, b = (task >> 5) / 6; const int r32 = F.lane & 31, hi = F.lane >> 5;
    const int row0 = b * SEQ + 64 * qb;
    const bf16* qrow[2] = {PROJ + (size_t)(row0 + r32) * RET_LD + RET_Q + h * 64, PROJ + (size_t)(row0 + 32 + r32) * RET_LD + RET_Q + h * 64};
    LAS bf16x8* ql = wave_q(F); stage_q<2>(ql, qrow, F.lane);
    KVp kv{PROJ + (size_t)(b * SEQ) * RET_LD + RET_K + h * 64, RET_LD, (const bf16*)F.out + ((size_t)b * 768 + h * 128) * SEQ, SEQ};
    f32x16 O[2][4]; float l[2]; zero_o<2, 4>(O, l);
    MaskArg ma{}; ma.q0[0] = 64 * qb; ma.q0[1] = 64 * qb + 32; const unsigned* mbr[2] = {nullptr, nullptr};
    ma.lg = __builtin_amdgcn_logf(1.0f - __builtin_amdgcn_exp2f(-5.0f - (float)h));
    attn_core<2, 4, RET_MODE, MK_CAUSAL, 1>(ql, kv, 0, 2 * qb + 2, 0.f, ma, mbr, O, l, F.lane);
#pragma unroll
    for (int s = 0; s < 2; ++s) ret_epilogue(F, O[s], row0 + 32 * s, h, PROJ);
}

typedef _Float16 h2_t __attribute__((ext_vector_type(2)));
__device__ __forceinline__ unsigned pkh(float a, float b) { h2_t v = {(_Float16)a, (_Float16)b}; return __builtin_bit_cast(unsigned, v); }
__device__ __forceinline__ void dsa_d1_task(Frame& F, int task, const bf16* PROJ) {
    const int b = task / 288; int rem = task % 288; int qb = 63, kc = 0;
    { int grp = 7; while (rem >= 8 * (grp + 1)) { rem -= 8 * (grp + 1); --grp; }
      qb = 8 * grp + 7 - rem / (grp + 1); kc = rem % (grp + 1); }
    const int r32 = F.lane & 31, hi = F.lane >> 5; const int row = b * SEQ + 32 * qb + r32;
    const bf16* qp = PROJ + (size_t)row * DSA_LD + DSA_IQ + 8 * hi;
    bf16x8 qf[4][4]; LAS bf16x8* ql = wave_q(F);
    { const int tpos = 32 * qb + r32; const float* tab = (const float*)(F.ws + WS_ROPE);
#pragma unroll
      for (int h = 0; h < 8; ++h) { float v[4][8]; q32_load(qp + h * 64, v); q32_xf(v, nullptr, true, tpos, 1.f, hi, tab);
#pragma unroll
          for (int ks = 0; ks < 4; ++ks) { const bf16x8 f = q32_pack(v[ks]); if (h < 4) qf[h & 3][ks] = f; else ql[((h & 3) * 4 + ks) * 64] = f; } } }
    LDS_WAIT(); asm volatile("" ::: "memory");
    float iw[8];
    { const v4u w = *(const GAS v4u*)(PROJ + (size_t)row * DSA_LD + DSA_IW); iw[0] = bflo(w.x); iw[1] = bfhi(w.x); iw[2] = bflo(w.y); iw[3] = bfhi(w.y); iw[4] = bflo(w.z); iw[5] = bfhi(w.z); iw[6] = bflo(w.w); iw[7] = bfhi(w.w); }
    const int kperm = (r32 & 0x13) | ((r32 & 4) << 1) | ((r32 & 8) >> 1);
    const bf16* kp = PROJ + (size_t)(b * SEQ + kperm) * DSA_LD + DSA_IK + 8 * hi;
    _Float16* sc = (_Float16*)(F.ws + WS_SC) + (size_t)row * SEQ + 8 * hi;
    const int kt1 = (8 * kc + 8 < qb + 1) ? 8 * kc + 8 : qb + 1;
    bf16x8 kf[4], kfn[4];
#pragma unroll
    for (int ks = 0; ks < 4; ++ks) kf[ks] = ld8(kp + (size_t)(32 * (8 * kc)) * DSA_LD + 16 * ks);
#pragma unroll 1
    for (int kt = 8 * kc; kt < kt1; ++kt) {
        { const int ktn = kt + 1 < kt1 ? kt + 1 : kt;
#pragma unroll
          for (int ks = 0; ks < 4; ++ks) kfn[ks] = ld8(kp + (size_t)(32 * ktn) * DSA_LD + 16 * ks); }
        float s[16];
#pragma unroll
        for (int r = 0; r < 16; ++r) s[r] = 0.f;
#pragma unroll
        for (int h = 0; h < 8; ++h) { f32x16 acc;
#pragma unroll
            for (int r = 0; r < 16; ++r) acc[r] = 0.f;
#pragma unroll
            for (int ks = 0; ks < 4; ++ks) acc = __builtin_amdgcn_mfma_f32_32x32x16_bf16(kf[ks], h < 4 ? qf[h & 3][ks] : ql[((h & 3) * 4 + ks) * 64], acc, 0, 0, 0);
#pragma unroll
            for (int r = 0; r < 16; ++r) s[r] += iw[h] * fmaxf(acc[r], 0.f);
            __builtin_amdgcn_sched_barrier(0); }
        v4u o0, o1; o0.x = pkh(s[0], s[1]); o0.y = pkh(s[2], s[3]); o0.z = pkh(s[4], s[5]); o0.w = pkh(s[6], s[7]);
        o1.x = pkh(s[8], s[9]); o1.y = pkh(s[10], s[11]); o1.z = pkh(s[12], s[13]); o1.w = pkh(s[14], s[15]);
        *(GAS v4u*)(sc + 32 * kt) = o0; *(GAS v4u*)(sc + 32 * kt + 16) = o1;
#pragma unroll
        for (int ks = 0; ks < 4; ++ks) kf[ks] = kfn[ks];
    }
}
__device__ __forceinline__ int hist_select(LAS unsigned* hist, const unsigned (&key)[32], bool lvl2, unsigned B, int target, int lane) {
    { unsigned z = 0u; asm volatile("" : "+v"(z)); *(LAS v4u*)(hist + 4 * lane) = (v4u){z, z, z, z}; }
    LDS_WAIT(); asm volatile("" ::: "memory");
#pragma unroll
    for (int e = 0; e < 32; ++e) { const unsigned d = lvl2 ? (key[e] & 255u) : (key[e] >> 8); const bool m = lvl2 ? ((key[e] >> 8) == B) : true;
        if (m) __hip_atomic_fetch_add(hist + d, 1u, __ATOMIC_RELAXED, __HIP_MEMORY_SCOPE_WAVEFRONT); }
    LDS_WAIT(); asm volatile("" ::: "memory");
    const v4u c = *(LAS v4u*)(hist + 4 * lane);
    const int s = (int)(c.x + c.y + c.z + c.w);
    int S = s;
#pragma unroll
    for (int o = 1; o < 64; o <<= 1) { const int v = __shfl_down(S, o); if (lane + o < 64) S += v; }
    const unsigned long long bm = __ballot(S >= target);
    const int Ls = 63 - __clzll(bm);
    int a = S - s, dig, abv;
    if (a + (int)c.w >= target) { dig = 3; abv = a; } else { a += (int)c.w;
        if (a + (int)c.z >= target) { dig = 2; abv = a; } else { a += (int)c.z;
            if (a + (int)c.y >= target) { dig = 1; abv = a; } else { a += (int)c.y; dig = 0; abv = a; } } }
    const int packed = ((4 * lane + dig) << 12) | abv;
    const int r = __shfl(packed, Ls);
    LDS_WAIT(); asm volatile("" ::: "memory");
    return r;
}
__device__ __forceinline__ void d2_load(Frame& F, int row, v4u (&raw)[4]) {
    const int t = row % SEQ, lane = F.lane;
    const unsigned short* sp = (const unsigned short*)(F.ws + WS_SC) + (size_t)row * SEQ + (32 * lane <= t ? 32 * lane : 0);
#pragma unroll
    for (int i = 0; i < 4; ++i) raw[i] = *(const GAS v4u*)(sp + 8 * i);
}
__device__ __forceinline__ void dsa_d2_row(Frame& F, int row, const v4u (&raw)[4]) {
    const int t = row % SEQ, lane = F.lane;
    unsigned* mbp = (unsigned*)(F.ws + WS_MB) + (size_t)row * 64;
    int nvalid = t + 1 - 32 * lane; nvalid = nvalid < 0 ? 0 : (nvalid > 32 ? 32 : nvalid);
    const unsigned cb = nvalid == 32 ? 0xffffffffu : ((1u << nvalid) - 1u);
    if (t < 256) { mbp[lane] = cb; return; }
    unsigned key[32];
#pragma unroll
    for (int i = 0; i < 4; ++i) { const unsigned w[4] = {raw[i].x, raw[i].y, raw[i].z, raw[i].w};
#pragma unroll
        for (int j = 0; j < 4; ++j) {
#pragma unroll
            for (int k = 0; k < 2; ++k) { const int e = 8 * i + 2 * j + k; const unsigned u = (w[j] >> (16 * k)) & 0xffffu;
                const unsigned sk = (u & 0x8000u) ? (~u & 0xffffu) : (u | 0x8000u);
                key[e] = (e < nvalid) ? sk : 0u; } } }
    LAS unsigned* hist = (LAS unsigned*)(F.lds + F.wave * 16384);
    const int d1 = hist_select(hist, key, false, 0u, 256, lane);
    const unsigned Bh = (unsigned)d1 >> 12; const int above1 = d1 & 0xfff;
    const int d2 = hist_select(hist, key, true, Bh, 256 - above1, lane);
    const unsigned T = (Bh << 8) | ((unsigned)d2 >> 12);
    const int cgt = above1 + (d2 & 0xfff);
    unsigned g = 0, eq = 0;
#pragma unroll
    for (int e = 0; e < 32; ++e) { unsigned bg = key[e] > T ? 1u : 0u, be = key[e] == T ? 1u : 0u; asm volatile("" : "+v"(bg), "+v"(be));
        g |= bg << e; eq |= be << e; }
    const int need = 256 - cgt; const int myeq = __popc(eq);
    int incl = myeq;
#pragma unroll
    for (int o = 1; o < 64; o <<= 1) { const int v = __shfl_up(incl, o); if (lane >= o) incl += v; }
    const int pre = incl - myeq; int take = need - pre; take = take < 0 ? 0 : (take > myeq ? myeq : take);
    unsigned te = eq; int cnt = myeq;
    while (cnt > take) { te &= ~(1u << (31 - __clz(te))); --cnt; }
    mbp[lane] = (g | te) & cb;
}
__device__ __forceinline__ void dsa_d3_task(Frame& F, int task, const bf16* PROJ) {
    const int hg = task & 3, qb = 63 - ((task >> 2) & 63), b = task >> 8; const int r32 = F.lane & 31;
    const int row0 = b * SEQ + 32 * qb;
    const bf16* qrow[3]; const unsigned* mbr[3];
#pragma unroll
    for (int s = 0; s < 3; ++s) { qrow[s] = PROJ + (size_t)(row0 + r32) * DSA_LD + DSA_Q + (3 * hg + s) * 64; mbr[s] = (const unsigned*)(F.ws + WS_MB) + (size_t)(row0 + r32) * 64; }
    LAS bf16x8* ql = wave_q(F); stage_q<3>(ql, qrow, F.lane);
    KVp kv{PROJ + (size_t)(b * SEQ) * DSA_LD + DSA_K, DSA_LD, (const bf16*)F.out + (size_t)b * 64 * SEQ, SEQ};
    f32x16 O[3][2]; float l[3]; zero_o<3, 2>(O, l);
    MaskArg ma{}; ma.q0[0] = ma.q0[1] = ma.q0[2] = 32 * qb;
    const float negb = 0.f;
    attn_core<3, 2, 0, MK_BITS, 2>(ql, kv, 0, qb + 1, negb, ma, mbr, O, l, F.lane);
    bf16* Y = (bf16*)(F.ws + WS_Y);
#pragma unroll
    for (int s = 0; s < 3; ++s) { const float lt = l[s] + __shfl_xor(l[s], 32); store_o<2, false>(O[s], (DBG_ZERO & 2) ? 0.f : 1.f / lt, Y, row0, (3 * hg + s) * 64, F.lane); }
}

constexpr unsigned D3_MOFF = 98304u, D3_ROFF = 98304u + 64u * 65u * 4u;
__device__ __forceinline__ void dsa_d3_wg_task(Frame& F, int task, const bf16* PROJ) {
    const int qb = 31 - (task & 31), b = task >> 5, w = F.wave, qs = w >> 2, hg = w & 3; const int r32 = F.lane & 31, hi = F.lane >> 5;
    const int row0 = b * SEQ + 64 * qb + 32 * qs;
    const bf16* qrow[3];
#pragma unroll
    for (int s = 0; s < 3; ++s) qrow[s] = PROJ + (size_t)(row0 + r32) * DSA_LD + DSA_Q + (3 * hg + s) * 64;
    LAS bf16x8* ql = (LAS bf16x8*)(F.lds + w * 12288) + F.lane; { const int tq_ = 64 * qb + 32 * qs + r32; const int tp[3] = {tq_, tq_, tq_}; stage_q_xf<3>(F, ql, qrow, tp, F.ka->in[14], true, QSCALE); }
    { const unsigned* mb = (const unsigned*)(F.ws + WS_MB) + (size_t)(b * SEQ + 64 * qb) * 64; LAS unsigned* ml = (LAS unsigned*)(F.lds + D3_MOFF);
#pragma unroll
      for (int j = 0; j < 2; ++j) { const int e = (F.tid + 512 * j) * 4, row = e >> 6, col = e & 63; const v4u m = *(const GAS v4u*)(mb + e);
          ml[row * 65 + col] = m.x; ml[row * 65 + col + 1] = m.y; ml[row * 65 + col + 2] = m.z; ml[row * 65 + col + 3] = m.w; } }
    asm volatile("s_waitcnt vmcnt(0) lgkmcnt(0)\n\ts_barrier" ::: "memory");
    const int kperm = (r32 & 0x13) | ((r32 & 4) << 1) | ((r32 & 8) >> 1);
    const bf16* psrc; int pstep;
    if (w < 4) { psrc = PROJ + (size_t)(b * SEQ + kperm) * DSA_LD + DSA_K + 16 * w + 8 * hi; pstep = 32 * DSA_LD; }
    else { const int j = w - 4; psrc = (const bf16*)F.out + ((size_t)b * 64 + 32 * (j >> 1) + r32) * SEQ + 16 * (j & 1) + 8 * hi; pstep = 32; }
    f32x16 O[3][2]; float l[3]; zero_o<3, 2>(O, l);
    MaskArg ma{}; ma.q0[0] = ma.q0[1] = ma.q0[2] = 64 * qb + 32 * qs;
    const LAS unsigned* mlds = (const LAS unsigned*)(F.lds + D3_MOFF) + (qs * 32 + r32) * 65;
    wg_attn<3, MK_BITS, 3>(F, ql, psrc, pstep, D3_ROFF, 0, 2 * qb + 2, 0xffffffffu, 0, 2 * qb + qs + 1, ma, mlds, O, l);
    bf16* Y = (bf16*)(F.ws + WS_Y);
#pragma unroll
    for (int s = 0; s < 3; ++s) { const float lt = l[s] + __shfl_xor(l[s], 32); store_o<2, false>(O[s], (DBG_ZERO & 2) ? 0.f : 1.f / lt, Y, row0, (3 * hg + s) * 64, F.lane); }
}

__device__ __forceinline__ void nsa_cmp_task(Frame& F, int task, int chunk, const bf16* PROJ, const float* kn0) {
    const int nb = task & 3, g = (task >> 2) & 3, b = task >> 4; const int r32 = F.lane & 31, hi = F.lane >> 5;
    const int n = 32 * nb + r32, nc = n > 126 ? 126 : n;
    const bf16* arow = PROJ + (size_t)(b * SEQ + 16 * nc) * NSA_LD + 64 * g + 8 * hi;
    const bf16* WkT = (const bf16*)(F.ws + WS_CMPW); const bf16* WvT = WkT + 64 * 2048;
    const bf16* wkp = WkT + (size_t)r32 * 2048 + 8 * hi; const bf16* wvp = WvT + (size_t)r32 * 2048 + 8 * hi;
    f32x16 Dk[2], Dv[2];
#pragma unroll
    for (int et = 0; et < 2; ++et)
#pragma unroll
        for (int r = 0; r < 16; ++r) { Dk[et][r] = 0.f; Dv[et][r] = 0.f; }
#pragma unroll 4
    for (int kk = 32 * chunk; kk < 32 * chunk + 32; ++kk) {
        const bf16* ap = arow + (size_t)(kk >> 2) * NSA_LD + 16 * (kk & 3);
        const bf16x8 kcf = ld8(ap + NSA_KC), vcf = ld8(ap + NSA_VC);
#pragma unroll
        for (int et = 0; et < 2; ++et) { const bf16x8 wk = ld8(wkp + (size_t)(32 * et) * 2048 + 16 * kk), wv = ld8(wvp + (size_t)(32 * et) * 2048 + 16 * kk);
            Dk[et] = __builtin_amdgcn_mfma_f32_32x32x16_bf16(wk, kcf, Dk[et], 0, 0, 0);
            Dv[et] = __builtin_amdgcn_mfma_f32_32x32x16_bf16(vcf, wv, Dv[et], 0, 0, 0); }
    }
    { LAS f32x4* pl = (LAS f32x4*)(F.lds + F.wave * 16384) + F.lane;
      if (chunk != 0) {
#pragma unroll
          for (int et = 0; et < 2; ++et)
#pragma unroll
              for (int c = 0; c < 4; ++c) { pl[(et * 4 + c) * 64] = (f32x4){Dk[et][4 * c], Dk[et][4 * c + 1], Dk[et][4 * c + 2], Dk[et][4 * c + 3]};
                                            pl[(8 + et * 4 + c) * 64] = (f32x4){Dv[et][4 * c], Dv[et][4 * c + 1], Dv[et][4 * c + 2], Dv[et][4 * c + 3]}; } }
      asm volatile("s_waitcnt vmcnt(0) lgkmcnt(0)\n\ts_barrier" ::: "memory");
      if (chunk != 0) return;
#pragma unroll 1
      for (int o = 1; o < 4; ++o) { const LAS f32x4* ql_ = pl + o * (16384 / 16);
#pragma unroll
          for (int et = 0; et < 2; ++et)
#pragma unroll
              for (int c = 0; c < 4; ++c) { const f32x4 a = ql_[(et * 4 + c) * 64], d = ql_[(8 + et * 4 + c) * 64];
#pragma unroll
                  for (int i = 0; i < 4; ++i) { Dk[et][4 * c + i] += a[i]; Dv[et][4 * c + i] += d[i]; } } } }
    const float* ck = (const float*)(F.ws + WS_CTL) + CW_CK; const float* cv = ck + 64;
    const float* tab = (const float*)(F.ws + WS_ROPE) + (size_t)(16 * nc + 31) * 64;
    float ss = 0.f;
#pragma unroll
    for (int et = 0; et < 2; ++et)
#pragma unroll
        for (int r = 0; r < 16; ++r) { Dk[et][r] += ck[32 * et + crow(r, hi)]; ss += Dk[et][r] * Dk[et][r]; }
    ss += __shfl_xor(ss, 32);
    const float rs = __builtin_amdgcn_rsqf(ss * (1.f / 64.f) + EPS);
    bf16* kout = (bf16*)(F.ws + WS_KCMP) + ((size_t)((b * 4 + g) * 128 + n)) * 64;
#pragma unroll
    for (int rq = 0; rq < 4; ++rq) { float o0[4], o1[4];
#pragma unroll
        for (int i = 0; i < 4; ++i) { const int r = 4 * rq + i, idx = crow(r, hi); const float v0 = Dk[0][r] * rs * kn0[idx], v1 = Dk[1][r] * rs * kn0[32 + idx];
            const float c = tab[idx], s = tab[32 + idx]; o0[i] = v0 * c - v1 * s; o1[i] = v1 * c + v0 * s; if (n > 126) { o0[i] = 0.f; o1[i] = 0.f; } }
        v2u w0, w1; w0.x = pk2(o0[0], o0[1]); w0.y = pk2(o0[2], o0[3]); w1.x = pk2(o1[0], o1[1]); w1.y = pk2(o1[2], o1[3]);
        *(GAS v2u*)(kout + 8 * rq + 4 * hi) = w0; *(GAS v2u*)(kout + 32 + 8 * rq + 4 * hi) = w1; }
    bf16* vout = (bf16*)(F.ws + WS_VCMPT) + ((size_t)((b * 4 + g) * 64)) * 128 + 32 * nb;
#pragma unroll
    for (int et = 0; et < 2; ++et) { const float cve = cv[32 * et + r32];
#pragma unroll
        for (int rq = 0; rq < 4; ++rq) { float o[4];
#pragma unroll
            for (int i = 0; i < 4; ++i) { const int nl = 8 * rq + 4 * hi + i; o[i] = (32 * nb + nl > 126) ? 0.f : Dv[et][4 * rq + i] + cve; }
            v2u w; w.x = pk2(o[0], o[1]); w.y = pk2(o[2], o[3]);
            *(GAS v2u*)(vout + (size_t)(32 * et + r32) * 128 + 8 * rq + 4 * hi) = w; } }
}
constexpr unsigned NSA_ROFF = 98304u;
template <bool WG>
__device__ NSA_INLINE void nsa_task(KArgs ka_, unsigned char* ws_, float* out_, LAS unsigned char* lds_, int wave_, int task, const bf16* PROJ) {
    Frame F; F.ka = ka_; F.ws = ws_; F.out = out_; F.lds = lds_; F.wave = wave_; F.MISC = (volatile LAS unsigned*)(lds_ + LDS_CTRL + 64);
    asm volatile("v_mbcnt_lo_u32_b32 %0, -1, 0\n\tv_mbcnt_hi_u32_b32 %0, -1, %0" : "=v"(F.lane));
    const int qb8 = 7 - (task & 7);
    const int g = WG ? (task >> 3) & 3 : task & 3, qb = WG ? 8 * qb8 + wave_ : 63 - ((task >> 2) & 63), b = WG ? task >> 5 : task >> 8; const int r32 = F.lane & 31, hi = F.lane >> 5;
    const int row0 = b * SEQ + 32 * qb, tq = 32 * qb + r32;
    const bf16* qrow[3];
#pragma unroll
    for (int s = 0; s < 3; ++s) qrow[s] = PROJ + (size_t)(row0 + r32) * NSA_LD + NSA_Q + (3 * g + s) * 64;
    LAS bf16x8* ql = WG ? (LAS bf16x8*)(F.lds + F.wave * 12288) + F.lane : wave_q(F); { const int tp[3] = {tq, tq, tq}; stage_q_xf<3>(F, ql, qrow, tp, F.ka->in[17], true, QSCALE); }
#define NSA_GLOAD(c_, dst_) do { const bf16* gp_ = PROJ + (size_t)(row0 + r32) * NSA_LD + NSA_GT + 9 * g + (c_); dst_[0] = gp_[0]; dst_[1] = gp_[3]; dst_[2] = gp_[6]; } while (0)
#define NSA_GATE(s_, c_) NSA_SIG(PROJ[(size_t)(row0 + r32) * NSA_LD + NSA_GT + 9 * g + 3 * (s_) + (c_)])
#define NSA_SIG(raw_) (__builtin_amdgcn_rcpf(1.f + fast_exp2(-1.4426950408889634f * bf2f(raw_))))
    bf16* Y = (bf16*)(F.ws + WS_Y);
    MaskArg ma{}; ma.q0[0] = ma.q0[1] = ma.q0[2] = 32 * qb; ma.nmax = tq >= 31 ? (tq - 31) >> 4 : -1;
    const KVp kvc{(const bf16*)(F.ws + WS_KCMP) + (size_t)((b * 4 + g) * 128) * 64, 64, (const bf16*)(F.ws + WS_VCMPT) + (size_t)((b * 4 + g) * 64) * 128, 128};
    float imp[16];
#pragma unroll
    for (int r = 0; r < 16; ++r) imp[r] = 0.f;
    {
        const int kperm = (r32 & 0x13) | ((r32 & 4) << 1) | ((r32 & 8) >> 1);
        { const int kt = F.wave >> 1; const unsigned dst = (unsigned)(uintptr_t)F.lds + NSA_ROFF + (unsigned)kt * 8192u + (unsigned)(F.wave & 1) * 4096u;
          if ((F.wave & 1) == 0) { const bf16* kp = kvc.K + (size_t)(32 * kt + kperm) * 64 + 8 * hi;
#pragma unroll
              for (int ks = 0; ks < 4; ++ks) glds16(kp + 16 * ks, (unsigned)__builtin_amdgcn_readfirstlane(dst + ks * 1024u)); }
          else { const bf16* vp = kvc.VT + (size_t)r32 * 128 + 32 * kt + 8 * hi;
#pragma unroll
              for (int j = 0; j < 4; ++j) glds16(vp + (size_t)(32 * (j >> 1)) * 128 + 16 * (j & 1), (unsigned)__builtin_amdgcn_readfirstlane(dst + j * 1024u)); } }
        unsigned short g0r[3]; NSA_GLOAD(0, g0r);
        asm volatile("s_waitcnt vmcnt(0)\n\ts_barrier" ::: "memory");
#pragma unroll 1
        for (int s = 0; s < 3; ++s) { f32x16 ia, Oc[2]; float ls = 0.f;
#pragma unroll
            for (int r = 0; r < 16; ++r) { ia[r] = 0.f; Oc[0][r] = 0.f; Oc[1][r] = 0.f; }
            bf16x8 qq[4];
#pragma unroll
            for (int ks = 0; ks < 4; ++ks) qq[ks] = ql[(s * 4 + ks) * 64];
#pragma unroll 1
            for (int kt = 0; kt < 4; ++kt) {
                const LAS bf16x8* sp = (const LAS bf16x8*)(F.lds + NSA_ROFF + kt * 8192) + F.lane;
                bf16x8 kf[4], vf[2][2];
#pragma unroll
                for (int ks = 0; ks < 4; ++ks) kf[ks] = sp[ks * 64];
#pragma unroll
                for (int nt = 0; nt < 2; ++nt) { vf[0][nt] = sp[(4 + 2 * nt) * 64]; vf[1][nt] = sp[(5 + 2 * nt) * 64]; }
                f32x16 acc;
#pragma unroll
                for (int r = 0; r < 16; ++r) acc[r] = 0.f;
#pragma unroll
                for (int ks = 0; ks < 4; ++ks) acc = __builtin_amdgcn_mfma_f32_32x32x16_bf16(kf[ks], qq[ks], acc, 0, 0, 0);
                float p[16];
#pragma unroll
                for (int r = 0; r < 16; ++r) { const int key = 32 * kt + 8 * hi + 16 * (r >> 3) + (r & 7); p[r] = key <= ma.nmax ? fast_exp2(acc[r]) : 0.f; ls += p[r]; }
#pragma unroll
                for (int ks2 = 0; ks2 < 2; ++ks2) { v4u pw, cw; unsigned short cvv[8];
                    pw.x = pk2(p[8 * ks2], p[8 * ks2 + 1]); pw.y = pk2(p[8 * ks2 + 2], p[8 * ks2 + 3]); pw.z = pk2(p[8 * ks2 + 4], p[8 * ks2 + 5]); pw.w = pk2(p[8 * ks2 + 6], p[8 * ks2 + 7]);
#pragma unroll
                    for (int jj = 0; jj < 8; ++jj) { const int nn = 32 * kt + 16 * ks2 + 8 * hi + jj; cvv[jj] = (nn >= 4 * r32 - 1 && nn <= 4 * r32 + 3) ? 0x3f80 : 0; }
                    cw.x = cvv[0] | (cvv[1] << 16); cw.y = cvv[2] | (cvv[3] << 16); cw.z = cvv[4] | (cvv[5] << 16); cw.w = cvv[6] | (cvv[7] << 16);
                    const bf16x8 pf = __builtin_bit_cast(bf16x8, pw);
                    ia = __builtin_amdgcn_mfma_f32_32x32x16_bf16(__builtin_bit_cast(bf16x8, cw), pf, ia, 0, 0, 0);
                    Oc[0] = __builtin_amdgcn_mfma_f32_32x32x16_bf16(pf, vf[ks2][0], Oc[0], 0, 0, 0);
                    Oc[1] = __builtin_amdgcn_mfma_f32_32x32x16_bf16(pf, vf[ks2][1], Oc[1], 0, 0, 0); }
            }
            const float lt = ls + __shfl_xor(ls, 32); const float inv = lt > 0.f ? 1.f / lt : 0.f;
#pragma unroll
            for (int r = 0; r < 16; ++r) imp[r] += ia[r] * inv;
            store_o<2, false>(Oc, (DBG_ZERO & 4) ? 0.f : NSA_SIG(s == 0 ? g0r[0] : (s == 1 ? g0r[1] : g0r[2])) * inv, Y, row0, (3 * g + s) * 64, F.lane);
        }
    }
    unsigned sel;
    { const int qblk = tq >> 6;
      if (32 * qb + 31 < 1024) sel = (2u << qblk) - 1u;
      else { float val[16], oth[16];
#pragma unroll
        for (int r = 0; r < 16; ++r) { const int j = crow(r, hi); val[r] = j > qblk ? -1e30f : ((j == 0 || j == qblk || j == qblk - 1) ? 1e9f : imp[r]); oth[r] = __shfl_xor(val[r], 32); }
        unsigned mine = 0;
#pragma unroll
        for (int r = 0; r < 16; ++r) { const int j = crow(r, hi); int rank = 0;
#pragma unroll
            for (int r2 = 0; r2 < 16; ++r2) { const int j2 = crow(r2, hi), j3 = crow(r2, hi ^ 1);
                rank += (val[r2] > val[r] || (val[r2] == val[r] && j2 < j)) ? 1 : 0;
                rank += (oth[r2] > val[r] || (oth[r2] == val[r] && j3 < j)) ? 1 : 0; }
            mine |= ((rank < 16 && j <= qblk) ? 1u : 0u) << ((r & 3) + 8 * (r >> 2)); }
        mine <<= 4 * hi;
        sel = mine | __shfl_xor(mine, 32); } }
    const unsigned* mbr2[2] = {nullptr, nullptr}; const unsigned* mbr1[1] = {nullptr};
    const KVp kvs{PROJ + (size_t)(b * SEQ) * NSA_LD + NSA_KS + 64 * g, NSA_LD, (const bf16*)F.out + ((size_t)b * 256 + 64 * g) * SEQ, SEQ};
    const KVp kvw{PROJ + (size_t)(b * SEQ) * NSA_LD + NSA_KW + 64 * g, NSA_LD, (const bf16*)F.out + (size_t)NB * 256 * SEQ + ((size_t)b * 256 + 64 * g) * SEQ, SEQ};
    ma.sel = sel;
#define NSA_BRANCH(MT_, KV_, KT0_, KT1_, C_, ADD_, ZBIT_) do { \
      { f32x16 O2[2][2]; float l2[2]; zero_o<2, 2>(O2, l2); attn_core<2, 2, 0, MT_>(ql, KV_, KT0_, KT1_, 0.f, ma, mbr2, O2, l2, F.lane); VM_WAIT(); \
        _Pragma("unroll") for (int s = 0; s < 2; ++s) { const float lt = l2[s] + __shfl_xor(l2[s], 32); \
          store_o<2, ADD_>(O2[s], (lt > 0.f && !(DBG_ZERO & ZBIT_)) ? NSA_GATE(s, C_) / lt : 0.f, Y, row0, (3 * g + s) * 64, F.lane); } } \
      { f32x16 O1[1][2]; float l1[1]; zero_o<1, 2>(O1, l1); attn_core<1, 2, 0, MT_>(ql + 2 * 4 * 64, KV_, KT0_, KT1_, 0.f, ma, mbr1, O1, l1, F.lane); VM_WAIT(); \
        const float lt = l1[0] + __shfl_xor(l1[0], 32); \
        store_o<2, ADD_>(O1[0], (lt > 0.f && !(DBG_ZERO & ZBIT_)) ? NSA_GATE(2, C_) / lt : 0.f, Y, row0, (3 * g + 2) * 64, F.lane); } } while (0)
    if (!WG) {
    NSA_BRANCH(MK_SLC, kvs, 0, qb + 1, 1, true, 16);
    NSA_BRANCH(MK_WIN, kvw, (qb > 16 ? qb - 16 : 0), qb + 1, 2, true, 32);
    } else {
        unsigned wsel = sel;
#pragma unroll
        for (int o = 1; o < 32; o <<= 1) wsel |= __shfl_xor(wsel, o);
        if (F.lane == 0) __hip_atomic_fetch_or((LAS unsigned*)(F.lds + LDS_CTRL + 64) + 17, wsel, __ATOMIC_RELAXED, __HIP_MEMORY_SCOPE_WORKGROUP);
        asm volatile("s_waitcnt vmcnt(0) lgkmcnt(0)\n\ts_barrier" ::: "memory");
        const unsigned blk = (unsigned)__builtin_amdgcn_readfirstlane((int)F.MISC[17]);
        const int kperm = (r32 & 0x13) | ((r32 & 4) << 1) | ((r32 & 8) >> 1), w = F.wave;
#define NSA_WGBRANCH(MT_, KCOL_, VTOFF_, KT0_, KT1_, MY0_, MY1_, BLK_, C_, ZBIT_) do { \
        const bf16* psrc; int pstep; \
        if (w < 4) { psrc = PROJ + (size_t)(b * SEQ + kperm) * NSA_LD + (KCOL_) + 64 * g + 16 * w + 8 * hi; pstep = 32 * NSA_LD; } \
        else { const int j_ = w - 4; psrc = (const bf16*)F.out + (VTOFF_) + ((size_t)b * 256 + 64 * g + 32 * (j_ >> 1) + r32) * SEQ + 16 * (j_ & 1) + 8 * hi; pstep = 32; } \
        f32x16 O3[3][2]; float l3[3]; zero_o<3, 2>(O3, l3); \
        wg_attn<3, MT_, 5>(F, ql, psrc, pstep, NSA_ROFF, KT0_, KT1_, BLK_, MY0_, MY1_, ma, (const LAS unsigned*)nullptr, O3, l3); \
        unsigned short gr_[3]; NSA_GLOAD(C_, gr_); \
        _Pragma("unroll") for (int s = 0; s < 3; ++s) { const float lt = l3[s] + __shfl_xor(l3[s], 32); \
          store_o<2, true>(O3[s], (lt > 0.f && !(DBG_ZERO & ZBIT_)) ? NSA_SIG(gr_[s]) / lt : 0.f, Y, row0, (3 * g + s) * 64, F.lane); } } while (0)
        NSA_WGBRANCH(MK_SLC, NSA_KS, (size_t)0, 0, 8 * qb8 + 8, 0, qb + 1, blk, 1, 16);
        NSA_WGBRANCH(MK_WIN, NSA_KW, (size_t)NB * 256 * SEQ, (8 * qb8 > 16 ? 8 * qb8 - 16 : 0), 8 * qb8 + 8, (qb > 16 ? qb - 16 : 0), qb + 1, 0xffffffffu, 2, 32);
#undef NSA_WGBRANCH
    }
#undef NSA_BRANCH
}
__device__ __forceinline__ void prologue_misc(Frame& F) {
    float* tab = (float*)(F.ws + WS_ROPE);
    for (int idx = blockIdx.x * (NWAVES * 64) + F.tid; idx < SEQ * 32; idx += F.G * NWAVES * 64) {
        const int t = idx >> 5, i = idx & 31;
        const float inv = exp2f(-(float)i * (13.287712379549449f / 32.0f));
        const float ang = (float)t * inv; float s, c; sincosf(ang, &s, &c);
        tab[t * 64 + i] = c; tab[t * 64 + 32 + i] = s; }
    if (blockIdx.x < 4) {
        const int kv = F.wave & 1, part = blockIdx.x * 4 + (F.wave >> 1);
        const float* pos = kv ? F.ka->in[20] : F.ka->in[19]; const float* w = kv ? F.ka->in[22] : F.ka->in[21]; float a = 0.f;
#pragma unroll 8
        for (int i = part * 128; i < part * 128 + 128; ++i) a += pos[i] * w[(size_t)i * 64 + F.lane];
        atomicAdd((float*)(F.ws + WS_CTL) + CW_CK + 64 * kv + F.lane, a);
    }
}
__device__ __forceinline__ void prologue_phase(Frame& F) {
    prologue_misc(F);
    bf16* XB = (bf16*)(F.ws + WS_XB); float* PART = (float*)(F.ws + WS_PART);
    for (int m = F.gw; m < MTOK; m += F.NGW) row_to_bf16(F, F.ka->in[0] + (size_t)m * DM, XB + (size_t)m * DM, PART + (size_t)m * 16);
    bf16* MEMB = (bf16*)(F.ws + WS_MEMB); float* PARTM = (float*)(F.ws + WS_PARTM);
    for (int m = F.gw; m < MMEM; m += F.NGW) row_to_bf16(F, F.ka->in[1] + (size_t)m * DM, MEMB + (size_t)m * DM, PARTM + (size_t)m * 16);
    int itb = 0;
#pragma unroll 1
    for (int ly = 0; ly < DEPTH; ++ly) cvt_matrix(F, itb, F.ka->in[9] + (size_t)ly * DM * 512, nullptr, 512, 512, F.ka->in[8] + (size_t)ly * DM, (bf16*)(F.ws + WS_WKV) + (size_t)ly * 512 * DM, DM, 512, 0);
    cvt_matrix(F, itb, F.ka->in[21], nullptr, 64, 64, nullptr, (bf16*)(F.ws + WS_CMPW), 2048, 64, 0);
    cvt_matrix(F, itb, F.ka->in[22], nullptr, 64, 64, nullptr, (bf16*)(F.ws + WS_CMPW) + 64 * 2048, 2048, 64, 0);
    convert_layer(F, 0);
}

template <unsigned PHASE_MASK> __global__ void __launch_bounds__(NWAVES * 64, 2) mk_fwd(Args args) {
    extern __shared__ __attribute__((aligned(16))) unsigned char lds[];
    Frame F;
    F.lds = (LAS unsigned char*)lds;
    F.MISC = (volatile LAS unsigned*)(F.lds + LDS_CTRL + 64);
    F.tid = threadIdx.x; F.lane = F.tid & 63; F.wave = __builtin_amdgcn_readfirstlane(F.tid >> 6);
    F.G = gridDim.x; F.gw = blockIdx.x * NWAVES + F.wave; F.NGW = F.G * NWAVES;
    F.ws = args.ws; F.ctl = (gu32*)(args.ws + WS_CTL); F.out = args.out;
    F.ka = (KArgs)__builtin_amdgcn_kernarg_segment_ptr();
    for (int u = F.tid; u < 1024 / 4; u += NWAVES * 64) ((LAS unsigned*)(F.lds + LDS_CTRL))[u] = 0u;
    __syncthreads();
    XcdBarrier bar = xcd_barrier_post((unsigned*)(F.ctl + CW_BAR), F.MISC + 8);
    constexpr bool ALLPH = PHASE_MASK == 0xffffffffu;
    const int lo = ALLPH ? 0 : args.ph_lo, hi = ALLPH ? 0 : args.ph_hi; int pc = 0;
    const bool dry = ALLPH ? false : (args.dry != 0);
#define PH_BEGIN(id) if (ALLPH || ((((PHASE_MASK) >> (id)) & 1u) && lo <= pc && pc < hi)) { asm volatile("" : "+s"(F.ka), "+s"(F.ws), "+s"(F.out), "+s"(F.gw), "+s"(F.NGW), "+s"(F.G), "+s"(F.wave)); asm volatile("v_mbcnt_lo_u32_b32 %0, -1, 0\n\tv_mbcnt_hi_u32_b32 %0, -1, %0" : "=v"(F.lane)); F.tid = F.wave * 64 + F.lane;
#define PH_END_(islast)   if (ALLPH ? !(islast) : (pc + 1 < hi)) { XcdBarrier b2_ = bar; asm volatile("" : "+s"(b2_.bar), "+s"(b2_.x)); xcd_barrier(b2_); } } if (!ALLPH) ++pc;
#define PH_END PH_END_(false)
#define QCTR(i) (F.ctl + CW_Q + 64 * (i))

#define XB ((bf16*)(F.ws + WS_XB))
#define VTB ((bf16*)F.out)
#define Yb ((bf16*)(F.ws + WS_Y))
#define HID ((bf16*)(F.ws + WS_HID))
#define PART ((float*)(F.ws + WS_PART))
    LAS unsigned char* ring = F.lds;

    PH_BEGIN(0) prologue_phase(F); PH_END
    PH_BEGIN(1) { pg8::Gemm g{(const bf16*)(F.ws + WS_MEMB), (const bf16*)(F.ws + WS_WKV), MMEM, 2048, DM}; pg8::StaticOrder S; S.init(MMEM, 2048, F.G, (int)blockIdx.x);
        pg8::EpiScale E{(bf16*)(F.ws + WS_MKV), 2048, (const float*)(F.ws + WS_PARTM)};
        pg8::gemm_phase<pg8::EpiScale, pg8::StaticOrder, true, true>(ring, g, S, E, F.wave); } PH_END

#pragma unroll 1
    for (int Ly = 0; Ly < DEPTH; ++Ly) {
#define WB ((const bf16*)(F.ws + WS_WBUF0 + (size_t)(Ly & 1) * WBUF_BYTES))
        const int kind = Ly % 3;
        const int ldp = kind == 0 ? RET_LD : (kind == 1 ? DSA_LD : NSA_LD);
        PH_BEGIN(3) { pg8::Gemm g{XB, WB + WB_W1A, MTOK, 2 * FF, DM}; pg8::StaticOrder S; S.init(MTOK, 2 * FF, F.G, (int)blockIdx.x);
            pg8::EpiSwiglu E{HID, FF, PART, dry ? DRY_MODE : 0};
            pg8::gemm_phase<pg8::EpiSwiglu, pg8::StaticOrder, true, true>(ring, g, S, E, F.wave); } PH_END
        PH_BEGIN(4) { pg8::Gemm g{HID, WB + WB_W2A, MTOK, DM, FF}; pg8::StaticOrder S; S.init(MTOK, DM, F.G, (int)blockIdx.x);
            pg8::EpiResid E{XB, XB, nullptr, PART, dry ? 0.f : 0.5f};
            pg8::gemm_phase<pg8::EpiResid, pg8::StaticOrder, true, true>(ring, g, S, E, F.wave); } PH_END
        PH_BEGIN(5) { pg8::Gemm g{XB, WB + WB_WIN, MTOK, ldp, DM}; pg8::StaticOrder S; S.init(MTOK, ldp, F.G, (int)blockIdx.x);
            pg8::EpiScale E{HID, ldp, PART};
            pg8::gemm_phase<pg8::EpiScale, pg8::StaticOrder, true, true>(ring, g, S, E, F.wave); } PH_END
        PH_BEGIN(6)
#define DO_X (!dry || DRY_MODE == 0 || DRY_MODE == 11)
#define DO_T (!dry || DRY_MODE == 0 || DRY_MODE == 12)
#define DO_C (!dry || DRY_MODE == 0 || DRY_MODE == 13)
            if (kind == 0) {
                if (DO_X) xform(F, HID, ldp, RET_K, 6, MTOK, SEQ, (dry ? Yb : HID), 0, (dry ? 1024 : ldp), (dry ? 0 : RET_K), nullptr, true, 0.125f, RET_MODE == 1 ? -1 : 0);
#if !QF_MEM
                xform(F, HID, ldp, RET_QM, 4, MTOK, SEQ, HID, 0, ldp, RET_QM, F.ka->in[10] + Ly * 64, false, QSCALE, 0);
#endif
                if (DO_T) transpose_cols(F, HID, ldp, RET_V, 768, NB, SEQ, VTB);
            } else if (kind == 1) {
                if (DO_X) xform(F, HID, ldp, DSA_K, 1, MTOK, SEQ, (dry ? Yb : HID), 0, (dry ? 1024 : ldp), (dry ? 0 : DSA_K), F.ka->in[15], true, 1.f, 0);
                if (DO_X) xform(F, HID, ldp, DSA_IK, 1, MTOK, SEQ, (dry ? Yb : HID), 0, (dry ? 1024 : ldp), (dry ? 0 : DSA_IK), nullptr, true, 1.f, 0);
#if !QF_MEM
                xform(F, HID, ldp, DSA_QM, 4, MTOK, SEQ, HID, 0, ldp, DSA_QM, F.ka->in[10] + Ly * 64, false, QSCALE, 0);
#endif
                if (DO_T) transpose_cols(F, HID, ldp, DSA_V, 64, NB, SEQ, VTB);
            } else {
                if (DO_T && blockIdx.x < 128) nsa_cmp_task(F, 2 * (int)blockIdx.x + (F.wave >> 2), F.wave & 3, HID, F.ka->in[18]);
                if (DO_X) xform(F, HID, ldp, NSA_KS, 4, MTOK, SEQ, (dry ? Yb : HID), 0, (dry ? 1024 : ldp), (dry ? 0 : NSA_KS), F.ka->in[18] + 64, true, 1.f, 0);
                if (DO_X) xform(F, HID, ldp, NSA_KW, 4, MTOK, SEQ, (dry ? Yb : HID), 0, (dry ? 1024 : ldp), (dry ? 0 : NSA_KW), F.ka->in[18] + 128, true, 1.f, 0);
#if !QF_MEM
                xform(F, HID, ldp, NSA_QM, 4, MTOK, SEQ, HID, 0, ldp, NSA_QM, F.ka->in[10] + Ly * 64, false, QSCALE, 0);
#endif
                if (DO_T) transpose_cols(F, HID, ldp, NSA_VS, 256, NB, SEQ, VTB);
                if (DO_T) transpose_cols(F, HID, ldp, NSA_VW, 256, NB, SEQ, VTB + (size_t)NB * 256 * SEQ);
            }
            if (Ly == 0 && !dry) {
#pragma unroll 1
        for (int ly = 0; ly < DEPTH; ++ly) {
            xform(F, (const bf16*)(F.ws + WS_MKV), 2048, ly * 512, 4, MMEM, NMEMT, (bf16*)(F.ws + WS_MK) + (size_t)ly * NB * 4 * NMEMT * 64, 1, 0, 0, F.ka->in[11] + ly * 64, false, 1.f, 0);
            transpose_cols(F, (const bf16*)(F.ws + WS_MKV), 2048, ly * 512 + 256, 256, NB, NMEMT, (bf16*)(F.ws + WS_MVT) + (size_t)ly * NB * 256 * NMEMT);
        }
            }
            if (DO_C && Ly + 1 < DEPTH) convert_layer(F, Ly + 1);
#undef DO_X
#undef DO_T
#undef DO_C
        PH_END
        if (kind == 0) {
            PH_BEGIN(7)
                if (!(dry && DRY_MODE == 21)) for (;;) {
                    asm volatile("s_waitcnt vmcnt(0) lgkmcnt(0)\n\ts_barrier" ::: "memory");
                    if (F.wave == 0 && pg8::lane_now() == 0) F.MISC[16] = __hip_atomic_fetch_add(QCTR(Ly * 8 + 3), 1u, RLX_AGENT);
                    asm volatile("s_waitcnt vmcnt(0) lgkmcnt(0)\n\ts_barrier" ::: "memory");
                    const int t = __builtin_amdgcn_readfirstlane((int)F.MISC[16]);
                    if (t >= NB * 6 * 8) break;
                    asm volatile("v_mbcnt_lo_u32_b32 %0, -1, 0\n\tv_mbcnt_hi_u32_b32 %0, -1, %0" : "=v"(F.lane));
                    ret_wg_task(F, t, HID);
                }
                for (;;) {
                    asm volatile("s_waitcnt vmcnt(0) lgkmcnt(0)\n\ts_barrier" ::: "memory");
                    if (F.wave == 0 && pg8::lane_now() == 0) F.MISC[16] = __hip_atomic_fetch_add(QCTR(Ly * 8 + 0), 1u, RLX_AGENT);
                    asm volatile("s_waitcnt vmcnt(0) lgkmcnt(0)\n\ts_barrier" ::: "memory");
                    const int t = __builtin_amdgcn_readfirstlane((int)F.MISC[16]);
                    if (t >= NB * 16) break;
                    asm volatile("v_mbcnt_lo_u32_b32 %0, -1, 0\n\tv_mbcnt_hi_u32_b32 %0, -1, %0" : "=v"(F.lane));
                    mem_wg_task(F, t, Ly, HID, ldp, RET_QM);
                }
            PH_END
        } else if (kind == 1) {
            PH_BEGIN(8)
                for (;;) { asm volatile("v_mbcnt_lo_u32_b32 %0, -1, 0\n\tv_mbcnt_hi_u32_b32 %0, -1, %0" : "=v"(F.lane)); const int t = grab(QCTR(Ly * 8 + 0), F.lane); if (t >= 4608) break; if (!(dry && DRY_MODE == 21)) dsa_d1_task(F, t, HID); }
                for (;;) {
                    asm volatile("s_waitcnt vmcnt(0) lgkmcnt(0)\n\ts_barrier" ::: "memory");
                    if (F.wave == 0 && pg8::lane_now() == 0) F.MISC[16] = __hip_atomic_fetch_add(QCTR(Ly * 8 + 4), 1u, RLX_AGENT);
                    asm volatile("s_waitcnt vmcnt(0) lgkmcnt(0)\n\ts_barrier" ::: "memory");
                    const int t = __builtin_amdgcn_readfirstlane((int)F.MISC[16]);
                    if (t >= NB * 16) break;
                    asm volatile("v_mbcnt_lo_u32_b32 %0, -1, 0\n\tv_mbcnt_hi_u32_b32 %0, -1, %0" : "=v"(F.lane));
                    mem_wg_task(F, t, Ly, HID, ldp, DSA_QM);
                }
            PH_END
            PH_BEGIN(9)
                for (;;) { asm volatile("v_mbcnt_lo_u32_b32 %0, -1, 0\n\tv_mbcnt_hi_u32_b32 %0, -1, %0" : "=v"(F.lane)); const int t = grab(QCTR(Ly * 8 + 1), F.lane); if (t >= MTOK / 8) break;
{ v4u ra[4], rb[4]; d2_load(F, MTOK - 1 - 8 * t, ra);
#pragma unroll 1
                      for (int i = 0; i < 8; i += 2) { d2_load(F, MTOK - 1 - (8 * t + i + 1), rb); dsa_d2_row(F, MTOK - 1 - (8 * t + i), ra);
                          if (i + 2 < 8) d2_load(F, MTOK - 1 - (8 * t + i + 2), ra); dsa_d2_row(F, MTOK - 1 - (8 * t + i + 1), rb); } } }
            PH_END
            PH_BEGIN(10)
                                for (;;) {
                    asm volatile("s_waitcnt vmcnt(0) lgkmcnt(0)\n\ts_barrier" ::: "memory");
                    if (F.wave == 0 && pg8::lane_now() == 0) F.MISC[16] = __hip_atomic_fetch_add(QCTR(Ly * 8 + 3), 1u, RLX_AGENT);
                    asm volatile("s_waitcnt vmcnt(0) lgkmcnt(0)\n\ts_barrier" ::: "memory");
                    const int t = __builtin_amdgcn_readfirstlane((int)F.MISC[16]);
                    if (t >= NB * 32) break;
                    asm volatile("v_mbcnt_lo_u32_b32 %0, -1, 0\n\tv_mbcnt_hi_u32_b32 %0, -1, %0" : "=v"(F.lane)); F.tid = F.wave * 64 + F.lane;
                    dsa_d3_wg_task(F, t, HID);
                }

            PH_END
        } else {
            PH_BEGIN(11)
                if (!(dry && DRY_MODE == 21)) for (;;) {
                    asm volatile("s_waitcnt vmcnt(0) lgkmcnt(0)\n\ts_barrier" ::: "memory");
                    if (F.wave == 0 && pg8::lane_now() == 0) { F.MISC[16] = __hip_atomic_fetch_add(QCTR(Ly * 8 + 3), 1u, RLX_AGENT); F.MISC[17] = 0u; }
                    asm volatile("s_waitcnt vmcnt(0) lgkmcnt(0)\n\ts_barrier" ::: "memory");
                    const int t = __builtin_amdgcn_readfirstlane((int)F.MISC[16]);
                    if (t >= NB * 4 * 8) break;
                    nsa_task<true>(F.ka, F.ws, F.out, F.lds, F.wave, t, HID);
                }
                for (;;) {
                    asm volatile("s_waitcnt vmcnt(0) lgkmcnt(0)\n\ts_barrier" ::: "memory");
                    if (F.wave == 0 && pg8::lane_now() == 0) F.MISC[16] = __hip_atomic_fetch_add(QCTR(Ly * 8 + 0), 1u, RLX_AGENT);
                    asm volatile("s_waitcnt vmcnt(0) lgkmcnt(0)\n\ts_barrier" ::: "memory");
                    const int t = __builtin_amdgcn_readfirstlane((int)F.MISC[16]);
                    if (t >= NB * 16) break;
                    asm volatile("v_mbcnt_lo_u32_b32 %0, -1, 0\n\tv_mbcnt_hi_u32_b32 %0, -1, %0" : "=v"(F.lane));
                    mem_wg_task(F, t, Ly, HID, ldp, NSA_QM);
                }
            PH_END
        }
        PH_BEGIN(12) { pg8::Gemm g{Yb, WB + WB_WO, MTOK, DM, DM}; pg8::StaticOrder S; S.init(MTOK, DM, F.G, (int)blockIdx.x);
            pg8::EpiResid E{XB, XB, nullptr, PART, dry ? 0.f : 1.0f};
            pg8::gemm_phase<pg8::EpiResid, pg8::StaticOrder, true, true>(ring, g, S, E, F.wave); } PH_END
        PH_BEGIN(13) { pg8::Gemm g{XB, WB + WB_W1B, MTOK, 2 * FF, DM}; pg8::StaticOrder S; S.init(MTOK, 2 * FF, F.G, (int)blockIdx.x);
            pg8::EpiSwiglu E{HID, FF, PART, dry ? DRY_MODE : 0};
            pg8::gemm_phase<pg8::EpiSwiglu, pg8::StaticOrder, true, true>(ring, g, S, E, F.wave); } PH_END
        PH_BEGIN(14) { pg8::Gemm g{HID, WB + WB_W2B, MTOK, DM, FF}; pg8::StaticOrder S; S.init(MTOK, DM, F.G, (int)blockIdx.x);
            pg8::EpiResid E{XB, XB, Ly == DEPTH - 1 ? F.out : nullptr, PART, dry ? 0.f : 0.5f};
            pg8::gemm_phase<pg8::EpiResid, pg8::StaticOrder, true, true>(ring, g, S, E, F.wave); } PH_END_(Ly == DEPTH - 1)
    }
#undef XB
#undef VTB
#undef Yb
#undef HID
#undef PART
#undef WB
#undef PH_BEGIN
#undef PH_END
#undef PH_END_
}

constexpr int LDS_BYTES = 147456;
#ifndef MK_PER_PHASE
#define MK_PER_PHASE 0
#endif
typedef void (*kern_t)(Args);
template <unsigned M> static kern_t kern_of() { return mk_fwd<M>; }
#if MK_PER_PHASE
static kern_t phase_kernel(int id) {
    switch (id) {
        case 0: return kern_of<1u << 0>(); case 1: return kern_of<1u << 1>(); case 2: return kern_of<1u << 2>(); case 3: return kern_of<1u << 3>(); case 4: return kern_of<1u << 4>();
        case 5: return kern_of<1u << 5>(); case 6: return kern_of<1u << 6>(); case 7: return kern_of<1u << 7>(); case 8: return kern_of<1u << 8>(); case 9: return kern_of<1u << 9>();
        case 10: return kern_of<1u << 10>(); case 11: return kern_of<1u << 11>(); case 12: return kern_of<1u << 12>(); case 13: return kern_of<1u << 13>(); default: return kern_of<1u << 14>();
    }
}
#endif
extern "C" void kernel_launch(void* const* d_in, const int* in_sizes, int n_in, void* d_out, int out_size, void* d_ws, size_t ws_size, hipStream_t stream) {
    static int grid = 0;
    if (grid == 0) {
        if (n_in != 23 || out_size != MTOK * DM || ws_size < WS_END) { fprintf(stderr, "kernel_launch: unexpected shapes (n_in %d, out %d, ws %zu)\n", n_in, out_size, ws_size); grid = -1; return; }
        int dev = 0, cus = 0;
        if (hipGetDevice(&dev) != hipSuccess || hipDeviceGetAttribute(&cus, hipDeviceAttributeMultiprocessorCount, dev) != hipSuccess) { grid = -1; return; }
#if MK_PER_PHASE
        for (int id = 0; id < 15; ++id) if (hipFuncSetAttribute((const void*)phase_kernel(id), hipFuncAttributeMaxDynamicSharedMemorySize, LDS_BYTES) != hipSuccess) { fprintf(stderr, "kernel_launch: hipFuncSetAttribute failed\n"); grid = -1; return; }
#else
        if (hipFuncSetAttribute((const void*)kern_of<0xffffffffu>(), hipFuncAttributeMaxDynamicSharedMemorySize, LDS_BYTES) != hipSuccess) { fprintf(stderr, "kernel_launch: hipFuncSetAttribute failed\n"); grid = -1; return; }
#endif
        (void)hipGetLastError();
        grid = cus;
    }
    if (grid < 0) return;
    if (hipMemsetAsync((char*)d_ws + WS_CTL, 0, CTL_ZERO_BYTES, stream) != hipSuccess) return;
    Args a{};
    for (int i = 0; i < 23; ++i) a.in[i] = (const float*)d_in[i];
    a.out = (float*)d_out; a.ws = (unsigned char*)d_ws;
    constexpr int NPH = 2 + 8 * DEPTH + 2;
#if MK_PER_PHASE
    int ids[NPH]; int n = 0; ids[n++] = 0; ids[n++] = 1;
    for (int ly = 0; ly < DEPTH; ++ly) { ids[n++] = 3; ids[n++] = 4; ids[n++] = 5; ids[n++] = 6;
        if (ly % 3 == 0) ids[n++] = 7; else if (ly % 3 == 1) { ids[n++] = 8; ids[n++] = 9; ids[n++] = 10; } else ids[n++] = 11;
        ids[n++] = 12; ids[n++] = 13; ids[n++] = 14; }
    for (int p = 0; p < NPH; ++p) { a.ph_lo = p; a.ph_hi = p + 1;
#if PROBE_DUP
        if ((PROBE_DUP >> ids[p]) & 1) {
            a.dry = 1; hipLaunchKernelGGL(phase_kernel(ids[p]), dim3(grid), dim3(NWAVES * 64), LDS_BYTES, stream, a); a.dry = 0;
            hipMemsetAsync((char*)d_ws + WS_CTL + CW_Q * 4, 0, 64 * 4 * 64, stream); }
#endif
        hipLaunchKernelGGL(phase_kernel(ids[p]), dim3(grid), dim3(NWAVES * 64), LDS_BYTES, stream, a);
#if PROBE_EMPTY
        if (p == 1) for (int e = 0; e < PROBE_EMPTY; ++e) hipLaunchKernelGGL(phase_kernel(2), dim3(grid), dim3(NWAVES * 64), LDS_BYTES, stream, a);
#endif
    }
#else
    a.ph_lo = 0; a.ph_hi = NPH; hipLaunchKernelGGL(kern_of<0xffffffffu>(), dim3(grid), dim3(NWAVES * 64), LDS_BYTES, stream, a);
#endif
}
```

```cpp
#include <hip/hip_runtime.h>
#include <cstdio>
#include <cstdint>
namespace pg8 {
#define PG8_LAS __attribute__((address_space(3)))
typedef unsigned short bf16_t;
typedef short bf16x8 __attribute__((ext_vector_type(8)));
typedef float f32x4 __attribute__((ext_vector_type(4)));
typedef unsigned u32x4 __attribute__((ext_vector_type(4)));
constexpr int BM = 256, BK = 64, HALF = 128, HTB = HALF * BK * 2  , STAGE_BYTES = 8 * HTB, NXCD = 8, WGM = 8;

__host__ __device__ __forceinline__ int lds_byte(int r, int c) { const int st = (r >> 4) * 2 + (c >> 5), rr = r & 15, cc = c & 31, ob = rr * 64 + cc * 2; return st * 1024 + (ob ^ (((ob >> 9) & 1) << 5)); }
__host__ __device__ __forceinline__ void stage_rc(int b, int& R, int& C) { const int st = b / 1024, sb = b % 1024, swz = sb ^ (((sb >> 9) & 1) << 5); R = (st >> 1) * 16 + swz / 64; C = (st & 1) * 32 + (swz % 64) / 2; }
__host__ __device__ __forceinline__ int perm32(int rho) { const int n = rho >> 4, i = rho & 15; return 8 * (i >> 2) + 4 * n + (i & 3); }

struct Unit { int pm, pn; };
struct Gemm { const bf16_t* A; const bf16_t* Bt; int M, N, K; };

struct StaticOrder {
    int nM, nN, nwg, G, c;
    __host__ __device__ void init(int M, int N, int G_, int c_) { nM = M / BM; nN = N / BM; nwg = nM * nN; G = G_; c = c_; }
    __host__ __device__ __forceinline__ bool next(int i, Unit& u) const {
        const long L = (long)i * G + c; if (L >= nwg) return false;
        int wgid = (int)L; { const int q = nwg / NXCD, r = nwg % NXCD, xcd = wgid % NXCD, off = wgid / NXCD; wgid = (xcd < r ? xcd * (q + 1) : r * (q + 1) + (xcd - r) * q) + off; }
        const int nig = WGM * nN, gid = wgid / nig, fm = gid * WGM, gsz = (nM - fm) < WGM ? (nM - fm) : WGM;
        u.pm = fm + ((wgid % nig) % gsz); u.pn = (wgid % nig) / gsz; return true;
    }
    __device__ __forceinline__ void a_ready(const Unit&) const {}
    __device__ __forceinline__ void done(const Unit&) const {}
};

__device__ __forceinline__ int lane_now() { int l; asm volatile("v_mbcnt_lo_u32_b32 %0, -1, 0\n\tv_mbcnt_hi_u32_b32 %0, -1, %0" : "=v"(l)); return l; }
__device__ __forceinline__ float shfl_idx_(float v, int src) { return __builtin_bit_cast(float, __builtin_amdgcn_ds_bpermute(src << 2, __builtin_bit_cast(int, v))); }
__device__ __forceinline__ int shfl_idx_(int v, int src) { return __builtin_amdgcn_ds_bpermute(src << 2, v); }
__device__ __forceinline__ unsigned shfl_idx_(unsigned v, int src) { return (unsigned)__builtin_amdgcn_ds_bpermute(src << 2, (int)v); }
#define __shfl_xor(v, o) pg8::shfl_idx_((v), pg8::lane_now() ^ (o))
#define __shfl(v, src) pg8::shfl_idx_((v), (src))
#define __shfl_down(v, o) pg8::shfl_idx_((v), pg8::lane_now() + (o))
#define __shfl_up(v, o) pg8::shfl_idx_((v), pg8::lane_now() - (o))
#define PG8_GAS __attribute__((address_space(1)))
typedef float f32x2_cv __attribute__((ext_vector_type(2))); typedef __bf16 bf16x2_cv __attribute__((ext_vector_type(2)));
__device__ __forceinline__ unsigned cvt_pk_bf16(float lo, float hi) { f32x2_cv v = {lo, hi}; bf16x2_cv b = __builtin_convertvector(v, bf16x2_cv); return __builtin_bit_cast(unsigned, b); }
constexpr float RMS_EPS = 1e-6f;
__device__ __forceinline__ void rows_rs(const float* part, int row0, int fq, float (&rs)[2][4]) {
    f32x4 pr[2][4];
#pragma unroll
    for (int ai = 0; ai < 2; ++ai)
#pragma unroll
        for (int m = 0; m < 4; ++m) pr[ai][m] = *(const PG8_GAS f32x4*)(part + (size_t)(row0 + ai * HALF + m * 16) * 16 + 4 * fq);
#pragma unroll
    for (int ai = 0; ai < 2; ++ai)
#pragma unroll
        for (int m = 0; m < 4; ++m) { float s = (pr[ai][m][0] + pr[ai][m][1]) + (pr[ai][m][2] + pr[ai][m][3]); s += __shfl_xor(s, 16); s += __shfl_xor(s, 32);
            rs[ai][m] = __builtin_amdgcn_rsqf(s * (1.0f / 1024.0f) + RMS_EPS); }
}
__device__ __forceinline__ void rows_rs_lds(const PG8_LAS float* rsl, int wr, int fr, float (&rs)[2][4]) {
#pragma unroll
    for (int ai = 0; ai < 2; ++ai)
#pragma unroll
        for (int m = 0; m < 4; ++m) rs[ai][m] = rsl[ai * HALF + wr * 64 + m * 16 + fr];
}
__device__ __forceinline__ void rs_fill(PG8_LAS float* rsl, const float* part, int pmA, int pmB, int tid) {
    const int r = tid & 255, pm = (tid >> 8) ? pmB : pmA;
    const PG8_GAS f32x4* p = (const PG8_GAS f32x4*)(part + (size_t)(pm * BM + r) * 16);
    const f32x4 a = p[0], b = p[1], c = p[2], d = p[3];
    const float s = (((a[0] + a[1]) + (a[2] + a[3])) + ((b[0] + b[1]) + (b[2] + b[3]))) + (((c[0] + c[1]) + (c[2] + c[3])) + ((d[0] + d[1]) + (d[2] + d[3])));
    rsl[tid] = __builtin_amdgcn_rsqf(s * (1.0f / 1024.0f) + RMS_EPS);
}
__device__ __forceinline__ float silu_mul(float g, float u) { return g * u * __builtin_amdgcn_rcpf(1.0f + __builtin_amdgcn_exp2f(-1.4426950408889634f * g)); }
struct EpiSwiglu {
    static constexpr bool PERM = true, AFTER_DRAIN = false; static constexpr int NST = 8;
    bf16_t* H; int ldh; const float* part; int dmode;
    const PG8_LAS float* rsl;
    __device__ __forceinline__ void prefill(int tid) const { if (rsl) { int bi = (int)blockIdx.x; asm volatile("" : "+s"(bi)); const int pmA = 16 * (bi & 7) + ((bi >> 3) & 7); rs_fill((PG8_LAS float*)rsl, part, pmA, pmA + 8, tid); } }
    __device__ __forceinline__ void operator()(const f32x4 (&acc)[2][2][4][2], const Unit& u, int wr, int wc, int fr_, int fq_) const {
        int le_; asm volatile("v_mbcnt_lo_u32_b32 %0, -1, 0\n\tv_mbcnt_hi_u32_b32 %0, -1, %0" : "=v"(le_)); const int fr = le_ & 15, fq = le_ >> 4;
        const int row0 = u.pm * BM + wr * 64 + fr, col0 = u.pn * HALF + wc * 32 + 8 * fq;
        float rsv[2][4];
        if (rsl) rows_rs_lds(rsl + ((u.pm & 8) ? BM : 0), wr, fr, rsv); else rows_rs(part, row0, fq, rsv);
#pragma unroll
        for (int ai = 0; ai < 2; ++ai)
#pragma unroll
            for (int m = 0; m < 4; ++m) { const int row = row0 + ai * HALF + m * 16; const float rs = rsv[ai][m];
                const float nrs = -1.4426950408889634f * rs, rs2 = rs * rs;
                const f32x4 g0 = acc[ai][0][m][0], g1 = acc[ai][0][m][1], u0 = acc[ai][1][m][0], u1 = acc[ai][1][m][1];
                float gg[8] = {g0[0], g0[1], g0[2], g0[3], g1[0], g1[1], g1[2], g1[3]}, uu[8] = {u0[0], u0[1], u0[2], u0[3], u1[0], u1[1], u1[2], u1[3]}, ee[8];
#pragma unroll
                for (int j = 0; j < 8; ++j) ee[j] = gg[j] * nrs;
#pragma unroll
                for (int j = 0; j < 8; ++j) ee[j] = __builtin_amdgcn_exp2f(ee[j]);
#pragma unroll
                for (int j = 0; j < 8; ++j) { ee[j] += 1.0f; gg[j] = gg[j] * uu[j]; }
#pragma unroll
                for (int j = 0; j < 8; ++j) ee[j] = __builtin_amdgcn_rcpf(ee[j]);
#pragma unroll
                for (int j = 0; j < 8; ++j) gg[j] = gg[j] * rs2 * ee[j];
                u32x4 w; w.x = cvt_pk_bf16(gg[0], gg[1]); w.y = cvt_pk_bf16(gg[2], gg[3]); w.z = cvt_pk_bf16(gg[4], gg[5]); w.w = cvt_pk_bf16(gg[6], gg[7]);
                *(PG8_GAS u32x4*)(H + (size_t)row * ldh + col0) = w; }
    }
};
struct EpiScale {
    static constexpr bool PERM = true, AFTER_DRAIN = false; static constexpr int NST = 16;
    bf16_t* O; int ldc; const float* part; const PG8_LAS float* rsl;
    __device__ __forceinline__ void prefill(int tid) const { if (rsl) { int bi = (int)blockIdx.x; asm volatile("" : "+s"(bi)); const int pmA = 16 * (bi & 7) + ((bi >> 3) & 7); rs_fill((PG8_LAS float*)rsl, part, pmA, pmA + 8, tid); } }
    __device__ __forceinline__ void operator()(const f32x4 (&acc)[2][2][4][2], const Unit& u, int wr, int wc, int fr_, int fq_) const {
        int le_; asm volatile("v_mbcnt_lo_u32_b32 %0, -1, 0\n\tv_mbcnt_hi_u32_b32 %0, -1, %0" : "=v"(le_)); const int fr = le_ & 15, fq = le_ >> 4;
        const int row0 = u.pm * BM + wr * 64 + fr, col0 = u.pn * BM + wc * 32 + 8 * fq;
        float rsv[2][4];
        if (rsl) rows_rs_lds(rsl + ((u.pm & 8) ? BM : 0), wr, fr, rsv); else rows_rs(part, row0, fq, rsv);
#pragma unroll
        for (int ai = 0; ai < 2; ++ai)
#pragma unroll
            for (int m = 0; m < 4; ++m) { const int row = row0 + ai * HALF + m * 16; const float rs = rsv[ai][m]; bf16_t* rowp = O + (size_t)row * ldc + col0;
#pragma unroll
                for (int bj = 0; bj < 2; ++bj) { const f32x4 v0 = acc[ai][bj][m][0] * rs, v1 = acc[ai][bj][m][1] * rs;
                    u32x4 w; w.x = cvt_pk_bf16(v0[0], v0[1]); w.y = cvt_pk_bf16(v0[2], v0[3]); w.z = cvt_pk_bf16(v1[0], v1[1]); w.w = cvt_pk_bf16(v1[2], v1[3]);
                    *(PG8_GAS u32x4*)(rowp + bj * HALF) = w; } }
    }
};
struct EpiResid {
    static constexpr bool PERM = true, AFTER_DRAIN = false; static constexpr int NST = 24;
    const bf16_t* base; bf16_t* xb; float* out; float* part_out; float coef;
    __device__ __forceinline__ void prefill(int) const {}
    __device__ __forceinline__ void operator()(const f32x4 (&acc)[2][2][4][2], const Unit& u, int wr, int wc, int fr_, int fq_) const {
        int le_; asm volatile("v_mbcnt_lo_u32_b32 %0, -1, 0\n\tv_mbcnt_hi_u32_b32 %0, -1, %0" : "=v"(le_)); const int fr = le_ & 15, fq = le_ >> 4;
        const int row0 = u.pm * BM + wr * 64 + fr, col0 = u.pn * BM + wc * 32 + 8 * fq;
        u32x4 bs[2][4][2];
#pragma unroll
        for (int ai = 0; ai < 2; ++ai)
#pragma unroll
            for (int m = 0; m < 4; ++m)
#pragma unroll
                for (int bj = 0; bj < 2; ++bj) bs[ai][m][bj] = *(const PG8_GAS u32x4*)(base + (size_t)(row0 + ai * HALF + m * 16) * 1024 + col0 + bj * HALF);
#pragma unroll
        for (int ai = 0; ai < 2; ++ai)
#pragma unroll
            for (int m = 0; m < 4; ++m) { const int row = row0 + ai * HALF + m * 16; const size_t off = (size_t)row * 1024 + col0; float ss = 0.f;
#pragma unroll
                for (int bj = 0; bj < 2; ++bj) { const u32x4 b = bs[ai][m][bj];
                    const f32x4 b0 = {__builtin_bit_cast(float, b.x << 16), __builtin_bit_cast(float, b.x & 0xffff0000u), __builtin_bit_cast(float, b.y << 16), __builtin_bit_cast(float, b.y & 0xffff0000u)};
                    const f32x4 b1 = {__builtin_bit_cast(float, b.z << 16), __builtin_bit_cast(float, b.z & 0xffff0000u), __builtin_bit_cast(float, b.w << 16), __builtin_bit_cast(float, b.w & 0xffff0000u)};
                    const f32x4 v0 = b0 + acc[ai][bj][m][0] * coef, v1 = b1 + acc[ai][bj][m][1] * coef;
                    if (out) { *(PG8_GAS f32x4*)(out + off + bj * HALF) = v0; *(PG8_GAS f32x4*)(out + off + bj * HALF + 4) = v1; }
                    u32x4 w; w.x = cvt_pk_bf16(v0[0], v0[1]); w.y = cvt_pk_bf16(v0[2], v0[3]); w.z = cvt_pk_bf16(v1[0], v1[1]); w.w = cvt_pk_bf16(v1[2], v1[3]);
                    *(PG8_GAS u32x4*)(xb + off + bj * HALF) = w;
                    ss += (v0[0] * v0[0] + v0[1] * v0[1]) + (v0[2] * v0[2] + v0[3] * v0[3]) + (v1[0] * v1[0] + v1[1] * v1[1]) + (v1[2] * v1[2] + v1[3] * v1[3]); }
                ss += __shfl_xor(ss, 16); ss += __shfl_xor(ss, 32);
                if (fq == 0) *(PG8_GAS float*)(part_out + (size_t)row * 16 + u.pn * 4 + wc) = ss; }
    }
};
template <class Epi, class Sched, bool ALIGN_EPI = false, bool SP2 = false>
__device__ __forceinline__ void gemm_phase(PG8_LAS unsigned char* lds, const Gemm g, const Sched& S, const Epi& E, int wave_id) {
    int lane_; asm volatile("v_mbcnt_lo_u32_b32 %0, -1, 0\n\tv_mbcnt_hi_u32_b32 %0, -1, %0" : "=v"(lane_));
    const int wid = wave_id, lane = lane_, tid = wid * 64 + lane, wr = wid >> 2, wc = wid & 3, fr = lane & 15, fq = lane >> 4;
    const int K = g.K, nt = K / BK;
    unsigned voffA[2], voffB[2];
#pragma unroll
    for (int i = 0; i < 2; ++i) { int R, C; stage_rc(tid * 16 + i * 8192, R, C); const int Rb = Epi::PERM ? ((R & ~31) + perm32(R & 31)) : R;
        voffA[i] = (unsigned)(R * K + C) * 2u; voffB[i] = (unsigned)(Rb * K + C) * 2u; }
    const size_t kstep = (size_t)(BK * 2);
    const size_t hstep = (size_t)HALF * K * 2;
    const size_t tstep = 2 * hstep;
    const unsigned ldsw = (unsigned)wid * 1024u;
    const int aoff = lds_byte(wr * 64 + fr, fq * 8), boff = lds_byte(wc * 32 + fr, fq * 8);
#define PG8_SA(b, h) (((b) * 2 + (h)) * HTB)
#define PG8_SB(b, h) ((4 + (b) * 2 + (h)) * HTB)
#define PG8_STAGE(bufoff, gbase, voff) do { _Pragma("unroll") for (int _i = 0; _i < 2; ++_i) \
        __builtin_amdgcn_global_load_lds((const unsigned*)((const char*)(gbase) + (voff)[_i]), (PG8_LAS unsigned*)(lds + (bufoff) + ldsw + _i * 8192), 16, 0, 0); } while (0)
#define PG8_LDA(dst, b, h) do { _Pragma("unroll") for (int m = 0; m < 4; ++m) _Pragma("unroll") for (int k = 0; k < 2; ++k) dst[m][k] = *(const PG8_LAS bf16x8*)(lds + PG8_SA(b, h) + aoff + m * 2048 + k * 1024); } while (0)
#define PG8_LDB(dst, b, h) do { _Pragma("unroll") for (int n = 0; n < 2; ++n) _Pragma("unroll") for (int k = 0; k < 2; ++k) dst[n][k] = *(const PG8_LAS bf16x8*)(lds + PG8_SB(b, h) + boff + n * 2048 + k * 1024); } while (0)
#define PG8_MMA(ai, bj, At, Bt) do { __builtin_amdgcn_s_setprio(1); _Pragma("unroll") for (int m = 0; m < 4; ++m) _Pragma("unroll") for (int n = 0; n < 2; ++n) _Pragma("unroll") for (int k = 0; k < 2; ++k) \
        acc[ai][bj][m][n] = __builtin_amdgcn_mfma_f32_16x16x32_bf16(Bt[n][k], At[m][k], acc[ai][bj][m][n], 0, 0, 0); __builtin_amdgcn_s_setprio(0); } while (0)
#define PG8_WAIT_V(n) asm volatile("s_waitcnt vmcnt(" #n ")" ::: "memory")
#define PG8_WAIT_VI(n) asm volatile("s_waitcnt vmcnt(%0)" :: "n"(n) : "memory")
#define PG8_WAIT_L(n) asm volatile("s_waitcnt lgkmcnt(" #n ")" ::: "memory")
#define PG8_BAR __builtin_amdgcn_s_barrier()
#define PG8_SCHED __builtin_amdgcn_sched_barrier(0)
    Unit cur, nxt; int ui = 0;
    if (!S.next(0, cur)) return;
    f32x4 acc[2][2][4][2];
#pragma unroll
    for (int a = 0; a < 2; ++a)
#pragma unroll
        for (int b = 0; b < 2; ++b)
#pragma unroll
            for (int m = 0; m < 4; ++m)
#pragma unroll
                for (int n = 0; n < 2; ++n) acc[a][b][m][n] = (f32x4){0.f, 0.f, 0.f, 0.f};
    bf16x8 At[4][2], B0[2][2], B1[2][2];
    const char* cA = (const char*)g.A + (size_t)cur.pm * tstep; const char* cB = (const char*)g.Bt + (size_t)cur.pn * tstep;
    S.a_ready(cur);
    if constexpr (SP2) {
        PG8_STAGE(PG8_SB(0, 0), cB, voffB); PG8_STAGE(PG8_SB(0, 1), cB + hstep, voffB); PG8_STAGE(PG8_SA(0, 0), cA, voffA); PG8_STAGE(PG8_SA(0, 1), cA + hstep, voffA);
        E.prefill(tid);
        if (wr == 1) PG8_BAR;
        PG8_WAIT_V(2); PG8_BAR;
        PG8_STAGE(PG8_SB(1, 0), cB + kstep, voffB); PG8_STAGE(PG8_SA(1, 0), cA + kstep, voffA); PG8_STAGE(PG8_SB(1, 1), cB + hstep + kstep, voffB);
        PG8_WAIT_V(6); PG8_BAR;
    } else {
        PG8_STAGE(PG8_SB(0, 0), cB, voffB); PG8_STAGE(PG8_SA(0, 0), cA, voffA); PG8_STAGE(PG8_SB(0, 1), cB + hstep, voffB); PG8_STAGE(PG8_SA(0, 1), cA + hstep, voffA);
        if (wr == 1) PG8_BAR;
        PG8_WAIT_V(4); PG8_BAR;
        PG8_STAGE(PG8_SB(1, 0), cB + kstep, voffB); PG8_STAGE(PG8_SA(1, 0), cA + kstep, voffA); PG8_STAGE(PG8_SB(1, 1), cB + hstep + kstep, voffB);
        PG8_WAIT_V(6); PG8_BAR;
    }
    for (;;) {
        const bool has_next = S.next(ui + 1, nxt);
        const char* nA = has_next ? (const char*)g.A + (size_t)nxt.pm * tstep : cA; const char* nB = has_next ? (const char*)g.Bt + (size_t)nxt.pn * tstep : cB;
        for (int t = 0; t < nt; t += 2) {
            const bool last = (t == nt - 2);
            const char* a1 = cA + (size_t)(t + 1) * kstep;
            const char* a2 = last ? nA : cA + (size_t)(t + 2) * kstep; const char* b2 = last ? nB : cB + (size_t)(t + 2) * kstep;
            const char* a3 = a2 + kstep; const char* b3 = b2 + kstep;
            if (last && has_next) S.a_ready(nxt);
            if constexpr (SP2) {
            const bool post_epi = Epi::NST > 0 && t == 0 && ui > 0;
            const int pe_ = __builtin_amdgcn_readfirstlane(post_epi ? 1 : 0);
#define PG8_WAIT_V1() asm volatile("s_cmp_eq_u32 %0, 0\n\ts_cbranch_scc1 .Lpg8wa_%=\n\ts_waitcnt vmcnt(%1)\n\ts_branch .Lpg8wb_%=\n.Lpg8wa_%=:\n\ts_waitcnt vmcnt(8)\n.Lpg8wb_%=:" :: "s"(pe_), "n"(8 + Epi::NST) : "memory", "scc")
            PG8_LDB(B0, 0, 0); PG8_LDB(B1, 0, 1); PG8_SCHED; PG8_LDA(At, 0, 0); PG8_STAGE(PG8_SA(1, 1), a1 + hstep, voffA);
            PG8_WAIT_V1(); PG8_WAIT_L(0); PG8_BAR; PG8_MMA(0, 0, At, B0); PG8_MMA(0, 1, At, B1); PG8_BAR; PG8_SCHED;
            PG8_LDA(At, 0, 1); PG8_STAGE(PG8_SB(0, 0), b2, voffB); PG8_STAGE(PG8_SB(0, 1), b2 + hstep, voffB); PG8_STAGE(PG8_SA(0, 0), a2, voffA);
            PG8_WAIT_V1(); PG8_WAIT_L(0); PG8_BAR; PG8_MMA(1, 0, At, B0); PG8_MMA(1, 1, At, B1); PG8_BAR; PG8_SCHED;
            PG8_LDB(B0, 1, 0); PG8_LDB(B1, 1, 1); PG8_SCHED; PG8_LDA(At, 1, 0); PG8_STAGE(PG8_SA(0, 1), a2 + hstep, voffA);
            PG8_WAIT_V(8); PG8_WAIT_L(0); PG8_BAR; PG8_MMA(0, 0, At, B0); PG8_MMA(0, 1, At, B1); PG8_BAR; PG8_SCHED;
            PG8_LDA(At, 1, 1); PG8_STAGE(PG8_SB(1, 0), b3, voffB); PG8_STAGE(PG8_SB(1, 1), b3 + hstep, voffB); PG8_STAGE(PG8_SA(1, 0), a3, voffA);
            PG8_WAIT_V(8); PG8_WAIT_L(0); PG8_BAR; PG8_MMA(1, 0, At, B0); PG8_MMA(1, 1, At, B1); PG8_BAR; PG8_SCHED;
#undef PG8_WAIT_V1
            } else {
            PG8_LDB(B0, 0, 0); PG8_SCHED; PG8_LDA(At, 0, 0); PG8_STAGE(PG8_SA(1, 1), a1 + hstep, voffA);
            PG8_WAIT_L(8); PG8_BAR; PG8_WAIT_L(0); PG8_MMA(0, 0, At, B0); PG8_BAR; PG8_SCHED;
            PG8_LDB(B1, 0, 1); PG8_STAGE(PG8_SB(0, 0), b2, voffB);
            PG8_BAR; PG8_WAIT_L(0); PG8_MMA(0, 1, At, B1); PG8_BAR;
            PG8_LDA(At, 0, 1); PG8_STAGE(PG8_SA(0, 0), a2, voffA);
            PG8_BAR; PG8_WAIT_L(0); PG8_MMA(1, 0, At, B0); PG8_BAR; PG8_SCHED;
            PG8_STAGE(PG8_SB(0, 1), b2 + hstep, voffB);
            PG8_WAIT_V(6); PG8_BAR; PG8_MMA(1, 1, At, B1); PG8_BAR;
            PG8_LDB(B0, 1, 0); PG8_SCHED; PG8_LDA(At, 1, 0); PG8_STAGE(PG8_SA(0, 1), a2 + hstep, voffA);
            PG8_WAIT_L(8); PG8_BAR; PG8_WAIT_L(0); PG8_MMA(0, 0, At, B0); PG8_BAR; PG8_SCHED;
            PG8_LDB(B1, 1, 1); PG8_STAGE(PG8_SB(1, 0), b3, voffB);
            PG8_BAR; PG8_WAIT_L(0); PG8_MMA(0, 1, At, B1); PG8_BAR;
            PG8_LDA(At, 1, 1); PG8_STAGE(PG8_SA(1, 0), a3, voffA);
            PG8_BAR; PG8_WAIT_L(0); PG8_MMA(1, 0, At, B0); PG8_BAR; PG8_SCHED;
            PG8_STAGE(PG8_SB(1, 1), b3 + hstep, voffB);
            PG8_WAIT_V(6); PG8_BAR; PG8_MMA(1, 1, At, B1); PG8_BAR;
            }
        }
        if constexpr (ALIGN_EPI) { if (wr == 0) PG8_BAR; }
        if constexpr (!Epi::AFTER_DRAIN) { E(acc, cur, wr, wc, fr, fq); S.done(cur); }
        if (!has_next) break;
#pragma unroll
        for (int a = 0; a < 2; ++a)
#pragma unroll
            for (int b = 0; b < 2; ++b)
#pragma unroll
                for (int m = 0; m < 4; ++m)
#pragma unroll
                    for (int n = 0; n < 2; ++n) acc[a][b][m][n] = (f32x4){0.f, 0.f, 0.f, 0.f};
        cur = nxt; cA = nA; cB = nB; ++ui;
        if constexpr (ALIGN_EPI) { if (wr == 1) PG8_BAR; }
    }
    PG8_WAIT_V(0);
    if constexpr (!ALIGN_EPI) { if (wr == 0) PG8_BAR; }
    PG8_BAR;
    if constexpr (Epi::AFTER_DRAIN) { E.fused(acc, cur, wr, wc, fr, fq, lds, wid, lane); S.done(cur); }
#undef PG8_SA
#undef PG8_SB
#undef PG8_STAGE
#undef PG8_LDA
#undef PG8_LDB
#undef PG8_MMA
#undef PG8_WAIT_V
#undef PG8_WAIT_VI
#undef PG8_WAIT_L
#undef PG8_BAR
#undef PG8_SCHED
}
}
#define LAS __attribute__((address_space(3)))
#define XB_TMO      128
#define XB_XCNT(j)  (256  + 64 * (j))
#define XB_XSUB(j)  (1280 + 64 * (j))
#define XB_XGEN(j)  (2304 + 64 * (j))
#define XB_TOP      3328
#define XB_TOPGEN   3392
#define XCD_BAR_WORDS 3456
#define XB_SPIN_CAP (1u << 18)

__device__ __forceinline__ unsigned xb_ld(unsigned* p)              { return __hip_atomic_load(p, __ATOMIC_RELAXED, __HIP_MEMORY_SCOPE_AGENT); }
__device__ __forceinline__ unsigned xb_add(unsigned* p, unsigned v) { return __hip_atomic_fetch_add(p, v, __ATOMIC_RELAXED, __HIP_MEMORY_SCOPE_AGENT); }
__device__ __forceinline__ unsigned xb_xcc_id() { return (unsigned)__builtin_amdgcn_s_getreg((3 << 11) | 20) & 0xFu; }
#define XB_SPIN(cond, bar) do { unsigned _sp = 0; while (cond) { __builtin_amdgcn_s_sleep(1); \
    if ((++_sp & 255u) == 0u) { if (xb_ld(&(bar)[XB_TMO])) break; if (_sp > XB_SPIN_CAP) { atomicAdd(&(bar)[XB_TMO], 1u); break; } } } } while (0)

struct XcdBarrier {
    unsigned* bar; unsigned x;
    volatile LAS unsigned* st;
};

__device__ __forceinline__ XcdBarrier xcd_barrier_post(unsigned* bar, volatile LAS unsigned* st) {
    XcdBarrier b; b.bar = bar; b.x = xb_xcc_id(); b.st = st;
    if (threadIdx.x == 0) (void)xb_add(&bar[XB_XCNT(b.x)], 1u);
    return b;
}
__device__ __forceinline__ void xcd_barrier_complete(unsigned* bar, unsigned x, unsigned& nloc, unsigned& nx) {
    const unsigned G = gridDim.x * gridDim.y * gridDim.z;
    unsigned sum, cnt, mine, sp = 0u;
    for (;;) {
        sum = 0u; cnt = 0u; mine = 0u;
#pragma unroll
        for (unsigned j = 0; j < 16; ++j) { const unsigned c = xb_ld(&bar[XB_XCNT(j)]); sum += c; cnt += (c > 0u) ? 1u : 0u; mine = (j == x) ? c : mine; }
        if (sum == G) break;
        __builtin_amdgcn_s_sleep(1);
        if ((++sp & 255u) == 0u) { if (xb_ld(&bar[XB_TMO])) break; if (sp > XB_SPIN_CAP) { atomicAdd(&bar[XB_TMO], 1u); break; } }
    }
    nloc = mine > 0u ? mine : 1u; nx = cnt > 0u ? cnt : 1u;
}

__device__ __forceinline__ void xcd_barrier(const XcdBarrier& b) {
    asm volatile("s_waitcnt vmcnt(0)" ::: "memory");
    __syncthreads();
    if (threadIdx.x == 0) {
        unsigned* bar = b.bar;
        __builtin_amdgcn_s_waitcnt(0);
        unsigned nloc = b.st[0], nx = b.st[1];
        if (nloc == 0u) { xcd_barrier_complete(bar, b.x, nloc, nx); b.st[0] = nloc; b.st[1] = nx; }
        const unsigned old = xb_add(&bar[XB_XSUB(b.x)], 1u);
        const unsigned gen = old / nloc;
        if (old + 1u == (gen + 1u) * nloc) {
            __builtin_amdgcn_fence(__ATOMIC_RELEASE, "agent");
            asm volatile("s_waitcnt vmcnt(0)" ::: "memory");
            const unsigned og = xb_add(&bar[XB_TOP], 1u);
            const unsigned tg = og / nx;
            if (og + 1u == (tg + 1u) * nx) xb_add(&bar[XB_TOPGEN], 1u);
            else XB_SPIN(xb_ld(&bar[XB_TOPGEN]) == tg, bar);
            __builtin_amdgcn_fence(__ATOMIC_ACQUIRE, "agent");
            xb_add(&bar[XB_XGEN(b.x)], 1u);
            asm volatile("s_waitcnt vmcnt(0)" ::: "memory");
        } else {
            XB_SPIN(xb_ld(&bar[XB_XGEN(b.x)]) == gen, bar);
            __builtin_amdgcn_fence(__ATOMIC_ACQUIRE, "agent");
            asm volatile("s_waitcnt vmcnt(0)" ::: "memory");
        }
    }
    __syncthreads();
}
#undef LAS
#ifndef RET_MODE
#define RET_MODE 1
#endif
#ifndef NSA_INLINE
#define NSA_INLINE __forceinline__
#endif
#ifndef DRY_MODE
#define DRY_MODE 0
#endif
#ifndef WG_SKEW
#define WG_SKEW 0
#endif
#ifndef BAR_EXTRA
#define BAR_EXTRA 0
#endif
#ifndef QF_MEM
#define QF_MEM 0
#endif
#ifndef TM_FENCE
#define TM_FENCE 0
#endif
#ifndef NSA_WG
#define NSA_WG 1
#endif
#ifndef D3_WG
#define D3_WG 1
#endif
#ifndef RET_WG
#define RET_WG 1
#endif
#ifndef PROBE_EMPTY
#define PROBE_EMPTY 0
#endif
#ifndef PROBE_DUP
#define PROBE_DUP 0
#endif
#ifndef DBG_BRUTE
#define DBG_BRUTE 0
#endif
#ifndef DBG_ZERO
#define DBG_ZERO 0
#endif
constexpr int NWAVES = 8;
constexpr int NB = 16, SEQ = 2048, DM = 1024, MTOK = NB * SEQ, FF = 2816, NMEMT = 256, MMEM = NB * NMEMT, DEPTH = 4;
constexpr float EPS = 1e-6f;
constexpr float QSCALE = 0.125f * 1.4426950408889634f;
constexpr int RET_LD = 2560, RET_Q = 0, RET_K = 384, RET_V = 768, RET_G = 1536, RET_QM = 2304;
constexpr int DSA_LD = 1792, DSA_Q = 0, DSA_K = 768, DSA_V = 832, DSA_IQ = 896, DSA_IK = 1408, DSA_IW = 1472, DSA_QM = 1480, DSA_COLS = 1736;
constexpr int NSA_LD = 2816, NSA_Q = 0, NSA_KC = 768, NSA_VC = 1024, NSA_KS = 1280, NSA_VS = 1536, NSA_KW = 1792, NSA_VW = 2048, NSA_QM = 2304, NSA_GT = 2560;
constexpr int NSA_SRC_GT = 2304, NSA_SRC_QM = 2340, NSA_COLS = 2596;

constexpr size_t MiB = 1u << 20;
constexpr size_t WS_CTL = 0, CTL_ZERO_BYTES = 1 * MiB;
constexpr size_t WS_PART = 1 * MiB;
constexpr size_t WS_PARTM = 3 * MiB;
constexpr size_t WS_ROPE = 3 * MiB + 512 * 1024;
constexpr size_t WS_MISC = 4 * MiB;
constexpr size_t WS_CMPW = 4 * MiB + 64 * 1024;
constexpr size_t WS_KCMP = 5 * MiB;
constexpr size_t WS_VCMPT = 6 * MiB;
constexpr size_t WS_MK = 7 * MiB;
constexpr size_t WS_MVT = 15 * MiB;
constexpr size_t WS_MEMB = 23 * MiB;
constexpr size_t WS_MKV = 31 * MiB;
constexpr size_t WS_WKV = 47 * MiB;
constexpr size_t WS_WBUF0 = 51 * MiB, WBUF_BYTES = 41 * MiB;
constexpr size_t WS_XB = 133 * MiB;
constexpr size_t WS_Y = 197 * MiB;
constexpr size_t WS_HID = 261 * MiB;
constexpr size_t WS_SC = 373 * MiB;
constexpr size_t WS_MB = 501 * MiB;
constexpr size_t WS_END = 509 * MiB;
static_assert(WS_HID + (size_t)MTOK * FF * 2 <= WS_MB && WS_SC + (size_t)MTOK * SEQ * 2 <= WS_MB && WS_WBUF0 + 2 * WBUF_BYTES <= WS_XB, "d_ws map");
constexpr size_t WB_W1A = 0, WB_W2A = WB_W1A + (size_t)2 * FF * DM, WB_W1B = WB_W2A + (size_t)DM * FF, WB_W2B = WB_W1B + (size_t)2 * FF * DM,
                 WB_WIN = WB_W2B + (size_t)DM * FF, WB_WO = WB_WIN + (size_t)NSA_LD * DM, WB_END = WB_WO + (size_t)DM * DM;
static_assert(WB_END * 2 <= WBUF_BYTES, "weight buffer");
constexpr int LDS_CTRL = 147456 - 1024;
constexpr int RS_LDS_OFF = 131072;
constexpr int CW_BAR = 4096;
constexpr int CW_CK = 32768;
constexpr int CW_CKP = 65536;
constexpr int CV_SPLIT = 3072;
constexpr int CW_Q = 16384;

#define GAS __attribute__((address_space(1)))
#define LAS __attribute__((address_space(3)))
typedef unsigned short bf16;
typedef unsigned v4u __attribute__((ext_vector_type(4)));
typedef unsigned v2u __attribute__((ext_vector_type(2)));
typedef float f32x4 __attribute__((ext_vector_type(4)));
typedef float f32x16 __attribute__((ext_vector_type(16)));
typedef short bf16x8 __attribute__((ext_vector_type(8)));
typedef GAS unsigned gu32;
#define RLX_AGENT __ATOMIC_RELAXED, __HIP_MEMORY_SCOPE_AGENT
#define LDS_WAIT() asm volatile("s_waitcnt lgkmcnt(0)" ::: "memory")
#define VM_WAIT() asm volatile("s_waitcnt vmcnt(0)" ::: "memory")
__device__ __forceinline__ unsigned f2bf(float f) { unsigned u = __builtin_bit_cast(unsigned, f); return (u + 0x7fffu + ((u >> 16) & 1u)) >> 16; }
__device__ __forceinline__ unsigned pk2(float lo, float hi) { return pg8::cvt_pk_bf16(lo, hi); }
__device__ __forceinline__ float bf2f(unsigned h) { return __builtin_bit_cast(float, h << 16); }
__device__ __forceinline__ float bflo(unsigned w) { return __builtin_bit_cast(float, w << 16); }
__device__ __forceinline__ float bfhi(unsigned w) { return __builtin_bit_cast(float, w & 0xffff0000u); }
struct Args { const float* in[23]; float* out; unsigned char* ws; int ph_lo, ph_hi, dry, pad; };
typedef const __attribute__((address_space(4))) Args* KArgs;
struct Frame {
    LAS unsigned char* lds;
    volatile LAS unsigned* MISC;
    gu32* ctl;
    int tid, lane, wave, G, gw, NGW;
    int cv_lo, cv_hi;
    unsigned char* ws;
    KArgs ka;
    float* out;
};
__device__ __forceinline__ float wave_sum(float v) {
#pragma unroll
    for (int o = 1; o < 64; o <<= 1) v += __shfl_xor(v, o);
    return v;
}
__device__ __forceinline__ float wave_max(float v) {
#pragma unroll
    for (int o = 1; o < 64; o <<= 1) v = fmaxf(v, __shfl_xor(v, o));
    return v;
}
__device__ __forceinline__ int grab(gu32* ctr, int lane) { unsigned v = 0; if (lane == 0) v = __hip_atomic_fetch_add(ctr, 1u, RLX_AGENT); return __builtin_amdgcn_readfirstlane((int)v); }

__device__ __forceinline__ void cvt_item(const float* W, int ldw, const float* gain, bf16* WT, int K, LAS float* scr, int k0, int src_col0, int nvalid, int dst_row0, int lane) {
    const int c = lane & 31;
    float wv[32], gv2[32];
#pragma unroll
    for (int i = 0; i < 32; ++i) { const int kk = 2 * i + (lane >> 5); wv[i] = (c < nvalid) ? W[(size_t)(k0 + kk) * ldw + src_col0 + c] : 0.f; gv2[i] = gain ? gain[k0 + kk] : 1.f; }
#pragma unroll
    for (int i = 0; i < 32; ++i) { const int kk = 2 * i + (lane >> 5); scr[kk * 33 + c] = wv[i] * gv2[i]; }
    LDS_WAIT(); asm volatile("" ::: "memory");
    const int c8 = lane & 7;
#pragma unroll
    for (int j = 0; j < 4; ++j) { const int n = (lane >> 3) + 8 * j; const LAS float* s = scr + (8 * c8) * 33 + n;
        v4u o; o.x = pk2(s[0 * 33], s[1 * 33]); o.y = pk2(s[2 * 33], s[3 * 33]); o.z = pk2(s[4 * 33], s[5 * 33]); o.w = pk2(s[6 * 33], s[7 * 33]);
        *(GAS v4u*)(WT + (size_t)(dst_row0 + n) * K + k0 + 8 * c8) = o; }
    LDS_WAIT(); asm volatile("" ::: "memory");
}
__device__ __forceinline__ void cvt_matrix(Frame& F, int& it_base, const float* W, const float* W2, int ldw, int ncols, const float* gain, bf16* WT, int K, int nrows_dst, int kind) {
    LAS float* scr = (LAS float*)(F.lds + F.wave * 16384);
    const int nkb = K / 64, njb = nrows_dst / 32, nitems = nkb * njb;
    int gw_ = F.gw; asm volatile("" : "+s"(gw_));
    int first = (gw_ - it_base % F.NGW + F.NGW) % F.NGW;
    for (int i = first; i < nitems; i += F.NGW) {
        if (it_base + i < F.cv_lo || it_base + i >= F.cv_hi) continue;
        const int kb = i / njb, jb = i % njb; const float* src = W; int sc0 = jb * 32, nv = 32;
        if (kind == 0) { nv = ncols - sc0; nv = nv < 0 ? 0 : (nv > 32 ? 32 : nv); }
        else if (kind == 1) { const int c = jb * 32, pn = c >> 8, bj = (c >> 7) & 1, j = c & 127; src = bj ? W2 : W; sc0 = pn * 128 + j; }
        else { const int c = jb * 32;
            if (c < NSA_QM) { sc0 = c; }
            else if (c < NSA_GT) { sc0 = NSA_SRC_QM + (c - NSA_QM); }
            else { sc0 = NSA_SRC_GT + (c - NSA_GT); nv = NSA_SRC_QM - sc0; nv = nv < 0 ? 0 : (nv > 32 ? 32 : nv); } }
        cvt_item(src, ldw, gain, WT, K, scr, kb * 64, sc0, nv, jb * 32, F.lane);
    }
    it_base += nitems;
}
__device__ __forceinline__ void convert_layer(Frame& F, int Ly) {
    bf16* WB = (bf16*)(F.ws + WS_WBUF0 + (size_t)(Ly & 1) * WBUF_BYTES);
    const float* fnorm = F.ka->in[2]; const float* wg = F.ka->in[3]; const float* wu = F.ka->in[4]; const float* wd = F.ka->in[5];
    int itb = 0;
#pragma unroll 1
    for (int hf = 0; hf < 2; ++hf) {
        const size_t o1 = (size_t)(Ly * 2 + hf) * DM * FF;
        cvt_matrix(F, itb, wg + o1, wu + o1, FF, FF, fnorm + (size_t)(Ly * 2 + hf) * DM, WB + (hf ? WB_W1B : WB_W1A), DM, 2 * FF, 1);
        cvt_matrix(F, itb, wd + o1, nullptr, DM, DM, nullptr, WB + (hf ? WB_W2B : WB_W2A), FF, DM, 0);
    }
    const float* mnorm = F.ka->in[6] + (size_t)Ly * DM;
    const int kind = Ly % 3, j = Ly / 3;
    if (kind == 0) cvt_matrix(F, itb, F.ka->in[12] + (size_t)j * DM * RET_LD, nullptr, RET_LD, RET_LD, mnorm, WB + WB_WIN, DM, RET_LD, 0);
    else if (kind == 1) cvt_matrix(F, itb, F.ka->in[13] + (size_t)j * DM * DSA_COLS, nullptr, DSA_COLS, DSA_COLS, mnorm, WB + WB_WIN, DM, DSA_LD, 0);
    else cvt_matrix(F, itb, F.ka->in[16] + (size_t)j * DM * NSA_COLS, nullptr, NSA_COLS, NSA_COLS, mnorm, WB + WB_WIN, DM, NSA_LD, 2);
    cvt_matrix(F, itb, F.ka->in[7] + (size_t)Ly * DM * DM, nullptr, DM, DM, nullptr, WB + WB_WO, DM, DM, 0);
}

__device__ __forceinline__ void xform(Frame& F, const bf16* src, int spitch, int scol0, int nheads, int rows, int Lr, bf16* dst, int dmode, int dpitch, int dcol0,
                                      const float* gain, bool rope, float cscale, int decay  ) {
    const float* tab = (const float*)(F.ws + WS_ROPE);
    const int i8 = F.lane & 7, sub = F.lane >> 3; const int items = rows * nheads;
    float gn[8];
#pragma unroll
    for (int j = 0; j < 8; ++j) gn[j] = gain ? gain[8 * i8 + j] : 1.f;
    constexpr int U = 4;
    for (int it0 = F.gw * (8 * U); it0 < items; it0 += F.NGW * (8 * U)) {
        v4u raw[U]; f32x4 c0[U], c1[U], s0[U], s1[U];
#pragma unroll
        for (int u = 0; u < U; ++u) { const int it = it0 + 8 * u + sub; const int row = it / nheads, h = it % nheads, t = row % Lr;
            raw[u] = *(const GAS v4u*)(src + (size_t)row * spitch + scol0 + h * 64 + 8 * i8);
            if (rope) { const float* tr = tab + (size_t)t * 64 + 8 * (i8 & 3);
                c0[u] = *(const GAS f32x4*)(tr); c1[u] = *(const GAS f32x4*)(tr + 4); s0[u] = *(const GAS f32x4*)(tr + 32); s1[u] = *(const GAS f32x4*)(tr + 36); } }
#pragma unroll
        for (int u = 0; u < U; ++u) { const int it = it0 + 8 * u + sub; const int row = it / nheads, h = it % nheads, t = row % Lr;
            float v[8] = {bflo(raw[u].x), bfhi(raw[u].x), bflo(raw[u].y), bfhi(raw[u].y), bflo(raw[u].z), bfhi(raw[u].z), bflo(raw[u].w), bfhi(raw[u].w)};
            if (gain) { float ss = 0.f;
#pragma unroll
                for (int j = 0; j < 8; ++j) ss += v[j] * v[j];
                ss += __shfl_xor(ss, 1); ss += __shfl_xor(ss, 2); ss += __shfl_xor(ss, 4);
                const float r = __builtin_amdgcn_rsqf(ss * (1.f / 64.f) + EPS);
#pragma unroll
                for (int j = 0; j < 8; ++j) v[j] = v[j] * r * gn[j]; }
            if (rope) {
                const float cs[8] = {c0[u][0], c0[u][1], c0[u][2], c0[u][3], c1[u][0], c1[u][1], c1[u][2], c1[u][3]}, sn[8] = {s0[u][0], s0[u][1], s0[u][2], s0[u][3], s1[u][0], s1[u][1], s1[u][2], s1[u][3]};
#pragma unroll
                for (int j = 0; j < 8; ++j) { const float p = __shfl_xor(v[j], 4); v[j] = (i8 < 4) ? (v[j] * cs[j] - p * sn[j]) : (v[j] * cs[j] + p * sn[j]); } }
            float f = cscale;
            if (decay) { const float lg = __builtin_amdgcn_logf(1.0f - __builtin_amdgcn_exp2f(-5.0f - (float)h)); f *= __builtin_amdgcn_exp2f((float)(decay * t) * lg); }
            v4u o; o.x = pk2(v[0] * f, v[1] * f); o.y = pk2(v[2] * f, v[3] * f); o.z = pk2(v[4] * f, v[5] * f); o.w = pk2(v[6] * f, v[7] * f);
            bf16* dp = dmode == 0 ? dst + (size_t)row * dpitch + dcol0 + h * 64 + 8 * i8 : dst + ((size_t)((row / Lr) * nheads + h) * Lr + t) * 64 + 8 * i8;
            *(GAS v4u*)dp = o; }
    }
}
__device__ __forceinline__ void transpose_cols(Frame& F, const bf16* src, int spitch, int scol0, int ncols, int nb, int Lr, bf16* dst) {
    LAS bf16* scr = (LAS bf16*)(F.lds + F.wave * 16384);
    const int ntt = Lr / 64, nct = ncols / 64, ntiles = nb * ntt * nct; const int i8 = F.lane & 7, sub = F.lane >> 3;
    for (int tl = F.gw; tl < ntiles; tl += F.NGW) {
        const int ct = tl % nct, tt = (tl / nct) % ntt, b = tl / (nct * ntt); const int t0 = tt * 64, c0 = ct * 64;
#pragma unroll
        for (int k = 0; k < 8; ++k) { const int r = sub + 8 * k;
            const v4u raw = *(const GAS v4u*)(src + (size_t)(b * Lr + t0 + r) * spitch + scol0 + c0 + 8 * i8);
            *(LAS v4u*)(scr + r * 72 + 8 * i8) = raw; }
        LDS_WAIT(); asm volatile("" ::: "memory");
        bf16* drow = dst + ((size_t)b * ncols + c0 + F.lane) * Lr + t0;
#pragma unroll
        for (int k = 0; k < 8; ++k) { unsigned w[4];
#pragma unroll
            for (int q = 0; q < 4; ++q) { const unsigned lo = scr[(8 * k + 2 * q) * 72 + F.lane], hi = scr[(8 * k + 2 * q + 1) * 72 + F.lane]; w[q] = lo | (hi << 16); }
            v4u o; o.x = w[0]; o.y = w[1]; o.z = w[2]; o.w = w[3]; *(GAS v4u*)(drow + 8 * k) = o; }
        LDS_WAIT(); asm volatile("" ::: "memory");
    }
}
__device__ __forceinline__ void row2_to_bf16(Frame& F, const float* xrow, bf16* orow, float* part, size_t rstep) {
    const GAS f32x4* xr0 = (const GAS f32x4*)xrow + F.lane; const GAS f32x4* xr1 = (const GAS f32x4*)(xrow + rstep) + F.lane;
    f32x4 v0[4], v1[4];
#pragma unroll
    for (int j = 0; j < 4; ++j) { v0[j] = xr0[64 * j]; v1[j] = xr1[64 * j]; }
    float s0 = 0.f, s1 = 0.f;
#pragma unroll
    for (int j = 0; j < 4; ++j) { s0 += (v0[j].x * v0[j].x + v0[j].y * v0[j].y) + (v0[j].z * v0[j].z + v0[j].w * v0[j].w); s1 += (v1[j].x * v1[j].x + v1[j].y * v1[j].y) + (v1[j].z * v1[j].z + v1[j].w * v1[j].w); }
#pragma unroll
    for (int o = 1; o < 64; o <<= 1) { s0 += __shfl_xor(s0, o); s1 += __shfl_xor(s1, o); }
    GAS v2u* o0 = (GAS v2u*)orow + F.lane; GAS v2u* o1 = (GAS v2u*)(orow + rstep) + F.lane;
#pragma unroll
    for (int j = 0; j < 4; ++j) { v2u a; a.x = pk2(v0[j].x, v0[j].y); a.y = pk2(v0[j].z, v0[j].w); o0[64 * j] = a; v2u b; b.x = pk2(v1[j].x, v1[j].y); b.y = pk2(v1[j].z, v1[j].w); o1[64 * j] = b; }
    if (F.lane < 16) { part[F.lane] = F.lane == 0 ? s0 : 0.f; part[(rstep >> 10) * 16 + F.lane] = F.lane == 0 ? s1 : 0.f; }
}
__device__ __forceinline__ void row_to_bf16(Frame& F, const float* xrow, bf16* orow, float* part) {
    const GAS f32x4* xr = (const GAS f32x4*)xrow + F.lane;
    f32x4 v[4]; float s = 0.f;
#pragma unroll
    for (int j = 0; j < 4; ++j) { v[j] = xr[64 * j]; s += (v[j].x * v[j].x + v[j].y * v[j].y) + (v[j].z * v[j].z + v[j].w * v[j].w); }
    s = wave_sum(s);
    GAS v2u* o8 = (GAS v2u*)orow + F.lane;
#pragma unroll
    for (int j = 0; j < 4; ++j) { v2u o; o.x = pk2(v[j].x, v[j].y); o.y = pk2(v[j].z, v[j].w); o8[64 * j] = o; }
    if (F.lane < 16) part[F.lane] = F.lane == 0 ? s : 0.f;
}
enum { MK_NONE = 0, MK_CAUSAL = 1, MK_WIN = 2, MK_BITS = 3, MK_SLC = 4, MK_CMP = 5 };
struct KVp { const bf16* K; int kpitch; const bf16* VT; int vpitch; };
struct MaskArg { int q0[3]; const unsigned* mb; unsigned sel; int nmax; float lg; };
__device__ __forceinline__ bf16x8 ld8(const bf16* p) { return *(const GAS bf16x8*)p; }
__device__ __forceinline__ float fast_exp2(float x) { return __builtin_amdgcn_exp2f(x); }

template <int NS, int NT, int MODE, int MT, int PF = 2>
__device__ __forceinline__ void attn_core(const LAS bf16x8* ql, const KVp kv, int kt0, int kt1, float negb, const MaskArg& ma, const unsigned* const (&mbrow)[NS],
                                          f32x16 (&O)[NS][NT], float (&lsum)[NS], int lane) {
    const int r32 = lane & 31, hi = lane >> 5;
    const int kperm = (r32 & 0x13) | ((r32 & 4) << 1) | ((r32 & 8) >> 1);
    const bf16* kp = kv.K + (size_t)kperm * kv.kpitch + 8 * hi;
    const bf16* vp = kv.VT + (size_t)r32 * kv.vpitch + 8 * hi;
    bf16x8 kf[4], vf[2][NT], kfn[4], vfn[2][NT];
#define AC_LOADK(dst, kt_) do { const bf16* kq_ = kp + (size_t)(32 * (kt_)) * kv.kpitch; _Pragma("unroll") for (int ks = 0; ks < 4; ++ks) dst[ks] = ld8(kq_ + 16 * ks); } while (0)
#define AC_LOADV(dst, kt_) do { _Pragma("unroll") for (int nt = 0; nt < NT; ++nt) { const bf16* vq_ = vp + (size_t)(32 * nt) * kv.vpitch + 32 * (kt_); dst[0][nt] = ld8(vq_); dst[1][nt] = ld8(vq_ + 16); } } while (0)
    unsigned mw[NS], mwn[NS];
    if (kt0 < kt1) { if (PF >= 1) AC_LOADK(kf, kt0); if (PF >= 2) AC_LOADV(vf, kt0);
        if (MT == MK_BITS) { _Pragma("unroll") for (int s = 0; s < NS; ++s) mw[s] = mbrow[s][kt0]; } }
#pragma unroll 1
    for (int kt = kt0; kt < kt1; ++kt) {
        unsigned selbit = 1u; bool active = true;
        if (MT == MK_SLC) { selbit = (ma.sel >> (kt >> 1)) & 1u; active = __any(selbit != 0u); }
        const int ktn = (kt + 1 < kt1) ? kt + 1 : kt;
        if (PF == 0) { if (active) { AC_LOADK(kf, kt); AC_LOADV(vf, kt); } }
        else { AC_LOADK(kfn, ktn); if (PF >= 2) AC_LOADV(vfn, ktn); else if (active) AC_LOADV(vf, kt); }
        if (MT == MK_BITS) { _Pragma("unroll") for (int s = 0; s < NS; ++s) mwn[s] = mbrow[s][ktn]; }
        if (active) {
        const LAS bf16x8* qlp = ql; asm volatile("" : "+v"(qlp));
#pragma unroll
        for (int s = 0; s < NS; ++s) {
            f32x16 acc;
#pragma unroll
            for (int r = 0; r < 16; ++r) acc[r] = 0.f;
            bf16x8 qq[4];
#pragma unroll
            for (int ks = 0; ks < 4; ++ks) qq[ks] = qlp[(s * 4 + ks) * 64];
#pragma unroll
            for (int ks = 0; ks < 4; ++ks) acc = __builtin_amdgcn_mfma_f32_32x32x16_bf16(kf[ks], qq[ks], acc, 0, 0, 0);
            const int tq = ma.q0[s] + r32, kb = 32 * kt + 8 * hi;
            bool full = true;
            if (MT == MK_CAUSAL) full = (32 * kt + 31 <= ma.q0[s]);
            if (MT == MK_WIN) full = (32 * kt + 31 <= ma.q0[s]) && (32 * kt >= ma.q0[s] + 31 - 511);
            if (MT == MK_SLC) full = (32 * kt + 31 <= ma.q0[s]) && __all(selbit != 0u);
            if (MT == MK_BITS || MT == MK_CMP) full = false;
            float p[16];
            if (full) {
#pragma unroll
                for (int r = 0; r < 16; ++r) { const int key = kb + 16 * (r >> 3) + (r & 7); p[r] = MODE == 0 ? fast_exp2(acc[r]) : (MODE == 1 ? acc[r] : acc[r] * fast_exp2((float)(tq - key) * ma.lg)); }
            } else {
                unsigned w = 0;
                if (MT == MK_BITS) w = mw[s];
#pragma unroll
                for (int r = 0; r < 16; ++r) { const int key = kb + 16 * (r >> 3) + (r & 7); bool v = true;
                    if (MT == MK_CAUSAL) v = key <= tq;
                    if (MT == MK_WIN) v = (key <= tq) && (key >= tq - 511);
                    if (MT == MK_SLC) v = (key <= tq) && (selbit != 0u);
                    if (MT == MK_BITS) v = (w >> (8 * hi + 16 * (r >> 3) + (r & 7))) & 1u;
                    if (MT == MK_CMP) v = key <= ma.nmax;
                    const float e = MODE == 0 ? fast_exp2(acc[r]) : (MODE == 1 ? acc[r] : acc[r] * fast_exp2((float)((tq - key) < 0 ? 0 : (tq - key)) * ma.lg));
                    p[r] = v ? e : 0.f; }
            }
            if (MODE == 0) { float a = 0.f;
#pragma unroll
                for (int r = 0; r < 16; ++r) a += p[r];
                lsum[s] += a; }
            bf16x8 pk0, pk1;
            { v4u t0, t1; t0.x = pk2(p[0], p[1]); t0.y = pk2(p[2], p[3]); t0.z = pk2(p[4], p[5]); t0.w = pk2(p[6], p[7]);
              t1.x = pk2(p[8], p[9]); t1.y = pk2(p[10], p[11]); t1.z = pk2(p[12], p[13]); t1.w = pk2(p[14], p[15]);
              pk0 = __builtin_bit_cast(bf16x8, t0); pk1 = __builtin_bit_cast(bf16x8, t1); }
#pragma unroll
            for (int nt = 0; nt < NT; ++nt) { O[s][nt] = __builtin_amdgcn_mfma_f32_32x32x16_bf16(pk0, vf[0][nt], O[s][nt], 0, 0, 0);
                                              O[s][nt] = __builtin_amdgcn_mfma_f32_32x32x16_bf16(pk1, vf[1][nt], O[s][nt], 0, 0, 0); }
            if (NS >= 3) __builtin_amdgcn_sched_barrier(0);
        }
        }
        if (MT == MK_BITS) { _Pragma("unroll") for (int s = 0; s < NS; ++s) mw[s] = mwn[s]; }
        if (PF >= 1) {
#pragma unroll
            for (int ks = 0; ks < 4; ++ks) kf[ks] = kfn[ks];
            if (PF >= 2) {
#pragma unroll
                for (int nt = 0; nt < NT; ++nt) { vf[0][nt] = vfn[0][nt]; vf[1][nt] = vfn[1][nt]; } }
        }
    }
#undef AC_LOADK
#undef AC_LOADV
}
template <int NS, int NT, int MODE, int MT, bool LDSK = false>
__device__ __forceinline__ void tile_math(const bf16x8 (&kf_)[4], const bf16x8 (&vf_)[2][NT], const LAS bf16x8* ql, int kt, const MaskArg& ma, const unsigned (&mw)[NS], unsigned selbit,
                                          f32x16 (&O)[NS][NT], float (&lsum)[NS], int lane, const LAS bf16x8* sp = nullptr) {
    const int r32 = lane & 31, hi = lane >> 5;
    const LAS bf16x8* qlp = ql; asm volatile("" : "+v"(qlp));
    f32x16 acc[NS];
#pragma unroll
    for (int s = 0; s < NS; ++s)
#pragma unroll
        for (int r = 0; r < 16; ++r) acc[s][r] = 0.f;
    bf16x8 kf[4], vf[2][NT];
    {
        bf16x8 qa[NS][4];
        if (LDSK) {
#pragma unroll
            for (int ks = 0; ks < 4; ++ks) { kf[ks] = sp[ks * 64];
#pragma unroll
                for (int s = 0; s < NS; ++s) qa[s][ks] = qlp[(s * 4 + ks) * 64];
                __builtin_amdgcn_sched_barrier(0); }
#pragma unroll
            for (int nt = 0; nt < NT; ++nt) { vf[0][nt] = sp[(4 + 2 * nt) * 64]; vf[1][nt] = sp[(5 + 2 * nt) * 64]; }
        } else {
#pragma unroll
            for (int ks = 0; ks < 4; ++ks) kf[ks] = kf_[ks];
#pragma unroll
            for (int nt = 0; nt < NT; ++nt) { vf[0][nt] = vf_[0][nt]; vf[1][nt] = vf_[1][nt]; }
#pragma unroll
            for (int s = 0; s < NS; ++s)
#pragma unroll
                for (int ks = 0; ks < 4; ++ks) qa[s][ks] = qlp[(s * 4 + ks) * 64];
        }
        __builtin_amdgcn_sched_barrier(0);
#pragma unroll
        for (int ks = 0; ks < 4; ++ks)
#pragma unroll
            for (int s = 0; s < NS; ++s) acc[s] = __builtin_amdgcn_mfma_f32_32x32x16_bf16(kf[ks], qa[s][ks], acc[s], 0, 0, 0);
        __builtin_amdgcn_sched_barrier(0);
    }
#pragma unroll
    for (int s = 0; s < NS; ++s) {
        const int tq = ma.q0[s] + r32, kb = 32 * kt + 8 * hi;
        bool full = true;
        if (MT == MK_CAUSAL) full = (32 * kt + 31 <= ma.q0[s]);
        if (MT == MK_WIN) full = (32 * kt + 31 <= ma.q0[s]) && (32 * kt >= ma.q0[s] + 31 - 511);
        if (MT == MK_SLC) full = (32 * kt + 31 <= ma.q0[s]) && __all(selbit != 0u);
        if (MT == MK_BITS || MT == MK_CMP) full = false;
        float p[16];
        if (full) {
#pragma unroll
            for (int r = 0; r < 16; ++r) p[r] = MODE == 0 ? fast_exp2(acc[s][r]) : acc[s][r];
        } else if (MT == MK_BITS) {
            const unsigned wsh = mw[s] >> (8 * hi);
#pragma unroll
            for (int r = 0; r < 16; ++r) { const int m = ((int)(wsh << (31 - (16 * (r >> 3) + (r & 7))))) >> 31;
                p[r] = __builtin_bit_cast(float, __builtin_bit_cast(unsigned, fast_exp2(acc[s][r])) & (unsigned)m); }
        } else {
#pragma unroll
            for (int r = 0; r < 16; ++r) { const int key = kb + 16 * (r >> 3) + (r & 7); bool v = true;
                if (MT == MK_CAUSAL) v = key <= tq;
                if (MT == MK_WIN) v = (key <= tq) && (key >= tq - 511);
                if (MT == MK_SLC) v = (key <= tq) && (selbit != 0u);
                if (MT == MK_CMP) v = key <= ma.nmax;
                const float e = MODE == 0 ? fast_exp2(acc[s][r]) : acc[s][r];
                p[r] = v ? e : 0.f; }
        }
        if (MODE == 0) { float a = 0.f;
#pragma unroll
            for (int r = 0; r < 16; ++r) a += p[r];
            lsum[s] += a; }
        bf16x8 pk0, pk1;
        { v4u t0, t1; t0.x = pk2(p[0], p[1]); t0.y = pk2(p[2], p[3]); t0.z = pk2(p[4], p[5]); t0.w = pk2(p[6], p[7]);
          t1.x = pk2(p[8], p[9]); t1.y = pk2(p[10], p[11]); t1.z = pk2(p[12], p[13]); t1.w = pk2(p[14], p[15]);
          pk0 = __builtin_bit_cast(bf16x8, t0); pk1 = __builtin_bit_cast(bf16x8, t1); }
#pragma unroll
        for (int nt = 0; nt < NT; ++nt) { O[s][nt] = __builtin_amdgcn_mfma_f32_32x32x16_bf16(pk0, vf[0][nt], O[s][nt], 0, 0, 0);
                                          O[s][nt] = __builtin_amdgcn_mfma_f32_32x32x16_bf16(pk1, vf[1][nt], O[s][nt], 0, 0, 0); }
    }
}
__device__ __forceinline__ int crow(int r, int hi) { return (r & 3) + 8 * (r >> 2) + 4 * hi; }
template <int NT, bool ADD>
__device__ __forceinline__ void store_o(const f32x16 (&O)[NT], float f, bf16* Y, int row0, int col0, int lane) {
    const int r32 = lane & 31, hi = lane >> 5;
    GAS bf16* Yg = (GAS bf16*)Y;
    unsigned ybase = (unsigned)((row0 + 4 * hi) * 1024 + col0 + r32); asm volatile("" : "+v"(ybase));
#pragma unroll
    for (int rh = 0; rh < 2; ++rh) {
        unsigned short old[NT][8];
        if (ADD) {
#pragma unroll
            for (int ri = 0; ri < 8; ++ri)
#pragma unroll
                for (int nt = 0; nt < NT; ++nt) { const int r = 8 * rh + ri; old[nt][ri] = Yg[ybase + (unsigned)(((r & 3) + 8 * (r >> 2)) * 1024) + 32 * nt]; }
        }
#pragma unroll
        for (int ri = 0; ri < 8; ++ri) { const int r = 8 * rh + ri; const int q = crow(r, hi); const float fr = __shfl(f, q);
            const unsigned yo = ybase + (unsigned)(((r & 3) + 8 * (r >> 2)) * 1024);
#pragma unroll
            for (int nt = 0; nt < NT; ++nt) { float v = O[nt][r] * fr; if (ADD) v += bf2f(old[nt][ri]); Yg[yo + 32 * nt] = (bf16)f2bf(v); } }
    }
}
template <int NS> __device__ __forceinline__ void stage_q(LAS bf16x8* ql, const bf16* const (&qrow)[NS], int lane) {
    const int hi = lane >> 5;
#pragma unroll
    for (int s = 0; s < NS; ++s)
#pragma unroll
        for (int ks = 0; ks < 4; ++ks) ql[(s * 4 + ks) * 64] = ld8(qrow[s] + 16 * ks + 8 * hi);
    LDS_WAIT(); asm volatile("" ::: "memory");
}
__device__ __forceinline__ void q32_load(const bf16* p  , float (&v)[4][8]) {
    v4u raw[4];
#pragma unroll
    for (int ks = 0; ks < 4; ++ks) raw[ks] = *(const GAS v4u*)(p + 16 * ks);
#pragma unroll
    for (int ks = 0; ks < 4; ++ks) { v[ks][0] = bflo(raw[ks].x); v[ks][1] = bfhi(raw[ks].x); v[ks][2] = bflo(raw[ks].y); v[ks][3] = bfhi(raw[ks].y);
        v[ks][4] = bflo(raw[ks].z); v[ks][5] = bfhi(raw[ks].z); v[ks][6] = bflo(raw[ks].w); v[ks][7] = bfhi(raw[ks].w); }
}
__device__ __forceinline__ void q32_xf(float (&v)[4][8], const float* gain, bool rope, int t, float scale, int hi, const float* tab) {
    if (gain) { float ss = 0.f;
#pragma unroll
        for (int ks = 0; ks < 4; ++ks)
#pragma unroll
            for (int j = 0; j < 8; ++j) ss += v[ks][j] * v[ks][j];
        ss += __shfl_xor(ss, 32);
        const float r = __builtin_amdgcn_rsqf(ss * (1.f / 64.f) + EPS);
#pragma unroll
        for (int ks = 0; ks < 4; ++ks) { const f32x4 g0 = *(const GAS f32x4*)(gain + 16 * ks + 8 * hi), g1 = *(const GAS f32x4*)(gain + 16 * ks + 8 * hi + 4);
#pragma unroll
            for (int j = 0; j < 4; ++j) { v[ks][j] *= r * g0[j]; v[ks][4 + j] *= r * g1[j]; } } }
    if (rope) { const float* tr = tab + (size_t)t * 64 + 8 * hi;
#pragma unroll
        for (int ks = 0; ks < 2; ++ks) { const f32x4 c0 = *(const GAS f32x4*)(tr + 16 * ks), c1 = *(const GAS f32x4*)(tr + 16 * ks + 4), s0 = *(const GAS f32x4*)(tr + 32 + 16 * ks), s1 = *(const GAS f32x4*)(tr + 36 + 16 * ks);
#pragma unroll
            for (int j = 0; j < 8; ++j) { const float c = j < 4 ? c0[j & 3] : c1[j & 3], sn = j < 4 ? s0[j & 3] : s1[j & 3]; const float a = v[ks][j], b = v[ks + 2][j];
                v[ks][j] = a * c - b * sn; v[ks + 2][j] = b * c + a * sn; } } }
#pragma unroll
    for (int ks = 0; ks < 4; ++ks)
#pragma unroll
        for (int j = 0; j < 8; ++j) v[ks][j] *= scale;
}
__device__ __forceinline__ bf16x8 q32_pack(const float (&v)[8]) { v4u o; o.x = pk2(v[0], v[1]); o.y = pk2(v[2], v[3]); o.z = pk2(v[4], v[5]); o.w = pk2(v[6], v[7]); return __builtin_bit_cast(bf16x8, o); }
template <int NS> __device__ __forceinline__ void stage_q_xf(Frame& F, LAS bf16x8* ql, const bf16* const (&qrow)[NS], const int (&tpos)[NS], const float* gain, bool rope, float scale) {
    const int hi = F.lane >> 5; const float* tab = (const float*)(F.ws + WS_ROPE);
#pragma unroll
    for (int s = 0; s < NS; ++s) { float v[4][8]; q32_load(qrow[s] + 8 * hi, v); q32_xf(v, gain, rope, tpos[s], scale, hi, tab);
#pragma unroll
        for (int ks = 0; ks < 4; ++ks) ql[(s * 4 + ks) * 64] = q32_pack(v[ks]); }
    LDS_WAIT(); asm volatile("" ::: "memory");
}
__device__ __forceinline__ LAS bf16x8* wave_q(Frame& F) { return (LAS bf16x8*)(F.lds + F.wave * 16384) + F.lane; }
template <int NS, int NT> __device__ __forceinline__ void zero_o(f32x16 (&O)[NS][NT], float (&l)[NS]) {
#pragma unroll
    for (int s = 0; s < NS; ++s) { l[s] = 0.f;
#pragma unroll
        for (int nt = 0; nt < NT; ++nt)
#pragma unroll
            for (int r = 0; r < 16; ++r) O[s][nt][r] = 0.f; }
}

__device__ __forceinline__ void mem_task(Frame& F, int task, int Ly, const bf16* PROJ, int ldp, int qmcol) {
    const int qb = task & 31, h = (task >> 5) & 3, b = task >> 7; const int r32 = F.lane & 31;
    const int row0 = b * SEQ + 64 * qb;
    const bf16* qrow[2] = {PROJ + (size_t)(row0 + r32) * ldp + qmcol + h * 64, PROJ + (size_t)(row0 + 32 + r32) * ldp + qmcol + h * 64};
#if QF_MEM
    LAS bf16x8* ql = wave_q(F); { const int tp[2] = {0, 0}; stage_q_xf<2>(F, ql, qrow, tp, F.ka->in[10] + Ly * 64, false, QSCALE); }
#else
    LAS bf16x8* ql = wave_q(F); stage_q<2>(ql, qrow, F.lane);
#endif
    KVp kv{(const bf16*)(F.ws + WS_MK) + ((size_t)((Ly * NB + b) * 4 + h) * NMEMT) * 64, 64, (const bf16*)(F.ws + WS_MVT) + ((size_t)(Ly * NB + b) * 256 + h * 64) * NMEMT, NMEMT};
    f32x16 O[2][2]; float l[2]; zero_o<2, 2>(O, l);
    MaskArg ma{}; const unsigned* mbr[2] = {nullptr, nullptr};
    const float negb = 0.f;
    attn_core<2, 2, 0, MK_NONE>(ql, kv, 0, NMEMT / 32, negb, ma, mbr, O, l, F.lane);
    bf16* Y = (bf16*)(F.ws + WS_Y);
#pragma unroll
    for (int s = 0; s < 2; ++s) { const float lt = l[s] + __shfl_xor(l[s], 32); store_o<2, false>(O[s], (DBG_ZERO & 8) ? 0.f : 1.f / lt, Y, row0 + 32 * s, 768 + h * 64, F.lane); }
}
__device__ __forceinline__ float dpp_add16(float x) {
    x += __builtin_bit_cast(float, __builtin_amdgcn_update_dpp(0, __builtin_bit_cast(int, x), 0xB1, 0xf, 0xf, true));
    x += __builtin_bit_cast(float, __builtin_amdgcn_update_dpp(0, __builtin_bit_cast(int, x), 0x4E, 0xf, 0xf, true));
    x += __builtin_bit_cast(float, __builtin_amdgcn_update_dpp(0, __builtin_bit_cast(int, x), 0x141, 0xf, 0xf, true));
    x += __builtin_bit_cast(float, __builtin_amdgcn_update_dpp(0, __builtin_bit_cast(int, x), 0x140, 0xf, 0xf, true));
    return x;
}
__device__ __forceinline__ void ret_gates(Frame& F, int rowb, int h, const bf16* PROJ, unsigned short (&gv)[16][4]) {
    const int r32 = F.lane & 31, hi = F.lane >> 5;
#pragma unroll
    for (int r = 0; r < 16; ++r) { const GAS bf16* gp = (const GAS bf16*)PROJ + (size_t)(rowb + crow(r, hi)) * RET_LD + RET_G + h * 128 + r32;
#pragma unroll
        for (int nt = 0; nt < 4; ++nt) gv[r][nt] = gp[32 * nt]; }
}
__device__ __forceinline__ void ret_epilogue(Frame& F, const f32x16 (&O)[4], int rowb, int h, const unsigned short (&gv)[16][4]) {
    const int r32 = F.lane & 31, hi = F.lane >> 5;
    bf16* Y = (bf16*)(F.ws + WS_Y);
#pragma unroll
    for (int rh = 0; rh < 2; ++rh) {
        float av[8], qv[8];
#pragma unroll
        for (int ri = 0; ri < 8; ++ri) { const int r = 8 * rh + ri;
            av[ri] = dpp_add16((O[0][r] + O[1][r]) + (O[2][r] + O[3][r]));
            qv[ri] = dpp_add16((O[0][r] * O[0][r] + O[1][r] * O[1][r]) + (O[2][r] * O[2][r] + O[3][r] * O[3][r])); }
#pragma unroll
        for (int ri = 0; ri < 8; ++ri) { av[ri] += __shfl_xor(av[ri], 16); qv[ri] += __shfl_xor(qv[ri], 16); }
#pragma unroll
        for (int ri = 0; ri < 8; ++ri) { const int r = 8 * rh + ri;
            const float mu = av[ri] * (1.f / 128.f);
            float var = qv[ri] * (1.f / 128.f) - mu * mu; var = var < 0.f ? 0.f : var;
            const float rstd = __builtin_amdgcn_rsqf(var + EPS);
            const int row = rowb + crow(r, hi);
            GAS bf16* yp = (GAS bf16*)Y + (size_t)row * 1024 + h * 128 + r32;
            const float dd[4] = {O[0][r] - mu, O[1][r] - mu, O[2][r] - mu, O[3][r] - mu};
#pragma unroll
            for (int nt = 0; nt < 4; ++nt) { const float g = bf2f(gv[r][nt]); const float sg = g * __builtin_amdgcn_rcpf(1.f + fast_exp2(-1.4426950408889634f * g));
                yp[32 * nt] = (DBG_ZERO & 1) ? (bf16)0 : (bf16)f2bf(sg * dd[nt] * rstd); }
        }
    }
}
__device__ __forceinline__ void glds16(const void* gsrc, unsigned lds_dst) { unsigned keep;
    asm volatile("s_mov_b32 %0, m0\n\ts_mov_b32 m0, %2\n\ts_nop 0\n\tglobal_load_lds_dwordx4 %1, off\n\ts_mov_b32 m0, %0" : "=&s"(keep) : "v"(gsrc), "s"(lds_dst) : "memory"); }
template <int NS, int MT, int R>
__device__ __forceinline__ void wg_attn(Frame& F, const LAS bf16x8* ql, const bf16* psrc, int pstep, unsigned ring_off, int kt0, int kt1, unsigned blk, int my0, int my1,
                                        const MaskArg& ma, const LAS unsigned* mlds, f32x16 (&O)[NS][2], float (&lsum)[NS]) {
    const unsigned pdst = (unsigned)(uintptr_t)F.lds + ring_off + (unsigned)F.wave * 1024u;
#define WG_NEED(k_) ((MT != MK_SLC) || (((blk) >> ((k_) >> 1)) & 1u))
#define WG_ADV(k_) do { ++(k_); } while ((k_) < kt1 && !WG_NEED(k_))
    int kd = kt0; if (kd < kt1 && !WG_NEED(kd)) WG_ADV(kd);
    int kc = kd;
    int sd = 0, sc = 0, nd = 0;
#pragma unroll 1
    for (int j = 0; j < R - 1; ++j) if (kd < kt1) { glds16(psrc + (size_t)kd * pstep, (unsigned)__builtin_amdgcn_readfirstlane(pdst + (unsigned)sd * 8192u)); WG_ADV(kd); sd = sd + 1 == R ? 0 : sd + 1; ++nd; }
    __builtin_amdgcn_s_waitcnt(0xC07F);
#pragma unroll 1
    while (kc < kt1) {
        const int yo = nd - 1;
        if (yo >= 3) asm volatile("s_waitcnt vmcnt(3)\n\ts_barrier" ::: "memory");
        else if (yo == 2) asm volatile("s_waitcnt vmcnt(2)\n\ts_barrier" ::: "memory");
        else if (yo == 1) asm volatile("s_waitcnt vmcnt(1)\n\ts_barrier" ::: "memory");
        else asm volatile("s_waitcnt vmcnt(0)\n\ts_barrier" ::: "memory");
        if (kd < kt1) { glds16(psrc + (size_t)kd * pstep, (unsigned)__builtin_amdgcn_readfirstlane(pdst + (unsigned)sd * 8192u)); WG_ADV(kd); sd = sd + 1 == R ? 0 : sd + 1; ++nd; }
#if WG_SKEW
        if (F.wave >= 4) __builtin_amdgcn_s_sleep(WG_SKEW);
#endif
        if (kc >= my0 && kc < my1) {
            unsigned selbit = 1u; bool active = true;
            if (MT == MK_SLC) { selbit = (ma.sel >> (kc >> 1)) & 1u; active = __any(selbit != 0u); }
            if (active) {
                const LAS bf16x8* sp = (const LAS bf16x8*)(F.lds + ring_off + sc * 8192) + F.lane;
                unsigned mw[NS];
#pragma unroll
                for (int s = 0; s < NS; ++s) mw[s] = (MT == MK_BITS) ? mlds[kc] : 0u;
                const bf16x8 kz[4] = {}; const bf16x8 vz[2][2] = {};
                tile_math<NS, 2, 0, MT, true>(kz, vz, ql, kc, ma, mw, selbit, O, lsum, F.lane, sp);
            }
        }
        WG_ADV(kc); sc = sc + 1 == R ? 0 : sc + 1; --nd;
    }
    asm volatile("s_waitcnt vmcnt(0)\n\ts_barrier" ::: "memory");
#undef WG_NEED
#undef WG_ADV
}
template <int NS, int MT>
__device__ __forceinline__ void wg_attn2(Frame& F, const LAS bf16x8* ql, const bf16* psrc, int pstep, unsigned ring_off, int kt0, int kt1, unsigned blk, int my0, int my1,
                                         const MaskArg& ma, f32x16 (&O)[NS][2], float (&lsum)[NS]) {
    const unsigned pdst = (unsigned)(uintptr_t)F.lds + ring_off + (unsigned)F.wave * 1024u;
    const int pend = kt1 >> 1;
#define WG2_NEED(p_) ((MT != MK_SLC) || (((blk) >> (p_)) & 1u))
#define WG2_ADV(p_) do { ++(p_); } while ((p_) < pend && !WG2_NEED(p_))
#define WG2_DMA(p_, slot_) do { const unsigned d_ = (unsigned)__builtin_amdgcn_readfirstlane(pdst + (unsigned)(slot_) * 16384u); \
        glds16(psrc + (size_t)(2 * (p_)) * pstep, d_); glds16(psrc + (size_t)(2 * (p_) + 1) * pstep, d_ + 8192u); } while (0)
    int pd = kt0 >> 1; if (pd < pend && !WG2_NEED(pd)) WG2_ADV(pd);
    int pc = pd, sd = 0, sc = 0, nd = 0;
    if (pd < pend) { WG2_DMA(pd, sd); WG2_ADV(pd); sd ^= 1; ++nd; }
    __builtin_amdgcn_s_waitcnt(0xC07F);
#pragma unroll 1
    while (pc < pend) {
        if (nd >= 2) asm volatile("s_waitcnt vmcnt(2)\n\ts_barrier" ::: "memory");
        else asm volatile("s_waitcnt vmcnt(0)\n\ts_barrier" ::: "memory");
        if (pd < pend) { WG2_DMA(pd, sd); WG2_ADV(pd); sd ^= 1; ++nd; }
#pragma unroll 1
        for (int t = 0; t < 2; ++t) { const int kc = 2 * pc + t;
            if (kc >= my0 && kc < my1) {
                unsigned selbit = 1u; bool active = true;
                if (MT == MK_SLC) { selbit = (ma.sel >> pc) & 1u; active = __any(selbit != 0u); }
                if (active) {
                    const LAS bf16x8* sp = (const LAS bf16x8*)(F.lds + ring_off + sc * 16384 + t * 8192) + F.lane;
                    unsigned mw[NS];
#pragma unroll
                    for (int s = 0; s < NS; ++s) mw[s] = 0u;
                    const bf16x8 kz[4] = {}; const bf16x8 vz[2][2] = {};
                    tile_math<NS, 2, 0, MT, true>(kz, vz, ql, kc, ma, mw, selbit, O, lsum, F.lane, sp);
                }
            }
        }
        WG2_ADV(pc); sc ^= 1; --nd;
    }
    asm volatile("s_waitcnt vmcnt(0)\n\ts_barrier" ::: "memory");
#undef WG2_NEED
#undef WG2_ADV
#undef WG2_DMA
}
__device__ __forceinline__ void mem_wg_task(Frame& F, int task, int Ly, const bf16* PROJ, int ldp, int qmcol) {
    const int qb = task & 3, h = (task >> 2) & 3, b = task >> 4, w = F.wave; const int r32 = F.lane & 31, hi = F.lane >> 5;
    const int row0 = b * SEQ + 512 * qb + 64 * w;
    const bf16* qrow[2] = {PROJ + (size_t)(row0 + r32) * ldp + qmcol + h * 64, PROJ + (size_t)(row0 + 32 + r32) * ldp + qmcol + h * 64};
    LAS bf16x8* ql = (LAS bf16x8*)(F.lds + 65536 + w * 8192) + F.lane;
    { const int kperm = (r32 & 0x13) | ((r32 & 4) << 1) | ((r32 & 8) >> 1);
      const bf16* Kb = (const bf16*)(F.ws + WS_MK) + ((size_t)((Ly * NB + b) * 4 + h) * NMEMT + 32 * w + kperm) * 64 + 8 * hi;
      const bf16* Vb = (const bf16*)(F.ws + WS_MVT) + ((size_t)(Ly * NB + b) * 256 + h * 64 + r32) * NMEMT + 32 * w + 8 * hi;
      const unsigned dst = (unsigned)(uintptr_t)F.lds + (unsigned)w * 8192u;
#pragma unroll
      for (int ks = 0; ks < 4; ++ks) glds16(Kb + 16 * ks, (unsigned)__builtin_amdgcn_readfirstlane(dst + ks * 1024u));
#pragma unroll
      for (int j = 0; j < 4; ++j) glds16(Vb + (size_t)(32 * (j >> 1)) * NMEMT + 16 * (j & 1), (unsigned)__builtin_amdgcn_readfirstlane(dst + (4 + j) * 1024u)); }
#if QF_MEM
    { const int tp[2] = {0, 0}; stage_q_xf<2>(F, ql, qrow, tp, F.ka->in[10] + Ly * 64, false, QSCALE); }
#else
    stage_q<2>(ql, qrow, F.lane);
#endif
    asm volatile("s_waitcnt lgkmcnt(0)" ::: "memory");
    asm volatile("s_waitcnt vmcnt(0)\n\ts_barrier" ::: "memory");
    f32x16 O[2][2]; float l[2]; zero_o<2, 2>(O, l);
    MaskArg ma{}; const unsigned mw[2] = {0u, 0u};
#pragma unroll 1
    for (int kt = 0; kt < 8; ++kt) {
        const LAS bf16x8* sp = (const LAS bf16x8*)(F.lds + kt * 8192) + F.lane;
        bf16x8 kf[4], vf[2][2];
#pragma unroll
        for (int ks = 0; ks < 4; ++ks) kf[ks] = sp[ks * 64];
#pragma unroll
        for (int nt = 0; nt < 2; ++nt) { vf[0][nt] = sp[(4 + 2 * nt) * 64]; vf[1][nt] = sp[(5 + 2 * nt) * 64]; }
        tile_math<2, 2, 0, MK_NONE>(kf, vf, ql, kt, ma, mw, 1u, O, l, F.lane);
    }
    bf16* Y = (bf16*)(F.ws + WS_Y);
#pragma unroll
    for (int s = 0; s < 2; ++s) { const float lt = l[s] + __shfl_xor(l[s], 32); store_o<2, false>(O[s], (DBG_ZERO & 8) ? 0.f : 1.f / lt, Y, row0 + 32 * s, 768 + h * 64, F.lane); }
}
#define STB ((bf16*)F.out + (size_t)32 * 1024 * 1024)
constexpr int RST_PITCH = 260, RST_BUF = 34816;
__device__ __forceinline__ void ret_state_task(Frame& F, int task, const bf16* PROJ) {
    const int h = task % 6, b = task / 6, w = F.wave; const int r32 = F.lane & 31, hi = F.lane >> 5; const int dt = w & 1, et = w >> 1; const int tid = w * 64 + F.lane;
    const bf16* ksrc = PROJ + (size_t)(b * SEQ + (tid >> 3)) * RET_LD + RET_K + h * 64 + 8 * (tid & 7);
    const bf16* vsrc = (const bf16*)F.out + ((size_t)b * 768 + h * 128 + 32 * et + r32) * SEQ + 8 * hi;
    bf16* st = STB + ((size_t)((b * 6 + h) * 7) * 128 + 32 * et + r32) * 64 + 32 * dt + 4 * hi;
    f32x16 acc;
#pragma unroll
    for (int r = 0; r < 16; ++r) acc[r] = 0.f;
    v4u kraw[4]; bf16x8 vf[16];
#pragma unroll
    for (int i = 0; i < 4; ++i) kraw[i] = *(const GAS v4u*)(ksrc + (size_t)(64 * i) * RET_LD);
#pragma unroll
    for (int ks = 0; ks < 16; ++ks) vf[ks] = ld8(vsrc + 16 * ks);
#pragma unroll 1
    for (int m = 0; m < 7; ++m) {
        LAS bf16* buf = (LAS bf16*)(F.lds + (m & 1) * RST_BUF);
#pragma unroll
        for (int i = 0; i < 4; ++i) { LAS bf16* bp = buf + (8 * (tid & 7)) * RST_PITCH + (tid >> 3) + 64 * i; const unsigned ww[4] = {kraw[i].x, kraw[i].y, kraw[i].z, kraw[i].w};
#pragma unroll
            for (int j = 0; j < 4; ++j) { bp[(2 * j) * RST_PITCH] = (bf16)(ww[j] & 0xffffu); bp[(2 * j + 1) * RST_PITCH] = (bf16)(ww[j] >> 16); } }
        if (m < 6) {
#pragma unroll
            for (int i = 0; i < 4; ++i) kraw[i] = *(const GAS v4u*)(ksrc + (size_t)(256 * (m + 1) + 64 * i) * RET_LD); }
        bf16x8 vc[16];
#pragma unroll
        for (int ks = 0; ks < 16; ++ks) vc[ks] = vf[ks];
        if (m < 6) {
#pragma unroll
            for (int ks = 0; ks < 16; ++ks) vf[ks] = ld8(vsrc + 256 * (m + 1) + 16 * ks); }
        asm volatile("s_waitcnt lgkmcnt(0)\n\ts_barrier" ::: "memory");
        const LAS bf16* kp = buf + (32 * dt + r32) * RST_PITCH + 8 * hi;
#pragma unroll
        for (int ks = 0; ks < 16; ++ks) { const v2u lo = *(const LAS v2u*)(kp + 16 * ks), hh = *(const LAS v2u*)(kp + 16 * ks + 4);
            v4u kk; kk.x = lo.x; kk.y = lo.y; kk.z = hh.x; kk.w = hh.y;
            acc = __builtin_amdgcn_mfma_f32_32x32x16_bf16(__builtin_bit_cast(bf16x8, kk), vc[ks], acc, 0, 0, 0); }
        bf16* sp = st + (size_t)m * 8192;
#pragma unroll
        for (int g = 0; g < 4; ++g) { v2u o; o.x = pk2(acc[4 * g], acc[4 * g + 1]); o.y = pk2(acc[4 * g + 2], acc[4 * g + 3]); *(GAS v2u*)(sp + 8 * g) = o; }
    }
}
constexpr int RWG_SLOT = 12288;
__device__ __forceinline__ void ret_wg_task(Frame& F, int task, const bf16* PROJ) {
    const int qb = task & 7, h = (task >> 3) % 6, b = (task >> 3) / 6, w = F.wave; const int r32 = F.lane & 31, hi = F.lane >> 5;
    const int ws = w < 4 ? w : 11 - w;
    const int rowb = b * SEQ + 256 * qb + 32 * ws;
    const int kperm = (r32 & 0x13) | ((r32 & 4) << 1) | ((r32 & 8) >> 1);
    const bf16* ksrc = PROJ + (size_t)(b * SEQ + 256 * qb + kperm) * RET_LD + RET_K + h * 64 + 16 * (w & 3) + 8 * hi;
    const bf16* vsrc = (const bf16*)F.out + ((size_t)b * 768 + h * 128 + 32 * (w >> 1) + r32) * SEQ + 256 * qb + 16 * (w & 1) + 8 * hi;
    const unsigned lds0 = (unsigned)(uintptr_t)F.lds;
#pragma unroll
    for (int i = 0; i < 4; ++i) { const int t = 2 * i + (w >> 2); glds16(ksrc + (size_t)(32 * t) * RET_LD, (unsigned)__builtin_amdgcn_readfirstlane(lds0 + (unsigned)t * RWG_SLOT + (unsigned)(w & 3) * 1024u)); }
#pragma unroll
    for (int t = 0; t < 8; ++t) glds16(vsrc + 32 * t, (unsigned)__builtin_amdgcn_readfirstlane(lds0 + (unsigned)t * RWG_SLOT + 4096u + (unsigned)w * 1024u));
    unsigned short gv[16][4]; ret_gates(F, rowb, h, PROJ, gv);
    bf16x8 qf[4];
    { float v[4][8]; q32_load(PROJ + (size_t)(rowb + r32) * RET_LD + RET_Q + h * 64 + 8 * hi, v);
      const int t = 256 * qb + 32 * ws + r32; const float lg = __builtin_amdgcn_logf(1.0f - __builtin_amdgcn_exp2f(-5.0f - (float)h));
      q32_xf(v, nullptr, true, t, __builtin_amdgcn_exp2f((float)t * lg), hi, (const float*)(F.ws + WS_ROPE));
#pragma unroll
      for (int ks = 0; ks < 4; ++ks) qf[ks] = q32_pack(v[ks]); }
    f32x16 O[4];
#pragma unroll
    for (int nt = 0; nt < 4; ++nt)
#pragma unroll
        for (int r = 0; r < 16; ++r) O[nt][r] = 0.f;
    if (qb > 0) {
        const bf16* sp = STB + ((size_t)((b * 6 + h) * 7 + qb - 1) * 128 + r32) * 64 + 8 * hi;
        bf16x8 sf[4][4];
#pragma unroll
        for (int nt = 0; nt < 4; ++nt)
#pragma unroll
            for (int ks = 0; ks < 4; ++ks) sf[nt][ks] = ld8(sp + (size_t)(32 * nt) * 64 + 16 * ks);
#pragma unroll
        for (int ks = 0; ks < 4; ++ks)
#pragma unroll
            for (int nt = 0; nt < 4; ++nt) O[nt] = __builtin_amdgcn_mfma_f32_32x32x16_bf16(qf[ks], sf[nt][ks], O[nt], 0, 0, 0);
    }
    asm volatile("s_waitcnt vmcnt(0)\n\ts_barrier" ::: "memory");
#pragma unroll 1
    for (int kt = 0; kt <= ws; ++kt) {
        const LAS bf16x8* sp = (const LAS bf16x8*)(F.lds + kt * RWG_SLOT) + F.lane;
        bf16x8 kf[4], vf[2][4];
#pragma unroll
        for (int ks = 0; ks < 4; ++ks) kf[ks] = sp[ks * 64];
#pragma unroll
        for (int nt = 0; nt < 4; ++nt) { vf[0][nt] = sp[(4 + 2 * nt) * 64]; vf[1][nt] = sp[(5 + 2 * nt) * 64]; }
        f32x16 acc;
#pragma unroll
        for (int r = 0; r < 16; ++r) acc[r] = 0.f;
#pragma unroll
        for (int ks = 0; ks < 4; ++ks) acc = __builtin_amdgcn_mfma_f32_32x32x16_bf16(kf[ks], qf[ks], acc, 0, 0, 0);
        float p[16];
        if (kt < ws) {
#pragma unroll
            for (int r = 0; r < 16; ++r) p[r] = acc[r];
        } else {
#pragma unroll
            for (int r = 0; r < 16; ++r) p[r] = (8 * hi + 16 * (r >> 3) + (r & 7) <= r32) ? acc[r] : 0.f;
        }
        bf16x8 pk0, pk1;
        { v4u t0, t1; t0.x = pk2(p[0], p[1]); t0.y = pk2(p[2], p[3]); t0.z = pk2(p[4], p[5]); t0.w = pk2(p[6], p[7]);
          t1.x = pk2(p[8], p[9]); t1.y = pk2(p[10], p[11]); t1.z = pk2(p[12], p[13]); t1.w = pk2(p[14], p[15]);
          pk0 = __builtin_bit_cast(bf16x8, t0); pk1 = __builtin_bit_cast(bf16x8, t1); }
#pragma unroll
        for (int nt = 0; nt < 4; ++nt) { O[nt] = __builtin_amdgcn_mfma_f32_32x32x16_bf16(pk0, vf[0][nt], O[nt], 0, 0, 0);
                                         O[nt] = __builtin_amdgcn_mfma_f32_32x32x16_bf16(pk1, vf[1][nt], O[nt], 0, 0, 0); }
    }
    ret_epilogue(F, O, rowb, h, gv);
}
__device__ __forceinline__ void ret_task(Frame& F, int task, const bf16* PROJ) {
    const int qb = 31 - (task & 31), h = (task >> 5) % 6, b = (task >> 5) / 6; const int r32 = F.lane & 31, hi = F.lane >> 5;
    const int row0 = b * SEQ + 64 * qb;
    const bf16* qrow[2] = {PROJ + (size_t)(row0 + r32) * RET_LD + RET_Q + h * 64, PROJ + (size_t)(row0 + 32 + r32) * RET_LD + RET_Q + h * 64};
    LAS bf16x8* ql = wave_q(F); stage_q<2>(ql, qrow, F.lane);
    KVp kv{PROJ + (size_t)(b * SEQ) * RET_LD + RET_K + h * 64, RET_LD, (const bf16*)F.out + ((size_t)b * 768 + h * 128) * SEQ, SEQ};
    f32x16 O[2][4]; float l[2]; zero_o<2, 4>(O, l);
    MaskArg ma{}; ma.q0[0] = 64 * qb; ma.q0[1] = 64 * qb + 32; const unsigned* mbr[2] = {nullptr, nullptr};
    ma.lg = __builtin_amdgcn_logf(1.0f - __builtin_amdgcn_exp2f(-5.0f - (float)h));
    attn_core<2, 4, RET_MODE, MK_CAUSAL, 1>(ql, kv, 0, 2 * qb + 2, 0.f, ma, mbr, O, l, F.lane);
#pragma unroll
    for (int s = 0; s < 2; ++s) { unsigned short gv[16][4]; ret_gates(F, row0 + 32 * s, h, PROJ, gv); ret_epilogue(F, O[s], row0 + 32 * s, h, gv); }
}

typedef _Float16 h2_t __attribute__((ext_vector_type(2)));
__device__ __forceinline__ unsigned pkh(float a, float b) { h2_t v = {(_Float16)a, (_Float16)b}; return __builtin_bit_cast(unsigned, v); }
__device__ __forceinline__ void dsa_d1_task(Frame& F, int task, const bf16* PROJ) {
    int b, qb, kc; task = __builtin_amdgcn_readfirstlane(task);
    if (task < 16 * 224) { b = task / 224; int rem = task % 224, grp = 7; while (rem >= 8 * grp) { rem -= 8 * grp; --grp; }
        qb = 8 * grp + 7 - rem / grp; kc = rem % grp; }
    else { const int p = task - 16 * 224, sz = 8 - (p >> 7), grp = p & 7; b = (p & 127) >> 3; qb = 8 * grp + sz - 1; kc = grp; }
    const int r32 = F.lane & 31, hi = F.lane >> 5; const int row = b * SEQ + 32 * qb + r32;
    const bf16* qp = PROJ + (size_t)row * DSA_LD + DSA_IQ + 8 * hi;
    bf16x8 qf[4][4]; LAS bf16x8* ql = wave_q(F);
    { const int tpos = 32 * qb + r32; const float* tab = (const float*)(F.ws + WS_ROPE);
#pragma unroll
      for (int h = 0; h < 8; ++h) { float v[4][8]; q32_load(qp + h * 64, v); q32_xf(v, nullptr, true, tpos, 1.f, hi, tab);
#pragma unroll
          for (int ks = 0; ks < 4; ++ks) { const bf16x8 f = q32_pack(v[ks]); if (h < 4) qf[h & 3][ks] = f; else ql[((h & 3) * 4 + ks) * 64] = f; } } }
    LDS_WAIT(); asm volatile("" ::: "memory");
    float iw[8];
    { const v4u w = *(const GAS v4u*)(PROJ + (size_t)row * DSA_LD + DSA_IW); iw[0] = bflo(w.x); iw[1] = bfhi(w.x); iw[2] = bflo(w.y); iw[3] = bfhi(w.y); iw[4] = bflo(w.z); iw[5] = bfhi(w.z); iw[6] = bflo(w.w); iw[7] = bfhi(w.w); }
    const int kperm = (r32 & 0x13) | ((r32 & 4) << 1) | ((r32 & 8) >> 1);
    const bf16* kp = PROJ + (size_t)(b * SEQ + kperm) * DSA_LD + DSA_IK + 8 * hi;
    _Float16* sc = (_Float16*)(F.ws + WS_SC) + (size_t)row * SEQ + 8 * hi;
    const int kt1 = (8 * kc + 8 < qb + 1) ? 8 * kc + 8 : qb + 1;
    bf16x8 kf[4], kfn[4];
#pragma unroll
    for (int ks = 0; ks < 4; ++ks) kf[ks] = ld8(kp + (size_t)(32 * (8 * kc)) * DSA_LD + 16 * ks);
#pragma unroll 1
    for (int kt = 8 * kc; kt < kt1; ++kt) {
        { const int ktn = kt + 1 < kt1 ? kt + 1 : kt;
#pragma unroll
          for (int ks = 0; ks < 4; ++ks) kfn[ks] = ld8(kp + (size_t)(32 * ktn) * DSA_LD + 16 * ks); }
        float s[16];
#pragma unroll
        for (int r = 0; r < 16; ++r) s[r] = 0.f;
#pragma unroll
        for (int hg = 0; hg < 4; ++hg) { f32x16 acc[2];
#pragma unroll
            for (int h = 0; h < 2; ++h)
#pragma unroll
                for (int r = 0; r < 16; ++r) acc[h][r] = 0.f;
            if (hg < 2) {
#pragma unroll
                for (int ks = 0; ks < 4; ++ks)
#pragma unroll
                    for (int h = 0; h < 2; ++h) acc[h] = __builtin_amdgcn_mfma_f32_32x32x16_bf16(kf[ks], qf[2 * hg + h][ks], acc[h], 0, 0, 0);
            } else {
#pragma unroll
                for (int ks = 0; ks < 4; ++ks)
#pragma unroll
                    for (int h = 0; h < 2; ++h) acc[h] = __builtin_amdgcn_mfma_f32_32x32x16_bf16(kf[ks], ql[((2 * (hg - 2) + h) * 4 + ks) * 64], acc[h], 0, 0, 0);
            }
#pragma unroll
            for (int h = 0; h < 2; ++h)
#pragma unroll
                for (int r = 0; r < 16; ++r) s[r] += iw[2 * hg + h] * fmaxf(acc[h][r], 0.f);
            __builtin_amdgcn_sched_barrier(0); }
        v4u o0, o1; o0.x = pkh(s[0], s[1]); o0.y = pkh(s[2], s[3]); o0.z = pkh(s[4], s[5]); o0.w = pkh(s[6], s[7]);
        o1.x = pkh(s[8], s[9]); o1.y = pkh(s[10], s[11]); o1.z = pkh(s[12], s[13]); o1.w = pkh(s[14], s[15]);
        *(GAS v4u*)(sc + 32 * kt) = o0; *(GAS v4u*)(sc + 32 * kt + 16) = o1;
#pragma unroll
        for (int ks = 0; ks < 4; ++ks) kf[ks] = kfn[ks];
    }
}
__device__ __forceinline__ int hist_select(LAS unsigned* hist, const unsigned (&key)[32], bool lvl2, unsigned B, int target, int lane) {
    { unsigned z = 0u; asm volatile("" : "+v"(z));
#pragma unroll
      for (int j = 0; j < 8; ++j) *(LAS v4u*)(hist + 4 * (lane + 64 * j)) = (v4u){z, z, z, z}; }
    LDS_WAIT(); asm volatile("" ::: "memory");
    { LAS unsigned* hc = hist + (lane & 7);
#pragma unroll
      for (int e = 0; e < 32; ++e) { const unsigned d = lvl2 ? (key[e] & 255u) : (key[e] >> 8); const bool m = lvl2 ? ((key[e] >> 8) == B) : true;
          if (m) __hip_atomic_fetch_add(hc + 8 * d, 1u, __ATOMIC_RELAXED, __HIP_MEMORY_SCOPE_WAVEFRONT); } }
    LDS_WAIT(); asm volatile("" ::: "memory");
    v4u c;
    { const LAS v4u* hp = (const LAS v4u*)(hist + 32 * lane);
      const v4u a0 = hp[0], a1 = hp[1], a2 = hp[2], a3 = hp[3], a4 = hp[4], a5 = hp[5], a6 = hp[6], a7 = hp[7];
      c.x = (a0.x + a0.y) + (a0.z + a0.w) + (a1.x + a1.y) + (a1.z + a1.w); c.y = (a2.x + a2.y) + (a2.z + a2.w) + (a3.x + a3.y) + (a3.z + a3.w);
      c.z = (a4.x + a4.y) + (a4.z + a4.w) + (a5.x + a5.y) + (a5.z + a5.w); c.w = (a6.x + a6.y) + (a6.z + a6.w) + (a7.x + a7.y) + (a7.z + a7.w); }
    const int s = (int)(c.x + c.y + c.z + c.w);
    int S = s;
#pragma unroll
    for (int o = 1; o < 64; o <<= 1) { const int v = __shfl_down(S, o); if (lane + o < 64) S += v; }
    const unsigned long long bm = __ballot(S >= target);
    const int Ls = 63 - __clzll(bm);
    int a = S - s, dig, abv;
    if (a + (int)c.w >= target) { dig = 3; abv = a; } else { a += (int)c.w;
        if (a + (int)c.z >= target) { dig = 2; abv = a; } else { a += (int)c.z;
            if (a + (int)c.y >= target) { dig = 1; abv = a; } else { a += (int)c.y; dig = 0; abv = a; } } }
    const int packed = ((4 * lane + dig) << 12) | abv;
    const int r = __shfl(packed, Ls);
    LDS_WAIT(); asm volatile("" ::: "memory");
    return r;
}
__device__ __forceinline__ void d2_load(Frame& F, int row, v4u (&raw)[4]) {
    const int t = row % SEQ, lane = F.lane;
    const unsigned short* sp = (const unsigned short*)(F.ws + WS_SC) + (size_t)row * SEQ + (32 * lane <= t ? 32 * lane : 0);
#pragma unroll
    for (int i = 0; i < 4; ++i) raw[i] = *(const GAS v4u*)(sp + 8 * i);
}
__device__ __forceinline__ void dsa_d2_row(Frame& F, int row, const v4u (&raw)[4]) {
    const int t = row % SEQ, lane = F.lane;
    unsigned* mbp = (unsigned*)(F.ws + WS_MB) + (size_t)row * 64;
    int nvalid = t + 1 - 32 * lane; nvalid = nvalid < 0 ? 0 : (nvalid > 32 ? 32 : nvalid);
    const unsigned cb = nvalid == 32 ? 0xffffffffu : ((1u << nvalid) - 1u);
    if (t < 256) { mbp[lane] = cb; return; }
    unsigned key[32];
#pragma unroll
    for (int i = 0; i < 4; ++i) { const unsigned w[4] = {raw[i].x, raw[i].y, raw[i].z, raw[i].w};
#pragma unroll
        for (int j = 0; j < 4; ++j) {
#pragma unroll
            for (int k = 0; k < 2; ++k) { const int e = 8 * i + 2 * j + k; const unsigned u = (w[j] >> (16 * k)) & 0xffffu;
                const unsigned sk = (u & 0x8000u) ? (~u & 0xffffu) : (u | 0x8000u);
                key[e] = (e < nvalid) ? sk : 0u; } } }
    LAS unsigned* hist = (LAS unsigned*)(F.lds + F.wave * 16384);
    const int d1 = hist_select(hist, key, false, 0u, 256, lane);
    const unsigned Bh = (unsigned)d1 >> 12; const int above1 = d1 & 0xfff;
    const int d2 = hist_select(hist, key, true, Bh, 256 - above1, lane);
    const unsigned T = (Bh << 8) | ((unsigned)d2 >> 12);
    const int cgt = above1 + (d2 & 0xfff);
    unsigned g = 0, eq = 0;
#pragma unroll
    for (int e = 0; e < 32; ++e) { unsigned bg = key[e] > T ? 1u : 0u, be = key[e] == T ? 1u : 0u; asm volatile("" : "+v"(bg), "+v"(be));
        g |= bg << e; eq |= be << e; }
    const int need = 256 - cgt; const int myeq = __popc(eq);
    int incl = myeq;
#pragma unroll
    for (int o = 1; o < 64; o <<= 1) { const int v = __shfl_up(incl, o); if (lane >= o) incl += v; }
    const int pre = incl - myeq; int take = need - pre; take = take < 0 ? 0 : (take > myeq ? myeq : take);
    unsigned te = eq; int cnt = myeq;
    while (cnt > take) { te &= ~(1u << (31 - __clz(te))); --cnt; }
    mbp[lane] = (g | te) & cb;
}
__device__ __forceinline__ int wave_incl_scan(int v) {
    v += __builtin_amdgcn_update_dpp(0, v, 0x111, 0xf, 0xf, false);
    v += __builtin_amdgcn_update_dpp(0, v, 0x112, 0xf, 0xf, false);
    v += __builtin_amdgcn_update_dpp(0, v, 0x114, 0xf, 0xf, false);
    v += __builtin_amdgcn_update_dpp(0, v, 0x118, 0xf, 0xf, false);
    v += __builtin_amdgcn_update_dpp(0, v, 0x142, 0xa, 0xf, false);
    v += __builtin_amdgcn_update_dpp(0, v, 0x143, 0xc, 0xf, false);
    return v;
}
__device__ __forceinline__ void hist_select2(LAS unsigned* h0, LAS unsigned* h1, const unsigned (&key)[2][32], bool lvl2, const unsigned (&B)[2], const int (&target)[2], int lane, int (&res)[2]) {
    { unsigned z = 0u; asm volatile("" : "+v"(z));
#pragma unroll
      for (int j = 0; j < 8; ++j) { *(LAS v4u*)(h0 + 4 * (lane + 64 * j)) = (v4u){z, z, z, z}; *(LAS v4u*)(h1 + 4 * (lane + 64 * j)) = (v4u){z, z, z, z}; } }
    LDS_WAIT(); asm volatile("" ::: "memory");
#pragma unroll
    for (int w = 0; w < 2; ++w) { LAS unsigned* hc = (w ? h1 : h0) + (lane & 7);
#pragma unroll
      for (int e = 0; e < 32; ++e) { const unsigned d = lvl2 ? (key[w][e] & 255u) : (key[w][e] >> 8); const bool m = lvl2 ? ((key[w][e] >> 8) == B[w]) : true;
          if (m) __hip_atomic_fetch_add(hc + 8 * d, 1u, __ATOMIC_RELAXED, __HIP_MEMORY_SCOPE_WAVEFRONT); } }
    LDS_WAIT(); asm volatile("" ::: "memory");
    v4u c[2];
#pragma unroll
    for (int w = 0; w < 2; ++w) { const LAS v4u* hp = (const LAS v4u*)((w ? h1 : h0) + 32 * lane);
      const v4u a0 = hp[0], a1 = hp[1], a2 = hp[2], a3 = hp[3], a4 = hp[4], a5 = hp[5], a6 = hp[6], a7 = hp[7];
      c[w].x = (a0.x + a0.y) + (a0.z + a0.w) + (a1.x + a1.y) + (a1.z + a1.w); c[w].y = (a2.x + a2.y) + (a2.z + a2.w) + (a3.x + a3.y) + (a3.z + a3.w);
      c[w].z = (a4.x + a4.y) + (a4.z + a4.w) + (a5.x + a5.y) + (a5.z + a5.w); c[w].w = (a6.x + a6.y) + (a6.z + a6.w) + (a7.x + a7.y) + (a7.z + a7.w); }
    int sv[2], S[2];
#pragma unroll
    for (int w = 0; w < 2; ++w) { sv[w] = (int)(c[w].x + c[w].y + c[w].z + c[w].w); S[w] = sv[w]; }
#pragma unroll
    for (int w = 0; w < 2; ++w) { const int inc = wave_incl_scan(sv[w]); S[w] = __builtin_amdgcn_readlane(inc, 63) - inc + sv[w]; }
    int packed[2], Ls[2];
#pragma unroll
    for (int w = 0; w < 2; ++w) {
        const unsigned long long bm = __ballot(S[w] >= target[w]);
        Ls[w] = 63 - __clzll(bm);
        int a = S[w] - sv[w], dig, abv;
        if (a + (int)c[w].w >= target[w]) { dig = 3; abv = a; } else { a += (int)c[w].w;
            if (a + (int)c[w].z >= target[w]) { dig = 2; abv = a; } else { a += (int)c[w].z;
                if (a + (int)c[w].y >= target[w]) { dig = 1; abv = a; } else { a += (int)c[w].y; dig = 0; abv = a; } } }
        packed[w] = ((4 * lane + dig) << 12) | abv; }
    res[0] = __builtin_amdgcn_readlane(packed[0], Ls[0]); res[1] = __builtin_amdgcn_readlane(packed[1], Ls[1]);
    LDS_WAIT(); asm volatile("" ::: "memory");
}
__device__ __forceinline__ void dsa_d2_row2(Frame& F, int rowA, int rowB, const v4u (&rawA)[4], const v4u (&rawB)[4]) {
    const int lane = F.lane; const int row[2] = {rowA, rowB};
    unsigned* mbp[2]; unsigned cb[2]; int nvalid[2];
#pragma unroll
    for (int w = 0; w < 2; ++w) { const int t = row[w] % SEQ; mbp[w] = (unsigned*)(F.ws + WS_MB) + (size_t)row[w] * 64;
        int nv = t + 1 - 32 * lane; nv = nv < 0 ? 0 : (nv > 32 ? 32 : nv); nvalid[w] = nv; cb[w] = nv == 32 ? 0xffffffffu : ((1u << nv) - 1u); }
    if (rowA % SEQ < 256) { *(GAS unsigned*)(mbp[0] + lane) = cb[0]; *(GAS unsigned*)(mbp[1] + lane) = cb[1]; return; }
    unsigned key[2][32];
#pragma unroll
    for (int w = 0; w < 2; ++w)
#pragma unroll
      for (int i = 0; i < 4; ++i) { const v4u rw = w ? rawB[i] : rawA[i]; const unsigned ww[4] = {rw.x, rw.y, rw.z, rw.w};
#pragma unroll
        for (int j = 0; j < 4; ++j) {
#pragma unroll
            for (int k = 0; k < 2; ++k) { const int e = 8 * i + 2 * j + k; const unsigned u = (ww[j] >> (16 * k)) & 0xffffu;
                const unsigned sk = (u & 0x8000u) ? (~u & 0xffffu) : (u | 0x8000u);
                key[w][e] = (e < nvalid[w]) ? sk : 0u; } } }
    LAS unsigned* h0 = (LAS unsigned*)(F.lds + F.wave * 16384); LAS unsigned* h1 = h0 + 2048;
    int d1[2], d2[2]; { const unsigned B0[2] = {0u, 0u}; const int tg[2] = {256, 256}; hist_select2(h0, h1, key, false, B0, tg, lane, d1); }
    unsigned Bh[2]; int above1[2], tg2[2];
#pragma unroll
    for (int w = 0; w < 2; ++w) { Bh[w] = (unsigned)d1[w] >> 12; above1[w] = d1[w] & 0xfff; tg2[w] = 256 - above1[w]; }
    hist_select2(h0, h1, key, true, Bh, tg2, lane, d2);
    unsigned g[2], eq[2]; int need[2], myeq[2], incl[2];
#pragma unroll
    for (int w = 0; w < 2; ++w) { const unsigned T = (Bh[w] << 8) | ((unsigned)d2[w] >> 12); const int cgt = above1[w] + (d2[w] & 0xfff);
        unsigned gg = 0, ee = 0;
#pragma unroll
        for (int e = 0; e < 32; ++e) { unsigned bg = key[w][e] > T ? 1u : 0u, be = key[w][e] == T ? 1u : 0u; asm volatile("" : "+v"(bg), "+v"(be)); gg |= bg << e; ee |= be << e; }
        g[w] = gg; eq[w] = ee; need[w] = 256 - cgt; myeq[w] = __popc(ee); incl[w] = myeq[w]; }
    incl[0] = wave_incl_scan(incl[0]); incl[1] = wave_incl_scan(incl[1]);
#pragma unroll
    for (int w = 0; w < 2; ++w) { const int pre = incl[w] - myeq[w]; int take = need[w] - pre; take = take < 0 ? 0 : (take > myeq[w] ? myeq[w] : take);
        unsigned te = eq[w]; int cnt = myeq[w];
        while (cnt > take) { te &= ~(1u << (31 - __clz(te))); --cnt; }
        *(GAS unsigned*)(mbp[w] + lane) = (g[w] | te) & cb[w]; }
}
__device__ __forceinline__ void dsa_d3_task(Frame& F, int task, const bf16* PROJ) {
    const int hg = task & 3, qb = 63 - ((task >> 2) & 63), b = task >> 8; const int r32 = F.lane & 31;
    const int row0 = b * SEQ + 32 * qb;
    const bf16* qrow[3]; const unsigned* mbr[3];
#pragma unroll
    for (int s = 0; s < 3; ++s) { qrow[s] = PROJ + (size_t)(row0 + r32) * DSA_LD + DSA_Q + (3 * hg + s) * 64; mbr[s] = (const unsigned*)(F.ws + WS_MB) + (size_t)(row0 + r32) * 64; }
    LAS bf16x8* ql = wave_q(F); stage_q<3>(ql, qrow, F.lane);
    KVp kv{PROJ + (size_t)(b * SEQ) * DSA_LD + DSA_K, DSA_LD, (const bf16*)F.out + (size_t)b * 64 * SEQ, SEQ};
    f32x16 O[3][2]; float l[3]; zero_o<3, 2>(O, l);
    MaskArg ma{}; ma.q0[0] = ma.q0[1] = ma.q0[2] = 32 * qb;
    const float negb = 0.f;
    attn_core<3, 2, 0, MK_BITS, 2>(ql, kv, 0, qb + 1, negb, ma, mbr, O, l, F.lane);
    bf16* Y = (bf16*)(F.ws + WS_Y);
#pragma unroll
    for (int s = 0; s < 3; ++s) { const float lt = l[s] + __shfl_xor(l[s], 32); store_o<2, false>(O[s], (DBG_ZERO & 2) ? 0.f : 1.f / lt, Y, row0, (3 * hg + s) * 64, F.lane); }
}

constexpr unsigned D3_MOFF = 98304u, D3_ROFF = 98304u + 64u * 65u * 4u;
__device__ __forceinline__ void dsa_d3_wg_task(Frame& F, int task, const bf16* PROJ) {
    const int qb = 31 - (task >> 4), b = task & 15, w = F.wave, qs = w >> 2, hg = w & 3; const int r32 = F.lane & 31, hi = F.lane >> 5;
    const int row0 = b * SEQ + 64 * qb + 32 * qs;
    const bf16* qrow[3];
#pragma unroll
    for (int s = 0; s < 3; ++s) qrow[s] = PROJ + (size_t)(row0 + r32) * DSA_LD + DSA_Q + (3 * hg + s) * 64;
    LAS bf16x8* ql = (LAS bf16x8*)(F.lds + w * 12288) + F.lane; { const int tq_ = 64 * qb + 32 * qs + r32; const int tp[3] = {tq_, tq_, tq_}; stage_q_xf<3>(F, ql, qrow, tp, F.ka->in[14], true, QSCALE); }
    { const unsigned* mb = (const unsigned*)(F.ws + WS_MB) + (size_t)(b * SEQ + 64 * qb) * 64; LAS unsigned* ml = (LAS unsigned*)(F.lds + D3_MOFF);
#pragma unroll
      for (int j = 0; j < 2; ++j) { const int e = (F.tid + 512 * j) * 4, row = e >> 6, col = e & 63; const v4u m = *(const GAS v4u*)(mb + e);
          ml[row * 65 + col] = m.x; ml[row * 65 + col + 1] = m.y; ml[row * 65 + col + 2] = m.z; ml[row * 65 + col + 3] = m.w; } }
    asm volatile("s_waitcnt vmcnt(0) lgkmcnt(0)\n\ts_barrier" ::: "memory");
    const int kperm = (r32 & 0x13) | ((r32 & 4) << 1) | ((r32 & 8) >> 1);
    const bf16* psrc; int pstep;
    if (w < 4) { psrc = PROJ + (size_t)(b * SEQ + kperm) * DSA_LD + DSA_K + 16 * w + 8 * hi; pstep = 32 * DSA_LD; }
    else { const int j = w - 4; psrc = (const bf16*)F.out + ((size_t)b * 64 + 32 * (j >> 1) + r32) * SEQ + 16 * (j & 1) + 8 * hi; pstep = 32; }
    f32x16 O[3][2]; float l[3]; zero_o<3, 2>(O, l);
    MaskArg ma{}; ma.q0[0] = ma.q0[1] = ma.q0[2] = 64 * qb + 32 * qs;
    const LAS unsigned* mlds = (const LAS unsigned*)(F.lds + D3_MOFF) + (qs * 32 + r32) * 65;
    wg_attn<3, MK_BITS, 3>(F, ql, psrc, pstep, D3_ROFF, 0, 2 * qb + 2, 0xffffffffu, 0, 2 * qb + qs + 1, ma, mlds, O, l);
    bf16* Y = (bf16*)(F.ws + WS_Y);
#pragma unroll
    for (int s = 0; s < 3; ++s) { const float lt = l[s] + __shfl_xor(l[s], 32); store_o<2, false>(O[s], (DBG_ZERO & 2) ? 0.f : 1.f / lt, Y, row0, (3 * hg + s) * 64, F.lane); }
}

__device__ __forceinline__ void nsa_cmp_task(Frame& F, int task, int chunk, const bf16* PROJ, const float* kn0) {
    const int nb = task & 3, g = (task >> 2) & 3, b = task >> 4; const int r32 = F.lane & 31, hi = F.lane >> 5;
    const int n = 32 * nb + r32, nc = n > 126 ? 126 : n;
    const bf16* arow = PROJ + (size_t)(b * SEQ + 16 * nc) * NSA_LD + 64 * g + 8 * hi;
    const bf16* WkT = (const bf16*)(F.ws + WS_CMPW); const bf16* WvT = WkT + 64 * 2048;
    const bf16* wkp = WkT + (size_t)r32 * 2048 + 8 * hi; const bf16* wvp = WvT + (size_t)r32 * 2048 + 8 * hi;
    f32x16 Dk[2], Dv[2];
#pragma unroll
    for (int et = 0; et < 2; ++et)
#pragma unroll
        for (int r = 0; r < 16; ++r) { Dk[et][r] = 0.f; Dv[et][r] = 0.f; }
#pragma unroll 4
    for (int kk = 32 * chunk; kk < 32 * chunk + 32; ++kk) {
        const bf16* ap = arow + (size_t)(kk >> 2) * NSA_LD + 16 * (kk & 3);
        const bf16x8 kcf = ld8(ap + NSA_KC), vcf = ld8(ap + NSA_VC);
#pragma unroll
        for (int et = 0; et < 2; ++et) { const bf16x8 wk = ld8(wkp + (size_t)(32 * et) * 2048 + 16 * kk), wv = ld8(wvp + (size_t)(32 * et) * 2048 + 16 * kk);
            Dk[et] = __builtin_amdgcn_mfma_f32_32x32x16_bf16(wk, kcf, Dk[et], 0, 0, 0);
            Dv[et] = __builtin_amdgcn_mfma_f32_32x32x16_bf16(vcf, wv, Dv[et], 0, 0, 0); }
    }
    { LAS f32x4* pl = (LAS f32x4*)(F.lds + F.wave * 16384) + F.lane;
      if (chunk != 0) {
#pragma unroll
          for (int et = 0; et < 2; ++et)
#pragma unroll
              for (int c = 0; c < 4; ++c) { pl[(et * 4 + c) * 64] = (f32x4){Dk[et][4 * c], Dk[et][4 * c + 1], Dk[et][4 * c + 2], Dk[et][4 * c + 3]};
                                            pl[(8 + et * 4 + c) * 64] = (f32x4){Dv[et][4 * c], Dv[et][4 * c + 1], Dv[et][4 * c + 2], Dv[et][4 * c + 3]}; } }
      asm volatile("s_waitcnt vmcnt(0) lgkmcnt(0)\n\ts_barrier" ::: "memory");
      if (chunk != 0) return;
#pragma unroll 1
      for (int o = 1; o < 4; ++o) { const LAS f32x4* ql_ = pl + o * (16384 / 16);
#pragma unroll
          for (int et = 0; et < 2; ++et)
#pragma unroll
              for (int c = 0; c < 4; ++c) { const f32x4 a = ql_[(et * 4 + c) * 64], d = ql_[(8 + et * 4 + c) * 64];
#pragma unroll
                  for (int i = 0; i < 4; ++i) { Dk[et][4 * c + i] += a[i]; Dv[et][4 * c + i] += d[i]; } } } }
    const float* ck = (const float*)(F.ws + WS_CTL) + CW_CK; const float* cv = ck + 64;
    const float* tab = (const float*)(F.ws + WS_ROPE) + (size_t)(16 * nc + 31) * 64;
    float ss = 0.f;
#pragma unroll
    for (int et = 0; et < 2; ++et)
#pragma unroll
        for (int r = 0; r < 16; ++r) { Dk[et][r] += ck[32 * et + crow(r, hi)]; ss += Dk[et][r] * Dk[et][r]; }
    ss += __shfl_xor(ss, 32);
    const float rs = __builtin_amdgcn_rsqf(ss * (1.f / 64.f) + EPS);
    bf16* kout = (bf16*)(F.ws + WS_KCMP) + ((size_t)((b * 4 + g) * 128 + n)) * 64;
#pragma unroll
    for (int rq = 0; rq < 4; ++rq) { float o0[4], o1[4];
#pragma unroll
        for (int i = 0; i < 4; ++i) { const int r = 4 * rq + i, idx = crow(r, hi); const float v0 = Dk[0][r] * rs * kn0[idx], v1 = Dk[1][r] * rs * kn0[32 + idx];
            const float c = tab[idx], s = tab[32 + idx]; o0[i] = v0 * c - v1 * s; o1[i] = v1 * c + v0 * s; if (n > 126) { o0[i] = 0.f; o1[i] = 0.f; } }
        v2u w0, w1; w0.x = pk2(o0[0], o0[1]); w0.y = pk2(o0[2], o0[3]); w1.x = pk2(o1[0], o1[1]); w1.y = pk2(o1[2], o1[3]);
        *(GAS v2u*)(kout + 8 * rq + 4 * hi) = w0; *(GAS v2u*)(kout + 32 + 8 * rq + 4 * hi) = w1; }
    bf16* vout = (bf16*)(F.ws + WS_VCMPT) + ((size_t)((b * 4 + g) * 64)) * 128 + 32 * nb;
#pragma unroll
    for (int et = 0; et < 2; ++et) { const float cve = cv[32 * et + r32];
#pragma unroll
        for (int rq = 0; rq < 4; ++rq) { float o[4];
#pragma unroll
            for (int i = 0; i < 4; ++i) { const int nl = 8 * rq + 4 * hi + i; o[i] = (32 * nb + nl > 126) ? 0.f : Dv[et][4 * rq + i] + cve; }
            v2u w; w.x = pk2(o[0], o[1]); w.y = pk2(o[2], o[3]);
            *(GAS v2u*)(vout + (size_t)(32 * et + r32) * 128 + 8 * rq + 4 * hi) = w; } }
}
constexpr unsigned NSA_ROFF = 98304u;
template <bool WG>
__device__ NSA_INLINE void nsa_task(KArgs ka_, unsigned char* ws_, float* out_, LAS unsigned char* lds_, int wave_, int task, const bf16* PROJ) {
    Frame F; F.ka = ka_; F.ws = ws_; F.out = out_; F.lds = lds_; F.wave = wave_; F.MISC = (volatile LAS unsigned*)(lds_ + LDS_CTRL + 64);
    asm volatile("v_mbcnt_lo_u32_b32 %0, -1, 0\n\tv_mbcnt_hi_u32_b32 %0, -1, %0" : "=v"(F.lane));
    const int qb8 = 7 - (task >> 6);
    const int g = task & 3, qb = WG ? 8 * qb8 + wave_ : 63 - ((task >> 2) & 63), b = WG ? (task >> 2) & 15 : task >> 8; const int r32 = F.lane & 31, hi = F.lane >> 5;
    const int row0 = b * SEQ + 32 * qb, tq = 32 * qb + r32;
    const bf16* qrow[3];
#pragma unroll
    for (int s = 0; s < 3; ++s) qrow[s] = PROJ + (size_t)(row0 + r32) * NSA_LD + NSA_Q + (3 * g + s) * 64;
    LAS bf16x8* ql = WG ? (LAS bf16x8*)(F.lds + F.wave * 12288) + F.lane : wave_q(F); { const int tp[3] = {tq, tq, tq}; stage_q_xf<3>(F, ql, qrow, tp, F.ka->in[17], true, QSCALE); }
#define NSA_GLOAD(c_, dst_) do { const GAS bf16* gp_ = (const GAS bf16*)PROJ + (size_t)(row0 + r32) * NSA_LD + NSA_GT + 9 * g + (c_); dst_[0] = gp_[0]; dst_[1] = gp_[3]; dst_[2] = gp_[6]; } while (0)
#define NSA_GATE(s_, c_) NSA_SIG(PROJ[(size_t)(row0 + r32) * NSA_LD + NSA_GT + 9 * g + 3 * (s_) + (c_)])
#define NSA_SIG(raw_) (__builtin_amdgcn_rcpf(1.f + fast_exp2(-1.4426950408889634f * bf2f(raw_))))
    bf16* Y = (bf16*)(F.ws + WS_Y);
    MaskArg ma{}; ma.q0[0] = ma.q0[1] = ma.q0[2] = 32 * qb; ma.nmax = tq >= 31 ? (tq - 31) >> 4 : -1;
    const KVp kvc{(const bf16*)(F.ws + WS_KCMP) + (size_t)((b * 4 + g) * 128) * 64, 64, (const bf16*)(F.ws + WS_VCMPT) + (size_t)((b * 4 + g) * 64) * 128, 128};
    float imp[16];
#pragma unroll
    for (int r = 0; r < 16; ++r) imp[r] = 0.f;
    {
        const int kperm = (r32 & 0x13) | ((r32 & 4) << 1) | ((r32 & 8) >> 1);
        { const int kt = F.wave >> 1; const unsigned dst = (unsigned)(uintptr_t)F.lds + NSA_ROFF + (unsigned)kt * 8192u + (unsigned)(F.wave & 1) * 4096u;
          if ((F.wave & 1) == 0) { const bf16* kp = kvc.K + (size_t)(32 * kt + kperm) * 64 + 8 * hi;
#pragma unroll
              for (int ks = 0; ks < 4; ++ks) glds16(kp + 16 * ks, (unsigned)__builtin_amdgcn_readfirstlane(dst + ks * 1024u)); }
          else { const bf16* vp = kvc.VT + (size_t)r32 * 128 + 32 * kt + 8 * hi;
#pragma unroll
              for (int j = 0; j < 4; ++j) glds16(vp + (size_t)(32 * (j >> 1)) * 128 + 16 * (j & 1), (unsigned)__builtin_amdgcn_readfirstlane(dst + j * 1024u)); } }
        unsigned short g0r[3]; NSA_GLOAD(0, g0r);
        asm volatile("s_waitcnt vmcnt(0)\n\ts_barrier" ::: "memory");
#pragma unroll 1
        for (int s = 0; s < 3; ++s) { f32x16 ia, Oc[2]; float ls = 0.f;
#pragma unroll
            for (int r = 0; r < 16; ++r) { ia[r] = 0.f; Oc[0][r] = 0.f; Oc[1][r] = 0.f; }
            bf16x8 qq[4];
#pragma unroll
            for (int ks = 0; ks < 4; ++ks) qq[ks] = ql[(s * 4 + ks) * 64];
#pragma unroll 1
            for (int kt = 0; kt < 4; ++kt) {
                const LAS bf16x8* sp = (const LAS bf16x8*)(F.lds + NSA_ROFF + kt * 8192) + F.lane;
                bf16x8 kf[4], vf[2][2];
#pragma unroll
                for (int ks = 0; ks < 4; ++ks) kf[ks] = sp[ks * 64];
#pragma unroll
                for (int nt = 0; nt < 2; ++nt) { vf[0][nt] = sp[(4 + 2 * nt) * 64]; vf[1][nt] = sp[(5 + 2 * nt) * 64]; }
                f32x16 acc;
#pragma unroll
                for (int r = 0; r < 16; ++r) acc[r] = 0.f;
#pragma unroll
                for (int ks = 0; ks < 4; ++ks) acc = __builtin_amdgcn_mfma_f32_32x32x16_bf16(kf[ks], qq[ks], acc, 0, 0, 0);
                float p[16];
#pragma unroll
                for (int r = 0; r < 16; ++r) { const int key = 32 * kt + 8 * hi + 16 * (r >> 3) + (r & 7); p[r] = key <= ma.nmax ? fast_exp2(acc[r]) : 0.f; ls += p[r]; }
#pragma unroll
                for (int ks2 = 0; ks2 < 2; ++ks2) { v4u pw, cw; unsigned short cvv[8];
                    pw.x = pk2(p[8 * ks2], p[8 * ks2 + 1]); pw.y = pk2(p[8 * ks2 + 2], p[8 * ks2 + 3]); pw.z = pk2(p[8 * ks2 + 4], p[8 * ks2 + 5]); pw.w = pk2(p[8 * ks2 + 6], p[8 * ks2 + 7]);
                    unsigned one_ = 0x3f80u; asm volatile("" : "+v"(one_));
#pragma unroll
                    for (int jj = 0; jj < 8; ++jj) { const int nn = 32 * kt + 16 * ks2 + 8 * hi + jj; cvv[jj] = (nn >= 4 * r32 - 1 && nn <= 4 * r32 + 3) ? (unsigned short)one_ : (unsigned short)0; }
                    cw.x = cvv[0] | (cvv[1] << 16); cw.y = cvv[2] | (cvv[3] << 16); cw.z = cvv[4] | (cvv[5] << 16); cw.w = cvv[6] | (cvv[7] << 16);
                    const bf16x8 pf = __builtin_bit_cast(bf16x8, pw);
                    ia = __builtin_amdgcn_mfma_f32_32x32x16_bf16(__builtin_bit_cast(bf16x8, cw), pf, ia, 0, 0, 0);
                    Oc[0] = __builtin_amdgcn_mfma_f32_32x32x16_bf16(pf, vf[ks2][0], Oc[0], 0, 0, 0);
                    Oc[1] = __builtin_amdgcn_mfma_f32_32x32x16_bf16(pf, vf[ks2][1], Oc[1], 0, 0, 0); }
            }
            const float lt = ls + __shfl_xor(ls, 32); const float inv = lt > 0.f ? 1.f / lt : 0.f;
#pragma unroll
            for (int r = 0; r < 16; ++r) imp[r] += ia[r] * inv;
            store_o<2, false>(Oc, (DBG_ZERO & 4) ? 0.f : NSA_SIG(s == 0 ? g0r[0] : (s == 1 ? g0r[1] : g0r[2])) * inv, Y, row0, (3 * g + s) * 64, F.lane);
        }
    }
    unsigned sel;
    { const int qblk = tq >> 6;
      if (32 * qb + 31 < 1024) sel = (2u << qblk) - 1u;
      else { float val[16], oth[16];
#pragma unroll
        for (int r = 0; r < 16; ++r) { const int j = crow(r, hi); val[r] = j > qblk ? -1e30f : ((j == 0 || j == qblk || j == qblk - 1) ? 1e9f : imp[r]); oth[r] = __shfl_xor(val[r], 32); }
        unsigned mine = 0;
#pragma unroll
        for (int r = 0; r < 16; ++r) { const int j = crow(r, hi); int rank = 0;
#pragma unroll
            for (int r2 = 0; r2 < 16; ++r2) { const int j2 = crow(r2, hi), j3 = crow(r2, hi ^ 1);
                rank += (val[r2] > val[r] || (val[r2] == val[r] && j2 < j)) ? 1 : 0;
                rank += (oth[r2] > val[r] || (oth[r2] == val[r] && j3 < j)) ? 1 : 0; }
            mine |= ((rank < 16 && j <= qblk) ? 1u : 0u) << ((r & 3) + 8 * (r >> 2)); }
        mine <<= 4 * hi;
        sel = mine | __shfl_xor(mine, 32); } }
    const unsigned* mbr2[2] = {nullptr, nullptr}; const unsigned* mbr1[1] = {nullptr};
    const KVp kvs{PROJ + (size_t)(b * SEQ) * NSA_LD + NSA_KS + 64 * g, NSA_LD, (const bf16*)F.out + ((size_t)b * 256 + 64 * g) * SEQ, SEQ};
    const KVp kvw{PROJ + (size_t)(b * SEQ) * NSA_LD + NSA_KW + 64 * g, NSA_LD, (const bf16*)F.out + (size_t)NB * 256 * SEQ + ((size_t)b * 256 + 64 * g) * SEQ, SEQ};
    ma.sel = sel;
#define NSA_BRANCH(MT_, KV_, KT0_, KT1_, C_, ADD_, ZBIT_) do { \
      { f32x16 O2[2][2]; float l2[2]; zero_o<2, 2>(O2, l2); attn_core<2, 2, 0, MT_>(ql, KV_, KT0_, KT1_, 0.f, ma, mbr2, O2, l2, F.lane); VM_WAIT(); \
        _Pragma("unroll") for (int s = 0; s < 2; ++s) { const float lt = l2[s] + __shfl_xor(l2[s], 32); \
          store_o<2, ADD_>(O2[s], (lt > 0.f && !(DBG_ZERO & ZBIT_)) ? NSA_GATE(s, C_) / lt : 0.f, Y, row0, (3 * g + s) * 64, F.lane); } } \
      { f32x16 O1[1][2]; float l1[1]; zero_o<1, 2>(O1, l1); attn_core<1, 2, 0, MT_>(ql + 2 * 4 * 64, KV_, KT0_, KT1_, 0.f, ma, mbr1, O1, l1, F.lane); VM_WAIT(); \
        const float lt = l1[0] + __shfl_xor(l1[0], 32); \
        store_o<2, ADD_>(O1[0], (lt > 0.f && !(DBG_ZERO & ZBIT_)) ? NSA_GATE(2, C_) / lt : 0.f, Y, row0, (3 * g + 2) * 64, F.lane); } } while (0)
    if (!WG) {
    NSA_BRANCH(MK_SLC, kvs, 0, qb + 1, 1, true, 16);
    NSA_BRANCH(MK_WIN, kvw, (qb > 16 ? qb - 16 : 0), qb + 1, 2, true, 32);
    } else {
        unsigned wsel = sel;
#pragma unroll
        for (int o = 1; o < 32; o <<= 1) wsel |= __shfl_xor(wsel, o);
        if (F.lane == 0) __hip_atomic_fetch_or((LAS unsigned*)(F.lds + LDS_CTRL + 64) + 17, wsel, __ATOMIC_RELAXED, __HIP_MEMORY_SCOPE_WORKGROUP);
        asm volatile("s_waitcnt vmcnt(0) lgkmcnt(0)\n\ts_barrier" ::: "memory");
        const unsigned blk = (unsigned)__builtin_amdgcn_readfirstlane((int)F.MISC[17]);
        const int kperm = (r32 & 0x13) | ((r32 & 4) << 1) | ((r32 & 8) >> 1), w = F.wave;
#define NSA_WGBRANCH(MT_, KCOL_, VTOFF_, KT0_, KT1_, MY0_, MY1_, BLK_, C_, ZBIT_) do { \
        const bf16* psrc; int pstep; \
        if (w < 4) { psrc = PROJ + (size_t)(b * SEQ + kperm) * NSA_LD + (KCOL_) + 64 * g + 16 * w + 8 * hi; pstep = 32 * NSA_LD; } \
        else { const int j_ = w - 4; psrc = (const bf16*)F.out + (VTOFF_) + ((size_t)b * 256 + 64 * g + 32 * (j_ >> 1) + r32) * SEQ + 16 * (j_ & 1) + 8 * hi; pstep = 32; } \
        f32x16 O3[3][2]; float l3[3]; zero_o<3, 2>(O3, l3); \
        wg_attn2<3, MT_>(F, ql, psrc, pstep, NSA_ROFF, KT0_, KT1_, BLK_, MY0_, MY1_, ma, O3, l3); \
        unsigned short gr_[3]; NSA_GLOAD(C_, gr_); \
        _Pragma("unroll") for (int s = 0; s < 3; ++s) { const float lt = l3[s] + __shfl_xor(l3[s], 32); \
          store_o<2, true>(O3[s], (lt > 0.f && !(DBG_ZERO & ZBIT_)) ? NSA_SIG(gr_[s]) / lt : 0.f, Y, row0, (3 * g + s) * 64, F.lane); } } while (0)
        NSA_WGBRANCH(MK_SLC, NSA_KS, (size_t)0, 0, 8 * qb8 + 8, 0, qb + 1, blk, 1, 16);
        NSA_WGBRANCH(MK_WIN, NSA_KW, (size_t)NB * 256 * SEQ, (8 * qb8 > 16 ? 8 * qb8 - 16 : 0), 8 * qb8 + 8, (qb > 16 ? qb - 16 : 0), qb + 1, 0xffffffffu, 2, 32);
#undef NSA_WGBRANCH
    }
#undef NSA_BRANCH
}
__device__ __forceinline__ void prologue_misc(Frame& F) {
    float* tab = (float*)(F.ws + WS_ROPE);
    for (int idx = blockIdx.x * (NWAVES * 64) + F.tid; idx < SEQ * 32; idx += F.G * NWAVES * 64) {
        const int t = idx >> 5, i = idx & 31;
        const float inv = exp2f(-(float)i * (13.287712379549449f / 32.0f));
        const float ang = (float)t * inv; float s, c; sincosf(ang, &s, &c);
        tab[t * 64 + i] = c; tab[t * 64 + 32 + i] = s; }
    if (F.wave < 2) {
#pragma unroll 1
        for (int part = blockIdx.x; part < 256; part += F.G) {
            const int kv = F.wave; const float* pos = (kv ? F.ka->in[20] : F.ka->in[19]) + 8 * part; const float* w = (kv ? F.ka->in[22] : F.ka->in[21]) + (size_t)(8 * part) * 64 + F.lane;
            float pv[8], wv[8];
#pragma unroll
            for (int i = 0; i < 8; ++i) { pv[i] = pos[i]; wv[i] = w[i * 64]; }
            float a = 0.f;
#pragma unroll
            for (int i = 0; i < 8; ++i) a += pv[i] * wv[i];
            ((float*)(F.ws + WS_CTL) + CW_CKP)[(kv * 256 + part) * 64 + F.lane] = a; }
    }
}
__device__ __forceinline__ void ck_reduce(Frame& F) {
    const int o = F.tid & 127, qd = F.tid >> 7; const float* cp = (const float*)(F.ws + WS_CTL) + CW_CKP + ((o >> 6) * 256 + 64 * qd) * 64 + (o & 63);
    float a = 0.f;
#pragma unroll 8
    for (int p = 0; p < 64; ++p) a += cp[p * 64];
    LAS float* red = (LAS float*)F.lds; red[F.tid] = a;
    __syncthreads();
    if (F.tid < 128) ((float*)(F.ws + WS_CTL) + CW_CK)[F.tid] = (red[F.tid] + red[F.tid + 128]) + (red[F.tid + 256] + red[F.tid + 384]);
}
__device__ __forceinline__ void prologue_phase(Frame& F) {
    prologue_misc(F);
    bf16* XB = (bf16*)(F.ws + WS_XB); float* PART = (float*)(F.ws + WS_PART);
    for (int m = F.gw; m < MTOK / 2; m += F.NGW) row2_to_bf16(F, F.ka->in[0] + (size_t)m * DM, XB + (size_t)m * DM, PART + (size_t)m * 16, (size_t)(MTOK / 2) * DM);
    bf16* MEMB = (bf16*)(F.ws + WS_MEMB); float* PARTM = (float*)(F.ws + WS_PARTM);
    for (int m = F.gw; m < MMEM; m += F.NGW) row_to_bf16(F, F.ka->in[1] + (size_t)m * DM, MEMB + (size_t)m * DM, PARTM + (size_t)m * 16);
    int itb = 0;
#pragma unroll 1
    for (int ly = 0; ly < DEPTH; ++ly) cvt_matrix(F, itb, F.ka->in[9] + (size_t)ly * DM * 512, nullptr, 512, 512, F.ka->in[8] + (size_t)ly * DM, (bf16*)(F.ws + WS_WKV) + (size_t)ly * 512 * DM, DM, 512, 0);
    cvt_matrix(F, itb, F.ka->in[21], nullptr, 64, 64, nullptr, (bf16*)(F.ws + WS_CMPW), 2048, 64, 0);
    cvt_matrix(F, itb, F.ka->in[22], nullptr, 64, 64, nullptr, (bf16*)(F.ws + WS_CMPW) + 64 * 2048, 2048, 64, 0);
    F.cv_lo = F.G > 128 ? CV_SPLIT : 0; convert_layer(F, 0); F.cv_lo = 0;
}

__device__ __forceinline__ void idle_convert(Frame& F, int Ly, int wi, int nw) {
    const int gw0 = F.gw, ngw0 = F.NGW;
    F.gw = wi * NWAVES + F.wave; F.NGW = nw * NWAVES; F.cv_lo = 0; F.cv_hi = CV_SPLIT;
    convert_layer(F, Ly);
    F.gw = gw0; F.NGW = ngw0; F.cv_lo = 0; F.cv_hi = 0x7fffffff;
}

template <unsigned PHASE_MASK> __global__ void __launch_bounds__(NWAVES * 64, 2) mk_fwd(Args args) {
    extern __shared__ __attribute__((aligned(16))) unsigned char lds[];
    __builtin_assume(blockIdx.x < 256u); __builtin_assume(gridDim.x <= 256u);
    Frame F;
    F.lds = (LAS unsigned char*)lds;
    F.MISC = (volatile LAS unsigned*)(F.lds + LDS_CTRL + 64);
    F.tid = threadIdx.x; F.lane = F.tid & 63; F.wave = __builtin_amdgcn_readfirstlane(F.tid >> 6); __builtin_assume(F.wave >= 0 && F.wave < NWAVES);
    F.G = gridDim.x; F.gw = blockIdx.x * NWAVES + F.wave; F.NGW = F.G * NWAVES; F.cv_lo = 0; F.cv_hi = 0x7fffffff;
    F.ws = args.ws; F.ctl = (gu32*)(args.ws + WS_CTL); F.out = args.out;
    F.ka = (KArgs)__builtin_amdgcn_kernarg_segment_ptr();
    for (int u = F.tid; u < 1024 / 4; u += NWAVES * 64) ((LAS unsigned*)(F.lds + LDS_CTRL))[u] = 0u;
    __syncthreads();
    XcdBarrier bar = xcd_barrier_post((unsigned*)(F.ctl + CW_BAR), F.MISC + 8);
    constexpr bool ALLPH = PHASE_MASK == 0xffffffffu;
    const int lo = ALLPH ? 0 : args.ph_lo, hi = ALLPH ? 0 : args.ph_hi; int pc = 0;
    const bool dry = ALLPH ? false : (args.dry != 0);
#define PH_BEGIN(id) if (ALLPH || ((((PHASE_MASK) >> (id)) & 1u) && lo <= pc && pc < hi)) { asm volatile("" : "+s"(F.ka), "+s"(F.ws), "+s"(F.out), "+s"(F.gw), "+s"(F.NGW), "+s"(F.G), "+s"(F.wave)); asm volatile("v_mbcnt_lo_u32_b32 %0, -1, 0\n\tv_mbcnt_hi_u32_b32 %0, -1, %0" : "=v"(F.lane)); F.tid = F.wave * 64 + F.lane;
#define PH_END_(islast)   if (ALLPH ? !(islast) : (pc + 1 < hi)) { XcdBarrier b2_ = bar; asm volatile("" : "+s"(b2_.bar), "+s"(b2_.x)); xcd_barrier(b2_); for (int e_ = 0; e_ < BAR_EXTRA; ++e_) { asm volatile("" : "+s"(b2_.bar), "+s"(b2_.x)); xcd_barrier(b2_); } } } if (!ALLPH) ++pc;
#define PH_END PH_END_(false)
#define QCTR(i) (F.ctl + CW_Q + 64 * (i))

#define RS_TABLE(S_) PG8_LAS float* rsl_ = F.G == 256 ? (PG8_LAS float*)(F.lds + RS_LDS_OFF) : nullptr;
#define XB ((bf16*)(F.ws + WS_XB))
#define VTB ((bf16*)F.out)
#define Yb ((bf16*)(F.ws + WS_Y))
#define HID ((bf16*)(F.ws + WS_HID))
#define PART ((float*)(F.ws + WS_PART))
    LAS unsigned char* ring = F.lds;

    PH_BEGIN(0) prologue_phase(F); PH_END
    PH_BEGIN(1) { pg8::Gemm g{(const bf16*)(F.ws + WS_MEMB), (const bf16*)(F.ws + WS_WKV), MMEM, 2048, DM}; pg8::StaticOrder S; S.init(MMEM, 2048, F.G, (int)blockIdx.x & 255);
        pg8::EpiScale E{(bf16*)(F.ws + WS_MKV), 2048, (const float*)(F.ws + WS_PARTM), nullptr};
        pg8::gemm_phase<pg8::EpiScale, pg8::StaticOrder, true, true>(ring, g, S, E, F.wave);
        if ((int)blockIdx.x == F.G - 1) ck_reduce(F);
        if (F.G > 128 && (int)blockIdx.x >= 128) { asm volatile("s_waitcnt vmcnt(0) lgkmcnt(0)\n\ts_barrier" ::: "memory"); idle_convert(F, 0, (int)blockIdx.x - 128, F.G - 128); } } PH_END

#pragma unroll 1
    for (int Ly = 0; Ly < DEPTH; ++Ly) {
#define WB ((const bf16*)(F.ws + WS_WBUF0 + (size_t)(Ly & 1) * WBUF_BYTES))
        const int kind = Ly % 3;
        const int ldp = kind == 0 ? RET_LD : (kind == 1 ? DSA_LD : NSA_LD);
        PH_BEGIN(3) { pg8::Gemm g{XB, WB + WB_W1A, MTOK, 2 * FF, DM}; pg8::StaticOrder S; S.init(MTOK, 2 * FF, F.G, (int)blockIdx.x & 255);
            RS_TABLE(S);
            pg8::EpiSwiglu E{HID, FF, PART, 0, rsl_};
            pg8::gemm_phase<pg8::EpiSwiglu, pg8::StaticOrder, true, true>(ring, g, S, E, F.wave); } PH_END
        PH_BEGIN(4) { pg8::Gemm g{HID, WB + WB_W2A, MTOK, DM, FF}; pg8::StaticOrder S; S.init(MTOK, DM, F.G, (int)blockIdx.x & 255);
            pg8::EpiResid E{XB, XB, nullptr, PART, dry ? 0.f : 0.5f};
            pg8::gemm_phase<pg8::EpiResid, pg8::StaticOrder, true, true>(ring, g, S, E, F.wave); } PH_END
        PH_BEGIN(5) { pg8::Gemm g{XB, WB + WB_WIN, MTOK, ldp, DM}; pg8::StaticOrder S; S.init(MTOK, ldp, F.G, (int)blockIdx.x & 255);
            RS_TABLE(S);
            pg8::EpiScale E{HID, ldp, PART, rsl_};
            pg8::gemm_phase<pg8::EpiScale, pg8::StaticOrder, true, true>(ring, g, S, E, F.wave);
            if (kind != 0 && Ly + 1 < DEPTH && F.G == 256 && (int)blockIdx.x >= 128 && !dry) idle_convert(F, Ly + 1, (int)blockIdx.x - 128, 128); } PH_END
        PH_BEGIN(6)
#define DO_X (!dry || DRY_MODE == 0 || DRY_MODE == 11)
#define DO_T (!dry || DRY_MODE == 0 || DRY_MODE == 12)
#define DO_C (!dry || DRY_MODE == 0 || DRY_MODE == 13)
            if (kind == 0) {
                if (DO_X) xform(F, HID, ldp, RET_K, 6, MTOK, SEQ, (dry ? Yb : HID), 0, (dry ? 1024 : ldp), (dry ? 0 : RET_K), nullptr, true, 0.125f, RET_MODE == 1 ? -1 : 0);
#if !QF_MEM
                xform(F, HID, ldp, RET_QM, 4, MTOK, SEQ, HID, 0, ldp, RET_QM, F.ka->in[10] + Ly * 64, false, QSCALE, 0);
#endif
                if (DO_T) transpose_cols(F, HID, ldp, RET_V, 768, NB, SEQ, VTB);
            } else if (kind == 1) {
                if (DO_X) xform(F, HID, ldp, DSA_K, 1, MTOK, SEQ, (dry ? Yb : HID), 0, (dry ? 1024 : ldp), (dry ? 0 : DSA_K), F.ka->in[15], true, 1.f, 0);
                if (DO_X) xform(F, HID, ldp, DSA_IK, 1, MTOK, SEQ, (dry ? Yb : HID), 0, (dry ? 1024 : ldp), (dry ? 0 : DSA_IK), nullptr, true, 1.f, 0);
#if !QF_MEM
                xform(F, HID, ldp, DSA_QM, 4, MTOK, SEQ, HID, 0, ldp, DSA_QM, F.ka->in[10] + Ly * 64, false, QSCALE, 0);
#endif
                if (DO_T) transpose_cols(F, HID, ldp, DSA_V, 64, NB, SEQ, VTB);
            } else {
                if (DO_T && blockIdx.x < 128) nsa_cmp_task(F, 2 * (int)blockIdx.x + (F.wave >> 2), F.wave & 3, HID, F.ka->in[18]);
                if (DO_X) xform(F, HID, ldp, NSA_KS, 4, MTOK, SEQ, (dry ? Yb : HID), 0, (dry ? 1024 : ldp), (dry ? 0 : NSA_KS), F.ka->in[18] + 64, true, 1.f, 0);
                if (DO_X) xform(F, HID, ldp, NSA_KW, 4, MTOK, SEQ, (dry ? Yb : HID), 0, (dry ? 1024 : ldp), (dry ? 0 : NSA_KW), F.ka->in[18] + 128, true, 1.f, 0);
#if !QF_MEM
                xform(F, HID, ldp, NSA_QM, 4, MTOK, SEQ, HID, 0, ldp, NSA_QM, F.ka->in[10] + Ly * 64, false, QSCALE, 0);
#endif
                if (DO_T) transpose_cols(F, HID, ldp, NSA_VS, 256, NB, SEQ, VTB);
                if (DO_T) transpose_cols(F, HID, ldp, NSA_VW, 256, NB, SEQ, VTB + (size_t)NB * 256 * SEQ);
            }
            if (Ly == 0 && !dry) {
#pragma unroll 1
        for (int ly = 0; ly < DEPTH; ++ly) {
            xform(F, (const bf16*)(F.ws + WS_MKV), 2048, ly * 512, 4, MMEM, NMEMT, (bf16*)(F.ws + WS_MK) + (size_t)ly * NB * 4 * NMEMT * 64, 1, 0, 0, F.ka->in[11] + ly * 64, false, 1.f, 0);
            transpose_cols(F, (const bf16*)(F.ws + WS_MKV), 2048, ly * 512 + 256, 256, NB, NMEMT, (bf16*)(F.ws + WS_MVT) + (size_t)ly * NB * 256 * NMEMT);
        }
            }
            if (DO_C && Ly + 1 < DEPTH) { F.cv_lo = (kind != 0 && F.G == 256 && !dry) ? CV_SPLIT : 0; convert_layer(F, Ly + 1); F.cv_lo = 0; }
#undef DO_X
#undef DO_T
#undef DO_C
        PH_END
        if (kind == 0) {
            PH_BEGIN(7)
                for (;;) {
                    asm volatile("s_waitcnt vmcnt(0) lgkmcnt(0)\n\ts_barrier" ::: "memory");
                    if (F.wave == 0 && pg8::lane_now() == 0) F.MISC[16] = __hip_atomic_fetch_add(QCTR(Ly * 8 + 0), 1u, RLX_AGENT);
                    asm volatile("s_waitcnt vmcnt(0) lgkmcnt(0)\n\ts_barrier" ::: "memory");
                    const int t = __builtin_amdgcn_readfirstlane((int)F.MISC[16]);
                    if (t >= NB * 6 + NB * 16) break;
                    asm volatile("v_mbcnt_lo_u32_b32 %0, -1, 0\n\tv_mbcnt_hi_u32_b32 %0, -1, %0" : "=v"(F.lane));
                    if (t < NB * 6) ret_state_task(F, t, HID); else mem_wg_task(F, t - NB * 6, Ly, HID, ldp, RET_QM);
                }
            PH_END
            PH_BEGIN(15)
                for (;;) {
                    asm volatile("s_waitcnt vmcnt(0) lgkmcnt(0)\n\ts_barrier" ::: "memory");
                    if (F.wave == 0 && pg8::lane_now() == 0) F.MISC[16] = __hip_atomic_fetch_add(QCTR(Ly * 8 + 3), 1u, RLX_AGENT);
                    asm volatile("s_waitcnt vmcnt(0) lgkmcnt(0)\n\ts_barrier" ::: "memory");
                    const int t = __builtin_amdgcn_readfirstlane((int)F.MISC[16]);
                    if (t >= NB * 6 * 8) break;
                    asm volatile("v_mbcnt_lo_u32_b32 %0, -1, 0\n\tv_mbcnt_hi_u32_b32 %0, -1, %0" : "=v"(F.lane));
                    ret_wg_task(F, t, HID);
                }
            PH_END
        } else if (kind == 1) {
            PH_BEGIN(8)
                for (;;) { asm volatile("v_mbcnt_lo_u32_b32 %0, -1, 0\n\tv_mbcnt_hi_u32_b32 %0, -1, %0" : "=v"(F.lane)); const int t = grab(QCTR(Ly * 8 + 0), F.lane); if (t >= 4608) break; if (!(dry && DRY_MODE == 21)) dsa_d1_task(F, t, HID); }
                for (;;) {
                    asm volatile("s_waitcnt vmcnt(0) lgkmcnt(0)\n\ts_barrier" ::: "memory");
                    if (F.wave == 0 && pg8::lane_now() == 0) F.MISC[16] = __hip_atomic_fetch_add(QCTR(Ly * 8 + 4), 1u, RLX_AGENT);
                    asm volatile("s_waitcnt vmcnt(0) lgkmcnt(0)\n\ts_barrier" ::: "memory");
                    const int t = __builtin_amdgcn_readfirstlane((int)F.MISC[16]);
                    if (t >= NB * 16) break;
                    asm volatile("v_mbcnt_lo_u32_b32 %0, -1, 0\n\tv_mbcnt_hi_u32_b32 %0, -1, %0" : "=v"(F.lane));
                    mem_wg_task(F, t, Ly, HID, ldp, DSA_QM);
                }
            PH_END
            PH_BEGIN(9)
                for (;;) { asm volatile("v_mbcnt_lo_u32_b32 %0, -1, 0\n\tv_mbcnt_hi_u32_b32 %0, -1, %0" : "=v"(F.lane)); const int t = grab(QCTR(Ly * 8 + 1), F.lane); if (t >= MTOK / 8) break;
{ v4u ra[4], rb[4], rc[4], rd[4]; d2_load(F, MTOK - 1 - 8 * t, ra); d2_load(F, MTOK - 2 - 8 * t, rb);
#pragma unroll 1
                      for (int i = 0; i < 8; i += 4) { d2_load(F, MTOK - 1 - (8 * t + i + 2), rc); d2_load(F, MTOK - 1 - (8 * t + i + 3), rd);
                          dsa_d2_row2(F, MTOK - 1 - (8 * t + i), MTOK - 1 - (8 * t + i + 1), ra, rb);
                          if (i + 4 < 8) { d2_load(F, MTOK - 1 - (8 * t + i + 4), ra); d2_load(F, MTOK - 1 - (8 * t + i + 5), rb); }
                          dsa_d2_row2(F, MTOK - 1 - (8 * t + i + 2), MTOK - 1 - (8 * t + i + 3), rc, rd); } } }
            PH_END
            PH_BEGIN(10)
                                for (;;) {
                    asm volatile("s_waitcnt vmcnt(0) lgkmcnt(0)\n\ts_barrier" ::: "memory");
                    if (F.wave == 0 && pg8::lane_now() == 0) F.MISC[16] = __hip_atomic_fetch_add(QCTR(Ly * 8 + 3), 1u, RLX_AGENT);
                    asm volatile("s_waitcnt vmcnt(0) lgkmcnt(0)\n\ts_barrier" ::: "memory");
                    const int t = __builtin_amdgcn_readfirstlane((int)F.MISC[16]);
                    if (t >= NB * 32) break;
                    asm volatile("v_mbcnt_lo_u32_b32 %0, -1, 0\n\tv_mbcnt_hi_u32_b32 %0, -1, %0" : "=v"(F.lane)); F.tid = F.wave * 64 + F.lane;
                    dsa_d3_wg_task(F, t, HID);
                }

            PH_END
        } else {
            PH_BEGIN(11)
                if (!(dry && DRY_MODE == 21)) for (;;) {
                    asm volatile("s_waitcnt vmcnt(0) lgkmcnt(0)\n\ts_barrier" ::: "memory");
                    if (F.wave == 0 && pg8::lane_now() == 0) { F.MISC[16] = __hip_atomic_fetch_add(QCTR(Ly * 8 + 3), 1u, RLX_AGENT); F.MISC[17] = 0u; }
                    asm volatile("s_waitcnt vmcnt(0) lgkmcnt(0)\n\ts_barrier" ::: "memory");
                    const int t = __builtin_amdgcn_readfirstlane((int)F.MISC[16]);
                    if (t >= NB * 4 * 8) break;
                    nsa_task<true>(F.ka, F.ws, F.out, F.lds, F.wave, t, HID);
                }
                for (;;) {
                    asm volatile("s_waitcnt vmcnt(0) lgkmcnt(0)\n\ts_barrier" ::: "memory");
                    if (F.wave == 0 && pg8::lane_now() == 0) F.MISC[16] = __hip_atomic_fetch_add(QCTR(Ly * 8 + 0), 1u, RLX_AGENT);
                    asm volatile("s_waitcnt vmcnt(0) lgkmcnt(0)\n\ts_barrier" ::: "memory");
                    const int t = __builtin_amdgcn_readfirstlane((int)F.MISC[16]);
                    if (t >= NB * 16) break;
                    asm volatile("v_mbcnt_lo_u32_b32 %0, -1, 0\n\tv_mbcnt_hi_u32_b32 %0, -1, %0" : "=v"(F.lane));
                    mem_wg_task(F, t, Ly, HID, ldp, NSA_QM);
                }
            PH_END
        }
        PH_BEGIN(12) { pg8::Gemm g{Yb, WB + WB_WO, MTOK, DM, DM}; pg8::StaticOrder S; S.init(MTOK, DM, F.G, (int)blockIdx.x & 255);
            pg8::EpiResid E{XB, XB, nullptr, PART, dry ? 0.f : 1.0f};
            pg8::gemm_phase<pg8::EpiResid, pg8::StaticOrder, true, true>(ring, g, S, E, F.wave); } PH_END
        PH_BEGIN(13) { pg8::Gemm g{XB, WB + WB_W1B, MTOK, 2 * FF, DM}; pg8::StaticOrder S; S.init(MTOK, 2 * FF, F.G, (int)blockIdx.x & 255);
            RS_TABLE(S);
            pg8::EpiSwiglu E{HID, FF, PART, 0, rsl_};
            pg8::gemm_phase<pg8::EpiSwiglu, pg8::StaticOrder, true, true>(ring, g, S, E, F.wave); } PH_END
        PH_BEGIN(14) { pg8::Gemm g{HID, WB + WB_W2B, MTOK, DM, FF}; pg8::StaticOrder S; S.init(MTOK, DM, F.G, (int)blockIdx.x & 255);
            pg8::EpiResid E{XB, XB, Ly == DEPTH - 1 ? F.out : nullptr, PART, dry ? 0.f : 0.5f};
            pg8::gemm_phase<pg8::EpiResid, pg8::StaticOrder, true, true>(ring, g, S, E, F.wave); } PH_END_(Ly == DEPTH - 1)
    }
#undef XB
#undef VTB
#undef Yb
#undef HID
#undef PART
#undef WB
#undef PH_BEGIN
#undef PH_END
#undef PH_END_
}

constexpr int LDS_BYTES = 147456;
#ifndef MK_PER_PHASE
#define MK_PER_PHASE 0
#endif
typedef void (*kern_t)(Args);
template <unsigned M> static kern_t kern_of() { return mk_fwd<M>; }
#if MK_PER_PHASE
static kern_t phase_kernel(int id) {
    switch (id) {
        case 0: return kern_of<1u << 0>(); case 1: return kern_of<1u << 1>(); case 2: return kern_of<1u << 2>(); case 3: return kern_of<1u << 3>(); case 4: return kern_of<1u << 4>();
        case 5: return kern_of<1u << 5>(); case 6: return kern_of<1u << 6>(); case 7: return kern_of<1u << 7>(); case 8: return kern_of<1u << 8>(); case 9: return kern_of<1u << 9>();
        case 10: return kern_of<1u << 10>(); case 11: return kern_of<1u << 11>(); case 12: return kern_of<1u << 12>(); case 13: return kern_of<1u << 13>(); default: return kern_of<1u << 14>();
    }
}
#endif
extern "C" void kernel_launch(void* const* d_in, const int* in_sizes, int n_in, void* d_out, int out_size, void* d_ws, size_t ws_size, hipStream_t stream) {
    static int grid = 0;
    if (grid == 0) {
        if (n_in != 23 || out_size != MTOK * DM || ws_size < WS_END) { fprintf(stderr, "kernel_launch: unexpected shapes (n_in %d, out %d, ws %zu)\n", n_in, out_size, ws_size); grid = -1; return; }
        int dev = 0, cus = 0;
        if (hipGetDevice(&dev) != hipSuccess || hipDeviceGetAttribute(&cus, hipDeviceAttributeMultiprocessorCount, dev) != hipSuccess) { grid = -1; return; }
#if MK_PER_PHASE
        for (int id = 0; id < 15; ++id) if (hipFuncSetAttribute((const void*)phase_kernel(id), hipFuncAttributeMaxDynamicSharedMemorySize, LDS_BYTES) != hipSuccess) { fprintf(stderr, "kernel_launch: hipFuncSetAttribute failed\n"); grid = -1; return; }
#else
        if (hipFuncSetAttribute((const void*)kern_of<0xffffffffu>(), hipFuncAttributeMaxDynamicSharedMemorySize, LDS_BYTES) != hipSuccess) { fprintf(stderr, "kernel_launch: hipFuncSetAttribute failed\n"); grid = -1; return; }
#endif
        (void)hipGetLastError();
        grid = cus < 256 ? cus : 256;
    }
    if (grid < 0) return;
    if (hipMemsetAsync((char*)d_ws + WS_CTL, 0, CTL_ZERO_BYTES, stream) != hipSuccess) return;
    Args a{};
    for (int i = 0; i < 23; ++i) a.in[i] = (const float*)d_in[i];
    a.out = (float*)d_out; a.ws = (unsigned char*)d_ws;
    constexpr int NPH = 2 + 8 * DEPTH + 2 + 2;
#if MK_PER_PHASE
    int ids[NPH]; int n = 0; ids[n++] = 0; ids[n++] = 1;
    for (int ly = 0; ly < DEPTH; ++ly) { ids[n++] = 3; ids[n++] = 4; ids[n++] = 5; ids[n++] = 6;
        if (ly % 3 == 0) { ids[n++] = 7; ids[n++] = 15; } else if (ly % 3 == 1) { ids[n++] = 8; ids[n++] = 9; ids[n++] = 10; } else ids[n++] = 11;
        ids[n++] = 12; ids[n++] = 13; ids[n++] = 14; }
    for (int p = 0; p < NPH; ++p) { a.ph_lo = p; a.ph_hi = p + 1;
#if PROBE_DUP
        if ((PROBE_DUP >> ids[p]) & 1) {
            a.dry = 1; hipLaunchKernelGGL(phase_kernel(ids[p]), dim3(grid), dim3(NWAVES * 64), LDS_BYTES, stream, a); a.dry = 0;
            hipMemsetAsync((char*)d_ws + WS_CTL + CW_Q * 4, 0, 64 * 4 * 64, stream); }
#endif
        hipLaunchKernelGGL(phase_kernel(ids[p]), dim3(grid), dim3(NWAVES * 64), LDS_BYTES, stream, a);
#if PROBE_EMPTY
        if (p == 1) for (int e = 0; e < PROBE_EMPTY; ++e) hipLaunchKernelGGL(phase_kernel(2), dim3(grid), dim3(NWAVES * 64), LDS_BYTES, stream, a);
#endif
    }
#else
    a.ph_lo = 0; a.ph_hi = NPH; hipLaunchKernelGGL(kern_of<0xffffffffu>(), dim3(grid), dim3(NWAVES * 64), LDS_BYTES, stream, a);
#endif
}
```

```cpp
#include <hip/hip_runtime.h>
#include <cstdio>
#include <cstdint>
namespace pg8 {
#define PG8_LAS __attribute__((address_space(3)))
typedef unsigned short bf16_t;
typedef short bf16x8 __attribute__((ext_vector_type(8)));
typedef float f32x4 __attribute__((ext_vector_type(4)));
typedef unsigned u32x4 __attribute__((ext_vector_type(4)));
constexpr int BM = 256, BK = 64, HALF = 128, HTB = HALF * BK * 2  , STAGE_BYTES = 8 * HTB, NXCD = 8, WGM = 8;

__host__ __device__ __forceinline__ int lds_byte(int r, int c) { const int st = (r >> 4) * 2 + (c >> 5), rr = r & 15, cc = c & 31, ob = rr * 64 + cc * 2; return st * 1024 + (ob ^ (((ob >> 9) & 1) << 5)); }
__host__ __device__ __forceinline__ void stage_rc(int b, int& R, int& C) { const int st = b / 1024, sb = b % 1024, swz = sb ^ (((sb >> 9) & 1) << 5); R = (st >> 1) * 16 + swz / 64; C = (st & 1) * 32 + (swz % 64) / 2; }
__host__ __device__ __forceinline__ int perm32(int rho) { const int n = rho >> 4, i = rho & 15; return 8 * (i >> 2) + 4 * n + (i & 3); }

struct Unit { int pm, pn; };
struct Gemm { const bf16_t* A; const bf16_t* Bt; int M, N, K; };

struct StaticOrder {
    int nM, nN, nwg, G, c;
    __host__ __device__ void init(int M, int N, int G_, int c_) { nM = M / BM; nN = N / BM; nwg = nM * nN; G = G_; c = c_; }
    __host__ __device__ __forceinline__ bool next(int i, Unit& u) const {
        const long L = (long)i * G + c; if (L >= nwg) return false;
        int wgid = (int)L; { const int q = nwg / NXCD, r = nwg % NXCD, xcd = wgid % NXCD, off = wgid / NXCD; wgid = (xcd < r ? xcd * (q + 1) : r * (q + 1) + (xcd - r) * q) + off; }
        const int nig = WGM * nN, gid = wgid / nig, fm = gid * WGM, gsz = (nM - fm) < WGM ? (nM - fm) : WGM;
        u.pm = fm + ((wgid % nig) % gsz); u.pn = (wgid % nig) / gsz; return true;
    }
    __device__ __forceinline__ void a_ready(const Unit&) const {}
    __device__ __forceinline__ void done(const Unit&) const {}
};

__device__ __forceinline__ int lane_now() { int l; asm volatile("v_mbcnt_lo_u32_b32 %0, -1, 0\n\tv_mbcnt_hi_u32_b32 %0, -1, %0" : "=v"(l)); return l; }
__device__ __forceinline__ float shfl_idx_(float v, int src) { return __builtin_bit_cast(float, __builtin_amdgcn_ds_bpermute(src << 2, __builtin_bit_cast(int, v))); }
__device__ __forceinline__ int shfl_idx_(int v, int src) { return __builtin_amdgcn_ds_bpermute(src << 2, v); }
__device__ __forceinline__ unsigned shfl_idx_(unsigned v, int src) { return (unsigned)__builtin_amdgcn_ds_bpermute(src << 2, (int)v); }
#define __shfl_xor(v, o) pg8::shfl_idx_((v), pg8::lane_now() ^ (o))
#define __shfl(v, src) pg8::shfl_idx_((v), (src))
#define __shfl_down(v, o) pg8::shfl_idx_((v), pg8::lane_now() + (o))
#define __shfl_up(v, o) pg8::shfl_idx_((v), pg8::lane_now() - (o))
#define PG8_GAS __attribute__((address_space(1)))
typedef float f32x2_cv __attribute__((ext_vector_type(2))); typedef __bf16 bf16x2_cv __attribute__((ext_vector_type(2)));
__device__ __forceinline__ unsigned cvt_pk_bf16(float lo, float hi) { f32x2_cv v = {lo, hi}; bf16x2_cv b = __builtin_convertvector(v, bf16x2_cv); return __builtin_bit_cast(unsigned, b); }
constexpr float RMS_EPS = 1e-6f;
__device__ __forceinline__ void rows_rs(const float* part, int row0, int fq, float (&rs)[2][4]) {
    f32x4 pr[2][4];
#pragma unroll
    for (int ai = 0; ai < 2; ++ai)
#pragma unroll
        for (int m = 0; m < 4; ++m) pr[ai][m] = *(const PG8_GAS f32x4*)(part + (size_t)(row0 + ai * HALF + m * 16) * 16 + 4 * fq);
#pragma unroll
    for (int ai = 0; ai < 2; ++ai)
#pragma unroll
        for (int m = 0; m < 4; ++m) { float s = (pr[ai][m][0] + pr[ai][m][1]) + (pr[ai][m][2] + pr[ai][m][3]); s += __shfl_xor(s, 16); s += __shfl_xor(s, 32);
            rs[ai][m] = __builtin_amdgcn_rsqf(s * (1.0f / 1024.0f) + RMS_EPS); }
}
__device__ __forceinline__ void rows_rs_lds(const PG8_LAS float* rsl, int wr, int fr, float (&rs)[2][4]) {
#pragma unroll
    for (int ai = 0; ai < 2; ++ai)
#pragma unroll
        for (int m = 0; m < 4; ++m) rs[ai][m] = rsl[ai * HALF + wr * 64 + m * 16 + fr];
}
__device__ __forceinline__ void rs_fill(PG8_LAS float* rsl, const float* part, int pmA, int pmB, int tid) {
    const int r = tid & 255, pm = (tid >> 8) ? pmB : pmA;
    const PG8_GAS f32x4* p = (const PG8_GAS f32x4*)(part + (size_t)(pm * BM + r) * 16);
    const f32x4 a = p[0], b = p[1], c = p[2], d = p[3];
    const float s = (((a[0] + a[1]) + (a[2] + a[3])) + ((b[0] + b[1]) + (b[2] + b[3]))) + (((c[0] + c[1]) + (c[2] + c[3])) + ((d[0] + d[1]) + (d[2] + d[3])));
    rsl[tid] = __builtin_amdgcn_rsqf(s * (1.0f / 1024.0f) + RMS_EPS);
}
__device__ __forceinline__ float silu_mul(float g, float u) { return g * u * __builtin_amdgcn_rcpf(1.0f + __builtin_amdgcn_exp2f(-1.4426950408889634f * g)); }
struct EpiSwiglu {
    static constexpr bool PERM = true, AFTER_DRAIN = false; static constexpr int NST = 8;
    bf16_t* H; int ldh; const float* part; int dmode;
    const PG8_LAS float* rsl;
    __device__ __forceinline__ void prefill(int tid) const { if (rsl) { int bi = (int)blockIdx.x; asm volatile("" : "+s"(bi)); const int pmA = 16 * (bi & 7) + ((bi >> 3) & 7); rs_fill((PG8_LAS float*)rsl, part, pmA, pmA + 8, tid); } }
    __device__ __forceinline__ void operator()(const f32x4 (&acc)[2][2][4][2], const Unit& u, int wr, int wc, int fr_, int fq_) const {
        int le_; asm volatile("v_mbcnt_lo_u32_b32 %0, -1, 0\n\tv_mbcnt_hi_u32_b32 %0, -1, %0" : "=v"(le_)); const int fr = le_ & 15, fq = le_ >> 4;
        const int row0 = u.pm * BM + wr * 64 + fr, col0 = u.pn * HALF + wc * 32 + 8 * fq;
        float rsv[2][4];
        if (rsl) rows_rs_lds(rsl + ((u.pm & 8) ? BM : 0), wr, fr, rsv); else rows_rs(part, row0, fq, rsv);
#pragma unroll
        for (int ai = 0; ai < 2; ++ai)
#pragma unroll
            for (int m = 0; m < 4; ++m) { const int row = row0 + ai * HALF + m * 16; const float rs = rsv[ai][m];
                const float nrs = -1.4426950408889634f * rs, rs2 = rs * rs;
                const f32x4 g0 = acc[ai][0][m][0], g1 = acc[ai][0][m][1], u0 = acc[ai][1][m][0], u1 = acc[ai][1][m][1];
                float gg[8] = {g0[0], g0[1], g0[2], g0[3], g1[0], g1[1], g1[2], g1[3]}, uu[8] = {u0[0], u0[1], u0[2], u0[3], u1[0], u1[1], u1[2], u1[3]}, ee[8];
#pragma unroll
                for (int j = 0; j < 8; ++j) ee[j] = gg[j] * nrs;
#pragma unroll
                for (int j = 0; j < 8; ++j) ee[j] = __builtin_amdgcn_exp2f(ee[j]);
#pragma unroll
                for (int j = 0; j < 8; ++j) { ee[j] += 1.0f; gg[j] = gg[j] * uu[j]; }
#pragma unroll
                for (int j = 0; j < 8; ++j) ee[j] = __builtin_amdgcn_rcpf(ee[j]);
#pragma unroll
                for (int j = 0; j < 8; ++j) gg[j] = gg[j] * rs2 * ee[j];
                u32x4 w; w.x = cvt_pk_bf16(gg[0], gg[1]); w.y = cvt_pk_bf16(gg[2], gg[3]); w.z = cvt_pk_bf16(gg[4], gg[5]); w.w = cvt_pk_bf16(gg[6], gg[7]);
                *(PG8_GAS u32x4*)(H + (size_t)row * ldh + col0) = w; }
    }
};
struct EpiScale {
    static constexpr bool PERM = true, AFTER_DRAIN = false; static constexpr int NST = 16;
    bf16_t* O; int ldc; const float* part; const PG8_LAS float* rsl;
    __device__ __forceinline__ void prefill(int tid) const { if (rsl) { int bi = (int)blockIdx.x; asm volatile("" : "+s"(bi)); const int pmA = 16 * (bi & 7) + ((bi >> 3) & 7); rs_fill((PG8_LAS float*)rsl, part, pmA, pmA + 8, tid); } }
    __device__ __forceinline__ void operator()(const f32x4 (&acc)[2][2][4][2], const Unit& u, int wr, int wc, int fr_, int fq_) const {
        int le_; asm volatile("v_mbcnt_lo_u32_b32 %0, -1, 0\n\tv_mbcnt_hi_u32_b32 %0, -1, %0" : "=v"(le_)); const int fr = le_ & 15, fq = le_ >> 4;
        const int row0 = u.pm * BM + wr * 64 + fr, col0 = u.pn * BM + wc * 32 + 8 * fq;
        float rsv[2][4];
        if (rsl) rows_rs_lds(rsl + ((u.pm & 8) ? BM : 0), wr, fr, rsv); else rows_rs(part, row0, fq, rsv);
#pragma unroll
        for (int ai = 0; ai < 2; ++ai)
#pragma unroll
            for (int m = 0; m < 4; ++m) { const int row = row0 + ai * HALF + m * 16; const float rs = rsv[ai][m]; bf16_t* rowp = O + (size_t)row * ldc + col0;
#pragma unroll
                for (int bj = 0; bj < 2; ++bj) { const f32x4 v0 = acc[ai][bj][m][0] * rs, v1 = acc[ai][bj][m][1] * rs;
                    u32x4 w; w.x = cvt_pk_bf16(v0[0], v0[1]); w.y = cvt_pk_bf16(v0[2], v0[3]); w.z = cvt_pk_bf16(v1[0], v1[1]); w.w = cvt_pk_bf16(v1[2], v1[3]);
                    *(PG8_GAS u32x4*)(rowp + bj * HALF) = w; } }
    }
};
struct EpiResid {
    static constexpr bool PERM = true, AFTER_DRAIN = false; static constexpr int NST = 24;
    const bf16_t* base; bf16_t* xb; float* out; float* part_out; float coef;
    __device__ __forceinline__ void prefill(int) const {}
    __device__ __forceinline__ void operator()(const f32x4 (&acc)[2][2][4][2], const Unit& u, int wr, int wc, int fr_, int fq_) const {
        int le_; asm volatile("v_mbcnt_lo_u32_b32 %0, -1, 0\n\tv_mbcnt_hi_u32_b32 %0, -1, %0" : "=v"(le_)); const int fr = le_ & 15, fq = le_ >> 4;
        const int row0 = u.pm * BM + wr * 64 + fr, col0 = u.pn * BM + wc * 32 + 8 * fq;
        u32x4 bs[2][4][2];
#pragma unroll
        for (int ai = 0; ai < 2; ++ai)
#pragma unroll
            for (int m = 0; m < 4; ++m)
#pragma unroll
                for (int bj = 0; bj < 2; ++bj) bs[ai][m][bj] = *(const PG8_GAS u32x4*)(base + (size_t)(row0 + ai * HALF + m * 16) * 1024 + col0 + bj * HALF);
#pragma unroll
        for (int ai = 0; ai < 2; ++ai)
#pragma unroll
            for (int m = 0; m < 4; ++m) { const int row = row0 + ai * HALF + m * 16; const size_t off = (size_t)row * 1024 + col0; float ss = 0.f;
#pragma unroll
                for (int bj = 0; bj < 2; ++bj) { const u32x4 b = bs[ai][m][bj];
                    const f32x4 b0 = {__builtin_bit_cast(float, b.x << 16), __builtin_bit_cast(float, b.x & 0xffff0000u), __builtin_bit_cast(float, b.y << 16), __builtin_bit_cast(float, b.y & 0xffff0000u)};
                    const f32x4 b1 = {__builtin_bit_cast(float, b.z << 16), __builtin_bit_cast(float, b.z & 0xffff0000u), __builtin_bit_cast(float, b.w << 16), __builtin_bit_cast(float, b.w & 0xffff0000u)};
                    const f32x4 v0 = b0 + acc[ai][bj][m][0] * coef, v1 = b1 + acc[ai][bj][m][1] * coef;
                    if (out) { *(PG8_GAS f32x4*)(out + off + bj * HALF) = v0; *(PG8_GAS f32x4*)(out + off + bj * HALF + 4) = v1; }
                    u32x4 w; w.x = cvt_pk_bf16(v0[0], v0[1]); w.y = cvt_pk_bf16(v0[2], v0[3]); w.z = cvt_pk_bf16(v1[0], v1[1]); w.w = cvt_pk_bf16(v1[2], v1[3]);
                    *(PG8_GAS u32x4*)(xb + off + bj * HALF) = w;
                    ss += (v0[0] * v0[0] + v0[1] * v0[1]) + (v0[2] * v0[2] + v0[3] * v0[3]) + (v1[0] * v1[0] + v1[1] * v1[1]) + (v1[2] * v1[2] + v1[3] * v1[3]); }
                ss += __shfl_xor(ss, 16); ss += __shfl_xor(ss, 32);
                if (fq == 0) *(PG8_GAS float*)(part_out + (size_t)row * 16 + u.pn * 4 + wc) = ss; }
    }
};
template <class Epi, class Sched, bool ALIGN_EPI = false, bool SP2 = false>
__device__ __forceinline__ void gemm_phase(PG8_LAS unsigned char* lds, const Gemm g, const Sched& S, const Epi& E, int wave_id) {
    int lane_; asm volatile("v_mbcnt_lo_u32_b32 %0, -1, 0\n\tv_mbcnt_hi_u32_b32 %0, -1, %0" : "=v"(lane_));
    const int wid = wave_id, lane = lane_, tid = wid * 64 + lane, wr = wid >> 2, wc = wid & 3, fr = lane & 15, fq = lane >> 4;
    const int K = g.K, nt = K / BK;
    unsigned voffA[2], voffB[2];
#pragma unroll
    for (int i = 0; i < 2; ++i) { int R, C; stage_rc(tid * 16 + i * 8192, R, C); const int Rb = Epi::PERM ? ((R & ~31) + perm32(R & 31)) : R;
        voffA[i] = (unsigned)(R * K + C) * 2u; voffB[i] = (unsigned)(Rb * K + C) * 2u; }
    const size_t kstep = (size_t)(BK * 2);
    const size_t hstep = (size_t)HALF * K * 2;
    const size_t tstep = 2 * hstep;
    const unsigned ldsw = (unsigned)wid * 1024u;
    const int aoff = lds_byte(wr * 64 + fr, fq * 8), boff = lds_byte(wc * 32 + fr, fq * 8);
#define PG8_SA(b, h) (((b) * 2 + (h)) * HTB)
#define PG8_SB(b, h) ((4 + (b) * 2 + (h)) * HTB)
#define PG8_STAGE(bufoff, gbase, voff) do { _Pragma("unroll") for (int _i = 0; _i < 2; ++_i) \
        __builtin_amdgcn_global_load_lds((const unsigned*)((const char*)(gbase) + (voff)[_i]), (PG8_LAS unsigned*)(lds + (bufoff) + ldsw + _i * 8192), 16, 0, 0); } while (0)
#define PG8_LDA(dst, b, h) do { _Pragma("unroll") for (int m = 0; m < 4; ++m) _Pragma("unroll") for (int k = 0; k < 2; ++k) dst[m][k] = *(const PG8_LAS bf16x8*)(lds + PG8_SA(b, h) + aoff + m * 2048 + k * 1024); } while (0)
#define PG8_LDB(dst, b, h) do { _Pragma("unroll") for (int n = 0; n < 2; ++n) _Pragma("unroll") for (int k = 0; k < 2; ++k) dst[n][k] = *(const PG8_LAS bf16x8*)(lds + PG8_SB(b, h) + boff + n * 2048 + k * 1024); } while (0)
#define PG8_MMA(ai, bj, At, Bt) do { __builtin_amdgcn_s_setprio(1); _Pragma("unroll") for (int m = 0; m < 4; ++m) _Pragma("unroll") for (int n = 0; n < 2; ++n) _Pragma("unroll") for (int k = 0; k < 2; ++k) \
        acc[ai][bj][m][n] = __builtin_amdgcn_mfma_f32_16x16x32_bf16(Bt[n][k], At[m][k], acc[ai][bj][m][n], 0, 0, 0); __builtin_amdgcn_s_setprio(0); } while (0)
#define PG8_WAIT_V(n) asm volatile("s_waitcnt vmcnt(" #n ")" ::: "memory")
#define PG8_WAIT_VI(n) asm volatile("s_waitcnt vmcnt(%0)" :: "n"(n) : "memory")
#define PG8_WAIT_L(n) asm volatile("s_waitcnt lgkmcnt(" #n ")" ::: "memory")
#define PG8_BAR __builtin_amdgcn_s_barrier()
#define PG8_SCHED __builtin_amdgcn_sched_barrier(0)
    Unit cur, nxt; int ui = 0;
    if (!S.next(0, cur)) return;
    f32x4 acc[2][2][4][2];
#pragma unroll
    for (int a = 0; a < 2; ++a)
#pragma unroll
        for (int b = 0; b < 2; ++b)
#pragma unroll
            for (int m = 0; m < 4; ++m)
#pragma unroll
                for (int n = 0; n < 2; ++n) acc[a][b][m][n] = (f32x4){0.f, 0.f, 0.f, 0.f};
    bf16x8 At[4][2], B0[2][2], B1[2][2];
    const char* cA = (const char*)g.A + (size_t)cur.pm * tstep; const char* cB = (const char*)g.Bt + (size_t)cur.pn * tstep;
    S.a_ready(cur);
    if constexpr (SP2) {
        PG8_STAGE(PG8_SB(0, 0), cB, voffB); PG8_STAGE(PG8_SB(0, 1), cB + hstep, voffB); PG8_STAGE(PG8_SA(0, 0), cA, voffA); PG8_STAGE(PG8_SA(0, 1), cA + hstep, voffA);
        E.prefill(tid);
        if (wr == 1) PG8_BAR;
        PG8_WAIT_V(2); PG8_BAR;
        PG8_STAGE(PG8_SB(1, 0), cB + kstep, voffB); PG8_STAGE(PG8_SA(1, 0), cA + kstep, voffA); PG8_STAGE(PG8_SB(1, 1), cB + hstep + kstep, voffB);
        PG8_WAIT_V(6); PG8_BAR;
    } else {
        PG8_STAGE(PG8_SB(0, 0), cB, voffB); PG8_STAGE(PG8_SA(0, 0), cA, voffA); PG8_STAGE(PG8_SB(0, 1), cB + hstep, voffB); PG8_STAGE(PG8_SA(0, 1), cA + hstep, voffA);
        if (wr == 1) PG8_BAR;
        PG8_WAIT_V(4); PG8_BAR;
        PG8_STAGE(PG8_SB(1, 0), cB + kstep, voffB); PG8_STAGE(PG8_SA(1, 0), cA + kstep, voffA); PG8_STAGE(PG8_SB(1, 1), cB + hstep + kstep, voffB);
        PG8_WAIT_V(6); PG8_BAR;
    }
    for (;;) {
        const bool has_next = S.next(ui + 1, nxt);
        const char* nA = has_next ? (const char*)g.A + (size_t)nxt.pm * tstep : cA; const char* nB = has_next ? (const char*)g.Bt + (size_t)nxt.pn * tstep : cB;
        for (int t = 0; t < nt; t += 2) {
            const bool last = (t == nt - 2);
            const char* a1 = cA + (size_t)(t + 1) * kstep;
            const char* a2 = last ? nA : cA + (size_t)(t + 2) * kstep; const char* b2 = last ? nB : cB + (size_t)(t + 2) * kstep;
            const char* a3 = a2 + kstep; const char* b3 = b2 + kstep;
            if (last && has_next) S.a_ready(nxt);
            if constexpr (SP2) {
            const bool post_epi = Epi::NST > 0 && t == 0 && ui > 0;
            const int pe_ = __builtin_amdgcn_readfirstlane(post_epi ? 1 : 0);
#define PG8_WAIT_V1() asm volatile("s_cmp_eq_u32 %0, 0\n\ts_cbranch_scc1 .Lpg8wa_%=\n\ts_waitcnt vmcnt(%1)\n\ts_branch .Lpg8wb_%=\n.Lpg8wa_%=:\n\ts_waitcnt vmcnt(8)\n.Lpg8wb_%=:" :: "s"(pe_), "n"(8 + Epi::NST) : "memory", "scc")
            PG8_LDB(B0, 0, 0); PG8_LDB(B1, 0, 1); PG8_SCHED; PG8_LDA(At, 0, 0); PG8_STAGE(PG8_SA(1, 1), a1 + hstep, voffA);
            PG8_WAIT_V1(); PG8_WAIT_L(0); PG8_BAR; PG8_MMA(0, 0, At, B0); PG8_MMA(0, 1, At, B1); PG8_BAR; PG8_SCHED;
            PG8_LDA(At, 0, 1); PG8_STAGE(PG8_SB(0, 0), b2, voffB); PG8_STAGE(PG8_SB(0, 1), b2 + hstep, voffB); PG8_STAGE(PG8_SA(0, 0), a2, voffA);
            PG8_WAIT_V1(); PG8_WAIT_L(0); PG8_BAR; PG8_MMA(1, 0, At, B0); PG8_MMA(1, 1, At, B1); PG8_BAR; PG8_SCHED;
            PG8_LDB(B0, 1, 0); PG8_LDB(B1, 1, 1); PG8_SCHED; PG8_LDA(At, 1, 0); PG8_STAGE(PG8_SA(0, 1), a2 + hstep, voffA);
            PG8_WAIT_V(8); PG8_WAIT_L(0); PG8_BAR; PG8_MMA(0, 0, At, B0); PG8_MMA(0, 1, At, B1); PG8_BAR; PG8_SCHED;
            PG8_LDA(At, 1, 1); PG8_STAGE(PG8_SB(1, 0), b3, voffB); PG8_STAGE(PG8_SB(1, 1), b3 + hstep, voffB); PG8_STAGE(PG8_SA(1, 0), a3, voffA);
            PG8_WAIT_V(8); PG8_WAIT_L(0); PG8_BAR; PG8_MMA(1, 0, At, B0); PG8_MMA(1, 1, At, B1); PG8_BAR; PG8_SCHED;
#undef PG8_WAIT_V1
            } else {
            PG8_LDB(B0, 0, 0); PG8_SCHED; PG8_LDA(At, 0, 0); PG8_STAGE(PG8_SA(1, 1), a1 + hstep, voffA);
            PG8_WAIT_L(8); PG8_BAR; PG8_WAIT_L(0); PG8_MMA(0, 0, At, B0); PG8_BAR; PG8_SCHED;
            PG8_LDB(B1, 0, 1); PG8_STAGE(PG8_SB(0, 0), b2, voffB);
            PG8_BAR; PG8_WAIT_L(0); PG8_MMA(0, 1, At, B1); PG8_BAR;
            PG8_LDA(At, 0, 1); PG8_STAGE(PG8_SA(0, 0), a2, voffA);
            PG8_BAR; PG8_WAIT_L(0); PG8_MMA(1, 0, At, B0); PG8_BAR; PG8_SCHED;
            PG8_STAGE(PG8_SB(0, 1), b2 + hstep, voffB);
            PG8_WAIT_V(6); PG8_BAR; PG8_MMA(1, 1, At, B1); PG8_BAR;
            PG8_LDB(B0, 1, 0); PG8_SCHED; PG8_LDA(At, 1, 0); PG8_STAGE(PG8_SA(0, 1), a2 + hstep, voffA);
            PG8_WAIT_L(8); PG8_BAR; PG8_WAIT_L(0); PG8_MMA(0, 0, At, B0); PG8_BAR; PG8_SCHED;
            PG8_LDB(B1, 1, 1); PG8_STAGE(PG8_SB(1, 0), b3, voffB);
            PG8_BAR; PG8_WAIT_L(0); PG8_MMA(0, 1, At, B1); PG8_BAR;
            PG8_LDA(At, 1, 1); PG8_STAGE(PG8_SA(1, 0), a3, voffA);
            PG8_BAR; PG8_WAIT_L(0); PG8_MMA(1, 0, At, B0); PG8_BAR; PG8_SCHED;
            PG8_STAGE(PG8_SB(1, 1), b3 + hstep, voffB);
            PG8_WAIT_V(6); PG8_BAR; PG8_MMA(1, 1, At, B1); PG8_BAR;
            }
        }
        if constexpr (ALIGN_EPI) { if (wr == 0) PG8_BAR; }
        if constexpr (!Epi::AFTER_DRAIN) { E(acc, cur, wr, wc, fr, fq); S.done(cur); }
        if (!has_next) break;
#pragma unroll
        for (int a = 0; a < 2; ++a)
#pragma unroll
            for (int b = 0; b < 2; ++b)
#pragma unroll
                for (int m = 0; m < 4; ++m)
#pragma unroll
                    for (int n = 0; n < 2; ++n) acc[a][b][m][n] = (f32x4){0.f, 0.f, 0.f, 0.f};
        cur = nxt; cA = nA; cB = nB; ++ui;
        if constexpr (ALIGN_EPI) { if (wr == 1) PG8_BAR; }
    }
    PG8_WAIT_V(0);
    if constexpr (!ALIGN_EPI) { if (wr == 0) PG8_BAR; }
    PG8_BAR;
    if constexpr (Epi::AFTER_DRAIN) { E.fused(acc, cur, wr, wc, fr, fq, lds, wid, lane); S.done(cur); }
#undef PG8_SA
#undef PG8_SB
#undef PG8_STAGE
#undef PG8_LDA
#undef PG8_LDB
#undef PG8_MMA
#undef PG8_WAIT_V
#undef PG8_WAIT_VI
#undef PG8_WAIT_L
#undef PG8_BAR
#undef PG8_SCHED
}
}
#define LAS __attribute__((address_space(3)))
#define XB_TMO      128
#define XB_XCNT(j)  (256  + 64 * (j))
#define XB_XSUB(j)  (1280 + 64 * (j))
#define XB_XGEN(j)  (2304 + 64 * (j))
#define XB_TOP      3328
#define XB_TOPGEN   3392
#define XCD_BAR_WORDS 3456
#define XB_SPIN_CAP (1u << 18)

__device__ __forceinline__ unsigned xb_ld(unsigned* p)              { return __hip_atomic_load(p, __ATOMIC_RELAXED, __HIP_MEMORY_SCOPE_AGENT); }
__device__ __forceinline__ unsigned xb_add(unsigned* p, unsigned v) { return __hip_atomic_fetch_add(p, v, __ATOMIC_RELAXED, __HIP_MEMORY_SCOPE_AGENT); }
__device__ __forceinline__ unsigned xb_xcc_id() { return (unsigned)__builtin_amdgcn_s_getreg((3 << 11) | 20) & 0xFu; }
#define XB_SPIN(cond, bar) do { unsigned _sp = 0; while (cond) { __builtin_amdgcn_s_sleep(1); \
    if ((++_sp & 255u) == 0u) { if (xb_ld(&(bar)[XB_TMO])) break; if (_sp > XB_SPIN_CAP) { atomicAdd(&(bar)[XB_TMO], 1u); break; } } } } while (0)

struct XcdBarrier {
    unsigned* bar; unsigned x;
    volatile LAS unsigned* st;
};

__device__ __forceinline__ XcdBarrier xcd_barrier_post(unsigned* bar, volatile LAS unsigned* st) {
    XcdBarrier b; b.bar = bar; b.x = xb_xcc_id(); b.st = st;
    if (threadIdx.x == 0) (void)xb_add(&bar[XB_XCNT(b.x)], 1u);
    return b;
}
__device__ __forceinline__ void xcd_barrier_complete(unsigned* bar, unsigned x, unsigned& nloc, unsigned& nx) {
    const unsigned G = gridDim.x * gridDim.y * gridDim.z;
    unsigned sum, cnt, mine, sp = 0u;
    for (;;) {
        sum = 0u; cnt = 0u; mine = 0u;
#pragma unroll
        for (unsigned j = 0; j < 16; ++j) { const unsigned c = xb_ld(&bar[XB_XCNT(j)]); sum += c; cnt += (c > 0u) ? 1u : 0u; mine = (j == x) ? c : mine; }
        if (sum == G) break;
        __builtin_amdgcn_s_sleep(1);
        if ((++sp & 255u) == 0u) { if (xb_ld(&bar[XB_TMO])) break; if (sp > XB_SPIN_CAP) { atomicAdd(&bar[XB_TMO], 1u); break; } }
    }
    nloc = mine > 0u ? mine : 1u; nx = cnt > 0u ? cnt : 1u;
}

__device__ __forceinline__ void xcd_barrier(const XcdBarrier& b) {
    asm volatile("s_waitcnt vmcnt(0)" ::: "memory");
    __syncthreads();
    if (threadIdx.x == 0) {
        unsigned* bar = b.bar;
        __builtin_amdgcn_s_waitcnt(0);
        unsigned nloc = b.st[0], nx = b.st[1];
        if (nloc == 0u) { xcd_barrier_complete(bar, b.x, nloc, nx); b.st[0] = nloc; b.st[1] = nx; }
        const unsigned old = xb_add(&bar[XB_XSUB(b.x)], 1u);
        const unsigned gen = old / nloc;
        if (old + 1u == (gen + 1u) * nloc) {
            __builtin_amdgcn_fence(__ATOMIC_RELEASE, "agent");
            asm volatile("s_waitcnt vmcnt(0)" ::: "memory");
            const unsigned og = xb_add(&bar[XB_TOP], 1u);
            const unsigned tg = og / nx;
            if (og + 1u == (tg + 1u) * nx) xb_add(&bar[XB_TOPGEN], 1u);
            else XB_SPIN(xb_ld(&bar[XB_TOPGEN]) == tg, bar);
            __builtin_amdgcn_fence(__ATOMIC_ACQUIRE, "agent");
            xb_add(&bar[XB_XGEN(b.x)], 1u);
            asm volatile("s_waitcnt vmcnt(0)" ::: "memory");
        } else {
            XB_SPIN(xb_ld(&bar[XB_XGEN(b.x)]) == gen, bar);
            __builtin_amdgcn_fence(__ATOMIC_ACQUIRE, "agent");
            asm volatile("s_waitcnt vmcnt(0)" ::: "memory");
        }
    }
    __syncthreads();
}
#undef LAS
#ifndef RET_MODE
#define RET_MODE 1
#endif
#ifndef NSA_INLINE
#define NSA_INLINE __forceinline__
#endif
#ifndef DRY_MODE
#define DRY_MODE 0
#endif
#ifndef WG_SKEW
#define WG_SKEW 0
#endif
#ifndef BAR_EXTRA
#define BAR_EXTRA 0
#endif
#ifndef QF_MEM
#define QF_MEM 0
#endif
#ifndef TM_FENCE
#define TM_FENCE 0
#endif
#ifndef NSA_WG
#define NSA_WG 1
#endif
#ifndef D3_WG
#define D3_WG 1
#endif
#ifndef RET_WG
#define RET_WG 1
#endif
#ifndef PROBE_EMPTY
#define PROBE_EMPTY 0
#endif
#ifndef PROBE_DUP
#define PROBE_DUP 0
#endif
#ifndef DBG_BRUTE
#define DBG_BRUTE 0
#endif
#ifndef DBG_ZERO
#define DBG_ZERO 0
#endif
constexpr int NWAVES = 8;
constexpr int NB = 16, SEQ = 2048, DM = 1024, MTOK = NB * SEQ, FF = 2816, NMEMT = 256, MMEM = NB * NMEMT, DEPTH = 4;
constexpr float EPS = 1e-6f;
constexpr float QSCALE = 0.125f * 1.4426950408889634f;
constexpr int RET_LD = 2560, RET_Q = 0, RET_K = 384, RET_V = 768, RET_G = 1536, RET_QM = 2304;
constexpr int DSA_LD = 1792, DSA_Q = 0, DSA_K = 768, DSA_V = 832, DSA_IQ = 896, DSA_IK = 1408, DSA_IW = 1472, DSA_QM = 1480, DSA_COLS = 1736;
constexpr int NSA_LD = 2816, NSA_Q = 0, NSA_KC = 768, NSA_VC = 1024, NSA_KS = 1280, NSA_VS = 1536, NSA_KW = 1792, NSA_VW = 2048, NSA_QM = 2304, NSA_GT = 2560;
constexpr int NSA_SRC_GT = 2304, NSA_SRC_QM = 2340, NSA_COLS = 2596;

constexpr size_t MiB = 1u << 20;
constexpr size_t WS_CTL = 0, CTL_ZERO_BYTES = 1 * MiB;
constexpr size_t WS_PART = 1 * MiB;
constexpr size_t WS_PARTM = 3 * MiB;
constexpr size_t WS_ROPE = 3 * MiB + 512 * 1024;
constexpr size_t WS_MISC = 4 * MiB;
constexpr size_t WS_CMPW = 4 * MiB + 64 * 1024;
constexpr size_t WS_KCMP = 5 * MiB;
constexpr size_t WS_VCMPT = 6 * MiB;
constexpr size_t WS_MK = 7 * MiB;
constexpr size_t WS_MVT = 15 * MiB;
constexpr size_t WS_MEMB = 23 * MiB;
constexpr size_t WS_MKV = 31 * MiB;
constexpr size_t WS_WKV = 47 * MiB;
constexpr size_t WS_WBUF0 = 51 * MiB, WBUF_BYTES = 41 * MiB;
constexpr size_t WS_XB = 133 * MiB;
constexpr size_t WS_Y = 197 * MiB;
constexpr size_t WS_HID = 261 * MiB;
constexpr size_t WS_SC = 373 * MiB;
constexpr size_t WS_MB = 501 * MiB;
constexpr size_t WS_END = 509 * MiB;
static_assert(WS_HID + (size_t)MTOK * FF * 2 <= WS_MB && WS_SC + (size_t)MTOK * SEQ * 2 <= WS_MB && WS_WBUF0 + 2 * WBUF_BYTES <= WS_XB, "d_ws map");
constexpr size_t WB_W1A = 0, WB_W2A = WB_W1A + (size_t)2 * FF * DM, WB_W1B = WB_W2A + (size_t)DM * FF, WB_W2B = WB_W1B + (size_t)2 * FF * DM,
                 WB_WIN = WB_W2B + (size_t)DM * FF, WB_WO = WB_WIN + (size_t)NSA_LD * DM, WB_END = WB_WO + (size_t)DM * DM;
static_assert(WB_END * 2 <= WBUF_BYTES, "weight buffer");
constexpr int LDS_CTRL = 147456 - 1024;
constexpr int RS_LDS_OFF = 131072;
constexpr int CW_BAR = 4096;
constexpr int CW_CK = 32768;
constexpr int CW_CKP = 65536;
constexpr int CV_SPLIT = 3072;
constexpr int CW_Q = 16384;

#define GAS __attribute__((address_space(1)))
#define LAS __attribute__((address_space(3)))
typedef unsigned short bf16;
typedef unsigned v4u __attribute__((ext_vector_type(4)));
typedef unsigned v2u __attribute__((ext_vector_type(2)));
typedef float f32x4 __attribute__((ext_vector_type(4)));
typedef float f32x16 __attribute__((ext_vector_type(16)));
typedef short bf16x8 __attribute__((ext_vector_type(8)));
typedef GAS unsigned gu32;
#define RLX_AGENT __ATOMIC_RELAXED, __HIP_MEMORY_SCOPE_AGENT
#define LDS_WAIT() asm volatile("s_waitcnt lgkmcnt(0)" ::: "memory")
#define VM_WAIT() asm volatile("s_waitcnt vmcnt(0)" ::: "memory")
__device__ __forceinline__ unsigned f2bf(float f) { unsigned u = __builtin_bit_cast(unsigned, f); return (u + 0x7fffu + ((u >> 16) & 1u)) >> 16; }
__device__ __forceinline__ unsigned pk2(float lo, float hi) { return pg8::cvt_pk_bf16(lo, hi); }
__device__ __forceinline__ float bf2f(unsigned h) { return __builtin_bit_cast(float, h << 16); }
__device__ __forceinline__ float bflo(unsigned w) { return __builtin_bit_cast(float, w << 16); }
__device__ __forceinline__ float bfhi(unsigned w) { return __builtin_bit_cast(float, w & 0xffff0000u); }
struct Args { const float* in[23]; float* out; unsigned char* ws; int ph_lo, ph_hi, dry, pad; };
typedef const __attribute__((address_space(4))) Args* KArgs;
struct Frame {
    LAS unsigned char* lds;
    volatile LAS unsigned* MISC;
    gu32* ctl;
    int tid, lane, wave, G, gw, NGW;
    int cv_lo, cv_hi;
    unsigned char* ws;
    KArgs ka;
    float* out;
};
__device__ __forceinline__ float wave_sum(float v) {
#pragma unroll
    for (int o = 1; o < 64; o <<= 1) v += __shfl_xor(v, o);
    return v;
}
__device__ __forceinline__ float wave_max(float v) {
#pragma unroll
    for (int o = 1; o < 64; o <<= 1) v = fmaxf(v, __shfl_xor(v, o));
    return v;
}
__device__ __forceinline__ int grab(gu32* ctr, int lane) { unsigned v = 0; if (lane == 0) v = __hip_atomic_fetch_add(ctr, 1u, RLX_AGENT); return __builtin_amdgcn_readfirstlane((int)v); }

__device__ __forceinline__ void cvt_item(const float* W, int ldw, const float* gain, bf16* WT, int K, LAS float* scr, int k0, int src_col0, int nvalid, int dst_row0, int lane) {
    const int c = lane & 31;
    float wv[32], gv2[32];
#pragma unroll
    for (int i = 0; i < 32; ++i) { const int kk = 2 * i + (lane >> 5); wv[i] = (c < nvalid) ? W[(size_t)(k0 + kk) * ldw + src_col0 + c] : 0.f; gv2[i] = gain ? gain[k0 + kk] : 1.f; }
#pragma unroll
    for (int i = 0; i < 32; ++i) { const int kk = 2 * i + (lane >> 5); scr[kk * 33 + c] = wv[i] * gv2[i]; }
    LDS_WAIT(); asm volatile("" ::: "memory");
    const int c8 = lane & 7;
#pragma unroll
    for (int j = 0; j < 4; ++j) { const int n = (lane >> 3) + 8 * j; const LAS float* s = scr + (8 * c8) * 33 + n;
        v4u o; o.x = pk2(s[0 * 33], s[1 * 33]); o.y = pk2(s[2 * 33], s[3 * 33]); o.z = pk2(s[4 * 33], s[5 * 33]); o.w = pk2(s[6 * 33], s[7 * 33]);
        *(GAS v4u*)(WT + (size_t)(dst_row0 + n) * K + k0 + 8 * c8) = o; }
    LDS_WAIT(); asm volatile("" ::: "memory");
}
__device__ __forceinline__ void cvt_matrix(Frame& F, int& it_base, const float* W, const float* W2, int ldw, int ncols, const float* gain, bf16* WT, int K, int nrows_dst, int kind) {
    LAS float* scr = (LAS float*)(F.lds + F.wave * 16384);
    const int nkb = K / 64, njb = nrows_dst / 32, nitems = nkb * njb;
    int gw_ = F.gw; asm volatile("" : "+s"(gw_));
    int first = (gw_ - it_base % F.NGW + F.NGW) % F.NGW;
    for (int i = first; i < nitems; i += F.NGW) {
        if (it_base + i < F.cv_lo || it_base + i >= F.cv_hi) continue;
        const int kb = i / njb, jb = i % njb; const float* src = W; int sc0 = jb * 32, nv = 32;
        if (kind == 0) { nv = ncols - sc0; nv = nv < 0 ? 0 : (nv > 32 ? 32 : nv); }
        else if (kind == 1) { const int c = jb * 32, pn = c >> 8, bj = (c >> 7) & 1, j = c & 127; src = bj ? W2 : W; sc0 = pn * 128 + j; }
        else { const int c = jb * 32;
            if (c < NSA_QM) { sc0 = c; }
            else if (c < NSA_GT) { sc0 = NSA_SRC_QM + (c - NSA_QM); }
            else { sc0 = NSA_SRC_GT + (c - NSA_GT); nv = NSA_SRC_QM - sc0; nv = nv < 0 ? 0 : (nv > 32 ? 32 : nv); } }
        cvt_item(src, ldw, gain, WT, K, scr, kb * 64, sc0, nv, jb * 32, F.lane);
    }
    it_base += nitems;
}
__device__ __forceinline__ void convert_layer(Frame& F, int Ly) {
    bf16* WB = (bf16*)(F.ws + WS_WBUF0 + (size_t)(Ly & 1) * WBUF_BYTES);
    const float* fnorm = F.ka->in[2]; const float* wg = F.ka->in[3]; const float* wu = F.ka->in[4]; const float* wd = F.ka->in[5];
    int itb = 0;
#pragma unroll 1
    for (int hf = 0; hf < 2; ++hf) {
        const size_t o1 = (size_t)(Ly * 2 + hf) * DM * FF;
        cvt_matrix(F, itb, wg + o1, wu + o1, FF, FF, fnorm + (size_t)(Ly * 2 + hf) * DM, WB + (hf ? WB_W1B : WB_W1A), DM, 2 * FF, 1);
        cvt_matrix(F, itb, wd + o1, nullptr, DM, DM, nullptr, WB + (hf ? WB_W2B : WB_W2A), FF, DM, 0);
    }
    const float* mnorm = F.ka->in[6] + (size_t)Ly * DM;
    const int kind = Ly % 3, j = Ly / 3;
    if (kind == 0) cvt_matrix(F, itb, F.ka->in[12] + (size_t)j * DM * RET_LD, nullptr, RET_LD, RET_LD, mnorm, WB + WB_WIN, DM, RET_LD, 0);
    else if (kind == 1) cvt_matrix(F, itb, F.ka->in[13] + (size_t)j * DM * DSA_COLS, nullptr, DSA_COLS, DSA_COLS, mnorm, WB + WB_WIN, DM, DSA_LD, 0);
    else cvt_matrix(F, itb, F.ka->in[16] + (size_t)j * DM * NSA_COLS, nullptr, NSA_COLS, NSA_COLS, mnorm, WB + WB_WIN, DM, NSA_LD, 2);
    cvt_matrix(F, itb, F.ka->in[7] + (size_t)Ly * DM * DM, nullptr, DM, DM, nullptr, WB + WB_WO, DM, DM, 0);
}

__device__ __forceinline__ void xform(Frame& F, const bf16* src, int spitch, int scol0, int nheads, int rows, int Lr, bf16* dst, int dmode, int dpitch, int dcol0,
                                      const float* gain, bool rope, float cscale, int decay  ) {
    const float* tab = (const float*)(F.ws + WS_ROPE);
    const int i8 = F.lane & 7, sub = F.lane >> 3; const int items = rows * nheads;
    float gn[8];
#pragma unroll
    for (int j = 0; j < 8; ++j) gn[j] = gain ? gain[8 * i8 + j] : 1.f;
    constexpr int U = 4;
    for (int it0 = F.gw * (8 * U); it0 < items; it0 += F.NGW * (8 * U)) {
        v4u raw[U]; f32x4 c0[U], c1[U], s0[U], s1[U];
#pragma unroll
        for (int u = 0; u < U; ++u) { const int it = it0 + 8 * u + sub; const int row = it / nheads, h = it % nheads, t = row % Lr;
            raw[u] = *(const GAS v4u*)(src + (size_t)row * spitch + scol0 + h * 64 + 8 * i8);
            if (rope) { const float* tr = tab + (size_t)t * 64 + 8 * (i8 & 3);
                c0[u] = *(const GAS f32x4*)(tr); c1[u] = *(const GAS f32x4*)(tr + 4); s0[u] = *(const GAS f32x4*)(tr + 32); s1[u] = *(const GAS f32x4*)(tr + 36); } }
#pragma unroll
        for (int u = 0; u < U; ++u) { const int it = it0 + 8 * u + sub; const int row = it / nheads, h = it % nheads, t = row % Lr;
            float v[8] = {bflo(raw[u].x), bfhi(raw[u].x), bflo(raw[u].y), bfhi(raw[u].y), bflo(raw[u].z), bfhi(raw[u].z), bflo(raw[u].w), bfhi(raw[u].w)};
            if (gain) { float ss = 0.f;
#pragma unroll
                for (int j = 0; j < 8; ++j) ss += v[j] * v[j];
                ss += __shfl_xor(ss, 1); ss += __shfl_xor(ss, 2); ss += __shfl_xor(ss, 4);
                const float r = __builtin_amdgcn_rsqf(ss * (1.f / 64.f) + EPS);
#pragma unroll
                for (int j = 0; j < 8; ++j) v[j] = v[j] * r * gn[j]; }
            if (rope) {
                const float cs[8] = {c0[u][0], c0[u][1], c0[u][2], c0[u][3], c1[u][0], c1[u][1], c1[u][2], c1[u][3]}, sn[8] = {s0[u][0], s0[u][1], s0[u][2], s0[u][3], s1[u][0], s1[u][1], s1[u][2], s1[u][3]};
#pragma unroll
                for (int j = 0; j < 8; ++j) { const float p = __shfl_xor(v[j], 4); v[j] = (i8 < 4) ? (v[j] * cs[j] - p * sn[j]) : (v[j] * cs[j] + p * sn[j]); } }
            float f = cscale;
            if (decay) { const float lg = __builtin_amdgcn_logf(1.0f - __builtin_amdgcn_exp2f(-5.0f - (float)h)); f *= __builtin_amdgcn_exp2f((float)(decay * t) * lg); }
            v4u o; o.x = pk2(v[0] * f, v[1] * f); o.y = pk2(v[2] * f, v[3] * f); o.z = pk2(v[4] * f, v[5] * f); o.w = pk2(v[6] * f, v[7] * f);
            bf16* dp = dmode == 0 ? dst + (size_t)row * dpitch + dcol0 + h * 64 + 8 * i8 : dst + ((size_t)((row / Lr) * nheads + h) * Lr + t) * 64 + 8 * i8;
            *(GAS v4u*)dp = o; }
    }
}
__device__ __forceinline__ void transpose_cols(Frame& F, const bf16* src, int spitch, int scol0, int ncols, int nb, int Lr, bf16* dst) {
    LAS bf16* scr = (LAS bf16*)(F.lds + F.wave * 16384);
    const int ntt = Lr / 64, nct = ncols / 64, ntiles = nb * ntt * nct; const int i8 = F.lane & 7, sub = F.lane >> 3;
    for (int tl = F.gw; tl < ntiles; tl += F.NGW) {
        const int ct = tl % nct, tt = (tl / nct) % ntt, b = tl / (nct * ntt); const int t0 = tt * 64, c0 = ct * 64;
#pragma unroll
        for (int k = 0; k < 8; ++k) { const int r = sub + 8 * k;
            const v4u raw = *(const GAS v4u*)(src + (size_t)(b * Lr + t0 + r) * spitch + scol0 + c0 + 8 * i8);
            *(LAS v4u*)(scr + r * 72 + 8 * i8) = raw; }
        LDS_WAIT(); asm volatile("" ::: "memory");
        bf16* drow = dst + ((size_t)b * ncols + c0 + F.lane) * Lr + t0;
#pragma unroll
        for (int k = 0; k < 8; ++k) { unsigned w[4];
#pragma unroll
            for (int q = 0; q < 4; ++q) { const unsigned lo = scr[(8 * k + 2 * q) * 72 + F.lane], hi = scr[(8 * k + 2 * q + 1) * 72 + F.lane]; w[q] = lo | (hi << 16); }
            v4u o; o.x = w[0]; o.y = w[1]; o.z = w[2]; o.w = w[3]; *(GAS v4u*)(drow + 8 * k) = o; }
        LDS_WAIT(); asm volatile("" ::: "memory");
    }
}
__device__ __forceinline__ void row2_to_bf16(Frame& F, const float* xrow, bf16* orow, float* part, size_t rstep) {
    const GAS f32x4* xr0 = (const GAS f32x4*)xrow + F.lane; const GAS f32x4* xr1 = (const GAS f32x4*)(xrow + rstep) + F.lane;
    f32x4 v0[4], v1[4];
#pragma unroll
    for (int j = 0; j < 4; ++j) { v0[j] = xr0[64 * j]; v1[j] = xr1[64 * j]; }
    float s0 = 0.f, s1 = 0.f;
#pragma unroll
    for (int j = 0; j < 4; ++j) { s0 += (v0[j].x * v0[j].x + v0[j].y * v0[j].y) + (v0[j].z * v0[j].z + v0[j].w * v0[j].w); s1 += (v1[j].x * v1[j].x + v1[j].y * v1[j].y) + (v1[j].z * v1[j].z + v1[j].w * v1[j].w); }
#pragma unroll
    for (int o = 1; o < 64; o <<= 1) { s0 += __shfl_xor(s0, o); s1 += __shfl_xor(s1, o); }
    GAS v2u* o0 = (GAS v2u*)orow + F.lane; GAS v2u* o1 = (GAS v2u*)(orow + rstep) + F.lane;
#pragma unroll
    for (int j = 0; j < 4; ++j) { v2u a; a.x = pk2(v0[j].x, v0[j].y); a.y = pk2(v0[j].z, v0[j].w); o0[64 * j] = a; v2u b; b.x = pk2(v1[j].x, v1[j].y); b.y = pk2(v1[j].z, v1[j].w); o1[64 * j] = b; }
    if (F.lane < 16) { part[F.lane] = F.lane == 0 ? s0 : 0.f; part[(rstep >> 10) * 16 + F.lane] = F.lane == 0 ? s1 : 0.f; }
}
__device__ __forceinline__ void row_to_bf16(Frame& F, const float* xrow, bf16* orow, float* part) {
    const GAS f32x4* xr = (const GAS f32x4*)xrow + F.lane;
    f32x4 v[4]; float s = 0.f;
#pragma unroll
    for (int j = 0; j < 4; ++j) { v[j] = xr[64 * j]; s += (v[j].x * v[j].x + v[j].y * v[j].y) + (v[j].z * v[j].z + v[j].w * v[j].w); }
    s = wave_sum(s);
    GAS v2u* o8 = (GAS v2u*)orow + F.lane;
#pragma unroll
    for (int j = 0; j < 4; ++j) { v2u o; o.x = pk2(v[j].x, v[j].y); o.y = pk2(v[j].z, v[j].w); o8[64 * j] = o; }
    if (F.lane < 16) part[F.lane] = F.lane == 0 ? s : 0.f;
}
enum { MK_NONE = 0, MK_CAUSAL = 1, MK_WIN = 2, MK_BITS = 3, MK_SLC = 4, MK_CMP = 5 };
struct KVp { const bf16* K; int kpitch; const bf16* VT; int vpitch; };
struct MaskArg { int q0[3]; const unsigned* mb; unsigned sel; int nmax; float lg; };
__device__ __forceinline__ bf16x8 ld8(const bf16* p) { return *(const GAS bf16x8*)p; }
__device__ __forceinline__ float fast_exp2(float x) { return __builtin_amdgcn_exp2f(x); }

template <int NS, int NT, int MODE, int MT, int PF = 2>
__device__ __forceinline__ void attn_core(const LAS bf16x8* ql, const KVp kv, int kt0, int kt1, float negb, const MaskArg& ma, const unsigned* const (&mbrow)[NS],
                                          f32x16 (&O)[NS][NT], float (&lsum)[NS], int lane) {
    const int r32 = lane & 31, hi = lane >> 5;
    const int kperm = (r32 & 0x13) | ((r32 & 4) << 1) | ((r32 & 8) >> 1);
    const bf16* kp = kv.K + (size_t)kperm * kv.kpitch + 8 * hi;
    const bf16* vp = kv.VT + (size_t)r32 * kv.vpitch + 8 * hi;
    bf16x8 kf[4], vf[2][NT], kfn[4], vfn[2][NT];
#define AC_LOADK(dst, kt_) do { const bf16* kq_ = kp + (size_t)(32 * (kt_)) * kv.kpitch; _Pragma("unroll") for (int ks = 0; ks < 4; ++ks) dst[ks] = ld8(kq_ + 16 * ks); } while (0)
#define AC_LOADV(dst, kt_) do { _Pragma("unroll") for (int nt = 0; nt < NT; ++nt) { const bf16* vq_ = vp + (size_t)(32 * nt) * kv.vpitch + 32 * (kt_); dst[0][nt] = ld8(vq_); dst[1][nt] = ld8(vq_ + 16); } } while (0)
    unsigned mw[NS], mwn[NS];
    if (kt0 < kt1) { if (PF >= 1) AC_LOADK(kf, kt0); if (PF >= 2) AC_LOADV(vf, kt0);
        if (MT == MK_BITS) { _Pragma("unroll") for (int s = 0; s < NS; ++s) mw[s] = mbrow[s][kt0]; } }
#pragma unroll 1
    for (int kt = kt0; kt < kt1; ++kt) {
        unsigned selbit = 1u; bool active = true;
        if (MT == MK_SLC) { selbit = (ma.sel >> (kt >> 1)) & 1u; active = __any(selbit != 0u); }
        const int ktn = (kt + 1 < kt1) ? kt + 1 : kt;
        if (PF == 0) { if (active) { AC_LOADK(kf, kt); AC_LOADV(vf, kt); } }
        else { AC_LOADK(kfn, ktn); if (PF >= 2) AC_LOADV(vfn, ktn); else if (active) AC_LOADV(vf, kt); }
        if (MT == MK_BITS) { _Pragma("unroll") for (int s = 0; s < NS; ++s) mwn[s] = mbrow[s][ktn]; }
        if (active) {
        const LAS bf16x8* qlp = ql; asm volatile("" : "+v"(qlp));
#pragma unroll
        for (int s = 0; s < NS; ++s) {
            f32x16 acc;
#pragma unroll
            for (int r = 0; r < 16; ++r) acc[r] = 0.f;
            bf16x8 qq[4];
#pragma unroll
            for (int ks = 0; ks < 4; ++ks) qq[ks] = qlp[(s * 4 + ks) * 64];
#pragma unroll
            for (int ks = 0; ks < 4; ++ks) acc = __builtin_amdgcn_mfma_f32_32x32x16_bf16(kf[ks], qq[ks], acc, 0, 0, 0);
            const int tq = ma.q0[s] + r32, kb = 32 * kt + 8 * hi;
            bool full = true;
            if (MT == MK_CAUSAL) full = (32 * kt + 31 <= ma.q0[s]);
            if (MT == MK_WIN) full = (32 * kt + 31 <= ma.q0[s]) && (32 * kt >= ma.q0[s] + 31 - 511);
            if (MT == MK_SLC) full = (32 * kt + 31 <= ma.q0[s]) && __all(selbit != 0u);
            if (MT == MK_BITS || MT == MK_CMP) full = false;
            float p[16];
            if (full) {
#pragma unroll
                for (int r = 0; r < 16; ++r) { const int key = kb + 16 * (r >> 3) + (r & 7); p[r] = MODE == 0 ? fast_exp2(acc[r]) : (MODE == 1 ? acc[r] : acc[r] * fast_exp2((float)(tq - key) * ma.lg)); }
            } else {
                unsigned w = 0;
                if (MT == MK_BITS) w = mw[s];
#pragma unroll
                for (int r = 0; r < 16; ++r) { const int key = kb + 16 * (r >> 3) + (r & 7); bool v = true;
                    if (MT == MK_CAUSAL) v = key <= tq;
                    if (MT == MK_WIN) v = (key <= tq) && (key >= tq - 511);
                    if (MT == MK_SLC) v = (key <= tq) && (selbit != 0u);
                    if (MT == MK_BITS) v = (w >> (8 * hi + 16 * (r >> 3) + (r & 7))) & 1u;
                    if (MT == MK_CMP) v = key <= ma.nmax;
                    const float e = MODE == 0 ? fast_exp2(acc[r]) : (MODE == 1 ? acc[r] : acc[r] * fast_exp2((float)((tq - key) < 0 ? 0 : (tq - key)) * ma.lg));
                    p[r] = v ? e : 0.f; }
            }
            if (MODE == 0) { float a = 0.f;
#pragma unroll
                for (int r = 0; r < 16; ++r) a += p[r];
                lsum[s] += a; }
            bf16x8 pk0, pk1;
            { v4u t0, t1; t0.x = pk2(p[0], p[1]); t0.y = pk2(p[2], p[3]); t0.z = pk2(p[4], p[5]); t0.w = pk2(p[6], p[7]);
              t1.x = pk2(p[8], p[9]); t1.y = pk2(p[10], p[11]); t1.z = pk2(p[12], p[13]); t1.w = pk2(p[14], p[15]);
              pk0 = __builtin_bit_cast(bf16x8, t0); pk1 = __builtin_bit_cast(bf16x8, t1); }
#pragma unroll
            for (int nt = 0; nt < NT; ++nt) { O[s][nt] = __builtin_amdgcn_mfma_f32_32x32x16_bf16(pk0, vf[0][nt], O[s][nt], 0, 0, 0);
                                              O[s][nt] = __builtin_amdgcn_mfma_f32_32x32x16_bf16(pk1, vf[1][nt], O[s][nt], 0, 0, 0); }
            if (NS >= 3) __builtin_amdgcn_sched_barrier(0);
        }
        }
        if (MT == MK_BITS) { _Pragma("unroll") for (int s = 0; s < NS; ++s) mw[s] = mwn[s]; }
        if (PF >= 1) {
#pragma unroll
            for (int ks = 0; ks < 4; ++ks) kf[ks] = kfn[ks];
            if (PF >= 2) {
#pragma unroll
                for (int nt = 0; nt < NT; ++nt) { vf[0][nt] = vfn[0][nt]; vf[1][nt] = vfn[1][nt]; } }
        }
    }
#undef AC_LOADK
#undef AC_LOADV
}
template <int NS, int NT, int MODE, int MT, bool LDSK = false>
__device__ __forceinline__ void tile_math(const bf16x8 (&kf_)[4], const bf16x8 (&vf_)[2][NT], const LAS bf16x8* ql, int kt, const MaskArg& ma, const unsigned (&mw)[NS], unsigned selbit,
                                          f32x16 (&O)[NS][NT], float (&lsum)[NS], int lane, const LAS bf16x8* sp = nullptr) {
    const int r32 = lane & 31, hi = lane >> 5;
    const LAS bf16x8* qlp = ql; asm volatile("" : "+v"(qlp));
    f32x16 acc[NS];
#pragma unroll
    for (int s = 0; s < NS; ++s)
#pragma unroll
        for (int r = 0; r < 16; ++r) acc[s][r] = 0.f;
    bf16x8 kf[4], vf[2][NT];
    {
        bf16x8 qa[NS][4];
        if (LDSK) {
#pragma unroll
            for (int ks = 0; ks < 4; ++ks) { kf[ks] = sp[ks * 64];
#pragma unroll
                for (int s = 0; s < NS; ++s) qa[s][ks] = qlp[(s * 4 + ks) * 64];
                __builtin_amdgcn_sched_barrier(0); }
#pragma unroll
            for (int nt = 0; nt < NT; ++nt) { vf[0][nt] = sp[(4 + 2 * nt) * 64]; vf[1][nt] = sp[(5 + 2 * nt) * 64]; }
        } else {
#pragma unroll
            for (int ks = 0; ks < 4; ++ks) kf[ks] = kf_[ks];
#pragma unroll
            for (int nt = 0; nt < NT; ++nt) { vf[0][nt] = vf_[0][nt]; vf[1][nt] = vf_[1][nt]; }
#pragma unroll
            for (int s = 0; s < NS; ++s)
#pragma unroll
                for (int ks = 0; ks < 4; ++ks) qa[s][ks] = qlp[(s * 4 + ks) * 64];
        }
        __builtin_amdgcn_sched_barrier(0);
#pragma unroll
        for (int ks = 0; ks < 4; ++ks)
#pragma unroll
            for (int s = 0; s < NS; ++s) acc[s] = __builtin_amdgcn_mfma_f32_32x32x16_bf16(kf[ks], qa[s][ks], acc[s], 0, 0, 0);
        __builtin_amdgcn_sched_barrier(0);
    }
#pragma unroll
    for (int s = 0; s < NS; ++s) {
        const int tq = ma.q0[s] + r32, kb = 32 * kt + 8 * hi;
        bool full = true;
        if (MT == MK_CAUSAL) full = (32 * kt + 31 <= ma.q0[s]);
        if (MT == MK_WIN) full = (32 * kt + 31 <= ma.q0[s]) && (32 * kt >= ma.q0[s] + 31 - 511);
        if (MT == MK_SLC) full = (32 * kt + 31 <= ma.q0[s]) && __all(selbit != 0u);
        if (MT == MK_BITS || MT == MK_CMP) full = false;
        float p[16];
        if (full) {
#pragma unroll
            for (int r = 0; r < 16; ++r) p[r] = MODE == 0 ? fast_exp2(acc[s][r]) : acc[s][r];
        } else if (MT == MK_BITS) {
            const unsigned wsh = mw[s] >> (8 * hi);
#pragma unroll
            for (int r = 0; r < 16; ++r) { const int m = ((int)(wsh << (31 - (16 * (r >> 3) + (r & 7))))) >> 31;
                p[r] = __builtin_bit_cast(float, __builtin_bit_cast(unsigned, fast_exp2(acc[s][r])) & (unsigned)m); }
        } else {
#pragma unroll
            for (int r = 0; r < 16; ++r) { const int key = kb + 16 * (r >> 3) + (r & 7); bool v = true;
                if (MT == MK_CAUSAL) v = key <= tq;
                if (MT == MK_WIN) v = (key <= tq) && (key >= tq - 511);
                if (MT == MK_SLC) v = (key <= tq) && (selbit != 0u);
                if (MT == MK_CMP) v = key <= ma.nmax;
                const float e = MODE == 0 ? fast_exp2(acc[s][r]) : acc[s][r];
                p[r] = v ? e : 0.f; }
        }
        if (MODE == 0) { float a = 0.f;
#pragma unroll
            for (int r = 0; r < 16; ++r) a += p[r];
            lsum[s] += a; }
        bf16x8 pk0, pk1;
        { v4u t0, t1; t0.x = pk2(p[0], p[1]); t0.y = pk2(p[2], p[3]); t0.z = pk2(p[4], p[5]); t0.w = pk2(p[6], p[7]);
          t1.x = pk2(p[8], p[9]); t1.y = pk2(p[10], p[11]); t1.z = pk2(p[12], p[13]); t1.w = pk2(p[14], p[15]);
          pk0 = __builtin_bit_cast(bf16x8, t0); pk1 = __builtin_bit_cast(bf16x8, t1); }
#pragma unroll
        for (int nt = 0; nt < NT; ++nt) { O[s][nt] = __builtin_amdgcn_mfma_f32_32x32x16_bf16(pk0, vf[0][nt], O[s][nt], 0, 0, 0);
                                          O[s][nt] = __builtin_amdgcn_mfma_f32_32x32x16_bf16(pk1, vf[1][nt], O[s][nt], 0, 0, 0); }
    }
}
__device__ __forceinline__ int crow(int r, int hi) { return (r & 3) + 8 * (r >> 2) + 4 * hi; }
template <int NT, bool ADD>
__device__ __forceinline__ void store_o(const f32x16 (&O)[NT], float f, bf16* Y, int row0, int col0, int lane) {
    const int r32 = lane & 31, hi = lane >> 5;
    GAS bf16* Yg = (GAS bf16*)Y;
    unsigned ybase = (unsigned)((row0 + 4 * hi) * 1024 + col0 + r32); asm volatile("" : "+v"(ybase));
#pragma unroll
    for (int rh = 0; rh < 2; ++rh) {
        unsigned short old[NT][8];
        if (ADD) {
#pragma unroll
            for (int ri = 0; ri < 8; ++ri)
#pragma unroll
                for (int nt = 0; nt < NT; ++nt) { const int r = 8 * rh + ri; old[nt][ri] = Yg[ybase + (unsigned)(((r & 3) + 8 * (r >> 2)) * 1024) + 32 * nt]; }
        }
#pragma unroll
        for (int ri = 0; ri < 8; ++ri) { const int r = 8 * rh + ri; const int q = crow(r, hi); const float fr = __shfl(f, q);
            const unsigned yo = ybase + (unsigned)(((r & 3) + 8 * (r >> 2)) * 1024);
#pragma unroll
            for (int nt = 0; nt < NT; ++nt) { float v = O[nt][r] * fr; if (ADD) v += bf2f(old[nt][ri]); Yg[yo + 32 * nt] = (bf16)f2bf(v); } }
    }
}
template <int NS> __device__ __forceinline__ void stage_q(LAS bf16x8* ql, const bf16* const (&qrow)[NS], int lane) {
    const int hi = lane >> 5;
#pragma unroll
    for (int s = 0; s < NS; ++s)
#pragma unroll
        for (int ks = 0; ks < 4; ++ks) ql[(s * 4 + ks) * 64] = ld8(qrow[s] + 16 * ks + 8 * hi);
    LDS_WAIT(); asm volatile("" ::: "memory");
}
__device__ __forceinline__ void q32_load(const bf16* p  , float (&v)[4][8]) {
    v4u raw[4];
#pragma unroll
    for (int ks = 0; ks < 4; ++ks) raw[ks] = *(const GAS v4u*)(p + 16 * ks);
#pragma unroll
    for (int ks = 0; ks < 4; ++ks) { v[ks][0] = bflo(raw[ks].x); v[ks][1] = bfhi(raw[ks].x); v[ks][2] = bflo(raw[ks].y); v[ks][3] = bfhi(raw[ks].y);
        v[ks][4] = bflo(raw[ks].z); v[ks][5] = bfhi(raw[ks].z); v[ks][6] = bflo(raw[ks].w); v[ks][7] = bfhi(raw[ks].w); }
}
__device__ __forceinline__ void q32_xf(float (&v)[4][8], const float* gain, bool rope, int t, float scale, int hi, const float* tab) {
    if (gain) { float ss = 0.f;
#pragma unroll
        for (int ks = 0; ks < 4; ++ks)
#pragma unroll
            for (int j = 0; j < 8; ++j) ss += v[ks][j] * v[ks][j];
        ss += __shfl_xor(ss, 32);
        const float r = __builtin_amdgcn_rsqf(ss * (1.f / 64.f) + EPS);
#pragma unroll
        for (int ks = 0; ks < 4; ++ks) { const f32x4 g0 = *(const GAS f32x4*)(gain + 16 * ks + 8 * hi), g1 = *(const GAS f32x4*)(gain + 16 * ks + 8 * hi + 4);
#pragma unroll
            for (int j = 0; j < 4; ++j) { v[ks][j] *= r * g0[j]; v[ks][4 + j] *= r * g1[j]; } } }
    if (rope) { const float* tr = tab + (size_t)t * 64 + 8 * hi;
#pragma unroll
        for (int ks = 0; ks < 2; ++ks) { const f32x4 c0 = *(const GAS f32x4*)(tr + 16 * ks), c1 = *(const GAS f32x4*)(tr + 16 * ks + 4), s0 = *(const GAS f32x4*)(tr + 32 + 16 * ks), s1 = *(const GAS f32x4*)(tr + 36 + 16 * ks);
#pragma unroll
            for (int j = 0; j < 8; ++j) { const float c = j < 4 ? c0[j & 3] : c1[j & 3], sn = j < 4 ? s0[j & 3] : s1[j & 3]; const float a = v[ks][j], b = v[ks + 2][j];
                v[ks][j] = a * c - b * sn; v[ks + 2][j] = b * c + a * sn; } } }
#pragma unroll
    for (int ks = 0; ks < 4; ++ks)
#pragma unroll
        for (int j = 0; j < 8; ++j) v[ks][j] *= scale;
}
__device__ __forceinline__ bf16x8 q32_pack(const float (&v)[8]) { v4u o; o.x = pk2(v[0], v[1]); o.y = pk2(v[2], v[3]); o.z = pk2(v[4], v[5]); o.w = pk2(v[6], v[7]); return __builtin_bit_cast(bf16x8, o); }
template <int NS> __device__ __forceinline__ void stage_q_xf(Frame& F, LAS bf16x8* ql, const bf16* const (&qrow)[NS], const int (&tpos)[NS], const float* gain, bool rope, float scale) {
    const int hi = F.lane >> 5; const float* tab = (const float*)(F.ws + WS_ROPE);
#pragma unroll
    for (int s = 0; s < NS; ++s) { float v[4][8]; q32_load(qrow[s] + 8 * hi, v); q32_xf(v, gain, rope, tpos[s], scale, hi, tab);
#pragma unroll
        for (int ks = 0; ks < 4; ++ks) ql[(s * 4 + ks) * 64] = q32_pack(v[ks]); }
    LDS_WAIT(); asm volatile("" ::: "memory");
}
__device__ __forceinline__ LAS bf16x8* wave_q(Frame& F) { return (LAS bf16x8*)(F.lds + F.wave * 16384) + F.lane; }
template <int NS, int NT> __device__ __forceinline__ void zero_o(f32x16 (&O)[NS][NT], float (&l)[NS]) {
#pragma unroll
    for (int s = 0; s < NS; ++s) { l[s] = 0.f;
#pragma unroll
        for (int nt = 0; nt < NT; ++nt)
#pragma unroll
            for (int r = 0; r < 16; ++r) O[s][nt][r] = 0.f; }
}

__device__ __forceinline__ void mem_task(Frame& F, int task, int Ly, const bf16* PROJ, int ldp, int qmcol) {
    const int qb = task & 31, h = (task >> 5) & 3, b = task >> 7; const int r32 = F.lane & 31;
    const int row0 = b * SEQ + 64 * qb;
    const bf16* qrow[2] = {PROJ + (size_t)(row0 + r32) * ldp + qmcol + h * 64, PROJ + (size_t)(row0 + 32 + r32) * ldp + qmcol + h * 64};
#if QF_MEM
    LAS bf16x8* ql = wave_q(F); { const int tp[2] = {0, 0}; stage_q_xf<2>(F, ql, qrow, tp, F.ka->in[10] + Ly * 64, false, QSCALE); }
#else
    LAS bf16x8* ql = wave_q(F); stage_q<2>(ql, qrow, F.lane);
#endif
    KVp kv{(const bf16*)(F.ws + WS_MK) + ((size_t)((Ly * NB + b) * 4 + h) * NMEMT) * 64, 64, (const bf16*)(F.ws + WS_MVT) + ((size_t)(Ly * NB + b) * 256 + h * 64) * NMEMT, NMEMT};
    f32x16 O[2][2]; float l[2]; zero_o<2, 2>(O, l);
    MaskArg ma{}; const unsigned* mbr[2] = {nullptr, nullptr};
    const float negb = 0.f;
    attn_core<2, 2, 0, MK_NONE>(ql, kv, 0, NMEMT / 32, negb, ma, mbr, O, l, F.lane);
    bf16* Y = (bf16*)(F.ws + WS_Y);
#pragma unroll
    for (int s = 0; s < 2; ++s) { const float lt = l[s] + __shfl_xor(l[s], 32); store_o<2, false>(O[s], (DBG_ZERO & 8) ? 0.f : 1.f / lt, Y, row0 + 32 * s, 768 + h * 64, F.lane); }
}
__device__ __forceinline__ float dpp_add16(float x) {
    x += __builtin_bit_cast(float, __builtin_amdgcn_update_dpp(0, __builtin_bit_cast(int, x), 0xB1, 0xf, 0xf, true));
    x += __builtin_bit_cast(float, __builtin_amdgcn_update_dpp(0, __builtin_bit_cast(int, x), 0x4E, 0xf, 0xf, true));
    x += __builtin_bit_cast(float, __builtin_amdgcn_update_dpp(0, __builtin_bit_cast(int, x), 0x141, 0xf, 0xf, true));
    x += __builtin_bit_cast(float, __builtin_amdgcn_update_dpp(0, __builtin_bit_cast(int, x), 0x140, 0xf, 0xf, true));
    return x;
}
__device__ __forceinline__ void ret_gates(Frame& F, int rowb, int h, const bf16* PROJ, unsigned short (&gv)[16][4]) {
    const int r32 = F.lane & 31, hi = F.lane >> 5;
#pragma unroll
    for (int r = 0; r < 16; ++r) { const GAS bf16* gp = (const GAS bf16*)PROJ + (size_t)(rowb + crow(r, hi)) * RET_LD + RET_G + h * 128 + r32;
#pragma unroll
        for (int nt = 0; nt < 4; ++nt) gv[r][nt] = gp[32 * nt]; }
}
__device__ __forceinline__ void ret_epilogue(Frame& F, const f32x16 (&O)[4], int rowb, int h, const unsigned short (&gv)[16][4]) {
    const int r32 = F.lane & 31, hi = F.lane >> 5;
    bf16* Y = (bf16*)(F.ws + WS_Y);
#pragma unroll
    for (int rh = 0; rh < 2; ++rh) {
        float av[8], qv[8];
#pragma unroll
        for (int ri = 0; ri < 8; ++ri) { const int r = 8 * rh + ri;
            av[ri] = dpp_add16((O[0][r] + O[1][r]) + (O[2][r] + O[3][r]));
            qv[ri] = dpp_add16((O[0][r] * O[0][r] + O[1][r] * O[1][r]) + (O[2][r] * O[2][r] + O[3][r] * O[3][r])); }
#pragma unroll
        for (int ri = 0; ri < 8; ++ri) { av[ri] += __shfl_xor(av[ri], 16); qv[ri] += __shfl_xor(qv[ri], 16); }
#pragma unroll
        for (int ri = 0; ri < 8; ++ri) { const int r = 8 * rh + ri;
            const float mu = av[ri] * (1.f / 128.f);
            float var = qv[ri] * (1.f / 128.f) - mu * mu; var = var < 0.f ? 0.f : var;
            const float rstd = __builtin_amdgcn_rsqf(var + EPS);
            const int row = rowb + crow(r, hi);
            GAS bf16* yp = (GAS bf16*)Y + (size_t)row * 1024 + h * 128 + r32;
            const float dd[4] = {O[0][r] - mu, O[1][r] - mu, O[2][r] - mu, O[3][r] - mu};
#pragma unroll
            for (int nt = 0; nt < 4; ++nt) { const float g = bf2f(gv[r][nt]); const float sg = g * __builtin_amdgcn_rcpf(1.f + fast_exp2(-1.4426950408889634f * g));
                yp[32 * nt] = (DBG_ZERO & 1) ? (bf16)0 : (bf16)f2bf(sg * dd[nt] * rstd); }
        }
    }
}
__device__ __forceinline__ void glds16(const void* gsrc, unsigned lds_dst) { unsigned keep;
    asm volatile("s_mov_b32 %0, m0\n\ts_mov_b32 m0, %2\n\ts_nop 0\n\tglobal_load_lds_dwordx4 %1, off\n\ts_mov_b32 m0, %0" : "=&s"(keep) : "v"(gsrc), "s"(lds_dst) : "memory"); }
template <int NS, int MT, int R>
__device__ __forceinline__ void wg_attn(Frame& F, const LAS bf16x8* ql, const bf16* psrc, int pstep, unsigned ring_off, int kt0, int kt1, unsigned blk, int my0, int my1,
                                        const MaskArg& ma, const LAS unsigned* mlds, f32x16 (&O)[NS][2], float (&lsum)[NS]) {
    const unsigned pdst = (unsigned)(uintptr_t)F.lds + ring_off + (unsigned)F.wave * 1024u;
#define WG_NEED(k_) ((MT != MK_SLC) || (((blk) >> ((k_) >> 1)) & 1u))
#define WG_ADV(k_) do { ++(k_); } while ((k_) < kt1 && !WG_NEED(k_))
    int kd = kt0; if (kd < kt1 && !WG_NEED(kd)) WG_ADV(kd);
    int kc = kd;
    int sd = 0, sc = 0, nd = 0;
#pragma unroll 1
    for (int j = 0; j < R - 1; ++j) if (kd < kt1) { glds16(psrc + (size_t)kd * pstep, (unsigned)__builtin_amdgcn_readfirstlane(pdst + (unsigned)sd * 8192u)); WG_ADV(kd); sd = sd + 1 == R ? 0 : sd + 1; ++nd; }
    __builtin_amdgcn_s_waitcnt(0xC07F);
#pragma unroll 1
    while (kc < kt1) {
        const int yo = nd - 1;
        if (yo >= 3) asm volatile("s_waitcnt vmcnt(3)\n\ts_barrier" ::: "memory");
        else if (yo == 2) asm volatile("s_waitcnt vmcnt(2)\n\ts_barrier" ::: "memory");
        else if (yo == 1) asm volatile("s_waitcnt vmcnt(1)\n\ts_barrier" ::: "memory");
        else asm volatile("s_waitcnt vmcnt(0)\n\ts_barrier" ::: "memory");
        if (kd < kt1) { glds16(psrc + (size_t)kd * pstep, (unsigned)__builtin_amdgcn_readfirstlane(pdst + (unsigned)sd * 8192u)); WG_ADV(kd); sd = sd + 1 == R ? 0 : sd + 1; ++nd; }
#if WG_SKEW
        if (F.wave >= 4) __builtin_amdgcn_s_sleep(WG_SKEW);
#endif
        if (kc >= my0 && kc < my1) {
            unsigned selbit = 1u; bool active = true;
            if (MT == MK_SLC) { selbit = (ma.sel >> (kc >> 1)) & 1u; active = __any(selbit != 0u); }
            if (active) {
                const LAS bf16x8* sp = (const LAS bf16x8*)(F.lds + ring_off + sc * 8192) + F.lane;
                unsigned mw[NS];
#pragma unroll
                for (int s = 0; s < NS; ++s) mw[s] = (MT == MK_BITS) ? mlds[kc] : 0u;
                const bf16x8 kz[4] = {}; const bf16x8 vz[2][2] = {};
                tile_math<NS, 2, 0, MT, true>(kz, vz, ql, kc, ma, mw, selbit, O, lsum, F.lane, sp);
            }
        }
        WG_ADV(kc); sc = sc + 1 == R ? 0 : sc + 1; --nd;
    }
    asm volatile("s_waitcnt vmcnt(0)\n\ts_barrier" ::: "memory");
#undef WG_NEED
#undef WG_ADV
}
template <int NS, int MT>
__device__ __forceinline__ void wg_attn2(Frame& F, const LAS bf16x8* ql, const bf16* psrc, int pstep, unsigned ring_off, int kt0, int kt1, unsigned blk, int my0, int my1,
                                         const MaskArg& ma, f32x16 (&O)[NS][2], float (&lsum)[NS]) {
    const unsigned pdst = (unsigned)(uintptr_t)F.lds + ring_off + (unsigned)F.wave * 1024u;
    const int pend = kt1 >> 1;
#define WG2_NEED(p_) ((MT != MK_SLC) || (((blk) >> (p_)) & 1u))
#define WG2_ADV(p_) do { ++(p_); } while ((p_) < pend && !WG2_NEED(p_))
#define WG2_DMA(p_, slot_) do { const unsigned d_ = (unsigned)__builtin_amdgcn_readfirstlane(pdst + (unsigned)(slot_) * 16384u); \
        glds16(psrc + (size_t)(2 * (p_)) * pstep, d_); glds16(psrc + (size_t)(2 * (p_) + 1) * pstep, d_ + 8192u); } while (0)
    int pd = kt0 >> 1; if (pd < pend && !WG2_NEED(pd)) WG2_ADV(pd);
    int pc = pd, sd = 0, sc = 0, nd = 0;
    if (pd < pend) { WG2_DMA(pd, sd); WG2_ADV(pd); sd ^= 1; ++nd; }
    __builtin_amdgcn_s_waitcnt(0xC07F);
#pragma unroll 1
    while (pc < pend) {
        if (nd >= 2) asm volatile("s_waitcnt vmcnt(2)\n\ts_barrier" ::: "memory");
        else asm volatile("s_waitcnt vmcnt(0)\n\ts_barrier" ::: "memory");
        if (pd < pend) { WG2_DMA(pd, sd); WG2_ADV(pd); sd ^= 1; ++nd; }
#pragma unroll 1
        for (int t = 0; t < 2; ++t) { const int kc = 2 * pc + t;
            if (kc >= my0 && kc < my1) {
                unsigned selbit = 1u; bool active = true;
                if (MT == MK_SLC) { selbit = (ma.sel >> pc) & 1u; active = __any(selbit != 0u); }
                if (active) {
                    const LAS bf16x8* sp = (const LAS bf16x8*)(F.lds + ring_off + sc * 16384 + t * 8192) + F.lane;
                    unsigned mw[NS];
#pragma unroll
                    for (int s = 0; s < NS; ++s) mw[s] = 0u;
                    const bf16x8 kz[4] = {}; const bf16x8 vz[2][2] = {};
                    tile_math<NS, 2, 0, MT, true>(kz, vz, ql, kc, ma, mw, selbit, O, lsum, F.lane, sp);
                }
            }
        }
        WG2_ADV(pc); sc ^= 1; --nd;
    }
    asm volatile("s_waitcnt vmcnt(0)\n\ts_barrier" ::: "memory");
#undef WG2_NEED
#undef WG2_ADV
#undef WG2_DMA
}
__device__ __forceinline__ void mem_wg_task(Frame& F, int task, int Ly, const bf16* PROJ, int ldp, int qmcol) {
    const int qb = task & 3, h = (task >> 2) & 3, b = task >> 4, w = F.wave; const int r32 = F.lane & 31, hi = F.lane >> 5;
    const int row0 = b * SEQ + 512 * qb + 64 * w;
    const bf16* qrow[2] = {PROJ + (size_t)(row0 + r32) * ldp + qmcol + h * 64, PROJ + (size_t)(row0 + 32 + r32) * ldp + qmcol + h * 64};
    LAS bf16x8* ql = (LAS bf16x8*)(F.lds + 65536 + w * 8192) + F.lane;
    { const int kperm = (r32 & 0x13) | ((r32 & 4) << 1) | ((r32 & 8) >> 1);
      const bf16* Kb = (const bf16*)(F.ws + WS_MK) + ((size_t)((Ly * NB + b) * 4 + h) * NMEMT + 32 * w + kperm) * 64 + 8 * hi;
      const bf16* Vb = (const bf16*)(F.ws + WS_MVT) + ((size_t)(Ly * NB + b) * 256 + h * 64 + r32) * NMEMT + 32 * w + 8 * hi;
      const unsigned dst = (unsigned)(uintptr_t)F.lds + (unsigned)w * 8192u;
#pragma unroll
      for (int ks = 0; ks < 4; ++ks) glds16(Kb + 16 * ks, (unsigned)__builtin_amdgcn_readfirstlane(dst + ks * 1024u));
#pragma unroll
      for (int j = 0; j < 4; ++j) glds16(Vb + (size_t)(32 * (j >> 1)) * NMEMT + 16 * (j & 1), (unsigned)__builtin_amdgcn_readfirstlane(dst + (4 + j) * 1024u)); }
#if QF_MEM
    { const int tp[2] = {0, 0}; stage_q_xf<2>(F, ql, qrow, tp, F.ka->in[10] + Ly * 64, false, QSCALE); }
#else
    stage_q<2>(ql, qrow, F.lane);
#endif
    asm volatile("s_waitcnt lgkmcnt(0)" ::: "memory");
    asm volatile("s_waitcnt vmcnt(0)\n\ts_barrier" ::: "memory");
    f32x16 O[2][2]; float l[2]; zero_o<2, 2>(O, l);
    MaskArg ma{}; const unsigned mw[2] = {0u, 0u};
#pragma unroll 1
    for (int kt = 0; kt < 8; ++kt) {
        const LAS bf16x8* sp = (const LAS bf16x8*)(F.lds + kt * 8192) + F.lane;
        bf16x8 kf[4], vf[2][2];
#pragma unroll
        for (int ks = 0; ks < 4; ++ks) kf[ks] = sp[ks * 64];
#pragma unroll
        for (int nt = 0; nt < 2; ++nt) { vf[0][nt] = sp[(4 + 2 * nt) * 64]; vf[1][nt] = sp[(5 + 2 * nt) * 64]; }
        tile_math<2, 2, 0, MK_NONE>(kf, vf, ql, kt, ma, mw, 1u, O, l, F.lane);
    }
    bf16* Y = (bf16*)(F.ws + WS_Y);
#pragma unroll
    for (int s = 0; s < 2; ++s) { const float lt = l[s] + __shfl_xor(l[s], 32); store_o<2, false>(O[s], (DBG_ZERO & 8) ? 0.f : 1.f / lt, Y, row0 + 32 * s, 768 + h * 64, F.lane); }
}
#define STB ((bf16*)F.out + (size_t)32 * 1024 * 1024)
constexpr int RST_PITCH = 260, RST_BUF = 34816;
__device__ __forceinline__ void ret_state_task(Frame& F, int task, const bf16* PROJ) {
    const int h = task % 6, b = task / 6, w = F.wave; const int r32 = F.lane & 31, hi = F.lane >> 5; const int dt = w & 1, et = w >> 1; const int tid = w * 64 + F.lane;
    const bf16* ksrc = PROJ + (size_t)(b * SEQ + (tid >> 3)) * RET_LD + RET_K + h * 64 + 8 * (tid & 7);
    const bf16* vsrc = (const bf16*)F.out + ((size_t)b * 768 + h * 128 + 32 * et + r32) * SEQ + 8 * hi;
    bf16* st = STB + ((size_t)((b * 6 + h) * 7) * 128 + 32 * et + r32) * 64 + 32 * dt + 4 * hi;
    f32x16 acc;
#pragma unroll
    for (int r = 0; r < 16; ++r) acc[r] = 0.f;
    v4u kraw[4]; bf16x8 vf[16];
#pragma unroll
    for (int i = 0; i < 4; ++i) kraw[i] = *(const GAS v4u*)(ksrc + (size_t)(64 * i) * RET_LD);
#pragma unroll
    for (int ks = 0; ks < 16; ++ks) vf[ks] = ld8(vsrc + 16 * ks);
#pragma unroll 1
    for (int m = 0; m < 7; ++m) {
        LAS bf16* buf = (LAS bf16*)(F.lds + (m & 1) * RST_BUF);
#pragma unroll
        for (int i = 0; i < 4; ++i) { LAS bf16* bp = buf + (8 * (tid & 7)) * RST_PITCH + (tid >> 3) + 64 * i; const unsigned ww[4] = {kraw[i].x, kraw[i].y, kraw[i].z, kraw[i].w};
#pragma unroll
            for (int j = 0; j < 4; ++j) { bp[(2 * j) * RST_PITCH] = (bf16)(ww[j] & 0xffffu); bp[(2 * j + 1) * RST_PITCH] = (bf16)(ww[j] >> 16); } }
        if (m < 6) {
#pragma unroll
            for (int i = 0; i < 4; ++i) kraw[i] = *(const GAS v4u*)(ksrc + (size_t)(256 * (m + 1) + 64 * i) * RET_LD); }
        bf16x8 vc[16];
#pragma unroll
        for (int ks = 0; ks < 16; ++ks) vc[ks] = vf[ks];
        if (m < 6) {
#pragma unroll
            for (int ks = 0; ks < 16; ++ks) vf[ks] = ld8(vsrc + 256 * (m + 1) + 16 * ks); }
        asm volatile("s_waitcnt lgkmcnt(0)\n\ts_barrier" ::: "memory");
        const LAS bf16* kp = buf + (32 * dt + r32) * RST_PITCH + 8 * hi;
#pragma unroll
        for (int ks = 0; ks < 16; ++ks) { const v2u lo = *(const LAS v2u*)(kp + 16 * ks), hh = *(const LAS v2u*)(kp + 16 * ks + 4);
            v4u kk; kk.x = lo.x; kk.y = lo.y; kk.z = hh.x; kk.w = hh.y;
            acc = __builtin_amdgcn_mfma_f32_32x32x16_bf16(__builtin_bit_cast(bf16x8, kk), vc[ks], acc, 0, 0, 0); }
        bf16* sp = st + (size_t)m * 8192;
#pragma unroll
        for (int g = 0; g < 4; ++g) { v2u o; o.x = pk2(acc[4 * g], acc[4 * g + 1]); o.y = pk2(acc[4 * g + 2], acc[4 * g + 3]); *(GAS v2u*)(sp + 8 * g) = o; }
    }
}
constexpr int RWG_SLOT = 12288;
__device__ __forceinline__ void ret_wg_task(Frame& F, int task, const bf16* PROJ) {
    const int qb = task & 7, h = (task >> 3) % 6, b = (task >> 3) / 6, w = F.wave; const int r32 = F.lane & 31, hi = F.lane >> 5;
    const int ws = w < 4 ? w : 11 - w;
    const int rowb = b * SEQ + 256 * qb + 32 * ws;
    const int kperm = (r32 & 0x13) | ((r32 & 4) << 1) | ((r32 & 8) >> 1);
    const bf16* ksrc = PROJ + (size_t)(b * SEQ + 256 * qb + kperm) * RET_LD + RET_K + h * 64 + 16 * (w & 3) + 8 * hi;
    const bf16* vsrc = (const bf16*)F.out + ((size_t)b * 768 + h * 128 + 32 * (w >> 1) + r32) * SEQ + 256 * qb + 16 * (w & 1) + 8 * hi;
    const unsigned lds0 = (unsigned)(uintptr_t)F.lds;
#pragma unroll
    for (int i = 0; i < 4; ++i) { const int t = 2 * i + (w >> 2); glds16(ksrc + (size_t)(32 * t) * RET_LD, (unsigned)__builtin_amdgcn_readfirstlane(lds0 + (unsigned)t * RWG_SLOT + (unsigned)(w & 3) * 1024u)); }
#pragma unroll
    for (int t = 0; t < 8; ++t) glds16(vsrc + 32 * t, (unsigned)__builtin_amdgcn_readfirstlane(lds0 + (unsigned)t * RWG_SLOT + 4096u + (unsigned)w * 1024u));
    unsigned short gv[16][4]; ret_gates(F, rowb, h, PROJ, gv);
    bf16x8 qf[4];
    { float v[4][8]; q32_load(PROJ + (size_t)(rowb + r32) * RET_LD + RET_Q + h * 64 + 8 * hi, v);
      const int t = 256 * qb + 32 * ws + r32; const float lg = __builtin_amdgcn_logf(1.0f - __builtin_amdgcn_exp2f(-5.0f - (float)h));
      q32_xf(v, nullptr, true, t, __builtin_amdgcn_exp2f((float)t * lg), hi, (const float*)(F.ws + WS_ROPE));
#pragma unroll
      for (int ks = 0; ks < 4; ++ks) qf[ks] = q32_pack(v[ks]); }
    f32x16 O[4];
#pragma unroll
    for (int nt = 0; nt < 4; ++nt)
#pragma unroll
        for (int r = 0; r < 16; ++r) O[nt][r] = 0.f;
    if (qb > 0) {
        const bf16* sp = STB + ((size_t)((b * 6 + h) * 7 + qb - 1) * 128 + r32) * 64 + 8 * hi;
        bf16x8 sf[4][4];
#pragma unroll
        for (int nt = 0; nt < 4; ++nt)
#pragma unroll
            for (int ks = 0; ks < 4; ++ks) sf[nt][ks] = ld8(sp + (size_t)(32 * nt) * 64 + 16 * ks);
#pragma unroll
        for (int ks = 0; ks < 4; ++ks)
#pragma unroll
            for (int nt = 0; nt < 4; ++nt) O[nt] = __builtin_amdgcn_mfma_f32_32x32x16_bf16(qf[ks], sf[nt][ks], O[nt], 0, 0, 0);
    }
    asm volatile("s_waitcnt vmcnt(0)\n\ts_barrier" ::: "memory");
#pragma unroll 1
    for (int kt = 0; kt <= ws; ++kt) {
        const LAS bf16x8* sp = (const LAS bf16x8*)(F.lds + kt * RWG_SLOT) + F.lane;
        bf16x8 kf[4], vf[2][4];
#pragma unroll
        for (int ks = 0; ks < 4; ++ks) kf[ks] = sp[ks * 64];
#pragma unroll
        for (int nt = 0; nt < 4; ++nt) { vf[0][nt] = sp[(4 + 2 * nt) * 64]; vf[1][nt] = sp[(5 + 2 * nt) * 64]; }
        f32x16 acc;
#pragma unroll
        for (int r = 0; r < 16; ++r) acc[r] = 0.f;
#pragma unroll
        for (int ks = 0; ks < 4; ++ks) acc = __builtin_amdgcn_mfma_f32_32x32x16_bf16(kf[ks], qf[ks], acc, 0, 0, 0);
        float p[16];
        if (kt < ws) {
#pragma unroll
            for (int r = 0; r < 16; ++r) p[r] = acc[r];
        } else {
#pragma unroll
            for (int r = 0; r < 16; ++r) p[r] = (8 * hi + 16 * (r >> 3) + (r & 7) <= r32) ? acc[r] : 0.f;
        }
        bf16x8 pk0, pk1;
        { v4u t0, t1; t0.x = pk2(p[0], p[1]); t0.y = pk2(p[2], p[3]); t0.z = pk2(p[4], p[5]); t0.w = pk2(p[6], p[7]);
          t1.x = pk2(p[8], p[9]); t1.y = pk2(p[10], p[11]); t1.z = pk2(p[12], p[13]); t1.w = pk2(p[14], p[15]);
          pk0 = __builtin_bit_cast(bf16x8, t0); pk1 = __builtin_bit_cast(bf16x8, t1); }
#pragma unroll
        for (int nt = 0; nt < 4; ++nt) { O[nt] = __builtin_amdgcn_mfma_f32_32x32x16_bf16(pk0, vf[0][nt], O[nt], 0, 0, 0);
                                         O[nt] = __builtin_amdgcn_mfma_f32_32x32x16_bf16(pk1, vf[1][nt], O[nt], 0, 0, 0); }
    }
    ret_epilogue(F, O, rowb, h, gv);
}
__device__ __forceinline__ void ret_task(Frame& F, int task, const bf16* PROJ) {
    const int qb = 31 - (task & 31), h = (task >> 5) % 6, b = (task >> 5) / 6; const int r32 = F.lane & 31, hi = F.lane >> 5;
    const int row0 = b * SEQ + 64 * qb;
    const bf16* qrow[2] = {PROJ + (size_t)(row0 + r32) * RET_LD + RET_Q + h * 64, PROJ + (size_t)(row0 + 32 + r32) * RET_LD + RET_Q + h * 64};
    LAS bf16x8* ql = wave_q(F); stage_q<2>(ql, qrow, F.lane);
    KVp kv{PROJ + (size_t)(b * SEQ) * RET_LD + RET_K + h * 64, RET_LD, (const bf16*)F.out + ((size_t)b * 768 + h * 128) * SEQ, SEQ};
    f32x16 O[2][4]; float l[2]; zero_o<2, 4>(O, l);
    MaskArg ma{}; ma.q0[0] = 64 * qb; ma.q0[1] = 64 * qb + 32; const unsigned* mbr[2] = {nullptr, nullptr};
    ma.lg = __builtin_amdgcn_logf(1.0f - __builtin_amdgcn_exp2f(-5.0f - (float)h));
    attn_core<2, 4, RET_MODE, MK_CAUSAL, 1>(ql, kv, 0, 2 * qb + 2, 0.f, ma, mbr, O, l, F.lane);
#pragma unroll
    for (int s = 0; s < 2; ++s) { unsigned short gv[16][4]; ret_gates(F, row0 + 32 * s, h, PROJ, gv); ret_epilogue(F, O[s], row0 + 32 * s, h, gv); }
}

typedef _Float16 h2_t __attribute__((ext_vector_type(2)));
__device__ __forceinline__ unsigned pkh(float a, float b) { h2_t v = {(_Float16)a, (_Float16)b}; return __builtin_bit_cast(unsigned, v); }
__device__ __forceinline__ void dsa_d1_task(Frame& F, int task, const bf16* PROJ) {
    int b, qb, kc; task = __builtin_amdgcn_readfirstlane(task);
    if (task < 16 * 224) { b = task / 224; int rem = task % 224, grp = 7; while (rem >= 8 * grp) { rem -= 8 * grp; --grp; }
        qb = 8 * grp + 7 - rem / grp; kc = rem % grp; }
    else { const int p = task - 16 * 224, sz = 8 - (p >> 7), grp = p & 7; b = (p & 127) >> 3; qb = 8 * grp + sz - 1; kc = grp; }
    const int r32 = F.lane & 31, hi = F.lane >> 5; const int row = b * SEQ + 32 * qb + r32;
    const bf16* qp = PROJ + (size_t)row * DSA_LD + DSA_IQ + 8 * hi;
    bf16x8 qf[4][4]; LAS bf16x8* ql = wave_q(F); v4u wraw;
    { const int tpos = 32 * qb + r32; const float* tab = (const float*)(F.ws + WS_ROPE);
      v4u raw[8][4];
#pragma unroll
      for (int h = 0; h < 8; ++h)
#pragma unroll
          for (int ks = 0; ks < 4; ++ks) raw[h][ks] = *(const GAS v4u*)(qp + h * 64 + 16 * ks);
      wraw = *(const GAS v4u*)(PROJ + (size_t)row * DSA_LD + DSA_IW);
      __builtin_amdgcn_sched_barrier(0);
#pragma unroll
      for (int h = 0; h < 8; ++h) { float v[4][8];
#pragma unroll
          for (int ks = 0; ks < 4; ++ks) { v[ks][0] = bflo(raw[h][ks].x); v[ks][1] = bfhi(raw[h][ks].x); v[ks][2] = bflo(raw[h][ks].y); v[ks][3] = bfhi(raw[h][ks].y);
              v[ks][4] = bflo(raw[h][ks].z); v[ks][5] = bfhi(raw[h][ks].z); v[ks][6] = bflo(raw[h][ks].w); v[ks][7] = bfhi(raw[h][ks].w); }
          q32_xf(v, nullptr, true, tpos, 1.f, hi, tab);
#pragma unroll
          for (int ks = 0; ks < 4; ++ks) { const bf16x8 f = q32_pack(v[ks]); if (h < 4) qf[h & 3][ks] = f; else ql[((h & 3) * 4 + ks) * 64] = f; } } }
    LDS_WAIT(); asm volatile("" ::: "memory");
    float iw[8];
    { const v4u w = wraw; iw[0] = bflo(w.x); iw[1] = bfhi(w.x); iw[2] = bflo(w.y); iw[3] = bfhi(w.y); iw[4] = bflo(w.z); iw[5] = bfhi(w.z); iw[6] = bflo(w.w); iw[7] = bfhi(w.w); }
    const int kperm = (r32 & 0x13) | ((r32 & 4) << 1) | ((r32 & 8) >> 1);
    const bf16* kp = PROJ + (size_t)(b * SEQ + kperm) * DSA_LD + DSA_IK + 8 * hi;
    _Float16* sc = (_Float16*)(F.ws + WS_SC) + (size_t)row * SEQ + 8 * hi;
    const int kt1 = (8 * kc + 8 < qb + 1) ? 8 * kc + 8 : qb + 1;
    bf16x8 kf[4], kfn[4];
#pragma unroll
    for (int ks = 0; ks < 4; ++ks) kf[ks] = ld8(kp + (size_t)(32 * (8 * kc)) * DSA_LD + 16 * ks);
#pragma unroll 1
    for (int kt = 8 * kc; kt < kt1; ++kt) {
        { const int ktn = kt + 1 < kt1 ? kt + 1 : kt;
#pragma unroll
          for (int ks = 0; ks < 4; ++ks) kfn[ks] = ld8(kp + (size_t)(32 * ktn) * DSA_LD + 16 * ks); }
        float s[16];
#pragma unroll
        for (int r = 0; r < 16; ++r) s[r] = 0.f;
#pragma unroll
        for (int h = 0; h < 8; ++h) { f32x16 acc;
#pragma unroll
            for (int r = 0; r < 16; ++r) acc[r] = 0.f;
#pragma unroll
            for (int ks = 0; ks < 4; ++ks) acc = __builtin_amdgcn_mfma_f32_32x32x16_bf16(kf[ks], h < 4 ? qf[h & 3][ks] : ql[((h & 3) * 4 + ks) * 64], acc, 0, 0, 0);
#pragma unroll
            for (int r = 0; r < 16; ++r) s[r] += iw[h] * fmaxf(acc[r], 0.f);
            __builtin_amdgcn_sched_barrier(0); }
        v4u o0, o1; o0.x = pkh(s[0], s[1]); o0.y = pkh(s[2], s[3]); o0.z = pkh(s[4], s[5]); o0.w = pkh(s[6], s[7]);
        o1.x = pkh(s[8], s[9]); o1.y = pkh(s[10], s[11]); o1.z = pkh(s[12], s[13]); o1.w = pkh(s[14], s[15]);
        *(GAS v4u*)(sc + 32 * kt) = o0; *(GAS v4u*)(sc + 32 * kt + 16) = o1;
#pragma unroll
        for (int ks = 0; ks < 4; ++ks) kf[ks] = kfn[ks];
    }
}
__device__ __forceinline__ int hist_select(LAS unsigned* hist, const unsigned (&key)[32], bool lvl2, unsigned B, int target, int lane) {
    { unsigned z = 0u; asm volatile("" : "+v"(z));
#pragma unroll
      for (int j = 0; j < 8; ++j) *(LAS v4u*)(hist + 4 * (lane + 64 * j)) = (v4u){z, z, z, z}; }
    LDS_WAIT(); asm volatile("" ::: "memory");
    { LAS unsigned* hc = hist + (lane & 7);
#pragma unroll
      for (int e = 0; e < 32; ++e) { const unsigned d = lvl2 ? (key[e] & 255u) : (key[e] >> 8); const bool m = lvl2 ? ((key[e] >> 8) == B) : true;
          if (m) __hip_atomic_fetch_add(hc + 8 * d, 1u, __ATOMIC_RELAXED, __HIP_MEMORY_SCOPE_WAVEFRONT); } }
    LDS_WAIT(); asm volatile("" ::: "memory");
    v4u c;
    { const LAS v4u* hp = (const LAS v4u*)(hist + 32 * lane);
      const v4u a0 = hp[0], a1 = hp[1], a2 = hp[2], a3 = hp[3], a4 = hp[4], a5 = hp[5], a6 = hp[6], a7 = hp[7];
      c.x = (a0.x + a0.y) + (a0.z + a0.w) + (a1.x + a1.y) + (a1.z + a1.w); c.y = (a2.x + a2.y) + (a2.z + a2.w) + (a3.x + a3.y) + (a3.z + a3.w);
      c.z = (a4.x + a4.y) + (a4.z + a4.w) + (a5.x + a5.y) + (a5.z + a5.w); c.w = (a6.x + a6.y) + (a6.z + a6.w) + (a7.x + a7.y) + (a7.z + a7.w); }
    const int s = (int)(c.x + c.y + c.z + c.w);
    int S = s;
#pragma unroll
    for (int o = 1; o < 64; o <<= 1) { const int v = __shfl_down(S, o); if (lane + o < 64) S += v; }
    const unsigned long long bm = __ballot(S >= target);
    const int Ls = 63 - __clzll(bm);
    int a = S - s, dig, abv;
    if (a + (int)c.w >= target) { dig = 3; abv = a; } else { a += (int)c.w;
        if (a + (int)c.z >= target) { dig = 2; abv = a; } else { a += (int)c.z;
            if (a + (int)c.y >= target) { dig = 1; abv = a; } else { a += (int)c.y; dig = 0; abv = a; } } }
    const int packed = ((4 * lane + dig) << 12) | abv;
    const int r = __shfl(packed, Ls);
    LDS_WAIT(); asm volatile("" ::: "memory");
    return r;
}
__device__ __forceinline__ void d2_load(Frame& F, int row, v4u (&raw)[4]) {
    const int t = row % SEQ, lane = F.lane;
    const unsigned short* sp = (const unsigned short*)(F.ws + WS_SC) + (size_t)row * SEQ + (32 * lane <= t ? 32 * lane : 0);
#pragma unroll
    for (int i = 0; i < 4; ++i) raw[i] = *(const GAS v4u*)(sp + 8 * i);
}
__device__ __forceinline__ void dsa_d2_row(Frame& F, int row, const v4u (&raw)[4]) {
    const int t = row % SEQ, lane = F.lane;
    unsigned* mbp = (unsigned*)(F.ws + WS_MB) + (size_t)row * 64;
    int nvalid = t + 1 - 32 * lane; nvalid = nvalid < 0 ? 0 : (nvalid > 32 ? 32 : nvalid);
    const unsigned cb = nvalid == 32 ? 0xffffffffu : ((1u << nvalid) - 1u);
    if (t < 256) { mbp[lane] = cb; return; }
    unsigned key[32];
#pragma unroll
    for (int i = 0; i < 4; ++i) { const unsigned w[4] = {raw[i].x, raw[i].y, raw[i].z, raw[i].w};
#pragma unroll
        for (int j = 0; j < 4; ++j) {
#pragma unroll
            for (int k = 0; k < 2; ++k) { const int e = 8 * i + 2 * j + k; const unsigned u = (w[j] >> (16 * k)) & 0xffffu;
                const unsigned sk = (u & 0x8000u) ? (~u & 0xffffu) : (u | 0x8000u);
                key[e] = (e < nvalid) ? sk : 0u; } } }
    LAS unsigned* hist = (LAS unsigned*)(F.lds + F.wave * 16384);
    const int d1 = hist_select(hist, key, false, 0u, 256, lane);
    const unsigned Bh = (unsigned)d1 >> 12; const int above1 = d1 & 0xfff;
    const int d2 = hist_select(hist, key, true, Bh, 256 - above1, lane);
    const unsigned T = (Bh << 8) | ((unsigned)d2 >> 12);
    const int cgt = above1 + (d2 & 0xfff);
    unsigned g = 0, eq = 0;
#pragma unroll
    for (int e = 0; e < 32; ++e) { unsigned bg = key[e] > T ? 1u : 0u, be = key[e] == T ? 1u : 0u; asm volatile("" : "+v"(bg), "+v"(be));
        g |= bg << e; eq |= be << e; }
    const int need = 256 - cgt; const int myeq = __popc(eq);
    int incl = myeq;
#pragma unroll
    for (int o = 1; o < 64; o <<= 1) { const int v = __shfl_up(incl, o); if (lane >= o) incl += v; }
    const int pre = incl - myeq; int take = need - pre; take = take < 0 ? 0 : (take > myeq ? myeq : take);
    unsigned te = eq; int cnt = myeq;
    while (cnt > take) { te &= ~(1u << (31 - __clz(te))); --cnt; }
    mbp[lane] = (g | te) & cb;
}
__device__ __forceinline__ int wave_incl_scan(int v) {
    v += __builtin_amdgcn_update_dpp(0, v, 0x111, 0xf, 0xf, false);
    v += __builtin_amdgcn_update_dpp(0, v, 0x112, 0xf, 0xf, false);
    v += __builtin_amdgcn_update_dpp(0, v, 0x114, 0xf, 0xf, false);
    v += __builtin_amdgcn_update_dpp(0, v, 0x118, 0xf, 0xf, false);
    v += __builtin_amdgcn_update_dpp(0, v, 0x142, 0xa, 0xf, false);
    v += __builtin_amdgcn_update_dpp(0, v, 0x143, 0xc, 0xf, false);
    return v;
}
__device__ __forceinline__ void hist_select2(LAS unsigned* h0, LAS unsigned* h1, const unsigned (&key)[2][32], bool lvl2, const unsigned (&B)[2], const int (&target)[2], int lane, int (&res)[2]) {
    { unsigned z = 0u; asm volatile("" : "+v"(z));
#pragma unroll
      for (int j = 0; j < 8; ++j) { *(LAS v4u*)(h0 + 4 * (lane + 64 * j)) = (v4u){z, z, z, z}; *(LAS v4u*)(h1 + 4 * (lane + 64 * j)) = (v4u){z, z, z, z}; } }
    LDS_WAIT(); asm volatile("" ::: "memory");
#pragma unroll
    for (int w = 0; w < 2; ++w) { LAS unsigned* hc = (w ? h1 : h0) + (lane & 7);
#pragma unroll
      for (int e = 0; e < 32; ++e) { const unsigned d = lvl2 ? (key[w][e] & 255u) : (key[w][e] >> 8); const bool m = lvl2 ? ((key[w][e] >> 8) == B[w]) : true;
          if (m) __hip_atomic_fetch_add(hc + 8 * d, 1u, __ATOMIC_RELAXED, __HIP_MEMORY_SCOPE_WAVEFRONT); } }
    LDS_WAIT(); asm volatile("" ::: "memory");
    v4u c[2];
#pragma unroll
    for (int w = 0; w < 2; ++w) { const LAS v4u* hp = (const LAS v4u*)((w ? h1 : h0) + 32 * lane);
      const v4u a0 = hp[0], a1 = hp[1], a2 = hp[2], a3 = hp[3], a4 = hp[4], a5 = hp[5], a6 = hp[6], a7 = hp[7];
      c[w].x = (a0.x + a0.y) + (a0.z + a0.w) + (a1.x + a1.y) + (a1.z + a1.w); c[w].y = (a2.x + a2.y) + (a2.z + a2.w) + (a3.x + a3.y) + (a3.z + a3.w);
      c[w].z = (a4.x + a4.y) + (a4.z + a4.w) + (a5.x + a5.y) + (a5.z + a5.w); c[w].w = (a6.x + a6.y) + (a6.z + a6.w) + (a7.x + a7.y) + (a7.z + a7.w); }
    int sv[2], S[2];
#pragma unroll
    for (int w = 0; w < 2; ++w) { sv[w] = (int)(c[w].x + c[w].y + c[w].z + c[w].w); S[w] = sv[w]; }
#pragma unroll
    for (int w = 0; w < 2; ++w) { const int inc = wave_incl_scan(sv[w]); S[w] = __builtin_amdgcn_readlane(inc, 63) - inc + sv[w]; }
    int packed[2], Ls[2];
#pragma unroll
    for (int w = 0; w < 2; ++w) {
        const unsigned long long bm = __ballot(S[w] >= target[w]);
        Ls[w] = 63 - __clzll(bm);
        int a = S[w] - sv[w], dig, abv;
        if (a + (int)c[w].w >= target[w]) { dig = 3; abv = a; } else { a += (int)c[w].w;
            if (a + (int)c[w].z >= target[w]) { dig = 2; abv = a; } else { a += (int)c[w].z;
                if (a + (int)c[w].y >= target[w]) { dig = 1; abv = a; } else { a += (int)c[w].y; dig = 0; abv = a; } } }
        packed[w] = ((4 * lane + dig) << 12) | abv; }
    res[0] = __builtin_amdgcn_readlane(packed[0], Ls[0]); res[1] = __builtin_amdgcn_readlane(packed[1], Ls[1]);
    LDS_WAIT(); asm volatile("" ::: "memory");
}
__device__ __forceinline__ void dsa_d2_row2(Frame& F, int rowA, int rowB, const v4u (&rawA)[4], const v4u (&rawB)[4]) {
    const int lane = F.lane; const int row[2] = {rowA, rowB};
    unsigned* mbp[2]; unsigned cb[2]; int nvalid[2];
#pragma unroll
    for (int w = 0; w < 2; ++w) { const int t = row[w] % SEQ; mbp[w] = (unsigned*)(F.ws + WS_MB) + (size_t)row[w] * 64;
        int nv = t + 1 - 32 * lane; nv = nv < 0 ? 0 : (nv > 32 ? 32 : nv); nvalid[w] = nv; cb[w] = nv == 32 ? 0xffffffffu : ((1u << nv) - 1u); }
    if (rowA % SEQ < 256) { *(GAS unsigned*)(mbp[0] + lane) = cb[0]; *(GAS unsigned*)(mbp[1] + lane) = cb[1]; return; }
    unsigned key[2][32];
#pragma unroll
    for (int w = 0; w < 2; ++w)
#pragma unroll
      for (int i = 0; i < 4; ++i) { const v4u rw = w ? rawB[i] : rawA[i]; const unsigned ww[4] = {rw.x, rw.y, rw.z, rw.w};
#pragma unroll
        for (int j = 0; j < 4; ++j) {
#pragma unroll
            for (int k = 0; k < 2; ++k) { const int e = 8 * i + 2 * j + k; const unsigned u = (ww[j] >> (16 * k)) & 0xffffu;
                const unsigned sk = (u & 0x8000u) ? (~u & 0xffffu) : (u | 0x8000u);
                key[w][e] = (e < nvalid[w]) ? sk : 0u; } } }
    LAS unsigned* h0 = (LAS unsigned*)(F.lds + F.wave * 16384); LAS unsigned* h1 = h0 + 2048;
    int d1[2], d2[2]; { const unsigned B0[2] = {0u, 0u}; const int tg[2] = {256, 256}; hist_select2(h0, h1, key, false, B0, tg, lane, d1); }
    unsigned Bh[2]; int above1[2], tg2[2];
#pragma unroll
    for (int w = 0; w < 2; ++w) { Bh[w] = (unsigned)d1[w] >> 12; above1[w] = d1[w] & 0xfff; tg2[w] = 256 - above1[w]; }
    hist_select2(h0, h1, key, true, Bh, tg2, lane, d2);
    unsigned g[2], eq[2]; int need[2], myeq[2], incl[2];
#pragma unroll
    for (int w = 0; w < 2; ++w) { const unsigned T = (Bh[w] << 8) | ((unsigned)d2[w] >> 12); const int cgt = above1[w] + (d2[w] & 0xfff);
        unsigned gg = 0, ee = 0;
#pragma unroll
        for (int e = 0; e < 32; ++e) { unsigned bg = key[w][e] > T ? 1u : 0u, be = key[w][e] == T ? 1u : 0u; asm volatile("" : "+v"(bg), "+v"(be)); gg |= bg << e; ee |= be << e; }
        g[w] = gg; eq[w] = ee; need[w] = 256 - cgt; myeq[w] = __popc(ee); incl[w] = myeq[w]; }
    incl[0] = wave_incl_scan(incl[0]); incl[1] = wave_incl_scan(incl[1]);
#pragma unroll
    for (int w = 0; w < 2; ++w) { const int pre = incl[w] - myeq[w]; int take = need[w] - pre; take = take < 0 ? 0 : (take > myeq[w] ? myeq[w] : take);
        unsigned te = eq[w]; int cnt = myeq[w];
        while (cnt > take) { te &= ~(1u << (31 - __clz(te))); --cnt; }
        *(GAS unsigned*)(mbp[w] + lane) = (g[w] | te) & cb[w]; }
}
__device__ __forceinline__ void dsa_d3_task(Frame& F, int task, const bf16* PROJ) {
    const int hg = task & 3, qb = 63 - ((task >> 2) & 63), b = task >> 8; const int r32 = F.lane & 31;
    const int row0 = b * SEQ + 32 * qb;
    const bf16* qrow[3]; const unsigned* mbr[3];
#pragma unroll
    for (int s = 0; s < 3; ++s) { qrow[s] = PROJ + (size_t)(row0 + r32) * DSA_LD + DSA_Q + (3 * hg + s) * 64; mbr[s] = (const unsigned*)(F.ws + WS_MB) + (size_t)(row0 + r32) * 64; }
    LAS bf16x8* ql = wave_q(F); stage_q<3>(ql, qrow, F.lane);
    KVp kv{PROJ + (size_t)(b * SEQ) * DSA_LD + DSA_K, DSA_LD, (const bf16*)F.out + (size_t)b * 64 * SEQ, SEQ};
    f32x16 O[3][2]; float l[3]; zero_o<3, 2>(O, l);
    MaskArg ma{}; ma.q0[0] = ma.q0[1] = ma.q0[2] = 32 * qb;
    const float negb = 0.f;
    attn_core<3, 2, 0, MK_BITS, 2>(ql, kv, 0, qb + 1, negb, ma, mbr, O, l, F.lane);
    bf16* Y = (bf16*)(F.ws + WS_Y);
#pragma unroll
    for (int s = 0; s < 3; ++s) { const float lt = l[s] + __shfl_xor(l[s], 32); store_o<2, false>(O[s], (DBG_ZERO & 2) ? 0.f : 1.f / lt, Y, row0, (3 * hg + s) * 64, F.lane); }
}

constexpr unsigned D3_MOFF = 98304u, D3_ROFF = 98304u + 64u * 65u * 4u;
__device__ __forceinline__ void dsa_d3_wg_task(Frame& F, int task, const bf16* PROJ) {
    const int qb = 31 - (task >> 4), b = task & 15, w = F.wave, qs = w >> 2, hg = w & 3; const int r32 = F.lane & 31, hi = F.lane >> 5;
    const int row0 = b * SEQ + 64 * qb + 32 * qs;
    const bf16* qrow[3];
#pragma unroll
    for (int s = 0; s < 3; ++s) qrow[s] = PROJ + (size_t)(row0 + r32) * DSA_LD + DSA_Q + (3 * hg + s) * 64;
    LAS bf16x8* ql = (LAS bf16x8*)(F.lds + w * 12288) + F.lane; { const int tq_ = 64 * qb + 32 * qs + r32; const int tp[3] = {tq_, tq_, tq_}; stage_q_xf<3>(F, ql, qrow, tp, F.ka->in[14], true, QSCALE); }
    { const unsigned* mb = (const unsigned*)(F.ws + WS_MB) + (size_t)(b * SEQ + 64 * qb) * 64; LAS unsigned* ml = (LAS unsigned*)(F.lds + D3_MOFF);
#pragma unroll
      for (int j = 0; j < 2; ++j) { const int e = (F.tid + 512 * j) * 4, row = e >> 6, col = e & 63; const v4u m = *(const GAS v4u*)(mb + e);
          ml[row * 65 + col] = m.x; ml[row * 65 + col + 1] = m.y; ml[row * 65 + col + 2] = m.z; ml[row * 65 + col + 3] = m.w; } }
    asm volatile("s_waitcnt vmcnt(0) lgkmcnt(0)\n\ts_barrier" ::: "memory");
    const int kperm = (r32 & 0x13) | ((r32 & 4) << 1) | ((r32 & 8) >> 1);
    const bf16* psrc; int pstep;
    if (w < 4) { psrc = PROJ + (size_t)(b * SEQ + kperm) * DSA_LD + DSA_K + 16 * w + 8 * hi; pstep = 32 * DSA_LD; }
    else { const int j = w - 4; psrc = (const bf16*)F.out + ((size_t)b * 64 + 32 * (j >> 1) + r32) * SEQ + 16 * (j & 1) + 8 * hi; pstep = 32; }
    f32x16 O[3][2]; float l[3]; zero_o<3, 2>(O, l);
    MaskArg ma{}; ma.q0[0] = ma.q0[1] = ma.q0[2] = 64 * qb + 32 * qs;
    const LAS unsigned* mlds = (const LAS unsigned*)(F.lds + D3_MOFF) + (qs * 32 + r32) * 65;
    wg_attn<3, MK_BITS, 3>(F, ql, psrc, pstep, D3_ROFF, 0, 2 * qb + 2, 0xffffffffu, 0, 2 * qb + qs + 1, ma, mlds, O, l);
    bf16* Y = (bf16*)(F.ws + WS_Y);
#pragma unroll
    for (int s = 0; s < 3; ++s) { const float lt = l[s] + __shfl_xor(l[s], 32); store_o<2, false>(O[s], (DBG_ZERO & 2) ? 0.f : 1.f / lt, Y, row0, (3 * hg + s) * 64, F.lane); }
}

__device__ __forceinline__ void nsa_cmp_task(Frame& F, int task, int chunk, const bf16* PROJ, const float* kn0) {
    const int nb = task & 3, g = (task >> 2) & 3, b = task >> 4; const int r32 = F.lane & 31, hi = F.lane >> 5;
    const int n = 32 * nb + r32, nc = n > 126 ? 126 : n;
    const bf16* arow = PROJ + (size_t)(b * SEQ + 16 * nc) * NSA_LD + 64 * g + 8 * hi;
    const bf16* WkT = (const bf16*)(F.ws + WS_CMPW); const bf16* WvT = WkT + 64 * 2048;
    const bf16* wkp = WkT + (size_t)r32 * 2048 + 8 * hi; const bf16* wvp = WvT + (size_t)r32 * 2048 + 8 * hi;
    f32x16 Dk[2], Dv[2];
#pragma unroll
    for (int et = 0; et < 2; ++et)
#pragma unroll
        for (int r = 0; r < 16; ++r) { Dk[et][r] = 0.f; Dv[et][r] = 0.f; }
#pragma unroll 4
    for (int kk = 32 * chunk; kk < 32 * chunk + 32; ++kk) {
        const bf16* ap = arow + (size_t)(kk >> 2) * NSA_LD + 16 * (kk & 3);
        const bf16x8 kcf = ld8(ap + NSA_KC), vcf = ld8(ap + NSA_VC);
#pragma unroll
        for (int et = 0; et < 2; ++et) { const bf16x8 wk = ld8(wkp + (size_t)(32 * et) * 2048 + 16 * kk), wv = ld8(wvp + (size_t)(32 * et) * 2048 + 16 * kk);
            Dk[et] = __builtin_amdgcn_mfma_f32_32x32x16_bf16(wk, kcf, Dk[et], 0, 0, 0);
            Dv[et] = __builtin_amdgcn_mfma_f32_32x32x16_bf16(vcf, wv, Dv[et], 0, 0, 0); }
    }
    { LAS f32x4* pl = (LAS f32x4*)(F.lds + F.wave * 16384) + F.lane;
      if (chunk != 0) {
#pragma unroll
          for (int et = 0; et < 2; ++et)
#pragma unroll
              for (int c = 0; c < 4; ++c) { pl[(et * 4 + c) * 64] = (f32x4){Dk[et][4 * c], Dk[et][4 * c + 1], Dk[et][4 * c + 2], Dk[et][4 * c + 3]};
                                            pl[(8 + et * 4 + c) * 64] = (f32x4){Dv[et][4 * c], Dv[et][4 * c + 1], Dv[et][4 * c + 2], Dv[et][4 * c + 3]}; } }
      asm volatile("s_waitcnt vmcnt(0) lgkmcnt(0)\n\ts_barrier" ::: "memory");
      if (chunk != 0) return;
#pragma unroll 1
      for (int o = 1; o < 4; ++o) { const LAS f32x4* ql_ = pl + o * (16384 / 16);
#pragma unroll
          for (int et = 0; et < 2; ++et)
#pragma unroll
              for (int c = 0; c < 4; ++c) { const f32x4 a = ql_[(et * 4 + c) * 64], d = ql_[(8 + et * 4 + c) * 64];
#pragma unroll
                  for (int i = 0; i < 4; ++i) { Dk[et][4 * c + i] += a[i]; Dv[et][4 * c + i] += d[i]; } } } }
    const float* ck = (const float*)(F.ws + WS_CTL) + CW_CK; const float* cv = ck + 64;
    const float* tab = (const float*)(F.ws + WS_ROPE) + (size_t)(16 * nc + 31) * 64;
    float ss = 0.f;
#pragma unroll
    for (int et = 0; et < 2; ++et)
#pragma unroll
        for (int r = 0; r < 16; ++r) { Dk[et][r] += ck[32 * et + crow(r, hi)]; ss += Dk[et][r] * Dk[et][r]; }
    ss += __shfl_xor(ss, 32);
    const float rs = __builtin_amdgcn_rsqf(ss * (1.f / 64.f) + EPS);
    bf16* kout = (bf16*)(F.ws + WS_KCMP) + ((size_t)((b * 4 + g) * 128 + n)) * 64;
#pragma unroll
    for (int rq = 0; rq < 4; ++rq) { float o0[4], o1[4];
#pragma unroll
        for (int i = 0; i < 4; ++i) { const int r = 4 * rq + i, idx = crow(r, hi); const float v0 = Dk[0][r] * rs * kn0[idx], v1 = Dk[1][r] * rs * kn0[32 + idx];
            const float c = tab[idx], s = tab[32 + idx]; o0[i] = v0 * c - v1 * s; o1[i] = v1 * c + v0 * s; if (n > 126) { o0[i] = 0.f; o1[i] = 0.f; } }
        v2u w0, w1; w0.x = pk2(o0[0], o0[1]); w0.y = pk2(o0[2], o0[3]); w1.x = pk2(o1[0], o1[1]); w1.y = pk2(o1[2], o1[3]);
        *(GAS v2u*)(kout + 8 * rq + 4 * hi) = w0; *(GAS v2u*)(kout + 32 + 8 * rq + 4 * hi) = w1; }
    bf16* vout = (bf16*)(F.ws + WS_VCMPT) + ((size_t)((b * 4 + g) * 64)) * 128 + 32 * nb;
#pragma unroll
    for (int et = 0; et < 2; ++et) { const float cve = cv[32 * et + r32];
#pragma unroll
        for (int rq = 0; rq < 4; ++rq) { float o[4];
#pragma unroll
            for (int i = 0; i < 4; ++i) { const int nl = 8 * rq + 4 * hi + i; o[i] = (32 * nb + nl > 126) ? 0.f : Dv[et][4 * rq + i] + cve; }
            v2u w; w.x = pk2(o[0], o[1]); w.y = pk2(o[2], o[3]);
            *(GAS v2u*)(vout + (size_t)(32 * et + r32) * 128 + 8 * rq + 4 * hi) = w; } }
}
constexpr unsigned NSA_ROFF = 98304u;
template <bool WG>
__device__ NSA_INLINE void nsa_task(KArgs ka_, unsigned char* ws_, float* out_, LAS unsigned char* lds_, int wave_, int task, const bf16* PROJ) {
    Frame F; F.ka = ka_; F.ws = ws_; F.out = out_; F.lds = lds_; F.wave = wave_; F.MISC = (volatile LAS unsigned*)(lds_ + LDS_CTRL + 64);
    asm volatile("v_mbcnt_lo_u32_b32 %0, -1, 0\n\tv_mbcnt_hi_u32_b32 %0, -1, %0" : "=v"(F.lane));
    const int qb8 = 7 - (task >> 6);
    const int g = task & 3, qb = WG ? 8 * qb8 + wave_ : 63 - ((task >> 2) & 63), b = WG ? (task >> 2) & 15 : task >> 8; const int r32 = F.lane & 31, hi = F.lane >> 5;
    const int row0 = b * SEQ + 32 * qb, tq = 32 * qb + r32;
    const bf16* qrow[3];
#pragma unroll
    for (int s = 0; s < 3; ++s) qrow[s] = PROJ + (size_t)(row0 + r32) * NSA_LD + NSA_Q + (3 * g + s) * 64;
    LAS bf16x8* ql = WG ? (LAS bf16x8*)(F.lds + F.wave * 12288) + F.lane : wave_q(F); { const int tp[3] = {tq, tq, tq}; stage_q_xf<3>(F, ql, qrow, tp, F.ka->in[17], true, QSCALE); }
#define NSA_GLOAD(c_, dst_) do { const GAS bf16* gp_ = (const GAS bf16*)PROJ + (size_t)(row0 + r32) * NSA_LD + NSA_GT + 9 * g + (c_); dst_[0] = gp_[0]; dst_[1] = gp_[3]; dst_[2] = gp_[6]; } while (0)
#define NSA_GATE(s_, c_) NSA_SIG(PROJ[(size_t)(row0 + r32) * NSA_LD + NSA_GT + 9 * g + 3 * (s_) + (c_)])
#define NSA_SIG(raw_) (__builtin_amdgcn_rcpf(1.f + fast_exp2(-1.4426950408889634f * bf2f(raw_))))
    bf16* Y = (bf16*)(F.ws + WS_Y);
    MaskArg ma{}; ma.q0[0] = ma.q0[1] = ma.q0[2] = 32 * qb; ma.nmax = tq >= 31 ? (tq - 31) >> 4 : -1;
    const KVp kvc{(const bf16*)(F.ws + WS_KCMP) + (size_t)((b * 4 + g) * 128) * 64, 64, (const bf16*)(F.ws + WS_VCMPT) + (size_t)((b * 4 + g) * 64) * 128, 128};
    float imp[16];
#pragma unroll
    for (int r = 0; r < 16; ++r) imp[r] = 0.f;
    {
        const int kperm = (r32 & 0x13) | ((r32 & 4) << 1) | ((r32 & 8) >> 1);
        { const int kt = F.wave >> 1; const unsigned dst = (unsigned)(uintptr_t)F.lds + NSA_ROFF + (unsigned)kt * 8192u + (unsigned)(F.wave & 1) * 4096u;
          if ((F.wave & 1) == 0) { const bf16* kp = kvc.K + (size_t)(32 * kt + kperm) * 64 + 8 * hi;
#pragma unroll
              for (int ks = 0; ks < 4; ++ks) glds16(kp + 16 * ks, (unsigned)__builtin_amdgcn_readfirstlane(dst + ks * 1024u)); }
          else { const bf16* vp = kvc.VT + (size_t)r32 * 128 + 32 * kt + 8 * hi;
#pragma unroll
              for (int j = 0; j < 4; ++j) glds16(vp + (size_t)(32 * (j >> 1)) * 128 + 16 * (j & 1), (unsigned)__builtin_amdgcn_readfirstlane(dst + j * 1024u)); } }
        unsigned short g0r[3]; NSA_GLOAD(0, g0r);
        asm volatile("s_waitcnt vmcnt(0)\n\ts_barrier" ::: "memory");
#pragma unroll 1
        for (int s = 0; s < 3; ++s) { f32x16 ia, Oc[2]; float ls = 0.f;
#pragma unroll
            for (int r = 0; r < 16; ++r) { ia[r] = 0.f; Oc[0][r] = 0.f; Oc[1][r] = 0.f; }
            bf16x8 qq[4];
#pragma unroll
            for (int ks = 0; ks < 4; ++ks) qq[ks] = ql[(s * 4 + ks) * 64];
#pragma unroll 1
            for (int kt = 0; kt < 4; ++kt) {
                const LAS bf16x8* sp = (const LAS bf16x8*)(F.lds + NSA_ROFF + kt * 8192) + F.lane;
                bf16x8 kf[4], vf[2][2];
#pragma unroll
                for (int ks = 0; ks < 4; ++ks) kf[ks] = sp[ks * 64];
#pragma unroll
                for (int nt = 0; nt < 2; ++nt) { vf[0][nt] = sp[(4 + 2 * nt) * 64]; vf[1][nt] = sp[(5 + 2 * nt) * 64]; }
                f32x16 acc;
#pragma unroll
                for (int r = 0; r < 16; ++r) acc[r] = 0.f;
#pragma unroll
                for (int ks = 0; ks < 4; ++ks) acc = __builtin_amdgcn_mfma_f32_32x32x16_bf16(kf[ks], qq[ks], acc, 0, 0, 0);
                float p[16];
#pragma unroll
                for (int r = 0; r < 16; ++r) { const int key = 32 * kt + 8 * hi + 16 * (r >> 3) + (r & 7); p[r] = key <= ma.nmax ? fast_exp2(acc[r]) : 0.f; ls += p[r]; }
#pragma unroll
                for (int ks2 = 0; ks2 < 2; ++ks2) { v4u pw, cw; unsigned short cvv[8];
                    pw.x = pk2(p[8 * ks2], p[8 * ks2 + 1]); pw.y = pk2(p[8 * ks2 + 2], p[8 * ks2 + 3]); pw.z = pk2(p[8 * ks2 + 4], p[8 * ks2 + 5]); pw.w = pk2(p[8 * ks2 + 6], p[8 * ks2 + 7]);
                    unsigned one_ = 0x3f80u; asm volatile("" : "+v"(one_));
#pragma unroll
                    for (int jj = 0; jj < 8; ++jj) { const int nn = 32 * kt + 16 * ks2 + 8 * hi + jj; cvv[jj] = (nn >= 4 * r32 - 1 && nn <= 4 * r32 + 3) ? (unsigned short)one_ : (unsigned short)0; }
                    cw.x = cvv[0] | (cvv[1] << 16); cw.y = cvv[2] | (cvv[3] << 16); cw.z = cvv[4] | (cvv[5] << 16); cw.w = cvv[6] | (cvv[7] << 16);
                    const bf16x8 pf = __builtin_bit_cast(bf16x8, pw);
                    ia = __builtin_amdgcn_mfma_f32_32x32x16_bf16(__builtin_bit_cast(bf16x8, cw), pf, ia, 0, 0, 0);
                    Oc[0] = __builtin_amdgcn_mfma_f32_32x32x16_bf16(pf, vf[ks2][0], Oc[0], 0, 0, 0);
                    Oc[1] = __builtin_amdgcn_mfma_f32_32x32x16_bf16(pf, vf[ks2][1], Oc[1], 0, 0, 0); }
            }
            const float lt = ls + __shfl_xor(ls, 32); const float inv = lt > 0.f ? 1.f / lt : 0.f;
#pragma unroll
            for (int r = 0; r < 16; ++r) imp[r] += ia[r] * inv;
            store_o<2, false>(Oc, (DBG_ZERO & 4) ? 0.f : NSA_SIG(s == 0 ? g0r[0] : (s == 1 ? g0r[1] : g0r[2])) * inv, Y, row0, (3 * g + s) * 64, F.lane);
        }
    }
    unsigned sel;
    { const int qblk = tq >> 6;
      if (32 * qb + 31 < 1024) sel = (2u << qblk) - 1u;
      else { float val[16], oth[16];
#pragma unroll
        for (int r = 0; r < 16; ++r) { const int j = crow(r, hi); val[r] = j > qblk ? -1e30f : ((j == 0 || j == qblk || j == qblk - 1) ? 1e9f : imp[r]); oth[r] = __shfl_xor(val[r], 32); }
        unsigned mine = 0;
#pragma unroll
        for (int r = 0; r < 16; ++r) { const int j = crow(r, hi); int rank = 0;
#pragma unroll
            for (int r2 = 0; r2 < 16; ++r2) { const int j2 = crow(r2, hi), j3 = crow(r2, hi ^ 1);
                rank += (val[r2] > val[r] || (val[r2] == val[r] && j2 < j)) ? 1 : 0;
                rank += (oth[r2] > val[r] || (oth[r2] == val[r] && j3 < j)) ? 1 : 0; }
            mine |= ((rank < 16 && j <= qblk) ? 1u : 0u) << ((r & 3) + 8 * (r >> 2)); }
        mine <<= 4 * hi;
        sel = mine | __shfl_xor(mine, 32); } }
    const unsigned* mbr2[2] = {nullptr, nullptr}; const unsigned* mbr1[1] = {nullptr};
    const KVp kvs{PROJ + (size_t)(b * SEQ) * NSA_LD + NSA_KS + 64 * g, NSA_LD, (const bf16*)F.out + ((size_t)b * 256 + 64 * g) * SEQ, SEQ};
    const KVp kvw{PROJ + (size_t)(b * SEQ) * NSA_LD + NSA_KW + 64 * g, NSA_LD, (const bf16*)F.out + (size_t)NB * 256 * SEQ + ((size_t)b * 256 + 64 * g) * SEQ, SEQ};
    ma.sel = sel;
#define NSA_BRANCH(MT_, KV_, KT0_, KT1_, C_, ADD_, ZBIT_) do { \
      { f32x16 O2[2][2]; float l2[2]; zero_o<2, 2>(O2, l2); attn_core<2, 2, 0, MT_>(ql, KV_, KT0_, KT1_, 0.f, ma, mbr2, O2, l2, F.lane); VM_WAIT(); \
        _Pragma("unroll") for (int s = 0; s < 2; ++s) { const float lt = l2[s] + __shfl_xor(l2[s], 32); \
          store_o<2, ADD_>(O2[s], (lt > 0.f && !(DBG_ZERO & ZBIT_)) ? NSA_GATE(s, C_) / lt : 0.f, Y, row0, (3 * g + s) * 64, F.lane); } } \
      { f32x16 O1[1][2]; float l1[1]; zero_o<1, 2>(O1, l1); attn_core<1, 2, 0, MT_>(ql + 2 * 4 * 64, KV_, KT0_, KT1_, 0.f, ma, mbr1, O1, l1, F.lane); VM_WAIT(); \
        const float lt = l1[0] + __shfl_xor(l1[0], 32); \
        store_o<2, ADD_>(O1[0], (lt > 0.f && !(DBG_ZERO & ZBIT_)) ? NSA_GATE(2, C_) / lt : 0.f, Y, row0, (3 * g + 2) * 64, F.lane); } } while (0)
    if (!WG) {
    NSA_BRANCH(MK_SLC, kvs, 0, qb + 1, 1, true, 16);
    NSA_BRANCH(MK_WIN, kvw, (qb > 16 ? qb - 16 : 0), qb + 1, 2, true, 32);
    } else {
        unsigned wsel = sel;
#pragma unroll
        for (int o = 1; o < 32; o <<= 1) wsel |= __shfl_xor(wsel, o);
        if (F.lane == 0) __hip_atomic_fetch_or((LAS unsigned*)(F.lds + LDS_CTRL + 64) + 17, wsel, __ATOMIC_RELAXED, __HIP_MEMORY_SCOPE_WORKGROUP);
        asm volatile("s_waitcnt vmcnt(0) lgkmcnt(0)\n\ts_barrier" ::: "memory");
        const unsigned blk = (unsigned)__builtin_amdgcn_readfirstlane((int)F.MISC[17]);
        const int kperm = (r32 & 0x13) | ((r32 & 4) << 1) | ((r32 & 8) >> 1), w = F.wave;
#define NSA_WGBRANCH(MT_, KCOL_, VTOFF_, KT0_, KT1_, MY0_, MY1_, BLK_, C_, ZBIT_) do { \
        const bf16* psrc; int pstep; \
        if (w < 4) { psrc = PROJ + (size_t)(b * SEQ + kperm) * NSA_LD + (KCOL_) + 64 * g + 16 * w + 8 * hi; pstep = 32 * NSA_LD; } \
        else { const int j_ = w - 4; psrc = (const bf16*)F.out + (VTOFF_) + ((size_t)b * 256 + 64 * g + 32 * (j_ >> 1) + r32) * SEQ + 16 * (j_ & 1) + 8 * hi; pstep = 32; } \
        f32x16 O3[3][2]; float l3[3]; zero_o<3, 2>(O3, l3); \
        wg_attn2<3, MT_>(F, ql, psrc, pstep, NSA_ROFF, KT0_, KT1_, BLK_, MY0_, MY1_, ma, O3, l3); \
        unsigned short gr_[3]; NSA_GLOAD(C_, gr_); \
        _Pragma("unroll") for (int s = 0; s < 3; ++s) { const float lt = l3[s] + __shfl_xor(l3[s], 32); \
          store_o<2, true>(O3[s], (lt > 0.f && !(DBG_ZERO & ZBIT_)) ? NSA_SIG(gr_[s]) / lt : 0.f, Y, row0, (3 * g + s) * 64, F.lane); } } while (0)
        NSA_WGBRANCH(MK_SLC, NSA_KS, (size_t)0, 0, 8 * qb8 + 8, 0, qb + 1, blk, 1, 16);
        NSA_WGBRANCH(MK_WIN, NSA_KW, (size_t)NB * 256 * SEQ, (8 * qb8 > 16 ? 8 * qb8 - 16 : 0), 8 * qb8 + 8, (qb > 16 ? qb - 16 : 0), qb + 1, 0xffffffffu, 2, 32);
#undef NSA_WGBRANCH
    }
#undef NSA_BRANCH
}
__device__ __forceinline__ void prologue_misc(Frame& F) {
    float* tab = (float*)(F.ws + WS_ROPE);
    for (int idx = blockIdx.x * (NWAVES * 64) + F.tid; idx < SEQ * 32; idx += F.G * NWAVES * 64) {
        const int t = idx >> 5, i = idx & 31;
        const float inv = exp2f(-(float)i * (13.287712379549449f / 32.0f));
        const float ang = (float)t * inv; float s, c; sincosf(ang, &s, &c);
        tab[t * 64 + i] = c; tab[t * 64 + 32 + i] = s; }
    if (F.wave < 2) {
#pragma unroll 1
        for (int part = blockIdx.x; part < 256; part += F.G) {
            const int kv = F.wave; const float* pos = (kv ? F.ka->in[20] : F.ka->in[19]) + 8 * part; const float* w = (kv ? F.ka->in[22] : F.ka->in[21]) + (size_t)(8 * part) * 64 + F.lane;
            float pv[8], wv[8];
#pragma unroll
            for (int i = 0; i < 8; ++i) { pv[i] = pos[i]; wv[i] = w[i * 64]; }
            float a = 0.f;
#pragma unroll
            for (int i = 0; i < 8; ++i) a += pv[i] * wv[i];
            ((float*)(F.ws + WS_CTL) + CW_CKP)[(kv * 256 + part) * 64 + F.lane] = a; }
    }
}
__device__ __forceinline__ void ck_reduce(Frame& F) {
    const int o = F.tid & 127, qd = F.tid >> 7; const float* cp = (const float*)(F.ws + WS_CTL) + CW_CKP + ((o >> 6) * 256 + 64 * qd) * 64 + (o & 63);
    float a = 0.f;
#pragma unroll 8
    for (int p = 0; p < 64; ++p) a += cp[p * 64];
    LAS float* red = (LAS float*)F.lds; red[F.tid] = a;
    __syncthreads();
    if (F.tid < 128) ((float*)(F.ws + WS_CTL) + CW_CK)[F.tid] = (red[F.tid] + red[F.tid + 128]) + (red[F.tid + 256] + red[F.tid + 384]);
}
__device__ __forceinline__ void prologue_phase(Frame& F) {
    prologue_misc(F);
    bf16* XB = (bf16*)(F.ws + WS_XB); float* PART = (float*)(F.ws + WS_PART);
    for (int m = F.gw; m < MTOK / 2; m += F.NGW) row2_to_bf16(F, F.ka->in[0] + (size_t)m * DM, XB + (size_t)m * DM, PART + (size_t)m * 16, (size_t)(MTOK / 2) * DM);
    bf16* MEMB = (bf16*)(F.ws + WS_MEMB); float* PARTM = (float*)(F.ws + WS_PARTM);
    for (int m = F.gw; m < MMEM; m += F.NGW) row_to_bf16(F, F.ka->in[1] + (size_t)m * DM, MEMB + (size_t)m * DM, PARTM + (size_t)m * 16);
    int itb = 0;
#pragma unroll 1
    for (int ly = 0; ly < DEPTH; ++ly) cvt_matrix(F, itb, F.ka->in[9] + (size_t)ly * DM * 512, nullptr, 512, 512, F.ka->in[8] + (size_t)ly * DM, (bf16*)(F.ws + WS_WKV) + (size_t)ly * 512 * DM, DM, 512, 0);
    cvt_matrix(F, itb, F.ka->in[21], nullptr, 64, 64, nullptr, (bf16*)(F.ws + WS_CMPW), 2048, 64, 0);
    cvt_matrix(F, itb, F.ka->in[22], nullptr, 64, 64, nullptr, (bf16*)(F.ws + WS_CMPW) + 64 * 2048, 2048, 64, 0);
    F.cv_lo = F.G > 128 ? CV_SPLIT : 0; convert_layer(F, 0); F.cv_lo = 0;
}

__device__ __forceinline__ void idle_convert(Frame& F, int Ly, int wi, int nw) {
    const int gw0 = F.gw, ngw0 = F.NGW;
    F.gw = wi * NWAVES + F.wave; F.NGW = nw * NWAVES; F.cv_lo = 0; F.cv_hi = CV_SPLIT;
    convert_layer(F, Ly);
    F.gw = gw0; F.NGW = ngw0; F.cv_lo = 0; F.cv_hi = 0x7fffffff;
}

template <unsigned PHASE_MASK> __global__ void __launch_bounds__(NWAVES * 64, 2) mk_fwd(Args args) {
    extern __shared__ __attribute__((aligned(16))) unsigned char lds[];
    __builtin_assume(blockIdx.x < 256u); __builtin_assume(gridDim.x <= 256u);
    Frame F;
    F.lds = (LAS unsigned char*)lds;
    F.MISC = (volatile LAS unsigned*)(F.lds + LDS_CTRL + 64);
    F.tid = threadIdx.x; F.lane = F.tid & 63; F.wave = __builtin_amdgcn_readfirstlane(F.tid >> 6); __builtin_assume(F.wave >= 0 && F.wave < NWAVES);
    F.G = gridDim.x; F.gw = blockIdx.x * NWAVES + F.wave; F.NGW = F.G * NWAVES; F.cv_lo = 0; F.cv_hi = 0x7fffffff;
    F.ws = args.ws; F.ctl = (gu32*)(args.ws + WS_CTL); F.out = args.out;
    F.ka = (KArgs)__builtin_amdgcn_kernarg_segment_ptr();
    for (int u = F.tid; u < 1024 / 4; u += NWAVES * 64) ((LAS unsigned*)(F.lds + LDS_CTRL))[u] = 0u;
    __syncthreads();
    XcdBarrier bar = xcd_barrier_post((unsigned*)(F.ctl + CW_BAR), F.MISC + 8);
    constexpr bool ALLPH = PHASE_MASK == 0xffffffffu;
    const int lo = ALLPH ? 0 : args.ph_lo, hi = ALLPH ? 0 : args.ph_hi; int pc = 0;
    const bool dry = ALLPH ? false : (args.dry != 0);
#define PH_BEGIN(id) if (ALLPH || ((((PHASE_MASK) >> (id)) & 1u) && lo <= pc && pc < hi)) { asm volatile("" : "+s"(F.ka), "+s"(F.ws), "+s"(F.out), "+s"(F.gw), "+s"(F.NGW), "+s"(F.G), "+s"(F.wave)); asm volatile("v_mbcnt_lo_u32_b32 %0, -1, 0\n\tv_mbcnt_hi_u32_b32 %0, -1, %0" : "=v"(F.lane)); F.tid = F.wave * 64 + F.lane;
#define PH_END_(islast)   if (ALLPH ? !(islast) : (pc + 1 < hi)) { XcdBarrier b2_ = bar; asm volatile("" : "+s"(b2_.bar), "+s"(b2_.x)); xcd_barrier(b2_); for (int e_ = 0; e_ < BAR_EXTRA; ++e_) { asm volatile("" : "+s"(b2_.bar), "+s"(b2_.x)); xcd_barrier(b2_); } } } if (!ALLPH) ++pc;
#define PH_END PH_END_(false)
#define QCTR(i) (F.ctl + CW_Q + 64 * (i))

#define RS_TABLE(S_) PG8_LAS float* rsl_ = F.G == 256 ? (PG8_LAS float*)(F.lds + RS_LDS_OFF) : nullptr;
#define XB ((bf16*)(F.ws + WS_XB))
#define VTB ((bf16*)F.out)
#define Yb ((bf16*)(F.ws + WS_Y))
#define HID ((bf16*)(F.ws + WS_HID))
#define PART ((float*)(F.ws + WS_PART))
    LAS unsigned char* ring = F.lds;

    PH_BEGIN(0) prologue_phase(F); PH_END
    PH_BEGIN(1) { pg8::Gemm g{(const bf16*)(F.ws + WS_MEMB), (const bf16*)(F.ws + WS_WKV), MMEM, 2048, DM}; pg8::StaticOrder S; S.init(MMEM, 2048, F.G, (int)blockIdx.x & 255);
        pg8::EpiScale E{(bf16*)(F.ws + WS_MKV), 2048, (const float*)(F.ws + WS_PARTM), nullptr};
        pg8::gemm_phase<pg8::EpiScale, pg8::StaticOrder, true, true>(ring, g, S, E, F.wave);
        if ((int)blockIdx.x == F.G - 1) ck_reduce(F);
        if (F.G > 128 && (int)blockIdx.x >= 128) { asm volatile("s_waitcnt vmcnt(0) lgkmcnt(0)\n\ts_barrier" ::: "memory"); idle_convert(F, 0, (int)blockIdx.x - 128, F.G - 128); } } PH_END

#pragma unroll 1
    for (int Ly = 0; Ly < DEPTH; ++Ly) {
#define WB ((const bf16*)(F.ws + WS_WBUF0 + (size_t)(Ly & 1) * WBUF_BYTES))
        const int kind = Ly % 3;
        const int ldp = kind == 0 ? RET_LD : (kind == 1 ? DSA_LD : NSA_LD);
        PH_BEGIN(3) { pg8::Gemm g{XB, WB + WB_W1A, MTOK, 2 * FF, DM}; pg8::StaticOrder S; S.init(MTOK, 2 * FF, F.G, (int)blockIdx.x & 255);
            RS_TABLE(S);
            pg8::EpiSwiglu E{HID, FF, PART, 0, rsl_};
            pg8::gemm_phase<pg8::EpiSwiglu, pg8::StaticOrder, true, true>(ring, g, S, E, F.wave); } PH_END
        PH_BEGIN(4) { pg8::Gemm g{HID, WB + WB_W2A, MTOK, DM, FF}; pg8::StaticOrder S; S.init(MTOK, DM, F.G, (int)blockIdx.x & 255);
            pg8::EpiResid E{XB, XB, nullptr, PART, dry ? 0.f : 0.5f};
            pg8::gemm_phase<pg8::EpiResid, pg8::StaticOrder, true, true>(ring, g, S, E, F.wave); } PH_END
        PH_BEGIN(5) { pg8::Gemm g{XB, WB + WB_WIN, MTOK, ldp, DM}; pg8::StaticOrder S; S.init(MTOK, ldp, F.G, (int)blockIdx.x & 255);
            RS_TABLE(S);
            pg8::EpiScale E{HID, ldp, PART, rsl_};
            pg8::gemm_phase<pg8::EpiScale, pg8::StaticOrder, true, true>(ring, g, S, E, F.wave);
            if (kind != 0 && Ly + 1 < DEPTH && F.G == 256 && (int)blockIdx.x >= 128 && !dry) idle_convert(F, Ly + 1, (int)blockIdx.x - 128, 128); } PH_END
        PH_BEGIN(6)
#define DO_X (!dry || DRY_MODE == 0 || DRY_MODE == 11)
#define DO_T (!dry || DRY_MODE == 0 || DRY_MODE == 12)
#define DO_C (!dry || DRY_MODE == 0 || DRY_MODE == 13)
            if (kind == 0) {
                if (DO_X) xform(F, HID, ldp, RET_K, 6, MTOK, SEQ, (dry ? Yb : HID), 0, (dry ? 1024 : ldp), (dry ? 0 : RET_K), nullptr, true, 0.125f, RET_MODE == 1 ? -1 : 0);
#if !QF_MEM
                xform(F, HID, ldp, RET_QM, 4, MTOK, SEQ, HID, 0, ldp, RET_QM, F.ka->in[10] + Ly * 64, false, QSCALE, 0);
#endif
                if (DO_T) transpose_cols(F, HID, ldp, RET_V, 768, NB, SEQ, VTB);
            } else if (kind == 1) {
                if (DO_X) xform(F, HID, ldp, DSA_K, 1, MTOK, SEQ, (dry ? Yb : HID), 0, (dry ? 1024 : ldp), (dry ? 0 : DSA_K), F.ka->in[15], true, 1.f, 0);
                if (DO_X) xform(F, HID, ldp, DSA_IK, 1, MTOK, SEQ, (dry ? Yb : HID), 0, (dry ? 1024 : ldp), (dry ? 0 : DSA_IK), nullptr, true, 1.f, 0);
#if !QF_MEM
                xform(F, HID, ldp, DSA_QM, 4, MTOK, SEQ, HID, 0, ldp, DSA_QM, F.ka->in[10] + Ly * 64, false, QSCALE, 0);
#endif
                if (DO_T) transpose_cols(F, HID, ldp, DSA_V, 64, NB, SEQ, VTB);
            } else {
                if (DO_T && blockIdx.x < 128) nsa_cmp_task(F, 2 * (int)blockIdx.x + (F.wave >> 2), F.wave & 3, HID, F.ka->in[18]);
                if (DO_X) xform(F, HID, ldp, NSA_KS, 4, MTOK, SEQ, (dry ? Yb : HID), 0, (dry ? 1024 : ldp), (dry ? 0 : NSA_KS), F.ka->in[18] + 64, true, 1.f, 0);
                if (DO_X) xform(F, HID, ldp, NSA_KW, 4, MTOK, SEQ, (dry ? Yb : HID), 0, (dry ? 1024 : ldp), (dry ? 0 : NSA_KW), F.ka->in[18] + 128, true, 1.f, 0);
#if !QF_MEM
                xform(F, HID, ldp, NSA_QM, 4, MTOK, SEQ, HID, 0, ldp, NSA_QM, F.ka->in[10] + Ly * 64, false, QSCALE, 0);
#endif
                if (DO_T) transpose_cols(F, HID, ldp, NSA_VS, 256, NB, SEQ, VTB);
                if (DO_T) transpose_cols(F, HID, ldp, NSA_VW, 256, NB, SEQ, VTB + (size_t)NB * 256 * SEQ);
            }
            if (Ly == 0 && !dry) {
#pragma unroll 1
        for (int ly = 0; ly < DEPTH; ++ly) {
            xform(F, (const bf16*)(F.ws + WS_MKV), 2048, ly * 512, 4, MMEM, NMEMT, (bf16*)(F.ws + WS_MK) + (size_t)ly * NB * 4 * NMEMT * 64, 1, 0, 0, F.ka->in[11] + ly * 64, false, 1.f, 0);
            transpose_cols(F, (const bf16*)(F.ws + WS_MKV), 2048, ly * 512 + 256, 256, NB, NMEMT, (bf16*)(F.ws + WS_MVT) + (size_t)ly * NB * 256 * NMEMT);
        }
            }
            if (DO_C && Ly + 1 < DEPTH) { F.cv_lo = (kind != 0 && F.G == 256 && !dry) ? CV_SPLIT : 0; convert_layer(F, Ly + 1); F.cv_lo = 0; }
#undef DO_X
#undef DO_T
#undef DO_C
        PH_END
        if (kind == 0) {
            PH_BEGIN(7)
                for (;;) {
                    asm volatile("s_waitcnt vmcnt(0) lgkmcnt(0)\n\ts_barrier" ::: "memory");
                    if (F.wave == 0 && pg8::lane_now() == 0) F.MISC[16] = __hip_atomic_fetch_add(QCTR(Ly * 8 + 0), 1u, RLX_AGENT);
                    asm volatile("s_waitcnt vmcnt(0) lgkmcnt(0)\n\ts_barrier" ::: "memory");
                    const int t = __builtin_amdgcn_readfirstlane((int)F.MISC[16]);
                    if (t >= NB * 6 + NB * 16) break;
                    asm volatile("v_mbcnt_lo_u32_b32 %0, -1, 0\n\tv_mbcnt_hi_u32_b32 %0, -1, %0" : "=v"(F.lane));
                    if (t < NB * 6) ret_state_task(F, t, HID); else mem_wg_task(F, t - NB * 6, Ly, HID, ldp, RET_QM);
                }
            PH_END
            PH_BEGIN(15)
                for (;;) {
                    asm volatile("s_waitcnt vmcnt(0) lgkmcnt(0)\n\ts_barrier" ::: "memory");
                    if (F.wave == 0 && pg8::lane_now() == 0) F.MISC[16] = __hip_atomic_fetch_add(QCTR(Ly * 8 + 3), 1u, RLX_AGENT);
                    asm volatile("s_waitcnt vmcnt(0) lgkmcnt(0)\n\ts_barrier" ::: "memory");
                    const int t = __builtin_amdgcn_readfirstlane((int)F.MISC[16]);
                    if (t >= NB * 6 * 8) break;
                    asm volatile("v_mbcnt_lo_u32_b32 %0, -1, 0\n\tv_mbcnt_hi_u32_b32 %0, -1, %0" : "=v"(F.lane));
                    ret_wg_task(F, t, HID);
                }
            PH_END
        } else if (kind == 1) {
            PH_BEGIN(8)
                for (;;) { asm volatile("v_mbcnt_lo_u32_b32 %0, -1, 0\n\tv_mbcnt_hi_u32_b32 %0, -1, %0" : "=v"(F.lane)); const int t = grab(QCTR(Ly * 8 + 0), F.lane); if (t >= 4608) break; if (!(dry && DRY_MODE == 21)) dsa_d1_task(F, t, HID); }
                for (;;) {
                    asm volatile("s_waitcnt vmcnt(0) lgkmcnt(0)\n\ts_barrier" ::: "memory");
                    if (F.wave == 0 && pg8::lane_now() == 0) F.MISC[16] = __hip_atomic_fetch_add(QCTR(Ly * 8 + 4), 1u, RLX_AGENT);
                    asm volatile("s_waitcnt vmcnt(0) lgkmcnt(0)\n\ts_barrier" ::: "memory");
                    const int t = __builtin_amdgcn_readfirstlane((int)F.MISC[16]);
                    if (t >= NB * 16) break;
                    asm volatile("v_mbcnt_lo_u32_b32 %0, -1, 0\n\tv_mbcnt_hi_u32_b32 %0, -1, %0" : "=v"(F.lane));
                    mem_wg_task(F, t, Ly, HID, ldp, DSA_QM);
                }
            PH_END
            PH_BEGIN(9)
                for (;;) { asm volatile("v_mbcnt_lo_u32_b32 %0, -1, 0\n\tv_mbcnt_hi_u32_b32 %0, -1, %0" : "=v"(F.lane)); const int t = grab(QCTR(Ly * 8 + 1), F.lane); if (t >= MTOK / 8) break;
{ v4u ra[4], rb[4], rc[4], rd[4]; d2_load(F, MTOK - 1 - 8 * t, ra); d2_load(F, MTOK - 2 - 8 * t, rb);
#pragma unroll 1
                      for (int i = 0; i < 8; i += 4) { d2_load(F, MTOK - 1 - (8 * t + i + 2), rc); d2_load(F, MTOK - 1 - (8 * t + i + 3), rd);
                          dsa_d2_row2(F, MTOK - 1 - (8 * t + i), MTOK - 1 - (8 * t + i + 1), ra, rb);
                          if (i + 4 < 8) { d2_load(F, MTOK - 1 - (8 * t + i + 4), ra); d2_load(F, MTOK - 1 - (8 * t + i + 5), rb); }
                          dsa_d2_row2(F, MTOK - 1 - (8 * t + i + 2), MTOK - 1 - (8 * t + i + 3), rc, rd); } } }
            PH_END
            PH_BEGIN(10)
                                for (;;) {
                    asm volatile("s_waitcnt vmcnt(0) lgkmcnt(0)\n\ts_barrier" ::: "memory");
                    if (F.wave == 0 && pg8::lane_now() == 0) F.MISC[16] = __hip_atomic_fetch_add(QCTR(Ly * 8 + 3), 1u, RLX_AGENT);
                    asm volatile("s_waitcnt vmcnt(0) lgkmcnt(0)\n\ts_barrier" ::: "memory");
                    const int t = __builtin_amdgcn_readfirstlane((int)F.MISC[16]);
                    if (t >= NB * 32) break;
                    asm volatile("v_mbcnt_lo_u32_b32 %0, -1, 0\n\tv_mbcnt_hi_u32_b32 %0, -1, %0" : "=v"(F.lane)); F.tid = F.wave * 64 + F.lane;
                    dsa_d3_wg_task(F, t, HID);
                }

            PH_END
        } else {
            PH_BEGIN(11)
                if (!(dry && DRY_MODE == 21)) for (;;) {
                    asm volatile("s_waitcnt vmcnt(0) lgkmcnt(0)\n\ts_barrier" ::: "memory");
                    if (F.wave == 0 && pg8::lane_now() == 0) { F.MISC[16] = __hip_atomic_fetch_add(QCTR(Ly * 8 + 3), 1u, RLX_AGENT); F.MISC[17] = 0u; }
                    asm volatile("s_waitcnt vmcnt(0) lgkmcnt(0)\n\ts_barrier" ::: "memory");
                    const int t = __builtin_amdgcn_readfirstlane((int)F.MISC[16]);
                    if (t >= NB * 4 * 8) break;
                    nsa_task<true>(F.ka, F.ws, F.out, F.lds, F.wave, t, HID);
                }
                for (;;) {
                    asm volatile("s_waitcnt vmcnt(0) lgkmcnt(0)\n\ts_barrier" ::: "memory");
                    if (F.wave == 0 && pg8::lane_now() == 0) F.MISC[16] = __hip_atomic_fetch_add(QCTR(Ly * 8 + 0), 1u, RLX_AGENT);
                    asm volatile("s_waitcnt vmcnt(0) lgkmcnt(0)\n\ts_barrier" ::: "memory");
                    const int t = __builtin_amdgcn_readfirstlane((int)F.MISC[16]);
                    if (t >= NB * 16) break;
                    asm volatile("v_mbcnt_lo_u32_b32 %0, -1, 0\n\tv_mbcnt_hi_u32_b32 %0, -1, %0" : "=v"(F.lane));
                    mem_wg_task(F, t, Ly, HID, ldp, NSA_QM);
                }
            PH_END
        }
        PH_BEGIN(12) { pg8::Gemm g{Yb, WB + WB_WO, MTOK, DM, DM}; pg8::StaticOrder S; S.init(MTOK, DM, F.G, (int)blockIdx.x & 255);
            pg8::EpiResid E{XB, XB, nullptr, PART, dry ? 0.f : 1.0f};
            pg8::gemm_phase<pg8::EpiResid, pg8::StaticOrder, true, true>(ring, g, S, E, F.wave); } PH_END
        PH_BEGIN(13) { pg8::Gemm g{XB, WB + WB_W1B, MTOK, 2 * FF, DM}; pg8::StaticOrder S; S.init(MTOK, 2 * FF, F.G, (int)blockIdx.x & 255);
            RS_TABLE(S);
            pg8::EpiSwiglu E{HID, FF, PART, 0, rsl_};
            pg8::gemm_phase<pg8::EpiSwiglu, pg8::StaticOrder, true, true>(ring, g, S, E, F.wave); } PH_END
        PH_BEGIN(14) { pg8::Gemm g{HID, WB + WB_W2B, MTOK, DM, FF}; pg8::StaticOrder S; S.init(MTOK, DM, F.G, (int)blockIdx.x & 255);
            pg8::EpiResid E{XB, XB, Ly == DEPTH - 1 ? F.out : nullptr, PART, dry ? 0.f : 0.5f};
            pg8::gemm_phase<pg8::EpiResid, pg8::StaticOrder, true, true>(ring, g, S, E, F.wave); } PH_END_(Ly == DEPTH - 1)
    }
#undef XB
#undef VTB
#undef Yb
#undef HID
#undef PART
#undef WB
#undef PH_BEGIN
#undef PH_END
#undef PH_END_
}

constexpr int LDS_BYTES = 147456;
#ifndef MK_PER_PHASE
#define MK_PER_PHASE 0
#endif
typedef void (*kern_t)(Args);
template <unsigned M> static kern_t kern_of() { return mk_fwd<M>; }
#if MK_PER_PHASE
static kern_t phase_kernel(int id) {
    switch (id) {
        case 0: return kern_of<1u << 0>(); case 1: return kern_of<1u << 1>(); case 2: return kern_of<1u << 2>(); case 3: return kern_of<1u << 3>(); case 4: return kern_of<1u << 4>();
        case 5: return kern_of<1u << 5>(); case 6: return kern_of<1u << 6>(); case 7: return kern_of<1u << 7>(); case 8: return kern_of<1u << 8>(); case 9: return kern_of<1u << 9>();
        case 10: return kern_of<1u << 10>(); case 11: return kern_of<1u << 11>(); case 12: return kern_of<1u << 12>(); case 13: return kern_of<1u << 13>(); default: return kern_of<1u << 14>();
    }
}
#endif
extern "C" void kernel_launch(void* const* d_in, const int* in_sizes, int n_in, void* d_out, int out_size, void* d_ws, size_t ws_size, hipStream_t stream) {
    static int grid = 0;
    if (grid == 0) {
        if (n_in != 23 || out_size != MTOK * DM || ws_size < WS_END) { fprintf(stderr, "kernel_launch: unexpected shapes (n_in %d, out %d, ws %zu)\n", n_in, out_size, ws_size); grid = -1; return; }
        int dev = 0, cus = 0;
        if (hipGetDevice(&dev) != hipSuccess || hipDeviceGetAttribute(&cus, hipDeviceAttributeMultiprocessorCount, dev) != hipSuccess) { grid = -1; return; }
#if MK_PER_PHASE
        for (int id = 0; id < 15; ++id) if (hipFuncSetAttribute((const void*)phase_kernel(id), hipFuncAttributeMaxDynamicSharedMemorySize, LDS_BYTES) != hipSuccess) { fprintf(stderr, "kernel_launch: hipFuncSetAttribute failed\n"); grid = -1; return; }
#else
        if (hipFuncSetAttribute((const void*)kern_of<0xffffffffu>(), hipFuncAttributeMaxDynamicSharedMemorySize, LDS_BYTES) != hipSuccess) { fprintf(stderr, "kernel_launch: hipFuncSetAttribute failed\n"); grid = -1; return; }
#endif
        (void)hipGetLastError();
        grid = cus < 256 ? cus : 256;
    }
    if (grid < 0) return;
    if (hipMemsetAsync((char*)d_ws + WS_CTL, 0, CTL_ZERO_BYTES, stream) != hipSuccess) return;
    Args a{};
    for (int i = 0; i < 23; ++i) a.in[i] = (const float*)d_in[i];
    a.out = (float*)d_out; a.ws = (unsigned char*)d_ws;
    constexpr int NPH = 2 + 8 * DEPTH + 2 + 2;
#if MK_PER_PHASE
    int ids[NPH]; int n = 0; ids[n++] = 0; ids[n++] = 1;
    for (int ly = 0; ly < DEPTH; ++ly) { ids[n++] = 3; ids[n++] = 4; ids[n++] = 5; ids[n++] = 6;
        if (ly % 3 == 0) { ids[n++] = 7; ids[n++] = 15; } else if (ly % 3 == 1) { ids[n++] = 8; ids[n++] = 9; ids[n++] = 10; } else ids[n++] = 11;
        ids[n++] = 12; ids[n++] = 13; ids[n++] = 14; }
    for (int p = 0; p < NPH; ++p) { a.ph_lo = p; a.ph_hi = p + 1;
#if PROBE_DUP
        if ((PROBE_DUP >> ids[p]) & 1) {
            a.dry = 1; hipLaunchKernelGGL(phase_kernel(ids[p]), dim3(grid), dim3(NWAVES * 64), LDS_BYTES, stream, a); a.dry = 0;
            hipMemsetAsync((char*)d_ws + WS_CTL + CW_Q * 4, 0, 64 * 4 * 64, stream); }
#endif
        hipLaunchKernelGGL(phase_kernel(ids[p]), dim3(grid), dim3(NWAVES * 64), LDS_BYTES, stream, a);
#if PROBE_EMPTY
        if (p == 1) for (int e = 0; e < PROBE_EMPTY; ++e) hipLaunchKernelGGL(phase_kernel(2), dim3(grid), dim3(NWAVES * 64), LDS_BYTES, stream, a);
#endif
    }
#else
    a.ph_lo = 0; a.ph_hi = NPH; hipLaunchKernelGGL(kern_of<0xffffffffu>(), dim3(grid), dim3(NWAVES * 64), LDS_BYTES, stream, a);
#endif
}
```
